# Optimizing an MI355X kernel written in HIP

```python
import math
import jax
import jax.numpy as jnp
from jax import lax
import numpy as np

D_MODEL = 1024
BATCH = 2
SEQ = 16384
DEPTH = 2

GRID_W = 64
CTX_LEN = 256
N_EVEN = (DEPTH + 1) // 2
N_ODD = DEPTH // 2

CONV_WIDTH = D_MODEL // 2
CONV_WIDTH_TAPS = 31
DIFF_HEAD_DIM = 64
DIFF_V_DIM = 2 * DIFF_HEAD_DIM
DIFF_HEADS = (D_MODEL // 2) // DIFF_V_DIM
QK_W = DIFF_HEADS * 2 * DIFF_HEAD_DIM
V_W = DIFF_HEADS * DIFF_V_DIM
EV_A0 = 2 * QK_W + V_W
EVEN_IN = EV_A0 + 2 * CONV_WIDTH
EVEN_OUT = CONV_WIDTH + V_W
ROPE_BASE = 10000.0
Q_BLOCK = 128

CHUNK = 128
GMLP_GROUPS = 4
GMLP_W = D_MODEL // 2
GMLP_GROUP_DIM = GMLP_W // GMLP_GROUPS
FOURIER_GROUPS = 4
FOURIER_W = D_MODEL // 2
FOURIER_GROUP_DIM = FOURIER_W // FOURIER_GROUPS
ODD_IN = 2 * GMLP_W + FOURIER_W
ODD_OUT = GMLP_W + FOURIER_W

N_EXPERTS = 32
TOP_K = 4
D_EXPERT = D_MODEL
SWIGLU_LIMIT = 7.0
SWIGLU_ALPHA = 1.702
EXPERT_BLOCK = 128

LN_EPS = 1e-5
DEEPNORM_ALPHA = (2 * DEPTH) ** 0.25
DEEPNORM_BETA = (8 * DEPTH) ** -0.25

kernel_name = 'hybrid_conformer_diffattn_gmlp_fnet_moe_dit'


def layer_norm(x, g, b):
    xf = x.astype(jnp.float32)
    mu = jnp.mean(xf, -1, keepdims=True)
    var = jnp.mean(jnp.square(xf - mu), -1, keepdims=True)
    return ((xf - mu) * lax.rsqrt(var + LN_EPS) * g.astype(jnp.float32) + b.astype(jnp.float32)).astype(x.dtype)


def rms_norm(x, g):
    xf = x.astype(jnp.float32)
    return (xf * lax.rsqrt(jnp.mean(xf * xf, -1, keepdims=True) + LN_EPS) * g.astype(jnp.float32)).astype(x.dtype)


def modulate(x, shift, scale):
    return x * (1.0 + scale) + shift


def axial_rope_tables(length):
    rows = length // GRID_W
    row = jnp.repeat(jnp.arange(rows, dtype=jnp.float32), GRID_W)
    col = jnp.tile(jnp.arange(GRID_W, dtype=jnp.float32), rows)
    n_freq = DIFF_HEAD_DIM // 4
    inv_freq = ROPE_BASE ** (-jnp.arange(n_freq, dtype=jnp.float32) / n_freq)
    ang = jnp.stack([row[:, None] * inv_freq, col[:, None] * inv_freq], axis=1)
    return jnp.cos(ang), jnp.sin(ang)


def apply_axial_rope(x, cos, sin):
    xs = x.astype(jnp.float32).reshape(x.shape[:-1] + (2, 2, DIFF_HEAD_DIM // 4))
    x1, x2 = xs[..., 0, :], xs[..., 1, :]
    c, s = cos[:, None, None], sin[:, None, None]
    out = jnp.stack([x1 * c - x2 * s, x1 * s + x2 * c], axis=-2)
    return out.reshape(x.shape).astype(x.dtype)


def heads_qk(z):
    return z.reshape(z.shape[:2] + (DIFF_HEADS, 2, DIFF_HEAD_DIM))


def heads_v(z):
    return z.reshape(z.shape[:2] + (DIFF_HEADS, DIFF_V_DIM))


def diff_lambda(lq1, lk1, lq2, lk2, lam_init):
    f32 = jnp.float32
    return (jnp.exp(jnp.sum(lq1.astype(f32) * lk1.astype(f32)))
            - jnp.exp(jnp.sum(lq2.astype(f32) * lk2.astype(f32))) + lam_init)


def diff_attend(q, k, v, lam):
    s = jnp.einsum('bqhcd,bkhcd->bhcqk', q, k, preferred_element_type=jnp.float32) * (DIFF_HEAD_DIM ** -0.5)
    p = jax.nn.softmax(s, axis=-1)
    w = p[:, :, 0] - lam * p[:, :, 1]
    return jnp.einsum('bhqk,bkhv->bqhv', w.astype(v.dtype), v)


def diff_attend_blocks(q, k, v, lam):
    b, length = q.shape[:2]
    n_blk = length // Q_BLOCK
    qb = jnp.moveaxis(q.reshape((b, n_blk, Q_BLOCK) + q.shape[2:]), 1, 0)
    out = lax.map(lambda qi: diff_attend(qi, k, v, lam), qb)
    return jnp.moveaxis(out, 0, 1).reshape((b, length) + out.shape[3:])


def diff_heads_out(o, g, lam_init):
    b, length = o.shape[:2]
    return (rms_norm(o, g) * (1.0 - lam_init)).reshape(b, length, V_W)


def conformer_conv(z, conv_w, conv_b, ln_g, ln_b):
    a = z[..., EV_A0:EV_A0 + CONV_WIDTH] * jax.nn.sigmoid(z[..., EV_A0 + CONV_WIDTH:])
    y = lax.conv_general_dilated(a, conv_w[:, None, :], window_strides=(1,),
                                 padding=[(CONV_WIDTH_TAPS // 2, CONV_WIDTH_TAPS // 2)],
                                 dimension_numbers=('NWC', 'WIO', 'NWC'),
                                 feature_group_count=CONV_WIDTH)
    return jax.nn.silu(layer_norm(y + conv_b, ln_g, ln_b))


def chunk_gmlp(u, v, ln_g, ln_b, ws, bs):
    b, length, _ = u.shape
    u = jax.nn.gelu(u)
    v = layer_norm(jax.nn.gelu(v), ln_g, ln_b)
    vc = v.reshape(b, length // CHUNK, CHUNK, GMLP_GROUPS, GMLP_GROUP_DIM)
    sv = jnp.einsum('gpq,bnqgc->bnpgc', ws, vc) + bs.T[:, :, None]
    return u * sv.reshape(b, length, GMLP_W)


def fourier_mix(f, ln_g, ln_b):
    b, length, _ = f.shape
    fg = f.reshape(b, length, FOURIER_GROUPS, FOURIER_GROUP_DIM)
    fg = layer_norm(fg, ln_g.reshape(FOURIER_GROUPS, FOURIER_GROUP_DIM), ln_b.reshape(FOURIER_GROUPS, FOURIER_GROUP_DIM))
    spec = jnp.fft.fft2(fg.astype(jnp.float32), axes=(1, 3), norm='ortho')
    return jnp.real(spec).astype(f.dtype).reshape(b, length, FOURIER_W)


def odd_mixer(z, gln_g, gln_b, ws, bs, fln_g, fln_b):
    spatial = chunk_gmlp(z[..., :GMLP_W], z[..., GMLP_W:2 * GMLP_W], gln_g, gln_b, ws, bs)
    spectral = fourier_mix(z[..., 2 * GMLP_W:], fln_g, fln_b)
    return jnp.concatenate([spatial, spectral], -1)


def expert_ffn(xb, wgu, bgu, wd, bd):
    gu = xb @ wgu + bgu
    x_glu, x_lin = jnp.split(gu, 2, axis=-1)
    x_glu = jnp.minimum(x_glu, SWIGLU_LIMIT)
    x_lin = jnp.clip(x_lin, -SWIGLU_LIMIT, SWIGLU_LIMIT)
    act = x_glu * jax.nn.sigmoid(SWIGLU_ALPHA * x_glu) * (x_lin + 1.0)
    return act @ wd + bd


def moe_channel_mixer(h, router_w, router_b, wgu, bgu, wd, bd):
    n_tok, d = h.shape
    logits = (h @ router_w + router_b).astype(jnp.float32)
    top_logit, top_e = lax.top_k(logits, TOP_K)
    gate = jax.nn.softmax(top_logit, axis=-1)
    n_asg = n_tok * TOP_K
    flat_e = top_e.reshape(-1)
    order = jnp.argsort(flat_e)
    sorted_e = flat_e[order]
    counts = jnp.bincount(flat_e, length=N_EXPERTS)
    padded = (counts + EXPERT_BLOCK - 1) // EXPERT_BLOCK * EXPERT_BLOCK
    pad_end = jnp.cumsum(padded)
    start = jnp.cumsum(counts) - counts
    dest = (pad_end - padded)[sorted_e] + jnp.arange(n_asg) - start[sorted_e]
    n_blk = -(-n_asg // EXPERT_BLOCK) + N_EXPERTS
    n_rows = n_blk * EXPERT_BLOCK
    row_tok = jnp.full((n_rows,), n_tok, jnp.int32).at[dest].set((order // TOP_K).astype(jnp.int32))
    row_gate = jnp.zeros((n_rows,), h.dtype).at[dest].set(gate.reshape(-1)[order].astype(h.dtype))
    blk_e = jnp.minimum(jnp.searchsorted(pad_end, jnp.arange(n_blk) * EXPERT_BLOCK, side='right'), N_EXPERTS - 1)
    h_pad = jnp.concatenate([h, jnp.zeros((1, d), h.dtype)], 0)
    xb = h_pad[row_tok].reshape(n_blk, EXPERT_BLOCK, d)
    yb = lax.map(lambda a: expert_ffn(a[0], wgu[a[1]], bgu[a[1]], wd[a[1]], bd[a[1]]), (xb, blk_e))
    y = yb.reshape(n_rows, d) * row_gate[:, None]
    return jnp.zeros((n_tok + 1, d), h.dtype).at[row_tok].add(y)[:n_tok]


def setup_inputs(seed: int = 0) -> dict:
    key = jax.random.key(seed)
    ks = iter(jax.random.split(key, 64))

    def nrm(shape, scale):
        return jax.random.normal(next(ks), shape, jnp.float32) * scale

    def gain(shape):
        return 1.0 + nrm(shape, 0.02)

    d, ne, no = D_MODEL, N_EVEN, N_ODD
    return {
        'x': nrm((BATCH, SEQ, d), 1.0),
        'c': nrm((BATCH, d), 1.0),
        'ctx': nrm((BATCH, CTX_LEN, d), 1.0),
        'c_ctx': nrm((d,), 1.0),
        'w_mod': nrm((DEPTH, d, 6 * d), 0.5 * d ** -0.5),
        'b_mod': nrm((DEPTH, 6 * d), 0.02),
        'ln1_g': gain((DEPTH, d)),
        'ln1_b': nrm((DEPTH, d), 0.02),
        'ln2_g': gain((DEPTH, d)),
        'ln2_b': nrm((DEPTH, d), 0.02),
        'ev_w_in': nrm((ne, d, EVEN_IN), d ** -0.5),
        'ev_w_out': nrm((ne, EVEN_OUT, d), DEEPNORM_BETA * EVEN_OUT ** -0.5),
        'conv_w': nrm((ne, CONV_WIDTH_TAPS, CONV_WIDTH), CONV_WIDTH_TAPS ** -0.5),
        'conv_b': nrm((ne, CONV_WIDTH), 0.02),
        'conv_ln_g': gain((ne, CONV_WIDTH)),
        'conv_ln_b': nrm((ne, CONV_WIDTH), 0.02),
        'lam_q1': nrm((ne, DIFF_HEAD_DIM), 0.1),
        'lam_k1': nrm((ne, DIFF_HEAD_DIM), 0.1),
        'lam_q2': nrm((ne, DIFF_HEAD_DIM), 0.1),
        'lam_k2': nrm((ne, DIFF_HEAD_DIM), 0.1),
        'diff_norm_g': gain((ne, DIFF_V_DIM)),
        'od_w_in': nrm((no, d, ODD_IN), d ** -0.5),
        'od_w_out': nrm((no, ODD_OUT, d), DEEPNORM_BETA * ODD_OUT ** -0.5),
        'gmlp_ln_g': gain((no, GMLP_W)),
        'gmlp_ln_b': nrm((no, GMLP_W), 0.02),
        'gmlp_ws': nrm((no, GMLP_GROUPS, CHUNK, CHUNK), CHUNK ** -0.5),
        'gmlp_bs': 1.0 + nrm((no, GMLP_GROUPS, CHUNK), 0.1),
        'four_ln_g': gain((no, FOURIER_W)),
        'four_ln_b': nrm((no, FOURIER_W), 0.02),
        'router_w': nrm((DEPTH, d, N_EXPERTS), d ** -0.5),
        'router_b': nrm((DEPTH, N_EXPERTS), 0.01),
        'w_gate_up': nrm((DEPTH, N_EXPERTS, d, 2 * D_EXPERT), d ** -0.5),
        'b_gate_up': nrm((DEPTH, N_EXPERTS, 2 * D_EXPERT), 0.02),
        'w_down': nrm((DEPTH, N_EXPERTS, D_EXPERT, d), DEEPNORM_BETA * D_EXPERT ** -0.5),
        'b_down': nrm((DEPTH, N_EXPERTS, d), 0.02),
    }


def reference(x, c, ctx, c_ctx, w_mod, b_mod, ln1_g, ln1_b, ln2_g, ln2_b,
              ev_w_in, ev_w_out, conv_w, conv_b, conv_ln_g, conv_ln_b,
              lam_q1, lam_k1, lam_q2, lam_k2, diff_norm_g,
              od_w_in, od_w_out, gmlp_ln_g, gmlp_ln_b, gmlp_ws, gmlp_bs,
              four_ln_g, four_ln_b,
              router_w, router_b, w_gate_up, b_gate_up, w_down, b_down):
    b, length, d = x.shape
    n_lat = b * length
    cos, sin = axial_rope_tables(length)
    h, hc = x, ctx
    for layer in range(DEPTH):
        even = layer % 2 == 0
        j = layer // 2
        ctx_out = any(l2 % 2 == 0 for l2 in range(layer + 1, DEPTH))
        mod = jax.nn.silu(c) @ w_mod[layer] + b_mod[layer]
        sh1, sc1, g1, sh2, sc2, g2 = jnp.split(mod[:, None, :], 6, axis=-1)
        if even or ctx_out:
            csh1, csc1, cg1, csh2, csc2, cg2 = jnp.split(jax.nn.silu(c_ctx) @ w_mod[layer] + b_mod[layer], 6)
            uc = modulate(hc, csh1, csc1)
        u = modulate(h, sh1, sc1)
        if even:
            w_in = ev_w_in[j]
            lam_init = 0.8 - 0.6 * math.exp(-0.3 * layer)
            lam = diff_lambda(lam_q1[j], lam_k1[j], lam_q2[j], lam_k2[j], lam_init)
            z = u @ w_in
            zc = uc @ (w_in if ctx_out else w_in[:, QK_W:EV_A0])
            zc_kv = zc[..., QK_W:EV_A0] if ctx_out else zc
            k_c = heads_qk(zc_kv[..., :QK_W])
            v_c = heads_v(zc_kv[..., QK_W:])
            q = apply_axial_rope(heads_qk(z[..., :QK_W]), cos, sin)
            k = apply_axial_rope(heads_qk(z[..., QK_W:2 * QK_W]), cos, sin)
            v = heads_v(z[..., 2 * QK_W:EV_A0])
            att = diff_attend_blocks(q, jnp.concatenate([k, k_c], 1), jnp.concatenate([v, v_c], 1), lam)
            conv = conformer_conv(z, conv_w[j], conv_b[j], conv_ln_g[j], conv_ln_b[j])
            y = jnp.concatenate([conv, diff_heads_out(att, diff_norm_g[j], lam_init)], -1) @ ev_w_out[j]
            if ctx_out:
                att_c = diff_attend(heads_qk(zc[..., :QK_W]), k_c, v_c, lam)
                conv_c = conformer_conv(zc, conv_w[j], conv_b[j], conv_ln_g[j], conv_ln_b[j])
                yc = jnp.concatenate([conv_c, diff_heads_out(att_c, diff_norm_g[j], lam_init)], -1) @ ev_w_out[j]
        else:
            y = odd_mixer(u @ od_w_in[j], gmlp_ln_g[j], gmlp_ln_b[j], gmlp_ws[j], gmlp_bs[j],
                          four_ln_g[j], four_ln_b[j]) @ od_w_out[j]
            if ctx_out:
                yc = odd_mixer(uc @ od_w_in[j], gmlp_ln_g[j], gmlp_ln_b[j], gmlp_ws[j], gmlp_bs[j],
                               four_ln_g[j], four_ln_b[j]) @ od_w_out[j]
        h = layer_norm(DEEPNORM_ALPHA * h + g1 * y, ln1_g[layer], ln1_b[layer])
        u2 = modulate(h, sh2, sc2).reshape(n_lat, d)
        if ctx_out:
            hc = layer_norm(DEEPNORM_ALPHA * hc + cg1 * yc, ln1_g[layer], ln1_b[layer])
            u2 = jnp.concatenate([u2, modulate(hc, csh2, csc2).reshape(-1, d)], 0)
        y2 = moe_channel_mixer(u2, router_w[layer], router_b[layer], w_gate_up[layer], b_gate_up[layer],
                               w_down[layer], b_down[layer])
        h = layer_norm(DEEPNORM_ALPHA * h + g2 * y2[:n_lat].reshape(b, length, d), ln2_g[layer], ln2_b[layer])
        if ctx_out:
            hc = layer_norm(DEEPNORM_ALPHA * hc + cg2 * y2[n_lat:].reshape(hc.shape), ln2_g[layer], ln2_b[layer])
    return h
```

```cpp
#include <hip/hip_runtime.h>
#include <cstdio>
#include <cstdint>

#define LAS __attribute__((address_space(3)))
#define GAS __attribute__((address_space(1)))
typedef unsigned short bf16_t;
typedef short bf16x8 __attribute__((ext_vector_type(8)));
typedef short s16x4 __attribute__((ext_vector_type(4)));
typedef float f32x4 __attribute__((ext_vector_type(4)));
typedef float f32x2 __attribute__((ext_vector_type(2)));
typedef float f32x16 __attribute__((ext_vector_type(16)));
typedef unsigned u32x4 __attribute__((ext_vector_type(4)));
typedef unsigned u32x2 __attribute__((ext_vector_type(2)));

namespace pg8 {
constexpr int BM = 256, BK = 64, HALF = 128, HTB = HALF * BK * 2, STAGE_BYTES = 8 * HTB, NXCD = 8, WGM = 8;
__host__ __device__ __forceinline__ int lds_byte(int r, int c) { const int st = (r >> 4) * 2 + (c >> 5), rr = r & 15, cc = c & 31, ob = rr * 64 + cc * 2; return st * 1024 + (ob ^ (((ob >> 9) & 1) << 5)); }
__host__ __device__ __forceinline__ void stage_rc(int b, int& R, int& C) { const int st = b / 1024, sb = b % 1024, swz = sb ^ (((sb >> 9) & 1) << 5); R = (st >> 1) * 16 + swz / 64; C = (st & 1) * 32 + (swz % 64) / 2; }
__host__ __device__ __forceinline__ int perm32(int rho) { const int n = rho >> 4, i = rho & 15; return 8 * (i >> 2) + 4 * n + (i & 3); }

struct Unit { int pm, pn, a0, a1, a2; };
struct Gemm { const bf16_t* A; const bf16_t* Bt; int M, N, K; };

struct StaticOrder {
    int nM, nN, nwg, G, c;
    __device__ void init(int M, int N, int G_, int c_) { nM = M / BM; nN = N / BM; nwg = nM * nN; G = G_; c = c_; }
    __device__ bool map(long L, Unit& u) const {
        if (L >= nwg) return false;
        int wgid = (int)L; { const int q = nwg / NXCD, r = nwg % NXCD, xcd = wgid % NXCD, off = wgid / NXCD; wgid = (xcd < r ? xcd * (q + 1) : r * (q + 1) + (xcd - r) * q) + off; }
        const int nig = WGM * nN, gid = wgid / nig, fm = gid * WGM, gsz = (nM - fm) < WGM ? (nM - fm) : WGM;
        u.pm = fm + ((wgid % nig) % gsz); u.pn = (wgid % nig) / gsz; u.a0 = 0; u.a1 = 0; u.a2 = 256; return true;
    }
    __device__ bool next(int i, Unit& u) const { return map((long)i * G + c, u); }
    __device__ __forceinline__ unsigned arow(const Unit&, int) const { return 0u; }
};

__device__ __forceinline__ unsigned cvt_pk_bf16(float lo, float hi) { unsigned r; asm volatile("v_cvt_pk_bf16_f32 %0, %1, %2" : "=v"(r) : "v"(lo), "v"(hi)); return r; }

__device__ __forceinline__ float gelu_tanh(float x) {
    const float t = x * (1.0f + 0.044715f * x * x) * (2.0f * 0.7978845608028654f * 1.4426950408889634f);
    return x * __builtin_amdgcn_rcpf(1.0f + __builtin_amdgcn_exp2f(-t));
}

struct EpiBf16 {
    static constexpr bool PERM = true;
    bf16_t* O; int ldc; int gelu_pn;
    __device__ __forceinline__ void operator()(const f32x4 (&acc)[2][2][4][2], const Unit& u, int wr, int wc, int fr, int fq) const {
        const int row0 = u.pm * BM + wr * 64 + fr; const int col0 = u.pn * BM + wc * 32 + 8 * fq;
        const bool act = u.pn < gelu_pn;
#pragma unroll
        for (int ai = 0; ai < 2; ++ai)
#pragma unroll
            for (int m = 0; m < 4; ++m) { bf16_t* rowp = O + (size_t)(row0 + ai * HALF + m * 16) * ldc + col0;
#pragma unroll
                for (int bj = 0; bj < 2; ++bj) { f32x4 v0 = acc[ai][bj][m][0], v1 = acc[ai][bj][m][1];
                    if (act) {
#pragma unroll
                        for (int j = 0; j < 4; ++j) { v0[j] = gelu_tanh(v0[j]); v1[j] = gelu_tanh(v1[j]); } }
                    u32x4 w; w.x = cvt_pk_bf16(v0[0], v0[1]); w.y = cvt_pk_bf16(v0[2], v0[3]); w.z = cvt_pk_bf16(v1[0], v1[1]); w.w = cvt_pk_bf16(v1[2], v1[3]);
                    *(u32x4*)(rowp + bj * HALF) = w; } }
    }
};

template <class Epi, class Sched, bool ALIGN_EPI, bool GATHER>
__device__ __forceinline__ void gemm_phase(LAS unsigned char* lds, const Gemm g, const Sched& S, const Epi& E, const int tid) {
    const int wid = __builtin_amdgcn_readfirstlane(tid >> 6), lane = tid & 63, wr = wid >> 2, wc = wid & 3, fr = lane & 15, fq = lane >> 4;
    const int K = g.K, nt = K / BK;
    unsigned voffA[2], voffB[2]; int Rr[2], Cc[2];
#pragma unroll
    for (int i = 0; i < 2; ++i) { int R, C; stage_rc(tid * 16 + i * 8192, R, C); const int Rb = Epi::PERM ? ((R & ~31) + perm32(R & 31)) : R; Rr[i] = R; Cc[i] = C;
        voffA[i] = (unsigned)(R * K + C) * 2u; voffB[i] = (unsigned)(Rb * K + C) * 2u; }
    const size_t kstep = (size_t)(BK * 2);
    const size_t hstep = (size_t)HALF * K * 2;
    const size_t tstep = 2 * hstep;
    const unsigned ldsw = (unsigned)wid * 1024u;
    const int aoff = lds_byte(wr * 64 + fr, fq * 8), boff = lds_byte(wc * 32 + fr, fq * 8);
#define PG8_SA(b, h) (((b) * 2 + (h)) * HTB)
#define PG8_SB(b, h) ((4 + (b) * 2 + (h)) * HTB)
#define PG8_STAGE(bufoff, gbase, voff) do { _Pragma("unroll") for (int _i = 0; _i < 2; ++_i) \
        __builtin_amdgcn_global_load_lds((const unsigned*)((const char*)(gbase) + (voff)[_i]), (LAS unsigned*)(lds + (bufoff) + ldsw + _i * 8192), 16, 0, 0); } while (0)
#define PG8_STAGE_A(bufoff, base, h, nx) do { if constexpr (GATHER) { _Pragma("unroll") for (int _i = 0; _i < 2; ++_i) { const unsigned _v = (nx) ? vAn[h][_i] : vAc[h][_i]; \
            __builtin_amdgcn_global_load_lds((const unsigned*)((const char*)(base) + _v), (LAS unsigned*)(lds + (bufoff) + ldsw + _i * 8192), 16, 0, 0); } } \
        else { PG8_STAGE(bufoff, (const char*)(base) + (h) * hstep, voffA); } } while (0)
#define PG8_LDA(dst, b, h) do { _Pragma("unroll") for (int m = 0; m < 4; ++m) _Pragma("unroll") for (int k = 0; k < 2; ++k) dst[m][k] = *(const LAS bf16x8*)(lds + PG8_SA(b, h) + aoff + m * 2048 + k * 1024); } while (0)
#define PG8_LDB(dst, b, h) do { _Pragma("unroll") for (int n = 0; n < 2; ++n) _Pragma("unroll") for (int k = 0; k < 2; ++k) dst[n][k] = *(const LAS bf16x8*)(lds + PG8_SB(b, h) + boff + n * 2048 + k * 1024); } while (0)
#define PG8_MMA(ai, bj, At, Bt) do { __builtin_amdgcn_s_setprio(1); _Pragma("unroll") for (int m = 0; m < 4; ++m) _Pragma("unroll") for (int n = 0; n < 2; ++n) _Pragma("unroll") for (int k = 0; k < 2; ++k) \
        acc[ai][bj][m][n] = __builtin_amdgcn_mfma_f32_16x16x32_bf16(Bt[n][k], At[m][k], acc[ai][bj][m][n], 0, 0, 0); __builtin_amdgcn_s_setprio(0); } while (0)
#define PG8_WAIT_V(n) asm volatile("s_waitcnt vmcnt(" #n ")" ::: "memory")
#define PG8_WAIT_L(n) asm volatile("s_waitcnt lgkmcnt(" #n ")" ::: "memory")
#define PG8_BAR __builtin_amdgcn_s_barrier()
#define PG8_SCHED __builtin_amdgcn_sched_barrier(0)
    Unit cur, nxt; int ui = 0;
    if (!S.next(0, cur)) return;
    f32x4 acc[2][2][4][2];
#pragma unroll
    for (int a = 0; a < 2; ++a)
#pragma unroll
        for (int b = 0; b < 2; ++b)
#pragma unroll
            for (int m = 0; m < 4; ++m)
#pragma unroll
                for (int n = 0; n < 2; ++n) acc[a][b][m][n] = (f32x4){0.f, 0.f, 0.f, 0.f};
    bf16x8 At[4][2], B0[2][2], B1[2][2];
    unsigned vAc[2][2], vAn[2][2];
#define PG8_ROWS(dst, un) do { if constexpr (GATHER) { _Pragma("unroll") for (int _h = 0; _h < 2; ++_h) _Pragma("unroll") for (int _i = 0; _i < 2; ++_i) \
        dst[_h][_i] = (S.arow(un, _h * HALF + Rr[_i]) * (unsigned)K + (unsigned)Cc[_i]) * 2u; } } while (0)
    PG8_ROWS(vAc, cur);
#pragma unroll
    for (int _h = 0; _h < 2; ++_h)
#pragma unroll
        for (int _i = 0; _i < 2; ++_i) vAn[_h][_i] = vAc[_h][_i];
    const char* cA = GATHER ? (const char*)g.A : (const char*)g.A + (size_t)cur.pm * tstep; const char* cB = (const char*)g.Bt + (size_t)cur.pn * tstep;
    PG8_STAGE(PG8_SB(0, 0), cB, voffB); PG8_STAGE(PG8_SB(0, 1), cB + hstep, voffB); PG8_STAGE_A(PG8_SA(0, 0), cA, 0, false); PG8_STAGE_A(PG8_SA(0, 1), cA, 1, false);
    if (wr == 1) PG8_BAR;
    PG8_WAIT_V(2); PG8_BAR;
    PG8_STAGE(PG8_SB(1, 0), cB + kstep, voffB); PG8_STAGE_A(PG8_SA(1, 0), cA + kstep, 0, false); PG8_STAGE(PG8_SB(1, 1), cB + hstep + kstep, voffB);
    PG8_WAIT_V(6); PG8_BAR;
    for (;;) {
        const bool has_next = S.next(ui + 1, nxt);
        if (has_next) { PG8_ROWS(vAn, nxt); if constexpr (GATHER) asm volatile("" : "+v"(vAn[0][0]), "+v"(vAn[0][1]), "+v"(vAn[1][0]), "+v"(vAn[1][1])); }
        const char* nA = GATHER ? (const char*)g.A : (has_next ? (const char*)g.A + (size_t)nxt.pm * tstep : cA);
        const char* nB = has_next ? (const char*)g.Bt + (size_t)nxt.pn * tstep : cB;
        for (int t = 0; t < nt; t += 2) {
            const bool last = (t == nt - 2);
            const bool nx = last && has_next;
            const char* a1 = cA + (size_t)(t + 1) * kstep;
            const char* a2 = last ? nA : cA + (size_t)(t + 2) * kstep; const char* b2 = last ? nB : cB + (size_t)(t + 2) * kstep;
            const char* a3 = a2 + kstep; const char* b3 = b2 + kstep;
            PG8_LDB(B0, 0, 0); PG8_LDB(B1, 0, 1); PG8_SCHED; PG8_LDA(At, 0, 0); PG8_STAGE_A(PG8_SA(1, 1), a1, 1, false);
            PG8_WAIT_V(8); PG8_WAIT_L(0); PG8_BAR; PG8_MMA(0, 0, At, B0); PG8_MMA(0, 1, At, B1); PG8_BAR; PG8_SCHED;
            PG8_LDA(At, 0, 1); PG8_STAGE(PG8_SB(0, 0), b2, voffB); PG8_STAGE(PG8_SB(0, 1), b2 + hstep, voffB); PG8_STAGE_A(PG8_SA(0, 0), a2, 0, nx);
            PG8_WAIT_V(8); PG8_WAIT_L(0); PG8_BAR; PG8_MMA(1, 0, At, B0); PG8_MMA(1, 1, At, B1); PG8_BAR; PG8_SCHED;
            PG8_LDB(B0, 1, 0); PG8_LDB(B1, 1, 1); PG8_SCHED; PG8_LDA(At, 1, 0); PG8_STAGE_A(PG8_SA(0, 1), a2, 1, nx);
            PG8_WAIT_V(8); PG8_WAIT_L(0); PG8_BAR; PG8_MMA(0, 0, At, B0); PG8_MMA(0, 1, At, B1); PG8_BAR; PG8_SCHED;
            PG8_LDA(At, 1, 1); PG8_STAGE(PG8_SB(1, 0), b3, voffB); PG8_STAGE(PG8_SB(1, 1), b3 + hstep, voffB); PG8_STAGE_A(PG8_SA(1, 0), a3, 0, nx);
            PG8_WAIT_V(8); PG8_WAIT_L(0); PG8_BAR; PG8_MMA(1, 0, At, B0); PG8_MMA(1, 1, At, B1); PG8_BAR; PG8_SCHED;
        }
        if constexpr (ALIGN_EPI) { if (wr == 0) PG8_BAR; }
        E(acc, cur, wr, wc, fr, fq);
        if (!has_next) break;
#pragma unroll
        for (int a = 0; a < 2; ++a)
#pragma unroll
            for (int b = 0; b < 2; ++b)
#pragma unroll
                for (int m = 0; m < 4; ++m)
#pragma unroll
                    for (int n = 0; n < 2; ++n) acc[a][b][m][n] = (f32x4){0.f, 0.f, 0.f, 0.f};
        cur = nxt; cA = nA; cB = nB; ++ui;
#pragma unroll
        for (int _h = 0; _h < 2; ++_h)
#pragma unroll
            for (int _i = 0; _i < 2; ++_i) vAc[_h][_i] = vAn[_h][_i];
        if constexpr (ALIGN_EPI) { if (wr == 1) PG8_BAR; }
    }
    PG8_WAIT_V(0);
    if constexpr (!ALIGN_EPI) { if (wr == 0) PG8_BAR; }
    PG8_BAR;
#undef PG8_SA
#undef PG8_SB
#undef PG8_STAGE
#undef PG8_STAGE_A
#undef PG8_ROWS
#undef PG8_LDA
#undef PG8_LDB
#undef PG8_MMA
#undef PG8_WAIT_V
#undef PG8_WAIT_L
#undef PG8_BAR
#undef PG8_SCHED
}
}

constexpr int DM = 1024, SEQ = 16384, NB = 2, T = NB * SEQ, CTX = 256, NCTX = NB * CTX, NKEY = SEQ + CTX;
constexpr int NE = 32, TOPK = 4, CAP = 32768;
constexpr float ALPHA = 1.4142135623730951f, LN_EPS = 1e-5f;
constexpr float QSCALE = 0.125f * 1.4426950408889634f;
constexpr float LAM_INIT0 = 0.2f;
constexpr int NWAVES = 8, NTHR = 512;

constexpr size_t MiB = 1u << 20;
constexpr size_t WS_CTL = 0, CTL_ZERO_BYTES = 1 * MiB;
constexpr size_t WS_MODP = 1 * MiB;
constexpr size_t WS_MOD = 3 * MiB;
constexpr size_t WS_TAB = 4 * MiB;
constexpr size_t WS_WEVIN = 6 * MiB, WS_WEVOUT = 11 * MiB, WS_WODIN = 13 * MiB, WS_WODOUT = 16 * MiB;
constexpr size_t WS_LIST = 18 * MiB, WS_GATES = 22 * MiB;
constexpr size_t WS_WGU = 32 * MiB;
constexpr size_t WS_WD = 288 * MiB;
constexpr size_t WS_U = 416 * MiB;
constexpr size_t WS_Q = 482 * MiB, WS_K = 514 * MiB, WS_V = 547 * MiB, WS_AB = 580 * MiB;
constexpr size_t WS_O0 = 612 * MiB;
constexpr size_t WS_MIX = 676 * MiB, WS_Y = 740 * MiB, WS_H1 = 804 * MiB, WS_U2 = 932 * MiB;
constexpr size_t WS_ACT = 996 * MiB;
constexpr size_t WS_YB = 1268 * MiB;
constexpr size_t WS_H2 = 1524 * MiB;
constexpr size_t WS_ZODD = 1652 * MiB;
constexpr size_t WS_WT = 1748 * MiB;
constexpr size_t WS_END = 1812 * MiB;
constexpr size_t TB_COS = 0, TB_SIN = 20480, TB_CS = 40960  , TB_AF = 106496  , TB_A3 = 237568  , TB_TW = 303104  , TB_WS = 434176  , TB_END = 565248;
constexpr int CW_ERR = 0, CW_BAR = 4096, CW_CNT = 16384;
#define XB_TMO      128
#define XB_XCNT(j)  (256  + 64 * (j))
#define XB_XSUB(j)  (1280 + 64 * (j))
#define XB_XGEN(j)  (2304 + 64 * (j))
#define XB_TOP      3328
#define XB_TOPGEN   3392
#define XCD_BAR_WORDS 3456
#define XB_SPIN_CAP (1u << 18)
constexpr int LDS_BYTES = 160 * 1024, MISC_OFF = LDS_BYTES - 256, META_OFF = 131072;

__device__ __forceinline__ unsigned xb_ld(unsigned* p)              { return __hip_atomic_load(p, __ATOMIC_RELAXED, __HIP_MEMORY_SCOPE_AGENT); }
__device__ __forceinline__ unsigned xb_add(unsigned* p, unsigned v) { return __hip_atomic_fetch_add(p, v, __ATOMIC_RELAXED, __HIP_MEMORY_SCOPE_AGENT); }
__device__ __forceinline__ unsigned xb_xcc_id() { return (unsigned)__builtin_amdgcn_s_getreg((3 << 11) | 20) & 0xFu; }
#define XB_SPIN(cond, bar) do { unsigned _sp = 0; while (cond) { __builtin_amdgcn_s_sleep(1); \
    if ((++_sp & 255u) == 0u) { if (xb_ld(&(bar)[XB_TMO])) break; if (_sp > XB_SPIN_CAP) { atomicAdd(&(bar)[XB_TMO], 1u); break; } } } } while (0)
struct XcdBarrier { unsigned* bar; unsigned x; volatile LAS unsigned* st; };
__device__ __forceinline__ XcdBarrier xcd_barrier_post(unsigned* bar, volatile LAS unsigned* st) {
    XcdBarrier b; b.bar = bar; b.x = xb_xcc_id(); b.st = st;
    if (threadIdx.x == 0) (void)xb_add(&bar[XB_XCNT(b.x)], 1u);
    return b;
}
__device__ __forceinline__ void xcd_barrier_complete(unsigned* bar, unsigned x, unsigned& nloc, unsigned& nx) {
    const unsigned G = gridDim.x * gridDim.y * gridDim.z;
    unsigned sum, cnt, mine, sp = 0u;
    for (;;) {
        sum = 0u; cnt = 0u; mine = 0u;
#pragma unroll
        for (unsigned j = 0; j < 16; ++j) { const unsigned c = xb_ld(&bar[XB_XCNT(j)]); sum += c; cnt += (c > 0u) ? 1u : 0u; mine = (j == x) ? c : mine; }
        if (sum == G) break;
        __builtin_amdgcn_s_sleep(1);
        if ((++sp & 255u) == 0u) { if (xb_ld(&bar[XB_TMO])) break; if (sp > XB_SPIN_CAP) { atomicAdd(&bar[XB_TMO], 1u); break; } }
    }
    nloc = mine > 0u ? mine : 1u; nx = cnt > 0u ? cnt : 1u;
}
__device__ __forceinline__ void xcd_barrier(const XcdBarrier& b) {
    asm volatile("s_waitcnt vmcnt(0)" ::: "memory");
    __syncthreads();
    if (threadIdx.x == 0) {
        unsigned* bar = b.bar;
        __builtin_amdgcn_s_waitcnt(0);
        unsigned nloc = b.st[0], nx = b.st[1];
        if (nloc == 0u) { xcd_barrier_complete(bar, b.x, nloc, nx); b.st[0] = nloc; b.st[1] = nx; }
        const unsigned old = xb_add(&bar[XB_XSUB(b.x)], 1u);
        const unsigned gen = old / nloc;
        if (old + 1u == (gen + 1u) * nloc) {
            __builtin_amdgcn_fence(__ATOMIC_RELEASE, "agent");
            asm volatile("s_waitcnt vmcnt(0)" ::: "memory");
            const unsigned og = xb_add(&bar[XB_TOP], 1u);
            const unsigned tg = og / nx;
            if (og + 1u == (tg + 1u) * nx) xb_add(&bar[XB_TOPGEN], 1u);
            else XB_SPIN(xb_ld(&bar[XB_TOPGEN]) == tg, bar);
            __builtin_amdgcn_fence(__ATOMIC_ACQUIRE, "agent");
            xb_add(&bar[XB_XGEN(b.x)], 1u);
            asm volatile("s_waitcnt vmcnt(0)" ::: "memory");
        } else {
            XB_SPIN(xb_ld(&bar[XB_XGEN(b.x)]) == gen, bar);
            __builtin_amdgcn_fence(__ATOMIC_ACQUIRE, "agent");
            asm volatile("s_waitcnt vmcnt(0)" ::: "memory");
        }
    }
    __syncthreads();
}

__device__ __forceinline__ float bf2f(unsigned short b) { return __uint_as_float(((unsigned)b) << 16); }
__device__ __forceinline__ unsigned f2bf(float f) { unsigned u = __float_as_uint(f); return (u + 0x7fffu + ((u >> 16) & 1u)) >> 16; }
__device__ __forceinline__ unsigned pk2(float lo, float hi) { return f2bf(lo) | (f2bf(hi) << 16); }
__device__ __forceinline__ float wave_sum(float v) {
#pragma unroll
    for (int o = 1; o < 64; o <<= 1) v += __shfl_xor(v, o);
    return v;
}
__device__ __forceinline__ float wave_max(float v) {
#pragma unroll
    for (int o = 1; o < 64; o <<= 1) v = fmaxf(v, __shfl_xor(v, o));
    return v;
}
__device__ __forceinline__ int crow(int r, int hi) { return (r & 3) + 8 * (r >> 2) + 4 * hi; }
__device__ __forceinline__ float silu_f(float x) { return x / (1.0f + __expf(-x)); }
__device__ __forceinline__ float sigmoid_f(float x) { return 1.0f / (1.0f + __expf(-x)); }
__device__ __forceinline__ int v_st(int k, int c) { const int kk = (k & ~0xC) | ((k & 4) << 1) | ((k & 8) >> 1); return ((kk >> 3) * 4 + (c >> 5)) * 512 + ((kk & 7) * 32 + (c & 31)) * 2; }
__device__ __forceinline__ int v_rd_base(int lane) { return ((lane & 3) << 3) | (((lane >> 2) & 3) << 6) | (((lane >> 4) & 1) << 5) | (((lane >> 5) & 1) << 8); }
__host__ __device__ constexpr int v_rd_off(int d0, int ks, int half) { return d0 * 512 + ks * 4096 + half * 2048; }
typedef short v4i16_t __attribute__((ext_vector_type(4)));
__device__ __forceinline__ bf16x8 vfrag(LAS unsigned char* tile_rd  , int d0, int ks) {
    const v4i16_t lo = __builtin_amdgcn_ds_read_tr16_b64_v4i16((LAS v4i16_t*)(tile_rd + v_rd_off(d0, ks, 0)));
    const v4i16_t hi = __builtin_amdgcn_ds_read_tr16_b64_v4i16((LAS v4i16_t*)(tile_rd + v_rd_off(d0, ks, 1)));
    return (bf16x8){lo[0], lo[1], lo[2], lo[3], hi[0], hi[1], hi[2], hi[3]};
}

struct Args { const float* in[35]; float* out; unsigned char* ws; int ph_lo, ph_hi; };

struct Frame { LAS unsigned char* lds; int tid, lane, wave, G, bx, kz; };
#define CAS __attribute__((address_space(4)))
__device__ __forceinline__ const float* kin_(int kz, int i) { return *(const float* const CAS*)((const CAS char*)__builtin_amdgcn_kernarg_segment_ptr() + kz + 8 * i); }
#define KIN(F, i) kin_((F).kz, (i))
#define KOUT(F) ((float*)kin_((F).kz, 35))
#define KWS(F) ((unsigned char*)kin_((F).kz, 36))
static_assert(sizeof(Args) == 37 * 8 + 8, "Args layout");

__device__ __forceinline__ void ph0_mod_tables(Frame& F) {
    const float* c = KIN(F, 1); const float* cctx = KIN(F, 3); const float* wmod = KIN(F, 4);
    LAS float* sv = (LAS float*)F.lds;
    for (int vb = F.bx; vb < 256; vb += F.G) {
    const int l = vb >> 7, rem = vb & 127, nch = rem & 7, kch = rem >> 3, k0 = kch * 64;
    if (F.tid < 192) { const int v = F.tid >> 6, k = F.tid & 63; const float x = (v < 2) ? c[v * DM + k0 + k] : cctx[k0 + k]; sv[v * 64 + k] = silu_f(x); }
    __syncthreads();
    if (F.tid < 384) {
        const int col = nch * 768 + F.tid * 2;
        const float* W = wmod + ((size_t)l * DM + k0) * 6144 + col;
        f32x2 a0 = {0.f, 0.f}, a1 = {0.f, 0.f}, a2 = {0.f, 0.f};
#pragma unroll 8
        for (int k = 0; k < 64; ++k) { const f32x2 w = *(const f32x2*)(W + (size_t)k * 6144); a0 += w * sv[k]; a1 += w * sv[64 + k]; a2 += w * sv[128 + k]; }
        float* mp = (float*)(KWS(F) + WS_MODP) + (size_t)kch * 5 * 6144 + col;
        if (l == 0) { *(f32x2*)(mp + 0 * 6144) = a0; *(f32x2*)(mp + 1 * 6144) = a1; *(f32x2*)(mp + 2 * 6144) = a2; }
        else { *(f32x2*)(mp + 3 * 6144) = a0; *(f32x2*)(mp + 4 * 6144) = a1; }
    }
    __syncthreads();
    }
    const int bx = F.bx;
    unsigned char* tb = KWS(F) + WS_TAB;
    const int gid = bx * NTHR + F.tid, NG = F.G * NTHR;
    const float s128 = 0.08838834764831845f;
    for (int i = gid; i < 5120; i += NG) {
        const int pos = i >> 4, f = i & 15; const int p = pos < 256 ? pos : pos - 256;
        const float inv = powf(10000.0f, -((float)f / 16.0f)); const float ang = (float)p * inv;
        ((float*)(tb + TB_COS))[i] = (float)cos((double)ang); ((float*)(tb + TB_SIN))[i] = (float)sin((double)ang);
    }
    for (int i = gid; i < 32768; i += NG) {
        const int j8 = i & 7, ln = (i >> 3) & 63, ks = (i >> 9) & 7, nb = i >> 12;
        const int n = 32 * nb + (ln & 31), cc = 16 * ks + 8 * (ln >> 5) + j8, part = n >> 7, jj = n & 127, m = (jj * cc) & 127;
        const double a = (double)m / 64.0; const float v = (part == 0 ? (float)cospi(a) : -(float)sinpi(a)) * s128;
        ((bf16_t*)(tb + TB_CS))[i] = (bf16_t)f2bf(v);
    }
    for (int i = gid; i < 65536; i += NG) {
        const int j8 = i & 7, ln = (i >> 3) & 63, ks = (i >> 9) & 15, mb = i >> 13;
        const int m = 32 * mb + (ln & 31), k = 16 * ks + 8 * (ln >> 5) + j8, mpart = m >> 7, k1 = m & 127, part = k >> 7, t1 = k & 127, ph = (k1 * t1) & 127;
        const double a = (double)ph / 64.0; const float cs = (float)cospi(a), sn = (float)sinpi(a);
        const float v = (mpart == 0 ? (part == 0 ? cs : sn) : (part == 0 ? -sn : cs)) * s128;
        ((bf16_t*)(tb + TB_AF))[i] = (bf16_t)f2bf(v);
    }
    for (int i = gid; i < 32768; i += NG) {
        const int j8 = i & 7, ln = (i >> 3) & 63, ks = (i >> 9) & 15, mb = i >> 13;
        const int k2 = 32 * mb + (ln & 31), k = 16 * ks + 8 * (ln >> 5) + j8, part = k >> 7, t2 = k & 127, ps = (k2 * t2) & 127;
        const double a = (double)ps / 64.0; const float v = (part == 0 ? (float)cospi(a) : (float)sinpi(a)) * s128;
        ((bf16_t*)(tb + TB_A3))[i] = (bf16_t)f2bf(v);
    }
    for (int i = gid; i < 16384; i += NG) {
        const int t2 = i >> 7, k1 = i & 127; const double a = (double)((k1 * t2) & 16383) / 8192.0;
        ((f32x2*)(tb + TB_TW))[i] = (f32x2){(float)cospi(a), (float)sinpi(a)};
    }
    const float* gws = KIN(F, 25);
    for (int i = gid; i < 65536; i += NG) ((bf16_t*)(tb + TB_WS))[i] = (bf16_t)f2bf(gws[i]);
}

__device__ __forceinline__ void transpose_item(const float* W, int K, int ldw, int k0, int n_src0, bf16_t* WT, int row_dst0, LAS float* scr, int lane) {
#pragma unroll 8
    for (int i = 0; i < 32; ++i) { const int kk = 2 * i + (lane >> 5); scr[kk * 33 + (lane & 31)] = W[(size_t)(k0 + kk) * ldw + n_src0 + (lane & 31)]; }
    asm volatile("s_waitcnt lgkmcnt(0)" ::: "memory");
    const int c = lane & 7;
#pragma unroll
    for (int j = 0; j < 4; ++j) { const int n = (lane >> 3) + 8 * j; const LAS float* s = scr + (8 * c) * 33 + n;
        u32x4 o; o.x = pk2(s[0 * 33], s[1 * 33]); o.y = pk2(s[2 * 33], s[3 * 33]); o.z = pk2(s[4 * 33], s[5 * 33]); o.w = pk2(s[6 * 33], s[7 * 33]);
        *(u32x4*)(WT + (size_t)(row_dst0 + n) * K + k0 + 8 * c) = o; }
    asm volatile("s_waitcnt lgkmcnt(0)" ::: "memory");
}
__device__ __forceinline__ void ph1_convert(Frame& F) {
    {
        const int gid = F.bx * NTHR + F.tid;
        if (gid < 5 * 6144) { const int vec = gid / 6144, n = gid % 6144, l = vec < 3 ? 0 : 1; float s = KIN(F, 5)[l * 6144 + n];
            const float* mp = (const float*)(KWS(F) + WS_MODP) + (size_t)vec * 6144 + n;
#pragma unroll
            for (int kc = 0; kc < 16; ++kc) s += mp[(size_t)kc * 5 * 6144];
            ((float*)(KWS(F) + WS_MOD))[gid] = s; }
    }
    LAS float* scr = (LAS float*)(F.lds + F.wave * 8704);
    const int gw = F.bx * NWAVES + F.wave, NGW = F.G * NWAVES;
    constexpr int I_EVIN = 16 * 80, I_EVOUT = 16 * 32, I_ODIN = 16 * 48, I_ODOUT = 16 * 32, I_DENSE = I_EVIN + I_EVOUT + I_ODIN + I_ODOUT;
    constexpr int I_GU = 64 * 1024, I_DN = 64 * 512, NITEMS = I_DENSE + I_GU + I_DN;
    for (int it = gw; it < NITEMS; it += NGW) {
        int r = it;
        if (r < I_EVIN) { const int kb = r / 80, nb = r % 80, n0 = 32 * nb; int src = n0;
            if (n0 >= 1536) { const int u = (n0 - 1536) >> 8, w = (n0 - 1536) & 255; src = (w < 128) ? 1536 + 128 * u + w : 2048 + 128 * u + (w - 128); }
            transpose_item(KIN(F, 10), DM, 2560, 64 * kb, src, (bf16_t*)(KWS(F) + WS_WEVIN), n0, scr, F.lane); continue; } r -= I_EVIN;
        if (r < I_EVOUT) { const int kb = r / 32, nb = r % 32; transpose_item(KIN(F, 11), DM, 1024, 64 * kb, 32 * nb, (bf16_t*)(KWS(F) + WS_WEVOUT), 32 * nb, scr, F.lane); continue; } r -= I_EVOUT;
        if (r < I_ODIN) { const int kb = r / 48, nb = r % 48; transpose_item(KIN(F, 21), DM, 1536, 64 * kb, 32 * nb, (bf16_t*)(KWS(F) + WS_WODIN), 32 * nb, scr, F.lane); continue; } r -= I_ODIN;
        if (r < I_ODOUT) { const int kb = r / 32, nb = r % 32; transpose_item(KIN(F, 22), DM, 1024, 64 * kb, 32 * nb, (bf16_t*)(KWS(F) + WS_WODOUT), 32 * nb, scr, F.lane); continue; } r -= I_ODOUT;
        if (r < I_GU) { const int le = r >> 10, q = r & 1023, kb = q >> 6, nb = q & 63, n0 = 32 * nb; const int u = n0 >> 8, w = n0 & 255;
            const int src = (w < 128) ? 128 * u + w : 1024 + 128 * u + (w - 128);
            transpose_item(KIN(F, 31) + (size_t)le * DM * 2048, DM, 2048, 64 * kb, src, (bf16_t*)(KWS(F) + WS_WGU) + (size_t)le * 2048 * DM, n0, scr, F.lane); continue; } r -= I_GU;
        { const int le = r >> 9, q = r & 511, kb = q >> 5, nb = q & 31;
            transpose_item(KIN(F, 33) + (size_t)le * DM * 1024, DM, 1024, 64 * kb, 32 * nb, (bf16_t*)(KWS(F) + WS_WD) + (size_t)le * 1024 * DM, 32 * nb, scr, F.lane); }
    }
}

__device__ __forceinline__ void mod_row(const float* xrow, const float* sh, const float* sc, bf16_t* orow, int lane) {
#pragma unroll
    for (int j = 0; j < 4; ++j) { const int d = 4 * lane + 256 * j; const f32x4 x = *(const f32x4*)(xrow + d), a = *(const f32x4*)(sc + d), b = *(const f32x4*)(sh + d);
        const f32x4 v = x * (a + 1.0f) + b; u32x2 w; w.x = pk2(v[0], v[1]); w.y = pk2(v[2], v[3]); *(u32x2*)(orow + d) = w; }
}
__device__ __forceinline__ void ph2_modulate(Frame& F) {
    const float* mod = (const float*)(KWS(F) + WS_MOD); bf16_t* U = (bf16_t*)(KWS(F) + WS_U);
    const int gw = F.bx * NWAVES + F.wave, NGW = F.G * NWAVES;
    for (int r = gw; r < T + NCTX; r += NGW) {
        if (r < T) { const int b = r >> 14; mod_row(KIN(F, 0) + (size_t)r * DM, mod + b * 6144, mod + b * 6144 + 1024, U + (size_t)r * DM, F.lane); }
        else { mod_row(KIN(F, 2) + (size_t)(r - T) * DM, mod + 2 * 6144, mod + 2 * 6144 + 1024, U + (size_t)r * DM, F.lane); }
    }
}

struct EvInOrder {
    pg8::StaticOrder so;
    __device__ bool next(int i, pg8::Unit& u) const {
        const long L = (long)i * so.G + so.c;
        if (L < so.nwg) return so.map(L, u);
        const int x = (int)(L - so.nwg); if (x >= 8) return false;
        u.pm = 128 + (x >> 2); u.pn = 2 + (x & 3); u.a0 = 0; u.a1 = 0; u.a2 = 256; return true;
    }
    __device__ __forceinline__ unsigned arow(const pg8::Unit&, int) const { return 0u; }
};
struct EpiEvIn {
    static constexpr bool PERM = false;
    bf16_t *Q, *Kb, *Vb, *Ab; const float* cosT; const float* sinT;
    __device__ __forceinline__ void operator()(const f32x4 (&acc)[2][2][4][2], const pg8::Unit& u, int wr, int wc, int fr, int fq) const {
        const int pn = u.pn;
        if (pn < 6) {
            const int kind = pn >> 1, colbase = (pn & 1) * 256 + wc * 32 + 4 * fq;
#pragma unroll
            for (int ai = 0; ai < 2; ++ai)
#pragma unroll
                for (int m = 0; m < 4; ++m) {
                    const int row = u.pm * 256 + ai * 128 + wr * 64 + m * 16 + fr; const bool isctx = row >= T;
                    int t, drow;
                    if (!isctx) { const int b = row >> 14; t = row & (SEQ - 1); drow = b * NKEY + t; } else { const int rc = row - T; t = 0; drow = (rc >> 8) * NKEY + SEQ + (rc & 255); }
                    f32x4 cs = {1.f, 1.f, 1.f, 1.f}, sn = {0.f, 0.f, 0.f, 0.f};
                    if (kind < 2 && !isctx) { const int pos = (wc & 1) ? 256 + (t & 63) : (t >> 6); cs = *(const f32x4*)(cosT + pos * 16 + 4 * fq); sn = *(const f32x4*)(sinT + pos * 16 + 4 * fq); }
                    bf16_t* dst = (kind == 0) ? Q + (size_t)row * 512 : ((kind == 1) ? Kb + (size_t)drow * 512 : Vb + (size_t)drow * 512);
                    if (kind == 0 && isctx) continue;
                    const float sc = (kind == 0) ? QSCALE : 1.0f;
#pragma unroll
                    for (int bj = 0; bj < 2; ++bj) {
                        const f32x4 x1 = acc[ai][bj][m][0], x2 = acc[ai][bj][m][1];
                        f32x4 o1, o2;
                        if (kind < 2) { o1 = (x1 * cs - x2 * sn) * sc; o2 = (x1 * sn + x2 * cs) * sc; } else { o1 = x1; o2 = x2; }
                        u32x2 w1, w2; w1.x = pk2(o1[0], o1[1]); w1.y = pk2(o1[2], o1[3]); w2.x = pk2(o2[0], o2[1]); w2.y = pk2(o2[2], o2[3]);
                        *(u32x2*)(dst + colbase + bj * 128) = w1; *(u32x2*)(dst + colbase + bj * 128 + 16) = w2;
                    }
                }
        } else {
            const int colbase = (pn - 6) * 128 + wc * 32 + 4 * fq;
#pragma unroll
            for (int ai = 0; ai < 2; ++ai)
#pragma unroll
                for (int m = 0; m < 4; ++m) {
                    const int row = u.pm * 256 + ai * 128 + wr * 64 + m * 16 + fr; if (row >= T) continue;
                    bf16_t* dst = Ab + (size_t)row * 512 + colbase;
#pragma unroll
                    for (int n = 0; n < 2; ++n) { const f32x4 v = acc[ai][0][m][n], g = acc[ai][1][m][n]; f32x4 o;
#pragma unroll
                        for (int j = 0; j < 4; ++j) o[j] = v[j] * sigmoid_f(g[j]);
                        u32x2 w; w.x = pk2(o[0], o[1]); w.y = pk2(o[2], o[3]); *(u32x2*)(dst + n * 16) = w; }
                }
        }
    }
};

__device__ __forceinline__ void ph4_conv(Frame& F) {
    const bf16_t* Ab = (const bf16_t*)(KWS(F) + WS_AB); bf16_t* MIX = (bf16_t*)(KWS(F) + WS_MIX);
    const float* cw = KIN(F, 12); const float* cb = KIN(F, 13); const float* lg = KIN(F, 14); const float* lb = KIN(F, 15);
    LAS bf16_t* At = (LAS bf16_t*)F.lds;
    LAS float* Yt = (LAS float*)(F.lds + 65536);
    const int ch = F.tid;
    float w[31];
#pragma unroll
    for (int j = 0; j < 31; ++j) w[j] = cw[j * 512 + ch];
    const float bias = cb[ch];
    for (int tile = F.bx; tile < T / 32; tile += F.G) {
        const int b = tile >> 9, t0 = (tile & 511) * 32;
        for (int idx = F.tid; idx < 62 * 64; idx += NTHR) { const int row = idx >> 6, c16 = idx & 63, t = t0 - 15 + row;
            u32x4 v = {0u, 0u, 0u, 0u}; if (t >= 0 && t < SEQ) v = *(const u32x4*)(Ab + ((size_t)(b * SEQ + t)) * 512 + c16 * 8);
            *(LAS u32x4*)(At + row * 512 + c16 * 8) = v; }
        __syncthreads();
        float a[62];
#pragma unroll
        for (int r = 0; r < 62; ++r) a[r] = bf2f(At[r * 512 + ch]);
#pragma unroll
        for (int t = 0; t < 32; ++t) { float y = bias;
#pragma unroll
            for (int j = 0; j < 31; ++j) y = fmaf(a[t + j], w[j], y);
            Yt[t * 512 + ch] = y; }
        __syncthreads();
#pragma unroll
        for (int q = 0; q < 4; ++q) { const int t = F.wave * 4 + q; const LAS float* yr = Yt + t * 512 + 8 * F.lane;
            const f32x4 y0 = *(const LAS f32x4*)yr, y1 = *(const LAS f32x4*)(yr + 4);
            float s = (y0[0] + y0[1]) + (y0[2] + y0[3]) + (y1[0] + y1[1]) + (y1[2] + y1[3]);
            const float mean = wave_sum(s) * (1.0f / 512.0f);
            const f32x4 d0 = y0 - mean, d1 = y1 - mean;
            float q2 = (d0[0] * d0[0] + d0[1] * d0[1]) + (d0[2] * d0[2] + d0[3] * d0[3]) + (d1[0] * d1[0] + d1[1] * d1[1]) + (d1[2] * d1[2] + d1[3] * d1[3]);
            const float rstd = 1.0f / sqrtf(wave_sum(q2) * (1.0f / 512.0f) + LN_EPS);
            const f32x4 g0 = *(const f32x4*)(lg + 8 * F.lane), g1 = *(const f32x4*)(lg + 8 * F.lane + 4), b0 = *(const f32x4*)(lb + 8 * F.lane), b1 = *(const f32x4*)(lb + 8 * F.lane + 4);
            f32x4 o0 = d0 * rstd * g0 + b0, o1 = d1 * rstd * g1 + b1;
#pragma unroll
            for (int j = 0; j < 4; ++j) { o0[j] = silu_f(o0[j]); o1[j] = silu_f(o1[j]); }
            u32x4 wv; wv.x = pk2(o0[0], o0[1]); wv.y = pk2(o0[2], o0[3]); wv.z = pk2(o1[0], o1[1]); wv.w = pk2(o1[2], o1[3]);
            *(u32x4*)(MIX + (size_t)(b * SEQ + t0 + t) * 1024 + 8 * F.lane) = wv; }
        __syncthreads();
    }
}

namespace att {
constexpr int KVBLK = 64, QBLK = 32;
constexpr int SHM_V = 64 * 128 * 2, SHM_K = 64 * 64 * 2;
constexpr int OFF_V = 0, OFF_K = 2 * SHM_V, OFF_WS = 2 * SHM_V + 2 * SHM_K;
constexpr float THR = 8.0f;
#define KSWZ64(row, colB) ((row) * 128 + ((colB) ^ ((((row) >> 1) & 7) << 4)))
#define SBAR() __builtin_amdgcn_sched_barrier(0)
__device__ __forceinline__ unsigned cvtpk(float lo, float hi) { unsigned r; asm volatile("v_cvt_pk_bf16_f32 %0, %1, %2" : "=v"(r) : "v"(lo), "v"(hi)); return r; }
__device__ __forceinline__ void partialSM(f32x16& p0, f32x16& p1, float& m_reg, float& mn, float& alpha) {
    float pmax = p0[0];
#pragma unroll
    for (int r = 1; r < 16; ++r) pmax = fmaxf(pmax, p0[r]);
#pragma unroll
    for (int r = 0; r < 16; ++r) pmax = fmaxf(pmax, p1[r]);
    { auto rr = __builtin_amdgcn_permlane32_swap(__float_as_uint(pmax), __float_as_uint(pmax), false, false);
      pmax = fmaxf(__uint_as_float(rr[0]), __uint_as_float(rr[1])); }
    if (__builtin_expect(__all(pmax - m_reg <= THR), 1)) { mn = m_reg; alpha = 1.f; }
    else { mn = fmaxf(m_reg, pmax); alpha = __builtin_amdgcn_exp2f(m_reg - mn); m_reg = mn; }
#pragma unroll
    for (int r = 0; r < 16; ++r) p0[r] = p0[r] - mn;
#pragma unroll
    for (int r = 0; r < 16; ++r) p1[r] = p1[r] - mn;
#pragma unroll
    for (int r = 0; r < 16; ++r) p0[r] = __builtin_amdgcn_exp2f(p0[r]);
}
__device__ __forceinline__ void finishSM(f32x16& p0, f32x16& p1, float alpha, float& l_reg, bf16x8& pa0, bf16x8& pa1, bf16x8& pa2, bf16x8& pa3) {
#pragma unroll
    for (int r = 0; r < 16; ++r) p1[r] = __builtin_amdgcn_exp2f(p1[r]);
    float ps = 0;
#pragma unroll
    for (int r = 0; r < 16; ++r) ps += p0[r];
#pragma unroll
    for (int r = 0; r < 16; ++r) ps += p1[r];
    { auto rr = __builtin_amdgcn_permlane32_swap(__float_as_uint(ps), __float_as_uint(ps), false, false);
      ps = __uint_as_float(rr[0]) + __uint_as_float(rr[1]); }
    l_reg = l_reg * alpha + ps;
#define PK4(P, BASE, OUT) do { unsigned a0 = cvtpk(P[BASE + 0], P[BASE + 1]), a1 = cvtpk(P[BASE + 2], P[BASE + 3]);   \
    unsigned b0 = cvtpk(P[BASE + 4], P[BASE + 5]), b1 = cvtpk(P[BASE + 6], P[BASE + 7]);                              \
    auto r0 = __builtin_amdgcn_permlane32_swap(a0, b0, false, false); auto r1 = __builtin_amdgcn_permlane32_swap(a1, b1, false, false); \
    u32x4 w = {r0[0], r1[0], r0[1], r1[1]}; OUT = __builtin_bit_cast(bf16x8, w); } while (0)
    PK4(p0, 0, pa0); PK4(p0, 8, pa1); PK4(p1, 0, pa2); PK4(p1, 8, pa3);
#undef PK4
}
__device__ __forceinline__ void qkt(f32x16& p0, f32x16& p1, const LAS unsigned char* Ks, const bf16x8* qr, int r32, int hi) {
    p0 = f32x16{}; p1 = f32x16{};
#pragma unroll
    for (int d0 = 0; d0 < 4; ++d0) { const int cb = (d0 * 16 + hi * 8) * 2;
        const bf16x8 b0 = *(const LAS bf16x8*)(Ks + KSWZ64(r32, cb));
        const bf16x8 b1 = *(const LAS bf16x8*)(Ks + KSWZ64(32 + r32, cb));
        p0 = __builtin_amdgcn_mfma_f32_32x32x16_bf16(b0, qr[d0], p0, 0, 0, 0);
        p1 = __builtin_amdgcn_mfma_f32_32x32x16_bf16(b1, qr[d0], p1, 0, 0, 0); }
}
template <int OFF> __device__ __forceinline__ s16x4 tr_read(int vb) {
    s16x4 r; asm volatile("ds_read_b64_tr_b16 %0, %1 offset:%2" : "=&v"(r) : "v"(vb), "i"(OFF) : "memory"); return r;
}
template <int D0> __device__ __forceinline__ void pv_one(f32x16& od, int vb, bf16x8 pa0, bf16x8 pa1, bf16x8 pa2, bf16x8 pa3) {
    const s16x4 l0 = tr_read<v_rd_off(D0, 0, 0)>(vb), h0 = tr_read<v_rd_off(D0, 0, 1)>(vb), l1 = tr_read<v_rd_off(D0, 1, 0)>(vb), h1 = tr_read<v_rd_off(D0, 1, 1)>(vb);
    const s16x4 l2 = tr_read<v_rd_off(D0, 2, 0)>(vb), h2 = tr_read<v_rd_off(D0, 2, 1)>(vb), l3 = tr_read<v_rd_off(D0, 3, 0)>(vb), h3 = tr_read<v_rd_off(D0, 3, 1)>(vb);
    asm volatile("s_waitcnt lgkmcnt(0)" ::: "memory"); SBAR();
#define PK(L, H) (bf16x8){L[0], L[1], L[2], L[3], H[0], H[1], H[2], H[3]}
    od = __builtin_amdgcn_mfma_f32_32x32x16_bf16(pa0, PK(l0, h0), od, 0, 0, 0);
    od = __builtin_amdgcn_mfma_f32_32x32x16_bf16(pa1, PK(l1, h1), od, 0, 0, 0);
    od = __builtin_amdgcn_mfma_f32_32x32x16_bf16(pa2, PK(l2, h2), od, 0, 0, 0);
    od = __builtin_amdgcn_mfma_f32_32x32x16_bf16(pa3, PK(l3, h3), od, 0, 0, 0);
#undef PK
}
__device__ __forceinline__ void pv_d0(f32x16* o, int vb, bf16x8 pa0, bf16x8 pa1, bf16x8 pa2, bf16x8 pa3) {
    pv_one<0>(o[0], vb, pa0, pa1, pa2, pa3); pv_one<1>(o[1], vb, pa0, pa1, pa2, pa3); pv_one<2>(o[2], vb, pa0, pa1, pa2, pa3); pv_one<3>(o[3], vb, pa0, pa1, pa2, pa3);
}

__device__ __forceinline__ void attn_pass(const bf16_t* __restrict__ Qw, const bf16_t* __restrict__ Kh, const bf16_t* __restrict__ Vh, LAS unsigned char* lds, f32x16 (&o)[4], float& l_out, const int tid) {
    const int wid = tid >> 6, lane = tid & 63, r32 = lane & 31, hi = lane >> 5;
    LAS unsigned char* V_lds = lds + OFF_V; LAS unsigned char* K_lds = lds + OFF_K;
    LAS float* al_l = (LAS float*)(lds + OFF_WS) + wid * 64 + 32;
    float m_reg = -1e30f, l_reg = 0;
#pragma unroll
    for (int d = 0; d < 4; ++d) o[d] = f32x16{};
    bf16x8 qr[4];
#pragma unroll
    for (int d0 = 0; d0 < 4; ++d0) qr[d0] = *(const bf16x8*)(Qw + d0 * 16);
    const int sr = tid >> 4, sc = (tid & 15) * 8, vst0 = v_st(sr, sc), vst1 = v_st(32 + sr, sc);
    const int kr = tid >> 3, kc = (tid & 7) * 8, kst = KSWZ64(kr, kc * 2);
    const int vb0 = (int)(uintptr_t)V_lds + v_rd_base(lane);
    struct { bf16x8 vs0, vs1, ks0; } sr_[2];
#define SLOAD(i, k0) do { sr_[i].vs0 = *(const bf16x8*)(&Vh[(long)((k0) + sr) * 512 + sc]); sr_[i].vs1 = *(const bf16x8*)(&Vh[(long)((k0) + 32 + sr) * 512 + sc]); \
    sr_[i].ks0 = *(const bf16x8*)(&Kh[(long)((k0) + kr) * 512 + kc]); } while (0)
#define SWRITE(b, i) do { *(LAS bf16x8*)(V_lds + (b) * SHM_V + vst0) = sr_[i].vs0; *(LAS bf16x8*)(V_lds + (b) * SHM_V + vst1) = sr_[i].vs1; \
    *(LAS bf16x8*)(K_lds + (b) * SHM_K + kst) = sr_[i].ks0; } while (0)
#define SWAIT() asm volatile("s_waitcnt vmcnt(3)" ::: "memory")
#define RESC(a) do { if (__any((a) < 1.f)) { if (hi == 0) al_l[r32] = (a); asm volatile("s_waitcnt lgkmcnt(0)" ::: "memory"); \
    _Pragma("unroll") for (int d = 0; d < 4; ++d) _Pragma("unroll") for (int r = 0; r < 16; ++r) o[d][r] *= al_l[crow(r, hi)]; } } while (0)
    f32x16 pA0, pA1, pB0, pB1; float mnA, mnB, alA, alB; bf16x8 pa0, pa1, pa2, pa3; constexpr int NT = NKEY / KVBLK;
    constexpr int SE = 0, SO = 1;
    SLOAD(SE, 0); asm volatile("s_waitcnt vmcnt(0)" ::: "memory"); SWRITE(0, SE); __syncthreads();
    qkt(pA0, pA1, K_lds, qr, r32, hi); partialSM(pA0, pA1, m_reg, mnA, alA);
    SLOAD(SO, KVBLK); SLOAD(SE, 2 * KVBLK);
    SWAIT(); SWRITE(1, SO); __syncthreads();
    for (int j = 1; j + 1 < NT; j += 2) {
        SBAR(); qkt(pB0, pB1, K_lds + SHM_K, qr, r32, hi);
        finishSM(pA0, pA1, alA, l_reg, pa0, pa1, pa2, pa3); SBAR();
        SLOAD(SO, (j + 2) * KVBLK); SBAR();
        pv_d0(o, vb0, pa0, pa1, pa2, pa3); partialSM(pB0, pB1, m_reg, mnB, alB);
        __syncthreads(); SWAIT(); SWRITE(0, SE);
        RESC(alB); __syncthreads();
        SBAR(); qkt(pA0, pA1, K_lds, qr, r32, hi);
        finishSM(pB0, pB1, alB, l_reg, pa0, pa1, pa2, pa3); SBAR();
        if (j + 3 < NT) SLOAD(SE, (j + 3) * KVBLK); SBAR();
        pv_d0(o, vb0 + SHM_V, pa0, pa1, pa2, pa3); partialSM(pA0, pA1, m_reg, mnA, alA);
        __syncthreads(); if (j + 3 < NT) SWAIT(); else asm volatile("s_waitcnt vmcnt(0)" ::: "memory"); SWRITE(1, SO);
        RESC(alA); __syncthreads();
    }
    SBAR(); qkt(pB0, pB1, K_lds + SHM_K, qr, r32, hi);
    finishSM(pA0, pA1, alA, l_reg, pa0, pa1, pa2, pa3); SBAR();
    pv_d0(o, vb0, pa0, pa1, pa2, pa3); partialSM(pB0, pB1, m_reg, mnB, alB);
    __syncthreads(); RESC(alB);
    finishSM(pB0, pB1, alB, l_reg, pa0, pa1, pa2, pa3); SBAR();
    pv_d0(o, vb0 + SHM_V, pa0, pa1, pa2, pa3);
    l_out = l_reg;
    __syncthreads();
#undef SLOAD
#undef SWRITE
#undef SWAIT
#undef RESC
}
}

__device__ __forceinline__ void ph4_attention(Frame& F) {
    const bf16_t* Q = (const bf16_t*)(KWS(F) + WS_Q); const bf16_t* Kb = (const bf16_t*)(KWS(F) + WS_K); const bf16_t* Vb = (const bf16_t*)(KWS(F) + WS_V);
    float* O0 = (float*)(KWS(F) + WS_O0); bf16_t* MIX = (bf16_t*)(KWS(F) + WS_MIX); const float* gn = KIN(F, 20);
    const int lane = F.lane, wid = F.wave;
    float lam;
    { const float a = wave_sum(KIN(F, 16)[lane] * KIN(F, 17)[lane]), b = wave_sum(KIN(F, 18)[lane] * KIN(F, 19)[lane]); lam = __expf(a) - __expf(b) + LAM_INIT0; }
    LAS float* li_l = (LAS float*)(F.lds + att::OFF_WS) + wid * 64;
    const int x = F.bx & 7, jb = F.bx >> 3;
    for (int vb = x; vb < 8; vb += 8) { const int b = vb >> 2, h = vb & 3;
    for (int qb = jb; qb < SEQ / 256; qb += (F.G >> 3)) {
        const long rowbase = (long)b * SEQ + qb * 256 + wid * 32;
        f32x16 o[4]; float l;
#pragma unroll 1
        for (int c = 0; c < 2; ++c) {
            const bf16_t* Qw = Q + (rowbase + (lane & 31)) * 512 + h * 128 + c * 64 + (lane >> 5) * 8;
            const bf16_t* Kh = Kb + (long)b * NKEY * 512 + h * 128 + c * 64;
            const bf16_t* Vh = Vb + (long)b * NKEY * 512 + h * 128;
            att::attn_pass(Qw, Kh, Vh, F.lds, o, l, F.tid);
            int lane_e = lane; asm volatile("" : "+v"(lane_e));
            const int r32 = lane_e & 31, hi = lane_e >> 5;
            if (hi == 0) li_l[r32] = l; asm volatile("s_waitcnt lgkmcnt(0)" ::: "memory");
            float rli[16];
#pragma unroll
            for (int r = 0; r < 16; ++r) rli[r] = __builtin_amdgcn_rcpf(li_l[crow(r, hi)]);
            if (c == 0) {
#pragma unroll
                for (int r = 0; r < 16; ++r) { const long grow = rowbase + crow(r, hi);
#pragma unroll
                    for (int d0 = 0; d0 < 4; ++d0) O0[grow * 512 + h * 128 + d0 * 32 + r32] = o[d0][r] * rli[r]; }
            } else {
                const float g0 = gn[r32], g1 = gn[32 + r32], g2 = gn[64 + r32], g3 = gn[96 + r32];
#pragma unroll
                for (int r = 0; r < 16; ++r) { const long grow = rowbase + crow(r, hi); const float* op = O0 + grow * 512 + h * 128 + r32;
                    const float v0 = op[0] - lam * (o[0][r] * rli[r]), v1 = op[32] - lam * (o[1][r] * rli[r]), v2 = op[64] - lam * (o[2][r] * rli[r]), v3 = op[96] - lam * (o[3][r] * rli[r]);
                    float ss = (v0 * v0 + v1 * v1) + (v2 * v2 + v3 * v3);
#pragma unroll
                    for (int off = 1; off < 32; off <<= 1) ss += __shfl_xor(ss, off);
                    const float scl = (1.0f - LAM_INIT0) / sqrtf(ss * (1.0f / 128.0f) + LN_EPS);
                    bf16_t* mp = MIX + grow * 1024 + 512 + h * 128 + r32;
                    mp[0] = (bf16_t)f2bf(v0 * scl * g0); mp[32] = (bf16_t)f2bf(v1 * scl * g1); mp[64] = (bf16_t)f2bf(v2 * scl * g2); mp[96] = (bf16_t)f2bf(v3 * scl * g3);
                    if ((r & 3) == 3) asm volatile("" ::: "memory"); }
            }
        }
    } }
}

__device__ __forceinline__ void ph_router(Frame& F, int layer, const float* hin) {
    const float* mod = (const float*)(KWS(F) + WS_MOD) + (size_t)(layer * 3) * 6144;
    const bf16_t* Y = (const bf16_t*)(KWS(F) + WS_Y); float* H1 = (float*)(KWS(F) + WS_H1); bf16_t* U2 = (bf16_t*)(KWS(F) + WS_U2);
    const float* lng = KIN(F, 6) + layer * DM; const float* lnb = KIN(F, 7) + layer * DM;
    const float* rw = KIN(F, 29) + (size_t)layer * DM * NE; const float* rb = KIN(F, 30) + layer * NE;
    unsigned* gcnt = (unsigned*)(KWS(F) + WS_CTL) + CW_CNT + layer * NE;
    unsigned* list = (unsigned*)(KWS(F) + WS_LIST); float* gates = (float*)(KWS(F) + WS_GATES);
    LAS float* rwT = (LAS float*)F.lds;
    LAS int* sel_e = (LAS int*)(F.lds + 131072);
    LAS float* sel_g = (LAS float*)(F.lds + 131072 + 2048);
    LAS unsigned* lcnt = (LAS unsigned*)(F.lds + 131072 + 4096);
    LAS unsigned* lbase = lcnt + 32;
    LAS unsigned* lpos = lcnt + 64;
    const int lane = F.lane;
    for (int i = F.tid; i < DM * NE; i += NTHR) { const int d = i >> 5, e = i & 31; rwT[e * DM + d] = rw[i]; }
    __syncthreads();
    for (int blk = F.bx; blk < T / 128; blk += F.G) {
        const int r0 = blk * 128, b = r0 >> 14;
        const float* g1 = mod + b * 6144 + 2048; const float* sh2 = mod + b * 6144 + 3072; const float* sc2 = mod + b * 6144 + 4096;
        if (F.tid < 32) lcnt[F.tid] = 0u;
        for (int q = 0; q < 16; ++q) {
            const int tl = F.wave * 16 + q, row = r0 + tl;
            f32x4 pre[4]; float s = 0.f;
#pragma unroll
            for (int j = 0; j < 4; ++j) { const int d = 4 * lane + 256 * j; const f32x4 x = *(const f32x4*)(hin + (size_t)row * DM + d); const u32x2 yw = *(const u32x2*)(Y + (size_t)row * DM + d);
                const f32x4 g = *(const f32x4*)(g1 + d);
                f32x4 y; y[0] = __uint_as_float(yw.x << 16); y[1] = __uint_as_float(yw.x & 0xffff0000u); y[2] = __uint_as_float(yw.y << 16); y[3] = __uint_as_float(yw.y & 0xffff0000u);
                pre[j] = x * ALPHA + g * y; s += (pre[j][0] + pre[j][1]) + (pre[j][2] + pre[j][3]); }
            const float mean = wave_sum(s) * (1.0f / DM); float q2 = 0.f;
#pragma unroll
            for (int j = 0; j < 4; ++j) { pre[j] = pre[j] - mean; q2 += (pre[j][0] * pre[j][0] + pre[j][1] * pre[j][1]) + (pre[j][2] * pre[j][2] + pre[j][3] * pre[j][3]); }
            const float rstd = 1.0f / sqrtf(wave_sum(q2) * (1.0f / DM) + LN_EPS);
            f32x4 u2[4];
#pragma unroll
            for (int j = 0; j < 4; ++j) { const int d = 4 * lane + 256 * j; const f32x4 h = pre[j] * rstd * *(const f32x4*)(lng + d) + *(const f32x4*)(lnb + d);
                *(f32x4*)(H1 + (size_t)row * DM + d) = h;
                u2[j] = h * (*(const f32x4*)(sc2 + d) + 1.0f) + *(const f32x4*)(sh2 + d);
                u32x2 w; w.x = pk2(u2[j][0], u2[j][1]); w.y = pk2(u2[j][2], u2[j][3]); *(u32x2*)(U2 + (size_t)row * DM + d) = w; }
            float p[32];
#pragma unroll
            for (int e = 0; e < 32; ++e) { float a = 0.f;
#pragma unroll
                for (int j = 0; j < 4; ++j) { const f32x4 w = *(const LAS f32x4*)(rwT + e * DM + 4 * lane + 256 * j); a += (u2[j][0] * w[0] + u2[j][1] * w[1]) + (u2[j][2] * w[2] + u2[j][3] * w[3]); }
                p[e] = a; }
#define RSTEP(N, MASK) do { const bool up = (lane & (MASK)) != 0; _Pragma("unroll") for (int i = 0; i < (N); ++i) { const float snd = up ? p[i] : p[i + (N)]; const float kp = up ? p[i + (N)] : p[i]; p[i] = kp + __shfl_xor(snd, (MASK)); } } while (0)
            RSTEP(16, 32); RSTEP(8, 16); RSTEP(4, 8); RSTEP(2, 4); RSTEP(1, 2);
#undef RSTEP
            float lg = p[0] + __shfl_xor(p[0], 1);
            const int me = lane >> 1; lg += rb[me];
            int es[4]; float ls[4];
#pragma unroll
            for (int k = 0; k < 4; ++k) { const float mx = wave_max(lg); const unsigned long long bal = __ballot(lg == mx); const int first = __ffsll((long long)bal) - 1; const int e = first >> 1;
                es[k] = e; ls[k] = mx; if (me == e) lg = -INFINITY; }
            const float e1 = __expf(ls[1] - ls[0]), e2 = __expf(ls[2] - ls[0]), e3 = __expf(ls[3] - ls[0]); const float inv = 1.0f / (1.0f + e1 + e2 + e3);
            if (lane == 0) { sel_e[tl * 4 + 0] = es[0]; sel_e[tl * 4 + 1] = es[1]; sel_e[tl * 4 + 2] = es[2]; sel_e[tl * 4 + 3] = es[3];
                sel_g[tl * 4 + 0] = inv; sel_g[tl * 4 + 1] = e1 * inv; sel_g[tl * 4 + 2] = e2 * inv; sel_g[tl * 4 + 3] = e3 * inv; }
        }
        __syncthreads();
        const int myE = sel_e[F.tid];
        lpos[F.tid] = __hip_atomic_fetch_add(&lcnt[myE], 1u, __ATOMIC_RELAXED, __HIP_MEMORY_SCOPE_WORKGROUP);
        __syncthreads();
        if (F.tid < 32) lbase[F.tid] = atomicAdd(&gcnt[F.tid], lcnt[F.tid]);
        __syncthreads();
        { const unsigned slot = (unsigned)(r0 * 4 + F.tid); list[(size_t)myE * CAP + lbase[myE] + lpos[F.tid]] = slot; gates[slot] = sel_g[F.tid]; }
        __syncthreads();
    }
}

struct MoeOrder {
    const LAS int* meta;
    const unsigned* list; int c, G, ncol, rpx;
    __device__ bool next(int i, pg8::Unit& u) const {
        const int x = c & 7, j = c >> 3; const int g = (i * 8 + x) * rpx + j / ncol; const int total = meta[32];
        if (g >= total) return false;
        int e = 0; while (meta[e + 1] <= g) ++e;
        const int rt = g - meta[e], cnt = meta[64 + e];
        u.pm = g; u.pn = e * ncol + (j % ncol); u.a0 = e; u.a1 = rt; u.a2 = min(256, cnt - rt * 256); return true;
    }
    __device__ __forceinline__ unsigned arow(const pg8::Unit& u, int R) const { return (R < u.a2) ? (list[(size_t)u.a0 * CAP + u.a1 * 256 + R] >> 2) : 0u; }
};
__device__ __forceinline__ void moe_meta(Frame& F, int layer) {
    LAS int* meta = (LAS int*)(F.lds + META_OFF);
    const unsigned* gcnt = (const unsigned*)(KWS(F) + WS_CTL) + CW_CNT + layer * NE;
    if (F.tid == 0) { int acc = 0; for (int e = 0; e < NE; ++e) { const int c = (int)__hip_atomic_load(&gcnt[e], __ATOMIC_RELAXED, __HIP_MEMORY_SCOPE_AGENT); meta[e] = acc; meta[64 + e] = c; acc += (c + 255) >> 8; } meta[32] = acc; }
    __syncthreads();
}
struct EpiGU {
    static constexpr bool PERM = true;
    bf16_t* ACT; const float* bgu;
    __device__ __forceinline__ void operator()(const f32x4 (&acc)[2][2][4][2], const pg8::Unit& u, int wr, int wc, int fr, int fq) const {
        const int e = u.a0, pnl = u.pn - e * 8; const int ccol = pnl * 128 + wc * 32 + 8 * fq; const int row0 = u.pm * 256 + wr * 64 + fr;
        f32x4 bg[2], bl[2];
#pragma unroll
        for (int n = 0; n < 2; ++n) { bg[n] = *(const f32x4*)(bgu + e * 2048 + ccol + 4 * n); bl[n] = *(const f32x4*)(bgu + e * 2048 + 1024 + ccol + 4 * n); }
#pragma unroll
        for (int ai = 0; ai < 2; ++ai)
#pragma unroll
            for (int m = 0; m < 4; ++m) { bf16_t* rowp = ACT + (size_t)(row0 + ai * 128 + m * 16) * 1024 + ccol; f32x4 o[2];
#pragma unroll
                for (int n = 0; n < 2; ++n) { const f32x4 gv = acc[ai][0][m][n] + bg[n], lv = acc[ai][1][m][n] + bl[n];
#pragma unroll
                    for (int j = 0; j < 4; ++j) { const float g = fminf(gv[j], 7.0f), l = fminf(fmaxf(lv[j], -7.0f), 7.0f);
                        o[n][j] = g * __builtin_amdgcn_rcpf(1.0f + __builtin_amdgcn_exp2f(-1.702f * 1.4426950408889634f * g)) * (l + 1.0f); } }
                u32x4 w; w.x = pg8::cvt_pk_bf16(o[0][0], o[0][1]); w.y = pg8::cvt_pk_bf16(o[0][2], o[0][3]); w.z = pg8::cvt_pk_bf16(o[1][0], o[1][1]); w.w = pg8::cvt_pk_bf16(o[1][2], o[1][3]);
                *(u32x4*)rowp = w; }
    }
};
struct EpiDown {
    static constexpr bool PERM = true;
    bf16_t* YB; const float* bd; const unsigned* list;
    __device__ __forceinline__ void operator()(const f32x4 (&acc)[2][2][4][2], const pg8::Unit& u, int wr, int wc, int fr, int fq) const {
        const int e = u.a0, rt = u.a1, pnl = u.pn - e * 4; const int col = pnl * 256 + wc * 32 + 8 * fq;
        f32x4 bv[2][2];
#pragma unroll
        for (int bj = 0; bj < 2; ++bj)
#pragma unroll
            for (int n = 0; n < 2; ++n) bv[bj][n] = *(const f32x4*)(bd + e * 1024 + col + bj * 128 + 4 * n);
#pragma unroll
        for (int ai = 0; ai < 2; ++ai)
#pragma unroll
            for (int m = 0; m < 4; ++m) { const int R = ai * 128 + wr * 64 + m * 16 + fr; if (R >= u.a2) continue;
                const unsigned slot = list[(size_t)e * CAP + rt * 256 + R]; bf16_t* rowp = YB + (size_t)slot * 1024 + col;
#pragma unroll
                for (int bj = 0; bj < 2; ++bj) { const f32x4 v0 = acc[ai][bj][m][0] + bv[bj][0], v1 = acc[ai][bj][m][1] + bv[bj][1];
                    u32x4 w; w.x = pg8::cvt_pk_bf16(v0[0], v0[1]); w.y = pg8::cvt_pk_bf16(v0[2], v0[3]); w.z = pg8::cvt_pk_bf16(v1[0], v1[1]); w.w = pg8::cvt_pk_bf16(v1[2], v1[3]);
                    *(u32x4*)(rowp + bj * 128) = w; } }
    }
};

__device__ __forceinline__ void ph_combine(Frame& F, int layer, float* hout, bool next_mod) {
    const float* mod = (const float*)(KWS(F) + WS_MOD) + (size_t)(layer * 3) * 6144;
    const float* modn = (const float*)(KWS(F) + WS_MOD) + (size_t)3 * 6144;
    const float* H1 = (const float*)(KWS(F) + WS_H1); const bf16_t* YB = (const bf16_t*)(KWS(F) + WS_YB); const float* gates = (const float*)(KWS(F) + WS_GATES);
    const float* lng = KIN(F, 8) + layer * DM; const float* lnb = KIN(F, 9) + layer * DM; bf16_t* U = (bf16_t*)(KWS(F) + WS_U);
    const int gw = F.bx * NWAVES + F.wave, NGW = F.G * NWAVES, lane = F.lane;
    for (int row = gw; row < T; row += NGW) {
        const int b = row >> 14; const float* g2 = mod + b * 6144 + 5120;
        const f32x4 gt = *(const f32x4*)(gates + (size_t)row * 4);
        f32x4 pre[4]; float s = 0.f;
#pragma unroll
        for (int j = 0; j < 4; ++j) { const int d = 4 * lane + 256 * j; f32x4 y = {0.f, 0.f, 0.f, 0.f};
#pragma unroll
            for (int k = 0; k < 4; ++k) { const u32x2 yw = *(const u32x2*)(YB + ((size_t)row * 4 + k) * DM + d);
                f32x4 v; v[0] = __uint_as_float(yw.x << 16); v[1] = __uint_as_float(yw.x & 0xffff0000u); v[2] = __uint_as_float(yw.y << 16); v[3] = __uint_as_float(yw.y & 0xffff0000u);
                y += v * gt[k]; }
            pre[j] = *(const f32x4*)(H1 + (size_t)row * DM + d) * ALPHA + *(const f32x4*)(g2 + d) * y; s += (pre[j][0] + pre[j][1]) + (pre[j][2] + pre[j][3]); }
        const float mean = wave_sum(s) * (1.0f / DM); float q2 = 0.f;
#pragma unroll
        for (int j = 0; j < 4; ++j) { pre[j] = pre[j] - mean; q2 += (pre[j][0] * pre[j][0] + pre[j][1] * pre[j][1]) + (pre[j][2] * pre[j][2] + pre[j][3] * pre[j][3]); }
        const float rstd = 1.0f / sqrtf(wave_sum(q2) * (1.0f / DM) + LN_EPS);
#pragma unroll
        for (int j = 0; j < 4; ++j) { const int d = 4 * lane + 256 * j; const f32x4 h = pre[j] * rstd * *(const f32x4*)(lng + d) + *(const f32x4*)(lnb + d);
            *(f32x4*)(hout + (size_t)row * DM + d) = h;
            if (next_mod) { const f32x4 v = h * (*(const f32x4*)(modn + b * 6144 + 1024 + d) + 1.0f) + *(const f32x4*)(modn + b * 6144 + d);
                u32x2 w; w.x = pk2(v[0], v[1]); w.y = pk2(v[2], v[3]); *(u32x2*)(U + (size_t)row * DM + d) = w; } }
    }
}

__device__ __forceinline__ void ph_gmlp(Frame& F) {
    const bf16_t* Z = (const bf16_t*)(KWS(F) + WS_ZODD); bf16_t* MIX = (bf16_t*)(KWS(F) + WS_MIX);
    const float* lg = KIN(F, 23); const float* lb = KIN(F, 24); const float* bs = KIN(F, 26); const bf16_t* wsb = (const bf16_t*)(KWS(F) + WS_TAB + TB_WS);
    const int lane = F.lane, r32 = lane & 31, hi = lane >> 5, wid = F.wave;
    for (int chunk = F.bx; chunk < T / 128; chunk += F.G) {
        const int r0 = chunk * 128;
        for (int qq = 0; qq < 16; ++qq) { const int q = wid * 16 + qq; const bf16x8 raw = *(const bf16x8*)(Z + (size_t)(r0 + q) * 1536 + 512 + 8 * lane);
            float v[8]; float s = 0.f;
#pragma unroll
            for (int j = 0; j < 8; ++j) { v[j] = bf2f((unsigned short)raw[j]); s += v[j]; }
            const float mean = wave_sum(s) * (1.0f / 512.0f); float q2 = 0.f;
#pragma unroll
            for (int j = 0; j < 8; ++j) { v[j] -= mean; q2 += v[j] * v[j]; }
            const float rstd = 1.0f / sqrtf(wave_sum(q2) * (1.0f / 512.0f) + LN_EPS);
            const f32x4 g0 = *(const f32x4*)(lg + 8 * lane), g1 = *(const f32x4*)(lg + 8 * lane + 4), b0 = *(const f32x4*)(lb + 8 * lane), b1 = *(const f32x4*)(lb + 8 * lane + 4);
            u32x4 w; w.x = pk2(v[0] * rstd * g0[0] + b0[0], v[1] * rstd * g0[1] + b0[1]); w.y = pk2(v[2] * rstd * g0[2] + b0[2], v[3] * rstd * g0[3] + b0[3]);
            w.z = pk2(v[4] * rstd * g1[0] + b1[0], v[5] * rstd * g1[1] + b1[1]); w.w = pk2(v[6] * rstd * g1[2] + b1[2], v[7] * rstd * g1[3] + b1[3]);
            const int ch = 8 * lane, g = ch >> 7, col = ch & 127, kt = (q >> 6) * 4 + g;
            *(LAS u32x4*)(F.lds + kt * 16384 + v_st(q & 63, col)) = w; }
        __syncthreads();
        const int pb = wid & 3, gh = wid >> 2;
#pragma unroll 1
        for (int gi = 0; gi < 2; ++gi) { const int g = 2 * gh + gi;
            f32x16 acc[4];
#pragma unroll
            for (int d0 = 0; d0 < 4; ++d0) acc[d0] = f32x16{};
#pragma unroll
            for (int ks = 0; ks < 8; ++ks) { const bf16x8 af = *(const bf16x8*)(wsb + ((size_t)g * 128 + 32 * pb + r32) * 128 + 16 * ks + 8 * hi);
                LAS unsigned char* trd = F.lds + ((ks >> 2) * 4 + g) * 16384 + v_rd_base(lane);
#pragma unroll
                for (int d0 = 0; d0 < 4; ++d0) acc[d0] = __builtin_amdgcn_mfma_f32_32x32x16_bf16(af, vfrag(trd, d0, ks & 3), acc[d0], 0, 0, 0); }
#pragma unroll
            for (int r = 0; r < 16; ++r) { const int p = 32 * pb + crow(r, hi); const float bias = bs[g * 128 + p];
#pragma unroll
                for (int d0 = 0; d0 < 4; ++d0) { const int ch = g * 128 + d0 * 32 + r32; const float uu = bf2f(Z[(size_t)(r0 + p) * 1536 + ch]);
                    MIX[(size_t)(r0 + p) * 1024 + ch] = (bf16_t)f2bf(uu * (acc[d0][r] + bias)); } }
        }
        __syncthreads();
    }
}

__device__ __forceinline__ void ph_fourier1(Frame& F) {
    const bf16_t* Z = (const bf16_t*)(KWS(F) + WS_ZODD); bf16_t* WT = (bf16_t*)(KWS(F) + WS_WT);
    const float* lg = KIN(F, 27); const float* lb = KIN(F, 28);
    const bf16x8* CSf = (const bf16x8*)(KWS(F) + WS_TAB + TB_CS); const bf16x8* AFf = (const bf16x8*)(KWS(F) + WS_TAB + TB_AF); const f32x2* tw = (const f32x2*)(KWS(F) + WS_TAB + TB_TW);
    const int lane = F.lane, r32 = lane & 31, hi = lane >> 5, wid = F.wave;
    for (int unit = F.bx; unit < NB * 128; unit += F.G) {
        const int b = unit >> 7, t2 = unit & 127;
#pragma unroll 1
        for (int g = 0; g < 4; ++g) {
            {
                const int tb = wid & 3, part = wid >> 2; int t1 = 32 * tb + r32; asm volatile("" : "+v"(t1)); const size_t row = (size_t)b * SEQ + 128 * t1 + t2;
                bf16x8 raw[8]; float s = 0.f;
#pragma unroll
                for (int ks = 0; ks < 8; ++ks) { raw[ks] = *(const bf16x8*)(Z + row * 1536 + 1024 + g * 128 + 16 * ks + 8 * hi);
#pragma unroll
                    for (int j = 0; j < 8; ++j) s += bf2f((unsigned short)raw[ks][j]); }
                s += __shfl_xor(s, 32); const float mean = s * (1.0f / 128.0f); float q2 = 0.f;
#pragma unroll
                for (int ks = 0; ks < 8; ++ks)
#pragma unroll
                    for (int j = 0; j < 8; ++j) { const float d = bf2f((unsigned short)raw[ks][j]) - mean; q2 += d * d; }
                q2 += __shfl_xor(q2, 32); const float rstd = 1.0f / sqrtf(q2 * (1.0f / 128.0f) + LN_EPS);
                bf16x8 af[8];
#pragma unroll
                for (int ks = 0; ks < 8; ++ks) { const int c0 = g * 128 + 16 * ks + 8 * hi; const f32x4 g0 = *(const f32x4*)(lg + c0), g1 = *(const f32x4*)(lg + c0 + 4), b0 = *(const f32x4*)(lb + c0), b1 = *(const f32x4*)(lb + c0 + 4);
                    float x[8];
#pragma unroll
                    for (int j = 0; j < 8; ++j) x[j] = (bf2f((unsigned short)raw[ks][j]) - mean) * rstd;
                    u32x4 w; w.x = pk2(x[0] * g0[0] + b0[0], x[1] * g0[1] + b0[1]); w.y = pk2(x[2] * g0[2] + b0[2], x[3] * g0[3] + b0[3]);
                    w.z = pk2(x[4] * g1[0] + b1[0], x[5] * g1[1] + b1[1]); w.w = pk2(x[6] * g1[2] + b1[2], x[7] * g1[3] + b1[3]);
                    af[ks] = __builtin_bit_cast(bf16x8, w); }
                f32x16 acc[4];
#pragma unroll
                for (int d0 = 0; d0 < 4; ++d0) acc[d0] = f32x16{};
#pragma unroll
                for (int ks = 0; ks < 8; ++ks) { unsigned fo = (unsigned)(((4 * part) * 8 + ks) * 64 + lane) * 16u; asm volatile("" : "+v"(fo));
#pragma unroll
                    for (int d0 = 0; d0 < 4; ++d0) acc[d0] = __builtin_amdgcn_mfma_f32_32x32x16_bf16(af[ks], *(const bf16x8*)((const char*)CSf + fo + d0 * 8192), acc[d0], 0, 0, 0); }
                int ybase = (part * 2 + (tb >> 1)) * 16384 + (tb & 1) * 8192 + hi * 2048 + r32 * 2; asm volatile("" : "+v"(ybase));
#pragma unroll
                for (int r = 0; r < 16; ++r)
#pragma unroll
                    for (int d0 = 0; d0 < 4; ++d0) *(LAS bf16_t*)(F.lds + ybase + ((r >> 3) & 1) * 4096 + d0 * 512 + ((r & 3) + 4 * ((r >> 2) & 1)) * 64) = (bf16_t)f2bf(acc[d0][r]);
            }
            __syncthreads();
            {
                const int kb = wid & 3, ch2 = wid >> 2;
                f32x16 aR[2], aI[2];
#pragma unroll
                for (int dd = 0; dd < 2; ++dd) { aR[dd] = f32x16{}; aI[dd] = f32x16{}; }
#pragma unroll
                for (int ks = 0; ks < 16; ++ks) { unsigned fo = (unsigned)((kb * 16 + ks) * 64 + lane) * 16u; asm volatile("" : "+v"(fo));
                    const bf16x8 fr = *(const bf16x8*)((const char*)AFf + fo), fi = *(const bf16x8*)((const char*)AFf + fo + 65536);
                    LAS unsigned char* trd = F.lds + (ks >> 2) * 16384 + v_rd_base(lane);
#pragma unroll
                    for (int dd = 0; dd < 2; ++dd) { const bf16x8 bf = vfrag(trd, 2 * ch2 + dd, ks & 3);
                        aR[dd] = __builtin_amdgcn_mfma_f32_32x32x16_bf16(fr, bf, aR[dd], 0, 0, 0); aI[dd] = __builtin_amdgcn_mfma_f32_32x32x16_bf16(fi, bf, aI[dd], 0, 0, 0); }
}
                int k1b = 32 * kb + 4 * hi; asm volatile("" : "+v"(k1b));
#pragma unroll
                for (int r = 0; r < 16; ++r) { const int k1 = k1b + (r & 3) + 8 * (r >> 2); const f32x2 cs = tw[t2 * 128 + k1];
                    bf16_t* dst = WT + ((((size_t)b * 128 + k1) * 128 + t2) * 4 + g) * 256;
#pragma unroll
                    for (int dd = 0; dd < 2; ++dd) { const float wr_ = aR[dd][r], wi_ = aI[dd][r]; const int j = 32 * (2 * ch2 + dd) + r32;
                        dst[j] = (bf16_t)f2bf(wr_ * cs[0] + wi_ * cs[1]); dst[128 + j] = (bf16_t)f2bf(wi_ * cs[0] - wr_ * cs[1]); }
                    if ((r & 3) == 3) asm volatile("" ::: "memory"); }
            }
            __syncthreads();
        }
    }
}
__device__ __forceinline__ void ph_fourier2(Frame& F) {
    const bf16_t* WT = (const bf16_t*)(KWS(F) + WS_WT); bf16_t* MIX = (bf16_t*)(KWS(F) + WS_MIX);
    const bf16x8* A3f = (const bf16x8*)(KWS(F) + WS_TAB + TB_A3);
    const int lane = F.lane, r32 = lane & 31, hi = lane >> 5, wid = F.wave;
    for (int unit = F.bx; unit < NB * 128; unit += F.G) {
        const int b = unit >> 7, k1 = unit & 127;
#pragma unroll 1
        for (int g = 0; g < 4; ++g) {
            for (int idx = F.tid; idx < 4096; idx += NTHR) { const int t2 = idx >> 5, c = idx & 31, part = c >> 4, j0 = (c & 15) * 8;
                const u32x4 v = *(const u32x4*)(WT + ((((size_t)b * 128 + k1) * 128 + t2) * 4 + g) * 256 + part * 128 + j0);
                *(LAS u32x4*)(F.lds + (part * 2 + (t2 >> 6)) * 16384 + v_st(t2 & 63, j0)) = v; }
            __syncthreads();
            const int mb = wid & 3, ch2 = wid >> 2;
            f32x16 acc[2] = {f32x16{}, f32x16{}};
#pragma unroll
            for (int ks = 0; ks < 16; ++ks) { unsigned fo = (unsigned)((mb * 16 + ks) * 64 + lane) * 16u; asm volatile("" : "+v"(fo)); const bf16x8 af = *(const bf16x8*)((const char*)A3f + fo);
                LAS unsigned char* trd = F.lds + (ks >> 2) * 16384 + v_rd_base(lane);
#pragma unroll
                for (int dd = 0; dd < 2; ++dd) acc[dd] = __builtin_amdgcn_mfma_f32_32x32x16_bf16(af, vfrag(trd, 2 * ch2 + dd, ks & 3), acc[dd], 0, 0, 0); }
#pragma unroll
            for (int r = 0; r < 16; ++r) { const int k2 = 32 * mb + crow(r, hi); const size_t row = (size_t)b * SEQ + k1 + 128 * k2;
#pragma unroll
                for (int dd = 0; dd < 2; ++dd) MIX[row * 1024 + 512 + g * 128 + 32 * (2 * ch2 + dd) + r32] = (bf16_t)f2bf(acc[dd][r]); }
            __syncthreads();
        }
    }
}

#ifndef MK_ONE_LAUNCH
#define MK_ONE_LAUNCH 1
#endif
constexpr int NPH = 18;
#ifndef PHMASK
#define PHMASK 0x3FFFF
#endif
#define HAS(k) (((PHMASK) >> (k)) & 1)
__global__ void __launch_bounds__(NTHR, 2) fwd_kernel(Args args) {
    extern __shared__ __attribute__((aligned(16))) unsigned char lds_raw[];
    Frame F;
    F.lds = (LAS unsigned char*)lds_raw; F.tid = threadIdx.x; F.lane = F.tid & 63; F.wave = __builtin_amdgcn_readfirstlane(F.tid >> 6); F.G = gridDim.x; F.bx = blockIdx.x;
    F.kz = 0;
    volatile LAS unsigned* MISC = (volatile LAS unsigned*)(F.lds + MISC_OFF);
    if (F.tid < 64) MISC[F.tid] = 0u;
    __syncthreads();
    if (MK_ONE_LAUNCH) (void)xcd_barrier_post((unsigned*)(args.ws + WS_CTL) + CW_BAR, MISC + 8);
    const int lo = args.ph_lo, hi = args.ph_hi;
#define IN(k) (lo <= (k) && (k) < hi)
#define ENTER() do { asm volatile("" : "+s"(F.kz), "+s"(F.wave), "+s"(F.G), "+s"(F.bx), "+v"(F.tid), "+v"(F.lane)); F.kz = __builtin_amdgcn_readfirstlane(F.kz); F.wave = __builtin_amdgcn_readfirstlane(F.wave); \
    F.G = __builtin_amdgcn_readfirstlane(F.G); F.bx = __builtin_amdgcn_readfirstlane(F.bx); } while (0)
#define SEAM(k) do { if (IN(k) && IN((k) + 1)) { if (MK_ONE_LAUNCH) { ENTER(); XcdBarrier bar_; bar_.bar = (unsigned*)(KWS(F) + WS_CTL) + CW_BAR; bar_.x = xb_xcc_id(); bar_.st = (volatile LAS unsigned*)(F.lds + MISC_OFF) + 8; xcd_barrier(bar_); } } } while (0)

    if (HAS(0) && IN(0)) { ENTER(); ph0_mod_tables(F); } SEAM(0);
    if (HAS(1) && IN(1)) { ENTER(); ph1_convert(F); } SEAM(1);
    if (HAS(2) && IN(2)) { ENTER(); ph2_modulate(F); } SEAM(2);

    for (int layer = 0; layer < 2; ++layer) {
        const int pb = layer == 0 ? 5 : 13;
        if (layer == 0) {
            if (HAS(3) && IN(3)) { ENTER();
                pg8::Gemm g{(const bf16_t*)(KWS(F) + WS_U), (const bf16_t*)(KWS(F) + WS_WEVIN), T, 2560, DM};
                EvInOrder S; S.so.init(T, 2560, F.G, F.bx);
                EpiEvIn E{(bf16_t*)(KWS(F) + WS_Q), (bf16_t*)(KWS(F) + WS_K), (bf16_t*)(KWS(F) + WS_V), (bf16_t*)(KWS(F) + WS_AB), (const float*)(KWS(F) + WS_TAB + TB_COS), (const float*)(KWS(F) + WS_TAB + TB_SIN)};
                pg8::gemm_phase<EpiEvIn, EvInOrder, true, false>(F.lds, g, S, E, F.tid);
            } SEAM(3);
            if (HAS(4) && IN(4)) { ENTER(); ph4_conv(F); ph4_attention(F); } SEAM(4);
        } else {
            if (HAS(10) && IN(10)) { ENTER();
                pg8::Gemm g{(const bf16_t*)(KWS(F) + WS_U), (const bf16_t*)(KWS(F) + WS_WODIN), T, 1536, DM};
                pg8::StaticOrder S; S.init(T, 1536, F.G, F.bx);
                pg8::EpiBf16 E{(bf16_t*)(KWS(F) + WS_ZODD), 1536, 4};
                pg8::gemm_phase<pg8::EpiBf16, pg8::StaticOrder, true, false>(F.lds, g, S, E, F.tid);
            } SEAM(10);
            if (HAS(11) && IN(11)) { ENTER(); ph_gmlp(F); ph_fourier1(F); } SEAM(11);
            if (HAS(12) && IN(12)) { ENTER(); ph_fourier2(F); } SEAM(12);
        }
        if (HAS(5) && IN(pb)) { ENTER();
            pg8::Gemm g{(const bf16_t*)(KWS(F) + WS_MIX), (const bf16_t*)(KWS(F) + (layer == 0 ? WS_WEVOUT : WS_WODOUT)), T, DM, DM};
            pg8::StaticOrder S; S.init(T, DM, F.G, F.bx);
            pg8::EpiBf16 E{(bf16_t*)(KWS(F) + WS_Y), DM, 0};
            pg8::gemm_phase<pg8::EpiBf16, pg8::StaticOrder, true, false>(F.lds, g, S, E, F.tid);
        } SEAM(pb);
        if (HAS(6) && IN(pb + 1)) { ENTER(); ph_router(F, layer, layer == 0 ? KIN(F, 0) : (const float*)(KWS(F) + WS_H2)); } SEAM(pb + 1);
        if (HAS(7) && IN(pb + 2)) { ENTER();
            moe_meta(F, layer);
            pg8::Gemm g{(const bf16_t*)(KWS(F) + WS_U2), (const bf16_t*)(KWS(F) + WS_WGU) + (size_t)layer * NE * 2048 * DM, 0, 0, DM};
            MoeOrder S{(const LAS int*)(F.lds + META_OFF), (const unsigned*)(KWS(F) + WS_LIST), F.bx, F.G, 8, 4};
            EpiGU E{(bf16_t*)(KWS(F) + WS_ACT), KIN(F, 32) + (size_t)layer * NE * 2048};
            pg8::gemm_phase<EpiGU, MoeOrder, true, true>(F.lds, g, S, E, F.tid);
        } SEAM(pb + 2);
        if (HAS(8) && IN(pb + 3)) { ENTER();
            moe_meta(F, layer);
            pg8::Gemm g{(const bf16_t*)(KWS(F) + WS_ACT), (const bf16_t*)(KWS(F) + WS_WD) + (size_t)layer * NE * 1024 * DM, 0, 0, DM};
            MoeOrder S{(const LAS int*)(F.lds + META_OFF), (const unsigned*)(KWS(F) + WS_LIST), F.bx, F.G, 4, 8};
            EpiDown E{(bf16_t*)(KWS(F) + WS_YB), KIN(F, 34) + (size_t)layer * NE * 1024, (const unsigned*)(KWS(F) + WS_LIST)};
            pg8::gemm_phase<EpiDown, MoeOrder, true, false>(F.lds, g, S, E, F.tid);
        } SEAM(pb + 3);
        if (HAS(9) && IN(pb + 4)) { ENTER(); ph_combine(F, layer, layer == 0 ? (float*)(KWS(F) + WS_H2) : KOUT(F), layer == 0); }
        if (layer == 0) SEAM(pb + 4);
    }
#undef IN
#undef SEAM
}

extern "C" void kernel_launch(void* const* d_in, const int* in_sizes, int n_in, void* d_out, int out_size, void* d_ws, size_t ws_size, hipStream_t stream) {
    static int grid = 0;
    if (grid == 0) {
        if (n_in != 35 || out_size != T * DM || ws_size < WS_END) { fprintf(stderr, "kernel_launch: unexpected shapes: n_in %d out %d ws %zu (need %zu)\n", n_in, out_size, ws_size, (size_t)WS_END); grid = -1; return; }
        int dev = 0, cus = 0;
        if (hipGetDevice(&dev) != hipSuccess || hipDeviceGetAttribute(&cus, hipDeviceAttributeMultiprocessorCount, dev) != hipSuccess) { grid = -1; return; }
        if (hipFuncSetAttribute((const void*)fwd_kernel, hipFuncAttributeMaxDynamicSharedMemorySize, LDS_BYTES) != hipSuccess) { fprintf(stderr, "kernel_launch: hipFuncSetAttribute failed\n"); grid = -1; return; }
        int per_cu = 0; (void)hipOccupancyMaxActiveBlocksPerMultiprocessor(&per_cu, (const void*)fwd_kernel, NTHR, LDS_BYTES); (void)hipGetLastError();
        if (per_cu < 1) fprintf(stderr, "kernel_launch: occupancy query reports %d blocks per CU\n", per_cu);
        grid = cus > 256 ? 256 : cus;
        if (grid != 256) fprintf(stderr, "kernel_launch: %d CUs; this kernel is laid out for 256\n", cus);
    }
    if (grid < 0) return;
    (void)hipMemsetAsync((char*)d_ws + WS_CTL, 0, CTL_ZERO_BYTES, stream);
    Args a{};
    for (int i = 0; i < 35; ++i) a.in[i] = (const float*)d_in[i];
    a.out = (float*)d_out; a.ws = (unsigned char*)d_ws;
#if MK_ONE_LAUNCH
    a.ph_lo = 0; a.ph_hi = NPH;
    hipLaunchKernelGGL(fwd_kernel, dim3(grid), dim3(NTHR), LDS_BYTES, stream, a);
#else
    for (int p = 0; p < NPH; ++p) { a.ph_lo = p; a.ph_hi = p + 1; hipLaunchKernelGGL(fwd_kernel, dim3(grid), dim3(NTHR), LDS_BYTES, stream, a); }
#endif
    const hipError_t le = hipPeekAtLastError();
    if (le != hipSuccess) fprintf(stderr, "kernel_launch: launch failed: %s\n", hipGetErrorName(le));
}
```

```cpp
#include <hip/hip_runtime.h>
#include <cstdio>
#include <cstdint>

#define LAS __attribute__((address_space(3)))
#define GAS __attribute__((address_space(1)))
typedef unsigned short bf16_t;
typedef short bf16x8 __attribute__((ext_vector_type(8)));
typedef short s16x4 __attribute__((ext_vector_type(4)));
typedef float f32x4 __attribute__((ext_vector_type(4)));
typedef float f32x2 __attribute__((ext_vector_type(2)));
typedef float f32x16 __attribute__((ext_vector_type(16)));
typedef unsigned u32x4 __attribute__((ext_vector_type(4)));
typedef unsigned u32x2 __attribute__((ext_vector_type(2)));

namespace pg8 {
constexpr int BM = 256, BK = 64, HALF = 128, HTB = HALF * BK * 2, STAGE_BYTES = 8 * HTB, NXCD = 8, WGM = 8;
__host__ __device__ __forceinline__ int lds_byte(int r, int c) { const int st = (r >> 4) * 2 + (c >> 5), rr = r & 15, cc = c & 31, ob = rr * 64 + cc * 2; return st * 1024 + (ob ^ (((ob >> 9) & 1) << 5)); }
__host__ __device__ __forceinline__ void stage_rc(int b, int& R, int& C) { const int st = b / 1024, sb = b % 1024, swz = sb ^ (((sb >> 9) & 1) << 5); R = (st >> 1) * 16 + swz / 64; C = (st & 1) * 32 + (swz % 64) / 2; }
__host__ __device__ __forceinline__ int perm32(int rho) { const int n = rho >> 4, i = rho & 15; return 8 * (i >> 2) + 4 * n + (i & 3); }

struct Unit { int pm, pn, a0, a1, a2; };
struct Gemm { const bf16_t* A; const bf16_t* Bt; int M, N, K; };

constexpr int PRE_ROWS = 131072 + 1024, PRE_EPI = PRE_ROWS + 2048;
struct StaticOrder {
    int nM, nN, nwg, G, c;
    __device__ void init(int M, int N, int G_, int c_) { nM = M / BM; nN = N / BM; nwg = nM * nN; G = G_; c = c_; }
    __device__ bool map(long L, Unit& u) const {
        if (L >= nwg) return false;
        int wgid = (int)L; { const int q = nwg / NXCD, r = nwg % NXCD, xcd = wgid % NXCD, off = wgid / NXCD; wgid = (xcd < r ? xcd * (q + 1) : r * (q + 1) + (xcd - r) * q) + off; }
        const int nig = WGM * nN, gid = wgid / nig, fm = gid * WGM, gsz = (nM - fm) < WGM ? (nM - fm) : WGM;
        u.pm = fm + ((wgid % nig) % gsz); u.pn = (wgid % nig) / gsz; u.a0 = 0; u.a1 = 0; u.a2 = 256; return true;
    }
    __device__ bool next(int i, Unit& u) const { return map((long)i * G + c, u); }
    __device__ __forceinline__ unsigned arow(const Unit&, int) const { return 0u; }
    __device__ __forceinline__ unsigned rowval(const Unit&, int, unsigned) const { return 0u; }
    __device__ __forceinline__ const unsigned* rows_ptr(const Unit&) const { return nullptr; }
};

__device__ __forceinline__ unsigned cvt_pk_bf16(float lo, float hi) { unsigned r; asm volatile("v_cvt_pk_bf16_f32 %0, %1, %2" : "=v"(r) : "v"(lo), "v"(hi)); return r; }

__device__ __forceinline__ float gelu_tanh(float x) {
    const float t = x * (1.0f + 0.044715f * x * x) * (2.0f * 0.7978845608028654f * 1.4426950408889634f);
    return x * __builtin_amdgcn_rcpf(1.0f + __builtin_amdgcn_exp2f(-t));
}

struct EpiBf16 {
    static constexpr bool PERM = true, HAS_PRE = false;
    bf16_t* O; int ldc; int gelu_pn;
    __device__ __forceinline__ void operator()(const f32x4 (&acc)[2][2][4][2], const Unit& u, int wr, int wc, int fr, int fq) const {
        const int row0 = u.pm * BM + wr * 64 + fr; const int col0 = u.pn * BM + wc * 32 + 8 * fq;
        const bool act = u.pn < gelu_pn;
#pragma unroll
        for (int ai = 0; ai < 2; ++ai)
#pragma unroll
            for (int m = 0; m < 4; ++m) { bf16_t* rowp = O + (size_t)(row0 + ai * HALF + m * 16) * ldc + col0;
#pragma unroll
                for (int bj = 0; bj < 2; ++bj) { f32x4 v0 = acc[ai][bj][m][0], v1 = acc[ai][bj][m][1];
                    if (act) {
#pragma unroll
                        for (int j = 0; j < 4; ++j) { v0[j] = gelu_tanh(v0[j]); v1[j] = gelu_tanh(v1[j]); } }
                    u32x4 w; w.x = cvt_pk_bf16(v0[0], v0[1]); w.y = cvt_pk_bf16(v0[2], v0[3]); w.z = cvt_pk_bf16(v1[0], v1[1]); w.w = cvt_pk_bf16(v1[2], v1[3]);
                    *(u32x4*)(rowp + bj * HALF) = w; } }
    }
};

typedef int v8i32 __attribute__((ext_vector_type(8)));
typedef short s16x16 __attribute__((ext_vector_type(16)));
template <class Epi, class Sched, bool ALIGN_EPI, bool GATHER, bool FP8 = false>
__device__ __forceinline__ void gemm_phase(LAS unsigned char* lds, const Gemm g, const Sched& S, const Epi& E, const int tid) {
    const int wid = __builtin_amdgcn_readfirstlane(tid >> 6), lane = tid & 63, wr = wid >> 2, wc = wid & 3, fr = lane & 15, fq = lane >> 4;
    const int K = g.K, nt = K / BK;
    unsigned voffA[2], voffB[2]; int Rr[2], Cc[2];
#pragma unroll
    for (int i = 0; i < 2; ++i) { int R, C; stage_rc(tid * 16 + i * 8192, R, C); const int Rb = Epi::PERM ? ((R & ~31) + perm32(R & 31)) : R; Rr[i] = R; Cc[i] = C;
        voffA[i] = (unsigned)(R * K + C) * 2u; voffB[i] = (unsigned)(Rb * K + C) * 2u; }
    const unsigned kstep = (unsigned)(BK * 2);
    const unsigned hstep = (unsigned)HALF * (unsigned)K * 2u;
    const unsigned tstep = 2u * hstep;
    const char* const baseA = (const char*)g.A; const char* const baseB = (const char*)g.Bt;
    const unsigned ldsw = (unsigned)wid * 1024u;
    const int aoff = lds_byte(wr * 64 + fr, fq * 8), boff = lds_byte(wc * 32 + fr, fq * 8);
    const int aoff0 = lds_byte(wr * 64 + fr, fq * 16), aoff1 = lds_byte(wr * 64 + fr, fq * 16 + 8), boff0 = lds_byte(wc * 32 + fr, fq * 16), boff1 = lds_byte(wc * 32 + fr, fq * 16 + 8);
#define PG8_SA(b, h) (((b) * 2 + (h)) * HTB)
#define PG8_SB(b, h) ((4 + (b) * 2 + (h)) * HTB)
#define PG8_STAGE(bufoff, gbase, voff) do { _Pragma("unroll") for (int _i = 0; _i < 2; ++_i) \
        __builtin_amdgcn_global_load_lds((const unsigned*)(baseB + (size_t)(unsigned)((gbase) + (voff)[_i])), (LAS unsigned*)(lds + (bufoff) + ldsw + _i * 8192), 16, 0, 0); } while (0)
#define PG8_STAGEA(bufoff, gbase, voff) do { _Pragma("unroll") for (int _i = 0; _i < 2; ++_i) \
        __builtin_amdgcn_global_load_lds((const unsigned*)(baseA + (size_t)(unsigned)((gbase) + (voff)[_i])), (LAS unsigned*)(lds + (bufoff) + ldsw + _i * 8192), 16, 0, 0); } while (0)
#define PG8_STAGE_A(bufoff, base, h, nx) do { if constexpr (GATHER) { _Pragma("unroll") for (int _i = 0; _i < 2; ++_i) { const unsigned _v = (nx) ? vAn[h][_i] : vAc[h][_i]; \
            __builtin_amdgcn_global_load_lds((const unsigned*)(baseA + (size_t)(unsigned)((base) + _v)), (LAS unsigned*)(lds + (bufoff) + ldsw + _i * 8192), 16, 0, 0); } } \
        else { PG8_STAGEA(bufoff, (base) + (h) * hstep, voffA); } } while (0)
#define PG8_LD8(dst, i, off0, off1) do { const bf16x8 _lo = *(const LAS bf16x8*)(lds + (off0)), _hi = *(const LAS bf16x8*)(lds + (off0) + 16); dst[i] = __builtin_bit_cast(v8i32, __builtin_shufflevector(_lo, _hi, 0, 1, 2, 3, 4, 5, 6, 7, 8, 9, 10, 11, 12, 13, 14, 15)); } while (0)
#define PG8_LDA8(dst, b, h) do { _Pragma("unroll") for (int m = 0; m < 4; ++m) PG8_LD8(dst, m, PG8_SA(b, h) + aoff0 + m * 2048, PG8_SA(b, h) + aoff1 + m * 2048); } while (0)
#define PG8_LDB8(dst, b, h) do { _Pragma("unroll") for (int n = 0; n < 2; ++n) PG8_LD8(dst, n, PG8_SB(b, h) + boff0 + n * 2048, PG8_SB(b, h) + boff1 + n * 2048); } while (0)
#define PG8_MMA8(ai, bj, At, Bt) do { __builtin_amdgcn_s_setprio(1); _Pragma("unroll") for (int m = 0; m < 4; ++m) _Pragma("unroll") for (int n = 0; n < 2; ++n) \
        asm volatile("v_mfma_scale_f32_16x16x128_f8f6f4 %0, %1, %2, %0, %3, %3 op_sel_hi:[0,0,0]" : "+v"(acc[ai][bj][m][n]) : "v"(Bt[n]), "v"(At[m]), "v"(one_scale)); __builtin_amdgcn_s_setprio(0); } while (0)
#define PG8_LDA(dst, b, h) do { _Pragma("unroll") for (int m = 0; m < 4; ++m) _Pragma("unroll") for (int k = 0; k < 2; ++k) dst[m][k] = *(const LAS bf16x8*)(lds + PG8_SA(b, h) + aoff + m * 2048 + k * 1024); } while (0)
#define PG8_LDB(dst, b, h) do { _Pragma("unroll") for (int n = 0; n < 2; ++n) _Pragma("unroll") for (int k = 0; k < 2; ++k) dst[n][k] = *(const LAS bf16x8*)(lds + PG8_SB(b, h) + boff + n * 2048 + k * 1024); } while (0)
#define PG8_MMA(ai, bj, At, Bt) do { __builtin_amdgcn_s_setprio(1); _Pragma("unroll") for (int m = 0; m < 4; ++m) _Pragma("unroll") for (int n = 0; n < 2; ++n) _Pragma("unroll") for (int k = 0; k < 2; ++k) \
        acc[ai][bj][m][n] = __builtin_amdgcn_mfma_f32_16x16x32_bf16(Bt[n][k], At[m][k], acc[ai][bj][m][n], 0, 0, 0); __builtin_amdgcn_s_setprio(0); } while (0)
#define PG8_WAIT_V(n) asm volatile("s_waitcnt vmcnt(" #n ")" ::: "memory")
#define PG8_WAIT_L(n) asm volatile("s_waitcnt lgkmcnt(" #n ")" ::: "memory")
#define PG8_BAR __builtin_amdgcn_s_barrier()
#define PG8_SCHED __builtin_amdgcn_sched_barrier(0)
    Unit cur, nxt; int ui = 0;
    if (!S.next(0, cur)) return;
    f32x4 acc[2][2][4][2];
#pragma unroll
    for (int a = 0; a < 2; ++a)
#pragma unroll
        for (int b = 0; b < 2; ++b)
#pragma unroll
            for (int m = 0; m < 4; ++m)
#pragma unroll
                for (int n = 0; n < 2; ++n) acc[a][b][m][n] = (f32x4){0.f, 0.f, 0.f, 0.f};
    bf16x8 At[4][2], B0[2][2], B1[2][2]; v8i32 At8[4], B08[2], B18[2]; const int one_scale = 0x7F7F7F7F;
#define XLDA(b, h) do { if constexpr (FP8) PG8_LDA8(At8, b, h); else PG8_LDA(At, b, h); } while (0)
#define XLDB0(b, h) do { if constexpr (FP8) PG8_LDB8(B08, b, h); else PG8_LDB(B0, b, h); } while (0)
#define XLDB1(b, h) do { if constexpr (FP8) PG8_LDB8(B18, b, h); else PG8_LDB(B1, b, h); } while (0)
#define XMMA0(ai, bj) do { if constexpr (FP8) PG8_MMA8(ai, bj, At8, B08); else PG8_MMA(ai, bj, At, B0); } while (0)
#define XMMA1(ai, bj) do { if constexpr (FP8) PG8_MMA8(ai, bj, At8, B18); else PG8_MMA(ai, bj, At, B1); } while (0)
    unsigned vAc[2][2], vAn[2][2];
#define PG8_ROWS(dst, un) do { if constexpr (GATHER) { _Pragma("unroll") for (int _h = 0; _h < 2; ++_h) _Pragma("unroll") for (int _i = 0; _i < 2; ++_i) \
        dst[_h][_i] = (S.arow(un, _h * HALF + Rr[0] + 64 * _i) * (unsigned)K + (unsigned)Cc[0]) * 2u; } } while (0)
    PG8_ROWS(vAc, cur);
#pragma unroll
    for (int _h = 0; _h < 2; ++_h)
#pragma unroll
        for (int _i = 0; _i < 2; ++_i) vAn[_h][_i] = vAc[_h][_i];
    unsigned cA = GATHER ? 0u : (unsigned)cur.pm * tstep; unsigned cB = (unsigned)cur.pn * tstep;
    PG8_STAGE(PG8_SB(0, 0), cB, voffB); PG8_STAGE(PG8_SB(0, 1), cB + hstep, voffB); PG8_STAGE_A(PG8_SA(0, 0), cA, 0, false); PG8_STAGE_A(PG8_SA(0, 1), cA, 1, false);
    if (wr == 1) PG8_BAR;
    PG8_WAIT_V(2); PG8_BAR;
    PG8_STAGE(PG8_SB(1, 0), cB + kstep, voffB); PG8_STAGE_A(PG8_SA(1, 0), cA + kstep, 0, false); PG8_STAGE(PG8_SB(1, 1), cB + hstep + kstep, voffB);
    PG8_WAIT_V(6); PG8_BAR;
    for (;;) {
        const bool has_next = S.next(ui + 1, nxt);
        if constexpr (GATHER) {
            if (has_next) {
                if (ui == 0) { PG8_ROWS(vAn, nxt); asm volatile("" : "+v"(vAn[0][0]), "+v"(vAn[0][1]), "+v"(vAn[1][0]), "+v"(vAn[1][1])); }
                else {
#pragma unroll
                    for (int _h = 0; _h < 2; ++_h)
#pragma unroll
                        for (int _i = 0; _i < 2; ++_i) { const int R_ = _h * HALF + Rr[0] + 64 * _i; const unsigned v_ = *(const LAS unsigned*)(lds + PRE_ROWS + ((ui + 1) & 1) * 1024 + R_ * 4);
                            vAn[_h][_i] = (S.rowval(nxt, R_, v_) * (unsigned)K + (unsigned)Cc[0]) * 2u; } }
            }
            Unit n2_; if (S.next(ui + 2, n2_)) { if (wid == 0) __builtin_amdgcn_global_load_lds((const unsigned*)(S.rows_ptr(n2_) + lane * 4), (LAS unsigned*)(lds + PRE_ROWS + (ui & 1) * 1024), 16, 0, 0); }
        } else { if (has_next) { PG8_ROWS(vAn, nxt); } }
        if constexpr (Epi::HAS_PRE) E.pre(lds + PRE_EPI + (ui & 1) * 2048, cur, wid, lane);
        const unsigned nA = GATHER ? 0u : (has_next ? (unsigned)nxt.pm * tstep : cA);
        const unsigned nB = has_next ? (unsigned)nxt.pn * tstep : cB;
#pragma unroll 1
        for (int t = 0; t < nt; t += 2) {
            const bool last = (t == nt - 2);
            const bool nx = last && has_next;
            const unsigned a1 = cA + (unsigned)(t + 1) * kstep;
            const unsigned a2 = last ? nA : cA + (unsigned)(t + 2) * kstep; const unsigned b2 = last ? nB : cB + (unsigned)(t + 2) * kstep;
            const unsigned a3 = a2 + kstep; const unsigned b3 = b2 + kstep;
            XLDB0(0, 0); XLDB1(0, 1); PG8_SCHED; XLDA(0, 0); PG8_STAGE_A(PG8_SA(1, 1), a1, 1, false);
            PG8_WAIT_V(8); PG8_WAIT_L(0); PG8_BAR; XMMA0(0, 0); XMMA1(0, 1); PG8_BAR; PG8_SCHED;
            XLDA(0, 1); PG8_STAGE(PG8_SB(0, 0), b2, voffB); PG8_STAGE(PG8_SB(0, 1), b2 + hstep, voffB); PG8_STAGE_A(PG8_SA(0, 0), a2, 0, nx);
            PG8_WAIT_V(8); PG8_WAIT_L(0); PG8_BAR; XMMA0(1, 0); XMMA1(1, 1); PG8_BAR; PG8_SCHED;
            XLDB0(1, 0); XLDB1(1, 1); PG8_SCHED; XLDA(1, 0); PG8_STAGE_A(PG8_SA(0, 1), a2, 1, nx);
            PG8_WAIT_V(8); PG8_WAIT_L(0); PG8_BAR; XMMA0(0, 0); XMMA1(0, 1); PG8_BAR; PG8_SCHED;
            XLDA(1, 1); PG8_STAGE(PG8_SB(1, 0), b3, voffB); PG8_STAGE(PG8_SB(1, 1), b3 + hstep, voffB); PG8_STAGE_A(PG8_SA(1, 0), a3, 0, nx);
            PG8_WAIT_V(8); PG8_WAIT_L(0); PG8_BAR; XMMA0(1, 0); XMMA1(1, 1); PG8_BAR; PG8_SCHED;
        }
        if constexpr (FP8) asm volatile("s_nop 15\n\ts_nop 15" ::: "memory");
        if constexpr (ALIGN_EPI) { if (wr == 0) PG8_BAR; }
        if constexpr (Epi::HAS_PRE) E(acc, cur, wr, wc, fr, fq, lds + PRE_EPI + (ui & 1) * 2048); else E(acc, cur, wr, wc, fr, fq);
        if (!has_next) break;
#pragma unroll
        for (int a = 0; a < 2; ++a)
#pragma unroll
            for (int b = 0; b < 2; ++b)
#pragma unroll
                for (int m = 0; m < 4; ++m)
#pragma unroll
                    for (int n = 0; n < 2; ++n) acc[a][b][m][n] = (f32x4){0.f, 0.f, 0.f, 0.f};
        cur = nxt; cA = nA; cB = nB; ++ui;
#pragma unroll
        for (int _h = 0; _h < 2; ++_h)
#pragma unroll
            for (int _i = 0; _i < 2; ++_i) vAc[_h][_i] = vAn[_h][_i];
        if constexpr (ALIGN_EPI) { if (wr == 1) PG8_BAR; }
    }
    PG8_WAIT_V(0);
    if constexpr (!ALIGN_EPI) { if (wr == 0) PG8_BAR; }
    PG8_BAR;
#undef PG8_SA
#undef PG8_SB
#undef PG8_STAGE
#undef PG8_STAGEA
#undef PG8_STAGE_A
#undef PG8_ROWS
#undef PG8_LDA
#undef PG8_LD8
#undef PG8_LDA8
#undef PG8_LDB8
#undef PG8_MMA8
#undef XLDA
#undef XLDB0
#undef XLDB1
#undef XMMA0
#undef XMMA1
#undef PG8_LDB
#undef PG8_MMA
#undef PG8_WAIT_V
#undef PG8_WAIT_L
#undef PG8_BAR
#undef PG8_SCHED
}
}

constexpr int DM = 1024, SEQ = 16384, NB = 2, T = NB * SEQ, CTX = 256, NCTX = NB * CTX, NKEY = SEQ + CTX;
constexpr int NE = 32, TOPK = 4, CAP = 32768;
constexpr float ALPHA = 1.4142135623730951f, LN_EPS = 1e-5f;
constexpr float QSCALE = 0.125f * 1.4426950408889634f;
constexpr float LAM_INIT0 = 0.2f;
constexpr int NWAVES = 8, NTHR = 512;

constexpr size_t MiB = 1u << 20;
constexpr size_t WS_CTL = 0, CTL_ZERO_BYTES = 1 * MiB;
constexpr size_t WS_MODP = 1 * MiB;
constexpr size_t WS_MOD = 3 * MiB;
constexpr size_t WS_TAB = 4 * MiB;
constexpr size_t WS_WEVIN = 6 * MiB, WS_WEVOUT = 11 * MiB, WS_WODIN = 13 * MiB, WS_WODOUT = 16 * MiB;
constexpr size_t WS_LIST = 18 * MiB, WS_GATES = 22 * MiB;
constexpr size_t WS_WGU = 32 * MiB;
constexpr size_t WS_WD = 288 * MiB;
constexpr size_t WS_U = 416 * MiB;
constexpr size_t WS_Q = 482 * MiB, WS_K = 514 * MiB, WS_V = 547 * MiB, WS_AB = 580 * MiB;
constexpr size_t WS_O0 = 612 * MiB;
constexpr size_t WS_MIX = 676 * MiB, WS_Y = 740 * MiB, WS_H1 = 804 * MiB, WS_U2 = 932 * MiB;
constexpr size_t WS_ACT = 996 * MiB;
constexpr size_t WS_YB = 1268 * MiB;
constexpr size_t WS_H2 = 1524 * MiB;
constexpr size_t WS_ZODD = 1652 * MiB;
constexpr size_t WS_WT = 1748 * MiB;
constexpr size_t WS_END = 1812 * MiB;
constexpr size_t TB_COS = 0, TB_SIN = 20480, TB_CS = 40960  , TB_AF = 106496  , TB_A3 = 237568  , TB_TW = 303104  , TB_WS = 434176  , TB_END = 565248;
constexpr int CW_ERR = 0, CW_BAR = 4096, CW_CNT = 16384;
#define XB_TMO      128
#define XB_XCNT(j)  (256  + 64 * (j))
#define XB_XSUB(j)  (1280 + 64 * (j))
#define XB_XGEN(j)  (2304 + 64 * (j))
#define XB_TOP      3328
#define XB_TOPGEN   3392
#define XCD_BAR_WORDS 3456
#define XB_SPIN_CAP (1u << 18)
constexpr int LDS_BYTES = 160 * 1024, MISC_OFF = LDS_BYTES - 256, META_OFF = 131072;

__device__ __forceinline__ unsigned xb_ld(unsigned* p)              { return __hip_atomic_load(p, __ATOMIC_RELAXED, __HIP_MEMORY_SCOPE_AGENT); }
__device__ __forceinline__ unsigned xb_add(unsigned* p, unsigned v) { return __hip_atomic_fetch_add(p, v, __ATOMIC_RELAXED, __HIP_MEMORY_SCOPE_AGENT); }
__device__ __forceinline__ unsigned xb_xcc_id() { return (unsigned)__builtin_amdgcn_s_getreg((3 << 11) | 20) & 0xFu; }
#define XB_SPIN(cond, bar) do { unsigned _sp = 0; while (cond) { __builtin_amdgcn_s_sleep(1); \
    if ((++_sp & 255u) == 0u) { if (xb_ld(&(bar)[XB_TMO])) break; if (_sp > XB_SPIN_CAP) { atomicAdd(&(bar)[XB_TMO], 1u); break; } } } } while (0)
struct XcdBarrier { unsigned* bar; unsigned x; volatile LAS unsigned* st; };
__device__ __forceinline__ XcdBarrier xcd_barrier_post(unsigned* bar, volatile LAS unsigned* st) {
    XcdBarrier b; b.bar = bar; b.x = xb_xcc_id(); b.st = st;
    if (threadIdx.x == 0) (void)xb_add(&bar[XB_XCNT(b.x)], 1u);
    return b;
}
__device__ __forceinline__ void xcd_barrier_complete(unsigned* bar, unsigned x, unsigned& nloc, unsigned& nx) {
    const unsigned G = gridDim.x * gridDim.y * gridDim.z;
    unsigned sum, cnt, mine, sp = 0u;
    for (;;) {
        sum = 0u; cnt = 0u; mine = 0u;
#pragma unroll
        for (unsigned j = 0; j < 16; ++j) { const unsigned c = xb_ld(&bar[XB_XCNT(j)]); sum += c; cnt += (c > 0u) ? 1u : 0u; mine = (j == x) ? c : mine; }
        if (sum == G) break;
        __builtin_amdgcn_s_sleep(1);
        if ((++sp & 255u) == 0u) { if (xb_ld(&bar[XB_TMO])) break; if (sp > XB_SPIN_CAP) { atomicAdd(&bar[XB_TMO], 1u); break; } }
    }
    nloc = mine > 0u ? mine : 1u; nx = cnt > 0u ? cnt : 1u;
}
__device__ __forceinline__ void xcd_barrier(const XcdBarrier& b) {
    asm volatile("s_waitcnt vmcnt(0)" ::: "memory");
    __syncthreads();
    if (threadIdx.x == 0) {
        unsigned* bar = b.bar;
        __builtin_amdgcn_s_waitcnt(0);
        unsigned nloc = b.st[0], nx = b.st[1];
        if (nloc == 0u) { xcd_barrier_complete(bar, b.x, nloc, nx); b.st[0] = nloc; b.st[1] = nx; }
        const unsigned old = xb_add(&bar[XB_XSUB(b.x)], 1u);
        const unsigned gen = old / nloc;
        if (old + 1u == (gen + 1u) * nloc) {
            __builtin_amdgcn_fence(__ATOMIC_RELEASE, "agent");
            asm volatile("s_waitcnt vmcnt(0)" ::: "memory");
            const unsigned og = xb_add(&bar[XB_TOP], 1u);
            const unsigned tg = og / nx;
            if (og + 1u == (tg + 1u) * nx) xb_add(&bar[XB_TOPGEN], 1u);
            else XB_SPIN(xb_ld(&bar[XB_TOPGEN]) == tg, bar);
            __builtin_amdgcn_fence(__ATOMIC_ACQUIRE, "agent");
            xb_add(&bar[XB_XGEN(b.x)], 1u);
            asm volatile("s_waitcnt vmcnt(0)" ::: "memory");
        } else {
            XB_SPIN(xb_ld(&bar[XB_XGEN(b.x)]) == gen, bar);
            __builtin_amdgcn_fence(__ATOMIC_ACQUIRE, "agent");
            asm volatile("s_waitcnt vmcnt(0)" ::: "memory");
        }
    }
    __syncthreads();
}

__device__ __forceinline__ float bf2f(unsigned short b) { return __uint_as_float(((unsigned)b) << 16); }
__device__ __forceinline__ unsigned f2bf(float f) { unsigned u = __float_as_uint(f); return (u + 0x7fffu + ((u >> 16) & 1u)) >> 16; }
__device__ __forceinline__ unsigned pk2(float lo, float hi) { return f2bf(lo) | (f2bf(hi) << 16); }
__device__ __forceinline__ unsigned pk4_fp8(float a, float b, float c, float d) { unsigned w = (unsigned)__builtin_amdgcn_cvt_pk_fp8_f32(a, b, 0, false); return (unsigned)__builtin_amdgcn_cvt_pk_fp8_f32(c, d, (int)w, true); }
constexpr float WGU_SCALE = 32.0f, WD_SCALE = 64.0f;
__device__ __forceinline__ float wave_sum(float v) {
#pragma unroll
    for (int o = 1; o < 64; o <<= 1) v += __shfl_xor(v, o);
    return v;
}
__device__ __forceinline__ float wave_max(float v) {
#pragma unroll
    for (int o = 1; o < 64; o <<= 1) v = fmaxf(v, __shfl_xor(v, o));
    return v;
}
__device__ __forceinline__ int crow(int r, int hi) { return (r & 3) + 8 * (r >> 2) + 4 * hi; }
__device__ __forceinline__ float silu_f(float x) { return x / (1.0f + __expf(-x)); }
__device__ __forceinline__ float sigmoid_f(float x) { return 1.0f / (1.0f + __expf(-x)); }
__device__ __forceinline__ int v_st(int k, int c) { const int kk = (k & ~0xC) | ((k & 4) << 1) | ((k & 8) >> 1); return ((kk >> 3) * 4 + (c >> 5)) * 512 + ((kk & 7) * 32 + (c & 31)) * 2; }
__device__ __forceinline__ int v_rd_base(int lane) { return ((lane & 3) << 3) | (((lane >> 2) & 3) << 6) | (((lane >> 4) & 1) << 5) | (((lane >> 5) & 1) << 8); }
__host__ __device__ constexpr int v_rd_off(int d0, int ks, int half) { return d0 * 512 + ks * 4096 + half * 2048; }
typedef short v4i16_t __attribute__((ext_vector_type(4)));
__device__ __forceinline__ bf16x8 vfrag(LAS unsigned char* tile_rd  , int d0, int ks) {
    const v4i16_t lo = __builtin_amdgcn_ds_read_tr16_b64_v4i16((LAS v4i16_t*)(tile_rd + v_rd_off(d0, ks, 0)));
    const v4i16_t hi = __builtin_amdgcn_ds_read_tr16_b64_v4i16((LAS v4i16_t*)(tile_rd + v_rd_off(d0, ks, 1)));
    return (bf16x8){lo[0], lo[1], lo[2], lo[3], hi[0], hi[1], hi[2], hi[3]};
}

struct Args { const float* in[35]; float* out; unsigned char* ws; int ph_lo, ph_hi; };

struct Frame { LAS unsigned char* lds; int tid, lane, wave, G, bx, kz; };
#define CAS __attribute__((address_space(4)))
__device__ __forceinline__ const float* kin_(int kz, int i) { return *(const float* const CAS*)((const CAS char*)__builtin_amdgcn_kernarg_segment_ptr() + kz + 8 * i); }
#define KIN(F, i) kin_((F).kz, (i))
#define KOUT(F) ((float*)kin_((F).kz, 35))
#define KWS(F) ((unsigned char*)kin_((F).kz, 36))
static_assert(sizeof(Args) == 37 * 8 + 8, "Args layout");

__device__ __forceinline__ void ph0_mod_tables(Frame& F) {
    const float* c = KIN(F, 1); const float* cctx = KIN(F, 3); const float* wmod = KIN(F, 4);
    LAS float* sv = (LAS float*)F.lds;
    for (int vb = F.bx; vb < 256; vb += F.G) {
    const int l = vb >> 7, rem = vb & 127, nch = rem & 7, kch = rem >> 3, k0 = kch * 64;
    if (F.tid < 192) { const int v = F.tid >> 6, k = F.tid & 63; const float x = (v < 2) ? c[v * DM + k0 + k] : cctx[k0 + k]; sv[v * 64 + k] = silu_f(x); }
    __syncthreads();
    if (F.tid < 384) {
        const int col = nch * 768 + F.tid * 2;
        const float* W = wmod + ((size_t)l * DM + k0) * 6144 + col;
        f32x2 a0 = {0.f, 0.f}, a1 = {0.f, 0.f}, a2 = {0.f, 0.f};
#pragma unroll 8
        for (int k = 0; k < 64; ++k) { const f32x2 w = *(const f32x2*)(W + (size_t)k * 6144); a0 += w * sv[k]; a1 += w * sv[64 + k]; a2 += w * sv[128 + k]; }
        float* mp = (float*)(KWS(F) + WS_MODP) + (size_t)kch * 5 * 6144 + col;
        if (l == 0) { *(f32x2*)(mp + 0 * 6144) = a0; *(f32x2*)(mp + 1 * 6144) = a1; *(f32x2*)(mp + 2 * 6144) = a2; }
        else { *(f32x2*)(mp + 3 * 6144) = a0; *(f32x2*)(mp + 4 * 6144) = a1; }
    }
    __syncthreads();
    }
    const int bx = F.bx;
    unsigned char* tb = KWS(F) + WS_TAB;
    const int gid = bx * NTHR + F.tid, NG = F.G * NTHR;
    const float s128 = 0.08838834764831845f;
    for (int i = gid; i < 5120; i += NG) {
        const int pos = i >> 4, f = i & 15; const int p = pos < 256 ? pos : pos - 256;
        const float inv = powf(10000.0f, -((float)f / 16.0f)); const float ang = (float)p * inv;
        ((float*)(tb + TB_COS))[i] = (float)cos((double)ang); ((float*)(tb + TB_SIN))[i] = (float)sin((double)ang);
    }
    for (int i = gid; i < 32768; i += NG) {
        const int j8 = i & 7, ln = (i >> 3) & 63, ks = (i >> 9) & 7, nb = i >> 12;
        const int n = 32 * nb + (ln & 31), cc = 16 * ks + 8 * (ln >> 5) + j8, part = n >> 7, jj = n & 127, m = (jj * cc) & 127;
        const double a = (double)m / 64.0; const float v = (part == 0 ? (float)cospi(a) : -(float)sinpi(a)) * s128;
        ((bf16_t*)(tb + TB_CS))[i] = (bf16_t)f2bf(v);
    }
    for (int i = gid; i < 65536; i += NG) {
        const int j8 = i & 7, ln = (i >> 3) & 63, ks = (i >> 9) & 15, mb = i >> 13;
        const int m = 32 * mb + (ln & 31), k = 16 * ks + 8 * (ln >> 5) + j8, mpart = m >> 7, k1 = m & 127, part = k >> 7, t1 = k & 127, ph = (k1 * t1) & 127;
        const double a = (double)ph / 64.0; const float cs = (float)cospi(a), sn = (float)sinpi(a);
        const float v = (mpart == 0 ? (part == 0 ? cs : sn) : (part == 0 ? -sn : cs)) * s128;
        ((bf16_t*)(tb + TB_AF))[i] = (bf16_t)f2bf(v);
    }
    for (int i = gid; i < 32768; i += NG) {
        const int j8 = i & 7, ln = (i >> 3) & 63, ks = (i >> 9) & 15, mb = i >> 13;
        const int k2 = 32 * mb + (ln & 31), k = 16 * ks + 8 * (ln >> 5) + j8, part = k >> 7, t2 = k & 127, ps = (k2 * t2) & 127;
        const double a = (double)ps / 64.0; const float v = (part == 0 ? (float)cospi(a) : (float)sinpi(a)) * s128;
        ((bf16_t*)(tb + TB_A3))[i] = (bf16_t)f2bf(v);
    }
    for (int i = gid; i < 16384; i += NG) {
        const int t2 = i >> 7, k1 = i & 127; const double a = (double)((k1 * t2) & 16383) / 8192.0;
        ((f32x2*)(tb + TB_TW))[i] = (f32x2){(float)cospi(a), (float)sinpi(a)};
    }
    const float* gws = KIN(F, 25);
    for (int i = gid; i < 65536; i += NG) ((bf16_t*)(tb + TB_WS))[i] = (bf16_t)f2bf(gws[i]);
}

__device__ __forceinline__ void transpose_item(const float* W, int K, int ldw, int k0, int n_src0, bf16_t* WT, int row_dst0, LAS float* scr, int lane) {
#pragma unroll 8
    for (int i = 0; i < 32; ++i) { const int kk = 2 * i + (lane >> 5); scr[kk * 33 + (lane & 31)] = W[(size_t)(k0 + kk) * ldw + n_src0 + (lane & 31)]; }
    asm volatile("s_waitcnt lgkmcnt(0)" ::: "memory");
    const int c = lane & 7;
#pragma unroll
    for (int j = 0; j < 4; ++j) { const int n = (lane >> 3) + 8 * j; const LAS float* s = scr + (8 * c) * 33 + n;
        u32x4 o; o.x = pk2(s[0 * 33], s[1 * 33]); o.y = pk2(s[2 * 33], s[3 * 33]); o.z = pk2(s[4 * 33], s[5 * 33]); o.w = pk2(s[6 * 33], s[7 * 33]);
        *(u32x4*)(WT + (size_t)(row_dst0 + n) * K + k0 + 8 * c) = o; }
    asm volatile("s_waitcnt lgkmcnt(0)" ::: "memory");
}
__device__ __forceinline__ void transpose_item_fp8(const float* W, int K, int ldw, int k0, int n_src0, unsigned char* WT8, int row_dst0, float scale, LAS float* scr, int lane) {
#pragma unroll 8
    for (int i = 0; i < 64; ++i) { const int kk = 2 * i + (lane >> 5); scr[kk * 33 + (lane & 31)] = W[(size_t)(k0 + kk) * ldw + n_src0 + (lane & 31)]; }
    asm volatile("s_waitcnt lgkmcnt(0)" ::: "memory");
    const int q = lane & 3;
#pragma unroll
    for (int j = 0; j < 2; ++j) { const int n = (lane >> 2) + 16 * j; const LAS float* s = scr + (32 * q) * 33 + n; unsigned w[8];
#pragma unroll
        for (int t = 0; t < 8; ++t) w[t] = pk4_fp8(s[(4 * t) * 33] * scale, s[(4 * t + 1) * 33] * scale, s[(4 * t + 2) * 33] * scale, s[(4 * t + 3) * 33] * scale);
        unsigned char* dst = WT8 + (size_t)(row_dst0 + n) * K + k0 + 32 * q;
        *(u32x4*)dst = (u32x4){w[0], w[1], w[2], w[3]}; *(u32x4*)(dst + 16) = (u32x4){w[4], w[5], w[6], w[7]}; }
    asm volatile("s_waitcnt lgkmcnt(0)" ::: "memory");
}
__device__ __forceinline__ void ph1_convert(Frame& F) {
    {
        const int gid = F.bx * NTHR + F.tid;
        if (gid < 5 * 6144) { const int vec = gid / 6144, n = gid % 6144, l = vec < 3 ? 0 : 1; float s = KIN(F, 5)[l * 6144 + n];
            const float* mp = (const float*)(KWS(F) + WS_MODP) + (size_t)vec * 6144 + n;
#pragma unroll
            for (int kc = 0; kc < 16; ++kc) s += mp[(size_t)kc * 5 * 6144];
            ((float*)(KWS(F) + WS_MOD))[gid] = s; }
    }
    LAS float* scr = (LAS float*)(F.lds + F.wave * 16896);
    const int gw = F.bx * NWAVES + F.wave, NGW = F.G * NWAVES;
    constexpr int I_EVIN = 16 * 80, I_EVOUT = 16 * 32, I_ODIN = 16 * 48, I_ODOUT = 16 * 32, I_DENSE = I_EVIN + I_EVOUT + I_ODIN + I_ODOUT;
    constexpr int I_GU = 64 * 512, I_DN = 64 * 256, NITEMS = I_DENSE + I_GU + I_DN;
    for (int it = gw; it < NITEMS; it += NGW) {
        int r = it;
        if (r < I_EVIN) { const int kb = r / 80, nb = r % 80, n0 = 32 * nb; int src = n0;
            if (n0 >= 1536) { const int u = (n0 - 1536) >> 8, w = (n0 - 1536) & 255; src = (w < 128) ? 1536 + 128 * u + w : 2048 + 128 * u + (w - 128); }
            transpose_item(KIN(F, 10), DM, 2560, 64 * kb, src, (bf16_t*)(KWS(F) + WS_WEVIN), n0, scr, F.lane); continue; } r -= I_EVIN;
        if (r < I_EVOUT) { const int kb = r / 32, nb = r % 32; transpose_item(KIN(F, 11), DM, 1024, 64 * kb, 32 * nb, (bf16_t*)(KWS(F) + WS_WEVOUT), 32 * nb, scr, F.lane); continue; } r -= I_EVOUT;
        if (r < I_ODIN) { const int kb = r / 48, nb = r % 48; transpose_item(KIN(F, 21), DM, 1536, 64 * kb, 32 * nb, (bf16_t*)(KWS(F) + WS_WODIN), 32 * nb, scr, F.lane); continue; } r -= I_ODIN;
        if (r < I_ODOUT) { const int kb = r / 32, nb = r % 32; transpose_item(KIN(F, 22), DM, 1024, 64 * kb, 32 * nb, (bf16_t*)(KWS(F) + WS_WODOUT), 32 * nb, scr, F.lane); continue; } r -= I_ODOUT;
        if (r < I_GU) { const int le = r >> 9, q = r & 511, kb = q >> 6, nb = q & 63, n0 = 32 * nb; const int u = n0 >> 8, w = n0 & 255;
            const int src = (w < 128) ? 128 * u + w : 1024 + 128 * u + (w - 128);
            transpose_item_fp8(KIN(F, 31) + (size_t)le * DM * 2048, DM, 2048, 128 * kb, src, (unsigned char*)(KWS(F) + WS_WGU) + (size_t)le * 2048 * DM, n0, WGU_SCALE, scr, F.lane); continue; } r -= I_GU;
        { const int le = r >> 8, q = r & 255, kb = q >> 5, nb = q & 31;
            transpose_item_fp8(KIN(F, 33) + (size_t)le * DM * 1024, DM, 1024, 128 * kb, 32 * nb, (unsigned char*)(KWS(F) + WS_WD) + (size_t)le * 1024 * DM, 32 * nb, WD_SCALE, scr, F.lane); }
    }
}

__device__ __forceinline__ void mod_row(const float* xrow, const float* sh, const float* sc, bf16_t* orow, int lane) {
    f32x4 x[4], a[4], b[4];
#pragma unroll
    for (int j = 0; j < 4; ++j) { const int d = 4 * lane + 256 * j; x[j] = *(const f32x4*)(xrow + d); a[j] = *(const f32x4*)(sc + d); b[j] = *(const f32x4*)(sh + d); }
    asm volatile("" ::: "memory");
#pragma unroll
    for (int j = 0; j < 4; ++j) { const int d = 4 * lane + 256 * j;
        const f32x4 v = x[j] * (a[j] + 1.0f) + b[j]; u32x2 w; w.x = pk2(v[0], v[1]); w.y = pk2(v[2], v[3]); *(u32x2*)(orow + d) = w; }
}
__device__ __forceinline__ void ph2_modulate(Frame& F) {
    const float* mod = (const float*)(KWS(F) + WS_MOD); bf16_t* U = (bf16_t*)(KWS(F) + WS_U);
    const int gw = F.bx * NWAVES + F.wave, NGW = F.G * NWAVES;
    for (int r = gw; r < T + NCTX; r += NGW) {
        if (r < T) { const int b = r >> 14; mod_row(KIN(F, 0) + (size_t)r * DM, mod + b * 6144, mod + b * 6144 + 1024, U + (size_t)r * DM, F.lane); }
        else { mod_row(KIN(F, 2) + (size_t)(r - T) * DM, mod + 2 * 6144, mod + 2 * 6144 + 1024, U + (size_t)r * DM, F.lane); }
    }
}

struct EvInOrder {
    pg8::StaticOrder so;
    __device__ bool next(int i, pg8::Unit& u) const {
        const long L = (long)i * so.G + so.c;
        if (L < so.nwg) return so.map(L, u);
        const int x = (int)(L - so.nwg); if (x >= 8) return false;
        u.pm = 128 + (x >> 2); u.pn = 2 + (x & 3); u.a0 = 0; u.a1 = 0; u.a2 = 256; return true;
    }
    __device__ __forceinline__ unsigned arow(const pg8::Unit&, int) const { return 0u; }
};
__device__ __forceinline__ int vpos64(int k) { return 32 * ((k >> 2) & 1) + 16 * (k >> 5) + ((k & 3) + 4 * ((k & 31) >> 3)); }
struct EpiEvIn {
    static constexpr bool PERM = false, HAS_PRE = false;
    unsigned char *Q8, *K8, *V8T; bf16_t* Ab; const float* cosT; const float* sinT; LAS unsigned char* tb;
    __device__ __forceinline__ void operator()(const f32x4 (&acc)[2][2][4][2], const pg8::Unit& u, int wr, int wc, int fr, int fq) const {
        const int pn = u.pn;
        if (pn == 4 || pn == 5) {
            LAS unsigned char* tw_ = tb + (wr * 4 + wc) * 2560; const int lane_ = fq * 16 + fr;
#pragma unroll
            for (int ai = 0; ai < 2; ++ai) {
                const int rowb = u.pm * 256 + ai * 128 + wr * 64; int b, keyb;
                if (rowb < T) { b = rowb >> 14; keyb = rowb & (SEQ - 1); } else { const int rc = rowb - T; b = rc >> 8; keyb = SEQ + (rc & 255); }
#pragma unroll
                for (int bj = 0; bj < 2; ++bj) {
#pragma unroll
                    for (int m = 0; m < 4; ++m) { const int pos = vpos64(m * 16 + fr);
#pragma unroll
                        for (int n = 0; n < 2; ++n) { const f32x4 x = acc[ai][bj][m][n]; const unsigned w = pk4_fp8(x[0], x[1], x[2], x[3]);
                            LAS unsigned char* d = tw_ + (n * 16 + 4 * fq) * 80 + pos;
                            d[0] = (unsigned char)(w & 0xff); d[80] = (unsigned char)((w >> 8) & 0xff); d[160] = (unsigned char)((w >> 16) & 0xff); d[240] = (unsigned char)(w >> 24); } }
#pragma unroll
                    for (int k = 0; k < 2; ++k) { const int rr = (lane_ >> 2) + 16 * k; const u32x4 v = *(const LAS u32x4*)(tw_ + rr * 80 + (lane_ & 3) * 16);
                        const int vcol = (pn & 1) * 256 + bj * 128 + wc * 32 + rr;
                        *(u32x4*)(V8T + ((size_t)(b * 4 + (vcol >> 7)) * 128 + (vcol & 127)) * NKEY + keyb + (lane_ & 3) * 16) = v; }
                }
            }
        } else if (pn < 6) {
            const int kind = pn >> 1, colbase = (pn & 1) * 256 + wc * 32 + 4 * fq;
#pragma unroll
            for (int ai = 0; ai < 2; ++ai)
#pragma unroll
                for (int m = 0; m < 4; ++m) {
                    const int row = u.pm * 256 + ai * 128 + wr * 64 + m * 16 + fr; const bool isctx = row >= T;
                    int t, b, key;
                    if (!isctx) { b = row >> 14; t = row & (SEQ - 1); key = t; } else { const int rc = row - T; t = 0; b = rc >> 8; key = SEQ + (rc & 255); }
                    if (kind == 0 && isctx) continue;
                    if (kind < 2) {
                        f32x4 cs = {1.f, 1.f, 1.f, 1.f}, sn = {0.f, 0.f, 0.f, 0.f};
                        if (!isctx) { const int pos = (wc & 1) ? 256 + (t & 63) : (t >> 6); cs = *(const f32x4*)(cosT + pos * 16 + 4 * fq); sn = *(const f32x4*)(sinT + pos * 16 + 4 * fq); }
                        unsigned char* dst = (kind == 0) ? Q8 + (size_t)row * 512 : K8 + (size_t)(b * NKEY + key) * 512;
                        const float sc = (kind == 0) ? QSCALE : 1.0f;
#pragma unroll
                        for (int bj = 0; bj < 2; ++bj) {
                            const f32x4 x1 = acc[ai][bj][m][0], x2 = acc[ai][bj][m][1];
                            const f32x4 o1 = (x1 * cs - x2 * sn) * sc, o2 = (x1 * sn + x2 * cs) * sc;
                            *(unsigned*)(dst + colbase + bj * 128) = pk4_fp8(o1[0], o1[1], o1[2], o1[3]); *(unsigned*)(dst + colbase + bj * 128 + 16) = pk4_fp8(o2[0], o2[1], o2[2], o2[3]);
                        }
                    }
                }
        } else {
            const int colbase = (pn - 6) * 128 + wc * 32 + 4 * fq;
#pragma unroll
            for (int ai = 0; ai < 2; ++ai)
#pragma unroll
                for (int m = 0; m < 4; ++m) {
                    const int row = u.pm * 256 + ai * 128 + wr * 64 + m * 16 + fr; if (row >= T) continue;
                    bf16_t* dst = Ab + (size_t)row * 512 + colbase;
#pragma unroll
                    for (int n = 0; n < 2; ++n) { const f32x4 v = acc[ai][0][m][n], g = acc[ai][1][m][n]; f32x4 o;
#pragma unroll
                        for (int j = 0; j < 4; ++j) o[j] = v[j] * sigmoid_f(g[j]);
                        u32x2 w; w.x = pk2(o[0], o[1]); w.y = pk2(o[2], o[3]); *(u32x2*)(dst + n * 16) = w; }
                }
        }
    }
};

__device__ __forceinline__ void ph4_conv(Frame& F) {
    const bf16_t* Ab = (const bf16_t*)(KWS(F) + WS_AB); bf16_t* MIX = (bf16_t*)(KWS(F) + WS_MIX);
    const float* cw = KIN(F, 12); const float* cb = KIN(F, 13); const float* lg = KIN(F, 14); const float* lb = KIN(F, 15);
    LAS bf16_t* At = (LAS bf16_t*)F.lds;
    LAS float* Yt = (LAS float*)(F.lds + 65536);
    const int ch = F.tid;
    float w[31];
#pragma unroll
    for (int j = 0; j < 31; ++j) w[j] = cw[j * 512 + ch];
    const float bias = cb[ch];
#define CONV_STAGE(tile_) do { const int b_ = (tile_) >> 9, t0_ = ((tile_) & 511) * 32; \
        _Pragma("unroll") for (int k_ = 0; k_ < 8; ++k_) { const int row_ = F.wave + 8 * k_; if (row_ < 62) { const int t_ = t0_ - 15 + row_; \
            if (t_ >= 0 && t_ < SEQ) __builtin_amdgcn_global_load_lds((const unsigned*)(Ab + ((size_t)(b_ * SEQ + t_)) * 512 + F.lane * 8), (LAS unsigned*)(At + row_ * 512), 16, 0, 0); \
            else { const unsigned z_ = (unsigned)F.kz; const u32x4 zv_ = {z_, z_, z_, z_}; *(LAS u32x4*)(At + row_ * 512 + F.lane * 8) = zv_; } } } } while (0)
    const f32x4 g0 = *(const f32x4*)(lg + 8 * F.lane), g1 = *(const f32x4*)(lg + 8 * F.lane + 4), b0 = *(const f32x4*)(lb + 8 * F.lane), b1 = *(const f32x4*)(lb + 8 * F.lane + 4);
    if (F.bx < T / 32) CONV_STAGE(F.bx);
    for (int tile = F.bx; tile < T / 32; tile += F.G) {
        const int b = tile >> 9, t0 = (tile & 511) * 32;
        asm volatile("s_waitcnt vmcnt(0)" ::: "memory");
        __syncthreads();
        float a[62];
#pragma unroll
        for (int r = 0; r < 62; ++r) a[r] = bf2f(At[r * 512 + ch]);
#pragma unroll
        for (int t = 0; t < 32; ++t) { float y = bias;
#pragma unroll
            for (int j = 0; j < 31; ++j) y = fmaf(a[t + j], w[j], y);
            Yt[t * 512 + ch] = y; }
        __syncthreads();
        if (tile + F.G < T / 32) CONV_STAGE(tile + F.G);
#pragma unroll
        for (int q = 0; q < 4; ++q) { const int t = F.wave * 4 + q; const LAS float* yr = Yt + t * 512 + 8 * F.lane;
            const f32x4 y0 = *(const LAS f32x4*)yr, y1 = *(const LAS f32x4*)(yr + 4);
            float s = (y0[0] + y0[1]) + (y0[2] + y0[3]) + (y1[0] + y1[1]) + (y1[2] + y1[3]);
            const float mean = wave_sum(s) * (1.0f / 512.0f);
            const f32x4 d0 = y0 - mean, d1 = y1 - mean;
            float q2 = (d0[0] * d0[0] + d0[1] * d0[1]) + (d0[2] * d0[2] + d0[3] * d0[3]) + (d1[0] * d1[0] + d1[1] * d1[1]) + (d1[2] * d1[2] + d1[3] * d1[3]);
            const float rstd = 1.0f / sqrtf(wave_sum(q2) * (1.0f / 512.0f) + LN_EPS);
            f32x4 o0 = d0 * rstd * g0 + b0, o1 = d1 * rstd * g1 + b1;
#pragma unroll
            for (int j = 0; j < 4; ++j) { o0[j] = silu_f(o0[j]); o1[j] = silu_f(o1[j]); }
            u32x4 wv; wv.x = pk2(o0[0], o0[1]); wv.y = pk2(o0[2], o0[3]); wv.z = pk2(o1[0], o1[1]); wv.w = pk2(o1[2], o1[3]);
            *(u32x4*)(MIX + (size_t)(b * SEQ + t0 + t) * 1024 + 8 * F.lane) = wv; }
        __syncthreads();
    }
#undef CONV_STAGE
}

namespace att {
constexpr int KVBLK = 64;
constexpr int SHM_V = 128 * 64, SHM_K = 64 * 64;
constexpr int SHM_1 = 32 * 64;
constexpr int NBUF = 5, DIST = 3, TILEB = SHM_V + SHM_1 + SHM_K;
constexpr int OFF_T = 0, OFF_WS = NBUF * TILEB;
constexpr int OFF_NEG = OFF_WS + 2048;
constexpr float PREF = 6.0f, PMAXLOG = 8.0f;
#define SBAR() __builtin_amdgcn_sched_barrier(0)
#define MX3(a, b, c) __builtin_fmaxf(__builtin_fmaxf((a), (b)), (c))
typedef int v8i32a __attribute__((ext_vector_type(8)));
__device__ __forceinline__ f32x16 mfma8(v8i32a a, v8i32a b, f32x16 c) { return __builtin_amdgcn_mfma_scale_f32_32x32x64_f8f6f4(a, b, c, 0, 0, 0, 0x7F7F7F7F, 0, 0x7F7F7F7F); }
template <bool FIRST> __device__ __forceinline__ void partialSM(f32x16& p0, f32x16& p1, f32x16& negm, float& alpha) {
    float a = MX3(p0[0], p0[1], p1[0]), b = MX3(p0[2], p0[3], p1[1]); a = MX3(a, p1[2], p1[3]);
#pragma unroll
    for (int r = 4; r < 16; r += 4) { a = MX3(a, p0[r], p0[r + 1]); b = MX3(b, p0[r + 2], p0[r + 3]); a = MX3(a, p1[r], p1[r + 1]); b = MX3(b, p1[r + 2], p1[r + 3]); }
    float pmax = fmaxf(a, b);
    { auto rr = __builtin_amdgcn_permlane32_swap(__float_as_uint(pmax), __float_as_uint(pmax), false, false);
      pmax = fmaxf(__uint_as_float(rr[0]), __uint_as_float(rr[1])); }
    alpha = 1.f;
    if (FIRST || __builtin_expect(__any(pmax > PMAXLOG), 0)) {
        const float dl = FIRST ? (pmax - PREF) : fmaxf(pmax - PREF, 0.f); const float nm = negm[0] - dl; alpha = __builtin_amdgcn_exp2f(-dl);
#pragma unroll
        for (int r = 0; r < 16; ++r) { p0[r] -= dl; p1[r] -= dl; negm[r] = nm; }
    }
#pragma unroll
    for (int r = 0; r < 16; ++r) p0[r] = __builtin_amdgcn_exp2f(p0[r]);
}
__device__ __forceinline__ void finishSM(f32x16& p0, f32x16& p1, v8i32a& pf) {
#pragma unroll
    for (int r = 0; r < 16; ++r) p1[r] = __builtin_amdgcn_exp2f(p1[r]);
#pragma unroll
    for (int i = 0; i < 4; ++i) { pf[i] = (int)pk4_fp8(p0[4 * i], p0[4 * i + 1], p0[4 * i + 2], p0[4 * i + 3]); pf[4 + i] = (int)pk4_fp8(p1[4 * i], p1[4 * i + 1], p1[4 * i + 2], p1[4 * i + 3]); }
}
__device__ __forceinline__ v8i32a frag32(const LAS unsigned char* base, int a0, int a1) {
    const bf16x8 lo = *(const LAS bf16x8*)(base + a0), hi = *(const LAS bf16x8*)(base + a1);
    return __builtin_bit_cast(v8i32a, __builtin_shufflevector(lo, hi, 0, 1, 2, 3, 4, 5, 6, 7, 8, 9, 10, 11, 12, 13, 14, 15));
}
__device__ __forceinline__ void attn_pass(const unsigned char* __restrict__ Qw, const unsigned char* __restrict__ Kh, const unsigned char* __restrict__ Vt, LAS unsigned char* lds, f32x16 (&o)[4], f32x16& lacc, const int tid, const int wid) {
    const int lane = tid & 63, r32 = lane & 31, hi = lane >> 5;
    LAS float* al_l = (LAS float*)(lds + OFF_WS) + wid * 64 + 32;
    f32x16 negm = f32x16{}; lacc = f32x16{};
#pragma unroll
    for (int d = 0; d < 4; ++d) o[d] = f32x16{};
    const v8i32a qf = __builtin_bit_cast(v8i32a, __builtin_shufflevector(*(const bf16x8*)Qw, *(const bf16x8*)(Qw + 16), 0, 1, 2, 3, 4, 5, 6, 7, 8, 9, 10, 11, 12, 13, 14, 15));
    const int sw = (r32 >> 2) & 3, a0 = r32 * 64 + (((2 * hi) ^ sw) << 4), a1 = r32 * 64 + (((2 * hi + 1) ^ sw) << 4);
    const int drow = 16 * wid + (lane >> 2), dch = (lane & 3) ^ ((drow >> 2) & 3);
    const unsigned vsrc = (unsigned)(drow * NKEY + dch * 16), ksrc = (unsigned)(drow * 512 + dch * 16); const bool kw = wid < 4;
    LAS unsigned char* T_lds = lds + OFF_T;
#define DMA(t, bi) do { __builtin_amdgcn_global_load_lds((const unsigned*)((const char*)Vt + (size_t)(t) * 64 + vsrc), (LAS unsigned*)(T_lds + (bi) * TILEB + wid * 1024), 16, 0, 0); \
    if (kw) __builtin_amdgcn_global_load_lds((const unsigned*)((const char*)Kh + (size_t)(t) * (64 * 512) + ksrc), (LAS unsigned*)(T_lds + (bi) * TILEB + SHM_V + SHM_1 + wid * 1024), 16, 0, 0); } while (0)
#define WAITBAR(n) do { if (kw) asm volatile("s_waitcnt vmcnt(%0) lgkmcnt(0)" :: "n"(2 * (n)) : "memory"); else asm volatile("s_waitcnt vmcnt(%0) lgkmcnt(0)" :: "n"(n) : "memory"); \
    __builtin_amdgcn_s_barrier(); asm volatile("" ::: "memory"); } while (0)
#define RESC(a) do { if (__any((a) < 1.f)) { if (hi == 0) al_l[r32] = (a); asm volatile("s_waitcnt lgkmcnt(0)" ::: "memory"); \
    _Pragma("unroll") for (int r = 0; r < 16; ++r) { const float f_ = al_l[crow(r, hi)]; o[0][r] *= f_; o[1][r] *= f_; o[2][r] *= f_; o[3][r] *= f_; lacc[r] *= f_; } } } while (0)
#define QKT(P0, P1, bi) do { const LAS unsigned char* kb_ = T_lds + (bi) * TILEB + SHM_V + SHM_1; P0 = mfma8(frag32(kb_, a0, a1), qf, negm); P1 = mfma8(frag32(kb_ + 2048, a0, a1), qf, negm); } while (0)
#ifndef MF8_ACC
#define MF8_ACC "+v"
#endif
#define MF8(acc_, v_) asm volatile("v_mfma_scale_f32_32x32x64_f8f6f4 %0, %1, %2, %0, %3, %3 op_sel_hi:[0,0,0]" : MF8_ACC(acc_) : "v"(pf), "v"(v_), "v"(one_sc))
#define PV(bi) do { const LAS unsigned char* vb_ = T_lds + (bi) * TILEB; { const v8i32a v0_ = frag32(vb_, a0, a1), v1_ = frag32(vb_ + 2048, a0, a1); asm volatile("s_nop 1" ::: ); MF8(o[0], v0_); MF8(o[1], v1_); } \
    { const v8i32a v2_ = frag32(vb_ + 4096, a0, a1), v3_ = frag32(vb_ + 6144, a0, a1); MF8(o[2], v2_); MF8(o[3], v3_); } \
    { const v8i32a v4_ = frag32(vb_ + 8192, a0, a1); MF8(lacc, v4_); } } while (0)
    f32x16 pA0, pA1, pB0, pB1; v8i32a pf; constexpr int NT = NKEY / KVBLK;
    const int one_sc = 0x7F7F7F7F;
#define MFQK(P_, kf_) P_ = mfma8(kf_, qf, negm)
#define EX8(P_, b_) do { _Pragma("unroll") for (int r_ = 0; r_ < 8; ++r_) P_[(b_) + r_] = __builtin_amdgcn_exp2f(P_[(b_) + r_]); } while (0)
#if defined(EXP_EXTRA_MFMA)
#define XMF() do { const v8i32a vn_ = frag32(lds + OFF_NEG, a0, a1); MF8(lacc, vn_); MF8(lacc, v4_); } while (0)
#else
#define XMF() do { } while (0)
#endif
#if defined(EXP_EXTRA_LDS)
#define XTRA(A_, B_) do { _Pragma("unroll") for (int r_ = 0; r_ < 5; ++r_) { const v8i32a t_ = frag32(vb_ + 2048 * r_, a0, a1); asm volatile("" :: "v"(t_)); } } while (0)
#elif defined(EXP_EXTRA_EXP)
#define XTRA(A_, B_) do { _Pragma("unroll") for (int r_ = 0; r_ < 16; ++r_) { float t_; asm volatile("v_exp_f32 %0, %1" : "=v"(t_) : "v"(A_[r_])); asm volatile("v_exp_f32 %0, %1" : "=v"(t_) : "v"(B_[r_])); } } while (0)
#elif defined(EXP_EXTRA_ADD)
#define XTRA(A_, B_) do { _Pragma("unroll") for (int r_ = 0; r_ < 16; ++r_) { float t_; asm volatile("v_add_f32 %0, %1, %1" : "=v"(t_) : "v"(A_[r_])); asm volatile("v_add_f32 %0, %1, %1" : "=v"(t_) : "v"(B_[r_])); } } while (0)
#else
#define XTRA(A_, B_) do { } while (0)
#endif
#define STEP(C0, C1, P0, P1, HAVEPREV, FIRSTT, tnext, dodma) do { \
    if (dodma) DMA(tnext, bd); \
    const LAS unsigned char* kb_ = T_lds + bc * TILEB + SHM_V + SHM_1; const LAS unsigned char* vb_ = T_lds + bp * TILEB; \
    const v8i32a kf0_ = frag32(kb_, a0, a1), kf1_ = frag32(kb_ + 2048, a0, a1); v8i32a v0_, v1_, v2_, v3_, v4_; if (HAVEPREV) { v0_ = frag32(vb_, a0, a1); v1_ = frag32(vb_ + 2048, a0, a1); } \
    SBAR(); MFQK(C0, kf0_); if (HAVEPREV) EX8(P1, 0); SBAR(); \
    MFQK(C1, kf1_); if (HAVEPREV) { EX8(P1, 8); _Pragma("unroll") for (int i_ = 0; i_ < 4; ++i_) { pf[i_] = (int)pk4_fp8(P0[4 * i_], P0[4 * i_ + 1], P0[4 * i_ + 2], P0[4 * i_ + 3]); pf[4 + i_] = (int)pk4_fp8(P1[4 * i_], P1[4 * i_ + 1], P1[4 * i_ + 2], P1[4 * i_ + 3]); } } SBAR(); \
    float al_ = 1.f; \
    if (HAVEPREV) { asm volatile("s_nop 1" ::: ); MF8(o[0], v0_); SBAR(); MF8(o[1], v1_); v2_ = frag32(vb_ + 4096, a0, a1); v3_ = frag32(vb_ + 6144, a0, a1); v4_ = frag32(vb_ + 8192, a0, a1); SBAR(); } \
    else { asm volatile("s_nop 15\n\ts_nop 15\n\ts_nop 15\n\ts_nop 15" ::: "memory"); }     \
    float mxa_ = MX3(C0[0], C0[1], C1[0]), mxb_ = MX3(C0[2], C0[3], C1[1]); mxa_ = MX3(mxa_, C1[2], C1[3]); \
    _Pragma("unroll") for (int r_ = 4; r_ < 16; r_ += 4) { mxa_ = MX3(mxa_, C0[r_], C0[r_ + 1]); mxb_ = MX3(mxb_, C0[r_ + 2], C0[r_ + 3]); mxa_ = MX3(mxa_, C1[r_], C1[r_ + 1]); mxb_ = MX3(mxb_, C1[r_ + 2], C1[r_ + 3]); } \
    float pm_ = fmaxf(mxa_, mxb_); { auto rr_ = __builtin_amdgcn_permlane32_swap(__float_as_uint(pm_), __float_as_uint(pm_), false, false); pm_ = fmaxf(__uint_as_float(rr_[0]), __uint_as_float(rr_[1])); } \
    SBAR(); \
    if (HAVEPREV) { MF8(o[2], v2_); SBAR(); MF8(o[3], v3_); SBAR(); } \
    if (FIRSTT || __builtin_expect(__any(pm_ > PMAXLOG), 0)) { const float dl_ = FIRSTT ? (pm_ - PREF) : fmaxf(pm_ - PREF, 0.f); const float nm_ = negm[0] - dl_; al_ = __builtin_amdgcn_exp2f(-dl_); \
        _Pragma("unroll") for (int r_ = 0; r_ < 16; ++r_) { C0[r_] -= dl_; C1[r_] -= dl_; negm[r_] = nm_; } } \
    SBAR(); \
    if (HAVEPREV) { MF8(lacc, v4_); XMF(); SBAR(); } \
    EX8(C0, 0); EX8(C0, 8); XTRA(C0, C1); SBAR(); \
    if (HAVEPREV) { if (__any(al_ < 1.f)) { asm volatile("s_nop 15\n\ts_nop 15" ::: "memory"); if (hi == 0) al_l[r32] = al_; asm volatile("s_waitcnt lgkmcnt(0)" ::: "memory"); \
        _Pragma("unroll") for (int r_ = 0; r_ < 16; ++r_) { const float f_ = al_l[crow(r_, hi)]; o[0][r_] *= f_; o[1][r_] *= f_; o[2][r_] *= f_; o[3][r_] *= f_; lacc[r_] *= f_; } } } \
    } while (0)
    int bp = 4, bc = 0, bd = 3;
#define ROT() do { bp = bc; bc = (bc == NBUF - 1) ? 0 : bc + 1; bd = (bd == NBUF - 1) ? 0 : bd + 1; } while (0)
#ifdef EXP_EXTRA_BAR
#define XBAR() do { __builtin_amdgcn_s_barrier(); asm volatile("" ::: "memory"); } while (0)
#else
#define XBAR() do { } while (0)
#endif
    DMA(0, 0); DMA(1, 1); DMA(2, 2); WAITBAR(2);
    STEP(pA0, pA1, pB0, pB1, false, true, 3, true); WAITBAR(2); ROT();
#pragma unroll 1
    for (int j = 1; j + 1 < NT; j += 2) {
        const bool more = (j + 4 < NT);
        STEP(pB0, pB1, pA0, pA1, true, false, j + 3, more); if (more) WAITBAR(2); else WAITBAR(0); XBAR(); ROT();
        STEP(pA0, pA1, pB0, pB1, true, false, j + 4, more); if (more) WAITBAR(2); else WAITBAR(0); XBAR(); ROT();
    }
    STEP(pB0, pB1, pA0, pA1, true, false, 0, false); WAITBAR(0); ROT();
    { EX8(pB1, 0); EX8(pB1, 8);
#pragma unroll
      for (int i_ = 0; i_ < 4; ++i_) { pf[i_] = (int)pk4_fp8(pB0[4 * i_], pB0[4 * i_ + 1], pB0[4 * i_ + 2], pB0[4 * i_ + 3]); pf[4 + i_] = (int)pk4_fp8(pB1[4 * i_], pB1[4 * i_ + 1], pB1[4 * i_ + 2], pB1[4 * i_ + 3]); }
      SBAR(); PV(bp); }
#undef STEP
#undef MFQK
#undef EX8
    __syncthreads();
#undef ROT
#undef DMA
#undef WAITBAR
#undef RESC
#undef QKT
#undef PV
#undef MF8
}
}

__device__ __forceinline__ void ph4_attention(Frame& F) {
    const unsigned char* Q8 = (const unsigned char*)(KWS(F) + WS_Q); const unsigned char* K8 = (const unsigned char*)(KWS(F) + WS_K); const unsigned char* V8T = (const unsigned char*)(KWS(F) + WS_V);
    float* O0 = (float*)(KWS(F) + WS_O0); bf16_t* MIX = (bf16_t*)(KWS(F) + WS_MIX); const float* gn = KIN(F, 20);
    const int lane = F.lane, wid = F.wave;
    float lam;
    { const float a = wave_sum(KIN(F, 16)[lane] * KIN(F, 17)[lane]), b = wave_sum(KIN(F, 18)[lane] * KIN(F, 19)[lane]); lam = __builtin_bit_cast(float, __builtin_amdgcn_readfirstlane(__builtin_bit_cast(int, __expf(a) - __expf(b) + LAM_INIT0))); }
    __syncthreads();
    const unsigned kz_ = (unsigned)F.kz;
    for (int i = F.tid; i < att::NBUF * (att::SHM_1 / 16); i += NTHR) { const int bi = i / (att::SHM_1 / 16), q = i % (att::SHM_1 / 16);
        *(LAS u32x4*)(F.lds + att::OFF_T + bi * att::TILEB + att::SHM_V + q * 16) = (u32x4){0x38383838u + kz_, 0x38383838u + kz_, 0x38383838u + kz_, 0x38383838u + kz_}; }
#if defined(EXP_EXTRA_MFMA)
    for (int i = F.tid; i < 128; i += NTHR) *(LAS u32x4*)(F.lds + att::OFF_NEG + i * 16) = (u32x4){0xB8B8B8B8u + kz_, 0xB8B8B8B8u + kz_, 0xB8B8B8B8u + kz_, 0xB8B8B8B8u + kz_};
#endif
    __syncthreads();
    const int x = F.bx & 7, jb = F.bx >> 3;
    for (int vb = x; vb < 8; vb += 8) { const int b = vb >> 2, h = vb & 3;
    for (int qb = jb; qb < SEQ / 256; qb += (F.G >> 3)) {
        const long rowbase = (long)b * SEQ + qb * 256 + wid * 32;
        f32x16 o[4]; f32x16 lacc;
#pragma unroll 1
        for (int c = 0; c < 2; ++c) {
            const unsigned char* Qw = Q8 + (rowbase + (lane & 31)) * 512 + h * 128 + c * 64 + (lane >> 5) * 32;
            const unsigned char* Kh = K8 + (long)b * NKEY * 512 + h * 128 + c * 64;
            const unsigned char* Vt = V8T + (long)(b * 4 + h) * 128 * NKEY;
            att::attn_pass(Qw, Kh, Vt, F.lds, o, lacc, F.tid, F.wave);
            int lane_e = lane; asm volatile("" : "+v"(lane_e));
            const int r32 = lane_e & 31, hi = lane_e >> 5;
            asm volatile("s_nop 15\n\ts_nop 15" : "+v"(lacc));
            float rli[16];
#pragma unroll
            for (int r = 0; r < 16; ++r) rli[r] = __builtin_amdgcn_rcpf(lacc[r]);
            if (c == 0) {
#pragma unroll
                for (int r = 0; r < 16; ++r) { const long grow = rowbase + crow(r, hi);
#pragma unroll
                    for (int d0 = 0; d0 < 4; ++d0) O0[grow * 512 + h * 128 + d0 * 32 + r32] = o[d0][r] * rli[r]; }
            } else {
                const float g0 = gn[r32], g1 = gn[32 + r32], g2 = gn[64 + r32], g3 = gn[96 + r32];
#pragma unroll
                for (int r = 0; r < 16; ++r) { const long grow = rowbase + crow(r, hi); const float* op = O0 + grow * 512 + h * 128 + r32;
                    const float v0 = op[0] - lam * (o[0][r] * rli[r]), v1 = op[32] - lam * (o[1][r] * rli[r]), v2 = op[64] - lam * (o[2][r] * rli[r]), v3 = op[96] - lam * (o[3][r] * rli[r]);
                    float ss = (v0 * v0 + v1 * v1) + (v2 * v2 + v3 * v3);
#pragma unroll
                    for (int off = 1; off < 32; off <<= 1) ss += __shfl_xor(ss, off);
                    const float scl = (1.0f - LAM_INIT0) / sqrtf(ss * (1.0f / 128.0f) + LN_EPS);
                    bf16_t* mp = MIX + grow * 1024 + 512 + h * 128 + r32;
                    mp[0] = (bf16_t)f2bf(v0 * scl * g0); mp[32] = (bf16_t)f2bf(v1 * scl * g1); mp[64] = (bf16_t)f2bf(v2 * scl * g2); mp[96] = (bf16_t)f2bf(v3 * scl * g3);
                    if ((r & 3) == 3) asm volatile("" ::: "memory"); }
            }
        }
    } }
}

__device__ __forceinline__ void ph_router(Frame& F, int layer, const float* hin) {
    const float* mod = (const float*)(KWS(F) + WS_MOD) + (size_t)(layer * 3) * 6144;
    const bf16_t* Y = (const bf16_t*)(KWS(F) + WS_Y); float* H1 = (float*)(KWS(F) + WS_H1); unsigned char* U2 = (unsigned char*)(KWS(F) + WS_U2);
    const float* lng = KIN(F, 6) + layer * DM; const float* lnb = KIN(F, 7) + layer * DM;
    const float* rw = KIN(F, 29) + (size_t)layer * DM * NE; const float* rb = KIN(F, 30) + layer * NE;
    unsigned* gcnt = (unsigned*)(KWS(F) + WS_CTL) + CW_CNT + layer * NE;
    unsigned* list = (unsigned*)(KWS(F) + WS_LIST); float* gates = (float*)(KWS(F) + WS_GATES);
    constexpr int RWS = 1028, RSEL = 131584, RVEC = RSEL + 10240;
    LAS float* rwT = (LAS float*)F.lds;
    LAS int* sel_e = (LAS int*)(F.lds + RSEL);
    LAS float* sel_g = (LAS float*)(F.lds + RSEL + 2048);
    LAS unsigned* lcnt = (LAS unsigned*)(F.lds + RSEL + 4096);
    LAS unsigned* lbase = lcnt + 32;
    LAS unsigned* lpos = lcnt + 64;
    LAS float* vG = (LAS float*)(F.lds + RVEC);
    const int lane = F.lane;
    for (int i = F.tid; i < DM * NE; i += NTHR) { const int d = i >> 5, e = i & 31; rwT[e * RWS + d] = rw[i]; }
    __syncthreads();
    for (int blk = F.bx; blk < T / 128; blk += F.G) {
        const int r0 = blk * 128, b = r0 >> 14;
        const float* g1 = mod + b * 6144 + 2048; const float* sh2 = mod + b * 6144 + 3072; const float* sc2 = mod + b * 6144 + 4096;
        if (F.tid < 32) lcnt[F.tid] = 0u;
        for (int i = F.tid; i < DM; i += NTHR) { vG[i] = g1[i]; vG[DM + i] = lng[i]; vG[2 * DM + i] = lnb[i]; vG[3 * DM + i] = sc2[i] + 1.0f; vG[4 * DM + i] = sh2[i]; }
        __syncthreads();
        f32x4 nx[2][4]; u32x2 ny[2][4];
#pragma unroll
        for (int t = 0; t < 2; ++t)
#pragma unroll
            for (int j = 0; j < 4; ++j) { const int d = 4 * lane + 256 * j; const size_t rr = (size_t)(r0 + F.wave * 16 + t); nx[t][j] = *(const f32x4*)(hin + rr * DM + d); ny[t][j] = *(const u32x2*)(Y + rr * DM + d); }
        for (int qq = 0; qq < 8; ++qq) {
            int lane4 = 4 * lane; asm volatile("" : "+v"(lane4));
            const int tl0 = F.wave * 16 + 2 * qq;
            f32x4 pre[2][4]; float s1[2] = {0.f, 0.f}, s2[2] = {0.f, 0.f};
#pragma unroll
            for (int t = 0; t < 2; ++t)
#pragma unroll
                for (int j = 0; j < 4; ++j) { const int d = lane4 + 256 * j; const f32x4 x = nx[t][j]; const u32x2 yw = ny[t][j]; const f32x4 g = *(const LAS f32x4*)(vG + d);
                    f32x4 y; y[0] = __uint_as_float(yw.x << 16); y[1] = __uint_as_float(yw.x & 0xffff0000u); y[2] = __uint_as_float(yw.y << 16); y[3] = __uint_as_float(yw.y & 0xffff0000u);
                    const f32x4 p_ = x * ALPHA + g * y; pre[t][j] = p_; s1[t] += (p_[0] + p_[1]) + (p_[2] + p_[3]); s2[t] += (p_[0] * p_[0] + p_[1] * p_[1]) + (p_[2] * p_[2] + p_[3] * p_[3]); }
            if (qq + 1 < 8) {
#pragma unroll
                for (int t = 0; t < 2; ++t)
#pragma unroll
                    for (int j = 0; j < 4; ++j) { const int d = lane4 + 256 * j; const size_t rr = (size_t)(r0 + tl0 + 2 + t); nx[t][j] = *(const f32x4*)(hin + rr * DM + d); ny[t][j] = *(const u32x2*)(Y + rr * DM + d); } }
#pragma unroll
            for (int o = 1; o < 64; o <<= 1) { s1[0] += __shfl_xor(s1[0], o); s1[1] += __shfl_xor(s1[1], o); s2[0] += __shfl_xor(s2[0], o); s2[1] += __shfl_xor(s2[1], o); }
            f32x4 u2[2][4];
#pragma unroll
            for (int t = 0; t < 2; ++t) { const float mean = s1[t] * (1.0f / DM); const float var = fmaxf(s2[t] * (1.0f / DM) - mean * mean, 0.f); const float rstd = 1.0f / sqrtf(var + LN_EPS); const size_t row = (size_t)(r0 + tl0 + t);
#pragma unroll
                for (int j = 0; j < 4; ++j) { const int d = lane4 + 256 * j; const f32x4 h = (pre[t][j] - mean) * rstd * *(const LAS f32x4*)(vG + DM + d) + *(const LAS f32x4*)(vG + 2 * DM + d);
                    *(f32x4*)(H1 + row * DM + d) = h;
                    u2[t][j] = h * *(const LAS f32x4*)(vG + 3 * DM + d) + *(const LAS f32x4*)(vG + 4 * DM + d);
                    *(unsigned*)(U2 + row * DM + d) = pk4_fp8(u2[t][j][0], u2[t][j][1], u2[t][j][2], u2[t][j][3]); } }
            f32x2 up[4][4];
#pragma unroll
            for (int j = 0; j < 4; ++j)
#pragma unroll
                for (int i = 0; i < 4; ++i) { up[j][i][0] = u2[0][j][i]; up[j][i][1] = u2[1][j][i]; }
            f32x2 P[32];
            f32x4 wc[4], wn[4];
#pragma unroll
            for (int j = 0; j < 4; ++j) wc[j] = *(const LAS f32x4*)(rwT + 4 * lane + 256 * j);
#pragma unroll
            for (int e = 0; e < 32; ++e) {
                if (e + 1 < 32) {
#pragma unroll
                    for (int j = 0; j < 4; ++j) wn[j] = *(const LAS f32x4*)(rwT + (e + 1) * RWS + 4 * lane + 256 * j); }
                f32x2 a0 = {0.f, 0.f}, a1 = {0.f, 0.f};
#pragma unroll
                for (int j = 0; j < 4; ++j) { f32x2 w0 = {wc[j][0], wc[j][0]}, w1 = {wc[j][1], wc[j][1]}, w2 = {wc[j][2], wc[j][2]}, w3 = {wc[j][3], wc[j][3]};
                    a0 = __builtin_elementwise_fma(up[j][0], w0, a0); a1 = __builtin_elementwise_fma(up[j][1], w1, a1); a0 = __builtin_elementwise_fma(up[j][2], w2, a0); a1 = __builtin_elementwise_fma(up[j][3], w3, a1); }
                P[e] = a0 + a1;
#pragma unroll
                for (int j = 0; j < 4; ++j) wc[j] = wn[j];
                if ((e & 3) == 3) __builtin_amdgcn_sched_barrier(0); }
#define RSTEP(N, MASK) do { _Pragma("unroll") for (int i = 0; i < (N); ++i) { int lm_ = lane & (MASK); asm volatile("" : "+v"(lm_)); const bool up_ = lm_ != 0;     \
                const f32x2 sv = up_ ? P[i] : P[i + (N)], kv = up_ ? P[i + (N)] : P[i]; f32x2 rv; rv[0] = __shfl_xor(sv[0], (MASK)); rv[1] = __shfl_xor(sv[1], (MASK)); P[i] = kv + rv; } } while (0)
            RSTEP(16, 32); RSTEP(8, 16); RSTEP(4, 8); RSTEP(2, 4); RSTEP(1, 2);
#undef RSTEP
            const int me = lane >> 1; const float rbv = rb[me];
            float lgs[2]; lgs[0] = P[0][0] + __shfl_xor(P[0][0], 1) + rbv; lgs[1] = P[0][1] + __shfl_xor(P[0][1], 1) + rbv;
            LAS float* lgbuf = (LAS float*)(F.lds + RSEL + 8192) + F.wave * 64;
            if ((lane & 1) == 0) { lgbuf[me] = lgs[0]; lgbuf[32 + me] = lgs[1]; }
            asm volatile("s_waitcnt lgkmcnt(0)" ::: "memory");
#pragma unroll
            for (int t = 0; t < 2; ++t) { const float mine = lgs[t]; int rank = 0;
#pragma unroll
                for (int e4 = 0; e4 < 8; ++e4) { const f32x4 v = *(const LAS f32x4*)(lgbuf + 32 * t + 4 * e4);
#pragma unroll
                    for (int i = 0; i < 4; ++i) { const int e = 4 * e4 + i; rank += (v[i] > mine || (v[i] == mine && e < me)) ? 1 : 0; } }
                float ls[4]; int es[4];
#pragma unroll
                for (int k = 0; k < 4; ++k) { const unsigned long long bal = __ballot(rank == k); const int first = __ffsll((long long)bal) - 1; es[k] = first >> 1; ls[k] = lgbuf[32 * t + es[k]]; }
                const float e1 = __expf(ls[1] - ls[0]), e2 = __expf(ls[2] - ls[0]), e3 = __expf(ls[3] - ls[0]); const float inv = 1.0f / (1.0f + e1 + e2 + e3);
                const int tl = tl0 + t;
                if (lane == 0) { sel_e[tl * 4 + 0] = es[0]; sel_e[tl * 4 + 1] = es[1]; sel_e[tl * 4 + 2] = es[2]; sel_e[tl * 4 + 3] = es[3];
                    sel_g[tl * 4 + 0] = inv; sel_g[tl * 4 + 1] = e1 * inv; sel_g[tl * 4 + 2] = e2 * inv; sel_g[tl * 4 + 3] = e3 * inv; } }
        }
        __syncthreads();
        const int myE = sel_e[F.tid];
        lpos[F.tid] = __hip_atomic_fetch_add(&lcnt[myE], 1u, __ATOMIC_RELAXED, __HIP_MEMORY_SCOPE_WORKGROUP);
        __syncthreads();
        if (F.tid < 32) lbase[F.tid] = atomicAdd(&gcnt[F.tid], lcnt[F.tid]);
        __syncthreads();
        { const unsigned slot = (unsigned)(r0 * 4 + F.tid); list[(size_t)myE * CAP + lbase[myE] + lpos[F.tid]] = slot; gates[slot] = sel_g[F.tid]; }
        __syncthreads();
    }
}

struct MoeOrder {
    const LAS int* meta;
    const unsigned* list; int c, G, ncol, rpx;
    __device__ bool next(int i, pg8::Unit& u) const {
        const int x = c & 7, j = c >> 3; const int g = (i * 8 + x) * rpx + j / ncol; const int total = meta[32];
        if (g >= total) return false;
        const int ln_ = (int)__builtin_amdgcn_mbcnt_hi(~0u, __builtin_amdgcn_mbcnt_lo(~0u, 0u)) & 31;
        const int e = __popc((unsigned)__ballot(meta[ln_ + 1] <= g));
        const int rt = g - meta[e], cnt = meta[64 + e];
        u.pm = g; u.pn = e * ncol + (j % ncol); u.a0 = e; u.a1 = rt; u.a2 = min(256, cnt - rt * 256); return true;
    }
    __device__ __forceinline__ unsigned arow(const pg8::Unit& u, int R) const { return (R < u.a2) ? (list[(size_t)u.a0 * CAP + u.a1 * 256 + R] >> 2) : 0u; }
    __device__ __forceinline__ unsigned rowval(const pg8::Unit& u, int R, unsigned v) const { return (R < u.a2) ? (v >> 2) : 0u; }
    __device__ __forceinline__ const unsigned* rows_ptr(const pg8::Unit& u) const { return list + (size_t)u.a0 * CAP + u.a1 * 256; }
};
__device__ __forceinline__ void moe_meta(Frame& F, int layer) {
    LAS int* meta = (LAS int*)(F.lds + META_OFF);
    const unsigned* gcnt = (const unsigned*)(KWS(F) + WS_CTL) + CW_CNT + layer * NE;
    if (F.tid < NE) { const int c = (int)__hip_atomic_load(&gcnt[F.tid], __ATOMIC_RELAXED, __HIP_MEMORY_SCOPE_AGENT); meta[64 + F.tid] = c; meta[96 + F.tid] = (c + 255) >> 8; }
    __syncthreads();
    if (F.tid <= NE) { int acc = 0;
#pragma unroll
        for (int e = 0; e < NE; ++e) { const int t = meta[96 + e]; acc += (e < F.tid) ? t : 0; }
        meta[F.tid] = acc; }
    __syncthreads();
}
struct EpiGU {
    static constexpr bool PERM = true, HAS_PRE = true;
    unsigned char* ACT; const float* bgu;
    __device__ __forceinline__ void pre(LAS unsigned char* dst, const pg8::Unit& u, int wid, int lane) const {
        if (wid == 1) { const int e = u.a0, pnl = u.pn - e * 8; const float* src = bgu + e * 2048 + (lane >> 5) * 1024 + pnl * 128 + (lane & 31) * 4;
            __builtin_amdgcn_global_load_lds((const unsigned*)src, (LAS unsigned*)dst, 16, 0, 0); } }
    __device__ __forceinline__ void operator()(const f32x4 (&acc)[2][2][4][2], const pg8::Unit& u, int wr, int wc, int fr, int fq, const LAS unsigned char* pre_) const {
        const int e = u.a0, pnl = u.pn - e * 8; const int lcol = wc * 32 + 8 * fq, ccol = pnl * 128 + lcol; const int row0 = u.pm * 256 + wr * 64 + fr;
        f32x2 bg[2][2], bl[2][2];
#pragma unroll
        for (int n = 0; n < 2; ++n) { const f32x4 g4 = *(const LAS f32x4*)(pre_ + (lcol + 4 * n) * 4), l4 = *(const LAS f32x4*)(pre_ + 512 + (lcol + 4 * n) * 4);
            bg[n][0] = (f32x2){g4[0], g4[1]}; bg[n][1] = (f32x2){g4[2], g4[3]}; bl[n][0] = (f32x2){l4[0] + 1.0f, l4[1] + 1.0f}; bl[n][1] = (f32x2){l4[2] + 1.0f, l4[3] + 1.0f}; }
        const f32x2 s2 = {1.0f / WGU_SCALE, 1.0f / WGU_SCALE}, c2 = {-1.702f * 1.4426950408889634f, -1.702f * 1.4426950408889634f}, one2 = {1.0f, 1.0f};
#pragma unroll
        for (int ai = 0; ai < 2; ++ai)
#pragma unroll
            for (int m = 0; m < 4; ++m) { unsigned char* rowp = ACT + (size_t)(row0 + ai * 128 + m * 16) * 1024 + ccol; f32x2 o[2][2];
#pragma unroll
                for (int n = 0; n < 2; ++n)
#pragma unroll
                    for (int h = 0; h < 2; ++h) { const f32x4 A4 = acc[ai][0][m][n], L4 = acc[ai][1][m][n];
                        f32x2 gv = __builtin_elementwise_fma((f32x2){A4[2 * h], A4[2 * h + 1]}, s2, bg[n][h]), lv = __builtin_elementwise_fma((f32x2){L4[2 * h], L4[2 * h + 1]}, s2, bl[n][h]);
                        gv[0] = fminf(gv[0], 7.0f); gv[1] = fminf(gv[1], 7.0f);
                        lv[0] = __builtin_amdgcn_fmed3f(lv[0], -6.0f, 8.0f); lv[1] = __builtin_amdgcn_fmed3f(lv[1], -6.0f, 8.0f);
                        const f32x2 t = gv * c2; f32x2 d = {__builtin_amdgcn_exp2f(t[0]), __builtin_amdgcn_exp2f(t[1])}; d = d + one2;
                        const f32x2 r = {__builtin_amdgcn_rcpf(d[0]), __builtin_amdgcn_rcpf(d[1])};
                        o[n][h] = gv * r * lv; }
                u32x2 w; w.x = pk4_fp8(o[0][0][0], o[0][0][1], o[0][1][0], o[0][1][1]); w.y = pk4_fp8(o[1][0][0], o[1][0][1], o[1][1][0], o[1][1][1]);
                *(u32x2*)rowp = w; }
    }
};
struct EpiDown {
    static constexpr bool PERM = true, HAS_PRE = true;
    unsigned char* YB; const float* bd; const unsigned* list;
    __device__ __forceinline__ void pre(LAS unsigned char* dst, const pg8::Unit& u, int wid, int lane) const {
        const int e = u.a0, rt = u.a1, pnl = u.pn - e * 4;
        if (wid == 1) __builtin_amdgcn_global_load_lds((const unsigned*)(bd + e * 1024 + pnl * 256 + lane * 4), (LAS unsigned*)dst, 16, 0, 0);
        if (wid == 2) __builtin_amdgcn_global_load_lds((const unsigned*)(list + (size_t)e * CAP + rt * 256 + lane * 4), (LAS unsigned*)(dst + 1024), 16, 0, 0); }
    __device__ __forceinline__ void operator()(const f32x4 (&acc)[2][2][4][2], const pg8::Unit& u, int wr, int wc, int fr, int fq, const LAS unsigned char* pre_) const {
        const int e = u.a0, pnl = u.pn - e * 4; const int lcol = wc * 32 + 8 * fq, col = pnl * 256 + lcol;
        f32x4 bv[2][2];
#pragma unroll
        for (int bj = 0; bj < 2; ++bj)
#pragma unroll
            for (int n = 0; n < 2; ++n) bv[bj][n] = *(const LAS f32x4*)(pre_ + (lcol + bj * 128 + 4 * n) * 4);
#pragma unroll
        for (int ai = 0; ai < 2; ++ai)
#pragma unroll
            for (int m = 0; m < 4; ++m) { const int R = ai * 128 + wr * 64 + m * 16 + fr; if (R >= u.a2) continue;
                const unsigned slot = *(const LAS unsigned*)(pre_ + 1024 + R * 4); unsigned char* rowp = YB + (size_t)slot * 1024 + col;
#pragma unroll
                for (int bj = 0; bj < 2; ++bj) { const f32x4 v0 = acc[ai][bj][m][0] * (1.0f / WD_SCALE) + bv[bj][0], v1 = acc[ai][bj][m][1] * (1.0f / WD_SCALE) + bv[bj][1];
                    u32x2 w; w.x = pk4_fp8(v0[0], v0[1], v0[2], v0[3]); w.y = pk4_fp8(v1[0], v1[1], v1[2], v1[3]);
                    *(u32x2*)(rowp + bj * 128) = w; } }
    }
};

__device__ __forceinline__ void ph_combine(Frame& F, int layer, float* hout, bool next_mod) {
    const float* mod = (const float*)(KWS(F) + WS_MOD) + (size_t)(layer * 3) * 6144;
    const float* modn = (const float*)(KWS(F) + WS_MOD) + (size_t)3 * 6144;
    const float* H1 = (const float*)(KWS(F) + WS_H1); const unsigned char* YB = (const unsigned char*)(KWS(F) + WS_YB); const float* gates = (const float*)(KWS(F) + WS_GATES);
    const float* lng = KIN(F, 8) + layer * DM; const float* lnb = KIN(F, 9) + layer * DM; bf16_t* U = (bf16_t*)(KWS(F) + WS_U);
    const int gw = F.bx * NWAVES + F.wave, NGW = F.G * NWAVES, lane = F.lane;
    LAS float* vC = (LAS float*)F.lds;
    for (int i = F.tid; i < 2 * DM; i += NTHR) { const int b = i >> 10, d = i & (DM - 1); LAS float* v = vC + b * 5 * DM + d;
        v[0] = mod[b * 6144 + 5120 + d]; v[DM] = lng[d]; v[2 * DM] = lnb[d]; v[3 * DM] = modn[b * 6144 + 1024 + d] + 1.0f; v[4 * DM] = modn[b * 6144 + d]; }
    __syncthreads();
    f32x4 nh[4]; unsigned nyb[4][4]; f32x4 ngt;
#define CMB_LOAD(r_) do { _Pragma("unroll") for (int j = 0; j < 4; ++j) { const int d = 4 * lane + 256 * j; nh[j] = *(const f32x4*)(H1 + (size_t)(r_) * DM + d); \
        _Pragma("unroll") for (int k = 0; k < 4; ++k) nyb[j][k] = *(const unsigned*)(YB + ((size_t)(r_) * 4 + k) * DM + d); } ngt = *(const f32x4*)(gates + (size_t)(r_) * 4); } while (0)
    if (gw < T) CMB_LOAD(gw);
    for (int row = gw; row < T; row += NGW) {
        int vb = (row >> 14) * 5 * DM + 4 * lane; asm volatile("" : "+v"(vb));
        const LAS float* vr = vC + vb;
        f32x4 ch[4]; unsigned cyb[4][4]; const f32x4 gt = ngt;
#pragma unroll
        for (int j = 0; j < 4; ++j) { ch[j] = nh[j];
#pragma unroll
            for (int k = 0; k < 4; ++k) cyb[j][k] = nyb[j][k]; }
        if (row + NGW < T) CMB_LOAD(row + NGW);
        f32x4 pre[4]; float s = 0.f;
#pragma unroll
        for (int j = 0; j < 4; ++j) { f32x4 y = {0.f, 0.f, 0.f, 0.f};
#pragma unroll
            for (int k = 0; k < 4; ++k) { const unsigned yw = cyb[j][k]; const f32x2 lo = __builtin_amdgcn_cvt_pk_f32_fp8((int)yw, false), hi2 = __builtin_amdgcn_cvt_pk_f32_fp8((int)yw, true);
                const f32x4 v = {lo[0], lo[1], hi2[0], hi2[1]};
                y += v * gt[k]; }
            pre[j] = ch[j] * ALPHA + *(const LAS f32x4*)(vr + 256 * j) * y; s += (pre[j][0] + pre[j][1]) + (pre[j][2] + pre[j][3]); }
        const float mean = wave_sum(s) * (1.0f / DM); float q2 = 0.f;
#pragma unroll
        for (int j = 0; j < 4; ++j) { pre[j] = pre[j] - mean; q2 += (pre[j][0] * pre[j][0] + pre[j][1] * pre[j][1]) + (pre[j][2] * pre[j][2] + pre[j][3] * pre[j][3]); }
        const float rstd = 1.0f / sqrtf(wave_sum(q2) * (1.0f / DM) + LN_EPS);
#pragma unroll
        for (int j = 0; j < 4; ++j) { const int d = 4 * lane + 256 * j; const f32x4 h = pre[j] * rstd * *(const LAS f32x4*)(vr + DM + 256 * j) + *(const LAS f32x4*)(vr + 2 * DM + 256 * j);
            *(f32x4*)(hout + (size_t)row * DM + d) = h;
            if (next_mod) { const f32x4 v = h * *(const LAS f32x4*)(vr + 3 * DM + 256 * j) + *(const LAS f32x4*)(vr + 4 * DM + 256 * j);
                u32x2 w; w.x = pk2(v[0], v[1]); w.y = pk2(v[2], v[3]); *(u32x2*)(U + (size_t)row * DM + d) = w; } }
    }
#undef CMB_LOAD
}

__device__ __forceinline__ void ph_gmlp(Frame& F) {
    const bf16_t* Z = (const bf16_t*)(KWS(F) + WS_ZODD); bf16_t* MIX = (bf16_t*)(KWS(F) + WS_MIX);
    const float* lg = KIN(F, 23); const float* lb = KIN(F, 24); const float* bs = KIN(F, 26); const bf16_t* wsb = (const bf16_t*)(KWS(F) + WS_TAB + TB_WS);
    const int lane = F.lane, r32 = lane & 31, hi = lane >> 5, wid = F.wave;
    for (int chunk = F.bx; chunk < T / 128; chunk += F.G) {
        const int r0 = chunk * 128;
        for (int qq = 0; qq < 16; ++qq) { const int q = wid * 16 + qq; const bf16x8 raw = *(const bf16x8*)(Z + (size_t)(r0 + q) * 1536 + 512 + 8 * lane);
            float v[8]; float s = 0.f;
#pragma unroll
            for (int j = 0; j < 8; ++j) { v[j] = bf2f((unsigned short)raw[j]); s += v[j]; }
            const float mean = wave_sum(s) * (1.0f / 512.0f); float q2 = 0.f;
#pragma unroll
            for (int j = 0; j < 8; ++j) { v[j] -= mean; q2 += v[j] * v[j]; }
            const float rstd = 1.0f / sqrtf(wave_sum(q2) * (1.0f / 512.0f) + LN_EPS);
            const f32x4 g0 = *(const f32x4*)(lg + 8 * lane), g1 = *(const f32x4*)(lg + 8 * lane + 4), b0 = *(const f32x4*)(lb + 8 * lane), b1 = *(const f32x4*)(lb + 8 * lane + 4);
            u32x4 w; w.x = pk2(v[0] * rstd * g0[0] + b0[0], v[1] * rstd * g0[1] + b0[1]); w.y = pk2(v[2] * rstd * g0[2] + b0[2], v[3] * rstd * g0[3] + b0[3]);
            w.z = pk2(v[4] * rstd * g1[0] + b1[0], v[5] * rstd * g1[1] + b1[1]); w.w = pk2(v[6] * rstd * g1[2] + b1[2], v[7] * rstd * g1[3] + b1[3]);
            const int ch = 8 * lane, g = ch >> 7, col = ch & 127, kt = (q >> 6) * 4 + g;
            *(LAS u32x4*)(F.lds + kt * 16384 + v_st(q & 63, col)) = w; }
        __syncthreads();
        const int pb = wid & 3, gh = wid >> 2;
#pragma unroll 1
        for (int gi = 0; gi < 2; ++gi) { const int g = 2 * gh + gi;
            unsigned wofs = (unsigned)(((g * 128 + 32 * pb + r32) * 128 + 8 * hi) * 2); asm volatile("" : "+v"(wofs));
            f32x16 acc[4];
#pragma unroll
            for (int d0 = 0; d0 < 4; ++d0) acc[d0] = f32x16{};
            bf16x8 af[8];
#pragma unroll
            for (int ks = 0; ks < 8; ++ks) af[ks] = *(const bf16x8*)((const char*)wsb + wofs + 32 * ks);
#pragma unroll
            for (int ks = 0; ks < 8; ++ks) {
                LAS unsigned char* trd = F.lds + ((ks >> 2) * 4 + g) * 16384 + v_rd_base(lane);
#pragma unroll
                for (int d0 = 0; d0 < 4; ++d0) acc[d0] = __builtin_amdgcn_mfma_f32_32x32x16_bf16(af[ks], vfrag(trd, d0, ks & 3), acc[d0], 0, 0, 0); }
            unsigned short uraw[16][4]; float bias[16];
#pragma unroll
            for (int r = 0; r < 16; ++r) { const int p = 32 * pb + crow(r, hi); bias[r] = bs[g * 128 + p];
#pragma unroll
                for (int d0 = 0; d0 < 4; ++d0) uraw[r][d0] = Z[(size_t)(r0 + p) * 1536 + g * 128 + d0 * 32 + r32]; }
            asm volatile("" ::: "memory");
#pragma unroll
            for (int r = 0; r < 16; ++r) { const int p = 32 * pb + crow(r, hi);
#pragma unroll
                for (int d0 = 0; d0 < 4; ++d0) { const int ch = g * 128 + d0 * 32 + r32;
                    MIX[(size_t)(r0 + p) * 1024 + ch] = (bf16_t)f2bf(bf2f(uraw[r][d0]) * (acc[d0][r] + bias[r])); } }
        }
        __syncthreads();
    }
}

__device__ __forceinline__ void ph_fourier1(Frame& F) {
    const bf16_t* Z = (const bf16_t*)(KWS(F) + WS_ZODD); bf16_t* WT = (bf16_t*)(KWS(F) + WS_WT);
    const float* lg = KIN(F, 27); const float* lb = KIN(F, 28);
    const bf16x8* CSf = (const bf16x8*)(KWS(F) + WS_TAB + TB_CS); const bf16x8* AFf = (const bf16x8*)(KWS(F) + WS_TAB + TB_AF); const f32x2* tw = (const f32x2*)(KWS(F) + WS_TAB + TB_TW);
    const int lane = F.lane, r32 = lane & 31, hi = lane >> 5, wid = F.wave;
    for (int unit = F.bx; unit < NB * 128; unit += F.G) {
        const int b = unit >> 7, t2 = unit & 127;
#pragma unroll 1
        for (int g = 0; g < 4; ++g) {
            {
                int lane_g = lane; asm volatile("" : "+v"(lane_g)); const int r32 = lane_g & 31, hi = lane_g >> 5;
                const int tb = wid & 3, part = wid >> 2; int t1 = 32 * tb + r32; asm volatile("" : "+v"(t1)); const size_t row = (size_t)b * SEQ + 128 * t1 + t2;
                bf16x8 raw[8]; float s = 0.f;
#pragma unroll
                for (int ks = 0; ks < 8; ++ks) { raw[ks] = *(const bf16x8*)(Z + row * 1536 + 1024 + g * 128 + 16 * ks + 8 * hi);
#pragma unroll
                    for (int j = 0; j < 8; ++j) s += bf2f((unsigned short)raw[ks][j]); }
                s += __shfl_xor(s, 32); const float mean = s * (1.0f / 128.0f); float q2 = 0.f;
#pragma unroll
                for (int ks = 0; ks < 8; ++ks)
#pragma unroll
                    for (int j = 0; j < 8; ++j) { const float d = bf2f((unsigned short)raw[ks][j]) - mean; q2 += d * d; }
                q2 += __shfl_xor(q2, 32); const float rstd = 1.0f / sqrtf(q2 * (1.0f / 128.0f) + LN_EPS);
                bf16x8 af[8];
#pragma unroll
                for (int ks = 0; ks < 8; ++ks) { const int c0 = g * 128 + 16 * ks + 8 * hi; const f32x4 g0 = *(const f32x4*)(lg + c0), g1 = *(const f32x4*)(lg + c0 + 4), b0 = *(const f32x4*)(lb + c0), b1 = *(const f32x4*)(lb + c0 + 4);
                    float x[8];
#pragma unroll
                    for (int j = 0; j < 8; ++j) x[j] = (bf2f((unsigned short)raw[ks][j]) - mean) * rstd;
                    u32x4 w; w.x = pk2(x[0] * g0[0] + b0[0], x[1] * g0[1] + b0[1]); w.y = pk2(x[2] * g0[2] + b0[2], x[3] * g0[3] + b0[3]);
                    w.z = pk2(x[4] * g1[0] + b1[0], x[5] * g1[1] + b1[1]); w.w = pk2(x[6] * g1[2] + b1[2], x[7] * g1[3] + b1[3]);
                    af[ks] = __builtin_bit_cast(bf16x8, w); }
                f32x16 acc[4];
#pragma unroll
                for (int d0 = 0; d0 < 4; ++d0) acc[d0] = f32x16{};
#pragma unroll
                for (int ks = 0; ks < 8; ++ks) { unsigned fo = (unsigned)(((4 * part) * 8 + ks) * 64 + lane) * 16u; asm volatile("" : "+v"(fo));
#pragma unroll
                    for (int d0 = 0; d0 < 4; ++d0) acc[d0] = __builtin_amdgcn_mfma_f32_32x32x16_bf16(af[ks], *(const bf16x8*)((const char*)CSf + fo + d0 * 8192), acc[d0], 0, 0, 0); }
                int ybase = (part * 2 + (tb >> 1)) * 16384 + (tb & 1) * 8192 + hi * 2048 + r32 * 2; asm volatile("" : "+v"(ybase));
#pragma unroll
                for (int r = 0; r < 16; ++r)
#pragma unroll
                    for (int d0 = 0; d0 < 4; ++d0) *(LAS bf16_t*)(F.lds + ybase + ((r >> 3) & 1) * 4096 + d0 * 512 + ((r & 3) + 4 * ((r >> 2) & 1)) * 64) = (bf16_t)f2bf(acc[d0][r]);
            }
            __syncthreads();
            {
                const int kb = wid & 3, ch2 = wid >> 2;
                f32x16 aR[2], aI[2];
#pragma unroll
                for (int dd = 0; dd < 2; ++dd) { aR[dd] = f32x16{}; aI[dd] = f32x16{}; }
#pragma unroll
                for (int kh = 0; kh < 4; ++kh) {
                    unsigned fo = (unsigned)((kb * 16 + kh * 4) * 64 + lane) * 16u; asm volatile("" : "+v"(fo));
                    bf16x8 fr8[4], fi8[4];
#pragma unroll
                    for (int k8 = 0; k8 < 4; ++k8) { fr8[k8] = *(const bf16x8*)((const char*)AFf + fo + k8 * 1024); fi8[k8] = *(const bf16x8*)((const char*)AFf + fo + k8 * 1024 + 65536); }
#pragma unroll
                    for (int k8 = 0; k8 < 4; ++k8) { const int ks = kh * 4 + k8;
                        LAS unsigned char* trd = F.lds + (ks >> 2) * 16384 + v_rd_base(lane);
#pragma unroll
                        for (int dd = 0; dd < 2; ++dd) { const bf16x8 bf = vfrag(trd, 2 * ch2 + dd, ks & 3);
                            aR[dd] = __builtin_amdgcn_mfma_f32_32x32x16_bf16(fr8[k8], bf, aR[dd], 0, 0, 0); aI[dd] = __builtin_amdgcn_mfma_f32_32x32x16_bf16(fi8[k8], bf, aI[dd], 0, 0, 0); } }
                }
                int k1b = 32 * kb + 4 * hi; asm volatile("" : "+v"(k1b));
                f32x2 csv[16];
#pragma unroll
                for (int r = 0; r < 16; ++r) csv[r] = tw[t2 * 128 + k1b + (r & 3) + 8 * (r >> 2)];
                asm volatile("" ::: "memory");
#pragma unroll
                for (int r = 0; r < 16; ++r) { const int k1 = k1b + (r & 3) + 8 * (r >> 2); const f32x2 cs = csv[r];
                    bf16_t* dst = WT + ((((size_t)b * 128 + k1) * 128 + t2) * 4 + g) * 256;
#pragma unroll
                    for (int dd = 0; dd < 2; ++dd) { const float wr_ = aR[dd][r], wi_ = aI[dd][r]; const int j = 32 * (2 * ch2 + dd) + r32;
                        dst[j] = (bf16_t)f2bf(wr_ * cs[0] + wi_ * cs[1]); dst[128 + j] = (bf16_t)f2bf(wi_ * cs[0] - wr_ * cs[1]); }
                    if ((r & 3) == 3) asm volatile("" ::: "memory"); }
            }
            __syncthreads();
        }
    }
}
__device__ __forceinline__ void ph_fourier2(Frame& F) {
    const bf16_t* WT = (const bf16_t*)(KWS(F) + WS_WT); bf16_t* MIX = (bf16_t*)(KWS(F) + WS_MIX);
    const bf16x8* A3f = (const bf16x8*)(KWS(F) + WS_TAB + TB_A3);
    const int lane = F.lane, r32 = lane & 31, hi = lane >> 5, wid = F.wave;
    for (int unit = F.bx; unit < NB * 128; unit += F.G) {
        const int b = unit >> 7, k1 = unit & 127;
#pragma unroll 1
        for (int g = 0; g < 4; ++g) {
            for (int idx = F.tid; idx < 4096; idx += NTHR) { const int t2 = idx >> 5, c = idx & 31, part = c >> 4, j0 = (c & 15) * 8;
                const u32x4 v = *(const u32x4*)(WT + ((((size_t)b * 128 + k1) * 128 + t2) * 4 + g) * 256 + part * 128 + j0);
                *(LAS u32x4*)(F.lds + (part * 2 + (t2 >> 6)) * 16384 + v_st(t2 & 63, j0)) = v; }
            __syncthreads();
            const int mb = wid & 3, ch2 = wid >> 2;
            f32x16 acc[2] = {f32x16{}, f32x16{}};
#pragma unroll
            for (int ks = 0; ks < 16; ++ks) { unsigned fo = (unsigned)((mb * 16 + ks) * 64 + lane) * 16u; asm volatile("" : "+v"(fo)); const bf16x8 af = *(const bf16x8*)((const char*)A3f + fo);
                LAS unsigned char* trd = F.lds + (ks >> 2) * 16384 + v_rd_base(lane);
#pragma unroll
                for (int dd = 0; dd < 2; ++dd) acc[dd] = __builtin_amdgcn_mfma_f32_32x32x16_bf16(af, vfrag(trd, 2 * ch2 + dd, ks & 3), acc[dd], 0, 0, 0); }
#pragma unroll
            for (int r = 0; r < 16; ++r) { const int k2 = 32 * mb + crow(r, hi); const size_t row = (size_t)b * SEQ + k1 + 128 * k2;
#pragma unroll
                for (int dd = 0; dd < 2; ++dd) MIX[row * 1024 + 512 + g * 128 + 32 * (2 * ch2 + dd) + r32] = (bf16_t)f2bf(acc[dd][r]); }
            __syncthreads();
        }
    }
}

#ifndef MK_ONE_LAUNCH
#define MK_ONE_LAUNCH 1
#endif
constexpr int NPH = 18;
#ifndef PHMASK
#define PHMASK 0x3FFFF
#endif
#define HAS(k) (((PHMASK) >> (k)) & 1)
__global__ void __launch_bounds__(NTHR, 2) fwd_kernel(Args args) {
    extern __shared__ __attribute__((aligned(16))) unsigned char lds_raw[];
    Frame F;
    F.lds = (LAS unsigned char*)lds_raw; F.tid = threadIdx.x; F.lane = F.tid & 63; F.wave = __builtin_amdgcn_readfirstlane(F.tid >> 6); F.G = gridDim.x; F.bx = blockIdx.x;
    F.kz = 0;
    volatile LAS unsigned* MISC = (volatile LAS unsigned*)(F.lds + MISC_OFF);
    if (F.tid < 64) MISC[F.tid] = 0u;
    __syncthreads();
    if (MK_ONE_LAUNCH) (void)xcd_barrier_post((unsigned*)(args.ws + WS_CTL) + CW_BAR, MISC + 8);
    const int lo = args.ph_lo, hi = args.ph_hi;
#define IN(k) (lo <= (k) && (k) < hi)
#ifndef REPMASK
#define REPMASK 0
#endif
#define REP(k) (((REPMASK) >> (k)) & 1)
#define BARNOW() do { ENTER(); XcdBarrier bar_; bar_.bar = (unsigned*)(KWS(F) + WS_CTL) + CW_BAR; bar_.x = xb_xcc_id(); bar_.st = (volatile LAS unsigned*)(F.lds + MISC_OFF) + 8; xcd_barrier(bar_); } while (0)
#ifndef DIAG_PH
#define DIAG_PH -1
#endif
    int nstamp = 0;
#define STAMP() do { if (DIAG_PH >= 0) { if (F.tid == 0) ((volatile LAS unsigned*)(F.lds + MISC_OFF))[16 + nstamp] = (unsigned)__builtin_amdgcn_s_memrealtime(); ++nstamp; } } while (0)
    STAMP();
#define ENTER() do { asm volatile("" : "+s"(F.kz), "+s"(F.wave), "+s"(F.G), "+s"(F.bx), "+v"(F.tid), "+v"(F.lane)); F.kz = __builtin_amdgcn_readfirstlane(F.kz); F.wave = __builtin_amdgcn_readfirstlane(F.wave); \
    F.G = __builtin_amdgcn_readfirstlane(F.G); F.bx = __builtin_amdgcn_readfirstlane(F.bx); } while (0)
#define SEAM(k) do { if (IN(k) && IN((k) + 1)) { if (MK_ONE_LAUNCH) { ENTER(); XcdBarrier bar_; bar_.bar = (unsigned*)(KWS(F) + WS_CTL) + CW_BAR; bar_.x = xb_xcc_id(); bar_.st = (volatile LAS unsigned*)(F.lds + MISC_OFF) + 8; xcd_barrier(bar_); STAMP(); } } } while (0)

    if (HAS(0) && IN(0)) { ENTER(); for (int rep_ = 0; rep_ <= REP(0); ++rep_) { if (rep_) BARNOW(); ph0_mod_tables(F); } } SEAM(0);
    if (HAS(1) && IN(1)) { ENTER(); for (int rep_ = 0; rep_ <= REP(1); ++rep_) { if (rep_) BARNOW(); ph1_convert(F); } } SEAM(1);
    if (HAS(2) && IN(2)) { ENTER(); for (int rep_ = 0; rep_ <= REP(2); ++rep_) { if (rep_) BARNOW(); ph2_modulate(F); } } SEAM(2);

    for (int layer = 0; layer < 2; ++layer) {
        const int pb = layer == 0 ? 5 : 13;
        if (layer == 0) {
            if (HAS(3) && IN(3)) { ENTER(); for (int rep_ = 0; rep_ <= REP(3); ++rep_) { if (rep_) BARNOW();
                pg8::Gemm g{(const bf16_t*)(KWS(F) + WS_U), (const bf16_t*)(KWS(F) + WS_WEVIN), T, 2560, DM};
                EvInOrder S; S.so.init(T, 2560, F.G, F.bx);
                EpiEvIn E{(unsigned char*)(KWS(F) + WS_Q), (unsigned char*)(KWS(F) + WS_K), (unsigned char*)(KWS(F) + WS_V), (bf16_t*)(KWS(F) + WS_AB), (const float*)(KWS(F) + WS_TAB + TB_COS), (const float*)(KWS(F) + WS_TAB + TB_SIN), F.lds + 138240};
                pg8::gemm_phase<EpiEvIn, EvInOrder, true, false>(F.lds, g, S, E, F.tid);
            } } SEAM(3);
            if (HAS(4) && IN(4)) { ENTER(); for (int rep_ = 0; rep_ <= REP(4); ++rep_) { if (rep_) BARNOW(); ph4_conv(F); ph4_attention(F); } } SEAM(4);
        } else {
            if (HAS(10) && IN(10)) { ENTER(); for (int rep_ = 0; rep_ <= REP(10); ++rep_) { if (rep_) BARNOW();
                pg8::Gemm g{(const bf16_t*)(KWS(F) + WS_U), (const bf16_t*)(KWS(F) + WS_WODIN), T, 1536, DM};
                pg8::StaticOrder S; S.init(T, 1536, F.G, F.bx);
                pg8::EpiBf16 E{(bf16_t*)(KWS(F) + WS_ZODD), 1536, 4};
                pg8::gemm_phase<pg8::EpiBf16, pg8::StaticOrder, true, false>(F.lds, g, S, E, F.tid);
            } } SEAM(10);
            if (HAS(11) && IN(11)) { ENTER(); for (int rep_ = 0; rep_ <= REP(11); ++rep_) { if (rep_) BARNOW(); ph_gmlp(F); ph_fourier1(F); } } SEAM(11);
            if (HAS(12) && IN(12)) { ENTER(); for (int rep_ = 0; rep_ <= REP(12); ++rep_) { if (rep_) BARNOW(); ph_fourier2(F); } } SEAM(12);
        }
        if (HAS(5) && IN(pb)) { ENTER(); for (int rep_ = 0; rep_ <= REP(5); ++rep_) { if (rep_) BARNOW();
            pg8::Gemm g{(const bf16_t*)(KWS(F) + WS_MIX), (const bf16_t*)(KWS(F) + (layer == 0 ? WS_WEVOUT : WS_WODOUT)), T, DM, DM};
            pg8::StaticOrder S; S.init(T, DM, F.G, F.bx);
            pg8::EpiBf16 E{(bf16_t*)(KWS(F) + WS_Y), DM, 0};
            pg8::gemm_phase<pg8::EpiBf16, pg8::StaticOrder, true, false>(F.lds, g, S, E, F.tid);
        } } SEAM(pb);
        if (HAS(6) && IN(pb + 1)) { ENTER(); for (int rep_ = 0; rep_ <= REP(6); ++rep_) { if (rep_) BARNOW(); ph_router(F, layer, layer == 0 ? KIN(F, 0) : (const float*)(KWS(F) + WS_H2)); } } SEAM(pb + 1);
        if (HAS(7) && IN(pb + 2)) { ENTER(); for (int rep_ = 0; rep_ <= REP(7); ++rep_) { if (rep_) BARNOW();
            moe_meta(F, layer);
            pg8::Gemm g{(const bf16_t*)(KWS(F) + WS_U2), (const bf16_t*)(KWS(F) + WS_WGU + (size_t)layer * NE * 2048 * DM), 0, 0, DM / 2};
            MoeOrder S{(const LAS int*)(F.lds + META_OFF), (const unsigned*)(KWS(F) + WS_LIST), F.bx, F.G, 8, 4};
            EpiGU E{(unsigned char*)(KWS(F) + WS_ACT), KIN(F, 32) + (size_t)layer * NE * 2048};
            pg8::gemm_phase<EpiGU, MoeOrder, true, true, true>(F.lds, g, S, E, F.tid);
        } } SEAM(pb + 2);
        if (HAS(8) && IN(pb + 3)) { ENTER(); for (int rep_ = 0; rep_ <= REP(8); ++rep_) { if (rep_) BARNOW();
            moe_meta(F, layer);
            pg8::Gemm g{(const bf16_t*)(KWS(F) + WS_ACT), (const bf16_t*)(KWS(F) + WS_WD + (size_t)layer * NE * 1024 * DM), 0, 0, DM / 2};
            MoeOrder S{(const LAS int*)(F.lds + META_OFF), (const unsigned*)(KWS(F) + WS_LIST), F.bx, F.G, 4, 8};
            EpiDown E{(unsigned char*)(KWS(F) + WS_YB), KIN(F, 34) + (size_t)layer * NE * 1024, (const unsigned*)(KWS(F) + WS_LIST)};
            pg8::gemm_phase<EpiDown, MoeOrder, true, false, true>(F.lds, g, S, E, F.tid);
        } } SEAM(pb + 3);
        if (HAS(9) && IN(pb + 4)) { ENTER(); for (int rep_ = 0; rep_ <= REP(9); ++rep_) { if (rep_) BARNOW(); ph_combine(F, layer, layer == 0 ? (float*)(KWS(F) + WS_H2) : KOUT(F), layer == 0); } }
        if (layer == 0) SEAM(pb + 4);
    }
    if (DIAG_PH >= 0) {
        ENTER(); XcdBarrier bar_; bar_.bar = (unsigned*)(KWS(F) + WS_CTL) + CW_BAR; bar_.x = xb_xcc_id(); bar_.st = (volatile LAS unsigned*)(F.lds + MISC_OFF) + 8; xcd_barrier(bar_); STAMP();
        __syncthreads();
        volatile LAS unsigned* st = (volatile LAS unsigned*)(F.lds + MISC_OFF) + 16;
        const unsigned d = st[DIAG_PH + 1] - st[DIAG_PH];
        const float c = sqrtf((float)d * 0.01f);
        float* o = KOUT(F);
        for (size_t i = (size_t)F.bx * NTHR + F.tid; i < (size_t)T * DM; i += (size_t)F.G * NTHR) o[i] = c;
    }
#undef IN
#undef SEAM
}

extern "C" void kernel_launch(void* const* d_in, const int* in_sizes, int n_in, void* d_out, int out_size, void* d_ws, size_t ws_size, hipStream_t stream) {
    static int grid = 0;
    if (grid == 0) {
        if (n_in != 35 || out_size != T * DM || ws_size < WS_END) { fprintf(stderr, "kernel_launch: unexpected shapes: n_in %d out %d ws %zu (need %zu)\n", n_in, out_size, ws_size, (size_t)WS_END); grid = -1; return; }
        int dev = 0, cus = 0;
        if (hipGetDevice(&dev) != hipSuccess || hipDeviceGetAttribute(&cus, hipDeviceAttributeMultiprocessorCount, dev) != hipSuccess) { grid = -1; return; }
        if (hipFuncSetAttribute((const void*)fwd_kernel, hipFuncAttributeMaxDynamicSharedMemorySize, LDS_BYTES) != hipSuccess) { fprintf(stderr, "kernel_launch: hipFuncSetAttribute failed\n"); grid = -1; return; }
        int per_cu = 0; (void)hipOccupancyMaxActiveBlocksPerMultiprocessor(&per_cu, (const void*)fwd_kernel, NTHR, LDS_BYTES); (void)hipGetLastError();
        if (per_cu < 1) fprintf(stderr, "kernel_launch: occupancy query reports %d blocks per CU\n", per_cu);
        grid = cus > 256 ? 256 : cus;
        if (grid != 256) fprintf(stderr, "kernel_launch: %d CUs; this kernel is laid out for 256\n", cus);
    }
    if (grid < 0) return;
    (void)hipMemsetAsync((char*)d_ws + WS_CTL, 0, CTL_ZERO_BYTES, stream);
    Args a{};
    for (int i = 0; i < 35; ++i) a.in[i] = (const float*)d_in[i];
    a.out = (float*)d_out; a.ws = (unsigned char*)d_ws;
#if MK_ONE_LAUNCH
    a.ph_lo = 0; a.ph_hi = NPH;
    hipLaunchKernelGGL(fwd_kernel, dim3(grid), dim3(NTHR), LDS_BYTES, stream, a);
#else
    for (int p = 0; p < NPH; ++p) { a.ph_lo = p; a.ph_hi = p + 1; hipLaunchKernelGGL(fwd_kernel, dim3(grid), dim3(NTHR), LDS_BYTES, stream, a); }
#endif
    const hipError_t le = hipPeekAtLastError();
    if (le != hipSuccess) fprintf(stderr, "kernel_launch: launch failed: %s\n", hipGetErrorName(le));
}
```

```cpp
#include <hip/hip_runtime.h>
#include <cstdio>
#include <cstdint>

#define LAS __attribute__((address_space(3)))
#define GAS __attribute__((address_space(1)))
typedef unsigned short bf16_t;
typedef short bf16x8 __attribute__((ext_vector_type(8)));
typedef short s16x4 __attribute__((ext_vector_type(4)));
typedef float f32x4 __attribute__((ext_vector_type(4)));
typedef float f32x2 __attribute__((ext_vector_type(2)));
typedef float f32x16 __attribute__((ext_vector_type(16)));
typedef unsigned u32x4 __attribute__((ext_vector_type(4)));
typedef unsigned u32x2 __attribute__((ext_vector_type(2)));

namespace pg8 {
constexpr int BM = 256, BK = 64, HALF = 128, HTB = HALF * BK * 2, STAGE_BYTES = 8 * HTB, NXCD = 8, WGM = 8;
__host__ __device__ __forceinline__ int lds_byte(int r, int c) { const int st = (r >> 4) * 2 + (c >> 5), rr = r & 15, cc = c & 31, ob = rr * 64 + cc * 2; return st * 1024 + (ob ^ (((ob >> 9) & 1) << 5)); }
__host__ __device__ __forceinline__ void stage_rc(int b, int& R, int& C) { const int st = b / 1024, sb = b % 1024, swz = sb ^ (((sb >> 9) & 1) << 5); R = (st >> 1) * 16 + swz / 64; C = (st & 1) * 32 + (swz % 64) / 2; }
__host__ __device__ __forceinline__ int perm32(int rho) { const int n = rho >> 4, i = rho & 15; return 8 * (i >> 2) + 4 * n + (i & 3); }

struct Unit { int pm, pn, a0, a1, a2; };
struct Gemm { const bf16_t* A; const bf16_t* Bt; int M, N, K; };

constexpr int PRE_ROWS = 131072 + 1024, PRE_EPI = PRE_ROWS + 2048;
struct StaticOrder {
    int nM, nN, nwg, G, c;
    __device__ void init(int M, int N, int G_, int c_) { nM = M / BM; nN = N / BM; nwg = nM * nN; G = G_; c = c_; }
    __device__ bool map(long L, Unit& u) const {
        if (L >= nwg) return false;
        int wgid = (int)L; { const int q = nwg / NXCD, r = nwg % NXCD, xcd = wgid % NXCD, off = wgid / NXCD; wgid = (xcd < r ? xcd * (q + 1) : r * (q + 1) + (xcd - r) * q) + off; }
        const int nig = WGM * nN, gid = wgid / nig, fm = gid * WGM, gsz = (nM - fm) < WGM ? (nM - fm) : WGM;
        u.pm = fm + ((wgid % nig) % gsz); u.pn = (wgid % nig) / gsz; u.a0 = 0; u.a1 = 0; u.a2 = 256; return true;
    }
    __device__ bool next(int i, Unit& u) const { return map((long)i * G + c, u); }
    __device__ __forceinline__ unsigned arow(const Unit&, int) const { return 0u; }
    __device__ __forceinline__ unsigned rowval(const Unit&, int, unsigned) const { return 0u; }
    __device__ __forceinline__ const unsigned* rows_ptr(const Unit&) const { return nullptr; }
};

__device__ __forceinline__ unsigned cvt_pk_bf16(float lo, float hi) { unsigned r; asm volatile("v_cvt_pk_bf16_f32 %0, %1, %2" : "=v"(r) : "v"(lo), "v"(hi)); return r; }

__device__ __forceinline__ float gelu_tanh(float x) {
    const float t = x * (1.0f + 0.044715f * x * x) * (2.0f * 0.7978845608028654f * 1.4426950408889634f);
    return x * __builtin_amdgcn_rcpf(1.0f + __builtin_amdgcn_exp2f(-t));
}

struct EpiBf16 {
    static constexpr bool PERM = true, HAS_PRE = false;
    bf16_t* O; int ldc; int gelu_pn;
    __device__ __forceinline__ void operator()(const f32x4 (&acc)[2][2][4][2], const Unit& u, int wr, int wc, int fr, int fq) const {
        const int row0 = u.pm * BM + wr * 64 + fr; const int col0 = u.pn * BM + wc * 32 + 8 * fq;
        const bool act = u.pn < gelu_pn;
#pragma unroll
        for (int ai = 0; ai < 2; ++ai)
#pragma unroll
            for (int m = 0; m < 4; ++m) { bf16_t* rowp = O + (size_t)(row0 + ai * HALF + m * 16) * ldc + col0;
#pragma unroll
                for (int bj = 0; bj < 2; ++bj) { f32x4 v0 = acc[ai][bj][m][0], v1 = acc[ai][bj][m][1];
                    if (act) {
#pragma unroll
                        for (int j = 0; j < 4; ++j) { v0[j] = gelu_tanh(v0[j]); v1[j] = gelu_tanh(v1[j]); } }
                    u32x4 w; w.x = cvt_pk_bf16(v0[0], v0[1]); w.y = cvt_pk_bf16(v0[2], v0[3]); w.z = cvt_pk_bf16(v1[0], v1[1]); w.w = cvt_pk_bf16(v1[2], v1[3]);
                    *(u32x4*)(rowp + bj * HALF) = w; } }
    }
};

typedef int v8i32 __attribute__((ext_vector_type(8)));
typedef short s16x16 __attribute__((ext_vector_type(16)));
template <class Epi, class Sched, bool ALIGN_EPI, bool GATHER, bool FP8 = false>
__device__ __forceinline__ void gemm_phase(LAS unsigned char* lds, const Gemm g, const Sched& S, const Epi& E, const int tid) {
    const int wid = __builtin_amdgcn_readfirstlane(tid >> 6), lane = tid & 63, wr = wid >> 2, wc = wid & 3, fr = lane & 15, fq = lane >> 4;
    const int K = g.K, nt = K / BK;
    unsigned voffA[2], voffB[2]; int Rr[2], Cc[2];
#pragma unroll
    for (int i = 0; i < 2; ++i) { int R, C; stage_rc(tid * 16 + i * 8192, R, C); const int Rb = Epi::PERM ? ((R & ~31) + perm32(R & 31)) : R; Rr[i] = R; Cc[i] = C;
        voffA[i] = (unsigned)(R * K + C) * 2u; voffB[i] = (unsigned)(Rb * K + C) * 2u; }
    const unsigned kstep = (unsigned)(BK * 2);
    const unsigned hstep = (unsigned)HALF * (unsigned)K * 2u;
    const unsigned tstep = 2u * hstep;
    const char* const baseA = (const char*)g.A; const char* const baseB = (const char*)g.Bt;
    const unsigned ldsw = (unsigned)wid * 1024u;
    const int aoff = lds_byte(wr * 64 + fr, fq * 8), boff = lds_byte(wc * 32 + fr, fq * 8);
    const int aoff0 = lds_byte(wr * 64 + fr, fq * 16), aoff1 = lds_byte(wr * 64 + fr, fq * 16 + 8), boff0 = lds_byte(wc * 32 + fr, fq * 16), boff1 = lds_byte(wc * 32 + fr, fq * 16 + 8);
#define PG8_SA(b, h) (((b) * 2 + (h)) * HTB)
#define PG8_SB(b, h) ((4 + (b) * 2 + (h)) * HTB)
#define PG8_STAGE(bufoff, gbase, voff) do { _Pragma("unroll") for (int _i = 0; _i < 2; ++_i) \
        __builtin_amdgcn_global_load_lds((const unsigned*)(baseB + (size_t)(unsigned)((gbase) + (voff)[_i])), (LAS unsigned*)(lds + (bufoff) + ldsw + _i * 8192), 16, 0, 0); } while (0)
#define PG8_STAGEA(bufoff, gbase, voff) do { _Pragma("unroll") for (int _i = 0; _i < 2; ++_i) \
        __builtin_amdgcn_global_load_lds((const unsigned*)(baseA + (size_t)(unsigned)((gbase) + (voff)[_i])), (LAS unsigned*)(lds + (bufoff) + ldsw + _i * 8192), 16, 0, 0); } while (0)
#define PG8_STAGE_A(bufoff, base, h, nx) do { if constexpr (GATHER) { _Pragma("unroll") for (int _i = 0; _i < 2; ++_i) { const unsigned _v = (nx) ? vAn[h][_i] : vAc[h][_i]; \
            __builtin_amdgcn_global_load_lds((const unsigned*)(baseA + (size_t)(unsigned)((base) + _v)), (LAS unsigned*)(lds + (bufoff) + ldsw + _i * 8192), 16, 0, 0); } } \
        else { PG8_STAGEA(bufoff, (base) + (h) * hstep, voffA); } } while (0)
#define PG8_LD8(dst, i, off0, off1) do { const bf16x8 _lo = *(const LAS bf16x8*)(lds + (off0)), _hi = *(const LAS bf16x8*)(lds + (off0) + 16); dst[i] = __builtin_bit_cast(v8i32, __builtin_shufflevector(_lo, _hi, 0, 1, 2, 3, 4, 5, 6, 7, 8, 9, 10, 11, 12, 13, 14, 15)); } while (0)
#define PG8_LDA8(dst, b, h) do { _Pragma("unroll") for (int m = 0; m < 4; ++m) PG8_LD8(dst, m, PG8_SA(b, h) + aoff0 + m * 2048, PG8_SA(b, h) + aoff1 + m * 2048); } while (0)
#define PG8_LDB8(dst, b, h) do { _Pragma("unroll") for (int n = 0; n < 2; ++n) PG8_LD8(dst, n, PG8_SB(b, h) + boff0 + n * 2048, PG8_SB(b, h) + boff1 + n * 2048); } while (0)
#define PG8_MMA8(ai, bj, At, Bt) do { __builtin_amdgcn_s_setprio(1); _Pragma("unroll") for (int m = 0; m < 4; ++m) _Pragma("unroll") for (int n = 0; n < 2; ++n) \
        asm volatile("v_mfma_scale_f32_16x16x128_f8f6f4 %0, %1, %2, %0, %3, %3 op_sel_hi:[0,0,0]" : "+v"(acc[ai][bj][m][n]) : "v"(Bt[n]), "v"(At[m]), "v"(one_scale)); __builtin_amdgcn_s_setprio(0); } while (0)
#define PG8_LDA(dst, b, h) do { _Pragma("unroll") for (int m = 0; m < 4; ++m) _Pragma("unroll") for (int k = 0; k < 2; ++k) dst[m][k] = *(const LAS bf16x8*)(lds + PG8_SA(b, h) + aoff + m * 2048 + k * 1024); } while (0)
#define PG8_LDB(dst, b, h) do { _Pragma("unroll") for (int n = 0; n < 2; ++n) _Pragma("unroll") for (int k = 0; k < 2; ++k) dst[n][k] = *(const LAS bf16x8*)(lds + PG8_SB(b, h) + boff + n * 2048 + k * 1024); } while (0)
#define PG8_MMA(ai, bj, At, Bt) do { __builtin_amdgcn_s_setprio(1); _Pragma("unroll") for (int m = 0; m < 4; ++m) _Pragma("unroll") for (int n = 0; n < 2; ++n) _Pragma("unroll") for (int k = 0; k < 2; ++k) \
        acc[ai][bj][m][n] = __builtin_amdgcn_mfma_f32_16x16x32_bf16(Bt[n][k], At[m][k], acc[ai][bj][m][n], 0, 0, 0); __builtin_amdgcn_s_setprio(0); } while (0)
#define PG8_WAIT_V(n) asm volatile("s_waitcnt vmcnt(" #n ")" ::: "memory")
#define PG8_WAIT_L(n) asm volatile("s_waitcnt lgkmcnt(" #n ")" ::: "memory")
#define PG8_BAR __builtin_amdgcn_s_barrier()
#define PG8_SCHED __builtin_amdgcn_sched_barrier(0)
    Unit cur, nxt; int ui = 0;
    if (!S.next(0, cur)) return;
    f32x4 acc[2][2][4][2];
#pragma unroll
    for (int a = 0; a < 2; ++a)
#pragma unroll
        for (int b = 0; b < 2; ++b)
#pragma unroll
            for (int m = 0; m < 4; ++m)
#pragma unroll
                for (int n = 0; n < 2; ++n) acc[a][b][m][n] = (f32x4){0.f, 0.f, 0.f, 0.f};
    bf16x8 At[4][2], B0[2][2], B1[2][2]; v8i32 At8[4], B08[2], B18[2]; const int one_scale = 0x7F7F7F7F;
#define XLDA(b, h) do { if constexpr (FP8) PG8_LDA8(At8, b, h); else PG8_LDA(At, b, h); } while (0)
#define XLDB0(b, h) do { if constexpr (FP8) PG8_LDB8(B08, b, h); else PG8_LDB(B0, b, h); } while (0)
#define XLDB1(b, h) do { if constexpr (FP8) PG8_LDB8(B18, b, h); else PG8_LDB(B1, b, h); } while (0)
#define XMMA0(ai, bj) do { if constexpr (FP8) PG8_MMA8(ai, bj, At8, B08); else PG8_MMA(ai, bj, At, B0); } while (0)
#define XMMA1(ai, bj) do { if constexpr (FP8) PG8_MMA8(ai, bj, At8, B18); else PG8_MMA(ai, bj, At, B1); } while (0)
    unsigned vAc[2][2], vAn[2][2];
#define PG8_ROWS(dst, un) do { if constexpr (GATHER) { _Pragma("unroll") for (int _h = 0; _h < 2; ++_h) _Pragma("unroll") for (int _i = 0; _i < 2; ++_i) \
        dst[_h][_i] = (S.arow(un, _h * HALF + Rr[0] + 64 * _i) * (unsigned)K + (unsigned)Cc[0]) * 2u; } } while (0)
    PG8_ROWS(vAc, cur);
#pragma unroll
    for (int _h = 0; _h < 2; ++_h)
#pragma unroll
        for (int _i = 0; _i < 2; ++_i) vAn[_h][_i] = vAc[_h][_i];
    unsigned cA = GATHER ? 0u : (unsigned)cur.pm * tstep; unsigned cB = (unsigned)cur.pn * tstep;
    PG8_STAGE(PG8_SB(0, 0), cB, voffB); PG8_STAGE(PG8_SB(0, 1), cB + hstep, voffB); PG8_STAGE_A(PG8_SA(0, 0), cA, 0, false); PG8_STAGE_A(PG8_SA(0, 1), cA, 1, false);
    if (wr == 1) PG8_BAR;
    PG8_WAIT_V(2); PG8_BAR;
    PG8_STAGE(PG8_SB(1, 0), cB + kstep, voffB); PG8_STAGE_A(PG8_SA(1, 0), cA + kstep, 0, false); PG8_STAGE(PG8_SB(1, 1), cB + hstep + kstep, voffB);
    PG8_WAIT_V(6); PG8_BAR;
    for (;;) {
        const bool has_next = S.next(ui + 1, nxt);
        if constexpr (GATHER) {
            if (has_next) {
                if (ui == 0) { PG8_ROWS(vAn, nxt); asm volatile("" : "+v"(vAn[0][0]), "+v"(vAn[0][1]), "+v"(vAn[1][0]), "+v"(vAn[1][1])); }
                else {
#pragma unroll
                    for (int _h = 0; _h < 2; ++_h)
#pragma unroll
                        for (int _i = 0; _i < 2; ++_i) { const int R_ = _h * HALF + Rr[0] + 64 * _i; const unsigned v_ = *(const LAS unsigned*)(lds + PRE_ROWS + ((ui + 1) & 1) * 1024 + R_ * 4);
                            vAn[_h][_i] = (S.rowval(nxt, R_, v_) * (unsigned)K + (unsigned)Cc[0]) * 2u; } }
            }
            Unit n2_; if (S.next(ui + 2, n2_)) { if (wid == 0) __builtin_amdgcn_global_load_lds((const unsigned*)(S.rows_ptr(n2_) + lane * 4), (LAS unsigned*)(lds + PRE_ROWS + (ui & 1) * 1024), 16, 0, 0); }
        } else { if (has_next) { PG8_ROWS(vAn, nxt); } }
        if constexpr (Epi::HAS_PRE) E.pre(lds + PRE_EPI + (ui & 1) * 2048, cur, wid, lane);
        const unsigned nA = GATHER ? 0u : (has_next ? (unsigned)nxt.pm * tstep : cA);
        const unsigned nB = has_next ? (unsigned)nxt.pn * tstep : cB;
#pragma unroll 1
        for (int t = 0; t < nt; t += 2) {
            const bool last = (t == nt - 2);
            const bool nx = last && has_next;
            const unsigned a1 = cA + (unsigned)(t + 1) * kstep;
            const unsigned a2 = last ? nA : cA + (unsigned)(t + 2) * kstep; const unsigned b2 = last ? nB : cB + (unsigned)(t + 2) * kstep;
            const unsigned a3 = a2 + kstep; const unsigned b3 = b2 + kstep;
            XLDB0(0, 0); XLDB1(0, 1); PG8_SCHED; XLDA(0, 0); PG8_STAGE_A(PG8_SA(1, 1), a1, 1, false);
            PG8_WAIT_V(8); PG8_WAIT_L(0); PG8_BAR; XMMA0(0, 0); XMMA1(0, 1); PG8_BAR; PG8_SCHED;
            XLDA(0, 1); PG8_STAGE(PG8_SB(0, 0), b2, voffB); PG8_STAGE(PG8_SB(0, 1), b2 + hstep, voffB); PG8_STAGE_A(PG8_SA(0, 0), a2, 0, nx);
            PG8_WAIT_V(8); PG8_WAIT_L(0); PG8_BAR; XMMA0(1, 0); XMMA1(1, 1); PG8_BAR; PG8_SCHED;
            XLDB0(1, 0); XLDB1(1, 1); PG8_SCHED; XLDA(1, 0); PG8_STAGE_A(PG8_SA(0, 1), a2, 1, nx);
            PG8_WAIT_V(8); PG8_WAIT_L(0); PG8_BAR; XMMA0(0, 0); XMMA1(0, 1); PG8_BAR; PG8_SCHED;
            XLDA(1, 1); PG8_STAGE(PG8_SB(1, 0), b3, voffB); PG8_STAGE(PG8_SB(1, 1), b3 + hstep, voffB); PG8_STAGE_A(PG8_SA(1, 0), a3, 0, nx);
            PG8_WAIT_V(8); PG8_WAIT_L(0); PG8_BAR; XMMA0(1, 0); XMMA1(1, 1); PG8_BAR; PG8_SCHED;
        }
        if constexpr (FP8) asm volatile("s_nop 15\n\ts_nop 15" ::: "memory");
        if constexpr (ALIGN_EPI) { if (wr == 0) PG8_BAR; }
        if constexpr (Epi::HAS_PRE) E(acc, cur, wr, wc, fr, fq, lds + PRE_EPI + (ui & 1) * 2048); else E(acc, cur, wr, wc, fr, fq);
        if (!has_next) break;
#pragma unroll
        for (int a = 0; a < 2; ++a)
#pragma unroll
            for (int b = 0; b < 2; ++b)
#pragma unroll
                for (int m = 0; m < 4; ++m)
#pragma unroll
                    for (int n = 0; n < 2; ++n) acc[a][b][m][n] = (f32x4){0.f, 0.f, 0.f, 0.f};
        cur = nxt; cA = nA; cB = nB; ++ui;
#pragma unroll
        for (int _h = 0; _h < 2; ++_h)
#pragma unroll
            for (int _i = 0; _i < 2; ++_i) vAc[_h][_i] = vAn[_h][_i];
        if constexpr (ALIGN_EPI) { if (wr == 1) PG8_BAR; }
    }
    PG8_WAIT_V(0);
    if constexpr (!ALIGN_EPI) { if (wr == 0) PG8_BAR; }
    PG8_BAR;
#undef PG8_SA
#undef PG8_SB
#undef PG8_STAGE
#undef PG8_STAGEA
#undef PG8_STAGE_A
#undef PG8_ROWS
#undef PG8_LDA
#undef PG8_LD8
#undef PG8_LDA8
#undef PG8_LDB8
#undef PG8_MMA8
#undef XLDA
#undef XLDB0
#undef XLDB1
#undef XMMA0
#undef XMMA1
#undef PG8_LDB
#undef PG8_MMA
#undef PG8_WAIT_V
#undef PG8_WAIT_L
#undef PG8_BAR
#undef PG8_SCHED
}
}

constexpr int DM = 1024, SEQ = 16384, NB = 2, T = NB * SEQ, CTX = 256, NCTX = NB * CTX, NKEY = SEQ + CTX;
constexpr int NE = 32, TOPK = 4, CAP = 32768;
constexpr float ALPHA = 1.4142135623730951f, LN_EPS = 1e-5f;
constexpr float QSCALE = 0.125f * 1.4426950408889634f;
constexpr float LAM_INIT0 = 0.2f;
constexpr int NWAVES = 8, NTHR = 512;

constexpr size_t MiB = 1u << 20;
constexpr size_t WS_CTL = 0, CTL_ZERO_BYTES = 1 * MiB;
constexpr size_t WS_MODP = 1 * MiB;
constexpr size_t WS_MOD = 3 * MiB;
constexpr size_t WS_TAB = 4 * MiB;
constexpr size_t WS_WEVIN = 6 * MiB, WS_WEVOUT = 11 * MiB, WS_WODIN = 13 * MiB, WS_WODOUT = 16 * MiB;
constexpr size_t WS_LIST = 18 * MiB, WS_GATES = 22 * MiB;
constexpr size_t WS_WGU = 32 * MiB;
constexpr size_t WS_WD = 288 * MiB;
constexpr size_t WS_U = 416 * MiB;
constexpr size_t WS_Q = 482 * MiB, WS_K = 514 * MiB, WS_V = 547 * MiB, WS_AB = 580 * MiB;
constexpr size_t WS_O0 = 612 * MiB;
constexpr size_t WS_MIX = 676 * MiB, WS_Y = 740 * MiB, WS_H1 = 804 * MiB, WS_U2 = 932 * MiB;
constexpr size_t WS_ACT = 996 * MiB;
constexpr size_t WS_YB = 1268 * MiB;
constexpr size_t WS_H2 = 1524 * MiB;
constexpr size_t WS_ZODD = 1652 * MiB;
constexpr size_t WS_WT = 1748 * MiB;
constexpr size_t WS_END = 1812 * MiB;
constexpr size_t TB_COS = 0, TB_SIN = 20480, TB_CS = 40960  , TB_AF = 106496  , TB_A3 = 237568  , TB_TW = 303104  , TB_WS = 434176  , TB_END = 565248;
constexpr int CW_ERR = 0, CW_BAR = 4096, CW_CNT = 16384;
#define XB_TMO      128
#define XB_XCNT(j)  (256  + 64 * (j))
#define XB_XSUB(j)  (1280 + 64 * (j))
#define XB_XGEN(j)  (2304 + 64 * (j))
#define XB_TOP      3328
#define XB_TOPGEN   3392
#define XCD_BAR_WORDS 3456
#define XB_SPIN_CAP (1u << 18)
constexpr int LDS_BYTES = 160 * 1024, MISC_OFF = LDS_BYTES - 256, META_OFF = 131072;

__device__ __forceinline__ unsigned xb_ld(unsigned* p)              { return __hip_atomic_load(p, __ATOMIC_RELAXED, __HIP_MEMORY_SCOPE_AGENT); }
__device__ __forceinline__ unsigned xb_add(unsigned* p, unsigned v) { return __hip_atomic_fetch_add(p, v, __ATOMIC_RELAXED, __HIP_MEMORY_SCOPE_AGENT); }
__device__ __forceinline__ unsigned xb_xcc_id() { return (unsigned)__builtin_amdgcn_s_getreg((3 << 11) | 20) & 0xFu; }
#define XB_SPIN(cond, bar) do { unsigned _sp = 0; while (cond) { __builtin_amdgcn_s_sleep(1); \
    if ((++_sp & 255u) == 0u) { if (xb_ld(&(bar)[XB_TMO])) break; if (_sp > XB_SPIN_CAP) { atomicAdd(&(bar)[XB_TMO], 1u); break; } } } } while (0)
struct XcdBarrier { unsigned* bar; unsigned x; volatile LAS unsigned* st; };
__device__ __forceinline__ XcdBarrier xcd_barrier_post(unsigned* bar, volatile LAS unsigned* st) {
    XcdBarrier b; b.bar = bar; b.x = xb_xcc_id(); b.st = st;
    if (threadIdx.x == 0) (void)xb_add(&bar[XB_XCNT(b.x)], 1u);
    return b;
}
__device__ __forceinline__ void xcd_barrier_complete(unsigned* bar, unsigned x, unsigned& nloc, unsigned& nx) {
    const unsigned G = gridDim.x * gridDim.y * gridDim.z;
    unsigned sum, cnt, mine, sp = 0u;
    for (;;) {
        sum = 0u; cnt = 0u; mine = 0u;
#pragma unroll
        for (unsigned j = 0; j < 16; ++j) { const unsigned c = xb_ld(&bar[XB_XCNT(j)]); sum += c; cnt += (c > 0u) ? 1u : 0u; mine = (j == x) ? c : mine; }
        if (sum == G) break;
        __builtin_amdgcn_s_sleep(1);
        if ((++sp & 255u) == 0u) { if (xb_ld(&bar[XB_TMO])) break; if (sp > XB_SPIN_CAP) { atomicAdd(&bar[XB_TMO], 1u); break; } }
    }
    nloc = mine > 0u ? mine : 1u; nx = cnt > 0u ? cnt : 1u;
}
__device__ __forceinline__ void xcd_barrier(const XcdBarrier& b) {
    asm volatile("s_waitcnt vmcnt(0)" ::: "memory");
    __syncthreads();
    if (threadIdx.x == 0) {
        unsigned* bar = b.bar;
        __builtin_amdgcn_s_waitcnt(0);
        unsigned nloc = b.st[0], nx = b.st[1];
        if (nloc == 0u) { xcd_barrier_complete(bar, b.x, nloc, nx); b.st[0] = nloc; b.st[1] = nx; }
        const unsigned old = xb_add(&bar[XB_XSUB(b.x)], 1u);
        const unsigned gen = old / nloc;
        if (old + 1u == (gen + 1u) * nloc) {
            __builtin_amdgcn_fence(__ATOMIC_RELEASE, "agent");
            asm volatile("s_waitcnt vmcnt(0)" ::: "memory");
            const unsigned og = xb_add(&bar[XB_TOP], 1u);
            const unsigned tg = og / nx;
            if (og + 1u == (tg + 1u) * nx) xb_add(&bar[XB_TOPGEN], 1u);
            else XB_SPIN(xb_ld(&bar[XB_TOPGEN]) == tg, bar);
            __builtin_amdgcn_fence(__ATOMIC_ACQUIRE, "agent");
            xb_add(&bar[XB_XGEN(b.x)], 1u);
            asm volatile("s_waitcnt vmcnt(0)" ::: "memory");
        } else {
            XB_SPIN(xb_ld(&bar[XB_XGEN(b.x)]) == gen, bar);
            __builtin_amdgcn_fence(__ATOMIC_ACQUIRE, "agent");
            asm volatile("s_waitcnt vmcnt(0)" ::: "memory");
        }
    }
    __syncthreads();
}

__device__ __forceinline__ float bf2f(unsigned short b) { return __uint_as_float(((unsigned)b) << 16); }
__device__ __forceinline__ unsigned f2bf(float f) { unsigned u = __float_as_uint(f); return (u + 0x7fffu + ((u >> 16) & 1u)) >> 16; }
__device__ __forceinline__ unsigned pk2(float lo, float hi) { return f2bf(lo) | (f2bf(hi) << 16); }
__device__ __forceinline__ unsigned pk4_fp8(float a, float b, float c, float d) { unsigned w = (unsigned)__builtin_amdgcn_cvt_pk_fp8_f32(a, b, 0, false); return (unsigned)__builtin_amdgcn_cvt_pk_fp8_f32(c, d, (int)w, true); }
constexpr float WGU_SCALE = 32.0f, WD_SCALE = 64.0f;
template <int CTRL> __device__ __forceinline__ float dpp_f(float v) { return __builtin_bit_cast(float, __builtin_amdgcn_update_dpp(0, __builtin_bit_cast(int, v), CTRL, 0xf, 0xf, true)); }
__device__ __forceinline__ float wave_sum(float v) {
    v += dpp_f<0xB1>(v); v += dpp_f<0x4E>(v); v += dpp_f<0x141>(v); v += dpp_f<0x140>(v);
    { const auto r = __builtin_amdgcn_permlane16_swap(__float_as_uint(v), __float_as_uint(v), false, false); v = __uint_as_float(r[0]) + __uint_as_float(r[1]); }
    { const auto r = __builtin_amdgcn_permlane32_swap(__float_as_uint(v), __float_as_uint(v), false, false); v = __uint_as_float(r[0]) + __uint_as_float(r[1]); }
    return v;
}
__device__ __forceinline__ float wave_max(float v) {
    v = fmaxf(v, dpp_f<0xB1>(v)); v = fmaxf(v, dpp_f<0x4E>(v)); v = fmaxf(v, dpp_f<0x141>(v)); v = fmaxf(v, dpp_f<0x140>(v));
    { const auto r = __builtin_amdgcn_permlane16_swap(__float_as_uint(v), __float_as_uint(v), false, false); v = fmaxf(__uint_as_float(r[0]), __uint_as_float(r[1])); }
    { const auto r = __builtin_amdgcn_permlane32_swap(__float_as_uint(v), __float_as_uint(v), false, false); v = fmaxf(__uint_as_float(r[0]), __uint_as_float(r[1])); }
    return v;
}
__device__ __forceinline__ int crow(int r, int hi) { return (r & 3) + 8 * (r >> 2) + 4 * hi; }
__device__ __forceinline__ float silu_f(float x) { return x / (1.0f + __expf(-x)); }
__device__ __forceinline__ float sigmoid_f(float x) { return 1.0f / (1.0f + __expf(-x)); }
__device__ __forceinline__ int v_st(int k, int c) { const int kk = (k & ~0xC) | ((k & 4) << 1) | ((k & 8) >> 1); return ((kk >> 3) * 4 + (c >> 5)) * 512 + ((kk & 7) * 32 + (c & 31)) * 2; }
__device__ __forceinline__ int v_rd_base(int lane) { return ((lane & 3) << 3) | (((lane >> 2) & 3) << 6) | (((lane >> 4) & 1) << 5) | (((lane >> 5) & 1) << 8); }
__host__ __device__ constexpr int v_rd_off(int d0, int ks, int half) { return d0 * 512 + ks * 4096 + half * 2048; }
typedef short v4i16_t __attribute__((ext_vector_type(4)));
__device__ __forceinline__ bf16x8 vfrag(LAS unsigned char* tile_rd  , int d0, int ks) {
    const v4i16_t lo = __builtin_amdgcn_ds_read_tr16_b64_v4i16((LAS v4i16_t*)(tile_rd + v_rd_off(d0, ks, 0)));
    const v4i16_t hi = __builtin_amdgcn_ds_read_tr16_b64_v4i16((LAS v4i16_t*)(tile_rd + v_rd_off(d0, ks, 1)));
    return (bf16x8){lo[0], lo[1], lo[2], lo[3], hi[0], hi[1], hi[2], hi[3]};
}

struct Args { const float* in[35]; float* out; unsigned char* ws; int ph_lo, ph_hi; };

struct Frame { LAS unsigned char* lds; int tid, lane, wave, G, bx, kz; };
#define CAS __attribute__((address_space(4)))
__device__ __forceinline__ const float* kin_(int kz, int i) { return *(const float* const CAS*)((const CAS char*)__builtin_amdgcn_kernarg_segment_ptr() + kz + 8 * i); }
#define KIN(F, i) kin_((F).kz, (i))
#define KOUT(F) ((float*)kin_((F).kz, 35))
#define KWS(F) ((unsigned char*)kin_((F).kz, 36))
static_assert(sizeof(Args) == 37 * 8 + 8, "Args layout");

__device__ __forceinline__ void ph0_mod_tables(Frame& F) {
    const float* c = KIN(F, 1); const float* cctx = KIN(F, 3); const float* wmod = KIN(F, 4);
    LAS float* sv = (LAS float*)F.lds;
    for (int vb = F.bx; vb < 256; vb += F.G) {
    const int l = vb >> 7, rem = vb & 127, nch = rem & 7, kch = rem >> 3, k0 = kch * 64;
    if (F.tid < 192) { const int v = F.tid >> 6, k = F.tid & 63; const float x = (v < 2) ? c[v * DM + k0 + k] : cctx[k0 + k]; sv[v * 64 + k] = silu_f(x); }
    __syncthreads();
    if (F.tid < 384) {
        const int col = nch * 768 + F.tid * 2;
        const float* W = wmod + ((size_t)l * DM + k0) * 6144 + col;
        f32x2 a0 = {0.f, 0.f}, a1 = {0.f, 0.f}, a2 = {0.f, 0.f};
#pragma unroll 8
        for (int k = 0; k < 64; ++k) { const f32x2 w = *(const f32x2*)(W + (size_t)k * 6144); a0 += w * sv[k]; a1 += w * sv[64 + k]; a2 += w * sv[128 + k]; }
        float* mp = (float*)(KWS(F) + WS_MODP) + (size_t)kch * 5 * 6144 + col;
        if (l == 0) { *(f32x2*)(mp + 0 * 6144) = a0; *(f32x2*)(mp + 1 * 6144) = a1; *(f32x2*)(mp + 2 * 6144) = a2; }
        else { *(f32x2*)(mp + 3 * 6144) = a0; *(f32x2*)(mp + 4 * 6144) = a1; }
    }
    __syncthreads();
    }
    const int bx = F.bx;
    unsigned char* tb = KWS(F) + WS_TAB;
    const int gid = bx * NTHR + F.tid, NG = F.G * NTHR;
    const float s128 = 0.08838834764831845f;
    for (int i = gid; i < 5120; i += NG) {
        const int pos = i >> 4, f = i & 15; const int p = pos < 256 ? pos : pos - 256;
        const float inv = powf(10000.0f, -((float)f / 16.0f)); const float ang = (float)p * inv;
        ((float*)(tb + TB_COS))[i] = (float)cos((double)ang); ((float*)(tb + TB_SIN))[i] = (float)sin((double)ang);
    }
    for (int i = gid; i < 32768; i += NG) {
        const int j8 = i & 7, ln = (i >> 3) & 63, ks = (i >> 9) & 7, nb = i >> 12;
        const int n = 32 * nb + (ln & 31), cc = 16 * ks + 8 * (ln >> 5) + j8, part = n >> 7, jj = n & 127, m = (jj * cc) & 127;
        const double a = (double)m / 64.0; const float v = (part == 0 ? (float)cospi(a) : -(float)sinpi(a)) * s128;
        ((bf16_t*)(tb + TB_CS))[i] = (bf16_t)f2bf(v);
    }
    for (int i = gid; i < 65536; i += NG) {
        const int j8 = i & 7, ln = (i >> 3) & 63, ks = (i >> 9) & 15, mb = i >> 13;
        const int m = 32 * mb + (ln & 31), k = 16 * ks + 8 * (ln >> 5) + j8, mpart = m >> 7, k1 = m & 127, part = k >> 7, t1 = k & 127, ph = (k1 * t1) & 127;
        const double a = (double)ph / 64.0; const float cs = (float)cospi(a), sn = (float)sinpi(a);
        const float v = (mpart == 0 ? (part == 0 ? cs : sn) : (part == 0 ? -sn : cs)) * s128;
        ((bf16_t*)(tb + TB_AF))[i] = (bf16_t)f2bf(v);
    }
    for (int i = gid; i < 32768; i += NG) {
        const int j8 = i & 7, ln = (i >> 3) & 63, ks = (i >> 9) & 15, mb = i >> 13;
        const int k2 = 32 * mb + (ln & 31), k = 16 * ks + 8 * (ln >> 5) + j8, part = k >> 7, t2 = k & 127, ps = (k2 * t2) & 127;
        const double a = (double)ps / 64.0; const float v = (part == 0 ? (float)cospi(a) : (float)sinpi(a)) * s128;
        ((bf16_t*)(tb + TB_A3))[i] = (bf16_t)f2bf(v);
    }
    for (int i = gid; i < 16384; i += NG) {
        const int t2 = i >> 7, k1 = i & 127; const double a = (double)((k1 * t2) & 16383) / 8192.0;
        ((f32x2*)(tb + TB_TW))[i] = (f32x2){(float)cospi(a), (float)sinpi(a)};
    }
    const float* gws = KIN(F, 25);
    for (int i = gid; i < 65536; i += NG) ((bf16_t*)(tb + TB_WS))[i] = (bf16_t)f2bf(gws[i]);
}

__device__ __forceinline__ void transpose_item(const float* W, int K, int ldw, int k0, int n_src0, bf16_t* WT, int row_dst0, LAS float* scr, int lane) {
#pragma unroll 8
    for (int i = 0; i < 32; ++i) { const int kk = 2 * i + (lane >> 5); scr[kk * 33 + (lane & 31)] = W[(size_t)(k0 + kk) * ldw + n_src0 + (lane & 31)]; }
    asm volatile("s_waitcnt lgkmcnt(0)" ::: "memory");
    const int c = lane & 7;
#pragma unroll
    for (int j = 0; j < 4; ++j) { const int n = (lane >> 3) + 8 * j; const LAS float* s = scr + (8 * c) * 33 + n;
        u32x4 o; o.x = pk2(s[0 * 33], s[1 * 33]); o.y = pk2(s[2 * 33], s[3 * 33]); o.z = pk2(s[4 * 33], s[5 * 33]); o.w = pk2(s[6 * 33], s[7 * 33]);
        *(u32x4*)(WT + (size_t)(row_dst0 + n) * K + k0 + 8 * c) = o; }
    asm volatile("s_waitcnt lgkmcnt(0)" ::: "memory");
}
__device__ __forceinline__ void transpose_item_fp8(const float* W, int K, int ldw, int k0, int n_src0, unsigned char* WT8, int row_dst0, float scale, LAS float* scr, int lane) {
#pragma unroll 8
    for (int i = 0; i < 64; ++i) { const int kk = 2 * i + (lane >> 5); scr[kk * 33 + (lane & 31)] = W[(size_t)(k0 + kk) * ldw + n_src0 + (lane & 31)]; }
    asm volatile("s_waitcnt lgkmcnt(0)" ::: "memory");
    const int q = lane & 3;
#pragma unroll
    for (int j = 0; j < 2; ++j) { const int n = (lane >> 2) + 16 * j; const LAS float* s = scr + (32 * q) * 33 + n; unsigned w[8];
#pragma unroll
        for (int t = 0; t < 8; ++t) w[t] = pk4_fp8(s[(4 * t) * 33] * scale, s[(4 * t + 1) * 33] * scale, s[(4 * t + 2) * 33] * scale, s[(4 * t + 3) * 33] * scale);
        unsigned char* dst = WT8 + (size_t)(row_dst0 + n) * K + k0 + 32 * q;
        *(u32x4*)dst = (u32x4){w[0], w[1], w[2], w[3]}; *(u32x4*)(dst + 16) = (u32x4){w[4], w[5], w[6], w[7]}; }
    asm volatile("s_waitcnt lgkmcnt(0)" ::: "memory");
}
__device__ __forceinline__ void ph1_convert(Frame& F) {
    {
        const int gid = F.bx * NTHR + F.tid;
        if (gid < 5 * 6144) { const int vec = gid / 6144, n = gid % 6144, l = vec < 3 ? 0 : 1; float s = KIN(F, 5)[l * 6144 + n];
            const float* mp = (const float*)(KWS(F) + WS_MODP) + (size_t)vec * 6144 + n;
#pragma unroll
            for (int kc = 0; kc < 16; ++kc) s += mp[(size_t)kc * 5 * 6144];
            ((float*)(KWS(F) + WS_MOD))[gid] = s; }
    }
    LAS float* scr = (LAS float*)(F.lds + F.wave * 16896);
    const int gw = F.bx * NWAVES + F.wave, NGW = F.G * NWAVES;
    constexpr int I_EVIN = 16 * 80, I_EVOUT = 16 * 32, I_ODIN = 16 * 48, I_ODOUT = 16 * 32, I_DENSE = I_EVIN + I_EVOUT + I_ODIN + I_ODOUT;
    constexpr int I_GU = 64 * 512, I_DN = 64 * 256, NITEMS = I_DENSE + I_GU + I_DN;
    for (int it = gw; it < NITEMS; it += NGW) {
        int r = it;
        if (r < I_EVIN) { const int kb = r / 80, nb = r % 80, n0 = 32 * nb; int src = n0;
            if (n0 >= 1536) { const int u = (n0 - 1536) >> 8, w = (n0 - 1536) & 255; src = (w < 128) ? 1536 + 128 * u + w : 2048 + 128 * u + (w - 128); }
            transpose_item(KIN(F, 10), DM, 2560, 64 * kb, src, (bf16_t*)(KWS(F) + WS_WEVIN), n0, scr, F.lane); continue; } r -= I_EVIN;
        if (r < I_EVOUT) { const int kb = r / 32, nb = r % 32; transpose_item(KIN(F, 11), DM, 1024, 64 * kb, 32 * nb, (bf16_t*)(KWS(F) + WS_WEVOUT), 32 * nb, scr, F.lane); continue; } r -= I_EVOUT;
        if (r < I_ODIN) { const int kb = r / 48, nb = r % 48; transpose_item(KIN(F, 21), DM, 1536, 64 * kb, 32 * nb, (bf16_t*)(KWS(F) + WS_WODIN), 32 * nb, scr, F.lane); continue; } r -= I_ODIN;
        if (r < I_ODOUT) { const int kb = r / 32, nb = r % 32; transpose_item(KIN(F, 22), DM, 1024, 64 * kb, 32 * nb, (bf16_t*)(KWS(F) + WS_WODOUT), 32 * nb, scr, F.lane); continue; } r -= I_ODOUT;
        if (r < I_GU) { const int le = r >> 9, q = r & 511, kb = q >> 6, nb = q & 63, n0 = 32 * nb; const int u = n0 >> 8, w = n0 & 255;
            const int src = (w < 128) ? 128 * u + w : 1024 + 128 * u + (w - 128);
            transpose_item_fp8(KIN(F, 31) + (size_t)le * DM * 2048, DM, 2048, 128 * kb, src, (unsigned char*)(KWS(F) + WS_WGU) + (size_t)le * 2048 * DM, n0, WGU_SCALE, scr, F.lane); continue; } r -= I_GU;
        { const int le = r >> 8, q = r & 255, kb = q >> 5, nb = q & 31;
            transpose_item_fp8(KIN(F, 33) + (size_t)le * DM * 1024, DM, 1024, 128 * kb, 32 * nb, (unsigned char*)(KWS(F) + WS_WD) + (size_t)le * 1024 * DM, 32 * nb, WD_SCALE, scr, F.lane); }
    }
}

__device__ __forceinline__ void mod_row(const float* xrow, const float* sh, const float* sc, bf16_t* orow, int lane) {
    f32x4 x[4], a[4], b[4];
#pragma unroll
    for (int j = 0; j < 4; ++j) { const int d = 4 * lane + 256 * j; x[j] = *(const f32x4*)(xrow + d); a[j] = *(const f32x4*)(sc + d); b[j] = *(const f32x4*)(sh + d); }
    asm volatile("" ::: "memory");
#pragma unroll
    for (int j = 0; j < 4; ++j) { const int d = 4 * lane + 256 * j;
        const f32x4 v = x[j] * (a[j] + 1.0f) + b[j]; u32x2 w; w.x = pk2(v[0], v[1]); w.y = pk2(v[2], v[3]); *(u32x2*)(orow + d) = w; }
}
__device__ __forceinline__ void ph2_modulate(Frame& F) {
    const float* mod = (const float*)(KWS(F) + WS_MOD); bf16_t* U = (bf16_t*)(KWS(F) + WS_U);
    const int gw = F.bx * NWAVES + F.wave, NGW = F.G * NWAVES;
    for (int r = gw; r < T + NCTX; r += NGW) {
        if (r < T) { const int b = r >> 14; mod_row(KIN(F, 0) + (size_t)r * DM, mod + b * 6144, mod + b * 6144 + 1024, U + (size_t)r * DM, F.lane); }
        else { mod_row(KIN(F, 2) + (size_t)(r - T) * DM, mod + 2 * 6144, mod + 2 * 6144 + 1024, U + (size_t)r * DM, F.lane); }
    }
}

struct EvInOrder {
    pg8::StaticOrder so;
    __device__ bool next(int i, pg8::Unit& u) const {
        const long L = (long)i * so.G + so.c;
        if (L < so.nwg) return so.map(L, u);
        const int x = (int)(L - so.nwg); if (x >= 8) return false;
        u.pm = 128 + (x >> 2); u.pn = 2 + (x & 3); u.a0 = 0; u.a1 = 0; u.a2 = 256; return true;
    }
    __device__ __forceinline__ unsigned arow(const pg8::Unit&, int) const { return 0u; }
};
__device__ __forceinline__ int vpos64(int k) { return 32 * ((k >> 2) & 1) + 16 * (k >> 5) + ((k & 3) + 4 * ((k & 31) >> 3)); }
struct EpiEvIn {
    static constexpr bool PERM = false, HAS_PRE = false;
    unsigned char *Q8, *K8, *V8T; bf16_t* Ab; const float* cosT; const float* sinT;
    __device__ __forceinline__ void operator()(const f32x4 (&acc)[2][2][4][2], const pg8::Unit& u, int wr, int wc, int fr, int fq) const {
        const int pn = u.pn;
        if (pn < 6) {
            const int kind = pn >> 1, colbase = (pn & 1) * 256 + wc * 32 + 4 * fq;
#pragma unroll
            for (int ai = 0; ai < 2; ++ai)
#pragma unroll
                for (int m = 0; m < 4; ++m) {
                    const int row = u.pm * 256 + ai * 128 + wr * 64 + m * 16 + fr; const bool isctx = row >= T;
                    int t, b, key;
                    if (!isctx) { b = row >> 14; t = row & (SEQ - 1); key = t; } else { const int rc = row - T; t = 0; b = rc >> 8; key = SEQ + (rc & 255); }
                    if (kind == 0 && isctx) continue;
                    if (kind < 2) {
                        f32x4 cs = {1.f, 1.f, 1.f, 1.f}, sn = {0.f, 0.f, 0.f, 0.f};
                        if (!isctx) { const int pos = (wc & 1) ? 256 + (t & 63) : (t >> 6); cs = *(const f32x4*)(cosT + pos * 16 + 4 * fq); sn = *(const f32x4*)(sinT + pos * 16 + 4 * fq); }
                        unsigned char* dst = (kind == 0) ? Q8 + (size_t)row * 512 : K8 + (size_t)(b * NKEY + key) * 512;
                        const float sc = (kind == 0) ? QSCALE : 1.0f;
#pragma unroll
                        for (int bj = 0; bj < 2; ++bj) {
                            const f32x4 x1 = acc[ai][bj][m][0], x2 = acc[ai][bj][m][1];
                            const f32x4 o1 = (x1 * cs - x2 * sn) * sc, o2 = (x1 * sn + x2 * cs) * sc;
                            *(unsigned*)(dst + colbase + bj * 128) = pk4_fp8(o1[0], o1[1], o1[2], o1[3]); *(unsigned*)(dst + colbase + bj * 128 + 16) = pk4_fp8(o2[0], o2[1], o2[2], o2[3]);
                        }
                    } else {
                        const size_t kofs = (size_t)(key & ~63) + vpos64(key & 63);
#pragma unroll
                        for (int bj = 0; bj < 2; ++bj)
#pragma unroll
                            for (int n = 0; n < 2; ++n) { const f32x4 x = acc[ai][bj][m][n]; const unsigned w = pk4_fp8(x[0], x[1], x[2], x[3]); const int vcol = colbase + bj * 128 + n * 16;
                                unsigned char* dst = V8T + ((size_t)(b * 4 + (vcol >> 7)) * 128 + (vcol & 127)) * NKEY + kofs;
                                dst[0] = (unsigned char)(w & 0xff); dst[NKEY] = (unsigned char)((w >> 8) & 0xff); dst[2 * NKEY] = (unsigned char)((w >> 16) & 0xff); dst[3 * NKEY] = (unsigned char)(w >> 24); }
                    }
                }
        } else {
            const int colbase = (pn - 6) * 128 + wc * 32 + 4 * fq;
#pragma unroll
            for (int ai = 0; ai < 2; ++ai)
#pragma unroll
                for (int m = 0; m < 4; ++m) {
                    const int row = u.pm * 256 + ai * 128 + wr * 64 + m * 16 + fr; if (row >= T) continue;
                    bf16_t* dst = Ab + (size_t)row * 512 + colbase;
#pragma unroll
                    for (int n = 0; n < 2; ++n) { const f32x4 v = acc[ai][0][m][n], g = acc[ai][1][m][n]; f32x4 o;
#pragma unroll
                        for (int j = 0; j < 4; ++j) o[j] = v[j] * sigmoid_f(g[j]);
                        u32x2 w; w.x = pk2(o[0], o[1]); w.y = pk2(o[2], o[3]); *(u32x2*)(dst + n * 16) = w; }
                }
        }
    }
};

__device__ __forceinline__ void ph4_conv(Frame& F) {
    const bf16_t* Ab = (const bf16_t*)(KWS(F) + WS_AB); bf16_t* MIX = (bf16_t*)(KWS(F) + WS_MIX);
    const float* cw = KIN(F, 12); const float* cb = KIN(F, 13); const float* lg = KIN(F, 14); const float* lb = KIN(F, 15);
    LAS bf16_t* At = (LAS bf16_t*)F.lds;
    LAS float* Yt = (LAS float*)(F.lds + 65536);
    const int ch = F.tid;
    float w[31];
#pragma unroll
    for (int j = 0; j < 31; ++j) w[j] = cw[j * 512 + ch];
    const float bias = cb[ch];
#define CONV_STAGE(tile_) do { const int b_ = (tile_) >> 9, t0_ = ((tile_) & 511) * 32; \
        _Pragma("unroll") for (int k_ = 0; k_ < 8; ++k_) { const int row_ = F.wave + 8 * k_; if (row_ < 62) { const int t_ = t0_ - 15 + row_; \
            if (t_ >= 0 && t_ < SEQ) __builtin_amdgcn_global_load_lds((const unsigned*)(Ab + ((size_t)(b_ * SEQ + t_)) * 512 + F.lane * 8), (LAS unsigned*)(At + row_ * 512), 16, 0, 0); \
            else { const unsigned z_ = (unsigned)F.kz; const u32x4 zv_ = {z_, z_, z_, z_}; *(LAS u32x4*)(At + row_ * 512 + F.lane * 8) = zv_; } } } } while (0)
    const f32x4 g0 = *(const f32x4*)(lg + 8 * F.lane), g1 = *(const f32x4*)(lg + 8 * F.lane + 4), b0 = *(const f32x4*)(lb + 8 * F.lane), b1 = *(const f32x4*)(lb + 8 * F.lane + 4);
    if (F.bx < T / 32) CONV_STAGE(F.bx);
    for (int tile = F.bx; tile < T / 32; tile += F.G) {
        const int b = tile >> 9, t0 = (tile & 511) * 32;
        asm volatile("s_waitcnt vmcnt(0)" ::: "memory");
        __syncthreads();
        float a[62];
#pragma unroll
        for (int r = 0; r < 62; ++r) a[r] = bf2f(At[r * 512 + ch]);
#pragma unroll
        for (int t = 0; t < 32; ++t) { float y = bias;
#pragma unroll
            for (int j = 0; j < 31; ++j) y = fmaf(a[t + j], w[j], y);
            Yt[t * 512 + ch] = y; }
        __syncthreads();
        if (tile + F.G < T / 32) CONV_STAGE(tile + F.G);
#pragma unroll
        for (int q = 0; q < 4; ++q) { const int t = F.wave * 4 + q; const LAS float* yr = Yt + t * 512 + 8 * F.lane;
            const f32x4 y0 = *(const LAS f32x4*)yr, y1 = *(const LAS f32x4*)(yr + 4);
            float s = (y0[0] + y0[1]) + (y0[2] + y0[3]) + (y1[0] + y1[1]) + (y1[2] + y1[3]);
            const float mean = wave_sum(s) * (1.0f / 512.0f);
            const f32x4 d0 = y0 - mean, d1 = y1 - mean;
            float q2 = (d0[0] * d0[0] + d0[1] * d0[1]) + (d0[2] * d0[2] + d0[3] * d0[3]) + (d1[0] * d1[0] + d1[1] * d1[1]) + (d1[2] * d1[2] + d1[3] * d1[3]);
            const float rstd = 1.0f / sqrtf(wave_sum(q2) * (1.0f / 512.0f) + LN_EPS);
            f32x4 o0 = d0 * rstd * g0 + b0, o1 = d1 * rstd * g1 + b1;
#pragma unroll
            for (int j = 0; j < 4; ++j) { o0[j] = silu_f(o0[j]); o1[j] = silu_f(o1[j]); }
            u32x4 wv; wv.x = pk2(o0[0], o0[1]); wv.y = pk2(o0[2], o0[3]); wv.z = pk2(o1[0], o1[1]); wv.w = pk2(o1[2], o1[3]);
            *(u32x4*)(MIX + (size_t)(b * SEQ + t0 + t) * 1024 + 8 * F.lane) = wv; }
        __syncthreads();
    }
#undef CONV_STAGE
}

namespace att {
constexpr int KVBLK = 64;
constexpr int SHM_V = 128 * 64, SHM_K = 64 * 64;
constexpr int SHM_1 = 32 * 64;
constexpr int NBUF = 5, DIST = 3, TILEB = SHM_V + SHM_1 + SHM_K;
constexpr int OFF_T = 0, OFF_WS = NBUF * TILEB;
constexpr int OFF_NEG = OFF_WS + 2048;
constexpr float PREF = 6.0f, PMAXLOG = 8.0f;
#define SBAR() __builtin_amdgcn_sched_barrier(0)
#define MX3(a, b, c) __builtin_fmaxf(__builtin_fmaxf((a), (b)), (c))
typedef int v8i32a __attribute__((ext_vector_type(8)));
__device__ __forceinline__ f32x16 mfma8(v8i32a a, v8i32a b, f32x16 c) { return __builtin_amdgcn_mfma_scale_f32_32x32x64_f8f6f4(a, b, c, 0, 0, 0, 0x7F7F7F7F, 0, 0x7F7F7F7F); }
template <bool FIRST> __device__ __forceinline__ void partialSM(f32x16& p0, f32x16& p1, f32x16& negm, float& alpha) {
    float a = MX3(p0[0], p0[1], p1[0]), b = MX3(p0[2], p0[3], p1[1]); a = MX3(a, p1[2], p1[3]);
#pragma unroll
    for (int r = 4; r < 16; r += 4) { a = MX3(a, p0[r], p0[r + 1]); b = MX3(b, p0[r + 2], p0[r + 3]); a = MX3(a, p1[r], p1[r + 1]); b = MX3(b, p1[r + 2], p1[r + 3]); }
    float pmax = fmaxf(a, b);
    { auto rr = __builtin_amdgcn_permlane32_swap(__float_as_uint(pmax), __float_as_uint(pmax), false, false);
      pmax = fmaxf(__uint_as_float(rr[0]), __uint_as_float(rr[1])); }
    alpha = 1.f;
    if (FIRST || __builtin_expect(__any(pmax > PMAXLOG), 0)) {
        const float dl = FIRST ? (pmax - PREF) : fmaxf(pmax - PREF, 0.f); const float nm = negm[0] - dl; alpha = __builtin_amdgcn_exp2f(-dl);
#pragma unroll
        for (int r = 0; r < 16; ++r) { p0[r] -= dl; p1[r] -= dl; negm[r] = nm; }
    }
#pragma unroll
    for (int r = 0; r < 16; ++r) p0[r] = __builtin_amdgcn_exp2f(p0[r]);
}
__device__ __forceinline__ void finishSM(f32x16& p0, f32x16& p1, v8i32a& pf) {
#pragma unroll
    for (int r = 0; r < 16; ++r) p1[r] = __builtin_amdgcn_exp2f(p1[r]);
#pragma unroll
    for (int i = 0; i < 4; ++i) { pf[i] = (int)pk4_fp8(p0[4 * i], p0[4 * i + 1], p0[4 * i + 2], p0[4 * i + 3]); pf[4 + i] = (int)pk4_fp8(p1[4 * i], p1[4 * i + 1], p1[4 * i + 2], p1[4 * i + 3]); }
}
__device__ __forceinline__ v8i32a frag32(const LAS unsigned char* base, int a0, int a1) {
    const bf16x8 lo = *(const LAS bf16x8*)(base + a0), hi = *(const LAS bf16x8*)(base + a1);
    return __builtin_bit_cast(v8i32a, __builtin_shufflevector(lo, hi, 0, 1, 2, 3, 4, 5, 6, 7, 8, 9, 10, 11, 12, 13, 14, 15));
}
__device__ __forceinline__ void attn_pass(const unsigned char* __restrict__ Qw, const unsigned char* __restrict__ Kh, const unsigned char* __restrict__ Vt, LAS unsigned char* lds, f32x16 (&o)[4], f32x16& lacc, const int tid, const int wid) {
    const int lane = tid & 63, r32 = lane & 31, hi = lane >> 5;
    LAS float* al_l = (LAS float*)(lds + OFF_WS) + wid * 64 + 32;
    f32x16 negm = f32x16{}; lacc = f32x16{};
#pragma unroll
    for (int d = 0; d < 4; ++d) o[d] = f32x16{};
    const v8i32a qf = __builtin_bit_cast(v8i32a, __builtin_shufflevector(*(const bf16x8*)Qw, *(const bf16x8*)(Qw + 16), 0, 1, 2, 3, 4, 5, 6, 7, 8, 9, 10, 11, 12, 13, 14, 15));
    const int sw = (r32 >> 2) & 3, a0 = r32 * 64 + (((2 * hi) ^ sw) << 4), a1 = r32 * 64 + (((2 * hi + 1) ^ sw) << 4);
    const int drow = 16 * wid + (lane >> 2), dch = (lane & 3) ^ ((drow >> 2) & 3);
    const unsigned vsrc = (unsigned)(drow * NKEY + dch * 16), ksrc = (unsigned)(drow * 512 + dch * 16); const bool kw = wid < 4;
    LAS unsigned char* T_lds = lds + OFF_T;
#define DMA(t, bi) do { __builtin_amdgcn_global_load_lds((const unsigned*)((const char*)Vt + (size_t)(t) * 64 + vsrc), (LAS unsigned*)(T_lds + (bi) * TILEB + wid * 1024), 16, 0, 0); \
    if (kw) __builtin_amdgcn_global_load_lds((const unsigned*)((const char*)Kh + (size_t)(t) * (64 * 512) + ksrc), (LAS unsigned*)(T_lds + (bi) * TILEB + SHM_V + SHM_1 + wid * 1024), 16, 0, 0); } while (0)
#define WAITBAR(n) do { if (kw) asm volatile("s_waitcnt vmcnt(%0) lgkmcnt(0)" :: "n"(2 * (n)) : "memory"); else asm volatile("s_waitcnt vmcnt(%0) lgkmcnt(0)" :: "n"(n) : "memory"); \
    __builtin_amdgcn_s_barrier(); asm volatile("" ::: "memory"); } while (0)
#define RESC(a) do { if (__any((a) < 1.f)) { if (hi == 0) al_l[r32] = (a); asm volatile("s_waitcnt lgkmcnt(0)" ::: "memory"); \
    _Pragma("unroll") for (int r = 0; r < 16; ++r) { const float f_ = al_l[crow(r, hi)]; o[0][r] *= f_; o[1][r] *= f_; o[2][r] *= f_; o[3][r] *= f_; lacc[r] *= f_; } } } while (0)
#define QKT(P0, P1, bi) do { const LAS unsigned char* kb_ = T_lds + (bi) * TILEB + SHM_V + SHM_1; P0 = mfma8(frag32(kb_, a0, a1), qf, negm); P1 = mfma8(frag32(kb_ + 2048, a0, a1), qf, negm); } while (0)
#ifndef MF8_ACC
#define MF8_ACC "+v"
#endif
#define MF8(acc_, v_) asm volatile("v_mfma_scale_f32_32x32x64_f8f6f4 %0, %1, %2, %0, %3, %3 op_sel_hi:[0,0,0]" : MF8_ACC(acc_) : "v"(pf), "v"(v_), "v"(one_sc))
#define PV(bi) do { const LAS unsigned char* vb_ = T_lds + (bi) * TILEB; { const v8i32a v0_ = frag32(vb_, a0, a1), v1_ = frag32(vb_ + 2048, a0, a1); asm volatile("s_nop 1" ::: ); MF8(o[0], v0_); MF8(o[1], v1_); } \
    { const v8i32a v2_ = frag32(vb_ + 4096, a0, a1), v3_ = frag32(vb_ + 6144, a0, a1); MF8(o[2], v2_); MF8(o[3], v3_); } \
    { const v8i32a v4_ = frag32(vb_ + 8192, a0, a1); MF8(lacc, v4_); } } while (0)
    f32x16 pA0, pA1, pB0, pB1; v8i32a pf; constexpr int NT = NKEY / KVBLK;
    const int one_sc = 0x7F7F7F7F;
#define MFQK(P_, kf_) P_ = mfma8(kf_, qf, negm)
#define EX8(P_, b_) do { _Pragma("unroll") for (int r_ = 0; r_ < 8; ++r_) P_[(b_) + r_] = __builtin_amdgcn_exp2f(P_[(b_) + r_]); } while (0)
#if defined(EXP_EXTRA_MFMA)
#define XMF() do { const v8i32a vn_ = frag32(lds + OFF_NEG, a0, a1); MF8(lacc, vn_); MF8(lacc, v4_); } while (0)
#else
#define XMF() do { } while (0)
#endif
#if defined(EXP_EXTRA_LDS)
#define XTRA(A_, B_) do { _Pragma("unroll") for (int r_ = 0; r_ < 5; ++r_) { const v8i32a t_ = frag32(vb_ + 2048 * r_, a0, a1); asm volatile("" :: "v"(t_)); } } while (0)
#elif defined(EXP_EXTRA_EXP)
#define XTRA(A_, B_) do { _Pragma("unroll") for (int r_ = 0; r_ < 16; ++r_) { float t_; asm volatile("v_exp_f32 %0, %1" : "=v"(t_) : "v"(A_[r_])); asm volatile("v_exp_f32 %0, %1" : "=v"(t_) : "v"(B_[r_])); } } while (0)
#elif defined(EXP_EXTRA_ADD)
#define XTRA(A_, B_) do { _Pragma("unroll") for (int r_ = 0; r_ < 16; ++r_) { float t_; asm volatile("v_add_f32 %0, %1, %1" : "=v"(t_) : "v"(A_[r_])); asm volatile("v_add_f32 %0, %1, %1" : "=v"(t_) : "v"(B_[r_])); } } while (0)
#else
#define XTRA(A_, B_) do { } while (0)
#endif
#define STEP(C0, C1, P0, P1, HAVEPREV, FIRSTT, tnext, dodma) do { \
    if (dodma) DMA(tnext, bd); \
    const LAS unsigned char* kb_ = T_lds + bc * TILEB + SHM_V + SHM_1; const LAS unsigned char* vb_ = T_lds + bp * TILEB; \
    const v8i32a kf0_ = frag32(kb_, a0, a1), kf1_ = frag32(kb_ + 2048, a0, a1); v8i32a v0_, v1_, v2_, v3_, v4_; if (HAVEPREV) { v0_ = frag32(vb_, a0, a1); v1_ = frag32(vb_ + 2048, a0, a1); } \
    SBAR(); MFQK(C0, kf0_); if (HAVEPREV) EX8(P1, 0); SBAR(); \
    MFQK(C1, kf1_); if (HAVEPREV) { EX8(P1, 8); _Pragma("unroll") for (int i_ = 0; i_ < 4; ++i_) { pf[i_] = (int)pk4_fp8(P0[4 * i_], P0[4 * i_ + 1], P0[4 * i_ + 2], P0[4 * i_ + 3]); pf[4 + i_] = (int)pk4_fp8(P1[4 * i_], P1[4 * i_ + 1], P1[4 * i_ + 2], P1[4 * i_ + 3]); } } SBAR(); \
    float al_ = 1.f; \
    if (HAVEPREV) { asm volatile("s_nop 1" ::: ); MF8(o[0], v0_); SBAR(); MF8(o[1], v1_); v2_ = frag32(vb_ + 4096, a0, a1); v3_ = frag32(vb_ + 6144, a0, a1); v4_ = frag32(vb_ + 8192, a0, a1); SBAR(); } \
    else { asm volatile("s_nop 15\n\ts_nop 15\n\ts_nop 15\n\ts_nop 15" ::: "memory"); }     \
    float mxa_ = MX3(C0[0], C0[1], C1[0]), mxb_ = MX3(C0[2], C0[3], C1[1]); mxa_ = MX3(mxa_, C1[2], C1[3]); \
    _Pragma("unroll") for (int r_ = 4; r_ < 16; r_ += 4) { mxa_ = MX3(mxa_, C0[r_], C0[r_ + 1]); mxb_ = MX3(mxb_, C0[r_ + 2], C0[r_ + 3]); mxa_ = MX3(mxa_, C1[r_], C1[r_ + 1]); mxb_ = MX3(mxb_, C1[r_ + 2], C1[r_ + 3]); } \
    float pm_ = fmaxf(mxa_, mxb_); { auto rr_ = __builtin_amdgcn_permlane32_swap(__float_as_uint(pm_), __float_as_uint(pm_), false, false); pm_ = fmaxf(__uint_as_float(rr_[0]), __uint_as_float(rr_[1])); } \
    SBAR(); \
    if (HAVEPREV) { MF8(o[2], v2_); SBAR(); MF8(o[3], v3_); SBAR(); } \
    if (FIRSTT || __builtin_expect(__any(pm_ > PMAXLOG), 0)) { const float dl_ = FIRSTT ? (pm_ - PREF) : fmaxf(pm_ - PREF, 0.f); const float nm_ = negm[0] - dl_; al_ = __builtin_amdgcn_exp2f(-dl_); \
        _Pragma("unroll") for (int r_ = 0; r_ < 16; ++r_) { C0[r_] -= dl_; C1[r_] -= dl_; negm[r_] = nm_; } } \
    SBAR(); \
    if (HAVEPREV) { MF8(lacc, v4_); XMF(); SBAR(); } \
    EX8(C0, 0); EX8(C0, 8); XTRA(C0, C1); SBAR(); \
    if (HAVEPREV) { if (__any(al_ < 1.f)) { asm volatile("s_nop 15\n\ts_nop 15" ::: "memory"); if (hi == 0) al_l[r32] = al_; asm volatile("s_waitcnt lgkmcnt(0)" ::: "memory"); \
        _Pragma("unroll") for (int r_ = 0; r_ < 16; ++r_) { const float f_ = al_l[crow(r_, hi)]; o[0][r_] *= f_; o[1][r_] *= f_; o[2][r_] *= f_; o[3][r_] *= f_; lacc[r_] *= f_; } } } \
    } while (0)
    int bp = 4, bc = 0, bd = 3;
#define ROT() do { bp = bc; bc = (bc == NBUF - 1) ? 0 : bc + 1; bd = (bd == NBUF - 1) ? 0 : bd + 1; } while (0)
#ifdef EXP_EXTRA_BAR
#define XBAR() do { __builtin_amdgcn_s_barrier(); asm volatile("" ::: "memory"); } while (0)
#else
#define XBAR() do { } while (0)
#endif
    DMA(0, 0); DMA(1, 1); DMA(2, 2); WAITBAR(2);
    STEP(pA0, pA1, pB0, pB1, false, true, 3, true); WAITBAR(2); ROT();
#pragma unroll 1
    for (int j = 1; j + 1 < NT; j += 2) {
        const bool more = (j + 4 < NT);
        STEP(pB0, pB1, pA0, pA1, true, false, j + 3, more); if (more) WAITBAR(2); else WAITBAR(0); XBAR(); ROT();
        STEP(pA0, pA1, pB0, pB1, true, false, j + 4, more); if (more) WAITBAR(2); else WAITBAR(0); XBAR(); ROT();
    }
    STEP(pB0, pB1, pA0, pA1, true, false, 0, false); WAITBAR(0); ROT();
    { EX8(pB1, 0); EX8(pB1, 8);
#pragma unroll
      for (int i_ = 0; i_ < 4; ++i_) { pf[i_] = (int)pk4_fp8(pB0[4 * i_], pB0[4 * i_ + 1], pB0[4 * i_ + 2], pB0[4 * i_ + 3]); pf[4 + i_] = (int)pk4_fp8(pB1[4 * i_], pB1[4 * i_ + 1], pB1[4 * i_ + 2], pB1[4 * i_ + 3]); }
      SBAR(); PV(bp); }
#undef STEP
#undef MFQK
#undef EX8
    __syncthreads();
#undef ROT
#undef DMA
#undef WAITBAR
#undef RESC
#undef QKT
#undef PV
#undef MF8
}
}

__device__ __forceinline__ void ph4_attention(Frame& F) {
    const unsigned char* Q8 = (const unsigned char*)(KWS(F) + WS_Q); const unsigned char* K8 = (const unsigned char*)(KWS(F) + WS_K); const unsigned char* V8T = (const unsigned char*)(KWS(F) + WS_V);
    float* O0 = (float*)(KWS(F) + WS_O0); bf16_t* MIX = (bf16_t*)(KWS(F) + WS_MIX); const float* gn = KIN(F, 20);
    const int lane = F.lane, wid = F.wave;
    float lam;
    { const float a = wave_sum(KIN(F, 16)[lane] * KIN(F, 17)[lane]), b = wave_sum(KIN(F, 18)[lane] * KIN(F, 19)[lane]); lam = __builtin_bit_cast(float, __builtin_amdgcn_readfirstlane(__builtin_bit_cast(int, __expf(a) - __expf(b) + LAM_INIT0))); }
    __syncthreads();
    const unsigned kz_ = (unsigned)F.kz;
    for (int i = F.tid; i < att::NBUF * (att::SHM_1 / 16); i += NTHR) { const int bi = i / (att::SHM_1 / 16), q = i % (att::SHM_1 / 16);
        *(LAS u32x4*)(F.lds + att::OFF_T + bi * att::TILEB + att::SHM_V + q * 16) = (u32x4){0x38383838u + kz_, 0x38383838u + kz_, 0x38383838u + kz_, 0x38383838u + kz_}; }
#if defined(EXP_EXTRA_MFMA)
    for (int i = F.tid; i < 128; i += NTHR) *(LAS u32x4*)(F.lds + att::OFF_NEG + i * 16) = (u32x4){0xB8B8B8B8u + kz_, 0xB8B8B8B8u + kz_, 0xB8B8B8B8u + kz_, 0xB8B8B8B8u + kz_};
#endif
    __syncthreads();
    const int x = F.bx & 7, jb = F.bx >> 3;
    for (int vb = x; vb < 8; vb += 8) { const int b = vb >> 2, h = vb & 3;
    for (int qb = jb; qb < SEQ / 256; qb += (F.G >> 3)) {
        const long rowbase = (long)b * SEQ + qb * 256 + wid * 32;
        f32x16 o[4]; f32x16 lacc;
#pragma unroll 1
        for (int c = 0; c < 2; ++c) {
            const unsigned char* Qw = Q8 + (rowbase + (lane & 31)) * 512 + h * 128 + c * 64 + (lane >> 5) * 32;
            const unsigned char* Kh = K8 + (long)b * NKEY * 512 + h * 128 + c * 64;
            const unsigned char* Vt = V8T + (long)(b * 4 + h) * 128 * NKEY;
            att::attn_pass(Qw, Kh, Vt, F.lds, o, lacc, F.tid, F.wave);
            int lane_e = lane; asm volatile("" : "+v"(lane_e));
            const int r32 = lane_e & 31, hi = lane_e >> 5;
            asm volatile("s_nop 15\n\ts_nop 15" : "+v"(lacc));
            float rli[16];
#pragma unroll
            for (int r = 0; r < 16; ++r) rli[r] = __builtin_amdgcn_rcpf(lacc[r]);
            if (c == 0) {
#pragma unroll
                for (int r = 0; r < 16; ++r) { const long grow = rowbase + crow(r, hi);
#pragma unroll
                    for (int d0 = 0; d0 < 4; ++d0) O0[grow * 512 + h * 128 + d0 * 32 + r32] = o[d0][r] * rli[r]; }
            } else {
                const float g0 = gn[r32], g1 = gn[32 + r32], g2 = gn[64 + r32], g3 = gn[96 + r32];
#pragma unroll
                for (int r = 0; r < 16; ++r) { const long grow = rowbase + crow(r, hi); const float* op = O0 + grow * 512 + h * 128 + r32;
                    const float v0 = op[0] - lam * (o[0][r] * rli[r]), v1 = op[32] - lam * (o[1][r] * rli[r]), v2 = op[64] - lam * (o[2][r] * rli[r]), v3 = op[96] - lam * (o[3][r] * rli[r]);
                    float ss = (v0 * v0 + v1 * v1) + (v2 * v2 + v3 * v3);
#pragma unroll
                    for (int off = 1; off < 32; off <<= 1) ss += __shfl_xor(ss, off);
                    const float scl = (1.0f - LAM_INIT0) / sqrtf(ss * (1.0f / 128.0f) + LN_EPS);
                    bf16_t* mp = MIX + grow * 1024 + 512 + h * 128 + r32;
                    mp[0] = (bf16_t)f2bf(v0 * scl * g0); mp[32] = (bf16_t)f2bf(v1 * scl * g1); mp[64] = (bf16_t)f2bf(v2 * scl * g2); mp[96] = (bf16_t)f2bf(v3 * scl * g3);
                    if ((r & 3) == 3) asm volatile("" ::: "memory"); }
            }
        }
    } }
}

__device__ __forceinline__ void ph_router(Frame& F, int layer, const float* hin) {
    const float* mod = (const float*)(KWS(F) + WS_MOD) + (size_t)(layer * 3) * 6144;
    const bf16_t* Y = (const bf16_t*)(KWS(F) + WS_Y); float* H1 = (float*)(KWS(F) + WS_H1); unsigned char* U2 = (unsigned char*)(KWS(F) + WS_U2);
    const float* lng = KIN(F, 6) + layer * DM; const float* lnb = KIN(F, 7) + layer * DM;
    const float* rw = KIN(F, 29) + (size_t)layer * DM * NE; const float* rb = KIN(F, 30) + layer * NE;
    unsigned* gcnt = (unsigned*)(KWS(F) + WS_CTL) + CW_CNT + layer * NE;
    unsigned* list = (unsigned*)(KWS(F) + WS_LIST); float* gates = (float*)(KWS(F) + WS_GATES);
    constexpr int RWS = 1028, RSEL = 131584, RVEC = RSEL + 10240;
    LAS float* rwT = (LAS float*)F.lds;
    LAS int* sel_e = (LAS int*)(F.lds + RSEL);
    LAS float* sel_g = (LAS float*)(F.lds + RSEL + 2048);
    LAS unsigned* lcnt = (LAS unsigned*)(F.lds + RSEL + 4096);
    LAS unsigned* lbase = lcnt + 32;
    LAS unsigned* lpos = lcnt + 64;
    LAS float* vG = (LAS float*)(F.lds + RVEC);
    const int lane = F.lane;
    for (int i = F.tid; i < DM * NE; i += NTHR) { const int d = i >> 5, e = i & 31; rwT[e * RWS + d] = rw[i]; }
    __syncthreads();
    for (int blk = F.bx; blk < T / 128; blk += F.G) {
        const int r0 = blk * 128, b = r0 >> 14;
        const float* g1 = mod + b * 6144 + 2048; const float* sh2 = mod + b * 6144 + 3072; const float* sc2 = mod + b * 6144 + 4096;
        if (F.tid < 32) lcnt[F.tid] = 0u;
        for (int i = F.tid; i < DM; i += NTHR) { vG[i] = g1[i]; vG[DM + i] = lng[i]; vG[2 * DM + i] = lnb[i]; vG[3 * DM + i] = sc2[i] + 1.0f; vG[4 * DM + i] = sh2[i]; }
        __syncthreads();
        f32x4 nx[2][4]; u32x2 ny[2][4];
#pragma unroll
        for (int t = 0; t < 2; ++t)
#pragma unroll
            for (int j = 0; j < 4; ++j) { const int d = 4 * lane + 256 * j; const size_t rr = (size_t)(r0 + F.wave * 16 + t); nx[t][j] = *(const f32x4*)(hin + rr * DM + d); ny[t][j] = *(const u32x2*)(Y + rr * DM + d); }
        for (int qq = 0; qq < 8; ++qq) {
            int lane4 = 4 * lane; asm volatile("" : "+v"(lane4));
            const int tl0 = F.wave * 16 + 2 * qq;
            f32x4 pre[2][4]; float s1[2] = {0.f, 0.f}, s2[2] = {0.f, 0.f};
#pragma unroll
            for (int t = 0; t < 2; ++t)
#pragma unroll
                for (int j = 0; j < 4; ++j) { const int d = lane4 + 256 * j; const f32x4 x = nx[t][j]; const u32x2 yw = ny[t][j]; const f32x4 g = *(const LAS f32x4*)(vG + d);
                    f32x4 y; y[0] = __uint_as_float(yw.x << 16); y[1] = __uint_as_float(yw.x & 0xffff0000u); y[2] = __uint_as_float(yw.y << 16); y[3] = __uint_as_float(yw.y & 0xffff0000u);
                    const f32x4 p_ = x * ALPHA + g * y; pre[t][j] = p_; s1[t] += (p_[0] + p_[1]) + (p_[2] + p_[3]); s2[t] += (p_[0] * p_[0] + p_[1] * p_[1]) + (p_[2] * p_[2] + p_[3] * p_[3]); }
            if (qq + 1 < 8) {
#pragma unroll
                for (int t = 0; t < 2; ++t)
#pragma unroll
                    for (int j = 0; j < 4; ++j) { const int d = lane4 + 256 * j; const size_t rr = (size_t)(r0 + tl0 + 2 + t); nx[t][j] = *(const f32x4*)(hin + rr * DM + d); ny[t][j] = *(const u32x2*)(Y + rr * DM + d); } }
            s1[0] = wave_sum(s1[0]); s1[1] = wave_sum(s1[1]); s2[0] = wave_sum(s2[0]); s2[1] = wave_sum(s2[1]);
            f32x4 u2[2][4];
#pragma unroll
            for (int t = 0; t < 2; ++t) { const float mean = s1[t] * (1.0f / DM); const float var = fmaxf(s2[t] * (1.0f / DM) - mean * mean, 0.f); const float rstd = 1.0f / sqrtf(var + LN_EPS); const size_t row = (size_t)(r0 + tl0 + t);
#pragma unroll
                for (int j = 0; j < 4; ++j) { const int d = lane4 + 256 * j; const f32x4 h = (pre[t][j] - mean) * rstd * *(const LAS f32x4*)(vG + DM + d) + *(const LAS f32x4*)(vG + 2 * DM + d);
                    *(f32x4*)(H1 + row * DM + d) = h;
                    u2[t][j] = h * *(const LAS f32x4*)(vG + 3 * DM + d) + *(const LAS f32x4*)(vG + 4 * DM + d);
                    *(unsigned*)(U2 + row * DM + d) = pk4_fp8(u2[t][j][0], u2[t][j][1], u2[t][j][2], u2[t][j][3]); } }
            f32x2 up[4][4];
#pragma unroll
            for (int j = 0; j < 4; ++j)
#pragma unroll
                for (int i = 0; i < 4; ++i) { up[j][i][0] = u2[0][j][i]; up[j][i][1] = u2[1][j][i]; }
            f32x2 P[32];
            f32x4 wc[4], wn[4];
#pragma unroll
            for (int j = 0; j < 4; ++j) wc[j] = *(const LAS f32x4*)(rwT + 4 * lane + 256 * j);
#pragma unroll
            for (int e = 0; e < 32; ++e) {
                if (e + 1 < 32) {
#pragma unroll
                    for (int j = 0; j < 4; ++j) wn[j] = *(const LAS f32x4*)(rwT + (e + 1) * RWS + 4 * lane + 256 * j); }
                f32x2 a0 = {0.f, 0.f}, a1 = {0.f, 0.f};
#pragma unroll
                for (int j = 0; j < 4; ++j) { f32x2 w0 = {wc[j][0], wc[j][0]}, w1 = {wc[j][1], wc[j][1]}, w2 = {wc[j][2], wc[j][2]}, w3 = {wc[j][3], wc[j][3]};
                    a0 = __builtin_elementwise_fma(up[j][0], w0, a0); a1 = __builtin_elementwise_fma(up[j][1], w1, a1); a0 = __builtin_elementwise_fma(up[j][2], w2, a0); a1 = __builtin_elementwise_fma(up[j][3], w3, a1); }
                P[e] = a0 + a1;
#pragma unroll
                for (int j = 0; j < 4; ++j) wc[j] = wn[j];
                if ((e & 3) == 3) __builtin_amdgcn_sched_barrier(0); }
#define RSTEP(N, MASK) do { _Pragma("unroll") for (int i = 0; i < (N); ++i) { int lm_ = lane & (MASK); asm volatile("" : "+v"(lm_)); const bool up_ = lm_ != 0;     \
                const f32x2 sv = up_ ? P[i] : P[i + (N)], kv = up_ ? P[i + (N)] : P[i]; f32x2 rv; rv[0] = __shfl_xor(sv[0], (MASK)); rv[1] = __shfl_xor(sv[1], (MASK)); P[i] = kv + rv; } } while (0)
#define RSWAP(N, SWAPFN) do { _Pragma("unroll") for (int i = 0; i < (N); ++i) { _Pragma("unroll") for (int c_ = 0; c_ < 2; ++c_) { \
                const auto r_ = SWAPFN(__float_as_uint(P[i][c_]), __float_as_uint(P[i + (N)][c_]), false, false); P[i][c_] = __uint_as_float(r_[0]) + __uint_as_float(r_[1]); } } } while (0)
            RSWAP(16, __builtin_amdgcn_permlane32_swap); RSWAP(8, __builtin_amdgcn_permlane16_swap);
#undef RSWAP
            RSTEP(4, 8); RSTEP(2, 4); RSTEP(1, 2);
#undef RSTEP
            const int me = lane >> 1; const float rbv = rb[me];
            float lgs[2]; lgs[0] = P[0][0] + __shfl_xor(P[0][0], 1) + rbv; lgs[1] = P[0][1] + __shfl_xor(P[0][1], 1) + rbv;
            LAS float* lgbuf = (LAS float*)(F.lds + RSEL + 8192) + F.wave * 64;
            if ((lane & 1) == 0) { lgbuf[me] = lgs[0]; lgbuf[32 + me] = lgs[1]; }
            asm volatile("s_waitcnt lgkmcnt(0)" ::: "memory");
#pragma unroll
            for (int t = 0; t < 2; ++t) { const float mine = lgs[t]; int rank = 0;
#pragma unroll
                for (int e4 = 0; e4 < 8; ++e4) { const f32x4 v = *(const LAS f32x4*)(lgbuf + 32 * t + 4 * e4);
#pragma unroll
                    for (int i = 0; i < 4; ++i) { const int e = 4 * e4 + i; rank += (v[i] > mine || (v[i] == mine && e < me)) ? 1 : 0; } }
                float ls[4]; int es[4];
#pragma unroll
                for (int k = 0; k < 4; ++k) { const unsigned long long bal = __ballot(rank == k); const int first = __ffsll((long long)bal) - 1; es[k] = first >> 1; ls[k] = lgbuf[32 * t + es[k]]; }
                const float e1 = __expf(ls[1] - ls[0]), e2 = __expf(ls[2] - ls[0]), e3 = __expf(ls[3] - ls[0]); const float inv = 1.0f / (1.0f + e1 + e2 + e3);
                const int tl = tl0 + t;
                if (lane == 0) { sel_e[tl * 4 + 0] = es[0]; sel_e[tl * 4 + 1] = es[1]; sel_e[tl * 4 + 2] = es[2]; sel_e[tl * 4 + 3] = es[3];
                    sel_g[tl * 4 + 0] = inv; sel_g[tl * 4 + 1] = e1 * inv; sel_g[tl * 4 + 2] = e2 * inv; sel_g[tl * 4 + 3] = e3 * inv; } }
        }
        __syncthreads();
        const int myE = sel_e[F.tid];
        lpos[F.tid] = __hip_atomic_fetch_add(&lcnt[myE], 1u, __ATOMIC_RELAXED, __HIP_MEMORY_SCOPE_WORKGROUP);
        __syncthreads();
        if (F.tid < 32) lbase[F.tid] = atomicAdd(&gcnt[F.tid], lcnt[F.tid]);
        __syncthreads();
        { const unsigned slot = (unsigned)(r0 * 4 + F.tid); list[(size_t)myE * CAP + lbase[myE] + lpos[F.tid]] = slot; gates[slot] = sel_g[F.tid]; }
        __syncthreads();
    }
}

struct MoeOrder {
    const LAS int* meta;
    const unsigned* list; int c, G, ncol, rpx;
    __device__ bool next(int i, pg8::Unit& u) const {
        const int x = c & 7, j = c >> 3; const int g = (i * 8 + x) * rpx + j / ncol; const int total = meta[32];
        if (g >= total) return false;
        const int ln_ = (int)__builtin_amdgcn_mbcnt_hi(~0u, __builtin_amdgcn_mbcnt_lo(~0u, 0u)) & 31;
        const int e = __popc((unsigned)__ballot(meta[ln_ + 1] <= g));
        const int rt = g - meta[e], cnt = meta[64 + e];
        u.pm = g; u.pn = e * ncol + (j % ncol); u.a0 = e; u.a1 = rt; u.a2 = min(256, cnt - rt * 256); return true;
    }
    __device__ __forceinline__ unsigned arow(const pg8::Unit& u, int R) const { return (R < u.a2) ? (list[(size_t)u.a0 * CAP + u.a1 * 256 + R] >> 2) : 0u; }
    __device__ __forceinline__ unsigned rowval(const pg8::Unit& u, int R, unsigned v) const { return (R < u.a2) ? (v >> 2) : 0u; }
    __device__ __forceinline__ const unsigned* rows_ptr(const pg8::Unit& u) const { return list + (size_t)u.a0 * CAP + u.a1 * 256; }
};
__device__ __forceinline__ void moe_meta(Frame& F, int layer) {
    LAS int* meta = (LAS int*)(F.lds + META_OFF);
    const unsigned* gcnt = (const unsigned*)(KWS(F) + WS_CTL) + CW_CNT + layer * NE;
    if (F.tid < NE) { const int c = (int)__hip_atomic_load(&gcnt[F.tid], __ATOMIC_RELAXED, __HIP_MEMORY_SCOPE_AGENT); meta[64 + F.tid] = c; meta[96 + F.tid] = (c + 255) >> 8; }
    __syncthreads();
    if (F.tid <= NE) { int acc = 0;
#pragma unroll
        for (int e = 0; e < NE; ++e) { const int t = meta[96 + e]; acc += (e < F.tid) ? t : 0; }
        meta[F.tid] = acc; }
    __syncthreads();
}
struct EpiGU {
    static constexpr bool PERM = true, HAS_PRE = true;
    unsigned char* ACT; const float* bgu;
    __device__ __forceinline__ void pre(LAS unsigned char* dst, const pg8::Unit& u, int wid, int lane) const {
        if (wid == 1) { const int e = u.a0, pnl = u.pn - e * 8; const float* src = bgu + e * 2048 + (lane >> 5) * 1024 + pnl * 128 + (lane & 31) * 4;
            __builtin_amdgcn_global_load_lds((const unsigned*)src, (LAS unsigned*)dst, 16, 0, 0); } }
    __device__ __forceinline__ void operator()(const f32x4 (&acc)[2][2][4][2], const pg8::Unit& u, int wr, int wc, int fr, int fq, const LAS unsigned char* pre_) const {
        const int e = u.a0, pnl = u.pn - e * 8; const int lcol = wc * 32 + 8 * fq, ccol = pnl * 128 + lcol; const int row0 = u.pm * 256 + wr * 64 + fr;
        f32x2 bg[2][2], bl[2][2];
#pragma unroll
        for (int n = 0; n < 2; ++n) { const f32x4 g4 = *(const LAS f32x4*)(pre_ + (lcol + 4 * n) * 4), l4 = *(const LAS f32x4*)(pre_ + 512 + (lcol + 4 * n) * 4);
            bg[n][0] = (f32x2){g4[0], g4[1]}; bg[n][1] = (f32x2){g4[2], g4[3]}; bl[n][0] = (f32x2){l4[0] + 1.0f, l4[1] + 1.0f}; bl[n][1] = (f32x2){l4[2] + 1.0f, l4[3] + 1.0f}; }
        const f32x2 s2 = {1.0f / WGU_SCALE, 1.0f / WGU_SCALE}, c2 = {-1.702f * 1.4426950408889634f, -1.702f * 1.4426950408889634f}, one2 = {1.0f, 1.0f};
#pragma unroll
        for (int ai = 0; ai < 2; ++ai)
#pragma unroll
            for (int m = 0; m < 4; ++m) { unsigned char* rowp = ACT + (size_t)(row0 + ai * 128 + m * 16) * 1024 + ccol; f32x2 o[2][2];
#pragma unroll
                for (int n = 0; n < 2; ++n)
#pragma unroll
                    for (int h = 0; h < 2; ++h) { const f32x4 A4 = acc[ai][0][m][n], L4 = acc[ai][1][m][n];
                        f32x2 gv = __builtin_elementwise_fma((f32x2){A4[2 * h], A4[2 * h + 1]}, s2, bg[n][h]), lv = __builtin_elementwise_fma((f32x2){L4[2 * h], L4[2 * h + 1]}, s2, bl[n][h]);
                        gv[0] = fminf(gv[0], 7.0f); gv[1] = fminf(gv[1], 7.0f);
                        lv[0] = __builtin_amdgcn_fmed3f(lv[0], -6.0f, 8.0f); lv[1] = __builtin_amdgcn_fmed3f(lv[1], -6.0f, 8.0f);
                        const f32x2 t = gv * c2; f32x2 d = {__builtin_amdgcn_exp2f(t[0]), __builtin_amdgcn_exp2f(t[1])}; d = d + one2;
                        const f32x2 r = {__builtin_amdgcn_rcpf(d[0]), __builtin_amdgcn_rcpf(d[1])};
                        o[n][h] = gv * r * lv; }
                u32x2 w; w.x = pk4_fp8(o[0][0][0], o[0][0][1], o[0][1][0], o[0][1][1]); w.y = pk4_fp8(o[1][0][0], o[1][0][1], o[1][1][0], o[1][1][1]);
                *(u32x2*)rowp = w; }
    }
};
struct EpiDown {
    static constexpr bool PERM = true, HAS_PRE = true;
    unsigned char* YB; const float* bd; const unsigned* list;
    __device__ __forceinline__ void pre(LAS unsigned char* dst, const pg8::Unit& u, int wid, int lane) const {
        const int e = u.a0, rt = u.a1, pnl = u.pn - e * 4;
        if (wid == 1) __builtin_amdgcn_global_load_lds((const unsigned*)(bd + e * 1024 + pnl * 256 + lane * 4), (LAS unsigned*)dst, 16, 0, 0);
        if (wid == 2) __builtin_amdgcn_global_load_lds((const unsigned*)(list + (size_t)e * CAP + rt * 256 + lane * 4), (LAS unsigned*)(dst + 1024), 16, 0, 0); }
    __device__ __forceinline__ void operator()(const f32x4 (&acc)[2][2][4][2], const pg8::Unit& u, int wr, int wc, int fr, int fq, const LAS unsigned char* pre_) const {
        const int e = u.a0, pnl = u.pn - e * 4; const int lcol = wc * 32 + 8 * fq, col = pnl * 256 + lcol;
        f32x4 bv[2][2];
#pragma unroll
        for (int bj = 0; bj < 2; ++bj)
#pragma unroll
            for (int n = 0; n < 2; ++n) bv[bj][n] = *(const LAS f32x4*)(pre_ + (lcol + bj * 128 + 4 * n) * 4);
#pragma unroll
        for (int ai = 0; ai < 2; ++ai)
#pragma unroll
            for (int m = 0; m < 4; ++m) { const int R = ai * 128 + wr * 64 + m * 16 + fr; if (R >= u.a2) continue;
                const unsigned slot = *(const LAS unsigned*)(pre_ + 1024 + R * 4); unsigned char* rowp = YB + (size_t)slot * 1024 + col;
#pragma unroll
                for (int bj = 0; bj < 2; ++bj) { const f32x4 v0 = acc[ai][bj][m][0] * (1.0f / WD_SCALE) + bv[bj][0], v1 = acc[ai][bj][m][1] * (1.0f / WD_SCALE) + bv[bj][1];
                    u32x2 w; w.x = pk4_fp8(v0[0], v0[1], v0[2], v0[3]); w.y = pk4_fp8(v1[0], v1[1], v1[2], v1[3]);
                    *(u32x2*)(rowp + bj * 128) = w; } }
    }
};

__device__ __forceinline__ void ph_combine(Frame& F, int layer, float* hout, bool next_mod) {
    const float* mod = (const float*)(KWS(F) + WS_MOD) + (size_t)(layer * 3) * 6144;
    const float* modn = (const float*)(KWS(F) + WS_MOD) + (size_t)3 * 6144;
    const float* H1 = (const float*)(KWS(F) + WS_H1); const unsigned char* YB = (const unsigned char*)(KWS(F) + WS_YB); const float* gates = (const float*)(KWS(F) + WS_GATES);
    const float* lng = KIN(F, 8) + layer * DM; const float* lnb = KIN(F, 9) + layer * DM; bf16_t* U = (bf16_t*)(KWS(F) + WS_U);
    const int gw = F.bx * NWAVES + F.wave, NGW = F.G * NWAVES, lane = F.lane;
    LAS float* vC = (LAS float*)F.lds;
    for (int i = F.tid; i < 2 * DM; i += NTHR) { const int b = i >> 10, d = i & (DM - 1); LAS float* v = vC + b * 5 * DM + d;
        v[0] = mod[b * 6144 + 5120 + d]; v[DM] = lng[d]; v[2 * DM] = lnb[d]; v[3 * DM] = modn[b * 6144 + 1024 + d] + 1.0f; v[4 * DM] = modn[b * 6144 + d]; }
    __syncthreads();
    f32x4 nh[4]; unsigned nyb[4][4]; f32x4 ngt;
#define CMB_LOAD(r_) do { _Pragma("unroll") for (int j = 0; j < 4; ++j) { const int d = 4 * lane + 256 * j; nh[j] = *(const f32x4*)(H1 + (size_t)(r_) * DM + d); \
        _Pragma("unroll") for (int k = 0; k < 4; ++k) nyb[j][k] = *(const unsigned*)(YB + ((size_t)(r_) * 4 + k) * DM + d); } ngt = *(const f32x4*)(gates + (size_t)(r_) * 4); } while (0)
    if (gw < T) CMB_LOAD(gw);
    for (int row = gw; row < T; row += NGW) {
        int vb = (row >> 14) * 5 * DM + 4 * lane; asm volatile("" : "+v"(vb));
        const LAS float* vr = vC + vb;
        f32x4 ch[4]; unsigned cyb[4][4]; const f32x4 gt = ngt;
#pragma unroll
        for (int j = 0; j < 4; ++j) { ch[j] = nh[j];
#pragma unroll
            for (int k = 0; k < 4; ++k) cyb[j][k] = nyb[j][k]; }
        if (row + NGW < T) CMB_LOAD(row + NGW);
        f32x4 pre[4]; float s = 0.f;
#pragma unroll
        for (int j = 0; j < 4; ++j) { f32x4 y = {0.f, 0.f, 0.f, 0.f};
#pragma unroll
            for (int k = 0; k < 4; ++k) { const unsigned yw = cyb[j][k]; const f32x2 lo = __builtin_amdgcn_cvt_pk_f32_fp8((int)yw, false), hi2 = __builtin_amdgcn_cvt_pk_f32_fp8((int)yw, true);
                const f32x4 v = {lo[0], lo[1], hi2[0], hi2[1]};
                y += v * gt[k]; }
            pre[j] = ch[j] * ALPHA + *(const LAS f32x4*)(vr + 256 * j) * y; s += (pre[j][0] + pre[j][1]) + (pre[j][2] + pre[j][3]); }
        const float mean = wave_sum(s) * (1.0f / DM); float q2 = 0.f;
#pragma unroll
        for (int j = 0; j < 4; ++j) { pre[j] = pre[j] - mean; q2 += (pre[j][0] * pre[j][0] + pre[j][1] * pre[j][1]) + (pre[j][2] * pre[j][2] + pre[j][3] * pre[j][3]); }
        const float rstd = 1.0f / sqrtf(wave_sum(q2) * (1.0f / DM) + LN_EPS);
#pragma unroll
        for (int j = 0; j < 4; ++j) { const int d = 4 * lane + 256 * j; const f32x4 h = pre[j] * rstd * *(const LAS f32x4*)(vr + DM + 256 * j) + *(const LAS f32x4*)(vr + 2 * DM + 256 * j);
            *(f32x4*)(hout + (size_t)row * DM + d) = h;
            if (next_mod) { const f32x4 v = h * *(const LAS f32x4*)(vr + 3 * DM + 256 * j) + *(const LAS f32x4*)(vr + 4 * DM + 256 * j);
                u32x2 w; w.x = pk2(v[0], v[1]); w.y = pk2(v[2], v[3]); *(u32x2*)(U + (size_t)row * DM + d) = w; } }
    }
#undef CMB_LOAD
}

__device__ __forceinline__ void ph_gmlp(Frame& F) {
    const bf16_t* Z = (const bf16_t*)(KWS(F) + WS_ZODD); bf16_t* MIX = (bf16_t*)(KWS(F) + WS_MIX);
    const float* lg = KIN(F, 23); const float* lb = KIN(F, 24); const float* bs = KIN(F, 26); const bf16_t* wsb = (const bf16_t*)(KWS(F) + WS_TAB + TB_WS);
    const int lane = F.lane, r32 = lane & 31, hi = lane >> 5, wid = F.wave;
    for (int chunk = F.bx; chunk < T / 128; chunk += F.G) {
        const int r0 = chunk * 128;
        for (int qq = 0; qq < 16; ++qq) { const int q = wid * 16 + qq; const bf16x8 raw = *(const bf16x8*)(Z + (size_t)(r0 + q) * 1536 + 512 + 8 * lane);
            float v[8]; float s = 0.f;
#pragma unroll
            for (int j = 0; j < 8; ++j) { v[j] = bf2f((unsigned short)raw[j]); s += v[j]; }
            const float mean = wave_sum(s) * (1.0f / 512.0f); float q2 = 0.f;
#pragma unroll
            for (int j = 0; j < 8; ++j) { v[j] -= mean; q2 += v[j] * v[j]; }
            const float rstd = 1.0f / sqrtf(wave_sum(q2) * (1.0f / 512.0f) + LN_EPS);
            const f32x4 g0 = *(const f32x4*)(lg + 8 * lane), g1 = *(const f32x4*)(lg + 8 * lane + 4), b0 = *(const f32x4*)(lb + 8 * lane), b1 = *(const f32x4*)(lb + 8 * lane + 4);
            u32x4 w; w.x = pk2(v[0] * rstd * g0[0] + b0[0], v[1] * rstd * g0[1] + b0[1]); w.y = pk2(v[2] * rstd * g0[2] + b0[2], v[3] * rstd * g0[3] + b0[3]);
            w.z = pk2(v[4] * rstd * g1[0] + b1[0], v[5] * rstd * g1[1] + b1[1]); w.w = pk2(v[6] * rstd * g1[2] + b1[2], v[7] * rstd * g1[3] + b1[3]);
            const int ch = 8 * lane, g = ch >> 7, col = ch & 127, kt = (q >> 6) * 4 + g;
            *(LAS u32x4*)(F.lds + kt * 16384 + v_st(q & 63, col)) = w; }
        __syncthreads();
        const int pb = wid & 3, gh = wid >> 2;
#pragma unroll 1
        for (int gi = 0; gi < 2; ++gi) { const int g = 2 * gh + gi;
            unsigned wofs = (unsigned)(((g * 128 + 32 * pb + r32) * 128 + 8 * hi) * 2); asm volatile("" : "+v"(wofs));
            f32x16 acc[4];
#pragma unroll
            for (int d0 = 0; d0 < 4; ++d0) acc[d0] = f32x16{};
            bf16x8 af[8];
#pragma unroll
            for (int ks = 0; ks < 8; ++ks) af[ks] = *(const bf16x8*)((const char*)wsb + wofs + 32 * ks);
#pragma unroll
            for (int ks = 0; ks < 8; ++ks) {
                LAS unsigned char* trd = F.lds + ((ks >> 2) * 4 + g) * 16384 + v_rd_base(lane);
#pragma unroll
                for (int d0 = 0; d0 < 4; ++d0) acc[d0] = __builtin_amdgcn_mfma_f32_32x32x16_bf16(af[ks], vfrag(trd, d0, ks & 3), acc[d0], 0, 0, 0); }
            unsigned short uraw[16][4]; float bias[16];
#pragma unroll
            for (int r = 0; r < 16; ++r) { const int p = 32 * pb + crow(r, hi); bias[r] = bs[g * 128 + p];
#pragma unroll
                for (int d0 = 0; d0 < 4; ++d0) uraw[r][d0] = Z[(size_t)(r0 + p) * 1536 + g * 128 + d0 * 32 + r32]; }
            asm volatile("" ::: "memory");
#pragma unroll
            for (int r = 0; r < 16; ++r) { const int p = 32 * pb + crow(r, hi);
#pragma unroll
                for (int d0 = 0; d0 < 4; ++d0) { const int ch = g * 128 + d0 * 32 + r32;
                    MIX[(size_t)(r0 + p) * 1024 + ch] = (bf16_t)f2bf(bf2f(uraw[r][d0]) * (acc[d0][r] + bias[r])); } }
        }
        __syncthreads();
    }
}

__device__ __forceinline__ void ph_fourier1(Frame& F) {
    const bf16_t* Z = (const bf16_t*)(KWS(F) + WS_ZODD); bf16_t* WT = (bf16_t*)(KWS(F) + WS_WT);
    const float* lg = KIN(F, 27); const float* lb = KIN(F, 28);
    const bf16x8* CSf = (const bf16x8*)(KWS(F) + WS_TAB + TB_CS); const bf16x8* AFf = (const bf16x8*)(KWS(F) + WS_TAB + TB_AF); const f32x2* tw = (const f32x2*)(KWS(F) + WS_TAB + TB_TW);
    const int lane = F.lane, r32 = lane & 31, hi = lane >> 5, wid = F.wave;
    for (int unit = F.bx; unit < NB * 128; unit += F.G) {
        const int b = unit >> 7, t2 = unit & 127;
#pragma unroll 1
        for (int g = 0; g < 4; ++g) {
            {
                int lane_g = lane; asm volatile("" : "+v"(lane_g)); const int r32 = lane_g & 31, hi = lane_g >> 5;
                const int tb = wid & 3, part = wid >> 2; int t1 = 32 * tb + r32; asm volatile("" : "+v"(t1)); const size_t row = (size_t)b * SEQ + 128 * t1 + t2;
                bf16x8 raw[8]; float s = 0.f;
#pragma unroll
                for (int ks = 0; ks < 8; ++ks) { raw[ks] = *(const bf16x8*)(Z + row * 1536 + 1024 + g * 128 + 16 * ks + 8 * hi);
#pragma unroll
                    for (int j = 0; j < 8; ++j) s += bf2f((unsigned short)raw[ks][j]); }
                s += __shfl_xor(s, 32); const float mean = s * (1.0f / 128.0f); float q2 = 0.f;
#pragma unroll
                for (int ks = 0; ks < 8; ++ks)
#pragma unroll
                    for (int j = 0; j < 8; ++j) { const float d = bf2f((unsigned short)raw[ks][j]) - mean; q2 += d * d; }
                q2 += __shfl_xor(q2, 32); const float rstd = 1.0f / sqrtf(q2 * (1.0f / 128.0f) + LN_EPS);
                bf16x8 af[8];
#pragma unroll
                for (int ks = 0; ks < 8; ++ks) { const int c0 = g * 128 + 16 * ks + 8 * hi; const f32x4 g0 = *(const f32x4*)(lg + c0), g1 = *(const f32x4*)(lg + c0 + 4), b0 = *(const f32x4*)(lb + c0), b1 = *(const f32x4*)(lb + c0 + 4);
                    float x[8];
#pragma unroll
                    for (int j = 0; j < 8; ++j) x[j] = (bf2f((unsigned short)raw[ks][j]) - mean) * rstd;
                    u32x4 w; w.x = pk2(x[0] * g0[0] + b0[0], x[1] * g0[1] + b0[1]); w.y = pk2(x[2] * g0[2] + b0[2], x[3] * g0[3] + b0[3]);
                    w.z = pk2(x[4] * g1[0] + b1[0], x[5] * g1[1] + b1[1]); w.w = pk2(x[6] * g1[2] + b1[2], x[7] * g1[3] + b1[3]);
                    af[ks] = __builtin_bit_cast(bf16x8, w); }
                f32x16 acc[4];
#pragma unroll
                for (int d0 = 0; d0 < 4; ++d0) acc[d0] = f32x16{};
#pragma unroll
                for (int ks = 0; ks < 8; ++ks) { unsigned fo = (unsigned)(((4 * part) * 8 + ks) * 64 + lane) * 16u; asm volatile("" : "+v"(fo));
#pragma unroll
                    for (int d0 = 0; d0 < 4; ++d0) acc[d0] = __builtin_amdgcn_mfma_f32_32x32x16_bf16(af[ks], *(const bf16x8*)((const char*)CSf + fo + d0 * 8192), acc[d0], 0, 0, 0); }
                int ybase = (part * 2 + (tb >> 1)) * 16384 + (tb & 1) * 8192 + hi * 2048 + r32 * 2; asm volatile("" : "+v"(ybase));
#pragma unroll
                for (int r = 0; r < 16; ++r)
#pragma unroll
                    for (int d0 = 0; d0 < 4; ++d0) *(LAS bf16_t*)(F.lds + ybase + ((r >> 3) & 1) * 4096 + d0 * 512 + ((r & 3) + 4 * ((r >> 2) & 1)) * 64) = (bf16_t)f2bf(acc[d0][r]);
            }
            __syncthreads();
            {
                const int kb = wid & 3, ch2 = wid >> 2;
                f32x16 aR[2], aI[2];
#pragma unroll
                for (int dd = 0; dd < 2; ++dd) { aR[dd] = f32x16{}; aI[dd] = f32x16{}; }
#pragma unroll
                for (int kh = 0; kh < 4; ++kh) {
                    unsigned fo = (unsigned)((kb * 16 + kh * 4) * 64 + lane) * 16u; asm volatile("" : "+v"(fo));
                    bf16x8 fr8[4], fi8[4];
#pragma unroll
                    for (int k8 = 0; k8 < 4; ++k8) { fr8[k8] = *(const bf16x8*)((const char*)AFf + fo + k8 * 1024); fi8[k8] = *(const bf16x8*)((const char*)AFf + fo + k8 * 1024 + 65536); }
#pragma unroll
                    for (int k8 = 0; k8 < 4; ++k8) { const int ks = kh * 4 + k8;
                        LAS unsigned char* trd = F.lds + (ks >> 2) * 16384 + v_rd_base(lane);
#pragma unroll
                        for (int dd = 0; dd < 2; ++dd) { const bf16x8 bf = vfrag(trd, 2 * ch2 + dd, ks & 3);
                            aR[dd] = __builtin_amdgcn_mfma_f32_32x32x16_bf16(fr8[k8], bf, aR[dd], 0, 0, 0); aI[dd] = __builtin_amdgcn_mfma_f32_32x32x16_bf16(fi8[k8], bf, aI[dd], 0, 0, 0); } }
                }
                int k1b = 32 * kb + 4 * hi; asm volatile("" : "+v"(k1b));
                f32x2 csv[16];
#pragma unroll
                for (int r = 0; r < 16; ++r) csv[r] = tw[t2 * 128 + k1b + (r & 3) + 8 * (r >> 2)];
                asm volatile("" ::: "memory");
#pragma unroll
                for (int r = 0; r < 16; ++r) { const int k1 = k1b + (r & 3) + 8 * (r >> 2); const f32x2 cs = csv[r];
                    bf16_t* dst = WT + ((((size_t)b * 128 + k1) * 128 + t2) * 4 + g) * 256;
#pragma unroll
                    for (int dd = 0; dd < 2; ++dd) { const float wr_ = aR[dd][r], wi_ = aI[dd][r]; const int j = 32 * (2 * ch2 + dd) + r32;
                        dst[j] = (bf16_t)f2bf(wr_ * cs[0] + wi_ * cs[1]); dst[128 + j] = (bf16_t)f2bf(wi_ * cs[0] - wr_ * cs[1]); }
                    if ((r & 3) == 3) asm volatile("" ::: "memory"); }
            }
            __syncthreads();
        }
    }
}
__device__ __forceinline__ void ph_fourier2(Frame& F) {
    const bf16_t* WT = (const bf16_t*)(KWS(F) + WS_WT); bf16_t* MIX = (bf16_t*)(KWS(F) + WS_MIX);
    const bf16x8* A3f = (const bf16x8*)(KWS(F) + WS_TAB + TB_A3);
    const int lane = F.lane, r32 = lane & 31, hi = lane >> 5, wid = F.wave;
    for (int unit = F.bx; unit < NB * 128; unit += F.G) {
        const int b = unit >> 7, k1 = unit & 127;
#pragma unroll 1
        for (int g = 0; g < 4; ++g) {
            for (int idx = F.tid; idx < 4096; idx += NTHR) { const int t2 = idx >> 5, c = idx & 31, part = c >> 4, j0 = (c & 15) * 8;
                const u32x4 v = *(const u32x4*)(WT + ((((size_t)b * 128 + k1) * 128 + t2) * 4 + g) * 256 + part * 128 + j0);
                *(LAS u32x4*)(F.lds + (part * 2 + (t2 >> 6)) * 16384 + v_st(t2 & 63, j0)) = v; }
            __syncthreads();
            const int mb = wid & 3, ch2 = wid >> 2;
            f32x16 acc[2] = {f32x16{}, f32x16{}};
#pragma unroll
            for (int ks = 0; ks < 16; ++ks) { unsigned fo = (unsigned)((mb * 16 + ks) * 64 + lane) * 16u; asm volatile("" : "+v"(fo)); const bf16x8 af = *(const bf16x8*)((const char*)A3f + fo);
                LAS unsigned char* trd = F.lds + (ks >> 2) * 16384 + v_rd_base(lane);
#pragma unroll
                for (int dd = 0; dd < 2; ++dd) acc[dd] = __builtin_amdgcn_mfma_f32_32x32x16_bf16(af, vfrag(trd, 2 * ch2 + dd, ks & 3), acc[dd], 0, 0, 0); }
#pragma unroll
            for (int r = 0; r < 16; ++r) { const int k2 = 32 * mb + crow(r, hi); const size_t row = (size_t)b * SEQ + k1 + 128 * k2;
#pragma unroll
                for (int dd = 0; dd < 2; ++dd) MIX[row * 1024 + 512 + g * 128 + 32 * (2 * ch2 + dd) + r32] = (bf16_t)f2bf(acc[dd][r]); }
            __syncthreads();
        }
    }
}

#ifndef MK_ONE_LAUNCH
#define MK_ONE_LAUNCH 1
#endif
constexpr int NPH = 18;
#ifndef PHMASK
#define PHMASK 0x3FFFF
#endif
#define HAS(k) (((PHMASK) >> (k)) & 1)
__global__ void __launch_bounds__(NTHR, 2) fwd_kernel(Args args) {
    extern __shared__ __attribute__((aligned(16))) unsigned char lds_raw[];
    Frame F;
    F.lds = (LAS unsigned char*)lds_raw; F.tid = threadIdx.x; F.lane = F.tid & 63; F.wave = __builtin_amdgcn_readfirstlane(F.tid >> 6); F.G = gridDim.x; F.bx = blockIdx.x;
    F.kz = 0;
    volatile LAS unsigned* MISC = (volatile LAS unsigned*)(F.lds + MISC_OFF);
    if (F.tid < 64) MISC[F.tid] = 0u;
    __syncthreads();
    if (MK_ONE_LAUNCH) (void)xcd_barrier_post((unsigned*)(args.ws + WS_CTL) + CW_BAR, MISC + 8);
    const int lo = args.ph_lo, hi = args.ph_hi;
#define IN(k) (lo <= (k) && (k) < hi)
#ifndef REPMASK
#define REPMASK 0
#endif
#define REP(k) (((REPMASK) >> (k)) & 1)
#define BARNOW() do { ENTER(); XcdBarrier bar_; bar_.bar = (unsigned*)(KWS(F) + WS_CTL) + CW_BAR; bar_.x = xb_xcc_id(); bar_.st = (volatile LAS unsigned*)(F.lds + MISC_OFF) + 8; xcd_barrier(bar_); } while (0)
#ifndef DIAG_PH
#define DIAG_PH -1
#endif
    int nstamp = 0;
#define STAMP() do { if (DIAG_PH >= 0) { if (F.tid == 0) ((volatile LAS unsigned*)(F.lds + MISC_OFF))[16 + nstamp] = (unsigned)__builtin_amdgcn_s_memrealtime(); ++nstamp; } } while (0)
    STAMP();
#define ENTER() do { asm volatile("" : "+s"(F.kz), "+s"(F.wave), "+s"(F.G), "+s"(F.bx), "+v"(F.tid), "+v"(F.lane)); F.kz = __builtin_amdgcn_readfirstlane(F.kz); F.wave = __builtin_amdgcn_readfirstlane(F.wave); \
    F.G = __builtin_amdgcn_readfirstlane(F.G); F.bx = __builtin_amdgcn_readfirstlane(F.bx); } while (0)
#define SEAM(k) do { if (IN(k) && IN((k) + 1)) { if (MK_ONE_LAUNCH) { ENTER(); XcdBarrier bar_; bar_.bar = (unsigned*)(KWS(F) + WS_CTL) + CW_BAR; bar_.x = xb_xcc_id(); bar_.st = (volatile LAS unsigned*)(F.lds + MISC_OFF) + 8; xcd_barrier(bar_); STAMP(); } } } while (0)

    if (HAS(0) && IN(0)) { ENTER(); for (int rep_ = 0; rep_ <= REP(0); ++rep_) { if (rep_) BARNOW(); ph0_mod_tables(F); } } SEAM(0);
    if (HAS(1) && IN(1)) { ENTER(); for (int rep_ = 0; rep_ <= REP(1); ++rep_) { if (rep_) BARNOW(); ph1_convert(F); } } SEAM(1);
    if (HAS(2) && IN(2)) { ENTER(); for (int rep_ = 0; rep_ <= REP(2); ++rep_) { if (rep_) BARNOW(); ph2_modulate(F); } } SEAM(2);

    for (int layer = 0; layer < 2; ++layer) {
        const int pb = layer == 0 ? 5 : 13;
        if (layer == 0) {
            if (HAS(3) && IN(3)) { ENTER(); for (int rep_ = 0; rep_ <= REP(3); ++rep_) { if (rep_) BARNOW();
                pg8::Gemm g{(const bf16_t*)(KWS(F) + WS_U), (const bf16_t*)(KWS(F) + WS_WEVIN), T, 2560, DM};
                EvInOrder S; S.so.init(T, 2560, F.G, F.bx);
                EpiEvIn E{(unsigned char*)(KWS(F) + WS_Q), (unsigned char*)(KWS(F) + WS_K), (unsigned char*)(KWS(F) + WS_V), (bf16_t*)(KWS(F) + WS_AB), (const float*)(KWS(F) + WS_TAB + TB_COS), (const float*)(KWS(F) + WS_TAB + TB_SIN)};
                pg8::gemm_phase<EpiEvIn, EvInOrder, true, false>(F.lds, g, S, E, F.tid);
            } } SEAM(3);
            if (HAS(4) && IN(4)) { ENTER(); for (int rep_ = 0; rep_ <= REP(4); ++rep_) { if (rep_) BARNOW(); ph4_conv(F); ph4_attention(F); } } SEAM(4);
        } else {
            if (HAS(10) && IN(10)) { ENTER(); for (int rep_ = 0; rep_ <= REP(10); ++rep_) { if (rep_) BARNOW();
                pg8::Gemm g{(const bf16_t*)(KWS(F) + WS_U), (const bf16_t*)(KWS(F) + WS_WODIN), T, 1536, DM};
                pg8::StaticOrder S; S.init(T, 1536, F.G, F.bx);
                pg8::EpiBf16 E{(bf16_t*)(KWS(F) + WS_ZODD), 1536, 4};
                pg8::gemm_phase<pg8::EpiBf16, pg8::StaticOrder, true, false>(F.lds, g, S, E, F.tid);
            } } SEAM(10);
            if (HAS(11) && IN(11)) { ENTER(); for (int rep_ = 0; rep_ <= REP(11); ++rep_) { if (rep_) BARNOW(); ph_gmlp(F); ph_fourier1(F); } } SEAM(11);
            if (HAS(12) && IN(12)) { ENTER(); for (int rep_ = 0; rep_ <= REP(12); ++rep_) { if (rep_) BARNOW(); ph_fourier2(F); } } SEAM(12);
        }
        if (HAS(5) && IN(pb)) { ENTER(); for (int rep_ = 0; rep_ <= REP(5); ++rep_) { if (rep_) BARNOW();
            pg8::Gemm g{(const bf16_t*)(KWS(F) + WS_MIX), (const bf16_t*)(KWS(F) + (layer == 0 ? WS_WEVOUT : WS_WODOUT)), T, DM, DM};
            pg8::StaticOrder S; S.init(T, DM, F.G, F.bx);
            pg8::EpiBf16 E{(bf16_t*)(KWS(F) + WS_Y), DM, 0};
            pg8::gemm_phase<pg8::EpiBf16, pg8::StaticOrder, true, false>(F.lds, g, S, E, F.tid);
        } } SEAM(pb);
        if (HAS(6) && IN(pb + 1)) { ENTER(); for (int rep_ = 0; rep_ <= REP(6); ++rep_) { if (rep_) BARNOW(); ph_router(F, layer, layer == 0 ? KIN(F, 0) : (const float*)(KWS(F) + WS_H2)); } } SEAM(pb + 1);
        if (HAS(7) && IN(pb + 2)) { ENTER(); for (int rep_ = 0; rep_ <= REP(7); ++rep_) { if (rep_) BARNOW();
            moe_meta(F, layer);
            pg8::Gemm g{(const bf16_t*)(KWS(F) + WS_U2), (const bf16_t*)(KWS(F) + WS_WGU + (size_t)layer * NE * 2048 * DM), 0, 0, DM / 2};
            MoeOrder S{(const LAS int*)(F.lds + META_OFF), (const unsigned*)(KWS(F) + WS_LIST), F.bx, F.G, 8, 4};
            EpiGU E{(unsigned char*)(KWS(F) + WS_ACT), KIN(F, 32) + (size_t)layer * NE * 2048};
            pg8::gemm_phase<EpiGU, MoeOrder, true, true, true>(F.lds, g, S, E, F.tid);
        } } SEAM(pb + 2);
        if (HAS(8) && IN(pb + 3)) { ENTER(); for (int rep_ = 0; rep_ <= REP(8); ++rep_) { if (rep_) BARNOW();
            moe_meta(F, layer);
            pg8::Gemm g{(const bf16_t*)(KWS(F) + WS_ACT), (const bf16_t*)(KWS(F) + WS_WD + (size_t)layer * NE * 1024 * DM), 0, 0, DM / 2};
            MoeOrder S{(const LAS int*)(F.lds + META_OFF), (const unsigned*)(KWS(F) + WS_LIST), F.bx, F.G, 4, 8};
            EpiDown E{(unsigned char*)(KWS(F) + WS_YB), KIN(F, 34) + (size_t)layer * NE * 1024, (const unsigned*)(KWS(F) + WS_LIST)};
            pg8::gemm_phase<EpiDown, MoeOrder, true, false, true>(F.lds, g, S, E, F.tid);
        } } SEAM(pb + 3);
        if (HAS(9) && IN(pb + 4)) { ENTER(); for (int rep_ = 0; rep_ <= REP(9); ++rep_) { if (rep_) BARNOW(); ph_combine(F, layer, layer == 0 ? (float*)(KWS(F) + WS_H2) : KOUT(F), layer == 0); } }
        if (layer == 0) SEAM(pb + 4);
    }
    if (DIAG_PH >= 0) {
        ENTER(); XcdBarrier bar_; bar_.bar = (unsigned*)(KWS(F) + WS_CTL) + CW_BAR; bar_.x = xb_xcc_id(); bar_.st = (volatile LAS unsigned*)(F.lds + MISC_OFF) + 8; xcd_barrier(bar_); STAMP();
        __syncthreads();
        volatile LAS unsigned* st = (volatile LAS unsigned*)(F.lds + MISC_OFF) + 16;
        const unsigned d = st[DIAG_PH + 1] - st[DIAG_PH];
        const float c = sqrtf((float)d * 0.01f);
        float* o = KOUT(F);
        for (size_t i = (size_t)F.bx * NTHR + F.tid; i < (size_t)T * DM; i += (size_t)F.G * NTHR) o[i] = c;
    }
#undef IN
#undef SEAM
}

extern "C" void kernel_launch(void* const* d_in, const int* in_sizes, int n_in, void* d_out, int out_size, void* d_ws, size_t ws_size, hipStream_t stream) {
    static int grid = 0;
    if (grid == 0) {
        if (n_in != 35 || out_size != T * DM || ws_size < WS_END) { fprintf(stderr, "kernel_launch: unexpected shapes: n_in %d out %d ws %zu (need %zu)\n", n_in, out_size, ws_size, (size_t)WS_END); grid = -1; return; }
        int dev = 0, cus = 0;
        if (hipGetDevice(&dev) != hipSuccess || hipDeviceGetAttribute(&cus, hipDeviceAttributeMultiprocessorCount, dev) != hipSuccess) { grid = -1; return; }
        if (hipFuncSetAttribute((const void*)fwd_kernel, hipFuncAttributeMaxDynamicSharedMemorySize, LDS_BYTES) != hipSuccess) { fprintf(stderr, "kernel_launch: hipFuncSetAttribute failed\n"); grid = -1; return; }
        int per_cu = 0; (void)hipOccupancyMaxActiveBlocksPerMultiprocessor(&per_cu, (const void*)fwd_kernel, NTHR, LDS_BYTES); (void)hipGetLastError();
        if (per_cu < 1) fprintf(stderr, "kernel_launch: occupancy query reports %d blocks per CU\n", per_cu);
        grid = cus > 256 ? 256 : cus;
        if (grid != 256) fprintf(stderr, "kernel_launch: %d CUs; this kernel is laid out for 256\n", cus);
    }
    if (grid < 0) return;
    (void)hipMemsetAsync((char*)d_ws + WS_CTL, 0, CTL_ZERO_BYTES, stream);
    Args a{};
    for (int i = 0; i < 35; ++i) a.in[i] = (const float*)d_in[i];
    a.out = (float*)d_out; a.ws = (unsigned char*)d_ws;
#if MK_ONE_LAUNCH
    a.ph_lo = 0; a.ph_hi = NPH;
    hipLaunchKernelGGL(fwd_kernel, dim3(grid), dim3(NTHR), LDS_BYTES, stream, a);
#else
    for (int p = 0; p < NPH; ++p) { a.ph_lo = p; a.ph_hi = p + 1; hipLaunchKernelGGL(fwd_kernel, dim3(grid), dim3(NTHR), LDS_BYTES, stream, a); }
#endif
    const hipError_t le = hipPeekAtLastError();
    if (le != hipSuccess) fprintf(stderr, "kernel_launch: launch failed: %s\n", hipGetErrorName(le));
}
```

```cpp
#include <hip/hip_runtime.h>
#include <cstdio>
#include <cstdint>

#define LAS __attribute__((address_space(3)))
#define GAS __attribute__((address_space(1)))
typedef unsigned short bf16_t;
typedef short bf16x8 __attribute__((ext_vector_type(8)));
typedef short s16x4 __attribute__((ext_vector_type(4)));
typedef float f32x4 __attribute__((ext_vector_type(4)));
typedef float f32x2 __attribute__((ext_vector_type(2)));
typedef float f32x16 __attribute__((ext_vector_type(16)));
typedef unsigned u32x4 __attribute__((ext_vector_type(4)));
typedef unsigned u32x2 __attribute__((ext_vector_type(2)));

namespace pg8 {
constexpr int BM = 256, BK = 64, HALF = 128, HTB = HALF * BK * 2, STAGE_BYTES = 8 * HTB, NXCD = 8, WGM = 8;
__host__ __device__ __forceinline__ int lds_byte(int r, int c) { const int st = (r >> 4) * 2 + (c >> 5), rr = r & 15, cc = c & 31, ob = rr * 64 + cc * 2; return st * 1024 + (ob ^ (((ob >> 9) & 1) << 5)); }
__host__ __device__ __forceinline__ void stage_rc(int b, int& R, int& C) { const int st = b / 1024, sb = b % 1024, swz = sb ^ (((sb >> 9) & 1) << 5); R = (st >> 1) * 16 + swz / 64; C = (st & 1) * 32 + (swz % 64) / 2; }
__host__ __device__ __forceinline__ int perm32(int rho) { const int n = rho >> 4, i = rho & 15; return 8 * (i >> 2) + 4 * n + (i & 3); }

struct Unit { int pm, pn, a0, a1, a2; };
struct Gemm { const bf16_t* A; const bf16_t* Bt; int M, N, K; };

constexpr int PRE_ROWS = 131072 + 1024, PRE_EPI = PRE_ROWS + 2048;
struct StaticOrder {
    int nM, nN, nwg, G, c;
    __device__ void init(int M, int N, int G_, int c_) { nM = M / BM; nN = N / BM; nwg = nM * nN; G = G_; c = c_; }
    __device__ bool map(long L, Unit& u) const {
        if (L >= nwg) return false;
        int wgid = (int)L; { const int q = nwg / NXCD, r = nwg % NXCD, xcd = wgid % NXCD, off = wgid / NXCD; wgid = (xcd < r ? xcd * (q + 1) : r * (q + 1) + (xcd - r) * q) + off; }
        const int nig = WGM * nN, gid = wgid / nig, fm = gid * WGM, gsz = (nM - fm) < WGM ? (nM - fm) : WGM;
        u.pm = fm + ((wgid % nig) % gsz); u.pn = (wgid % nig) / gsz; u.a0 = 0; u.a1 = 0; u.a2 = 256; return true;
    }
    __device__ bool next(int i, Unit& u) const { return map((long)i * G + c, u); }
    __device__ __forceinline__ unsigned arow(const Unit&, int) const { return 0u; }
    __device__ __forceinline__ unsigned rowval(const Unit&, int, unsigned) const { return 0u; }
    __device__ __forceinline__ const unsigned* rows_ptr(const Unit&) const { return nullptr; }
};

__device__ __forceinline__ unsigned cvt_pk_bf16(float lo, float hi) { unsigned r; asm volatile("v_cvt_pk_bf16_f32 %0, %1, %2" : "=v"(r) : "v"(lo), "v"(hi)); return r; }

__device__ __forceinline__ float gelu_tanh(float x) {
    const float t = x * (1.0f + 0.044715f * x * x) * (2.0f * 0.7978845608028654f * 1.4426950408889634f);
    return x * __builtin_amdgcn_rcpf(1.0f + __builtin_amdgcn_exp2f(-t));
}

struct EpiBf16 {
    static constexpr bool PERM = true, HAS_PRE = false;
    bf16_t* O; int ldc; int gelu_pn;
    __device__ __forceinline__ void operator()(const f32x4 (&acc)[2][2][4][2], const Unit& u, int wr, int wc, int fr, int fq) const {
        const int row0 = u.pm * BM + wr * 64 + fr; const int col0 = u.pn * BM + wc * 32 + 8 * fq;
        const bool act = u.pn < gelu_pn;
#pragma unroll
        for (int ai = 0; ai < 2; ++ai)
#pragma unroll
            for (int m = 0; m < 4; ++m) { bf16_t* rowp = O + (size_t)(row0 + ai * HALF + m * 16) * ldc + col0;
#pragma unroll
                for (int bj = 0; bj < 2; ++bj) { f32x4 v0 = acc[ai][bj][m][0], v1 = acc[ai][bj][m][1];
                    if (act) {
#pragma unroll
                        for (int j = 0; j < 4; ++j) { v0[j] = gelu_tanh(v0[j]); v1[j] = gelu_tanh(v1[j]); } }
                    u32x4 w; w.x = cvt_pk_bf16(v0[0], v0[1]); w.y = cvt_pk_bf16(v0[2], v0[3]); w.z = cvt_pk_bf16(v1[0], v1[1]); w.w = cvt_pk_bf16(v1[2], v1[3]);
                    *(u32x4*)(rowp + bj * HALF) = w; } }
    }
};

typedef int v8i32 __attribute__((ext_vector_type(8)));
typedef short s16x16 __attribute__((ext_vector_type(16)));
template <class Epi, class Sched, bool ALIGN_EPI, bool GATHER, bool FP8 = false>
__device__ __forceinline__ void gemm_phase(LAS unsigned char* lds, const Gemm g, const Sched& S, const Epi& E, const int tid) {
    const int wid = __builtin_amdgcn_readfirstlane(tid >> 6), lane = tid & 63, wr = wid >> 2, wc = wid & 3, fr = lane & 15, fq = lane >> 4;
    const int K = g.K, nt = K / BK;
    unsigned voffA[2], voffB[2]; int Rr[2], Cc[2];
#pragma unroll
    for (int i = 0; i < 2; ++i) { int R, C; stage_rc(tid * 16 + i * 8192, R, C); const int Rb = Epi::PERM ? ((R & ~31) + perm32(R & 31)) : R; Rr[i] = R; Cc[i] = C;
        voffA[i] = (unsigned)(R * K + C) * 2u; voffB[i] = (unsigned)(Rb * K + C) * 2u; }
    const unsigned kstep = (unsigned)(BK * 2);
    const unsigned hstep = (unsigned)HALF * (unsigned)K * 2u;
    const unsigned tstep = 2u * hstep;
    const char* const baseA = (const char*)g.A; const char* const baseB = (const char*)g.Bt;
    const unsigned ldsw = (unsigned)wid * 1024u;
    const int aoff = lds_byte(wr * 64 + fr, fq * 8), boff = lds_byte(wc * 32 + fr, fq * 8);
    const int aoff0 = lds_byte(wr * 64 + fr, fq * 16), aoff1 = lds_byte(wr * 64 + fr, fq * 16 + 8), boff0 = lds_byte(wc * 32 + fr, fq * 16), boff1 = lds_byte(wc * 32 + fr, fq * 16 + 8);
#define PG8_SA(b, h) (((b) * 2 + (h)) * HTB)
#define PG8_SB(b, h) ((4 + (b) * 2 + (h)) * HTB)
#define PG8_STAGE(bufoff, gbase, voff) do { _Pragma("unroll") for (int _i = 0; _i < 2; ++_i) \
        __builtin_amdgcn_global_load_lds((const unsigned*)(baseB + (size_t)(unsigned)((gbase) + (voff)[_i])), (LAS unsigned*)(lds + (bufoff) + ldsw + _i * 8192), 16, 0, 0); } while (0)
#define PG8_STAGEA(bufoff, gbase, voff) do { _Pragma("unroll") for (int _i = 0; _i < 2; ++_i) \
        __builtin_amdgcn_global_load_lds((const unsigned*)(baseA + (size_t)(unsigned)((gbase) + (voff)[_i])), (LAS unsigned*)(lds + (bufoff) + ldsw + _i * 8192), 16, 0, 0); } while (0)
#define PG8_STAGE_A(bufoff, base, h, nx) do { if constexpr (GATHER) { _Pragma("unroll") for (int _i = 0; _i < 2; ++_i) { const unsigned _v = (nx) ? vAn[h][_i] : vAc[h][_i]; \
            __builtin_amdgcn_global_load_lds((const unsigned*)(baseA + (size_t)(unsigned)((base) + _v)), (LAS unsigned*)(lds + (bufoff) + ldsw + _i * 8192), 16, 0, 0); } } \
        else { PG8_STAGEA(bufoff, (base) + (h) * hstep, voffA); } } while (0)
#define PG8_LD8(dst, i, off0, off1) do { const bf16x8 _lo = *(const LAS bf16x8*)(lds + (off0)), _hi = *(const LAS bf16x8*)(lds + (off0) + 16); dst[i] = __builtin_bit_cast(v8i32, __builtin_shufflevector(_lo, _hi, 0, 1, 2, 3, 4, 5, 6, 7, 8, 9, 10, 11, 12, 13, 14, 15)); } while (0)
#define PG8_LDA8(dst, b, h) do { _Pragma("unroll") for (int m = 0; m < 4; ++m) PG8_LD8(dst, m, PG8_SA(b, h) + aoff0 + m * 2048, PG8_SA(b, h) + aoff1 + m * 2048); } while (0)
#define PG8_LDB8(dst, b, h) do { _Pragma("unroll") for (int n = 0; n < 2; ++n) PG8_LD8(dst, n, PG8_SB(b, h) + boff0 + n * 2048, PG8_SB(b, h) + boff1 + n * 2048); } while (0)
#define PG8_MMA8(ai, bj, At, Bt) do { __builtin_amdgcn_s_setprio(1); _Pragma("unroll") for (int m = 0; m < 4; ++m) _Pragma("unroll") for (int n = 0; n < 2; ++n) \
        asm volatile("v_mfma_scale_f32_16x16x128_f8f6f4 %0, %1, %2, %0, %3, %3 op_sel_hi:[0,0,0]" : "+v"(acc[ai][bj][m][n]) : "v"(Bt[n]), "v"(At[m]), "v"(one_scale)); __builtin_amdgcn_s_setprio(0); } while (0)
#define PG8_LDA(dst, b, h) do { _Pragma("unroll") for (int m = 0; m < 4; ++m) _Pragma("unroll") for (int k = 0; k < 2; ++k) dst[m][k] = *(const LAS bf16x8*)(lds + PG8_SA(b, h) + aoff + m * 2048 + k * 1024); } while (0)
#define PG8_LDB(dst, b, h) do { _Pragma("unroll") for (int n = 0; n < 2; ++n) _Pragma("unroll") for (int k = 0; k < 2; ++k) dst[n][k] = *(const LAS bf16x8*)(lds + PG8_SB(b, h) + boff + n * 2048 + k * 1024); } while (0)
#define PG8_MMA(ai, bj, At, Bt) do { __builtin_amdgcn_s_setprio(1); _Pragma("unroll") for (int m = 0; m < 4; ++m) _Pragma("unroll") for (int n = 0; n < 2; ++n) _Pragma("unroll") for (int k = 0; k < 2; ++k) \
        acc[ai][bj][m][n] = __builtin_amdgcn_mfma_f32_16x16x32_bf16(Bt[n][k], At[m][k], acc[ai][bj][m][n], 0, 0, 0); __builtin_amdgcn_s_setprio(0); } while (0)
#define PG8_WAIT_V(n) asm volatile("s_waitcnt vmcnt(" #n ")" ::: "memory")
#define PG8_WAIT_L(n) asm volatile("s_waitcnt lgkmcnt(" #n ")" ::: "memory")
#define PG8_BAR __builtin_amdgcn_s_barrier()
#define PG8_SCHED __builtin_amdgcn_sched_barrier(0)
    Unit cur, nxt; int ui = 0;
    if (!S.next(0, cur)) return;
    f32x4 acc[2][2][4][2];
#pragma unroll
    for (int a = 0; a < 2; ++a)
#pragma unroll
        for (int b = 0; b < 2; ++b)
#pragma unroll
            for (int m = 0; m < 4; ++m)
#pragma unroll
                for (int n = 0; n < 2; ++n) acc[a][b][m][n] = (f32x4){0.f, 0.f, 0.f, 0.f};
    bf16x8 At[4][2], B0[2][2], B1[2][2]; v8i32 At8[4], B08[2], B18[2]; const int one_scale = 0x7F7F7F7F;
#define XLDA(b, h) do { if constexpr (FP8) PG8_LDA8(At8, b, h); else PG8_LDA(At, b, h); } while (0)
#define XLDB0(b, h) do { if constexpr (FP8) PG8_LDB8(B08, b, h); else PG8_LDB(B0, b, h); } while (0)
#define XLDB1(b, h) do { if constexpr (FP8) PG8_LDB8(B18, b, h); else PG8_LDB(B1, b, h); } while (0)
#define XMMA0(ai, bj) do { if constexpr (FP8) PG8_MMA8(ai, bj, At8, B08); else PG8_MMA(ai, bj, At, B0); } while (0)
#define XMMA1(ai, bj) do { if constexpr (FP8) PG8_MMA8(ai, bj, At8, B18); else PG8_MMA(ai, bj, At, B1); } while (0)
    unsigned vAc[2][2], vAn[2][2];
#define PG8_ROWS(dst, un) do { if constexpr (GATHER) { _Pragma("unroll") for (int _h = 0; _h < 2; ++_h) _Pragma("unroll") for (int _i = 0; _i < 2; ++_i) \
        dst[_h][_i] = (S.arow(un, _h * HALF + Rr[0] + 64 * _i) * (unsigned)K + (unsigned)Cc[0]) * 2u; } } while (0)
    PG8_ROWS(vAc, cur);
#pragma unroll
    for (int _h = 0; _h < 2; ++_h)
#pragma unroll
        for (int _i = 0; _i < 2; ++_i) vAn[_h][_i] = vAc[_h][_i];
    unsigned cA = GATHER ? 0u : (unsigned)cur.pm * tstep; unsigned cB = (unsigned)cur.pn * tstep;
    PG8_STAGE(PG8_SB(0, 0), cB, voffB); PG8_STAGE(PG8_SB(0, 1), cB + hstep, voffB); PG8_STAGE_A(PG8_SA(0, 0), cA, 0, false); PG8_STAGE_A(PG8_SA(0, 1), cA, 1, false);
    if (wr == 1) PG8_BAR;
    PG8_WAIT_V(2); PG8_BAR;
    PG8_STAGE(PG8_SB(1, 0), cB + kstep, voffB); PG8_STAGE_A(PG8_SA(1, 0), cA + kstep, 0, false); PG8_STAGE(PG8_SB(1, 1), cB + hstep + kstep, voffB);
    PG8_WAIT_V(6); PG8_BAR;
    for (;;) {
        const bool has_next = S.next(ui + 1, nxt);
        if constexpr (GATHER) {
            if (has_next) {
                if (ui == 0) { PG8_ROWS(vAn, nxt); asm volatile("" : "+v"(vAn[0][0]), "+v"(vAn[0][1]), "+v"(vAn[1][0]), "+v"(vAn[1][1])); }
                else {
#pragma unroll
                    for (int _h = 0; _h < 2; ++_h)
#pragma unroll
                        for (int _i = 0; _i < 2; ++_i) { const int R_ = _h * HALF + Rr[0] + 64 * _i; const unsigned v_ = *(const LAS unsigned*)(lds + PRE_ROWS + ((ui + 1) & 1) * 1024 + R_ * 4);
                            vAn[_h][_i] = (S.rowval(nxt, R_, v_) * (unsigned)K + (unsigned)Cc[0]) * 2u; } }
            }
            Unit n2_; if (S.next(ui + 2, n2_)) { if (wid == 0) __builtin_amdgcn_global_load_lds((const unsigned*)(S.rows_ptr(n2_) + lane * 4), (LAS unsigned*)(lds + PRE_ROWS + (ui & 1) * 1024), 16, 0, 0); }
        } else { if (has_next) { PG8_ROWS(vAn, nxt); } }
        if constexpr (Epi::HAS_PRE) E.pre(lds + PRE_EPI + (ui & 1) * 2048, cur, wid, lane);
        const unsigned nA = GATHER ? 0u : (has_next ? (unsigned)nxt.pm * tstep : cA);
        const unsigned nB = has_next ? (unsigned)nxt.pn * tstep : cB;
#pragma unroll 1
        for (int t = 0; t < nt; t += 2) {
            const bool last = (t == nt - 2);
            const bool nx = last && has_next;
            const unsigned a1 = cA + (unsigned)(t + 1) * kstep;
            const unsigned a2 = last ? nA : cA + (unsigned)(t + 2) * kstep; const unsigned b2 = last ? nB : cB + (unsigned)(t + 2) * kstep;
            const unsigned a3 = a2 + kstep; const unsigned b3 = b2 + kstep;
            XLDB0(0, 0); XLDB1(0, 1); PG8_SCHED; XLDA(0, 0); PG8_STAGE_A(PG8_SA(1, 1), a1, 1, false);
            PG8_WAIT_V(8); PG8_WAIT_L(0); PG8_BAR; XMMA0(0, 0); XMMA1(0, 1); PG8_BAR; PG8_SCHED;
            XLDA(0, 1); PG8_STAGE(PG8_SB(0, 0), b2, voffB); PG8_STAGE(PG8_SB(0, 1), b2 + hstep, voffB); PG8_STAGE_A(PG8_SA(0, 0), a2, 0, nx);
            PG8_WAIT_V(8); PG8_WAIT_L(0); PG8_BAR; XMMA0(1, 0); XMMA1(1, 1); PG8_BAR; PG8_SCHED;
            XLDB0(1, 0); XLDB1(1, 1); PG8_SCHED; XLDA(1, 0); PG8_STAGE_A(PG8_SA(0, 1), a2, 1, nx);
            PG8_WAIT_V(8); PG8_WAIT_L(0); PG8_BAR; XMMA0(0, 0); XMMA1(0, 1); PG8_BAR; PG8_SCHED;
            XLDA(1, 1); PG8_STAGE(PG8_SB(1, 0), b3, voffB); PG8_STAGE(PG8_SB(1, 1), b3 + hstep, voffB); PG8_STAGE_A(PG8_SA(1, 0), a3, 0, nx);
            PG8_WAIT_V(8); PG8_WAIT_L(0); PG8_BAR; XMMA0(1, 0); XMMA1(1, 1); PG8_BAR; PG8_SCHED;
        }
        if constexpr (FP8) asm volatile("s_nop 15\n\ts_nop 15" ::: "memory");
        if constexpr (ALIGN_EPI) { if (wr == 0) PG8_BAR; }
        if constexpr (Epi::HAS_PRE) E(acc, cur, wr, wc, fr, fq, lds + PRE_EPI + (ui & 1) * 2048); else E(acc, cur, wr, wc, fr, fq);
        if (!has_next) break;
#pragma unroll
        for (int a = 0; a < 2; ++a)
#pragma unroll
            for (int b = 0; b < 2; ++b)
#pragma unroll
                for (int m = 0; m < 4; ++m)
#pragma unroll
                    for (int n = 0; n < 2; ++n) acc[a][b][m][n] = (f32x4){0.f, 0.f, 0.f, 0.f};
        cur = nxt; cA = nA; cB = nB; ++ui;
#pragma unroll
        for (int _h = 0; _h < 2; ++_h)
#pragma unroll
            for (int _i = 0; _i < 2; ++_i) vAc[_h][_i] = vAn[_h][_i];
        if constexpr (ALIGN_EPI) { if (wr == 1) PG8_BAR; }
    }
    PG8_WAIT_V(0);
    if constexpr (!ALIGN_EPI) { if (wr == 0) PG8_BAR; }
    PG8_BAR;
#undef PG8_SA
#undef PG8_SB
#undef PG8_STAGE
#undef PG8_STAGEA
#undef PG8_STAGE_A
#undef PG8_ROWS
#undef PG8_LDA
#undef PG8_LD8
#undef PG8_LDA8
#undef PG8_LDB8
#undef PG8_MMA8
#undef XLDA
#undef XLDB0
#undef XLDB1
#undef XMMA0
#undef XMMA1
#undef PG8_LDB
#undef PG8_MMA
#undef PG8_WAIT_V
#undef PG8_WAIT_L
#undef PG8_BAR
#undef PG8_SCHED
}
}

constexpr int DM = 1024, SEQ = 16384, NB = 2, T = NB * SEQ, CTX = 256, NCTX = NB * CTX, NKEY = SEQ + CTX;
constexpr int NE = 32, TOPK = 4, CAP = 32768;
constexpr float ALPHA = 1.4142135623730951f, LN_EPS = 1e-5f;
constexpr float QSCALE = 0.125f * 1.4426950408889634f;
constexpr float LAM_INIT0 = 0.2f;
constexpr int NWAVES = 8, NTHR = 512;

constexpr size_t MiB = 1u << 20;
constexpr size_t WS_CTL = 0, CTL_ZERO_BYTES = 1 * MiB;
constexpr size_t WS_MODP = 1 * MiB;
constexpr size_t WS_MOD = 3 * MiB;
constexpr size_t WS_TAB = 4 * MiB;
constexpr size_t WS_WEVIN = 6 * MiB, WS_WEVOUT = 11 * MiB, WS_WODIN = 13 * MiB, WS_WODOUT = 16 * MiB;
constexpr size_t WS_LIST = 18 * MiB, WS_GATES = 22 * MiB;
constexpr size_t WS_WGU = 32 * MiB;
constexpr size_t WS_WD = 288 * MiB;
constexpr size_t WS_U = 416 * MiB;
constexpr size_t WS_Q = 482 * MiB, WS_K = 514 * MiB, WS_V = 547 * MiB, WS_AB = 580 * MiB;
constexpr size_t WS_O0 = 612 * MiB;
constexpr size_t WS_MIX = 676 * MiB, WS_Y = 740 * MiB, WS_H1 = 804 * MiB, WS_U2 = 932 * MiB;
constexpr size_t WS_ACT = 996 * MiB;
constexpr size_t WS_YB = 1268 * MiB;
constexpr size_t WS_H2 = 1524 * MiB;
constexpr size_t WS_ZODD = 1652 * MiB;
constexpr size_t WS_WT = 1748 * MiB;
constexpr size_t WS_END = 1812 * MiB;
constexpr size_t TB_COS = 0, TB_SIN = 20480, TB_CS = 40960  , TB_AF = 106496  , TB_A3 = 237568  , TB_TW = 303104  , TB_WS = 434176  , TB_END = 565248;
constexpr int CW_ERR = 0, CW_BAR = 4096, CW_CNT = 16384;
#define XB_TMO      128
#define XB_XCNT(j)  (256  + 64 * (j))
#define XB_XSUB(j)  (1280 + 64 * (j))
#define XB_XGEN(j)  (2304 + 64 * (j))
#define XB_TOP      3328
#define XB_TOPGEN   3392
#define XCD_BAR_WORDS 3456
#define XB_SPIN_CAP (1u << 18)
constexpr int LDS_BYTES = 160 * 1024, MISC_OFF = LDS_BYTES - 256, META_OFF = 131072;

__device__ __forceinline__ unsigned xb_ld(unsigned* p)              { return __hip_atomic_load(p, __ATOMIC_RELAXED, __HIP_MEMORY_SCOPE_AGENT); }
__device__ __forceinline__ unsigned xb_add(unsigned* p, unsigned v) { return __hip_atomic_fetch_add(p, v, __ATOMIC_RELAXED, __HIP_MEMORY_SCOPE_AGENT); }
__device__ __forceinline__ unsigned xb_xcc_id() { return (unsigned)__builtin_amdgcn_s_getreg((3 << 11) | 20) & 0xFu; }
#define XB_SPIN(cond, bar) do { unsigned _sp = 0; while (cond) { __builtin_amdgcn_s_sleep(1); \
    if ((++_sp & 255u) == 0u) { if (xb_ld(&(bar)[XB_TMO])) break; if (_sp > XB_SPIN_CAP) { atomicAdd(&(bar)[XB_TMO], 1u); break; } } } } while (0)
struct XcdBarrier { unsigned* bar; unsigned x; volatile LAS unsigned* st; };
__device__ __forceinline__ XcdBarrier xcd_barrier_post(unsigned* bar, volatile LAS unsigned* st) {
    XcdBarrier b; b.bar = bar; b.x = xb_xcc_id(); b.st = st;
    if (threadIdx.x == 0) (void)xb_add(&bar[XB_XCNT(b.x)], 1u);
    return b;
}
__device__ __forceinline__ void xcd_barrier_complete(unsigned* bar, unsigned x, unsigned& nloc, unsigned& nx) {
    const unsigned G = gridDim.x * gridDim.y * gridDim.z;
    unsigned sum, cnt, mine, sp = 0u;
    for (;;) {
        sum = 0u; cnt = 0u; mine = 0u;
#pragma unroll
        for (unsigned j = 0; j < 16; ++j) { const unsigned c = xb_ld(&bar[XB_XCNT(j)]); sum += c; cnt += (c > 0u) ? 1u : 0u; mine = (j == x) ? c : mine; }
        if (sum == G) break;
        __builtin_amdgcn_s_sleep(1);
        if ((++sp & 255u) == 0u) { if (xb_ld(&bar[XB_TMO])) break; if (sp > XB_SPIN_CAP) { atomicAdd(&bar[XB_TMO], 1u); break; } }
    }
    nloc = mine > 0u ? mine : 1u; nx = cnt > 0u ? cnt : 1u;
}
__device__ __forceinline__ void xcd_barrier(const XcdBarrier& b) {
    asm volatile("s_waitcnt vmcnt(0)" ::: "memory");
    __syncthreads();
    if (threadIdx.x == 0) {
        unsigned* bar = b.bar;
        __builtin_amdgcn_s_waitcnt(0);
        unsigned nloc = b.st[0], nx = b.st[1];
        if (nloc == 0u) { xcd_barrier_complete(bar, b.x, nloc, nx); b.st[0] = nloc; b.st[1] = nx; }
        const unsigned old = xb_add(&bar[XB_XSUB(b.x)], 1u);
        const unsigned gen = old / nloc;
        if (old + 1u == (gen + 1u) * nloc) {
            __builtin_amdgcn_fence(__ATOMIC_RELEASE, "agent");
            asm volatile("s_waitcnt vmcnt(0)" ::: "memory");
            const unsigned og = xb_add(&bar[XB_TOP], 1u);
            const unsigned tg = og / nx;
            if (og + 1u == (tg + 1u) * nx) xb_add(&bar[XB_TOPGEN], 1u);
            else XB_SPIN(xb_ld(&bar[XB_TOPGEN]) == tg, bar);
            __builtin_amdgcn_fence(__ATOMIC_ACQUIRE, "agent");
            xb_add(&bar[XB_XGEN(b.x)], 1u);
            asm volatile("s_waitcnt vmcnt(0)" ::: "memory");
        } else {
            XB_SPIN(xb_ld(&bar[XB_XGEN(b.x)]) == gen, bar);
            __builtin_amdgcn_fence(__ATOMIC_ACQUIRE, "agent");
            asm volatile("s_waitcnt vmcnt(0)" ::: "memory");
        }
    }
    __syncthreads();
}

__device__ __forceinline__ float bf2f(unsigned short b) { return __uint_as_float(((unsigned)b) << 16); }
__device__ __forceinline__ unsigned f2bf(float f) { unsigned u = __float_as_uint(f); return (u + 0x7fffu + ((u >> 16) & 1u)) >> 16; }
__device__ __forceinline__ unsigned pk2(float lo, float hi) { return f2bf(lo) | (f2bf(hi) << 16); }
__device__ __forceinline__ unsigned pk4_fp8(float a, float b, float c, float d) { unsigned w = (unsigned)__builtin_amdgcn_cvt_pk_fp8_f32(a, b, 0, false); return (unsigned)__builtin_amdgcn_cvt_pk_fp8_f32(c, d, (int)w, true); }
constexpr float WGU_SCALE = 32.0f, WD_SCALE = 64.0f;
template <int CTRL> __device__ __forceinline__ float dpp_f(float v) { return __builtin_bit_cast(float, __builtin_amdgcn_update_dpp(0, __builtin_bit_cast(int, v), CTRL, 0xf, 0xf, true)); }
__device__ __forceinline__ float wave_sum(float v) {
    v += dpp_f<0xB1>(v); v += dpp_f<0x4E>(v); v += dpp_f<0x141>(v); v += dpp_f<0x140>(v);
    { const auto r = __builtin_amdgcn_permlane16_swap(__float_as_uint(v), __float_as_uint(v), false, false); v = __uint_as_float(r[0]) + __uint_as_float(r[1]); }
    { const auto r = __builtin_amdgcn_permlane32_swap(__float_as_uint(v), __float_as_uint(v), false, false); v = __uint_as_float(r[0]) + __uint_as_float(r[1]); }
    return v;
}
__device__ __forceinline__ float half_sum(float v) {
    v += dpp_f<0xB1>(v); v += dpp_f<0x4E>(v); v += dpp_f<0x141>(v); v += dpp_f<0x140>(v);
    { const auto r = __builtin_amdgcn_permlane16_swap(__float_as_uint(v), __float_as_uint(v), false, false); v = __uint_as_float(r[0]) + __uint_as_float(r[1]); }
    return v;
}
__device__ __forceinline__ float xhalf_sum(float v) {
    const auto r = __builtin_amdgcn_permlane32_swap(__float_as_uint(v), __float_as_uint(v), false, false); return __uint_as_float(r[0]) + __uint_as_float(r[1]);
}
__device__ __forceinline__ float wave_max(float v) {
    v = fmaxf(v, dpp_f<0xB1>(v)); v = fmaxf(v, dpp_f<0x4E>(v)); v = fmaxf(v, dpp_f<0x141>(v)); v = fmaxf(v, dpp_f<0x140>(v));
    { const auto r = __builtin_amdgcn_permlane16_swap(__float_as_uint(v), __float_as_uint(v), false, false); v = fmaxf(__uint_as_float(r[0]), __uint_as_float(r[1])); }
    { const auto r = __builtin_amdgcn_permlane32_swap(__float_as_uint(v), __float_as_uint(v), false, false); v = fmaxf(__uint_as_float(r[0]), __uint_as_float(r[1])); }
    return v;
}
__device__ __forceinline__ int crow(int r, int hi) { return (r & 3) + 8 * (r >> 2) + 4 * hi; }
__device__ __forceinline__ float silu_f(float x) { return x / (1.0f + __expf(-x)); }
__device__ __forceinline__ float sigmoid_f(float x) { return 1.0f / (1.0f + __expf(-x)); }
__device__ __forceinline__ int v_st(int k, int c) { const int kk = (k & ~0xC) | ((k & 4) << 1) | ((k & 8) >> 1); return ((kk >> 3) * 4 + (c >> 5)) * 512 + ((kk & 7) * 32 + (c & 31)) * 2; }
__device__ __forceinline__ int v_rd_base(int lane) { return ((lane & 3) << 3) | (((lane >> 2) & 3) << 6) | (((lane >> 4) & 1) << 5) | (((lane >> 5) & 1) << 8); }
__host__ __device__ constexpr int v_rd_off(int d0, int ks, int half) { return d0 * 512 + ks * 4096 + half * 2048; }
typedef short v4i16_t __attribute__((ext_vector_type(4)));
__device__ __forceinline__ bf16x8 vfrag(LAS unsigned char* tile_rd  , int d0, int ks) {
    const v4i16_t lo = __builtin_amdgcn_ds_read_tr16_b64_v4i16((LAS v4i16_t*)(tile_rd + v_rd_off(d0, ks, 0)));
    const v4i16_t hi = __builtin_amdgcn_ds_read_tr16_b64_v4i16((LAS v4i16_t*)(tile_rd + v_rd_off(d0, ks, 1)));
    return (bf16x8){lo[0], lo[1], lo[2], lo[3], hi[0], hi[1], hi[2], hi[3]};
}

struct Args { const float* in[35]; float* out; unsigned char* ws; int ph_lo, ph_hi; };

struct Frame { LAS unsigned char* lds; int tid, lane, wave, G, bx, kz; };
#define CAS __attribute__((address_space(4)))
__device__ __forceinline__ const float* kin_(int kz, int i) { return *(const float* const CAS*)((const CAS char*)__builtin_amdgcn_kernarg_segment_ptr() + kz + 8 * i); }
#define KIN(F, i) kin_((F).kz, (i))
#define KOUT(F) ((float*)kin_((F).kz, 35))
#define KWS(F) ((unsigned char*)kin_((F).kz, 36))
static_assert(sizeof(Args) == 37 * 8 + 8, "Args layout");

__device__ __forceinline__ void ph0_mod_tables(Frame& F) {
    const float* c = KIN(F, 1); const float* cctx = KIN(F, 3); const float* wmod = KIN(F, 4);
    LAS float* sv = (LAS float*)F.lds;
    for (int vb = F.bx; vb < 256; vb += F.G) {
    const int l = vb >> 7, rem = vb & 127, nch = rem & 7, kch = rem >> 3, k0 = kch * 64;
    if (F.tid < 192) { const int v = F.tid >> 6, k = F.tid & 63; const float x = (v < 2) ? c[v * DM + k0 + k] : cctx[k0 + k]; sv[v * 64 + k] = silu_f(x); }
    __syncthreads();
    if (F.tid < 384) {
        const int col = nch * 768 + F.tid * 2;
        const float* W = wmod + ((size_t)l * DM + k0) * 6144 + col;
        f32x2 a0 = {0.f, 0.f}, a1 = {0.f, 0.f}, a2 = {0.f, 0.f};
#pragma unroll 8
        for (int k = 0; k < 64; ++k) { const f32x2 w = *(const f32x2*)(W + (size_t)k * 6144); a0 += w * sv[k]; a1 += w * sv[64 + k]; a2 += w * sv[128 + k]; }
        float* mp = (float*)(KWS(F) + WS_MODP) + (size_t)kch * 5 * 6144 + col;
        if (l == 0) { *(f32x2*)(mp + 0 * 6144) = a0; *(f32x2*)(mp + 1 * 6144) = a1; *(f32x2*)(mp + 2 * 6144) = a2; }
        else { *(f32x2*)(mp + 3 * 6144) = a0; *(f32x2*)(mp + 4 * 6144) = a1; }
    }
    __syncthreads();
    }
    const int bx = F.bx;
    unsigned char* tb = KWS(F) + WS_TAB;
    const int gid = bx * NTHR + F.tid, NG = F.G * NTHR;
    const float s128 = 0.08838834764831845f;
    for (int i = gid; i < 5120; i += NG) {
        const int pos = i >> 4, f = i & 15; const int p = pos < 256 ? pos : pos - 256;
        const float inv = powf(10000.0f, -((float)f / 16.0f)); const float ang = (float)p * inv;
        ((float*)(tb + TB_COS))[i] = (float)cos((double)ang); ((float*)(tb + TB_SIN))[i] = (float)sin((double)ang);
    }
    for (int i = gid; i < 32768; i += NG) {
        const int j8 = i & 7, ln = (i >> 3) & 63, ks = (i >> 9) & 7, nb = i >> 12;
        const int n = 32 * nb + (ln & 31), cc = 16 * ks + 8 * (ln >> 5) + j8, part = n >> 7, jj = n & 127, m = (jj * cc) & 127;
        const double a = (double)m / 64.0; const float v = (part == 0 ? (float)cospi(a) : -(float)sinpi(a)) * s128;
        ((bf16_t*)(tb + TB_CS))[i] = (bf16_t)f2bf(v);
    }
    for (int i = gid; i < 65536; i += NG) {
        const int j8 = i & 7, ln = (i >> 3) & 63, ks = (i >> 9) & 15, mb = i >> 13;
        const int m = 32 * mb + (ln & 31), k = 16 * ks + 8 * (ln >> 5) + j8, mpart = m >> 7, k1 = m & 127, part = k >> 7, t1 = k & 127, ph = (k1 * t1) & 127;
        const double a = (double)ph / 64.0; const float cs = (float)cospi(a), sn = (float)sinpi(a);
        const float v = (mpart == 0 ? (part == 0 ? cs : sn) : (part == 0 ? -sn : cs)) * s128;
        ((bf16_t*)(tb + TB_AF))[i] = (bf16_t)f2bf(v);
    }
    for (int i = gid; i < 32768; i += NG) {
        const int j8 = i & 7, ln = (i >> 3) & 63, ks = (i >> 9) & 15, mb = i >> 13;
        const int k2 = 32 * mb + (ln & 31), k = 16 * ks + 8 * (ln >> 5) + j8, part = k >> 7, t2 = k & 127, ps = (k2 * t2) & 127;
        const double a = (double)ps / 64.0; const float v = (part == 0 ? (float)cospi(a) : (float)sinpi(a)) * s128;
        ((bf16_t*)(tb + TB_A3))[i] = (bf16_t)f2bf(v);
    }
    for (int i = gid; i < 16384; i += NG) {
        const int t2 = i >> 7, k1 = i & 127; const double a = (double)((k1 * t2) & 16383) / 8192.0;
        ((f32x2*)(tb + TB_TW))[i] = (f32x2){(float)cospi(a), (float)sinpi(a)};
    }
    const float* gws = KIN(F, 25);
    for (int i = gid; i < 65536; i += NG) ((bf16_t*)(tb + TB_WS))[i] = (bf16_t)f2bf(gws[i]);
}

__device__ __forceinline__ void transpose_item(const float* W, int K, int ldw, int k0, int n_src0, bf16_t* WT, int row_dst0, LAS float* scr, int lane) {
#pragma unroll 8
    for (int i = 0; i < 32; ++i) { const int kk = 2 * i + (lane >> 5); scr[kk * 33 + (lane & 31)] = W[(size_t)(k0 + kk) * ldw + n_src0 + (lane & 31)]; }
    asm volatile("s_waitcnt lgkmcnt(0)" ::: "memory");
    const int c = lane & 7;
#pragma unroll
    for (int j = 0; j < 4; ++j) { const int n = (lane >> 3) + 8 * j; const LAS float* s = scr + (8 * c) * 33 + n;
        u32x4 o; o.x = pk2(s[0 * 33], s[1 * 33]); o.y = pk2(s[2 * 33], s[3 * 33]); o.z = pk2(s[4 * 33], s[5 * 33]); o.w = pk2(s[6 * 33], s[7 * 33]);
        *(u32x4*)(WT + (size_t)(row_dst0 + n) * K + k0 + 8 * c) = o; }
    asm volatile("s_waitcnt lgkmcnt(0)" ::: "memory");
}
__device__ __forceinline__ void transpose_item_fp8(const float* W, int K, int ldw, int k0, int n_src0, unsigned char* WT8, int row_dst0, float scale, LAS float* scr, int lane) {
#pragma unroll 8
    for (int i = 0; i < 64; ++i) { const int kk = 2 * i + (lane >> 5); scr[kk * 33 + (lane & 31)] = W[(size_t)(k0 + kk) * ldw + n_src0 + (lane & 31)]; }
    asm volatile("s_waitcnt lgkmcnt(0)" ::: "memory");
    const int q = lane & 3;
#pragma unroll
    for (int j = 0; j < 2; ++j) { const int n = (lane >> 2) + 16 * j; const LAS float* s = scr + (32 * q) * 33 + n; unsigned w[8];
#pragma unroll
        for (int t = 0; t < 8; ++t) w[t] = pk4_fp8(s[(4 * t) * 33] * scale, s[(4 * t + 1) * 33] * scale, s[(4 * t + 2) * 33] * scale, s[(4 * t + 3) * 33] * scale);
        unsigned char* dst = WT8 + (size_t)(row_dst0 + n) * K + k0 + 32 * q;
        *(u32x4*)dst = (u32x4){w[0], w[1], w[2], w[3]}; *(u32x4*)(dst + 16) = (u32x4){w[4], w[5], w[6], w[7]}; }
    asm volatile("s_waitcnt lgkmcnt(0)" ::: "memory");
}
__device__ __forceinline__ void ph1_convert(Frame& F) {
    {
        const int gid = F.bx * NTHR + F.tid;
        if (gid < 5 * 6144) { const int vec = gid / 6144, n = gid % 6144, l = vec < 3 ? 0 : 1; float s = KIN(F, 5)[l * 6144 + n];
            const float* mp = (const float*)(KWS(F) + WS_MODP) + (size_t)vec * 6144 + n;
#pragma unroll
            for (int kc = 0; kc < 16; ++kc) s += mp[(size_t)kc * 5 * 6144];
            ((float*)(KWS(F) + WS_MOD))[gid] = s; }
    }
    LAS float* scr = (LAS float*)(F.lds + F.wave * 16896);
    const int gw = F.bx * NWAVES + F.wave, NGW = F.G * NWAVES;
    constexpr int I_EVIN = 16 * 80, I_EVOUT = 16 * 32, I_ODIN = 16 * 48, I_ODOUT = 16 * 32, I_DENSE = I_EVIN + I_EVOUT + I_ODIN + I_ODOUT;
    constexpr int I_GU = 64 * 512, I_DN = 64 * 256, NITEMS = I_DENSE + I_GU + I_DN;
    for (int it = gw; it < NITEMS; it += NGW) {
        int r = it;
        if (r < I_EVIN) { const int kb = r / 80, nb = r % 80, n0 = 32 * nb; int src = n0;
            if (n0 >= 1536) { const int u = (n0 - 1536) >> 8, w = (n0 - 1536) & 255; src = (w < 128) ? 1536 + 128 * u + w : 2048 + 128 * u + (w - 128); }
            transpose_item(KIN(F, 10), DM, 2560, 64 * kb, src, (bf16_t*)(KWS(F) + WS_WEVIN), n0, scr, F.lane); continue; } r -= I_EVIN;
        if (r < I_EVOUT) { const int kb = r / 32, nb = r % 32; transpose_item(KIN(F, 11), DM, 1024, 64 * kb, 32 * nb, (bf16_t*)(KWS(F) + WS_WEVOUT), 32 * nb, scr, F.lane); continue; } r -= I_EVOUT;
        if (r < I_ODIN) { const int kb = r / 48, nb = r % 48; transpose_item(KIN(F, 21), DM, 1536, 64 * kb, 32 * nb, (bf16_t*)(KWS(F) + WS_WODIN), 32 * nb, scr, F.lane); continue; } r -= I_ODIN;
        if (r < I_ODOUT) { const int kb = r / 32, nb = r % 32; transpose_item(KIN(F, 22), DM, 1024, 64 * kb, 32 * nb, (bf16_t*)(KWS(F) + WS_WODOUT), 32 * nb, scr, F.lane); continue; } r -= I_ODOUT;
        if (r < I_GU) { const int le = r >> 9, q = r & 511, kb = q >> 6, nb = q & 63, n0 = 32 * nb; const int u = n0 >> 8, w = n0 & 255;
            const int src = (w < 128) ? 128 * u + w : 1024 + 128 * u + (w - 128);
            transpose_item_fp8(KIN(F, 31) + (size_t)le * DM * 2048, DM, 2048, 128 * kb, src, (unsigned char*)(KWS(F) + WS_WGU) + (size_t)le * 2048 * DM, n0, WGU_SCALE, scr, F.lane); continue; } r -= I_GU;
        { const int le = r >> 8, q = r & 255, kb = q >> 5, nb = q & 31;
            transpose_item_fp8(KIN(F, 33) + (size_t)le * DM * 1024, DM, 1024, 128 * kb, 32 * nb, (unsigned char*)(KWS(F) + WS_WD) + (size_t)le * 1024 * DM, 32 * nb, WD_SCALE, scr, F.lane); }
    }
}

__device__ __forceinline__ void mod_row(const float* xrow, const float* sh, const float* sc, bf16_t* orow, int lane) {
    f32x4 x[4], a[4], b[4];
#pragma unroll
    for (int j = 0; j < 4; ++j) { const int d = 4 * lane + 256 * j; x[j] = *(const f32x4*)(xrow + d); a[j] = *(const f32x4*)(sc + d); b[j] = *(const f32x4*)(sh + d); }
    asm volatile("" ::: "memory");
#pragma unroll
    for (int j = 0; j < 4; ++j) { const int d = 4 * lane + 256 * j;
        const f32x4 v = x[j] * (a[j] + 1.0f) + b[j]; u32x2 w; w.x = pk2(v[0], v[1]); w.y = pk2(v[2], v[3]); *(u32x2*)(orow + d) = w; }
}
__device__ __forceinline__ void ph2_modulate(Frame& F) {
    const float* mod = (const float*)(KWS(F) + WS_MOD); bf16_t* U = (bf16_t*)(KWS(F) + WS_U);
    const int gw = F.bx * NWAVES + F.wave, NGW = F.G * NWAVES;
    for (int r = gw; r < T + NCTX; r += NGW) {
        if (r < T) { const int b = r >> 14; mod_row(KIN(F, 0) + (size_t)r * DM, mod + b * 6144, mod + b * 6144 + 1024, U + (size_t)r * DM, F.lane); }
        else { mod_row(KIN(F, 2) + (size_t)(r - T) * DM, mod + 2 * 6144, mod + 2 * 6144 + 1024, U + (size_t)r * DM, F.lane); }
    }
}

struct EvInOrder {
    pg8::StaticOrder so;
    __device__ bool next(int i, pg8::Unit& u) const {
        const long L = (long)i * so.G + so.c;
        if (L < so.nwg) return so.map(L, u);
        const int x = (int)(L - so.nwg); if (x >= 8) return false;
        u.pm = 128 + (x >> 2); u.pn = 2 + (x & 3); u.a0 = 0; u.a1 = 0; u.a2 = 256; return true;
    }
    __device__ __forceinline__ unsigned arow(const pg8::Unit&, int) const { return 0u; }
};
__device__ __forceinline__ int vpos64(int k) { return 32 * ((k >> 2) & 1) + 16 * (k >> 5) + ((k & 3) + 4 * ((k & 31) >> 3)); }
struct EpiEvIn {
    static constexpr bool PERM = false, HAS_PRE = false;
    unsigned char *Q8, *K8, *V8T; bf16_t* Ab; const float* cosT; const float* sinT;
    __device__ __forceinline__ void operator()(const f32x4 (&acc)[2][2][4][2], const pg8::Unit& u, int wr, int wc, int fr, int fq) const {
        const int pn = u.pn;
        if (pn < 6) {
            const int kind = pn >> 1, colbase = (pn & 1) * 256 + wc * 32 + 4 * fq;
#pragma unroll
            for (int ai = 0; ai < 2; ++ai)
#pragma unroll
                for (int m = 0; m < 4; ++m) {
                    const int row = u.pm * 256 + ai * 128 + wr * 64 + m * 16 + fr; const bool isctx = row >= T;
                    int t, b, key;
                    if (!isctx) { b = row >> 14; t = row & (SEQ - 1); key = t; } else { const int rc = row - T; t = 0; b = rc >> 8; key = SEQ + (rc & 255); }
                    if (kind == 0 && isctx) continue;
                    if (kind < 2) {
                        f32x4 cs = {1.f, 1.f, 1.f, 1.f}, sn = {0.f, 0.f, 0.f, 0.f};
                        if (!isctx) { const int pos = (wc & 1) ? 256 + (t & 63) : (t >> 6); cs = *(const f32x4*)(cosT + pos * 16 + 4 * fq); sn = *(const f32x4*)(sinT + pos * 16 + 4 * fq); }
                        unsigned char* dst = (kind == 0) ? Q8 + (size_t)row * 512 : K8 + (size_t)(b * NKEY + key) * 512;
                        const float sc = (kind == 0) ? QSCALE : 1.0f;
#pragma unroll
                        for (int bj = 0; bj < 2; ++bj) {
                            const f32x4 x1 = acc[ai][bj][m][0], x2 = acc[ai][bj][m][1];
                            const f32x4 o1 = (x1 * cs - x2 * sn) * sc, o2 = (x1 * sn + x2 * cs) * sc;
                            *(unsigned*)(dst + colbase + bj * 128) = pk4_fp8(o1[0], o1[1], o1[2], o1[3]); *(unsigned*)(dst + colbase + bj * 128 + 16) = pk4_fp8(o2[0], o2[1], o2[2], o2[3]);
                        }
                    } else {
                        const size_t kofs = (size_t)(key & ~63) + vpos64(key & 63);
#pragma unroll
                        for (int bj = 0; bj < 2; ++bj)
#pragma unroll
                            for (int n = 0; n < 2; ++n) { const f32x4 x = acc[ai][bj][m][n]; const unsigned w = pk4_fp8(x[0], x[1], x[2], x[3]); const int vcol = colbase + bj * 128 + n * 16;
                                unsigned char* dst = V8T + ((size_t)(b * 4 + (vcol >> 7)) * 128 + (vcol & 127)) * NKEY + kofs;
                                dst[0] = (unsigned char)(w & 0xff); dst[NKEY] = (unsigned char)((w >> 8) & 0xff); dst[2 * NKEY] = (unsigned char)((w >> 16) & 0xff); dst[3 * NKEY] = (unsigned char)(w >> 24); }
                    }
                }
        } else {
            const int colbase = (pn - 6) * 128 + wc * 32 + 4 * fq;
#pragma unroll
            for (int ai = 0; ai < 2; ++ai)
#pragma unroll
                for (int m = 0; m < 4; ++m) {
                    const int row = u.pm * 256 + ai * 128 + wr * 64 + m * 16 + fr; if (row >= T) continue;
                    bf16_t* dst = Ab + (size_t)row * 512 + colbase;
#pragma unroll
                    for (int n = 0; n < 2; ++n) { const f32x4 v = acc[ai][0][m][n], g = acc[ai][1][m][n]; f32x4 o;
#pragma unroll
                        for (int j = 0; j < 4; ++j) o[j] = v[j] * sigmoid_f(g[j]);
                        u32x2 w; w.x = pk2(o[0], o[1]); w.y = pk2(o[2], o[3]); *(u32x2*)(dst + n * 16) = w; }
                }
        }
    }
};

__device__ __forceinline__ void ph4_conv(Frame& F) {
    const bf16_t* Ab = (const bf16_t*)(KWS(F) + WS_AB); bf16_t* MIX = (bf16_t*)(KWS(F) + WS_MIX);
    const float* cw = KIN(F, 12); const float* cb = KIN(F, 13); const float* lg = KIN(F, 14); const float* lb = KIN(F, 15);
    LAS bf16_t* At = (LAS bf16_t*)F.lds;
    LAS float* Yt = (LAS float*)(F.lds + 65536);
    const int ch = F.tid;
    float w[31];
#pragma unroll
    for (int j = 0; j < 31; ++j) w[j] = cw[j * 512 + ch];
    const float bias = cb[ch];
#define CONV_STAGE(tile_) do { const int b_ = (tile_) >> 9, t0_ = ((tile_) & 511) * 32; \
        _Pragma("unroll") for (int k_ = 0; k_ < 8; ++k_) { const int row_ = F.wave + 8 * k_; if (row_ < 62) { const int t_ = t0_ - 15 + row_; \
            if (t_ >= 0 && t_ < SEQ) __builtin_amdgcn_global_load_lds((const unsigned*)(Ab + ((size_t)(b_ * SEQ + t_)) * 512 + F.lane * 8), (LAS unsigned*)(At + row_ * 512), 16, 0, 0); \
            else { const unsigned z_ = (unsigned)F.kz; const u32x4 zv_ = {z_, z_, z_, z_}; *(LAS u32x4*)(At + row_ * 512 + F.lane * 8) = zv_; } } } } while (0)
    const f32x4 g0 = *(const f32x4*)(lg + 8 * F.lane), g1 = *(const f32x4*)(lg + 8 * F.lane + 4), b0 = *(const f32x4*)(lb + 8 * F.lane), b1 = *(const f32x4*)(lb + 8 * F.lane + 4);
    if (F.bx < T / 32) CONV_STAGE(F.bx);
    for (int tile = F.bx; tile < T / 32; tile += F.G) {
        const int b = tile >> 9, t0 = (tile & 511) * 32;
        asm volatile("s_waitcnt vmcnt(0)" ::: "memory");
        __syncthreads();
        float a[62];
#pragma unroll
        for (int r = 0; r < 62; ++r) a[r] = bf2f(At[r * 512 + ch]);
#pragma unroll
        for (int t = 0; t < 32; ++t) { float y = bias;
#pragma unroll
            for (int j = 0; j < 31; ++j) y = fmaf(a[t + j], w[j], y);
            Yt[t * 512 + ch] = y; }
        __syncthreads();
        if (tile + F.G < T / 32) CONV_STAGE(tile + F.G);
#pragma unroll
        for (int q = 0; q < 4; ++q) { const int t = F.wave * 4 + q; const LAS float* yr = Yt + t * 512 + 8 * F.lane;
            const f32x4 y0 = *(const LAS f32x4*)yr, y1 = *(const LAS f32x4*)(yr + 4);
            float s = (y0[0] + y0[1]) + (y0[2] + y0[3]) + (y1[0] + y1[1]) + (y1[2] + y1[3]);
            const float mean = wave_sum(s) * (1.0f / 512.0f);
            const f32x4 d0 = y0 - mean, d1 = y1 - mean;
            float q2 = (d0[0] * d0[0] + d0[1] * d0[1]) + (d0[2] * d0[2] + d0[3] * d0[3]) + (d1[0] * d1[0] + d1[1] * d1[1]) + (d1[2] * d1[2] + d1[3] * d1[3]);
            const float rstd = 1.0f / sqrtf(wave_sum(q2) * (1.0f / 512.0f) + LN_EPS);
            f32x4 o0 = d0 * rstd * g0 + b0, o1 = d1 * rstd * g1 + b1;
#pragma unroll
            for (int j = 0; j < 4; ++j) { o0[j] = silu_f(o0[j]); o1[j] = silu_f(o1[j]); }
            u32x4 wv; wv.x = pk2(o0[0], o0[1]); wv.y = pk2(o0[2], o0[3]); wv.z = pk2(o1[0], o1[1]); wv.w = pk2(o1[2], o1[3]);
            *(u32x4*)(MIX + (size_t)(b * SEQ + t0 + t) * 1024 + 8 * F.lane) = wv; }
        __syncthreads();
    }
#undef CONV_STAGE
}

namespace att {
constexpr int KVBLK = 64;
constexpr int SHM_V = 128 * 64, SHM_K = 64 * 64;
constexpr int SHM_1 = 32 * 64;
constexpr int NBUF = 5, DIST = 3, TILEB = SHM_V + SHM_1 + SHM_K;
constexpr int OFF_T = 0, OFF_WS = NBUF * TILEB;
constexpr int OFF_NEG = OFF_WS + 2048;
constexpr float PREF = 6.0f, PMAXLOG = 8.0f;
#define SBAR() __builtin_amdgcn_sched_barrier(0)
#define MX3(a, b, c) __builtin_fmaxf(__builtin_fmaxf((a), (b)), (c))
typedef int v8i32a __attribute__((ext_vector_type(8)));
__device__ __forceinline__ f32x16 mfma8(v8i32a a, v8i32a b, f32x16 c) { return __builtin_amdgcn_mfma_scale_f32_32x32x64_f8f6f4(a, b, c, 0, 0, 0, 0x7F7F7F7F, 0, 0x7F7F7F7F); }
template <bool FIRST> __device__ __forceinline__ void partialSM(f32x16& p0, f32x16& p1, f32x16& negm, float& alpha) {
    float a = MX3(p0[0], p0[1], p1[0]), b = MX3(p0[2], p0[3], p1[1]); a = MX3(a, p1[2], p1[3]);
#pragma unroll
    for (int r = 4; r < 16; r += 4) { a = MX3(a, p0[r], p0[r + 1]); b = MX3(b, p0[r + 2], p0[r + 3]); a = MX3(a, p1[r], p1[r + 1]); b = MX3(b, p1[r + 2], p1[r + 3]); }
    float pmax = fmaxf(a, b);
    { auto rr = __builtin_amdgcn_permlane32_swap(__float_as_uint(pmax), __float_as_uint(pmax), false, false);
      pmax = fmaxf(__uint_as_float(rr[0]), __uint_as_float(rr[1])); }
    alpha = 1.f;
    if (FIRST || __builtin_expect(__any(pmax > PMAXLOG), 0)) {
        const float dl = FIRST ? (pmax - PREF) : fmaxf(pmax - PREF, 0.f); const float nm = negm[0] - dl; alpha = __builtin_amdgcn_exp2f(-dl);
#pragma unroll
        for (int r = 0; r < 16; ++r) { p0[r] -= dl; p1[r] -= dl; negm[r] = nm; }
    }
#pragma unroll
    for (int r = 0; r < 16; ++r) p0[r] = __builtin_amdgcn_exp2f(p0[r]);
}
__device__ __forceinline__ void finishSM(f32x16& p0, f32x16& p1, v8i32a& pf) {
#pragma unroll
    for (int r = 0; r < 16; ++r) p1[r] = __builtin_amdgcn_exp2f(p1[r]);
#pragma unroll
    for (int i = 0; i < 4; ++i) { pf[i] = (int)pk4_fp8(p0[4 * i], p0[4 * i + 1], p0[4 * i + 2], p0[4 * i + 3]); pf[4 + i] = (int)pk4_fp8(p1[4 * i], p1[4 * i + 1], p1[4 * i + 2], p1[4 * i + 3]); }
}
__device__ __forceinline__ v8i32a frag32(const LAS unsigned char* base, int a0, int a1) {
    const bf16x8 lo = *(const LAS bf16x8*)(base + a0), hi = *(const LAS bf16x8*)(base + a1);
    return __builtin_bit_cast(v8i32a, __builtin_shufflevector(lo, hi, 0, 1, 2, 3, 4, 5, 6, 7, 8, 9, 10, 11, 12, 13, 14, 15));
}
__device__ __forceinline__ void attn_pass(const unsigned char* __restrict__ Qw, const unsigned char* __restrict__ Kh, const unsigned char* __restrict__ Vt, LAS unsigned char* lds, f32x16 (&o)[4], f32x16& lacc, const int tid, const int wid) {
    const int lane = tid & 63, r32 = lane & 31, hi = lane >> 5;
    LAS float* al_l = (LAS float*)(lds + OFF_WS) + wid * 64 + 32;
    f32x16 negm = f32x16{}; lacc = f32x16{};
#pragma unroll
    for (int d = 0; d < 4; ++d) o[d] = f32x16{};
    const v8i32a qf = __builtin_bit_cast(v8i32a, __builtin_shufflevector(*(const bf16x8*)Qw, *(const bf16x8*)(Qw + 16), 0, 1, 2, 3, 4, 5, 6, 7, 8, 9, 10, 11, 12, 13, 14, 15));
    const int sw = (r32 >> 2) & 3, a0 = r32 * 64 + (((2 * hi) ^ sw) << 4), a1 = r32 * 64 + (((2 * hi + 1) ^ sw) << 4);
    const int drow = 16 * wid + (lane >> 2), dch = (lane & 3) ^ ((drow >> 2) & 3);
    const unsigned vsrc = (unsigned)(drow * NKEY + dch * 16), ksrc = (unsigned)(drow * 512 + dch * 16); const bool kw = wid < 4;
    LAS unsigned char* T_lds = lds + OFF_T;
#define DMA(t, bi) do { __builtin_amdgcn_global_load_lds((const unsigned*)((const char*)Vt + (size_t)(t) * 64 + vsrc), (LAS unsigned*)(T_lds + (bi) * TILEB + wid * 1024), 16, 0, 0); \
    if (kw) __builtin_amdgcn_global_load_lds((const unsigned*)((const char*)Kh + (size_t)(t) * (64 * 512) + ksrc), (LAS unsigned*)(T_lds + (bi) * TILEB + SHM_V + SHM_1 + wid * 1024), 16, 0, 0); } while (0)
#define WAITBAR(n) do { if (kw) asm volatile("s_waitcnt vmcnt(%0) lgkmcnt(0)" :: "n"(2 * (n)) : "memory"); else asm volatile("s_waitcnt vmcnt(%0) lgkmcnt(0)" :: "n"(n) : "memory"); \
    __builtin_amdgcn_s_barrier(); asm volatile("" ::: "memory"); } while (0)
#define RESC(a) do { if (__any((a) < 1.f)) { if (hi == 0) al_l[r32] = (a); asm volatile("s_waitcnt lgkmcnt(0)" ::: "memory"); \
    _Pragma("unroll") for (int r = 0; r < 16; ++r) { const float f_ = al_l[crow(r, hi)]; o[0][r] *= f_; o[1][r] *= f_; o[2][r] *= f_; o[3][r] *= f_; lacc[r] *= f_; } } } while (0)
#define QKT(P0, P1, bi) do { const LAS unsigned char* kb_ = T_lds + (bi) * TILEB + SHM_V + SHM_1; P0 = mfma8(frag32(kb_, a0, a1), qf, negm); P1 = mfma8(frag32(kb_ + 2048, a0, a1), qf, negm); } while (0)
#ifndef MF8_ACC
#define MF8_ACC "+v"
#endif
#define MF8(acc_, v_) asm volatile("v_mfma_scale_f32_32x32x64_f8f6f4 %0, %1, %2, %0, %3, %3 op_sel_hi:[0,0,0]" : MF8_ACC(acc_) : "v"(pf), "v"(v_), "v"(one_sc))
#define PV(bi) do { const LAS unsigned char* vb_ = T_lds + (bi) * TILEB; { const v8i32a v0_ = frag32(vb_, a0, a1), v1_ = frag32(vb_ + 2048, a0, a1); asm volatile("s_nop 1" ::: ); MF8(o[0], v0_); MF8(o[1], v1_); } \
    { const v8i32a v2_ = frag32(vb_ + 4096, a0, a1), v3_ = frag32(vb_ + 6144, a0, a1); MF8(o[2], v2_); MF8(o[3], v3_); } \
    { const v8i32a v4_ = frag32(vb_ + 8192, a0, a1); MF8(lacc, v4_); } } while (0)
    f32x16 pA0, pA1, pB0, pB1; v8i32a pf; constexpr int NT = NKEY / KVBLK;
    const int one_sc = 0x7F7F7F7F;
#define MFQK(P_, kf_) P_ = mfma8(kf_, qf, negm)
#define EX8(P_, b_) do { _Pragma("unroll") for (int r_ = 0; r_ < 8; ++r_) P_[(b_) + r_] = __builtin_amdgcn_exp2f(P_[(b_) + r_]); } while (0)
#if defined(EXP_EXTRA_MFMA)
#define XMF() do { const v8i32a vn_ = frag32(lds + OFF_NEG, a0, a1); MF8(lacc, vn_); MF8(lacc, v4_); } while (0)
#else
#define XMF() do { } while (0)
#endif
#if defined(EXP_EXTRA_LDS)
#define XTRA(A_, B_) do { _Pragma("unroll") for (int r_ = 0; r_ < 5; ++r_) { const v8i32a t_ = frag32(vb_ + 2048 * r_, a0, a1); asm volatile("" :: "v"(t_)); } } while (0)
#elif defined(EXP_EXTRA_EXP)
#define XTRA(A_, B_) do { _Pragma("unroll") for (int r_ = 0; r_ < 16; ++r_) { float t_; asm volatile("v_exp_f32 %0, %1" : "=v"(t_) : "v"(A_[r_])); asm volatile("v_exp_f32 %0, %1" : "=v"(t_) : "v"(B_[r_])); } } while (0)
#elif defined(EXP_EXTRA_ADD)
#define XTRA(A_, B_) do { _Pragma("unroll") for (int r_ = 0; r_ < 16; ++r_) { float t_; asm volatile("v_add_f32 %0, %1, %1" : "=v"(t_) : "v"(A_[r_])); asm volatile("v_add_f32 %0, %1, %1" : "=v"(t_) : "v"(B_[r_])); } } while (0)
#else
#define XTRA(A_, B_) do { } while (0)
#endif
#define STEP(C0, C1, P0, P1, HAVEPREV, FIRSTT, tnext, dodma) do { \
    if (dodma) DMA(tnext, bd); \
    const LAS unsigned char* kb_ = T_lds + bc * TILEB + SHM_V + SHM_1; const LAS unsigned char* vb_ = T_lds + bp * TILEB; \
    const v8i32a kf0_ = frag32(kb_, a0, a1), kf1_ = frag32(kb_ + 2048, a0, a1); v8i32a v0_, v1_, v2_, v3_, v4_; if (HAVEPREV) { v0_ = frag32(vb_, a0, a1); v1_ = frag32(vb_ + 2048, a0, a1); } \
    SBAR(); MFQK(C0, kf0_); if (HAVEPREV) EX8(P1, 0); SBAR(); \
    MFQK(C1, kf1_); if (HAVEPREV) { EX8(P1, 8); _Pragma("unroll") for (int i_ = 0; i_ < 4; ++i_) { pf[i_] = (int)pk4_fp8(P0[4 * i_], P0[4 * i_ + 1], P0[4 * i_ + 2], P0[4 * i_ + 3]); pf[4 + i_] = (int)pk4_fp8(P1[4 * i_], P1[4 * i_ + 1], P1[4 * i_ + 2], P1[4 * i_ + 3]); } } SBAR(); \
    float al_ = 1.f; \
    if (HAVEPREV) { asm volatile("s_nop 1" ::: ); MF8(o[0], v0_); SBAR(); MF8(o[1], v1_); v2_ = frag32(vb_ + 4096, a0, a1); v3_ = frag32(vb_ + 6144, a0, a1); v4_ = frag32(vb_ + 8192, a0, a1); SBAR(); } \
    else { asm volatile("s_nop 15\n\ts_nop 15\n\ts_nop 15\n\ts_nop 15" ::: "memory"); }     \
    float mxa_ = MX3(C0[0], C0[1], C1[0]), mxb_ = MX3(C0[2], C0[3], C1[1]); mxa_ = MX3(mxa_, C1[2], C1[3]); \
    _Pragma("unroll") for (int r_ = 4; r_ < 16; r_ += 4) { mxa_ = MX3(mxa_, C0[r_], C0[r_ + 1]); mxb_ = MX3(mxb_, C0[r_ + 2], C0[r_ + 3]); mxa_ = MX3(mxa_, C1[r_], C1[r_ + 1]); mxb_ = MX3(mxb_, C1[r_ + 2], C1[r_ + 3]); } \
    float pm_ = fmaxf(mxa_, mxb_); { auto rr_ = __builtin_amdgcn_permlane32_swap(__float_as_uint(pm_), __float_as_uint(pm_), false, false); pm_ = fmaxf(__uint_as_float(rr_[0]), __uint_as_float(rr_[1])); } \
    SBAR(); \
    if (HAVEPREV) { MF8(o[2], v2_); SBAR(); MF8(o[3], v3_); SBAR(); } \
    if (FIRSTT || __builtin_expect(__any(pm_ > PMAXLOG), 0)) { const float dl_ = FIRSTT ? (pm_ - PREF) : fmaxf(pm_ - PREF, 0.f); const float nm_ = negm[0] - dl_; al_ = __builtin_amdgcn_exp2f(-dl_); \
        _Pragma("unroll") for (int r_ = 0; r_ < 16; ++r_) { C0[r_] -= dl_; C1[r_] -= dl_; negm[r_] = nm_; } } \
    SBAR(); \
    if (HAVEPREV) { MF8(lacc, v4_); XMF(); SBAR(); } \
    EX8(C0, 0); EX8(C0, 8); XTRA(C0, C1); SBAR(); \
    if (HAVEPREV) { if (__any(al_ < 1.f)) { asm volatile("s_nop 15\n\ts_nop 15" ::: "memory"); if (hi == 0) al_l[r32] = al_; asm volatile("s_waitcnt lgkmcnt(0)" ::: "memory"); \
        _Pragma("unroll") for (int r_ = 0; r_ < 16; ++r_) { const float f_ = al_l[crow(r_, hi)]; o[0][r_] *= f_; o[1][r_] *= f_; o[2][r_] *= f_; o[3][r_] *= f_; lacc[r_] *= f_; } } } \
    } while (0)
    int bp = 4, bc = 0, bd = 3;
#define ROT() do { bp = bc; bc = (bc == NBUF - 1) ? 0 : bc + 1; bd = (bd == NBUF - 1) ? 0 : bd + 1; } while (0)
#ifdef EXP_EXTRA_BAR
#define XBAR() do { __builtin_amdgcn_s_barrier(); asm volatile("" ::: "memory"); } while (0)
#else
#define XBAR() do { } while (0)
#endif
    DMA(0, 0); DMA(1, 1); DMA(2, 2); WAITBAR(2);
    STEP(pA0, pA1, pB0, pB1, false, true, 3, true); WAITBAR(2); ROT();
#pragma unroll 1
    for (int j = 1; j + 1 < NT; j += 2) {
        const bool more = (j + 4 < NT);
        STEP(pB0, pB1, pA0, pA1, true, false, j + 3, more); if (more) WAITBAR(2); else WAITBAR(0); XBAR(); ROT();
        STEP(pA0, pA1, pB0, pB1, true, false, j + 4, more); if (more) WAITBAR(2); else WAITBAR(0); XBAR(); ROT();
    }
    STEP(pB0, pB1, pA0, pA1, true, false, 0, false); WAITBAR(0); ROT();
    { EX8(pB1, 0); EX8(pB1, 8);
#pragma unroll
      for (int i_ = 0; i_ < 4; ++i_) { pf[i_] = (int)pk4_fp8(pB0[4 * i_], pB0[4 * i_ + 1], pB0[4 * i_ + 2], pB0[4 * i_ + 3]); pf[4 + i_] = (int)pk4_fp8(pB1[4 * i_], pB1[4 * i_ + 1], pB1[4 * i_ + 2], pB1[4 * i_ + 3]); }
      SBAR(); PV(bp); }
#undef STEP
#undef MFQK
#undef EX8
    __syncthreads();
#undef ROT
#undef DMA
#undef WAITBAR
#undef RESC
#undef QKT
#undef PV
#undef MF8
}
}

__device__ __forceinline__ void ph4_attention(Frame& F) {
    const unsigned char* Q8 = (const unsigned char*)(KWS(F) + WS_Q); const unsigned char* K8 = (const unsigned char*)(KWS(F) + WS_K); const unsigned char* V8T = (const unsigned char*)(KWS(F) + WS_V);
    float* O0 = (float*)(KWS(F) + WS_O0); bf16_t* MIX = (bf16_t*)(KWS(F) + WS_MIX); const float* gn = KIN(F, 20);
    const int lane = F.lane, wid = F.wave;
    float lam;
    { const float a = wave_sum(KIN(F, 16)[lane] * KIN(F, 17)[lane]), b = wave_sum(KIN(F, 18)[lane] * KIN(F, 19)[lane]); lam = __builtin_bit_cast(float, __builtin_amdgcn_readfirstlane(__builtin_bit_cast(int, __expf(a) - __expf(b) + LAM_INIT0))); }
    __syncthreads();
    const unsigned kz_ = (unsigned)F.kz;
    for (int i = F.tid; i < att::NBUF * (att::SHM_1 / 16); i += NTHR) { const int bi = i / (att::SHM_1 / 16), q = i % (att::SHM_1 / 16);
        *(LAS u32x4*)(F.lds + att::OFF_T + bi * att::TILEB + att::SHM_V + q * 16) = (u32x4){0x38383838u + kz_, 0x38383838u + kz_, 0x38383838u + kz_, 0x38383838u + kz_}; }
#if defined(EXP_EXTRA_MFMA)
    for (int i = F.tid; i < 128; i += NTHR) *(LAS u32x4*)(F.lds + att::OFF_NEG + i * 16) = (u32x4){0xB8B8B8B8u + kz_, 0xB8B8B8B8u + kz_, 0xB8B8B8B8u + kz_, 0xB8B8B8B8u + kz_};
#endif
    __syncthreads();
    const int x = F.bx & 7, jb = F.bx >> 3;
    for (int vb = x; vb < 8; vb += 8) { const int b = vb >> 2, h = vb & 3;
    for (int qb = jb; qb < SEQ / 256; qb += (F.G >> 3)) {
        const long rowbase = (long)b * SEQ + qb * 256 + wid * 32;
        f32x16 o[4]; f32x16 lacc;
#pragma unroll 1
        for (int c = 0; c < 2; ++c) {
            const unsigned char* Qw = Q8 + (rowbase + (lane & 31)) * 512 + h * 128 + c * 64 + (lane >> 5) * 32;
            const unsigned char* Kh = K8 + (long)b * NKEY * 512 + h * 128 + c * 64;
            const unsigned char* Vt = V8T + (long)(b * 4 + h) * 128 * NKEY;
            att::attn_pass(Qw, Kh, Vt, F.lds, o, lacc, F.tid, F.wave);
            int lane_e = lane; asm volatile("" : "+v"(lane_e));
            const int r32 = lane_e & 31, hi = lane_e >> 5;
            asm volatile("s_nop 15\n\ts_nop 15" : "+v"(lacc));
            float rli[16];
#pragma unroll
            for (int r = 0; r < 16; ++r) rli[r] = __builtin_amdgcn_rcpf(lacc[r]);
            if (c == 0) {
#pragma unroll
                for (int r = 0; r < 16; ++r) { const long grow = rowbase + crow(r, hi);
#pragma unroll
                    for (int d0 = 0; d0 < 4; ++d0) O0[grow * 512 + h * 128 + d0 * 32 + r32] = o[d0][r] * rli[r]; }
            } else {
                const float g0 = gn[r32], g1 = gn[32 + r32], g2 = gn[64 + r32], g3 = gn[96 + r32];
                float ov[16][4];
#pragma unroll
                for (int r = 0; r < 16; ++r) { const float* op = O0 + (rowbase + crow(r, hi)) * 512 + h * 128 + r32; ov[r][0] = op[0]; ov[r][1] = op[32]; ov[r][2] = op[64]; ov[r][3] = op[96]; }
                asm volatile("" ::: "memory");
#pragma unroll
                for (int r = 0; r < 16; ++r) { const long grow = rowbase + crow(r, hi);
                    const float v0 = ov[r][0] - lam * (o[0][r] * rli[r]), v1 = ov[r][1] - lam * (o[1][r] * rli[r]), v2 = ov[r][2] - lam * (o[2][r] * rli[r]), v3 = ov[r][3] - lam * (o[3][r] * rli[r]);
                    float ss = (v0 * v0 + v1 * v1) + (v2 * v2 + v3 * v3);
                    ss = half_sum(ss);
                    const float scl = (1.0f - LAM_INIT0) / sqrtf(ss * (1.0f / 128.0f) + LN_EPS);
                    bf16_t* mp = MIX + grow * 1024 + 512 + h * 128 + r32;
                    mp[0] = (bf16_t)f2bf(v0 * scl * g0); mp[32] = (bf16_t)f2bf(v1 * scl * g1); mp[64] = (bf16_t)f2bf(v2 * scl * g2); mp[96] = (bf16_t)f2bf(v3 * scl * g3);
                    if ((r & 3) == 3) asm volatile("" ::: "memory"); }
            }
        }
    } }
}

__device__ __forceinline__ void ph_router(Frame& F, int layer, const float* hin) {
    const float* mod = (const float*)(KWS(F) + WS_MOD) + (size_t)(layer * 3) * 6144;
    const bf16_t* Y = (const bf16_t*)(KWS(F) + WS_Y); float* H1 = (float*)(KWS(F) + WS_H1); unsigned char* U2 = (unsigned char*)(KWS(F) + WS_U2);
    const float* lng = KIN(F, 6) + layer * DM; const float* lnb = KIN(F, 7) + layer * DM;
    const float* rw = KIN(F, 29) + (size_t)layer * DM * NE; const float* rb = KIN(F, 30) + layer * NE;
    unsigned* gcnt = (unsigned*)(KWS(F) + WS_CTL) + CW_CNT + layer * NE;
    unsigned* list = (unsigned*)(KWS(F) + WS_LIST); float* gates = (float*)(KWS(F) + WS_GATES);
    constexpr int RWS = 1028, RSEL = 131584, RVEC = RSEL + 10240;
    LAS float* rwT = (LAS float*)F.lds;
    LAS int* sel_e = (LAS int*)(F.lds + RSEL);
    LAS float* sel_g = (LAS float*)(F.lds + RSEL + 2048);
    LAS unsigned* lcnt = (LAS unsigned*)(F.lds + RSEL + 4096);
    LAS unsigned* lbase = lcnt + 32;
    LAS unsigned* lpos = lcnt + 64;
    LAS float* vG = (LAS float*)(F.lds + RVEC);
    const int lane = F.lane;
    for (int i = F.tid; i < DM * NE; i += NTHR) { const int d = i >> 5, e = i & 31; rwT[e * RWS + d] = rw[i]; }
    __syncthreads();
    for (int blk = F.bx; blk < T / 128; blk += F.G) {
        const int r0 = blk * 128, b = r0 >> 14;
        const float* g1 = mod + b * 6144 + 2048; const float* sh2 = mod + b * 6144 + 3072; const float* sc2 = mod + b * 6144 + 4096;
        if (F.tid < 32) lcnt[F.tid] = 0u;
        for (int i = F.tid; i < DM; i += NTHR) { vG[i] = g1[i]; vG[DM + i] = lng[i]; vG[2 * DM + i] = lnb[i]; vG[3 * DM + i] = sc2[i] + 1.0f; vG[4 * DM + i] = sh2[i]; }
        __syncthreads();
        f32x4 nx[2][4]; u32x2 ny[2][4];
#pragma unroll
        for (int t = 0; t < 2; ++t)
#pragma unroll
            for (int j = 0; j < 4; ++j) { const int d = 4 * lane + 256 * j; const size_t rr = (size_t)(r0 + F.wave * 16 + t); nx[t][j] = *(const f32x4*)(hin + rr * DM + d); ny[t][j] = *(const u32x2*)(Y + rr * DM + d); }
        for (int qq = 0; qq < 8; ++qq) {
            int lane4 = 4 * lane; asm volatile("" : "+v"(lane4));
            const int tl0 = F.wave * 16 + 2 * qq;
            f32x4 pre[2][4]; float s1[2] = {0.f, 0.f}, s2[2] = {0.f, 0.f};
#pragma unroll
            for (int t = 0; t < 2; ++t)
#pragma unroll
                for (int j = 0; j < 4; ++j) { const int d = lane4 + 256 * j; const f32x4 x = nx[t][j]; const u32x2 yw = ny[t][j]; const f32x4 g = *(const LAS f32x4*)(vG + d);
                    f32x4 y; y[0] = __uint_as_float(yw.x << 16); y[1] = __uint_as_float(yw.x & 0xffff0000u); y[2] = __uint_as_float(yw.y << 16); y[3] = __uint_as_float(yw.y & 0xffff0000u);
                    const f32x4 p_ = x * ALPHA + g * y; pre[t][j] = p_; s1[t] += (p_[0] + p_[1]) + (p_[2] + p_[3]); s2[t] += (p_[0] * p_[0] + p_[1] * p_[1]) + (p_[2] * p_[2] + p_[3] * p_[3]); }
            if (qq + 1 < 8) {
#pragma unroll
                for (int t = 0; t < 2; ++t)
#pragma unroll
                    for (int j = 0; j < 4; ++j) { const int d = lane4 + 256 * j; const size_t rr = (size_t)(r0 + tl0 + 2 + t); nx[t][j] = *(const f32x4*)(hin + rr * DM + d); ny[t][j] = *(const u32x2*)(Y + rr * DM + d); } }
            s1[0] = wave_sum(s1[0]); s1[1] = wave_sum(s1[1]); s2[0] = wave_sum(s2[0]); s2[1] = wave_sum(s2[1]);
            f32x4 u2[2][4];
#pragma unroll
            for (int t = 0; t < 2; ++t) { const float mean = s1[t] * (1.0f / DM); const float var = fmaxf(s2[t] * (1.0f / DM) - mean * mean, 0.f); const float rstd = 1.0f / sqrtf(var + LN_EPS); const size_t row = (size_t)(r0 + tl0 + t);
#pragma unroll
                for (int j = 0; j < 4; ++j) { const int d = lane4 + 256 * j; const f32x4 h = (pre[t][j] - mean) * rstd * *(const LAS f32x4*)(vG + DM + d) + *(const LAS f32x4*)(vG + 2 * DM + d);
                    *(f32x4*)(H1 + row * DM + d) = h;
                    u2[t][j] = h * *(const LAS f32x4*)(vG + 3 * DM + d) + *(const LAS f32x4*)(vG + 4 * DM + d);
                    *(unsigned*)(U2 + row * DM + d) = pk4_fp8(u2[t][j][0], u2[t][j][1], u2[t][j][2], u2[t][j][3]); } }
            f32x2 up[4][4];
#pragma unroll
            for (int j = 0; j < 4; ++j)
#pragma unroll
                for (int i = 0; i < 4; ++i) { up[j][i][0] = u2[0][j][i]; up[j][i][1] = u2[1][j][i]; }
            f32x2 P[32];
            f32x4 wc[4], wn[4];
#pragma unroll
            for (int j = 0; j < 4; ++j) wc[j] = *(const LAS f32x4*)(rwT + 4 * lane + 256 * j);
#pragma unroll
            for (int e = 0; e < 32; ++e) {
                if (e + 1 < 32) {
#pragma unroll
                    for (int j = 0; j < 4; ++j) wn[j] = *(const LAS f32x4*)(rwT + (e + 1) * RWS + 4 * lane + 256 * j); }
                f32x2 a0 = {0.f, 0.f}, a1 = {0.f, 0.f};
#pragma unroll
                for (int j = 0; j < 4; ++j) { f32x2 w0 = {wc[j][0], wc[j][0]}, w1 = {wc[j][1], wc[j][1]}, w2 = {wc[j][2], wc[j][2]}, w3 = {wc[j][3], wc[j][3]};
                    a0 = __builtin_elementwise_fma(up[j][0], w0, a0); a1 = __builtin_elementwise_fma(up[j][1], w1, a1); a0 = __builtin_elementwise_fma(up[j][2], w2, a0); a1 = __builtin_elementwise_fma(up[j][3], w3, a1); }
                P[e] = a0 + a1;
#pragma unroll
                for (int j = 0; j < 4; ++j) wc[j] = wn[j];
                if ((e & 3) == 3) __builtin_amdgcn_sched_barrier(0); }
#define RSTEP(N, MASK, CTRL) do { _Pragma("unroll") for (int i = 0; i < (N); ++i) { int lm_ = lane & (MASK); asm volatile("" : "+v"(lm_)); const bool up_ = lm_ != 0;     \
                const f32x2 sv = up_ ? P[i] : P[i + (N)], kv = up_ ? P[i + (N)] : P[i]; f32x2 rv; rv[0] = dpp_f<CTRL>(sv[0]); rv[1] = dpp_f<CTRL>(sv[1]); P[i] = kv + rv; } } while (0)
#define RSWAP(N, SWAPFN) do { _Pragma("unroll") for (int i = 0; i < (N); ++i) { _Pragma("unroll") for (int c_ = 0; c_ < 2; ++c_) { \
                const auto r_ = SWAPFN(__float_as_uint(P[i][c_]), __float_as_uint(P[i + (N)][c_]), false, false); P[i][c_] = __uint_as_float(r_[0]) + __uint_as_float(r_[1]); } } } while (0)
            RSWAP(16, __builtin_amdgcn_permlane32_swap); RSWAP(8, __builtin_amdgcn_permlane16_swap);
#undef RSWAP
            RSTEP(4, 8, 0x140); RSTEP(2, 4, 0x141); RSTEP(1, 2, 0x4E);
#undef RSTEP
            const int me = lane >> 1; const float rbv = rb[me];
            float lgs[2]; lgs[0] = P[0][0] + dpp_f<0xB1>(P[0][0]) + rbv; lgs[1] = P[0][1] + dpp_f<0xB1>(P[0][1]) + rbv;
            LAS float* lgbuf = (LAS float*)(F.lds + RSEL + 8192) + F.wave * 64;
            if ((lane & 1) == 0) { lgbuf[me] = lgs[0]; lgbuf[32 + me] = lgs[1]; }
            asm volatile("s_waitcnt lgkmcnt(0)" ::: "memory");
#pragma unroll
            for (int t = 0; t < 2; ++t) { const float mine = lgs[t]; int rank = 0;
#pragma unroll
                for (int e4 = 0; e4 < 8; ++e4) { const f32x4 v = *(const LAS f32x4*)(lgbuf + 32 * t + 4 * e4);
#pragma unroll
                    for (int i = 0; i < 4; ++i) { const int e = 4 * e4 + i; rank += (v[i] > mine || (v[i] == mine && e < me)) ? 1 : 0; } }
                float ls[4]; int es[4];
#pragma unroll
                for (int k = 0; k < 4; ++k) { const unsigned long long bal = __ballot(rank == k); const int first = __ffsll((long long)bal) - 1; es[k] = first >> 1; ls[k] = lgbuf[32 * t + es[k]]; }
                const float e1 = __expf(ls[1] - ls[0]), e2 = __expf(ls[2] - ls[0]), e3 = __expf(ls[3] - ls[0]); const float inv = 1.0f / (1.0f + e1 + e2 + e3);
                const int tl = tl0 + t;
                if (lane == 0) { sel_e[tl * 4 + 0] = es[0]; sel_e[tl * 4 + 1] = es[1]; sel_e[tl * 4 + 2] = es[2]; sel_e[tl * 4 + 3] = es[3];
                    sel_g[tl * 4 + 0] = inv; sel_g[tl * 4 + 1] = e1 * inv; sel_g[tl * 4 + 2] = e2 * inv; sel_g[tl * 4 + 3] = e3 * inv; } }
        }
        __syncthreads();
        const int myE = sel_e[F.tid];
        lpos[F.tid] = __hip_atomic_fetch_add(&lcnt[myE], 1u, __ATOMIC_RELAXED, __HIP_MEMORY_SCOPE_WORKGROUP);
        __syncthreads();
        if (F.tid < 32) lbase[F.tid] = atomicAdd(&gcnt[F.tid], lcnt[F.tid]);
        __syncthreads();
        { const unsigned slot = (unsigned)(r0 * 4 + F.tid); list[(size_t)myE * CAP + lbase[myE] + lpos[F.tid]] = slot; gates[slot] = sel_g[F.tid]; }
        __syncthreads();
    }
}

struct MoeOrder {
    const LAS int* meta;
    const unsigned* list; int c, G, ncol, rpx;
    __device__ bool next(int i, pg8::Unit& u) const {
        const int x = c & 7, j = c >> 3; const int g = (i * 8 + x) * rpx + j / ncol; const int total = meta[32];
        if (g >= total) return false;
        const int ln_ = (int)__builtin_amdgcn_mbcnt_hi(~0u, __builtin_amdgcn_mbcnt_lo(~0u, 0u)) & 31;
        const int e = __popc((unsigned)__ballot(meta[ln_ + 1] <= g));
        const int rt = g - meta[e], cnt = meta[64 + e];
        u.pm = g; u.pn = e * ncol + (j % ncol); u.a0 = e; u.a1 = rt; u.a2 = min(256, cnt - rt * 256); return true;
    }
    __device__ __forceinline__ unsigned arow(const pg8::Unit& u, int R) const { return (R < u.a2) ? (list[(size_t)u.a0 * CAP + u.a1 * 256 + R] >> 2) : 0u; }
    __device__ __forceinline__ unsigned rowval(const pg8::Unit& u, int R, unsigned v) const { return (R < u.a2) ? (v >> 2) : 0u; }
    __device__ __forceinline__ const unsigned* rows_ptr(const pg8::Unit& u) const { return list + (size_t)u.a0 * CAP + u.a1 * 256; }
};
__device__ __forceinline__ void moe_meta(Frame& F, int layer) {
    LAS int* meta = (LAS int*)(F.lds + META_OFF);
    const unsigned* gcnt = (const unsigned*)(KWS(F) + WS_CTL) + CW_CNT + layer * NE;
    if (F.tid < NE) { const int c = (int)__hip_atomic_load(&gcnt[F.tid], __ATOMIC_RELAXED, __HIP_MEMORY_SCOPE_AGENT); meta[64 + F.tid] = c; meta[96 + F.tid] = (c + 255) >> 8; }
    __syncthreads();
    if (F.tid <= NE) { int acc = 0;
#pragma unroll
        for (int e = 0; e < NE; ++e) { const int t = meta[96 + e]; acc += (e < F.tid) ? t : 0; }
        meta[F.tid] = acc; }
    __syncthreads();
}
struct EpiGU {
    static constexpr bool PERM = true, HAS_PRE = true;
    unsigned char* ACT; const float* bgu;
    __device__ __forceinline__ void pre(LAS unsigned char* dst, const pg8::Unit& u, int wid, int lane) const {
        if (wid == 1) { const int e = u.a0, pnl = u.pn - e * 8; const float* src = bgu + e * 2048 + (lane >> 5) * 1024 + pnl * 128 + (lane & 31) * 4;
            __builtin_amdgcn_global_load_lds((const unsigned*)src, (LAS unsigned*)dst, 16, 0, 0); } }
    __device__ __forceinline__ void operator()(const f32x4 (&acc)[2][2][4][2], const pg8::Unit& u, int wr, int wc, int fr, int fq, const LAS unsigned char* pre_) const {
        const int e = u.a0, pnl = u.pn - e * 8; const int lcol = wc * 32 + 8 * fq, ccol = pnl * 128 + lcol; const int row0 = u.pm * 256 + wr * 64 + fr;
        f32x2 bg[2][2], bl[2][2];
#pragma unroll
        for (int n = 0; n < 2; ++n) { const f32x4 g4 = *(const LAS f32x4*)(pre_ + (lcol + 4 * n) * 4), l4 = *(const LAS f32x4*)(pre_ + 512 + (lcol + 4 * n) * 4);
            bg[n][0] = (f32x2){g4[0], g4[1]}; bg[n][1] = (f32x2){g4[2], g4[3]}; bl[n][0] = (f32x2){l4[0] + 1.0f, l4[1] + 1.0f}; bl[n][1] = (f32x2){l4[2] + 1.0f, l4[3] + 1.0f}; }
        const f32x2 s2 = {1.0f / WGU_SCALE, 1.0f / WGU_SCALE}, c2 = {-1.702f * 1.4426950408889634f, -1.702f * 1.4426950408889634f}, one2 = {1.0f, 1.0f};
#pragma unroll
        for (int ai = 0; ai < 2; ++ai)
#pragma unroll
            for (int m = 0; m < 4; ++m) { unsigned char* rowp = ACT + (size_t)(row0 + ai * 128 + m * 16) * 1024 + ccol; f32x2 o[2][2];
#pragma unroll
                for (int n = 0; n < 2; ++n)
#pragma unroll
                    for (int h = 0; h < 2; ++h) { const f32x4 A4 = acc[ai][0][m][n], L4 = acc[ai][1][m][n];
                        f32x2 gv = __builtin_elementwise_fma((f32x2){A4[2 * h], A4[2 * h + 1]}, s2, bg[n][h]), lv = __builtin_elementwise_fma((f32x2){L4[2 * h], L4[2 * h + 1]}, s2, bl[n][h]);
                        gv[0] = fminf(gv[0], 7.0f); gv[1] = fminf(gv[1], 7.0f);
                        lv[0] = __builtin_amdgcn_fmed3f(lv[0], -6.0f, 8.0f); lv[1] = __builtin_amdgcn_fmed3f(lv[1], -6.0f, 8.0f);
                        const f32x2 t = gv * c2; f32x2 d = {__builtin_amdgcn_exp2f(t[0]), __builtin_amdgcn_exp2f(t[1])}; d = d + one2;
                        const f32x2 r = {__builtin_amdgcn_rcpf(d[0]), __builtin_amdgcn_rcpf(d[1])};
                        o[n][h] = gv * r * lv; }
                u32x2 w; w.x = pk4_fp8(o[0][0][0], o[0][0][1], o[0][1][0], o[0][1][1]); w.y = pk4_fp8(o[1][0][0], o[1][0][1], o[1][1][0], o[1][1][1]);
                *(u32x2*)rowp = w; }
    }
};
struct EpiDown {
    static constexpr bool PERM = true, HAS_PRE = true;
    unsigned char* YB; const float* bd; const unsigned* list;
    __device__ __forceinline__ void pre(LAS unsigned char* dst, const pg8::Unit& u, int wid, int lane) const {
        const int e = u.a0, rt = u.a1, pnl = u.pn - e * 4;
        if (wid == 1) __builtin_amdgcn_global_load_lds((const unsigned*)(bd + e * 1024 + pnl * 256 + lane * 4), (LAS unsigned*)dst, 16, 0, 0);
        if (wid == 2) __builtin_amdgcn_global_load_lds((const unsigned*)(list + (size_t)e * CAP + rt * 256 + lane * 4), (LAS unsigned*)(dst + 1024), 16, 0, 0); }
    __device__ __forceinline__ void operator()(const f32x4 (&acc)[2][2][4][2], const pg8::Unit& u, int wr, int wc, int fr, int fq, const LAS unsigned char* pre_) const {
        const int e = u.a0, pnl = u.pn - e * 4; const int lcol = wc * 32 + 8 * fq, col = pnl * 256 + lcol;
        f32x4 bv[2][2];
#pragma unroll
        for (int bj = 0; bj < 2; ++bj)
#pragma unroll
            for (int n = 0; n < 2; ++n) bv[bj][n] = *(const LAS f32x4*)(pre_ + (lcol + bj * 128 + 4 * n) * 4);
#pragma unroll
        for (int ai = 0; ai < 2; ++ai)
#pragma unroll
            for (int m = 0; m < 4; ++m) { const int R = ai * 128 + wr * 64 + m * 16 + fr; if (R >= u.a2) continue;
                const unsigned slot = *(const LAS unsigned*)(pre_ + 1024 + R * 4); unsigned char* rowp = YB + (size_t)slot * 1024 + col;
#pragma unroll
                for (int bj = 0; bj < 2; ++bj) { const f32x4 v0 = acc[ai][bj][m][0] * (1.0f / WD_SCALE) + bv[bj][0], v1 = acc[ai][bj][m][1] * (1.0f / WD_SCALE) + bv[bj][1];
                    u32x2 w; w.x = pk4_fp8(v0[0], v0[1], v0[2], v0[3]); w.y = pk4_fp8(v1[0], v1[1], v1[2], v1[3]);
                    *(u32x2*)(rowp + bj * 128) = w; } }
    }
};

__device__ __forceinline__ void ph_combine(Frame& F, int layer, float* hout, bool next_mod) {
    const float* mod = (const float*)(KWS(F) + WS_MOD) + (size_t)(layer * 3) * 6144;
    const float* modn = (const float*)(KWS(F) + WS_MOD) + (size_t)3 * 6144;
    const float* H1 = (const float*)(KWS(F) + WS_H1); const unsigned char* YB = (const unsigned char*)(KWS(F) + WS_YB); const float* gates = (const float*)(KWS(F) + WS_GATES);
    const float* lng = KIN(F, 8) + layer * DM; const float* lnb = KIN(F, 9) + layer * DM; bf16_t* U = (bf16_t*)(KWS(F) + WS_U);
    const int gw = F.bx * NWAVES + F.wave, NGW = F.G * NWAVES, lane = F.lane;
    LAS float* vC = (LAS float*)F.lds;
    for (int i = F.tid; i < 2 * DM; i += NTHR) { const int b = i >> 10, d = i & (DM - 1); LAS float* v = vC + b * 5 * DM + d;
        v[0] = mod[b * 6144 + 5120 + d]; v[DM] = lng[d]; v[2 * DM] = lnb[d]; v[3 * DM] = modn[b * 6144 + 1024 + d] + 1.0f; v[4 * DM] = modn[b * 6144 + d]; }
    __syncthreads();
    f32x4 nh[4]; unsigned nyb[4][4]; f32x4 ngt;
#define CMB_LOAD(r_) do { _Pragma("unroll") for (int j = 0; j < 4; ++j) { const int d = 4 * lane + 256 * j; nh[j] = *(const f32x4*)(H1 + (size_t)(r_) * DM + d); \
        _Pragma("unroll") for (int k = 0; k < 4; ++k) nyb[j][k] = *(const unsigned*)(YB + ((size_t)(r_) * 4 + k) * DM + d); } ngt = *(const f32x4*)(gates + (size_t)(r_) * 4); } while (0)
    if (gw < T) CMB_LOAD(gw);
    for (int row = gw; row < T; row += NGW) {
        int vb = (row >> 14) * 5 * DM + 4 * lane; asm volatile("" : "+v"(vb));
        const LAS float* vr = vC + vb;
        f32x4 ch[4]; unsigned cyb[4][4]; const f32x4 gt = ngt;
#pragma unroll
        for (int j = 0; j < 4; ++j) { ch[j] = nh[j];
#pragma unroll
            for (int k = 0; k < 4; ++k) cyb[j][k] = nyb[j][k]; }
        if (row + NGW < T) CMB_LOAD(row + NGW);
        f32x4 pre[4]; float s = 0.f;
#pragma unroll
        for (int j = 0; j < 4; ++j) { f32x4 y = {0.f, 0.f, 0.f, 0.f};
#pragma unroll
            for (int k = 0; k < 4; ++k) { const unsigned yw = cyb[j][k]; const f32x2 lo = __builtin_amdgcn_cvt_pk_f32_fp8((int)yw, false), hi2 = __builtin_amdgcn_cvt_pk_f32_fp8((int)yw, true);
                const f32x4 v = {lo[0], lo[1], hi2[0], hi2[1]};
                y += v * gt[k]; }
            pre[j] = ch[j] * ALPHA + *(const LAS f32x4*)(vr + 256 * j) * y; s += (pre[j][0] + pre[j][1]) + (pre[j][2] + pre[j][3]); }
        const float mean = wave_sum(s) * (1.0f / DM); float q2 = 0.f;
#pragma unroll
        for (int j = 0; j < 4; ++j) { pre[j] = pre[j] - mean; q2 += (pre[j][0] * pre[j][0] + pre[j][1] * pre[j][1]) + (pre[j][2] * pre[j][2] + pre[j][3] * pre[j][3]); }
        const float rstd = 1.0f / sqrtf(wave_sum(q2) * (1.0f / DM) + LN_EPS);
#pragma unroll
        for (int j = 0; j < 4; ++j) { const int d = 4 * lane + 256 * j; const f32x4 h = pre[j] * rstd * *(const LAS f32x4*)(vr + DM + 256 * j) + *(const LAS f32x4*)(vr + 2 * DM + 256 * j);
            *(f32x4*)(hout + (size_t)row * DM + d) = h;
            if (next_mod) { const f32x4 v = h * *(const LAS f32x4*)(vr + 3 * DM + 256 * j) + *(const LAS f32x4*)(vr + 4 * DM + 256 * j);
                u32x2 w; w.x = pk2(v[0], v[1]); w.y = pk2(v[2], v[3]); *(u32x2*)(U + (size_t)row * DM + d) = w; } }
    }
#undef CMB_LOAD
}

__device__ __forceinline__ void ph_gmlp(Frame& F) {
    const bf16_t* Z = (const bf16_t*)(KWS(F) + WS_ZODD); bf16_t* MIX = (bf16_t*)(KWS(F) + WS_MIX);
    const float* lg = KIN(F, 23); const float* lb = KIN(F, 24); const float* bs = KIN(F, 26); const bf16_t* wsb = (const bf16_t*)(KWS(F) + WS_TAB + TB_WS);
    const int lane = F.lane, r32 = lane & 31, hi = lane >> 5, wid = F.wave;
    for (int chunk = F.bx; chunk < T / 128; chunk += F.G) {
        const int r0 = chunk * 128;
        for (int qq = 0; qq < 16; ++qq) { const int q = wid * 16 + qq; const bf16x8 raw = *(const bf16x8*)(Z + (size_t)(r0 + q) * 1536 + 512 + 8 * lane);
            float v[8]; float s = 0.f;
#pragma unroll
            for (int j = 0; j < 8; ++j) { v[j] = bf2f((unsigned short)raw[j]); s += v[j]; }
            const float mean = wave_sum(s) * (1.0f / 512.0f); float q2 = 0.f;
#pragma unroll
            for (int j = 0; j < 8; ++j) { v[j] -= mean; q2 += v[j] * v[j]; }
            const float rstd = 1.0f / sqrtf(wave_sum(q2) * (1.0f / 512.0f) + LN_EPS);
            const f32x4 g0 = *(const f32x4*)(lg + 8 * lane), g1 = *(const f32x4*)(lg + 8 * lane + 4), b0 = *(const f32x4*)(lb + 8 * lane), b1 = *(const f32x4*)(lb + 8 * lane + 4);
            u32x4 w; w.x = pk2(v[0] * rstd * g0[0] + b0[0], v[1] * rstd * g0[1] + b0[1]); w.y = pk2(v[2] * rstd * g0[2] + b0[2], v[3] * rstd * g0[3] + b0[3]);
            w.z = pk2(v[4] * rstd * g1[0] + b1[0], v[5] * rstd * g1[1] + b1[1]); w.w = pk2(v[6] * rstd * g1[2] + b1[2], v[7] * rstd * g1[3] + b1[3]);
            const int ch = 8 * lane, g = ch >> 7, col = ch & 127, kt = (q >> 6) * 4 + g;
            *(LAS u32x4*)(F.lds + kt * 16384 + v_st(q & 63, col)) = w; }
        __syncthreads();
        const int pb = wid & 3, gh = wid >> 2;
#pragma unroll 1
        for (int gi = 0; gi < 2; ++gi) { const int g = 2 * gh + gi;
            unsigned wofs = (unsigned)(((g * 128 + 32 * pb + r32) * 128 + 8 * hi) * 2); asm volatile("" : "+v"(wofs));
            f32x16 acc[4];
#pragma unroll
            for (int d0 = 0; d0 < 4; ++d0) acc[d0] = f32x16{};
            bf16x8 af[8];
#pragma unroll
            for (int ks = 0; ks < 8; ++ks) af[ks] = *(const bf16x8*)((const char*)wsb + wofs + 32 * ks);
#pragma unroll
            for (int ks = 0; ks < 8; ++ks) {
                LAS unsigned char* trd = F.lds + ((ks >> 2) * 4 + g) * 16384 + v_rd_base(lane);
#pragma unroll
                for (int d0 = 0; d0 < 4; ++d0) acc[d0] = __builtin_amdgcn_mfma_f32_32x32x16_bf16(af[ks], vfrag(trd, d0, ks & 3), acc[d0], 0, 0, 0); }
            unsigned short uraw[16][4]; float bias[16];
#pragma unroll
            for (int r = 0; r < 16; ++r) { const int p = 32 * pb + crow(r, hi); bias[r] = bs[g * 128 + p];
#pragma unroll
                for (int d0 = 0; d0 < 4; ++d0) uraw[r][d0] = Z[(size_t)(r0 + p) * 1536 + g * 128 + d0 * 32 + r32]; }
            asm volatile("" ::: "memory");
#pragma unroll
            for (int r = 0; r < 16; ++r) { const int p = 32 * pb + crow(r, hi);
#pragma unroll
                for (int d0 = 0; d0 < 4; ++d0) { const int ch = g * 128 + d0 * 32 + r32;
                    MIX[(size_t)(r0 + p) * 1024 + ch] = (bf16_t)f2bf(bf2f(uraw[r][d0]) * (acc[d0][r] + bias[r])); } }
        }
        __syncthreads();
    }
}

__device__ __forceinline__ void ph_fourier1(Frame& F) {
    const bf16_t* Z = (const bf16_t*)(KWS(F) + WS_ZODD); bf16_t* WT = (bf16_t*)(KWS(F) + WS_WT);
    const float* lg = KIN(F, 27); const float* lb = KIN(F, 28);
    const bf16x8* CSf = (const bf16x8*)(KWS(F) + WS_TAB + TB_CS); const bf16x8* AFf = (const bf16x8*)(KWS(F) + WS_TAB + TB_AF); const f32x2* tw = (const f32x2*)(KWS(F) + WS_TAB + TB_TW);
    const int lane = F.lane, r32 = lane & 31, hi = lane >> 5, wid = F.wave;
    for (int unit = F.bx; unit < NB * 128; unit += F.G) {
        const int b = unit >> 7, t2 = unit & 127;
#pragma unroll 1
        for (int g = 0; g < 4; ++g) {
            {
                int lane_g = lane; asm volatile("" : "+v"(lane_g)); const int r32 = lane_g & 31, hi = lane_g >> 5;
                const int tb = wid & 3, part = wid >> 2; int t1 = 32 * tb + r32; asm volatile("" : "+v"(t1)); const size_t row = (size_t)b * SEQ + 128 * t1 + t2;
                bf16x8 raw[8]; float s = 0.f;
#pragma unroll
                for (int ks = 0; ks < 8; ++ks) { raw[ks] = *(const bf16x8*)(Z + row * 1536 + 1024 + g * 128 + 16 * ks + 8 * hi);
#pragma unroll
                    for (int j = 0; j < 8; ++j) s += bf2f((unsigned short)raw[ks][j]); }
                s = xhalf_sum(s); const float mean = s * (1.0f / 128.0f); float q2 = 0.f;
#pragma unroll
                for (int ks = 0; ks < 8; ++ks)
#pragma unroll
                    for (int j = 0; j < 8; ++j) { const float d = bf2f((unsigned short)raw[ks][j]) - mean; q2 += d * d; }
                q2 = xhalf_sum(q2); const float rstd = 1.0f / sqrtf(q2 * (1.0f / 128.0f) + LN_EPS);
                bf16x8 af[8];
#pragma unroll
                for (int ks = 0; ks < 8; ++ks) { const int c0 = g * 128 + 16 * ks + 8 * hi; const f32x4 g0 = *(const f32x4*)(lg + c0), g1 = *(const f32x4*)(lg + c0 + 4), b0 = *(const f32x4*)(lb + c0), b1 = *(const f32x4*)(lb + c0 + 4);
                    float x[8];
#pragma unroll
                    for (int j = 0; j < 8; ++j) x[j] = (bf2f((unsigned short)raw[ks][j]) - mean) * rstd;
                    u32x4 w; w.x = pk2(x[0] * g0[0] + b0[0], x[1] * g0[1] + b0[1]); w.y = pk2(x[2] * g0[2] + b0[2], x[3] * g0[3] + b0[3]);
                    w.z = pk2(x[4] * g1[0] + b1[0], x[5] * g1[1] + b1[1]); w.w = pk2(x[6] * g1[2] + b1[2], x[7] * g1[3] + b1[3]);
                    af[ks] = __builtin_bit_cast(bf16x8, w); }
                f32x16 acc[4];
#pragma unroll
                for (int d0 = 0; d0 < 4; ++d0) acc[d0] = f32x16{};
#pragma unroll
                for (int ks = 0; ks < 8; ++ks) { unsigned fo = (unsigned)(((4 * part) * 8 + ks) * 64 + lane) * 16u; asm volatile("" : "+v"(fo));
#pragma unroll
                    for (int d0 = 0; d0 < 4; ++d0) acc[d0] = __builtin_amdgcn_mfma_f32_32x32x16_bf16(af[ks], *(const bf16x8*)((const char*)CSf + fo + d0 * 8192), acc[d0], 0, 0, 0); }
                int ybase = (part * 2 + (tb >> 1)) * 16384 + (tb & 1) * 8192 + hi * 2048 + r32 * 2; asm volatile("" : "+v"(ybase));
#pragma unroll
                for (int r = 0; r < 16; ++r)
#pragma unroll
                    for (int d0 = 0; d0 < 4; ++d0) *(LAS bf16_t*)(F.lds + ybase + ((r >> 3) & 1) * 4096 + d0 * 512 + ((r & 3) + 4 * ((r >> 2) & 1)) * 64) = (bf16_t)f2bf(acc[d0][r]);
            }
            __syncthreads();
            {
                const int kb = wid & 3, ch2 = wid >> 2;
                f32x16 aR[2], aI[2];
#pragma unroll
                for (int dd = 0; dd < 2; ++dd) { aR[dd] = f32x16{}; aI[dd] = f32x16{}; }
#pragma unroll
                for (int kh = 0; kh < 4; ++kh) {
                    unsigned fo = (unsigned)((kb * 16 + kh * 4) * 64 + lane) * 16u; asm volatile("" : "+v"(fo));
                    bf16x8 fr8[4], fi8[4];
#pragma unroll
                    for (int k8 = 0; k8 < 4; ++k8) { fr8[k8] = *(const bf16x8*)((const char*)AFf + fo + k8 * 1024); fi8[k8] = *(const bf16x8*)((const char*)AFf + fo + k8 * 1024 + 65536); }
#pragma unroll
                    for (int k8 = 0; k8 < 4; ++k8) { const int ks = kh * 4 + k8;
                        LAS unsigned char* trd = F.lds + (ks >> 2) * 16384 + v_rd_base(lane);
#pragma unroll
                        for (int dd = 0; dd < 2; ++dd) { const bf16x8 bf = vfrag(trd, 2 * ch2 + dd, ks & 3);
                            aR[dd] = __builtin_amdgcn_mfma_f32_32x32x16_bf16(fr8[k8], bf, aR[dd], 0, 0, 0); aI[dd] = __builtin_amdgcn_mfma_f32_32x32x16_bf16(fi8[k8], bf, aI[dd], 0, 0, 0); } }
                }
                int k1b = 32 * kb + 4 * hi; asm volatile("" : "+v"(k1b));
                f32x2 csv[16];
#pragma unroll
                for (int r = 0; r < 16; ++r) csv[r] = tw[t2 * 128 + k1b + (r & 3) + 8 * (r >> 2)];
                asm volatile("" ::: "memory");
#pragma unroll
                for (int r = 0; r < 16; ++r) { const int k1 = k1b + (r & 3) + 8 * (r >> 2); const f32x2 cs = csv[r];
                    bf16_t* dst = WT + ((((size_t)b * 128 + k1) * 128 + t2) * 4 + g) * 256;
#pragma unroll
                    for (int dd = 0; dd < 2; ++dd) { const float wr_ = aR[dd][r], wi_ = aI[dd][r]; const int j = 32 * (2 * ch2 + dd) + r32;
                        dst[j] = (bf16_t)f2bf(wr_ * cs[0] + wi_ * cs[1]); dst[128 + j] = (bf16_t)f2bf(wi_ * cs[0] - wr_ * cs[1]); }
                    if ((r & 3) == 3) asm volatile("" ::: "memory"); }
            }
            __syncthreads();
        }
    }
}
__device__ __forceinline__ void ph_fourier2(Frame& F) {
    const bf16_t* WT = (const bf16_t*)(KWS(F) + WS_WT); bf16_t* MIX = (bf16_t*)(KWS(F) + WS_MIX);
    const bf16x8* A3f = (const bf16x8*)(KWS(F) + WS_TAB + TB_A3);
    const int lane = F.lane, r32 = lane & 31, hi = lane >> 5, wid = F.wave;
    for (int unit = F.bx; unit < NB * 128; unit += F.G) {
        const int b = unit >> 7, k1 = unit & 127;
#pragma unroll 1
        for (int g = 0; g < 4; ++g) {
            for (int idx = F.tid; idx < 4096; idx += NTHR) { const int t2 = idx >> 5, c = idx & 31, part = c >> 4, j0 = (c & 15) * 8;
                const u32x4 v = *(const u32x4*)(WT + ((((size_t)b * 128 + k1) * 128 + t2) * 4 + g) * 256 + part * 128 + j0);
                *(LAS u32x4*)(F.lds + (part * 2 + (t2 >> 6)) * 16384 + v_st(t2 & 63, j0)) = v; }
            __syncthreads();
            const int mb = wid & 3, ch2 = wid >> 2;
            f32x16 acc[2] = {f32x16{}, f32x16{}};
#pragma unroll
            for (int ks = 0; ks < 16; ++ks) { unsigned fo = (unsigned)((mb * 16 + ks) * 64 + lane) * 16u; asm volatile("" : "+v"(fo)); const bf16x8 af = *(const bf16x8*)((const char*)A3f + fo);
                LAS unsigned char* trd = F.lds + (ks >> 2) * 16384 + v_rd_base(lane);
#pragma unroll
                for (int dd = 0; dd < 2; ++dd) acc[dd] = __builtin_amdgcn_mfma_f32_32x32x16_bf16(af, vfrag(trd, 2 * ch2 + dd, ks & 3), acc[dd], 0, 0, 0); }
#pragma unroll
            for (int r = 0; r < 16; ++r) { const int k2 = 32 * mb + crow(r, hi); const size_t row = (size_t)b * SEQ + k1 + 128 * k2;
#pragma unroll
                for (int dd = 0; dd < 2; ++dd) MIX[row * 1024 + 512 + g * 128 + 32 * (2 * ch2 + dd) + r32] = (bf16_t)f2bf(acc[dd][r]); }
            __syncthreads();
        }
    }
}

#ifndef MK_ONE_LAUNCH
#define MK_ONE_LAUNCH 1
#endif
constexpr int NPH = 18;
#ifndef PHMASK
#define PHMASK 0x3FFFF
#endif
#define HAS(k) (((PHMASK) >> (k)) & 1)
__global__ void __launch_bounds__(NTHR, 2) fwd_kernel(Args args) {
    extern __shared__ __attribute__((aligned(16))) unsigned char lds_raw[];
    Frame F;
    F.lds = (LAS unsigned char*)lds_raw; F.tid = threadIdx.x; F.lane = F.tid & 63; F.wave = __builtin_amdgcn_readfirstlane(F.tid >> 6); F.G = gridDim.x; F.bx = blockIdx.x;
    F.kz = 0;
    volatile LAS unsigned* MISC = (volatile LAS unsigned*)(F.lds + MISC_OFF);
    if (F.tid < 64) MISC[F.tid] = 0u;
    __syncthreads();
    if (MK_ONE_LAUNCH) (void)xcd_barrier_post((unsigned*)(args.ws + WS_CTL) + CW_BAR, MISC + 8);
    const int lo = args.ph_lo, hi = args.ph_hi;
#define IN(k) (lo <= (k) && (k) < hi)
#ifndef REPMASK
#define REPMASK 0
#endif
#define REP(k) (((REPMASK) >> (k)) & 1)
#define BARNOW() do { ENTER(); XcdBarrier bar_; bar_.bar = (unsigned*)(KWS(F) + WS_CTL) + CW_BAR; bar_.x = xb_xcc_id(); bar_.st = (volatile LAS unsigned*)(F.lds + MISC_OFF) + 8; xcd_barrier(bar_); } while (0)
#ifndef DIAG_PH
#define DIAG_PH -1
#endif
    int nstamp = 0;
#define STAMP() do { if (DIAG_PH >= 0) { if (F.tid == 0) ((volatile LAS unsigned*)(F.lds + MISC_OFF))[16 + nstamp] = (unsigned)__builtin_amdgcn_s_memrealtime(); ++nstamp; } } while (0)
    STAMP();
#define ENTER() do { asm volatile("" : "+s"(F.kz), "+s"(F.wave), "+s"(F.G), "+s"(F.bx), "+v"(F.tid), "+v"(F.lane)); F.kz = __builtin_amdgcn_readfirstlane(F.kz); F.wave = __builtin_amdgcn_readfirstlane(F.wave); \
    F.G = __builtin_amdgcn_readfirstlane(F.G); F.bx = __builtin_amdgcn_readfirstlane(F.bx); } while (0)
#define SEAM(k) do { if (IN(k) && IN((k) + 1)) { if (MK_ONE_LAUNCH) { ENTER(); XcdBarrier bar_; bar_.bar = (unsigned*)(KWS(F) + WS_CTL) + CW_BAR; bar_.x = xb_xcc_id(); bar_.st = (volatile LAS unsigned*)(F.lds + MISC_OFF) + 8; xcd_barrier(bar_); STAMP(); } } } while (0)

    if (HAS(0) && IN(0)) { ENTER(); for (int rep_ = 0; rep_ <= REP(0); ++rep_) { if (rep_) BARNOW(); ph0_mod_tables(F); } } SEAM(0);
    if (HAS(1) && IN(1)) { ENTER(); for (int rep_ = 0; rep_ <= REP(1); ++rep_) { if (rep_) BARNOW(); ph1_convert(F); } } SEAM(1);
    if (HAS(2) && IN(2)) { ENTER(); for (int rep_ = 0; rep_ <= REP(2); ++rep_) { if (rep_) BARNOW(); ph2_modulate(F); } } SEAM(2);

    for (int layer = 0; layer < 2; ++layer) {
        const int pb = layer == 0 ? 5 : 13;
        if (layer == 0) {
            if (HAS(3) && IN(3)) { ENTER(); for (int rep_ = 0; rep_ <= REP(3); ++rep_) { if (rep_) BARNOW();
                pg8::Gemm g{(const bf16_t*)(KWS(F) + WS_U), (const bf16_t*)(KWS(F) + WS_WEVIN), T, 2560, DM};
                EvInOrder S; S.so.init(T, 2560, F.G, F.bx);
                EpiEvIn E{(unsigned char*)(KWS(F) + WS_Q), (unsigned char*)(KWS(F) + WS_K), (unsigned char*)(KWS(F) + WS_V), (bf16_t*)(KWS(F) + WS_AB), (const float*)(KWS(F) + WS_TAB + TB_COS), (const float*)(KWS(F) + WS_TAB + TB_SIN)};
                pg8::gemm_phase<EpiEvIn, EvInOrder, true, false>(F.lds, g, S, E, F.tid);
            } } SEAM(3);
            if (HAS(4) && IN(4)) { ENTER(); for (int rep_ = 0; rep_ <= REP(4); ++rep_) { if (rep_) BARNOW(); ph4_conv(F); ph4_attention(F); } } SEAM(4);
        } else {
            if (HAS(10) && IN(10)) { ENTER(); for (int rep_ = 0; rep_ <= REP(10); ++rep_) { if (rep_) BARNOW();
                pg8::Gemm g{(const bf16_t*)(KWS(F) + WS_U), (const bf16_t*)(KWS(F) + WS_WODIN), T, 1536, DM};
                pg8::StaticOrder S; S.init(T, 1536, F.G, F.bx);
                pg8::EpiBf16 E{(bf16_t*)(KWS(F) + WS_ZODD), 1536, 4};
                pg8::gemm_phase<pg8::EpiBf16, pg8::StaticOrder, true, false>(F.lds, g, S, E, F.tid);
            } } SEAM(10);
            if (HAS(11) && IN(11)) { ENTER(); for (int rep_ = 0; rep_ <= REP(11); ++rep_) { if (rep_) BARNOW(); ph_gmlp(F); ph_fourier1(F); } } SEAM(11);
            if (HAS(12) && IN(12)) { ENTER(); for (int rep_ = 0; rep_ <= REP(12); ++rep_) { if (rep_) BARNOW(); ph_fourier2(F); } } SEAM(12);
        }
        if (HAS(5) && IN(pb)) { ENTER(); for (int rep_ = 0; rep_ <= REP(5); ++rep_) { if (rep_) BARNOW();
            pg8::Gemm g{(const bf16_t*)(KWS(F) + WS_MIX), (const bf16_t*)(KWS(F) + (layer == 0 ? WS_WEVOUT : WS_WODOUT)), T, DM, DM};
            pg8::StaticOrder S; S.init(T, DM, F.G, F.bx);
            pg8::EpiBf16 E{(bf16_t*)(KWS(F) + WS_Y), DM, 0};
            pg8::gemm_phase<pg8::EpiBf16, pg8::StaticOrder, true, false>(F.lds, g, S, E, F.tid);
        } } SEAM(pb);
        if (HAS(6) && IN(pb + 1)) { ENTER(); for (int rep_ = 0; rep_ <= REP(6); ++rep_) { if (rep_) BARNOW(); ph_router(F, layer, layer == 0 ? KIN(F, 0) : (const float*)(KWS(F) + WS_H2)); } } SEAM(pb + 1);
        if (HAS(7) && IN(pb + 2)) { ENTER(); for (int rep_ = 0; rep_ <= REP(7); ++rep_) { if (rep_) BARNOW();
            moe_meta(F, layer);
            pg8::Gemm g{(const bf16_t*)(KWS(F) + WS_U2), (const bf16_t*)(KWS(F) + WS_WGU + (size_t)layer * NE * 2048 * DM), 0, 0, DM / 2};
            MoeOrder S{(const LAS int*)(F.lds + META_OFF), (const unsigned*)(KWS(F) + WS_LIST), F.bx, F.G, 8, 4};
            EpiGU E{(unsigned char*)(KWS(F) + WS_ACT), KIN(F, 32) + (size_t)layer * NE * 2048};
            pg8::gemm_phase<EpiGU, MoeOrder, true, true, true>(F.lds, g, S, E, F.tid);
        } } SEAM(pb + 2);
        if (HAS(8) && IN(pb + 3)) { ENTER(); for (int rep_ = 0; rep_ <= REP(8); ++rep_) { if (rep_) BARNOW();
            moe_meta(F, layer);
            pg8::Gemm g{(const bf16_t*)(KWS(F) + WS_ACT), (const bf16_t*)(KWS(F) + WS_WD + (size_t)layer * NE * 1024 * DM), 0, 0, DM / 2};
            MoeOrder S{(const LAS int*)(F.lds + META_OFF), (const unsigned*)(KWS(F) + WS_LIST), F.bx, F.G, 4, 8};
            EpiDown E{(unsigned char*)(KWS(F) + WS_YB), KIN(F, 34) + (size_t)layer * NE * 1024, (const unsigned*)(KWS(F) + WS_LIST)};
            pg8::gemm_phase<EpiDown, MoeOrder, true, false, true>(F.lds, g, S, E, F.tid);
        } } SEAM(pb + 3);
        if (HAS(9) && IN(pb + 4)) { ENTER(); for (int rep_ = 0; rep_ <= REP(9); ++rep_) { if (rep_) BARNOW(); ph_combine(F, layer, layer == 0 ? (float*)(KWS(F) + WS_H2) : KOUT(F), layer == 0); } }
        if (layer == 0) SEAM(pb + 4);
    }
    if (DIAG_PH >= 0) {
        ENTER(); XcdBarrier bar_; bar_.bar = (unsigned*)(KWS(F) + WS_CTL) + CW_BAR; bar_.x = xb_xcc_id(); bar_.st = (volatile LAS unsigned*)(F.lds + MISC_OFF) + 8; xcd_barrier(bar_); STAMP();
        __syncthreads();
        volatile LAS unsigned* st = (volatile LAS unsigned*)(F.lds + MISC_OFF) + 16;
        const unsigned d = st[DIAG_PH + 1] - st[DIAG_PH];
        const float c = sqrtf((float)d * 0.01f);
        float* o = KOUT(F);
        for (size_t i = (size_t)F.bx * NTHR + F.tid; i < (size_t)T * DM; i += (size_t)F.G * NTHR) o[i] = c;
    }
#undef IN
#undef SEAM
}

extern "C" void kernel_launch(void* const* d_in, const int* in_sizes, int n_in, void* d_out, int out_size, void* d_ws, size_t ws_size, hipStream_t stream) {
    static int grid = 0;
    if (grid == 0) {
        if (n_in != 35 || out_size != T * DM || ws_size < WS_END) { fprintf(stderr, "kernel_launch: unexpected shapes: n_in %d out %d ws %zu (need %zu)\n", n_in, out_size, ws_size, (size_t)WS_END); grid = -1; return; }
        int dev = 0, cus = 0;
        if (hipGetDevice(&dev) != hipSuccess || hipDeviceGetAttribute(&cus, hipDeviceAttributeMultiprocessorCount, dev) != hipSuccess) { grid = -1; return; }
        if (hipFuncSetAttribute((const void*)fwd_kernel, hipFuncAttributeMaxDynamicSharedMemorySize, LDS_BYTES) != hipSuccess) { fprintf(stderr, "kernel_launch: hipFuncSetAttribute failed\n"); grid = -1; return; }
        int per_cu = 0; (void)hipOccupancyMaxActiveBlocksPerMultiprocessor(&per_cu, (const void*)fwd_kernel, NTHR, LDS_BYTES); (void)hipGetLastError();
        if (per_cu < 1) fprintf(stderr, "kernel_launch: occupancy query reports %d blocks per CU\n", per_cu);
        grid = cus > 256 ? 256 : cus;
        if (grid != 256) fprintf(stderr, "kernel_launch: %d CUs; this kernel is laid out for 256\n", cus);
    }
    if (grid < 0) return;
    (void)hipMemsetAsync((char*)d_ws + WS_CTL, 0, CTL_ZERO_BYTES, stream);
    Args a{};
    for (int i = 0; i < 35; ++i) a.in[i] = (const float*)d_in[i];
    a.out = (float*)d_out; a.ws = (unsigned char*)d_ws;
#if MK_ONE_LAUNCH
    a.ph_lo = 0; a.ph_hi = NPH;
    hipLaunchKernelGGL(fwd_kernel, dim3(grid), dim3(NTHR), LDS_BYTES, stream, a);
#else
    for (int p = 0; p < NPH; ++p) { a.ph_lo = p; a.ph_hi = p + 1; hipLaunchKernelGGL(fwd_kernel, dim3(grid), dim3(NTHR), LDS_BYTES, stream, a); }
#endif
    const hipError_t le = hipPeekAtLastError();
    if (le != hipSuccess) fprintf(stderr, "kernel_launch: launch failed: %s\n", hipGetErrorName(le));
}
```

```cpp
#include <hip/hip_runtime.h>
#include <cstdio>
#include <cstdint>

#define LAS __attribute__((address_space(3)))
#define GAS __attribute__((address_space(1)))
typedef unsigned short bf16_t;
typedef short bf16x8 __attribute__((ext_vector_type(8)));
typedef short s16x4 __attribute__((ext_vector_type(4)));
typedef float f32x4 __attribute__((ext_vector_type(4)));
typedef float f32x2 __attribute__((ext_vector_type(2)));
typedef float f32x16 __attribute__((ext_vector_type(16)));
typedef unsigned u32x4 __attribute__((ext_vector_type(4)));
typedef unsigned u32x2 __attribute__((ext_vector_type(2)));

namespace pg8 {
constexpr int BM = 256, BK = 64, HALF = 128, HTB = HALF * BK * 2, STAGE_BYTES = 8 * HTB, NXCD = 8, WGM = 8;
__host__ __device__ __forceinline__ int lds_byte(int r, int c) { const int st = (r >> 4) * 2 + (c >> 5), rr = r & 15, cc = c & 31, ob = rr * 64 + cc * 2; return st * 1024 + (ob ^ (((ob >> 9) & 1) << 5)); }
__host__ __device__ __forceinline__ void stage_rc(int b, int& R, int& C) { const int st = b / 1024, sb = b % 1024, swz = sb ^ (((sb >> 9) & 1) << 5); R = (st >> 1) * 16 + swz / 64; C = (st & 1) * 32 + (swz % 64) / 2; }
__host__ __device__ __forceinline__ int perm32(int rho) { const int n = rho >> 4, i = rho & 15; return 8 * (i >> 2) + 4 * n + (i & 3); }

struct Unit { int pm, pn, a0, a1, a2; };
struct Gemm { const bf16_t* A; const bf16_t* Bt; int M, N, K; };

constexpr int PRE_ROWS = 131072 + 1024, PRE_EPI = PRE_ROWS + 2048;
struct StaticOrder {
    int nM, nN, nwg, G, c;
    __device__ void init(int M, int N, int G_, int c_) { nM = M / BM; nN = N / BM; nwg = nM * nN; G = G_; c = c_; }
    __device__ bool map(long L, Unit& u) const {
        if (L >= nwg) return false;
        int wgid = (int)L; { const int q = nwg / NXCD, r = nwg % NXCD, xcd = wgid % NXCD, off = wgid / NXCD; wgid = (xcd < r ? xcd * (q + 1) : r * (q + 1) + (xcd - r) * q) + off; }
        const int nig = WGM * nN, gid = wgid / nig, fm = gid * WGM, gsz = (nM - fm) < WGM ? (nM - fm) : WGM;
        u.pm = fm + ((wgid % nig) % gsz); u.pn = (wgid % nig) / gsz; u.a0 = 0; u.a1 = 0; u.a2 = 256; return true;
    }
    __device__ bool next(int i, Unit& u) const { return map((long)i * G + c, u); }
    __device__ __forceinline__ unsigned arow(const Unit&, int) const { return 0u; }
    __device__ __forceinline__ unsigned rowval(const Unit&, int, unsigned) const { return 0u; }
    __device__ __forceinline__ const unsigned* rows_ptr(const Unit&) const { return nullptr; }
};

__device__ __forceinline__ unsigned cvt_pk_bf16(float lo, float hi) { unsigned r; asm volatile("v_cvt_pk_bf16_f32 %0, %1, %2" : "=v"(r) : "v"(lo), "v"(hi)); return r; }

__device__ __forceinline__ float gelu_tanh(float x) {
    const float t = x * (1.0f + 0.044715f * x * x) * (2.0f * 0.7978845608028654f * 1.4426950408889634f);
    return x * __builtin_amdgcn_rcpf(1.0f + __builtin_amdgcn_exp2f(-t));
}

struct EpiBf16 {
    static constexpr bool PERM = true, HAS_PRE = false;
    bf16_t* O; int ldc; int gelu_pn;
    __device__ __forceinline__ void operator()(const f32x4 (&acc)[2][2][4][2], const Unit& u, int wr, int wc, int fr, int fq) const {
        const int row0 = u.pm * BM + wr * 64 + fr; const int col0 = u.pn * BM + wc * 32 + 8 * fq;
        const bool act = u.pn < gelu_pn;
#pragma unroll
        for (int ai = 0; ai < 2; ++ai)
#pragma unroll
            for (int m = 0; m < 4; ++m) { bf16_t* rowp = O + (size_t)(row0 + ai * HALF + m * 16) * ldc + col0;
#pragma unroll
                for (int bj = 0; bj < 2; ++bj) { f32x4 v0 = acc[ai][bj][m][0], v1 = acc[ai][bj][m][1];
                    if (act) {
#pragma unroll
                        for (int j = 0; j < 4; ++j) { v0[j] = gelu_tanh(v0[j]); v1[j] = gelu_tanh(v1[j]); } }
                    u32x4 w; w.x = cvt_pk_bf16(v0[0], v0[1]); w.y = cvt_pk_bf16(v0[2], v0[3]); w.z = cvt_pk_bf16(v1[0], v1[1]); w.w = cvt_pk_bf16(v1[2], v1[3]);
                    *(u32x4*)(rowp + bj * HALF) = w; } }
    }
};

typedef int v8i32 __attribute__((ext_vector_type(8)));
typedef short s16x16 __attribute__((ext_vector_type(16)));
template <class Epi, class Sched, bool ALIGN_EPI, bool GATHER, bool FP8 = false>
__device__ __forceinline__ void gemm_phase(LAS unsigned char* lds, const Gemm g, const Sched& S, const Epi& E, const int tid) {
    const int wid = __builtin_amdgcn_readfirstlane(tid >> 6), lane = tid & 63, wr = wid >> 2, wc = wid & 3, fr = lane & 15, fq = lane >> 4;
    const int K = g.K, nt = K / BK;
    unsigned voffA[2], voffB[2]; int Rr[2], Cc[2];
#pragma unroll
    for (int i = 0; i < 2; ++i) { int R, C; stage_rc(tid * 16 + i * 8192, R, C); const int Rb = Epi::PERM ? ((R & ~31) + perm32(R & 31)) : R; Rr[i] = R; Cc[i] = C;
        voffA[i] = (unsigned)(R * K + C) * 2u; voffB[i] = (unsigned)(Rb * K + C) * 2u; }
    const unsigned kstep = (unsigned)(BK * 2);
    const unsigned hstep = (unsigned)HALF * (unsigned)K * 2u;
    const unsigned tstep = 2u * hstep;
    const char* const baseA = (const char*)g.A; const char* const baseB = (const char*)g.Bt;
    const unsigned ldsw = (unsigned)wid * 1024u;
    const int aoff = lds_byte(wr * 64 + fr, fq * 8), boff = lds_byte(wc * 32 + fr, fq * 8);
    const int aoff0 = lds_byte(wr * 64 + fr, fq * 16), aoff1 = lds_byte(wr * 64 + fr, fq * 16 + 8), boff0 = lds_byte(wc * 32 + fr, fq * 16), boff1 = lds_byte(wc * 32 + fr, fq * 16 + 8);
#define PG8_SA(b, h) (((b) * 2 + (h)) * HTB)
#define PG8_SB(b, h) ((4 + (b) * 2 + (h)) * HTB)
#define PG8_STAGE(bufoff, gbase, voff) do { _Pragma("unroll") for (int _i = 0; _i < 2; ++_i) \
        __builtin_amdgcn_global_load_lds((const unsigned*)(baseB + (size_t)(unsigned)((gbase) + (voff)[_i])), (LAS unsigned*)(lds + (bufoff) + ldsw + _i * 8192), 16, 0, 0); } while (0)
#define PG8_STAGEA(bufoff, gbase, voff) do { _Pragma("unroll") for (int _i = 0; _i < 2; ++_i) \
        __builtin_amdgcn_global_load_lds((const unsigned*)(baseA + (size_t)(unsigned)((gbase) + (voff)[_i])), (LAS unsigned*)(lds + (bufoff) + ldsw + _i * 8192), 16, 0, 0); } while (0)
#define PG8_STAGE_A(bufoff, base, h, nx) do { if constexpr (GATHER) { _Pragma("unroll") for (int _i = 0; _i < 2; ++_i) { const unsigned _v = (nx) ? vAn[h][_i] : vAc[h][_i]; \
            __builtin_amdgcn_global_load_lds((const unsigned*)(baseA + (size_t)(unsigned)((base) + _v)), (LAS unsigned*)(lds + (bufoff) + ldsw + _i * 8192), 16, 0, 0); } } \
        else { PG8_STAGEA(bufoff, (base) + (h) * hstep, voffA); } } while (0)
#define PG8_LD8(dst, i, off0, off1) do { const bf16x8 _lo = *(const LAS bf16x8*)(lds + (off0)), _hi = *(const LAS bf16x8*)(lds + (off0) + 16); dst[i] = __builtin_bit_cast(v8i32, __builtin_shufflevector(_lo, _hi, 0, 1, 2, 3, 4, 5, 6, 7, 8, 9, 10, 11, 12, 13, 14, 15)); } while (0)
#define PG8_LDA8(dst, b, h) do { _Pragma("unroll") for (int m = 0; m < 4; ++m) PG8_LD8(dst, m, PG8_SA(b, h) + aoff0 + m * 2048, PG8_SA(b, h) + aoff1 + m * 2048); } while (0)
#define PG8_LDB8(dst, b, h) do { _Pragma("unroll") for (int n = 0; n < 2; ++n) PG8_LD8(dst, n, PG8_SB(b, h) + boff0 + n * 2048, PG8_SB(b, h) + boff1 + n * 2048); } while (0)
#define PG8_MMA8(ai, bj, At, Bt) do { __builtin_amdgcn_s_setprio(1); _Pragma("unroll") for (int m = 0; m < 4; ++m) _Pragma("unroll") for (int n = 0; n < 2; ++n) \
        asm volatile("v_mfma_scale_f32_16x16x128_f8f6f4 %0, %1, %2, %0, %3, %3 op_sel_hi:[0,0,0]" : "+v"(acc[ai][bj][m][n]) : "v"(Bt[n]), "v"(At[m]), "v"(one_scale)); __builtin_amdgcn_s_setprio(0); } while (0)
#define PG8_LDA(dst, b, h) do { _Pragma("unroll") for (int m = 0; m < 4; ++m) _Pragma("unroll") for (int k = 0; k < 2; ++k) dst[m][k] = *(const LAS bf16x8*)(lds + PG8_SA(b, h) + aoff + m * 2048 + k * 1024); } while (0)
#define PG8_LDB(dst, b, h) do { _Pragma("unroll") for (int n = 0; n < 2; ++n) _Pragma("unroll") for (int k = 0; k < 2; ++k) dst[n][k] = *(const LAS bf16x8*)(lds + PG8_SB(b, h) + boff + n * 2048 + k * 1024); } while (0)
#define PG8_MMA(ai, bj, At, Bt) do { __builtin_amdgcn_s_setprio(1); _Pragma("unroll") for (int m = 0; m < 4; ++m) _Pragma("unroll") for (int n = 0; n < 2; ++n) _Pragma("unroll") for (int k = 0; k < 2; ++k) \
        acc[ai][bj][m][n] = __builtin_amdgcn_mfma_f32_16x16x32_bf16(Bt[n][k], At[m][k], acc[ai][bj][m][n], 0, 0, 0); __builtin_amdgcn_s_setprio(0); } while (0)
#define PG8_WAIT_V(n) asm volatile("s_waitcnt vmcnt(" #n ")" ::: "memory")
#define PG8_WAIT_L(n) asm volatile("s_waitcnt lgkmcnt(" #n ")" ::: "memory")
#define PG8_BAR __builtin_amdgcn_s_barrier()
#define PG8_SCHED __builtin_amdgcn_sched_barrier(0)
    Unit cur, nxt; int ui = 0;
    if (!S.next(0, cur)) return;
    f32x4 acc[2][2][4][2];
#pragma unroll
    for (int a = 0; a < 2; ++a)
#pragma unroll
        for (int b = 0; b < 2; ++b)
#pragma unroll
            for (int m = 0; m < 4; ++m)
#pragma unroll
                for (int n = 0; n < 2; ++n) acc[a][b][m][n] = (f32x4){0.f, 0.f, 0.f, 0.f};
    bf16x8 At[4][2], B0[2][2], B1[2][2]; v8i32 At8[4], B08[2], B18[2]; const int one_scale = 0x7F7F7F7F;
#define XLDA(b, h) do { if constexpr (FP8) PG8_LDA8(At8, b, h); else PG8_LDA(At, b, h); } while (0)
#define XLDB0(b, h) do { if constexpr (FP8) PG8_LDB8(B08, b, h); else PG8_LDB(B0, b, h); } while (0)
#define XLDB1(b, h) do { if constexpr (FP8) PG8_LDB8(B18, b, h); else PG8_LDB(B1, b, h); } while (0)
#define XMMA0(ai, bj) do { if constexpr (FP8) PG8_MMA8(ai, bj, At8, B08); else PG8_MMA(ai, bj, At, B0); } while (0)
#define XMMA1(ai, bj) do { if constexpr (FP8) PG8_MMA8(ai, bj, At8, B18); else PG8_MMA(ai, bj, At, B1); } while (0)
    unsigned vAc[2][2], vAn[2][2];
#define PG8_ROWS(dst, un) do { if constexpr (GATHER) { _Pragma("unroll") for (int _h = 0; _h < 2; ++_h) _Pragma("unroll") for (int _i = 0; _i < 2; ++_i) \
        dst[_h][_i] = (S.arow(un, _h * HALF + Rr[0] + 64 * _i) * (unsigned)K + (unsigned)Cc[0]) * 2u; } } while (0)
    PG8_ROWS(vAc, cur);
#pragma unroll
    for (int _h = 0; _h < 2; ++_h)
#pragma unroll
        for (int _i = 0; _i < 2; ++_i) vAn[_h][_i] = vAc[_h][_i];
    unsigned cA = GATHER ? 0u : (unsigned)cur.pm * tstep; unsigned cB = (unsigned)cur.pn * tstep;
    PG8_STAGE(PG8_SB(0, 0), cB, voffB); PG8_STAGE(PG8_SB(0, 1), cB + hstep, voffB); PG8_STAGE_A(PG8_SA(0, 0), cA, 0, false); PG8_STAGE_A(PG8_SA(0, 1), cA, 1, false);
    if (wr == 1) PG8_BAR;
    PG8_WAIT_V(2); PG8_BAR;
    PG8_STAGE(PG8_SB(1, 0), cB + kstep, voffB); PG8_STAGE_A(PG8_SA(1, 0), cA + kstep, 0, false); PG8_STAGE(PG8_SB(1, 1), cB + hstep + kstep, voffB);
    PG8_WAIT_V(6); PG8_BAR;
    for (;;) {
        const bool has_next = S.next(ui + 1, nxt);
        if constexpr (GATHER) {
            if (has_next) {
                if (ui == 0) { PG8_ROWS(vAn, nxt); asm volatile("" : "+v"(vAn[0][0]), "+v"(vAn[0][1]), "+v"(vAn[1][0]), "+v"(vAn[1][1])); }
                else {
#pragma unroll
                    for (int _h = 0; _h < 2; ++_h)
#pragma unroll
                        for (int _i = 0; _i < 2; ++_i) { const int R_ = _h * HALF + Rr[0] + 64 * _i; const unsigned v_ = *(const LAS unsigned*)(lds + PRE_ROWS + ((ui + 1) & 1) * 1024 + R_ * 4);
                            vAn[_h][_i] = (S.rowval(nxt, R_, v_) * (unsigned)K + (unsigned)Cc[0]) * 2u; } }
            }
            Unit n2_; if (S.next(ui + 2, n2_)) { if (wid == 0) __builtin_amdgcn_global_load_lds((const unsigned*)(S.rows_ptr(n2_) + lane * 4), (LAS unsigned*)(lds + PRE_ROWS + (ui & 1) * 1024), 16, 0, 0); }
        } else { if (has_next) { PG8_ROWS(vAn, nxt); } }
        if constexpr (Epi::HAS_PRE) E.pre(lds + PRE_EPI + (ui & 1) * 2048, cur, wid, lane);
        const unsigned nA = GATHER ? 0u : (has_next ? (unsigned)nxt.pm * tstep : cA);
        const unsigned nB = has_next ? (unsigned)nxt.pn * tstep : cB;
#pragma unroll 1
        for (int t = 0; t < nt; t += 2) {
            const bool last = (t == nt - 2);
            const bool nx = last && has_next;
            const unsigned a1 = cA + (unsigned)(t + 1) * kstep;
            const unsigned a2 = last ? nA : cA + (unsigned)(t + 2) * kstep; const unsigned b2 = last ? nB : cB + (unsigned)(t + 2) * kstep;
            const unsigned a3 = a2 + kstep; const unsigned b3 = b2 + kstep;
            XLDB0(0, 0); XLDB1(0, 1); PG8_SCHED; XLDA(0, 0); PG8_STAGE_A(PG8_SA(1, 1), a1, 1, false);
            PG8_WAIT_V(8); PG8_WAIT_L(0); PG8_BAR; XMMA0(0, 0); XMMA1(0, 1); PG8_BAR; PG8_SCHED;
            XLDA(0, 1); PG8_STAGE(PG8_SB(0, 0), b2, voffB); PG8_STAGE(PG8_SB(0, 1), b2 + hstep, voffB); PG8_STAGE_A(PG8_SA(0, 0), a2, 0, nx);
            PG8_WAIT_V(8); PG8_WAIT_L(0); PG8_BAR; XMMA0(1, 0); XMMA1(1, 1); PG8_BAR; PG8_SCHED;
            XLDB0(1, 0); XLDB1(1, 1); PG8_SCHED; XLDA(1, 0); PG8_STAGE_A(PG8_SA(0, 1), a2, 1, nx);
            PG8_WAIT_V(8); PG8_WAIT_L(0); PG8_BAR; XMMA0(0, 0); XMMA1(0, 1); PG8_BAR; PG8_SCHED;
            XLDA(1, 1); PG8_STAGE(PG8_SB(1, 0), b3, voffB); PG8_STAGE(PG8_SB(1, 1), b3 + hstep, voffB); PG8_STAGE_A(PG8_SA(1, 0), a3, 0, nx);
            PG8_WAIT_V(8); PG8_WAIT_L(0); PG8_BAR; XMMA0(1, 0); XMMA1(1, 1); PG8_BAR; PG8_SCHED;
        }
        if constexpr (FP8) asm volatile("s_nop 15\n\ts_nop 15" ::: "memory");
        if constexpr (ALIGN_EPI) { if (wr == 0) PG8_BAR; }
        if constexpr (Epi::HAS_PRE) E(acc, cur, wr, wc, fr, fq, lds + PRE_EPI + (ui & 1) * 2048); else E(acc, cur, wr, wc, fr, fq);
        if (!has_next) break;
#pragma unroll
        for (int a = 0; a < 2; ++a)
#pragma unroll
            for (int b = 0; b < 2; ++b)
#pragma unroll
                for (int m = 0; m < 4; ++m)
#pragma unroll
                    for (int n = 0; n < 2; ++n) acc[a][b][m][n] = (f32x4){0.f, 0.f, 0.f, 0.f};
        cur = nxt; cA = nA; cB = nB; ++ui;
#pragma unroll
        for (int _h = 0; _h < 2; ++_h)
#pragma unroll
            for (int _i = 0; _i < 2; ++_i) vAc[_h][_i] = vAn[_h][_i];
        if constexpr (ALIGN_EPI) { if (wr == 1) PG8_BAR; }
    }
    PG8_WAIT_V(0);
    if constexpr (!ALIGN_EPI) { if (wr == 0) PG8_BAR; }
    PG8_BAR;
#undef PG8_SA
#undef PG8_SB
#undef PG8_STAGE
#undef PG8_STAGEA
#undef PG8_STAGE_A
#undef PG8_ROWS
#undef PG8_LDA
#undef PG8_LD8
#undef PG8_LDA8
#undef PG8_LDB8
#undef PG8_MMA8
#undef XLDA
#undef XLDB0
#undef XLDB1
#undef XMMA0
#undef XMMA1
#undef PG8_LDB
#undef PG8_MMA
#undef PG8_WAIT_V
#undef PG8_WAIT_L
#undef PG8_BAR
#undef PG8_SCHED
}
}

constexpr int DM = 1024, SEQ = 16384, NB = 2, T = NB * SEQ, CTX = 256, NCTX = NB * CTX, NKEY = SEQ + CTX;
constexpr int NE = 32, TOPK = 4, CAP = 32768;
constexpr float ALPHA = 1.4142135623730951f, LN_EPS = 1e-5f;
constexpr float QSCALE = 0.125f * 1.4426950408889634f;
constexpr float LAM_INIT0 = 0.2f;
constexpr int NWAVES = 8, NTHR = 512;

constexpr size_t MiB = 1u << 20;
constexpr size_t WS_CTL = 0, CTL_ZERO_BYTES = 1 * MiB;
constexpr size_t WS_MODP = 1 * MiB;
constexpr size_t WS_MOD = 3 * MiB;
constexpr size_t WS_TAB = 4 * MiB;
constexpr size_t WS_WEVIN = 6 * MiB, WS_WEVOUT = 11 * MiB, WS_WODIN = 13 * MiB, WS_WODOUT = 16 * MiB;
constexpr size_t WS_LIST = 18 * MiB, WS_GATES = 22 * MiB;
constexpr size_t WS_WGU = 32 * MiB;
constexpr size_t WS_WD = 288 * MiB;
constexpr size_t WS_U = 416 * MiB;
constexpr size_t WS_Q = 482 * MiB, WS_K = 514 * MiB, WS_V = 547 * MiB, WS_AB = 580 * MiB;
constexpr size_t WS_O0 = 612 * MiB;
constexpr size_t WS_MIX = 676 * MiB, WS_Y = 740 * MiB, WS_H1 = 804 * MiB, WS_U2 = 932 * MiB;
constexpr size_t WS_ACT = 996 * MiB;
constexpr size_t WS_YB = 1268 * MiB;
constexpr size_t WS_H2 = 1524 * MiB;
constexpr size_t WS_ZODD = 1652 * MiB;
constexpr size_t WS_WT = 1748 * MiB;
constexpr size_t WS_END = 1812 * MiB;
constexpr size_t TB_COS = 0, TB_SIN = 20480, TB_CS = 40960  , TB_AF = 106496  , TB_A3 = 237568  , TB_TW = 303104  , TB_WS = 434176  , TB_END = 565248;
constexpr int CW_ERR = 0, CW_BAR = 4096, CW_CNT = 16384;
#define XB_TMO      128
#define XB_XCNT(j)  (256  + 64 * (j))
#define XB_XSUB(j)  (1280 + 64 * (j))
#define XB_XGEN(j)  (2304 + 64 * (j))
#define XB_TOP      3328
#define XB_TOPGEN   3392
#define XCD_BAR_WORDS 3456
#define XB_SPIN_CAP (1u << 18)
constexpr int LDS_BYTES = 160 * 1024, MISC_OFF = LDS_BYTES - 256, META_OFF = 131072;

__device__ __forceinline__ unsigned xb_ld(unsigned* p)              { return __hip_atomic_load(p, __ATOMIC_RELAXED, __HIP_MEMORY_SCOPE_AGENT); }
__device__ __forceinline__ unsigned xb_add(unsigned* p, unsigned v) { return __hip_atomic_fetch_add(p, v, __ATOMIC_RELAXED, __HIP_MEMORY_SCOPE_AGENT); }
__device__ __forceinline__ unsigned xb_xcc_id() { return (unsigned)__builtin_amdgcn_s_getreg((3 << 11) | 20) & 0xFu; }
#define XB_SPIN(cond, bar) do { unsigned _sp = 0; while (cond) { __builtin_amdgcn_s_sleep(1); \
    if ((++_sp & 255u) == 0u) { if (xb_ld(&(bar)[XB_TMO])) break; if (_sp > XB_SPIN_CAP) { atomicAdd(&(bar)[XB_TMO], 1u); break; } } } } while (0)
struct XcdBarrier { unsigned* bar; unsigned x; volatile LAS unsigned* st; };
__device__ __forceinline__ XcdBarrier xcd_barrier_post(unsigned* bar, volatile LAS unsigned* st) {
    XcdBarrier b; b.bar = bar; b.x = xb_xcc_id(); b.st = st;
    if (threadIdx.x == 0) (void)xb_add(&bar[XB_XCNT(b.x)], 1u);
    return b;
}
__device__ __forceinline__ void xcd_barrier_complete(unsigned* bar, unsigned x, unsigned& nloc, unsigned& nx) {
    const unsigned G = gridDim.x * gridDim.y * gridDim.z;
    unsigned sum, cnt, mine, sp = 0u;
    for (;;) {
        sum = 0u; cnt = 0u; mine = 0u;
#pragma unroll
        for (unsigned j = 0; j < 16; ++j) { const unsigned c = xb_ld(&bar[XB_XCNT(j)]); sum += c; cnt += (c > 0u) ? 1u : 0u; mine = (j == x) ? c : mine; }
        if (sum == G) break;
        __builtin_amdgcn_s_sleep(1);
        if ((++sp & 255u) == 0u) { if (xb_ld(&bar[XB_TMO])) break; if (sp > XB_SPIN_CAP) { atomicAdd(&bar[XB_TMO], 1u); break; } }
    }
    nloc = mine > 0u ? mine : 1u; nx = cnt > 0u ? cnt : 1u;
}
__device__ __forceinline__ void xcd_barrier(const XcdBarrier& b) {
    asm volatile("s_waitcnt vmcnt(0)" ::: "memory");
    __syncthreads();
    if (threadIdx.x == 0) {
        unsigned* bar = b.bar;
        __builtin_amdgcn_s_waitcnt(0);
        unsigned nloc = b.st[0], nx = b.st[1];
        if (nloc == 0u) { xcd_barrier_complete(bar, b.x, nloc, nx); b.st[0] = nloc; b.st[1] = nx; }
        const unsigned old = xb_add(&bar[XB_XSUB(b.x)], 1u);
        const unsigned gen = old / nloc;
        if (old + 1u == (gen + 1u) * nloc) {
            __builtin_amdgcn_fence(__ATOMIC_RELEASE, "agent");
            asm volatile("s_waitcnt vmcnt(0)" ::: "memory");
            const unsigned og = xb_add(&bar[XB_TOP], 1u);
            const unsigned tg = og / nx;
            if (og + 1u == (tg + 1u) * nx) xb_add(&bar[XB_TOPGEN], 1u);
            else XB_SPIN(xb_ld(&bar[XB_TOPGEN]) == tg, bar);
            __builtin_amdgcn_fence(__ATOMIC_ACQUIRE, "agent");
            xb_add(&bar[XB_XGEN(b.x)], 1u);
            asm volatile("s_waitcnt vmcnt(0)" ::: "memory");
        } else {
            XB_SPIN(xb_ld(&bar[XB_XGEN(b.x)]) == gen, bar);
            __builtin_amdgcn_fence(__ATOMIC_ACQUIRE, "agent");
            asm volatile("s_waitcnt vmcnt(0)" ::: "memory");
        }
    }
    __syncthreads();
}

__device__ __forceinline__ float bf2f(unsigned short b) { return __uint_as_float(((unsigned)b) << 16); }
__device__ __forceinline__ unsigned f2bf(float f) { unsigned u = __float_as_uint(f); return (u + 0x7fffu + ((u >> 16) & 1u)) >> 16; }
__device__ __forceinline__ unsigned pk2(float lo, float hi) { return f2bf(lo) | (f2bf(hi) << 16); }
__device__ __forceinline__ unsigned pk4_fp8(float a, float b, float c, float d) { unsigned w = (unsigned)__builtin_amdgcn_cvt_pk_fp8_f32(a, b, 0, false); return (unsigned)__builtin_amdgcn_cvt_pk_fp8_f32(c, d, (int)w, true); }
constexpr float WGU_SCALE = 32.0f, WD_SCALE = 64.0f;
template <int CTRL> __device__ __forceinline__ float dpp_f(float v) { return __builtin_bit_cast(float, __builtin_amdgcn_update_dpp(0, __builtin_bit_cast(int, v), CTRL, 0xf, 0xf, true)); }
__device__ __forceinline__ float wave_sum(float v) {
    v += dpp_f<0xB1>(v); v += dpp_f<0x4E>(v); v += dpp_f<0x141>(v); v += dpp_f<0x140>(v);
    { const auto r = __builtin_amdgcn_permlane16_swap(__float_as_uint(v), __float_as_uint(v), false, false); v = __uint_as_float(r[0]) + __uint_as_float(r[1]); }
    { const auto r = __builtin_amdgcn_permlane32_swap(__float_as_uint(v), __float_as_uint(v), false, false); v = __uint_as_float(r[0]) + __uint_as_float(r[1]); }
    return v;
}
__device__ __forceinline__ float half_sum(float v) {
    v += dpp_f<0xB1>(v); v += dpp_f<0x4E>(v); v += dpp_f<0x141>(v); v += dpp_f<0x140>(v);
    { const auto r = __builtin_amdgcn_permlane16_swap(__float_as_uint(v), __float_as_uint(v), false, false); v = __uint_as_float(r[0]) + __uint_as_float(r[1]); }
    return v;
}
__device__ __forceinline__ float xhalf_sum(float v) {
    const auto r = __builtin_amdgcn_permlane32_swap(__float_as_uint(v), __float_as_uint(v), false, false); return __uint_as_float(r[0]) + __uint_as_float(r[1]);
}
__device__ __forceinline__ float wave_max(float v) {
    v = fmaxf(v, dpp_f<0xB1>(v)); v = fmaxf(v, dpp_f<0x4E>(v)); v = fmaxf(v, dpp_f<0x141>(v)); v = fmaxf(v, dpp_f<0x140>(v));
    { const auto r = __builtin_amdgcn_permlane16_swap(__float_as_uint(v), __float_as_uint(v), false, false); v = fmaxf(__uint_as_float(r[0]), __uint_as_float(r[1])); }
    { const auto r = __builtin_amdgcn_permlane32_swap(__float_as_uint(v), __float_as_uint(v), false, false); v = fmaxf(__uint_as_float(r[0]), __uint_as_float(r[1])); }
    return v;
}
__device__ __forceinline__ int crow(int r, int hi) { return (r & 3) + 8 * (r >> 2) + 4 * hi; }
__device__ __forceinline__ float silu_f(float x) { return x / (1.0f + __expf(-x)); }
__device__ __forceinline__ float sigmoid_f(float x) { return 1.0f / (1.0f + __expf(-x)); }
__device__ __forceinline__ int v_st(int k, int c) { const int kk = (k & ~0xC) | ((k & 4) << 1) | ((k & 8) >> 1); return ((kk >> 3) * 4 + (c >> 5)) * 512 + ((kk & 7) * 32 + (c & 31)) * 2; }
__device__ __forceinline__ int v_rd_base(int lane) { return ((lane & 3) << 3) | (((lane >> 2) & 3) << 6) | (((lane >> 4) & 1) << 5) | (((lane >> 5) & 1) << 8); }
__host__ __device__ constexpr int v_rd_off(int d0, int ks, int half) { return d0 * 512 + ks * 4096 + half * 2048; }
typedef short v4i16_t __attribute__((ext_vector_type(4)));
__device__ __forceinline__ bf16x8 vfrag(LAS unsigned char* tile_rd  , int d0, int ks) {
    const v4i16_t lo = __builtin_amdgcn_ds_read_tr16_b64_v4i16((LAS v4i16_t*)(tile_rd + v_rd_off(d0, ks, 0)));
    const v4i16_t hi = __builtin_amdgcn_ds_read_tr16_b64_v4i16((LAS v4i16_t*)(tile_rd + v_rd_off(d0, ks, 1)));
    return (bf16x8){lo[0], lo[1], lo[2], lo[3], hi[0], hi[1], hi[2], hi[3]};
}

struct Args { const float* in[35]; float* out; unsigned char* ws; int ph_lo, ph_hi; };

struct Frame { LAS unsigned char* lds; int tid, lane, wave, G, bx, kz; };
#define CAS __attribute__((address_space(4)))
__device__ __forceinline__ const float* kin_(int kz, int i) { return *(const float* const CAS*)((const CAS char*)__builtin_amdgcn_kernarg_segment_ptr() + kz + 8 * i); }
#define KIN(F, i) kin_((F).kz, (i))
#define KOUT(F) ((float*)kin_((F).kz, 35))
#define KWS(F) ((unsigned char*)kin_((F).kz, 36))
static_assert(sizeof(Args) == 37 * 8 + 8, "Args layout");

__device__ __forceinline__ void ph0_mod_tables(Frame& F) {
    const float* c = KIN(F, 1); const float* cctx = KIN(F, 3); const float* wmod = KIN(F, 4);
    LAS float* sv = (LAS float*)F.lds;
    for (int vb = F.bx; vb < 256; vb += F.G) {
    const int l = vb >> 7, rem = vb & 127, nch = rem & 7, kch = rem >> 3, k0 = kch * 64;
    if (F.tid < 192) { const int v = F.tid >> 6, k = F.tid & 63; const float x = (v < 2) ? c[v * DM + k0 + k] : cctx[k0 + k]; sv[v * 64 + k] = silu_f(x); }
    __syncthreads();
    if (F.tid < 384) {
        const int col = nch * 768 + F.tid * 2;
        const float* W = wmod + ((size_t)l * DM + k0) * 6144 + col;
        f32x2 a0 = {0.f, 0.f}, a1 = {0.f, 0.f}, a2 = {0.f, 0.f};
#pragma unroll 8
        for (int k = 0; k < 64; ++k) { const f32x2 w = *(const f32x2*)(W + (size_t)k * 6144); a0 += w * sv[k]; a1 += w * sv[64 + k]; a2 += w * sv[128 + k]; }
        float* mp = (float*)(KWS(F) + WS_MODP) + (size_t)kch * 5 * 6144 + col;
        if (l == 0) { *(f32x2*)(mp + 0 * 6144) = a0; *(f32x2*)(mp + 1 * 6144) = a1; *(f32x2*)(mp + 2 * 6144) = a2; }
        else { *(f32x2*)(mp + 3 * 6144) = a0; *(f32x2*)(mp + 4 * 6144) = a1; }
    }
    __syncthreads();
    }
    const int bx = F.bx;
    unsigned char* tb = KWS(F) + WS_TAB;
    const int gid = bx * NTHR + F.tid, NG = F.G * NTHR;
    const float s128 = 0.08838834764831845f;
    for (int i = gid; i < 5120; i += NG) {
        const int pos = i >> 4, f = i & 15; const int p = pos < 256 ? pos : pos - 256;
        const float inv = powf(10000.0f, -((float)f / 16.0f)); const float ang = (float)p * inv;
        ((float*)(tb + TB_COS))[i] = (float)cos((double)ang); ((float*)(tb + TB_SIN))[i] = (float)sin((double)ang);
    }
    for (int i = gid; i < 32768; i += NG) {
        const int j8 = i & 7, ln = (i >> 3) & 63, ks = (i >> 9) & 7, nb = i >> 12;
        const int n = 32 * nb + (ln & 31), cc = 16 * ks + 8 * (ln >> 5) + j8, part = n >> 7, jj = n & 127, m = (jj * cc) & 127;
        const double a = (double)m / 64.0; const float v = (part == 0 ? (float)cospi(a) : -(float)sinpi(a)) * s128;
        ((bf16_t*)(tb + TB_CS))[i] = (bf16_t)f2bf(v);
    }
    for (int i = gid; i < 65536; i += NG) {
        const int j8 = i & 7, ln = (i >> 3) & 63, ks = (i >> 9) & 15, mb = i >> 13;
        const int m = 32 * mb + (ln & 31), k = 16 * ks + 8 * (ln >> 5) + j8, mpart = m >> 7, k1 = m & 127, part = k >> 7, t1 = k & 127, ph = (k1 * t1) & 127;
        const double a = (double)ph / 64.0; const float cs = (float)cospi(a), sn = (float)sinpi(a);
        const float v = (mpart == 0 ? (part == 0 ? cs : sn) : (part == 0 ? -sn : cs)) * s128;
        ((bf16_t*)(tb + TB_AF))[i] = (bf16_t)f2bf(v);
    }
    for (int i = gid; i < 32768; i += NG) {
        const int j8 = i & 7, ln = (i >> 3) & 63, ks = (i >> 9) & 15, mb = i >> 13;
        const int k2 = 32 * mb + (ln & 31), k = 16 * ks + 8 * (ln >> 5) + j8, part = k >> 7, t2 = k & 127, ps = (k2 * t2) & 127;
        const double a = (double)ps / 64.0; const float v = (part == 0 ? (float)cospi(a) : (float)sinpi(a)) * s128;
        ((bf16_t*)(tb + TB_A3))[i] = (bf16_t)f2bf(v);
    }
    for (int i = gid; i < 16384; i += NG) {
        const int t2 = i >> 7, k1 = i & 127; const double a = (double)((k1 * t2) & 16383) / 8192.0;
        ((f32x2*)(tb + TB_TW))[i] = (f32x2){(float)cospi(a), (float)sinpi(a)};
    }
    const float* gws = KIN(F, 25);
    for (int i = gid; i < 65536; i += NG) ((bf16_t*)(tb + TB_WS))[i] = (bf16_t)f2bf(gws[i]);
}

__device__ __forceinline__ void transpose_item(const float* W, int K, int ldw, int k0, int n_src0, bf16_t* WT, int row_dst0, LAS float* scr, int lane) {
#pragma unroll 8
    for (int i = 0; i < 32; ++i) { const int kk = 2 * i + (lane >> 5); scr[kk * 33 + (lane & 31)] = W[(size_t)(k0 + kk) * ldw + n_src0 + (lane & 31)]; }
    asm volatile("s_waitcnt lgkmcnt(0)" ::: "memory");
    const int c = lane & 7;
#pragma unroll
    for (int j = 0; j < 4; ++j) { const int n = (lane >> 3) + 8 * j; const LAS float* s = scr + (8 * c) * 33 + n;
        u32x4 o; o.x = pk2(s[0 * 33], s[1 * 33]); o.y = pk2(s[2 * 33], s[3 * 33]); o.z = pk2(s[4 * 33], s[5 * 33]); o.w = pk2(s[6 * 33], s[7 * 33]);
        *(u32x4*)(WT + (size_t)(row_dst0 + n) * K + k0 + 8 * c) = o; }
    asm volatile("s_waitcnt lgkmcnt(0)" ::: "memory");
}
__device__ __forceinline__ void transpose_item_fp8(const float* W, int K, int ldw, int k0, int n_src0, unsigned char* WT8, int row_dst0, float scale, LAS float* scr, int lane) {
#pragma unroll 8
    for (int i = 0; i < 64; ++i) { const int kk = 2 * i + (lane >> 5); scr[kk * 33 + (lane & 31)] = W[(size_t)(k0 + kk) * ldw + n_src0 + (lane & 31)]; }
    asm volatile("s_waitcnt lgkmcnt(0)" ::: "memory");
    const int q = lane & 3;
#pragma unroll
    for (int j = 0; j < 2; ++j) { const int n = (lane >> 2) + 16 * j; const LAS float* s = scr + (32 * q) * 33 + n; unsigned w[8];
#pragma unroll
        for (int t = 0; t < 8; ++t) w[t] = pk4_fp8(s[(4 * t) * 33] * scale, s[(4 * t + 1) * 33] * scale, s[(4 * t + 2) * 33] * scale, s[(4 * t + 3) * 33] * scale);
        unsigned char* dst = WT8 + (size_t)(row_dst0 + n) * K + k0 + 32 * q;
        *(u32x4*)dst = (u32x4){w[0], w[1], w[2], w[3]}; *(u32x4*)(dst + 16) = (u32x4){w[4], w[5], w[6], w[7]}; }
    asm volatile("s_waitcnt lgkmcnt(0)" ::: "memory");
}
__device__ __forceinline__ void ph1_convert(Frame& F) {
    {
        const int gid = F.bx * NTHR + F.tid;
        if (gid < 5 * 6144) { const int vec = gid / 6144, n = gid % 6144, l = vec < 3 ? 0 : 1; float s = KIN(F, 5)[l * 6144 + n];
            const float* mp = (const float*)(KWS(F) + WS_MODP) + (size_t)vec * 6144 + n;
#pragma unroll
            for (int kc = 0; kc < 16; ++kc) s += mp[(size_t)kc * 5 * 6144];
            ((float*)(KWS(F) + WS_MOD))[gid] = s; }
    }
    LAS float* scr = (LAS float*)(F.lds + F.wave * 16896);
    const int gw = F.bx * NWAVES + F.wave, NGW = F.G * NWAVES;
    constexpr int I_EVIN = 16 * 80, I_EVOUT = 16 * 32, I_ODIN = 16 * 48, I_ODOUT = 16 * 32, I_DENSE = I_EVIN + I_EVOUT + I_ODIN + I_ODOUT;
    constexpr int I_GU = 64 * 512, I_DN = 64 * 256, NITEMS = I_DENSE + I_GU + I_DN;
    for (int it = gw; it < NITEMS; it += NGW) {
        int r = it;
        if (r < I_EVIN) { const int kb = r / 80, nb = r % 80, n0 = 32 * nb; int src = n0;
            if (n0 >= 1536) { const int u = (n0 - 1536) >> 8, w = (n0 - 1536) & 255; src = (w < 128) ? 1536 + 128 * u + w : 2048 + 128 * u + (w - 128); }
            transpose_item(KIN(F, 10), DM, 2560, 64 * kb, src, (bf16_t*)(KWS(F) + WS_WEVIN), n0, scr, F.lane); continue; } r -= I_EVIN;
        if (r < I_EVOUT) { const int kb = r / 32, nb = r % 32; transpose_item(KIN(F, 11), DM, 1024, 64 * kb, 32 * nb, (bf16_t*)(KWS(F) + WS_WEVOUT), 32 * nb, scr, F.lane); continue; } r -= I_EVOUT;
        if (r < I_ODIN) { const int kb = r / 48, nb = r % 48; transpose_item(KIN(F, 21), DM, 1536, 64 * kb, 32 * nb, (bf16_t*)(KWS(F) + WS_WODIN), 32 * nb, scr, F.lane); continue; } r -= I_ODIN;
        if (r < I_ODOUT) { const int kb = r / 32, nb = r % 32; transpose_item(KIN(F, 22), DM, 1024, 64 * kb, 32 * nb, (bf16_t*)(KWS(F) + WS_WODOUT), 32 * nb, scr, F.lane); continue; } r -= I_ODOUT;
        if (r < I_GU) { const int le = r >> 9, q = r & 511, kb = q >> 6, nb = q & 63, n0 = 32 * nb; const int u = n0 >> 8, w = n0 & 255;
            const int src = (w < 128) ? 128 * u + w : 1024 + 128 * u + (w - 128);
            transpose_item_fp8(KIN(F, 31) + (size_t)le * DM * 2048, DM, 2048, 128 * kb, src, (unsigned char*)(KWS(F) + WS_WGU) + (size_t)le * 2048 * DM, n0, WGU_SCALE, scr, F.lane); continue; } r -= I_GU;
        { const int le = r >> 8, q = r & 255, kb = q >> 5, nb = q & 31;
            transpose_item_fp8(KIN(F, 33) + (size_t)le * DM * 1024, DM, 1024, 128 * kb, 32 * nb, (unsigned char*)(KWS(F) + WS_WD) + (size_t)le * 1024 * DM, 32 * nb, WD_SCALE, scr, F.lane); }
    }
}

__device__ __forceinline__ void mod_row(const float* xrow, const float* sh, const float* sc, bf16_t* orow, int lane) {
    f32x4 x[4], a[4], b[4];
#pragma unroll
    for (int j = 0; j < 4; ++j) { const int d = 4 * lane + 256 * j; x[j] = *(const f32x4*)(xrow + d); a[j] = *(const f32x4*)(sc + d); b[j] = *(const f32x4*)(sh + d); }
    asm volatile("" ::: "memory");
#pragma unroll
    for (int j = 0; j < 4; ++j) { const int d = 4 * lane + 256 * j;
        const f32x4 v = x[j] * (a[j] + 1.0f) + b[j]; u32x2 w; w.x = pk2(v[0], v[1]); w.y = pk2(v[2], v[3]); *(u32x2*)(orow + d) = w; }
}
__device__ __forceinline__ void ph2_modulate(Frame& F) {
    const float* mod = (const float*)(KWS(F) + WS_MOD); bf16_t* U = (bf16_t*)(KWS(F) + WS_U);
    const int gw = F.bx * NWAVES + F.wave, NGW = F.G * NWAVES;
    for (int r = gw; r < T + NCTX; r += NGW) {
        if (r < T) { const int b = r >> 14; mod_row(KIN(F, 0) + (size_t)r * DM, mod + b * 6144, mod + b * 6144 + 1024, U + (size_t)r * DM, F.lane); }
        else { mod_row(KIN(F, 2) + (size_t)(r - T) * DM, mod + 2 * 6144, mod + 2 * 6144 + 1024, U + (size_t)r * DM, F.lane); }
    }
}

struct EvInOrder {
    pg8::StaticOrder so;
    __device__ bool next(int i, pg8::Unit& u) const {
        const long L = (long)i * so.G + so.c;
        if (L < so.nwg) return so.map(L, u);
        const int x = (int)(L - so.nwg); if (x >= 8) return false;
        u.pm = 128 + (x >> 2); u.pn = 2 + (x & 3); u.a0 = 0; u.a1 = 0; u.a2 = 256; return true;
    }
    __device__ __forceinline__ unsigned arow(const pg8::Unit&, int) const { return 0u; }
};
__device__ __forceinline__ int vpos64(int k) { return 32 * ((k >> 2) & 1) + 16 * (k >> 5) + ((k & 3) + 4 * ((k & 31) >> 3)); }
struct EpiEvIn {
    static constexpr bool PERM = false, HAS_PRE = false;
    unsigned char *Q8, *K8, *V8T; bf16_t* Ab; const float* cosT; const float* sinT;
    __device__ __forceinline__ void operator()(const f32x4 (&acc)[2][2][4][2], const pg8::Unit& u, int wr, int wc, int fr, int fq) const {
        const int pn = u.pn;
        if (pn < 4) {
            const int kind = pn >> 1, colbase = (pn & 1) * 256 + wc * 32 + 4 * fq; const bool isctx = u.pm >= 128;
            const float sc = (kind == 0) ? QSCALE : 1.0f;
#define QK_ROW(ai, m, CS, SN) do { const int row = u.pm * 256 + (ai) * 128 + wr * 64 + (m) * 16 + fr; int b_, key_; \
                if (!isctx) { b_ = row >> 14; key_ = row & (SEQ - 1); } else { const int rc_ = row - T; b_ = rc_ >> 8; key_ = SEQ + (rc_ & 255); } \
                unsigned char* dst = (kind == 0) ? Q8 + (size_t)row * 512 : K8 + (size_t)(b_ * NKEY + key_) * 512; \
                _Pragma("unroll") for (int bj = 0; bj < 2; ++bj) { const f32x4 x1 = acc[ai][bj][m][0], x2 = acc[ai][bj][m][1]; \
                    const f32x4 o1 = (x1 * (CS) - x2 * (SN)) * sc, o2 = (x1 * (SN) + x2 * (CS)) * sc; \
                    *(unsigned*)(dst + colbase + bj * 128) = pk4_fp8(o1[0], o1[1], o1[2], o1[3]); *(unsigned*)(dst + colbase + bj * 128 + 16) = pk4_fp8(o2[0], o2[1], o2[2], o2[3]); } } while (0)
            if (wc & 1) {
                f32x4 cs[4], sn[4];
#pragma unroll
                for (int m = 0; m < 4; ++m) { cs[m] = (f32x4){1.f, 1.f, 1.f, 1.f}; sn[m] = (f32x4){0.f, 0.f, 0.f, 0.f};
                    if (!isctx) { const int pos = 256 + m * 16 + fr; cs[m] = *(const f32x4*)(cosT + pos * 16 + 4 * fq); sn[m] = *(const f32x4*)(sinT + pos * 16 + 4 * fq); } }
                asm volatile("" ::: "memory");
#pragma unroll
                for (int ai = 0; ai < 2; ++ai)
#pragma unroll
                    for (int m = 0; m < 4; ++m) QK_ROW(ai, m, cs[m], sn[m]);
            } else {
                f32x4 cs[2], sn[2];
#pragma unroll
                for (int ai = 0; ai < 2; ++ai) { cs[ai] = (f32x4){1.f, 1.f, 1.f, 1.f}; sn[ai] = (f32x4){0.f, 0.f, 0.f, 0.f};
                    if (!isctx) { const int pos = ((u.pm * 256 + ai * 128 + wr * 64) & (SEQ - 1)) >> 6; cs[ai] = *(const f32x4*)(cosT + pos * 16 + 4 * fq); sn[ai] = *(const f32x4*)(sinT + pos * 16 + 4 * fq); } }
                asm volatile("" ::: "memory");
#pragma unroll
                for (int ai = 0; ai < 2; ++ai)
#pragma unroll
                    for (int m = 0; m < 4; ++m) QK_ROW(ai, m, cs[ai], sn[ai]);
            }
#undef QK_ROW
        } else if (pn < 6) {
            const int colbase = (pn & 1) * 256 + wc * 32 + 4 * fq;
#pragma unroll
            for (int ai = 0; ai < 2; ++ai)
#pragma unroll
                for (int m = 0; m < 4; ++m) {
                    const int row = u.pm * 256 + ai * 128 + wr * 64 + m * 16 + fr; const bool isctx = row >= T;
                    int b, key;
                    if (!isctx) { b = row >> 14; key = row & (SEQ - 1); } else { const int rc = row - T; b = rc >> 8; key = SEQ + (rc & 255); }
                    const size_t kofs = (size_t)(key & ~63) + vpos64(key & 63);
#pragma unroll
                    for (int bj = 0; bj < 2; ++bj)
#pragma unroll
                        for (int n = 0; n < 2; ++n) { const f32x4 x = acc[ai][bj][m][n]; const unsigned w = pk4_fp8(x[0], x[1], x[2], x[3]); const int vcol = colbase + bj * 128 + n * 16;
                            unsigned char* dst = V8T + ((size_t)(b * 4 + (vcol >> 7)) * 128 + (vcol & 127)) * NKEY + kofs;
                            dst[0] = (unsigned char)(w & 0xff); dst[NKEY] = (unsigned char)((w >> 8) & 0xff); dst[2 * NKEY] = (unsigned char)((w >> 16) & 0xff); dst[3 * NKEY] = (unsigned char)(w >> 24); }
                }
        } else {
            const int colbase = (pn - 6) * 128 + wc * 32 + 4 * fq;
#pragma unroll
            for (int ai = 0; ai < 2; ++ai)
#pragma unroll
                for (int m = 0; m < 4; ++m) {
                    const int row = u.pm * 256 + ai * 128 + wr * 64 + m * 16 + fr; if (row >= T) continue;
                    bf16_t* dst = Ab + (size_t)row * 512 + colbase;
#pragma unroll
                    for (int n = 0; n < 2; ++n) { const f32x4 v = acc[ai][0][m][n], g = acc[ai][1][m][n]; f32x4 o;
#pragma unroll
                        for (int j = 0; j < 4; ++j) o[j] = v[j] * sigmoid_f(g[j]);
                        u32x2 w; w.x = pk2(o[0], o[1]); w.y = pk2(o[2], o[3]); *(u32x2*)(dst + n * 16) = w; }
                }
        }
    }
};

__device__ __forceinline__ void ph4_conv(Frame& F) {
    const bf16_t* Ab = (const bf16_t*)(KWS(F) + WS_AB); bf16_t* MIX = (bf16_t*)(KWS(F) + WS_MIX);
    const float* cw = KIN(F, 12); const float* cb = KIN(F, 13); const float* lg = KIN(F, 14); const float* lb = KIN(F, 15);
    LAS bf16_t* At = (LAS bf16_t*)F.lds;
    LAS float* Yt = (LAS float*)(F.lds + 65536);
    const int ch = F.tid;
    float w[31];
#pragma unroll
    for (int j = 0; j < 31; ++j) w[j] = cw[j * 512 + ch];
    const float bias = cb[ch];
#define CONV_STAGE(tile_) do { const int b_ = (tile_) >> 9, t0_ = ((tile_) & 511) * 32; \
        _Pragma("unroll") for (int k_ = 0; k_ < 8; ++k_) { const int row_ = F.wave + 8 * k_; if (row_ < 62) { const int t_ = t0_ - 15 + row_; \
            if (t_ >= 0 && t_ < SEQ) __builtin_amdgcn_global_load_lds((const unsigned*)(Ab + ((size_t)(b_ * SEQ + t_)) * 512 + F.lane * 8), (LAS unsigned*)(At + row_ * 512), 16, 0, 0); \
            else { const unsigned z_ = (unsigned)F.kz; const u32x4 zv_ = {z_, z_, z_, z_}; *(LAS u32x4*)(At + row_ * 512 + F.lane * 8) = zv_; } } } } while (0)
    const f32x4 g0 = *(const f32x4*)(lg + 8 * F.lane), g1 = *(const f32x4*)(lg + 8 * F.lane + 4), b0 = *(const f32x4*)(lb + 8 * F.lane), b1 = *(const f32x4*)(lb + 8 * F.lane + 4);
    if (F.bx < T / 32) CONV_STAGE(F.bx);
    for (int tile = F.bx; tile < T / 32; tile += F.G) {
        const int b = tile >> 9, t0 = (tile & 511) * 32;
        asm volatile("s_waitcnt vmcnt(0)" ::: "memory");
        __syncthreads();
        float a[62];
#pragma unroll
        for (int r = 0; r < 62; ++r) a[r] = bf2f(At[r * 512 + ch]);
#pragma unroll
        for (int t = 0; t < 32; ++t) { float y = bias;
#pragma unroll
            for (int j = 0; j < 31; ++j) y = fmaf(a[t + j], w[j], y);
            Yt[t * 512 + ch] = y; }
        __syncthreads();
        if (tile + F.G < T / 32) CONV_STAGE(tile + F.G);
#pragma unroll
        for (int q = 0; q < 4; ++q) { const int t = F.wave * 4 + q; const LAS float* yr = Yt + t * 512 + 8 * F.lane;
            const f32x4 y0 = *(const LAS f32x4*)yr, y1 = *(const LAS f32x4*)(yr + 4);
            float s = (y0[0] + y0[1]) + (y0[2] + y0[3]) + (y1[0] + y1[1]) + (y1[2] + y1[3]);
            const float mean = wave_sum(s) * (1.0f / 512.0f);
            const f32x4 d0 = y0 - mean, d1 = y1 - mean;
            float q2 = (d0[0] * d0[0] + d0[1] * d0[1]) + (d0[2] * d0[2] + d0[3] * d0[3]) + (d1[0] * d1[0] + d1[1] * d1[1]) + (d1[2] * d1[2] + d1[3] * d1[3]);
            const float rstd = 1.0f / sqrtf(wave_sum(q2) * (1.0f / 512.0f) + LN_EPS);
            f32x4 o0 = d0 * rstd * g0 + b0, o1 = d1 * rstd * g1 + b1;
#pragma unroll
            for (int j = 0; j < 4; ++j) { o0[j] = silu_f(o0[j]); o1[j] = silu_f(o1[j]); }
            u32x4 wv; wv.x = pk2(o0[0], o0[1]); wv.y = pk2(o0[2], o0[3]); wv.z = pk2(o1[0], o1[1]); wv.w = pk2(o1[2], o1[3]);
            *(u32x4*)(MIX + (size_t)(b * SEQ + t0 + t) * 1024 + 8 * F.lane) = wv; }
        __syncthreads();
    }
#undef CONV_STAGE
}

namespace att {
constexpr int KVBLK = 64;
constexpr int SHM_V = 128 * 64, SHM_K = 64 * 64;
constexpr int SHM_1 = 32 * 64;
constexpr int NBUF = 5, DIST = 3, TILEB = SHM_V + SHM_1 + SHM_K;
constexpr int OFF_T = 0, OFF_WS = NBUF * TILEB;
constexpr int OFF_NEG = OFF_WS + 2048;
constexpr float PREF = 6.0f, PMAXLOG = 8.0f;
#define SBAR() __builtin_amdgcn_sched_barrier(0)
#define MX3(a, b, c) __builtin_fmaxf(__builtin_fmaxf((a), (b)), (c))
typedef int v8i32a __attribute__((ext_vector_type(8)));
__device__ __forceinline__ f32x16 mfma8(v8i32a a, v8i32a b, f32x16 c) { return __builtin_amdgcn_mfma_scale_f32_32x32x64_f8f6f4(a, b, c, 0, 0, 0, 0x7F7F7F7F, 0, 0x7F7F7F7F); }
template <bool FIRST> __device__ __forceinline__ void partialSM(f32x16& p0, f32x16& p1, f32x16& negm, float& alpha) {
    float a = MX3(p0[0], p0[1], p1[0]), b = MX3(p0[2], p0[3], p1[1]); a = MX3(a, p1[2], p1[3]);
#pragma unroll
    for (int r = 4; r < 16; r += 4) { a = MX3(a, p0[r], p0[r + 1]); b = MX3(b, p0[r + 2], p0[r + 3]); a = MX3(a, p1[r], p1[r + 1]); b = MX3(b, p1[r + 2], p1[r + 3]); }
    float pmax = fmaxf(a, b);
    { auto rr = __builtin_amdgcn_permlane32_swap(__float_as_uint(pmax), __float_as_uint(pmax), false, false);
      pmax = fmaxf(__uint_as_float(rr[0]), __uint_as_float(rr[1])); }
    alpha = 1.f;
    if (FIRST || __builtin_expect(__any(pmax > PMAXLOG), 0)) {
        const float dl = FIRST ? (pmax - PREF) : fmaxf(pmax - PREF, 0.f); const float nm = negm[0] - dl; alpha = __builtin_amdgcn_exp2f(-dl);
#pragma unroll
        for (int r = 0; r < 16; ++r) { p0[r] -= dl; p1[r] -= dl; negm[r] = nm; }
    }
#pragma unroll
    for (int r = 0; r < 16; ++r) p0[r] = __builtin_amdgcn_exp2f(p0[r]);
}
__device__ __forceinline__ void finishSM(f32x16& p0, f32x16& p1, v8i32a& pf) {
#pragma unroll
    for (int r = 0; r < 16; ++r) p1[r] = __builtin_amdgcn_exp2f(p1[r]);
#pragma unroll
    for (int i = 0; i < 4; ++i) { pf[i] = (int)pk4_fp8(p0[4 * i], p0[4 * i + 1], p0[4 * i + 2], p0[4 * i + 3]); pf[4 + i] = (int)pk4_fp8(p1[4 * i], p1[4 * i + 1], p1[4 * i + 2], p1[4 * i + 3]); }
}
__device__ __forceinline__ v8i32a frag32(const LAS unsigned char* base, int a0, int a1) {
    const bf16x8 lo = *(const LAS bf16x8*)(base + a0), hi = *(const LAS bf16x8*)(base + a1);
    return __builtin_bit_cast(v8i32a, __builtin_shufflevector(lo, hi, 0, 1, 2, 3, 4, 5, 6, 7, 8, 9, 10, 11, 12, 13, 14, 15));
}
__device__ __forceinline__ void attn_pass(const unsigned char* __restrict__ Qw, const unsigned char* __restrict__ Kh, const unsigned char* __restrict__ Vt, LAS unsigned char* lds, f32x16 (&o)[4], f32x16& lacc, const int tid, const int wid) {
    const int lane = tid & 63, r32 = lane & 31, hi = lane >> 5;
    LAS float* al_l = (LAS float*)(lds + OFF_WS) + wid * 64 + 32;
    f32x16 negm = f32x16{}; lacc = f32x16{};
#pragma unroll
    for (int d = 0; d < 4; ++d) o[d] = f32x16{};
    const v8i32a qf = __builtin_bit_cast(v8i32a, __builtin_shufflevector(*(const bf16x8*)Qw, *(const bf16x8*)(Qw + 16), 0, 1, 2, 3, 4, 5, 6, 7, 8, 9, 10, 11, 12, 13, 14, 15));
    const int sw = (r32 >> 2) & 3, a0 = r32 * 64 + (((2 * hi) ^ sw) << 4), a1 = r32 * 64 + (((2 * hi + 1) ^ sw) << 4);
    const int drow = 16 * wid + (lane >> 2), dch = (lane & 3) ^ ((drow >> 2) & 3);
    const unsigned vsrc = (unsigned)(drow * NKEY + dch * 16), ksrc = (unsigned)(drow * 512 + dch * 16); const bool kw = wid < 4;
    LAS unsigned char* T_lds = lds + OFF_T;
#define DMA(t, bi) do { __builtin_amdgcn_global_load_lds((const unsigned*)((const char*)Vt + (size_t)(t) * 64 + vsrc), (LAS unsigned*)(T_lds + (bi) * TILEB + wid * 1024), 16, 0, 0); \
    if (kw) __builtin_amdgcn_global_load_lds((const unsigned*)((const char*)Kh + (size_t)(t) * (64 * 512) + ksrc), (LAS unsigned*)(T_lds + (bi) * TILEB + SHM_V + SHM_1 + wid * 1024), 16, 0, 0); } while (0)
#define WAITBAR(n) do { if (kw) asm volatile("s_waitcnt vmcnt(%0) lgkmcnt(0)" :: "n"(2 * (n)) : "memory"); else asm volatile("s_waitcnt vmcnt(%0) lgkmcnt(0)" :: "n"(n) : "memory"); \
    __builtin_amdgcn_s_barrier(); asm volatile("" ::: "memory"); } while (0)
#define RESC(a) do { if (__any((a) < 1.f)) { if (hi == 0) al_l[r32] = (a); asm volatile("s_waitcnt lgkmcnt(0)" ::: "memory"); \
    _Pragma("unroll") for (int r = 0; r < 16; ++r) { const float f_ = al_l[crow(r, hi)]; o[0][r] *= f_; o[1][r] *= f_; o[2][r] *= f_; o[3][r] *= f_; lacc[r] *= f_; } } } while (0)
#define QKT(P0, P1, bi) do { const LAS unsigned char* kb_ = T_lds + (bi) * TILEB + SHM_V + SHM_1; P0 = mfma8(frag32(kb_, a0, a1), qf, negm); P1 = mfma8(frag32(kb_ + 2048, a0, a1), qf, negm); } while (0)
#ifndef MF8_ACC
#define MF8_ACC "+v"
#endif
#define MF8(acc_, v_) asm volatile("v_mfma_scale_f32_32x32x64_f8f6f4 %0, %1, %2, %0, %3, %3 op_sel_hi:[0,0,0]" : MF8_ACC(acc_) : "v"(pf), "v"(v_), "v"(one_sc))
#define PV(bi) do { const LAS unsigned char* vb_ = T_lds + (bi) * TILEB; { const v8i32a v0_ = frag32(vb_, a0, a1), v1_ = frag32(vb_ + 2048, a0, a1); asm volatile("s_nop 1" ::: ); MF8(o[0], v0_); MF8(o[1], v1_); } \
    { const v8i32a v2_ = frag32(vb_ + 4096, a0, a1), v3_ = frag32(vb_ + 6144, a0, a1); MF8(o[2], v2_); MF8(o[3], v3_); } \
    { const v8i32a v4_ = frag32(vb_ + 8192, a0, a1); MF8(lacc, v4_); } } while (0)
    f32x16 pA0, pA1, pB0, pB1; v8i32a pf; constexpr int NT = NKEY / KVBLK;
    const int one_sc = 0x7F7F7F7F;
#define MFQK(P_, kf_) P_ = mfma8(kf_, qf, negm)
#define EX8(P_, b_) do { _Pragma("unroll") for (int r_ = 0; r_ < 8; ++r_) P_[(b_) + r_] = __builtin_amdgcn_exp2f(P_[(b_) + r_]); } while (0)
#if defined(EXP_EXTRA_MFMA)
#define XMF() do { const v8i32a vn_ = frag32(lds + OFF_NEG, a0, a1); MF8(lacc, vn_); MF8(lacc, v4_); } while (0)
#else
#define XMF() do { } while (0)
#endif
#if defined(EXP_EXTRA_LDS)
#define XTRA(A_, B_) do { _Pragma("unroll") for (int r_ = 0; r_ < 5; ++r_) { const v8i32a t_ = frag32(vb_ + 2048 * r_, a0, a1); asm volatile("" :: "v"(t_)); } } while (0)
#elif defined(EXP_EXTRA_EXP)
#define XTRA(A_, B_) do { _Pragma("unroll") for (int r_ = 0; r_ < 16; ++r_) { float t_; asm volatile("v_exp_f32 %0, %1" : "=v"(t_) : "v"(A_[r_])); asm volatile("v_exp_f32 %0, %1" : "=v"(t_) : "v"(B_[r_])); } } while (0)
#elif defined(EXP_EXTRA_ADD)
#define XTRA(A_, B_) do { _Pragma("unroll") for (int r_ = 0; r_ < 16; ++r_) { float t_; asm volatile("v_add_f32 %0, %1, %1" : "=v"(t_) : "v"(A_[r_])); asm volatile("v_add_f32 %0, %1, %1" : "=v"(t_) : "v"(B_[r_])); } } while (0)
#else
#define XTRA(A_, B_) do { } while (0)
#endif
#define STEP(C0, C1, P0, P1, HAVEPREV, FIRSTT, tnext, dodma) do { \
    if (dodma) DMA(tnext, bd); \
    const LAS unsigned char* kb_ = T_lds + bc * TILEB + SHM_V + SHM_1; const LAS unsigned char* vb_ = T_lds + bp * TILEB; \
    const v8i32a kf0_ = frag32(kb_, a0, a1), kf1_ = frag32(kb_ + 2048, a0, a1); v8i32a v0_, v1_, v2_, v3_, v4_; if (HAVEPREV) { v0_ = frag32(vb_, a0, a1); v1_ = frag32(vb_ + 2048, a0, a1); } \
    SBAR(); MFQK(C0, kf0_); if (HAVEPREV) EX8(P1, 0); SBAR(); \
    MFQK(C1, kf1_); if (HAVEPREV) { EX8(P1, 8); _Pragma("unroll") for (int i_ = 0; i_ < 4; ++i_) { pf[i_] = (int)pk4_fp8(P0[4 * i_], P0[4 * i_ + 1], P0[4 * i_ + 2], P0[4 * i_ + 3]); pf[4 + i_] = (int)pk4_fp8(P1[4 * i_], P1[4 * i_ + 1], P1[4 * i_ + 2], P1[4 * i_ + 3]); } } SBAR(); \
    float al_ = 1.f; \
    if (HAVEPREV) { asm volatile("s_nop 1" ::: ); MF8(o[0], v0_); SBAR(); MF8(o[1], v1_); v2_ = frag32(vb_ + 4096, a0, a1); v3_ = frag32(vb_ + 6144, a0, a1); v4_ = frag32(vb_ + 8192, a0, a1); SBAR(); } \
    else { asm volatile("s_nop 15\n\ts_nop 15\n\ts_nop 15\n\ts_nop 15" ::: "memory"); }     \
    float mxa_ = MX3(C0[0], C0[1], C1[0]), mxb_ = MX3(C0[2], C0[3], C1[1]); mxa_ = MX3(mxa_, C1[2], C1[3]); \
    _Pragma("unroll") for (int r_ = 4; r_ < 16; r_ += 4) { mxa_ = MX3(mxa_, C0[r_], C0[r_ + 1]); mxb_ = MX3(mxb_, C0[r_ + 2], C0[r_ + 3]); mxa_ = MX3(mxa_, C1[r_], C1[r_ + 1]); mxb_ = MX3(mxb_, C1[r_ + 2], C1[r_ + 3]); } \
    float pm_ = fmaxf(mxa_, mxb_); { auto rr_ = __builtin_amdgcn_permlane32_swap(__float_as_uint(pm_), __float_as_uint(pm_), false, false); pm_ = fmaxf(__uint_as_float(rr_[0]), __uint_as_float(rr_[1])); } \
    SBAR(); \
    if (HAVEPREV) { MF8(o[2], v2_); SBAR(); MF8(o[3], v3_); SBAR(); } \
    if (FIRSTT || __builtin_expect(__any(pm_ > PMAXLOG), 0)) { const float dl_ = FIRSTT ? (pm_ - PREF) : fmaxf(pm_ - PREF, 0.f); const float nm_ = negm[0] - dl_; al_ = __builtin_amdgcn_exp2f(-dl_); \
        _Pragma("unroll") for (int r_ = 0; r_ < 16; ++r_) { C0[r_] -= dl_; C1[r_] -= dl_; negm[r_] = nm_; } } \
    SBAR(); \
    if (HAVEPREV) { MF8(lacc, v4_); XMF(); SBAR(); } \
    EX8(C0, 0); EX8(C0, 8); XTRA(C0, C1); SBAR(); \
    if (HAVEPREV) { if (__any(al_ < 1.f)) { asm volatile("s_nop 15\n\ts_nop 15" ::: "memory"); if (hi == 0) al_l[r32] = al_; asm volatile("s_waitcnt lgkmcnt(0)" ::: "memory"); \
        _Pragma("unroll") for (int r_ = 0; r_ < 16; ++r_) { const float f_ = al_l[crow(r_, hi)]; o[0][r_] *= f_; o[1][r_] *= f_; o[2][r_] *= f_; o[3][r_] *= f_; lacc[r_] *= f_; } } } \
    } while (0)
    int bp = 4, bc = 0, bd = 3;
#define ROT() do { bp = bc; bc = (bc == NBUF - 1) ? 0 : bc + 1; bd = (bd == NBUF - 1) ? 0 : bd + 1; } while (0)
#ifdef EXP_EXTRA_BAR
#define XBAR() do { __builtin_amdgcn_s_barrier(); asm volatile("" ::: "memory"); } while (0)
#else
#define XBAR() do { } while (0)
#endif
    DMA(0, 0); DMA(1, 1); DMA(2, 2); WAITBAR(2);
    STEP(pA0, pA1, pB0, pB1, false, true, 3, true); WAITBAR(2); ROT();
#pragma unroll 1
    for (int j = 1; j + 1 < NT; j += 2) {
        const bool more = (j + 4 < NT);
        STEP(pB0, pB1, pA0, pA1, true, false, j + 3, more); if (more) WAITBAR(2); else WAITBAR(0); XBAR(); ROT();
        STEP(pA0, pA1, pB0, pB1, true, false, j + 4, more); if (more) WAITBAR(2); else WAITBAR(0); XBAR(); ROT();
    }
    STEP(pB0, pB1, pA0, pA1, true, false, 0, false); WAITBAR(0); ROT();
    { EX8(pB1, 0); EX8(pB1, 8);
#pragma unroll
      for (int i_ = 0; i_ < 4; ++i_) { pf[i_] = (int)pk4_fp8(pB0[4 * i_], pB0[4 * i_ + 1], pB0[4 * i_ + 2], pB0[4 * i_ + 3]); pf[4 + i_] = (int)pk4_fp8(pB1[4 * i_], pB1[4 * i_ + 1], pB1[4 * i_ + 2], pB1[4 * i_ + 3]); }
      SBAR(); PV(bp); }
#undef STEP
#undef MFQK
#undef EX8
    __syncthreads();
#undef ROT
#undef DMA
#undef WAITBAR
#undef RESC
#undef QKT
#undef PV
#undef MF8
}
}

__device__ __forceinline__ void ph4_attention(Frame& F) {
    const unsigned char* Q8 = (const unsigned char*)(KWS(F) + WS_Q); const unsigned char* K8 = (const unsigned char*)(KWS(F) + WS_K); const unsigned char* V8T = (const unsigned char*)(KWS(F) + WS_V);
    float* O0 = (float*)(KWS(F) + WS_O0); bf16_t* MIX = (bf16_t*)(KWS(F) + WS_MIX); const float* gn = KIN(F, 20);
    const int lane = F.lane, wid = F.wave;
    float lam;
    { const float a = wave_sum(KIN(F, 16)[lane] * KIN(F, 17)[lane]), b = wave_sum(KIN(F, 18)[lane] * KIN(F, 19)[lane]); lam = __builtin_bit_cast(float, __builtin_amdgcn_readfirstlane(__builtin_bit_cast(int, __expf(a) - __expf(b) + LAM_INIT0))); }
    __syncthreads();
    const unsigned kz_ = (unsigned)F.kz;
    for (int i = F.tid; i < att::NBUF * (att::SHM_1 / 16); i += NTHR) { const int bi = i / (att::SHM_1 / 16), q = i % (att::SHM_1 / 16);
        *(LAS u32x4*)(F.lds + att::OFF_T + bi * att::TILEB + att::SHM_V + q * 16) = (u32x4){0x38383838u + kz_, 0x38383838u + kz_, 0x38383838u + kz_, 0x38383838u + kz_}; }
#if defined(EXP_EXTRA_MFMA)
    for (int i = F.tid; i < 128; i += NTHR) *(LAS u32x4*)(F.lds + att::OFF_NEG + i * 16) = (u32x4){0xB8B8B8B8u + kz_, 0xB8B8B8B8u + kz_, 0xB8B8B8B8u + kz_, 0xB8B8B8B8u + kz_};
#endif
    __syncthreads();
    const int x = F.bx & 7, jb = F.bx >> 3;
    for (int vb = x; vb < 8; vb += 8) { const int b = vb >> 2, h = vb & 3;
    for (int qb = jb; qb < SEQ / 256; qb += (F.G >> 3)) {
        const long rowbase = (long)b * SEQ + qb * 256 + wid * 32;
        f32x16 o[4]; f32x16 lacc;
#pragma unroll 1
        for (int c = 0; c < 2; ++c) {
            const unsigned char* Qw = Q8 + (rowbase + (lane & 31)) * 512 + h * 128 + c * 64 + (lane >> 5) * 32;
            const unsigned char* Kh = K8 + (long)b * NKEY * 512 + h * 128 + c * 64;
            const unsigned char* Vt = V8T + (long)(b * 4 + h) * 128 * NKEY;
            att::attn_pass(Qw, Kh, Vt, F.lds, o, lacc, F.tid, F.wave);
            int lane_e = lane; asm volatile("" : "+v"(lane_e));
            const int r32 = lane_e & 31, hi = lane_e >> 5;
            asm volatile("s_nop 15\n\ts_nop 15" : "+v"(lacc));
            float rli[16];
#pragma unroll
            for (int r = 0; r < 16; ++r) rli[r] = __builtin_amdgcn_rcpf(lacc[r]);
            if (c == 0) {
#pragma unroll
                for (int r = 0; r < 16; ++r) { const long grow = rowbase + crow(r, hi);
#pragma unroll
                    for (int d0 = 0; d0 < 4; ++d0) O0[grow * 512 + h * 128 + d0 * 32 + r32] = o[d0][r] * rli[r]; }
            } else {
                const float g0 = gn[r32], g1 = gn[32 + r32], g2 = gn[64 + r32], g3 = gn[96 + r32];
                float ov[16][4];
#pragma unroll
                for (int r = 0; r < 16; ++r) { const float* op = O0 + (rowbase + crow(r, hi)) * 512 + h * 128 + r32; ov[r][0] = op[0]; ov[r][1] = op[32]; ov[r][2] = op[64]; ov[r][3] = op[96]; }
                asm volatile("" ::: "memory");
#pragma unroll
                for (int r = 0; r < 16; ++r) { const long grow = rowbase + crow(r, hi);
                    const float v0 = ov[r][0] - lam * (o[0][r] * rli[r]), v1 = ov[r][1] - lam * (o[1][r] * rli[r]), v2 = ov[r][2] - lam * (o[2][r] * rli[r]), v3 = ov[r][3] - lam * (o[3][r] * rli[r]);
                    float ss = (v0 * v0 + v1 * v1) + (v2 * v2 + v3 * v3);
                    ss = half_sum(ss);
                    const float scl = (1.0f - LAM_INIT0) / sqrtf(ss * (1.0f / 128.0f) + LN_EPS);
                    bf16_t* mp = MIX + grow * 1024 + 512 + h * 128 + r32;
                    mp[0] = (bf16_t)f2bf(v0 * scl * g0); mp[32] = (bf16_t)f2bf(v1 * scl * g1); mp[64] = (bf16_t)f2bf(v2 * scl * g2); mp[96] = (bf16_t)f2bf(v3 * scl * g3);
                    if ((r & 3) == 3) asm volatile("" ::: "memory"); }
            }
        }
    } }
}

__device__ __forceinline__ void ph_router(Frame& F, int layer, const float* hin) {
    const float* mod = (const float*)(KWS(F) + WS_MOD) + (size_t)(layer * 3) * 6144;
    const bf16_t* Y = (const bf16_t*)(KWS(F) + WS_Y); float* H1 = (float*)(KWS(F) + WS_H1); unsigned char* U2 = (unsigned char*)(KWS(F) + WS_U2);
    const float* lng = KIN(F, 6) + layer * DM; const float* lnb = KIN(F, 7) + layer * DM;
    const float* rw = KIN(F, 29) + (size_t)layer * DM * NE; const float* rb = KIN(F, 30) + layer * NE;
    unsigned* gcnt = (unsigned*)(KWS(F) + WS_CTL) + CW_CNT + layer * NE;
    unsigned* list = (unsigned*)(KWS(F) + WS_LIST); float* gates = (float*)(KWS(F) + WS_GATES);
    constexpr int RWS = 1028, RSEL = 131584, RVEC = RSEL + 10240;
    LAS float* rwT = (LAS float*)F.lds;
    LAS int* sel_e = (LAS int*)(F.lds + RSEL);
    LAS float* sel_g = (LAS float*)(F.lds + RSEL + 2048);
    LAS unsigned* lcnt = (LAS unsigned*)(F.lds + RSEL + 4096);
    LAS unsigned* lbase = lcnt + 32;
    LAS unsigned* lpos = lcnt + 64;
    LAS float* vG = (LAS float*)(F.lds + RVEC);
    const int lane = F.lane;
    for (int i = F.tid; i < DM * NE; i += NTHR) { const int d = i >> 5, e = i & 31; rwT[e * RWS + d] = rw[i]; }
    __syncthreads();
    for (int blk = F.bx; blk < T / 128; blk += F.G) {
        const int r0 = blk * 128, b = r0 >> 14;
        const float* g1 = mod + b * 6144 + 2048; const float* sh2 = mod + b * 6144 + 3072; const float* sc2 = mod + b * 6144 + 4096;
        if (F.tid < 32) lcnt[F.tid] = 0u;
        for (int i = F.tid; i < DM; i += NTHR) { vG[i] = g1[i]; vG[DM + i] = lng[i]; vG[2 * DM + i] = lnb[i]; vG[3 * DM + i] = sc2[i] + 1.0f; vG[4 * DM + i] = sh2[i]; }
        __syncthreads();
        f32x4 nx[2][4]; u32x2 ny[2][4];
#pragma unroll
        for (int t = 0; t < 2; ++t)
#pragma unroll
            for (int j = 0; j < 4; ++j) { const int d = 4 * lane + 256 * j; const size_t rr = (size_t)(r0 + F.wave * 16 + t); nx[t][j] = *(const f32x4*)(hin + rr * DM + d); ny[t][j] = *(const u32x2*)(Y + rr * DM + d); }
        for (int qq = 0; qq < 8; ++qq) {
            int lane4 = 4 * lane; asm volatile("" : "+v"(lane4));
            const int tl0 = F.wave * 16 + 2 * qq;
            f32x4 pre[2][4]; float s1[2] = {0.f, 0.f}, s2[2] = {0.f, 0.f};
#pragma unroll
            for (int t = 0; t < 2; ++t)
#pragma unroll
                for (int j = 0; j < 4; ++j) { const int d = lane4 + 256 * j; const f32x4 x = nx[t][j]; const u32x2 yw = ny[t][j]; const f32x4 g = *(const LAS f32x4*)(vG + d);
                    f32x4 y; y[0] = __uint_as_float(yw.x << 16); y[1] = __uint_as_float(yw.x & 0xffff0000u); y[2] = __uint_as_float(yw.y << 16); y[3] = __uint_as_float(yw.y & 0xffff0000u);
                    const f32x4 p_ = x * ALPHA + g * y; pre[t][j] = p_; s1[t] += (p_[0] + p_[1]) + (p_[2] + p_[3]); s2[t] += (p_[0] * p_[0] + p_[1] * p_[1]) + (p_[2] * p_[2] + p_[3] * p_[3]); }
            if (qq + 1 < 8) {
#pragma unroll
                for (int t = 0; t < 2; ++t)
#pragma unroll
                    for (int j = 0; j < 4; ++j) { const int d = lane4 + 256 * j; const size_t rr = (size_t)(r0 + tl0 + 2 + t); nx[t][j] = *(const f32x4*)(hin + rr * DM + d); ny[t][j] = *(const u32x2*)(Y + rr * DM + d); } }
            s1[0] = wave_sum(s1[0]); s1[1] = wave_sum(s1[1]); s2[0] = wave_sum(s2[0]); s2[1] = wave_sum(s2[1]);
            f32x4 u2[2][4];
#pragma unroll
            for (int t = 0; t < 2; ++t) { const float mean = s1[t] * (1.0f / DM); const float var = fmaxf(s2[t] * (1.0f / DM) - mean * mean, 0.f); const float rstd = 1.0f / sqrtf(var + LN_EPS); const size_t row = (size_t)(r0 + tl0 + t);
#pragma unroll
                for (int j = 0; j < 4; ++j) { const int d = lane4 + 256 * j; const f32x4 h = (pre[t][j] - mean) * rstd * *(const LAS f32x4*)(vG + DM + d) + *(const LAS f32x4*)(vG + 2 * DM + d);
                    *(f32x4*)(H1 + row * DM + d) = h;
                    u2[t][j] = h * *(const LAS f32x4*)(vG + 3 * DM + d) + *(const LAS f32x4*)(vG + 4 * DM + d);
                    *(unsigned*)(U2 + row * DM + d) = pk4_fp8(u2[t][j][0], u2[t][j][1], u2[t][j][2], u2[t][j][3]); } }
            f32x2 up[4][4];
#pragma unroll
            for (int j = 0; j < 4; ++j)
#pragma unroll
                for (int i = 0; i < 4; ++i) { up[j][i][0] = u2[0][j][i]; up[j][i][1] = u2[1][j][i]; }
            f32x2 P[32];
            f32x4 wc[4], wn[4];
#pragma unroll
            for (int j = 0; j < 4; ++j) wc[j] = *(const LAS f32x4*)(rwT + 4 * lane + 256 * j);
#pragma unroll
            for (int e = 0; e < 32; ++e) {
                if (e + 1 < 32) {
#pragma unroll
                    for (int j = 0; j < 4; ++j) wn[j] = *(const LAS f32x4*)(rwT + (e + 1) * RWS + 4 * lane + 256 * j); }
                f32x2 a0 = {0.f, 0.f}, a1 = {0.f, 0.f};
#pragma unroll
                for (int j = 0; j < 4; ++j) { f32x2 w0 = {wc[j][0], wc[j][0]}, w1 = {wc[j][1], wc[j][1]}, w2 = {wc[j][2], wc[j][2]}, w3 = {wc[j][3], wc[j][3]};
                    a0 = __builtin_elementwise_fma(up[j][0], w0, a0); a1 = __builtin_elementwise_fma(up[j][1], w1, a1); a0 = __builtin_elementwise_fma(up[j][2], w2, a0); a1 = __builtin_elementwise_fma(up[j][3], w3, a1); }
                P[e] = a0 + a1;
#pragma unroll
                for (int j = 0; j < 4; ++j) wc[j] = wn[j];
                if ((e & 3) == 3) __builtin_amdgcn_sched_barrier(0); }
#define RSTEP(N, MASK, CTRL) do { _Pragma("unroll") for (int i = 0; i < (N); ++i) { int lm_ = lane & (MASK); asm volatile("" : "+v"(lm_)); const bool up_ = lm_ != 0;     \
                const f32x2 sv = up_ ? P[i] : P[i + (N)], kv = up_ ? P[i + (N)] : P[i]; f32x2 rv; rv[0] = dpp_f<CTRL>(sv[0]); rv[1] = dpp_f<CTRL>(sv[1]); P[i] = kv + rv; } } while (0)
#define RSWAP(N, SWAPFN) do { _Pragma("unroll") for (int i = 0; i < (N); ++i) { _Pragma("unroll") for (int c_ = 0; c_ < 2; ++c_) { \
                const auto r_ = SWAPFN(__float_as_uint(P[i][c_]), __float_as_uint(P[i + (N)][c_]), false, false); P[i][c_] = __uint_as_float(r_[0]) + __uint_as_float(r_[1]); } } } while (0)
            RSWAP(16, __builtin_amdgcn_permlane32_swap); RSWAP(8, __builtin_amdgcn_permlane16_swap);
#undef RSWAP
            RSTEP(4, 8, 0x140); RSTEP(2, 4, 0x141); RSTEP(1, 2, 0x4E);
#undef RSTEP
            const int me = lane >> 1; const float rbv = rb[me];
            float lgs[2]; lgs[0] = P[0][0] + dpp_f<0xB1>(P[0][0]) + rbv; lgs[1] = P[0][1] + dpp_f<0xB1>(P[0][1]) + rbv;
            LAS float* lgbuf = (LAS float*)(F.lds + RSEL + 8192) + F.wave * 64;
            if ((lane & 1) == 0) { lgbuf[me] = lgs[0]; lgbuf[32 + me] = lgs[1]; }
            asm volatile("s_waitcnt lgkmcnt(0)" ::: "memory");
#pragma unroll
            for (int t = 0; t < 2; ++t) { const float mine = lgs[t]; int rank = 0;
#pragma unroll
                for (int e4 = 0; e4 < 8; ++e4) { const f32x4 v = *(const LAS f32x4*)(lgbuf + 32 * t + 4 * e4);
#pragma unroll
                    for (int i = 0; i < 4; ++i) { const int e = 4 * e4 + i; rank += (v[i] > mine || (v[i] == mine && e < me)) ? 1 : 0; } }
                float ls[4]; int es[4];
#pragma unroll
                for (int k = 0; k < 4; ++k) { const unsigned long long bal = __ballot(rank == k); const int first = __ffsll((long long)bal) - 1; es[k] = first >> 1; ls[k] = lgbuf[32 * t + es[k]]; }
                const float e1 = __expf(ls[1] - ls[0]), e2 = __expf(ls[2] - ls[0]), e3 = __expf(ls[3] - ls[0]); const float inv = 1.0f / (1.0f + e1 + e2 + e3);
                const int tl = tl0 + t;
                if (lane == 0) { sel_e[tl * 4 + 0] = es[0]; sel_e[tl * 4 + 1] = es[1]; sel_e[tl * 4 + 2] = es[2]; sel_e[tl * 4 + 3] = es[3];
                    sel_g[tl * 4 + 0] = inv; sel_g[tl * 4 + 1] = e1 * inv; sel_g[tl * 4 + 2] = e2 * inv; sel_g[tl * 4 + 3] = e3 * inv; } }
        }
        __syncthreads();
        const int myE = sel_e[F.tid];
        lpos[F.tid] = __hip_atomic_fetch_add(&lcnt[myE], 1u, __ATOMIC_RELAXED, __HIP_MEMORY_SCOPE_WORKGROUP);
        __syncthreads();
        if (F.tid < 32) lbase[F.tid] = atomicAdd(&gcnt[F.tid], lcnt[F.tid]);
        __syncthreads();
        { const unsigned slot = (unsigned)(r0 * 4 + F.tid); list[(size_t)myE * CAP + lbase[myE] + lpos[F.tid]] = slot; gates[slot] = sel_g[F.tid]; }
        __syncthreads();
    }
}

struct MoeOrder {
    const LAS int* meta;
    const unsigned* list; int c, G, ncol, rpx;
    __device__ bool next(int i, pg8::Unit& u) const {
        const int x = c & 7, j = c >> 3; const int g = (i * 8 + x) * rpx + j / ncol; const int total = meta[32];
        if (g >= total) return false;
        const int ln_ = (int)__builtin_amdgcn_mbcnt_hi(~0u, __builtin_amdgcn_mbcnt_lo(~0u, 0u)) & 31;
        const int e = __popc((unsigned)__ballot(meta[ln_ + 1] <= g));
        const int rt = g - meta[e], cnt = meta[64 + e];
        u.pm = g; u.pn = e * ncol + (j % ncol); u.a0 = e; u.a1 = rt; u.a2 = min(256, cnt - rt * 256); return true;
    }
    __device__ __forceinline__ unsigned arow(const pg8::Unit& u, int R) const { return (R < u.a2) ? (list[(size_t)u.a0 * CAP + u.a1 * 256 + R] >> 2) : 0u; }
    __device__ __forceinline__ unsigned rowval(const pg8::Unit& u, int R, unsigned v) const { return (R < u.a2) ? (v >> 2) : 0u; }
    __device__ __forceinline__ const unsigned* rows_ptr(const pg8::Unit& u) const { return list + (size_t)u.a0 * CAP + u.a1 * 256; }
};
__device__ __forceinline__ void moe_meta(Frame& F, int layer) {
    LAS int* meta = (LAS int*)(F.lds + META_OFF);
    const unsigned* gcnt = (const unsigned*)(KWS(F) + WS_CTL) + CW_CNT + layer * NE;
    if (F.tid < NE) { const int c = (int)__hip_atomic_load(&gcnt[F.tid], __ATOMIC_RELAXED, __HIP_MEMORY_SCOPE_AGENT); meta[64 + F.tid] = c; meta[96 + F.tid] = (c + 255) >> 8; }
    __syncthreads();
    if (F.tid <= NE) { int acc = 0;
#pragma unroll
        for (int e = 0; e < NE; ++e) { const int t = meta[96 + e]; acc += (e < F.tid) ? t : 0; }
        meta[F.tid] = acc; }
    __syncthreads();
}
struct EpiGU {
    static constexpr bool PERM = true, HAS_PRE = true;
    unsigned char* ACT; const float* bgu;
    __device__ __forceinline__ void pre(LAS unsigned char* dst, const pg8::Unit& u, int wid, int lane) const {
        if (wid == 1) { const int e = u.a0, pnl = u.pn - e * 8; const float* src = bgu + e * 2048 + (lane >> 5) * 1024 + pnl * 128 + (lane & 31) * 4;
            __builtin_amdgcn_global_load_lds((const unsigned*)src, (LAS unsigned*)dst, 16, 0, 0); } }
    __device__ __forceinline__ void operator()(const f32x4 (&acc)[2][2][4][2], const pg8::Unit& u, int wr, int wc, int fr, int fq, const LAS unsigned char* pre_) const {
        const int e = u.a0, pnl = u.pn - e * 8; const int lcol = wc * 32 + 8 * fq, ccol = pnl * 128 + lcol; const int row0 = u.pm * 256 + wr * 64 + fr;
        f32x2 bg[2][2], bl[2][2];
#pragma unroll
        for (int n = 0; n < 2; ++n) { const f32x4 g4 = *(const LAS f32x4*)(pre_ + (lcol + 4 * n) * 4), l4 = *(const LAS f32x4*)(pre_ + 512 + (lcol + 4 * n) * 4);
            bg[n][0] = (f32x2){g4[0], g4[1]}; bg[n][1] = (f32x2){g4[2], g4[3]}; bl[n][0] = (f32x2){l4[0] + 1.0f, l4[1] + 1.0f}; bl[n][1] = (f32x2){l4[2] + 1.0f, l4[3] + 1.0f}; }
        const f32x2 s2 = {1.0f / WGU_SCALE, 1.0f / WGU_SCALE}, c2 = {-1.702f * 1.4426950408889634f, -1.702f * 1.4426950408889634f}, one2 = {1.0f, 1.0f};
#pragma unroll
        for (int ai = 0; ai < 2; ++ai)
#pragma unroll
            for (int m = 0; m < 4; ++m) { unsigned char* rowp = ACT + (size_t)(row0 + ai * 128 + m * 16) * 1024 + ccol; f32x2 o[2][2];
#pragma unroll
                for (int n = 0; n < 2; ++n)
#pragma unroll
                    for (int h = 0; h < 2; ++h) { const f32x4 A4 = acc[ai][0][m][n], L4 = acc[ai][1][m][n];
                        f32x2 gv = __builtin_elementwise_fma((f32x2){A4[2 * h], A4[2 * h + 1]}, s2, bg[n][h]), lv = __builtin_elementwise_fma((f32x2){L4[2 * h], L4[2 * h + 1]}, s2, bl[n][h]);
                        gv[0] = fminf(gv[0], 7.0f); gv[1] = fminf(gv[1], 7.0f);
                        lv[0] = __builtin_amdgcn_fmed3f(lv[0], -6.0f, 8.0f); lv[1] = __builtin_amdgcn_fmed3f(lv[1], -6.0f, 8.0f);
                        const f32x2 t = gv * c2; f32x2 d = {__builtin_amdgcn_exp2f(t[0]), __builtin_amdgcn_exp2f(t[1])}; d = d + one2;
                        const f32x2 r = {__builtin_amdgcn_rcpf(d[0]), __builtin_amdgcn_rcpf(d[1])};
                        o[n][h] = gv * r * lv; }
                u32x2 w; w.x = pk4_fp8(o[0][0][0], o[0][0][1], o[0][1][0], o[0][1][1]); w.y = pk4_fp8(o[1][0][0], o[1][0][1], o[1][1][0], o[1][1][1]);
                *(u32x2*)rowp = w; }
    }
};
struct EpiDown {
    static constexpr bool PERM = true, HAS_PRE = true;
    unsigned char* YB; const float* bd; const unsigned* list;
    __device__ __forceinline__ void pre(LAS unsigned char* dst, const pg8::Unit& u, int wid, int lane) const {
        const int e = u.a0, rt = u.a1, pnl = u.pn - e * 4;
        if (wid == 1) __builtin_amdgcn_global_load_lds((const unsigned*)(bd + e * 1024 + pnl * 256 + lane * 4), (LAS unsigned*)dst, 16, 0, 0);
        if (wid == 2) __builtin_amdgcn_global_load_lds((const unsigned*)(list + (size_t)e * CAP + rt * 256 + lane * 4), (LAS unsigned*)(dst + 1024), 16, 0, 0); }
    __device__ __forceinline__ void operator()(const f32x4 (&acc)[2][2][4][2], const pg8::Unit& u, int wr, int wc, int fr, int fq, const LAS unsigned char* pre_) const {
        const int e = u.a0, pnl = u.pn - e * 4; const int lcol = wc * 32 + 8 * fq, col = pnl * 256 + lcol;
        f32x4 bv[2][2];
#pragma unroll
        for (int bj = 0; bj < 2; ++bj)
#pragma unroll
            for (int n = 0; n < 2; ++n) bv[bj][n] = *(const LAS f32x4*)(pre_ + (lcol + bj * 128 + 4 * n) * 4);
#pragma unroll
        for (int ai = 0; ai < 2; ++ai)
#pragma unroll
            for (int m = 0; m < 4; ++m) { const int R = ai * 128 + wr * 64 + m * 16 + fr; if (R >= u.a2) continue;
                const unsigned slot = *(const LAS unsigned*)(pre_ + 1024 + R * 4); unsigned char* rowp = YB + (size_t)slot * 1024 + col;
#pragma unroll
                for (int bj = 0; bj < 2; ++bj) { const f32x4 v0 = acc[ai][bj][m][0] * (1.0f / WD_SCALE) + bv[bj][0], v1 = acc[ai][bj][m][1] * (1.0f / WD_SCALE) + bv[bj][1];
                    u32x2 w; w.x = pk4_fp8(v0[0], v0[1], v0[2], v0[3]); w.y = pk4_fp8(v1[0], v1[1], v1[2], v1[3]);
                    *(u32x2*)(rowp + bj * 128) = w; } }
    }
};

__device__ __forceinline__ void ph_combine(Frame& F, int layer, float* hout, bool next_mod) {
    const float* mod = (const float*)(KWS(F) + WS_MOD) + (size_t)(layer * 3) * 6144;
    const float* modn = (const float*)(KWS(F) + WS_MOD) + (size_t)3 * 6144;
    const float* H1 = (const float*)(KWS(F) + WS_H1); const unsigned char* YB = (const unsigned char*)(KWS(F) + WS_YB); const float* gates = (const float*)(KWS(F) + WS_GATES);
    const float* lng = KIN(F, 8) + layer * DM; const float* lnb = KIN(F, 9) + layer * DM; bf16_t* U = (bf16_t*)(KWS(F) + WS_U);
    const int gw = F.bx * NWAVES + F.wave, NGW = F.G * NWAVES, lane = F.lane;
    LAS float* vC = (LAS float*)F.lds;
    for (int i = F.tid; i < 2 * DM; i += NTHR) { const int b = i >> 10, d = i & (DM - 1); LAS float* v = vC + b * 5 * DM + d;
        v[0] = mod[b * 6144 + 5120 + d]; v[DM] = lng[d]; v[2 * DM] = lnb[d]; v[3 * DM] = modn[b * 6144 + 1024 + d] + 1.0f; v[4 * DM] = modn[b * 6144 + d]; }
    __syncthreads();
    f32x4 nh[4]; unsigned nyb[4][4]; f32x4 ngt;
#define CMB_LOAD(r_) do { _Pragma("unroll") for (int j = 0; j < 4; ++j) { const int d = 4 * lane + 256 * j; nh[j] = *(const f32x4*)(H1 + (size_t)(r_) * DM + d); \
        _Pragma("unroll") for (int k = 0; k < 4; ++k) nyb[j][k] = *(const unsigned*)(YB + ((size_t)(r_) * 4 + k) * DM + d); } ngt = *(const f32x4*)(gates + (size_t)(r_) * 4); } while (0)
    if (gw < T) CMB_LOAD(gw);
    for (int row = gw; row < T; row += NGW) {
        int vb = (row >> 14) * 5 * DM + 4 * lane; asm volatile("" : "+v"(vb));
        const LAS float* vr = vC + vb;
        f32x4 ch[4]; unsigned cyb[4][4]; const f32x4 gt = ngt;
#pragma unroll
        for (int j = 0; j < 4; ++j) { ch[j] = nh[j];
#pragma unroll
            for (int k = 0; k < 4; ++k) cyb[j][k] = nyb[j][k]; }
        if (row + NGW < T) CMB_LOAD(row + NGW);
        f32x4 pre[4]; float s = 0.f;
#pragma unroll
        for (int j = 0; j < 4; ++j) { f32x4 y = {0.f, 0.f, 0.f, 0.f};
#pragma unroll
            for (int k = 0; k < 4; ++k) { const unsigned yw = cyb[j][k]; const f32x2 lo = __builtin_amdgcn_cvt_pk_f32_fp8((int)yw, false), hi2 = __builtin_amdgcn_cvt_pk_f32_fp8((int)yw, true);
                const f32x4 v = {lo[0], lo[1], hi2[0], hi2[1]};
                y += v * gt[k]; }
            pre[j] = ch[j] * ALPHA + *(const LAS f32x4*)(vr + 256 * j) * y; s += (pre[j][0] + pre[j][1]) + (pre[j][2] + pre[j][3]); }
        const float mean = wave_sum(s) * (1.0f / DM); float q2 = 0.f;
#pragma unroll
        for (int j = 0; j < 4; ++j) { pre[j] = pre[j] - mean; q2 += (pre[j][0] * pre[j][0] + pre[j][1] * pre[j][1]) + (pre[j][2] * pre[j][2] + pre[j][3] * pre[j][3]); }
        const float rstd = 1.0f / sqrtf(wave_sum(q2) * (1.0f / DM) + LN_EPS);
#pragma unroll
        for (int j = 0; j < 4; ++j) { const int d = 4 * lane + 256 * j; const f32x4 h = pre[j] * rstd * *(const LAS f32x4*)(vr + DM + 256 * j) + *(const LAS f32x4*)(vr + 2 * DM + 256 * j);
            *(f32x4*)(hout + (size_t)row * DM + d) = h;
            if (next_mod) { const f32x4 v = h * *(const LAS f32x4*)(vr + 3 * DM + 256 * j) + *(const LAS f32x4*)(vr + 4 * DM + 256 * j);
                u32x2 w; w.x = pk2(v[0], v[1]); w.y = pk2(v[2], v[3]); *(u32x2*)(U + (size_t)row * DM + d) = w; } }
    }
#undef CMB_LOAD
}

__device__ __forceinline__ void ph_gmlp(Frame& F) {
    const bf16_t* Z = (const bf16_t*)(KWS(F) + WS_ZODD); bf16_t* MIX = (bf16_t*)(KWS(F) + WS_MIX);
    const float* lg = KIN(F, 23); const float* lb = KIN(F, 24); const float* bs = KIN(F, 26); const bf16_t* wsb = (const bf16_t*)(KWS(F) + WS_TAB + TB_WS);
    const int lane = F.lane, r32 = lane & 31, hi = lane >> 5, wid = F.wave;
    for (int chunk = F.bx; chunk < T / 128; chunk += F.G) {
        const int r0 = chunk * 128;
        for (int qq = 0; qq < 16; ++qq) { const int q = wid * 16 + qq; const bf16x8 raw = *(const bf16x8*)(Z + (size_t)(r0 + q) * 1536 + 512 + 8 * lane);
            float v[8]; float s = 0.f;
#pragma unroll
            for (int j = 0; j < 8; ++j) { v[j] = bf2f((unsigned short)raw[j]); s += v[j]; }
            const float mean = wave_sum(s) * (1.0f / 512.0f); float q2 = 0.f;
#pragma unroll
            for (int j = 0; j < 8; ++j) { v[j] -= mean; q2 += v[j] * v[j]; }
            const float rstd = 1.0f / sqrtf(wave_sum(q2) * (1.0f / 512.0f) + LN_EPS);
            const f32x4 g0 = *(const f32x4*)(lg + 8 * lane), g1 = *(const f32x4*)(lg + 8 * lane + 4), b0 = *(const f32x4*)(lb + 8 * lane), b1 = *(const f32x4*)(lb + 8 * lane + 4);
            u32x4 w; w.x = pk2(v[0] * rstd * g0[0] + b0[0], v[1] * rstd * g0[1] + b0[1]); w.y = pk2(v[2] * rstd * g0[2] + b0[2], v[3] * rstd * g0[3] + b0[3]);
            w.z = pk2(v[4] * rstd * g1[0] + b1[0], v[5] * rstd * g1[1] + b1[1]); w.w = pk2(v[6] * rstd * g1[2] + b1[2], v[7] * rstd * g1[3] + b1[3]);
            const int ch = 8 * lane, g = ch >> 7, col = ch & 127, kt = (q >> 6) * 4 + g;
            *(LAS u32x4*)(F.lds + kt * 16384 + v_st(q & 63, col)) = w; }
        __syncthreads();
        const int pb = wid & 3, gh = wid >> 2;
#pragma unroll 1
        for (int gi = 0; gi < 2; ++gi) { const int g = 2 * gh + gi;
            unsigned wofs = (unsigned)(((g * 128 + 32 * pb + r32) * 128 + 8 * hi) * 2); asm volatile("" : "+v"(wofs));
            f32x16 acc[4];
#pragma unroll
            for (int d0 = 0; d0 < 4; ++d0) acc[d0] = f32x16{};
            bf16x8 af[8];
#pragma unroll
            for (int ks = 0; ks < 8; ++ks) af[ks] = *(const bf16x8*)((const char*)wsb + wofs + 32 * ks);
#pragma unroll
            for (int ks = 0; ks < 8; ++ks) {
                LAS unsigned char* trd = F.lds + ((ks >> 2) * 4 + g) * 16384 + v_rd_base(lane);
#pragma unroll
                for (int d0 = 0; d0 < 4; ++d0) acc[d0] = __builtin_amdgcn_mfma_f32_32x32x16_bf16(af[ks], vfrag(trd, d0, ks & 3), acc[d0], 0, 0, 0); }
            unsigned short uraw[16][4]; float bias[16];
#pragma unroll
            for (int r = 0; r < 16; ++r) { const int p = 32 * pb + crow(r, hi); bias[r] = bs[g * 128 + p];
#pragma unroll
                for (int d0 = 0; d0 < 4; ++d0) uraw[r][d0] = Z[(size_t)(r0 + p) * 1536 + g * 128 + d0 * 32 + r32]; }
            asm volatile("" ::: "memory");
#pragma unroll
            for (int r = 0; r < 16; ++r) { const int p = 32 * pb + crow(r, hi);
#pragma unroll
                for (int d0 = 0; d0 < 4; ++d0) { const int ch = g * 128 + d0 * 32 + r32;
                    MIX[(size_t)(r0 + p) * 1024 + ch] = (bf16_t)f2bf(bf2f(uraw[r][d0]) * (acc[d0][r] + bias[r])); } }
        }
        __syncthreads();
    }
}

__device__ __forceinline__ void ph_fourier1(Frame& F) {
    const bf16_t* Z = (const bf16_t*)(KWS(F) + WS_ZODD); bf16_t* WT = (bf16_t*)(KWS(F) + WS_WT);
    const float* lg = KIN(F, 27); const float* lb = KIN(F, 28);
    const bf16x8* CSf = (const bf16x8*)(KWS(F) + WS_TAB + TB_CS); const bf16x8* AFf = (const bf16x8*)(KWS(F) + WS_TAB + TB_AF); const f32x2* tw = (const f32x2*)(KWS(F) + WS_TAB + TB_TW);
    const int lane = F.lane, r32 = lane & 31, hi = lane >> 5, wid = F.wave;
    for (int unit = F.bx; unit < NB * 128; unit += F.G) {
        const int b = unit >> 7, t2 = unit & 127;
#pragma unroll 1
        for (int g = 0; g < 4; ++g) {
            {
                int lane_g = lane; asm volatile("" : "+v"(lane_g)); const int r32 = lane_g & 31, hi = lane_g >> 5;
                const int tb = wid & 3, part = wid >> 2; int t1 = 32 * tb + r32; asm volatile("" : "+v"(t1)); const size_t row = (size_t)b * SEQ + 128 * t1 + t2;
                bf16x8 raw[8]; float s = 0.f;
#pragma unroll
                for (int ks = 0; ks < 8; ++ks) { raw[ks] = *(const bf16x8*)(Z + row * 1536 + 1024 + g * 128 + 16 * ks + 8 * hi);
#pragma unroll
                    for (int j = 0; j < 8; ++j) s += bf2f((unsigned short)raw[ks][j]); }
                s = xhalf_sum(s); const float mean = s * (1.0f / 128.0f); float q2 = 0.f;
#pragma unroll
                for (int ks = 0; ks < 8; ++ks)
#pragma unroll
                    for (int j = 0; j < 8; ++j) { const float d = bf2f((unsigned short)raw[ks][j]) - mean; q2 += d * d; }
                q2 = xhalf_sum(q2); const float rstd = 1.0f / sqrtf(q2 * (1.0f / 128.0f) + LN_EPS);
                bf16x8 af[8];
#pragma unroll
                for (int ks = 0; ks < 8; ++ks) { const int c0 = g * 128 + 16 * ks + 8 * hi; const f32x4 g0 = *(const f32x4*)(lg + c0), g1 = *(const f32x4*)(lg + c0 + 4), b0 = *(const f32x4*)(lb + c0), b1 = *(const f32x4*)(lb + c0 + 4);
                    float x[8];
#pragma unroll
                    for (int j = 0; j < 8; ++j) x[j] = (bf2f((unsigned short)raw[ks][j]) - mean) * rstd;
                    u32x4 w; w.x = pk2(x[0] * g0[0] + b0[0], x[1] * g0[1] + b0[1]); w.y = pk2(x[2] * g0[2] + b0[2], x[3] * g0[3] + b0[3]);
                    w.z = pk2(x[4] * g1[0] + b1[0], x[5] * g1[1] + b1[1]); w.w = pk2(x[6] * g1[2] + b1[2], x[7] * g1[3] + b1[3]);
                    af[ks] = __builtin_bit_cast(bf16x8, w); }
                f32x16 acc[4];
#pragma unroll
                for (int d0 = 0; d0 < 4; ++d0) acc[d0] = f32x16{};
#pragma unroll
                for (int ks = 0; ks < 8; ++ks) { unsigned fo = (unsigned)(((4 * part) * 8 + ks) * 64 + lane) * 16u; asm volatile("" : "+v"(fo));
#pragma unroll
                    for (int d0 = 0; d0 < 4; ++d0) acc[d0] = __builtin_amdgcn_mfma_f32_32x32x16_bf16(af[ks], *(const bf16x8*)((const char*)CSf + fo + d0 * 8192), acc[d0], 0, 0, 0); }
                int ybase = (part * 2 + (tb >> 1)) * 16384 + (tb & 1) * 8192 + hi * 2048 + r32 * 2; asm volatile("" : "+v"(ybase));
#pragma unroll
                for (int r = 0; r < 16; ++r)
#pragma unroll
                    for (int d0 = 0; d0 < 4; ++d0) *(LAS bf16_t*)(F.lds + ybase + ((r >> 3) & 1) * 4096 + d0 * 512 + ((r & 3) + 4 * ((r >> 2) & 1)) * 64) = (bf16_t)f2bf(acc[d0][r]);
            }
            __syncthreads();
            {
                const int kb = wid & 3, ch2 = wid >> 2;
                f32x16 aR[2], aI[2];
#pragma unroll
                for (int dd = 0; dd < 2; ++dd) { aR[dd] = f32x16{}; aI[dd] = f32x16{}; }
#pragma unroll
                for (int kh = 0; kh < 4; ++kh) {
                    unsigned fo = (unsigned)((kb * 16 + kh * 4) * 64 + lane) * 16u; asm volatile("" : "+v"(fo));
                    bf16x8 fr8[4], fi8[4];
#pragma unroll
                    for (int k8 = 0; k8 < 4; ++k8) { fr8[k8] = *(const bf16x8*)((const char*)AFf + fo + k8 * 1024); fi8[k8] = *(const bf16x8*)((const char*)AFf + fo + k8 * 1024 + 65536); }
#pragma unroll
                    for (int k8 = 0; k8 < 4; ++k8) { const int ks = kh * 4 + k8;
                        LAS unsigned char* trd = F.lds + (ks >> 2) * 16384 + v_rd_base(lane);
#pragma unroll
                        for (int dd = 0; dd < 2; ++dd) { const bf16x8 bf = vfrag(trd, 2 * ch2 + dd, ks & 3);
                            aR[dd] = __builtin_amdgcn_mfma_f32_32x32x16_bf16(fr8[k8], bf, aR[dd], 0, 0, 0); aI[dd] = __builtin_amdgcn_mfma_f32_32x32x16_bf16(fi8[k8], bf, aI[dd], 0, 0, 0); } }
                }
                int k1b = 32 * kb + 4 * hi; asm volatile("" : "+v"(k1b));
                f32x2 csv[16];
#pragma unroll
                for (int r = 0; r < 16; ++r) csv[r] = tw[t2 * 128 + k1b + (r & 3) + 8 * (r >> 2)];
                asm volatile("" ::: "memory");
#pragma unroll
                for (int r = 0; r < 16; ++r) { const int k1 = k1b + (r & 3) + 8 * (r >> 2); const f32x2 cs = csv[r];
                    bf16_t* dst = WT + ((((size_t)b * 128 + k1) * 128 + t2) * 4 + g) * 256;
#pragma unroll
                    for (int dd = 0; dd < 2; ++dd) { const float wr_ = aR[dd][r], wi_ = aI[dd][r]; const int j = 32 * (2 * ch2 + dd) + r32;
                        dst[j] = (bf16_t)f2bf(wr_ * cs[0] + wi_ * cs[1]); dst[128 + j] = (bf16_t)f2bf(wi_ * cs[0] - wr_ * cs[1]); }
                    if ((r & 3) == 3) asm volatile("" ::: "memory"); }
            }
            __syncthreads();
        }
    }
}
__device__ __forceinline__ void ph_fourier2(Frame& F) {
    const bf16_t* WT = (const bf16_t*)(KWS(F) + WS_WT); bf16_t* MIX = (bf16_t*)(KWS(F) + WS_MIX);
    const bf16x8* A3f = (const bf16x8*)(KWS(F) + WS_TAB + TB_A3);
    const int lane = F.lane, r32 = lane & 31, hi = lane >> 5, wid = F.wave;
    for (int unit = F.bx; unit < NB * 128; unit += F.G) {
        const int b = unit >> 7, k1 = unit & 127;
#pragma unroll 1
        for (int g = 0; g < 4; ++g) {
            for (int idx = F.tid; idx < 4096; idx += NTHR) { const int t2 = idx >> 5, c = idx & 31, part = c >> 4, j0 = (c & 15) * 8;
                const u32x4 v = *(const u32x4*)(WT + ((((size_t)b * 128 + k1) * 128 + t2) * 4 + g) * 256 + part * 128 + j0);
                *(LAS u32x4*)(F.lds + (part * 2 + (t2 >> 6)) * 16384 + v_st(t2 & 63, j0)) = v; }
            __syncthreads();
            const int mb = wid & 3, ch2 = wid >> 2;
            f32x16 acc[2] = {f32x16{}, f32x16{}};
#pragma unroll
            for (int ks = 0; ks < 16; ++ks) { unsigned fo = (unsigned)((mb * 16 + ks) * 64 + lane) * 16u; asm volatile("" : "+v"(fo)); const bf16x8 af = *(const bf16x8*)((const char*)A3f + fo);
                LAS unsigned char* trd = F.lds + (ks >> 2) * 16384 + v_rd_base(lane);
#pragma unroll
                for (int dd = 0; dd < 2; ++dd) acc[dd] = __builtin_amdgcn_mfma_f32_32x32x16_bf16(af, vfrag(trd, 2 * ch2 + dd, ks & 3), acc[dd], 0, 0, 0); }
#pragma unroll
            for (int r = 0; r < 16; ++r) { const int k2 = 32 * mb + crow(r, hi); const size_t row = (size_t)b * SEQ + k1 + 128 * k2;
#pragma unroll
                for (int dd = 0; dd < 2; ++dd) MIX[row * 1024 + 512 + g * 128 + 32 * (2 * ch2 + dd) + r32] = (bf16_t)f2bf(acc[dd][r]); }
            __syncthreads();
        }
    }
}

#ifndef MK_ONE_LAUNCH
#define MK_ONE_LAUNCH 1
#endif
constexpr int NPH = 18;
#ifndef PHMASK
#define PHMASK 0x3FFFF
#endif
#define HAS(k) (((PHMASK) >> (k)) & 1)
__global__ void __launch_bounds__(NTHR, 2) fwd_kernel(Args args) {
    extern __shared__ __attribute__((aligned(16))) unsigned char lds_raw[];
    Frame F;
    F.lds = (LAS unsigned char*)lds_raw; F.tid = threadIdx.x; F.lane = F.tid & 63; F.wave = __builtin_amdgcn_readfirstlane(F.tid >> 6); F.G = gridDim.x; F.bx = blockIdx.x;
    F.kz = 0;
    volatile LAS unsigned* MISC = (volatile LAS unsigned*)(F.lds + MISC_OFF);
    if (F.tid < 64) MISC[F.tid] = 0u;
    __syncthreads();
    if (MK_ONE_LAUNCH) (void)xcd_barrier_post((unsigned*)(args.ws + WS_CTL) + CW_BAR, MISC + 8);
    const int lo = args.ph_lo, hi = args.ph_hi;
#define IN(k) (lo <= (k) && (k) < hi)
#ifndef REPMASK
#define REPMASK 0
#endif
#define REP(k) (((REPMASK) >> (k)) & 1)
#define BARNOW() do { ENTER(); XcdBarrier bar_; bar_.bar = (unsigned*)(KWS(F) + WS_CTL) + CW_BAR; bar_.x = xb_xcc_id(); bar_.st = (volatile LAS unsigned*)(F.lds + MISC_OFF) + 8; xcd_barrier(bar_); } while (0)
#ifndef DIAG_PH
#define DIAG_PH -1
#endif
    int nstamp = 0;
#define STAMP() do { if (DIAG_PH >= 0) { if (F.tid == 0) ((volatile LAS unsigned*)(F.lds + MISC_OFF))[16 + nstamp] = (unsigned)__builtin_amdgcn_s_memrealtime(); ++nstamp; } } while (0)
    STAMP();
#define ENTER() do { asm volatile("" : "+s"(F.kz), "+s"(F.wave), "+s"(F.G), "+s"(F.bx), "+v"(F.tid), "+v"(F.lane)); F.kz = __builtin_amdgcn_readfirstlane(F.kz); F.wave = __builtin_amdgcn_readfirstlane(F.wave); \
    F.G = __builtin_amdgcn_readfirstlane(F.G); F.bx = __builtin_amdgcn_readfirstlane(F.bx); } while (0)
#define SEAM(k) do { if (IN(k) && IN((k) + 1)) { if (MK_ONE_LAUNCH) { ENTER(); XcdBarrier bar_; bar_.bar = (unsigned*)(KWS(F) + WS_CTL) + CW_BAR; bar_.x = xb_xcc_id(); bar_.st = (volatile LAS unsigned*)(F.lds + MISC_OFF) + 8; xcd_barrier(bar_); STAMP(); } } } while (0)

    if (HAS(0) && IN(0)) { ENTER(); for (int rep_ = 0; rep_ <= REP(0); ++rep_) { if (rep_) BARNOW(); ph0_mod_tables(F); } } SEAM(0);
    if (HAS(1) && IN(1)) { ENTER(); for (int rep_ = 0; rep_ <= REP(1); ++rep_) { if (rep_) BARNOW(); ph1_convert(F); } } SEAM(1);
    if (HAS(2) && IN(2)) { ENTER(); for (int rep_ = 0; rep_ <= REP(2); ++rep_) { if (rep_) BARNOW(); ph2_modulate(F); } } SEAM(2);

    for (int layer = 0; layer < 2; ++layer) {
        const int pb = layer == 0 ? 5 : 13;
        if (layer == 0) {
            if (HAS(3) && IN(3)) { ENTER(); for (int rep_ = 0; rep_ <= REP(3); ++rep_) { if (rep_) BARNOW();
                pg8::Gemm g{(const bf16_t*)(KWS(F) + WS_U), (const bf16_t*)(KWS(F) + WS_WEVIN), T, 2560, DM};
                EvInOrder S; S.so.init(T, 2560, F.G, F.bx);
                EpiEvIn E{(unsigned char*)(KWS(F) + WS_Q), (unsigned char*)(KWS(F) + WS_K), (unsigned char*)(KWS(F) + WS_V), (bf16_t*)(KWS(F) + WS_AB), (const float*)(KWS(F) + WS_TAB + TB_COS), (const float*)(KWS(F) + WS_TAB + TB_SIN)};
                pg8::gemm_phase<EpiEvIn, EvInOrder, true, false>(F.lds, g, S, E, F.tid);
            } } SEAM(3);
            if (HAS(4) && IN(4)) { ENTER(); for (int rep_ = 0; rep_ <= REP(4); ++rep_) { if (rep_) BARNOW(); ph4_conv(F); ph4_attention(F); } } SEAM(4);
        } else {
            if (HAS(10) && IN(10)) { ENTER(); for (int rep_ = 0; rep_ <= REP(10); ++rep_) { if (rep_) BARNOW();
                pg8::Gemm g{(const bf16_t*)(KWS(F) + WS_U), (const bf16_t*)(KWS(F) + WS_WODIN), T, 1536, DM};
                pg8::StaticOrder S; S.init(T, 1536, F.G, F.bx);
                pg8::EpiBf16 E{(bf16_t*)(KWS(F) + WS_ZODD), 1536, 4};
                pg8::gemm_phase<pg8::EpiBf16, pg8::StaticOrder, true, false>(F.lds, g, S, E, F.tid);
            } } SEAM(10);
            if (HAS(11) && IN(11)) { ENTER(); for (int rep_ = 0; rep_ <= REP(11); ++rep_) { if (rep_) BARNOW(); ph_gmlp(F); ph_fourier1(F); } } SEAM(11);
            if (HAS(12) && IN(12)) { ENTER(); for (int rep_ = 0; rep_ <= REP(12); ++rep_) { if (rep_) BARNOW(); ph_fourier2(F); } } SEAM(12);
        }
        if (HAS(5) && IN(pb)) { ENTER(); for (int rep_ = 0; rep_ <= REP(5); ++rep_) { if (rep_) BARNOW();
            pg8::Gemm g{(const bf16_t*)(KWS(F) + WS_MIX), (const bf16_t*)(KWS(F) + (layer == 0 ? WS_WEVOUT : WS_WODOUT)), T, DM, DM};
            pg8::StaticOrder S; S.init(T, DM, F.G, F.bx);
            pg8::EpiBf16 E{(bf16_t*)(KWS(F) + WS_Y), DM, 0};
            pg8::gemm_phase<pg8::EpiBf16, pg8::StaticOrder, true, false>(F.lds, g, S, E, F.tid);
        } } SEAM(pb);
        if (HAS(6) && IN(pb + 1)) { ENTER(); for (int rep_ = 0; rep_ <= REP(6); ++rep_) { if (rep_) BARNOW(); ph_router(F, layer, layer == 0 ? KIN(F, 0) : (const float*)(KWS(F) + WS_H2)); } } SEAM(pb + 1);
        if (HAS(7) && IN(pb + 2)) { ENTER(); for (int rep_ = 0; rep_ <= REP(7); ++rep_) { if (rep_) BARNOW();
            moe_meta(F, layer);
            pg8::Gemm g{(const bf16_t*)(KWS(F) + WS_U2), (const bf16_t*)(KWS(F) + WS_WGU + (size_t)layer * NE * 2048 * DM), 0, 0, DM / 2};
            MoeOrder S{(const LAS int*)(F.lds + META_OFF), (const unsigned*)(KWS(F) + WS_LIST), F.bx, F.G, 8, 4};
            EpiGU E{(unsigned char*)(KWS(F) + WS_ACT), KIN(F, 32) + (size_t)layer * NE * 2048};
            pg8::gemm_phase<EpiGU, MoeOrder, true, true, true>(F.lds, g, S, E, F.tid);
        } } SEAM(pb + 2);
        if (HAS(8) && IN(pb + 3)) { ENTER(); for (int rep_ = 0; rep_ <= REP(8); ++rep_) { if (rep_) BARNOW();
            moe_meta(F, layer);
            pg8::Gemm g{(const bf16_t*)(KWS(F) + WS_ACT), (const bf16_t*)(KWS(F) + WS_WD + (size_t)layer * NE * 1024 * DM), 0, 0, DM / 2};
            MoeOrder S{(const LAS int*)(F.lds + META_OFF), (const unsigned*)(KWS(F) + WS_LIST), F.bx, F.G, 4, 8};
            EpiDown E{(unsigned char*)(KWS(F) + WS_YB), KIN(F, 34) + (size_t)layer * NE * 1024, (const unsigned*)(KWS(F) + WS_LIST)};
            pg8::gemm_phase<EpiDown, MoeOrder, true, false, true>(F.lds, g, S, E, F.tid);
        } } SEAM(pb + 3);
        if (HAS(9) && IN(pb + 4)) { ENTER(); for (int rep_ = 0; rep_ <= REP(9); ++rep_) { if (rep_) BARNOW(); ph_combine(F, layer, layer == 0 ? (float*)(KWS(F) + WS_H2) : KOUT(F), layer == 0); } }
        if (layer == 0) SEAM(pb + 4);
    }
    if (DIAG_PH >= 0) {
        ENTER(); XcdBarrier bar_; bar_.bar = (unsigned*)(KWS(F) + WS_CTL) + CW_BAR; bar_.x = xb_xcc_id(); bar_.st = (volatile LAS unsigned*)(F.lds + MISC_OFF) + 8; xcd_barrier(bar_); STAMP();
        __syncthreads();
        volatile LAS unsigned* st = (volatile LAS unsigned*)(F.lds + MISC_OFF) + 16;
        const unsigned d = st[DIAG_PH + 1] - st[DIAG_PH];
        const float c = sqrtf((float)d * 0.01f);
        float* o = KOUT(F);
        for (size_t i = (size_t)F.bx * NTHR + F.tid; i < (size_t)T * DM; i += (size_t)F.G * NTHR) o[i] = c;
    }
#undef IN
#undef SEAM
}

extern "C" void kernel_launch(void* const* d_in, const int* in_sizes, int n_in, void* d_out, int out_size, void* d_ws, size_t ws_size, hipStream_t stream) {
    static int grid = 0;
    if (grid == 0) {
        if (n_in != 35 || out_size != T * DM || ws_size < WS_END) { fprintf(stderr, "kernel_launch: unexpected shapes: n_in %d out %d ws %zu (need %zu)\n", n_in, out_size, ws_size, (size_t)WS_END); grid = -1; return; }
        int dev = 0, cus = 0;
        if (hipGetDevice(&dev) != hipSuccess || hipDeviceGetAttribute(&cus, hipDeviceAttributeMultiprocessorCount, dev) != hipSuccess) { grid = -1; return; }
        if (hipFuncSetAttribute((const void*)fwd_kernel, hipFuncAttributeMaxDynamicSharedMemorySize, LDS_BYTES) != hipSuccess) { fprintf(stderr, "kernel_launch: hipFuncSetAttribute failed\n"); grid = -1; return; }
        int per_cu = 0; (void)hipOccupancyMaxActiveBlocksPerMultiprocessor(&per_cu, (const void*)fwd_kernel, NTHR, LDS_BYTES); (void)hipGetLastError();
        if (per_cu < 1) fprintf(stderr, "kernel_launch: occupancy query reports %d blocks per CU\n", per_cu);
        grid = cus > 256 ? 256 : cus;
        if (grid != 256) fprintf(stderr, "kernel_launch: %d CUs; this kernel is laid out for 256\n", cus);
    }
    if (grid < 0) return;
    (void)hipMemsetAsync((char*)d_ws + WS_CTL, 0, CTL_ZERO_BYTES, stream);
    Args a{};
    for (int i = 0; i < 35; ++i) a.in[i] = (const float*)d_in[i];
    a.out = (float*)d_out; a.ws = (unsigned char*)d_ws;
#if MK_ONE_LAUNCH
    a.ph_lo = 0; a.ph_hi = NPH;
    hipLaunchKernelGGL(fwd_kernel, dim3(grid), dim3(NTHR), LDS_BYTES, stream, a);
#else
    for (int p = 0; p < NPH; ++p) { a.ph_lo = p; a.ph_hi = p + 1; hipLaunchKernelGGL(fwd_kernel, dim3(grid), dim3(NTHR), LDS_BYTES, stream, a); }
#endif
    const hipError_t le = hipPeekAtLastError();
    if (le != hipSuccess) fprintf(stderr, "kernel_launch: launch failed: %s\n", hipGetErrorName(le));
}
```

```cpp
#include <hip/hip_runtime.h>
#include <cstdio>
#include <cstdint>

#define LAS __attribute__((address_space(3)))
#define GAS __attribute__((address_space(1)))
typedef unsigned short bf16_t;
typedef short bf16x8 __attribute__((ext_vector_type(8)));
typedef short s16x4 __attribute__((ext_vector_type(4)));
typedef float f32x4 __attribute__((ext_vector_type(4)));
typedef float f32x2 __attribute__((ext_vector_type(2)));
typedef float f32x16 __attribute__((ext_vector_type(16)));
typedef unsigned u32x4 __attribute__((ext_vector_type(4)));
typedef unsigned u32x2 __attribute__((ext_vector_type(2)));

namespace pg8 {
constexpr int BM = 256, BK = 64, HALF = 128, HTB = HALF * BK * 2, STAGE_BYTES = 8 * HTB, NXCD = 8, WGM = 8;
__host__ __device__ __forceinline__ int lds_byte(int r, int c) { const int st = (r >> 4) * 2 + (c >> 5), rr = r & 15, cc = c & 31, ob = rr * 64 + cc * 2; return st * 1024 + (ob ^ (((ob >> 9) & 1) << 5)); }
__host__ __device__ __forceinline__ void stage_rc(int b, int& R, int& C) { const int st = b / 1024, sb = b % 1024, swz = sb ^ (((sb >> 9) & 1) << 5); R = (st >> 1) * 16 + swz / 64; C = (st & 1) * 32 + (swz % 64) / 2; }
__host__ __device__ __forceinline__ int perm32(int rho) { const int n = rho >> 4, i = rho & 15; return 8 * (i >> 2) + 4 * n + (i & 3); }

struct Unit { int pm, pn, a0, a1, a2; };
struct Gemm { const bf16_t* A; const bf16_t* Bt; int M, N, K; };

constexpr int PRE_ROWS = 131072 + 1024, PRE_EPI = PRE_ROWS + 2048;
struct StaticOrder {
    int nM, nN, nwg, G, c;
    __device__ void init(int M, int N, int G_, int c_) { nM = M / BM; nN = N / BM; nwg = nM * nN; G = G_; c = c_; }
    __device__ bool map(long L, Unit& u) const {
        if (L >= nwg) return false;
        int wgid = (int)L; { const int q = nwg / NXCD, r = nwg % NXCD, xcd = wgid % NXCD, off = wgid / NXCD; wgid = (xcd < r ? xcd * (q + 1) : r * (q + 1) + (xcd - r) * q) + off; }
        const int nig = WGM * nN, gid = wgid / nig, fm = gid * WGM, gsz = (nM - fm) < WGM ? (nM - fm) : WGM;
        u.pm = fm + ((wgid % nig) % gsz); u.pn = (wgid % nig) / gsz; u.a0 = 0; u.a1 = 0; u.a2 = 256; return true;
    }
    __device__ bool next(int i, Unit& u) const { return map((long)i * G + c, u); }
    __device__ __forceinline__ unsigned arow(const Unit&, int) const { return 0u; }
    __device__ __forceinline__ unsigned rowval(const Unit&, int, unsigned) const { return 0u; }
    __device__ __forceinline__ const unsigned* rows_ptr(const Unit&) const { return nullptr; }
};

__device__ __forceinline__ unsigned cvt_pk_bf16(float lo, float hi) { unsigned r; asm volatile("v_cvt_pk_bf16_f32 %0, %1, %2" : "=v"(r) : "v"(lo), "v"(hi)); return r; }

__device__ __forceinline__ float gelu_tanh(float x) {
    const float t = x * (1.0f + 0.044715f * x * x) * (2.0f * 0.7978845608028654f * 1.4426950408889634f);
    return x * __builtin_amdgcn_rcpf(1.0f + __builtin_amdgcn_exp2f(-t));
}

struct EpiBf16 {
    static constexpr bool PERM = true, HAS_PRE = false;
    bf16_t* O; int ldc; int gelu_pn; float scale;
    __device__ __forceinline__ void operator()(const f32x4 (&acc)[2][2][4][2], const Unit& u, int wr, int wc, int fr, int fq) const {
        const int row0 = u.pm * BM + wr * 64 + fr; const int col0 = u.pn * BM + wc * 32 + 8 * fq;
        const bool act = u.pn < gelu_pn;
#pragma unroll
        for (int ai = 0; ai < 2; ++ai)
#pragma unroll
            for (int m = 0; m < 4; ++m) { bf16_t* rowp = O + (size_t)(row0 + ai * HALF + m * 16) * ldc + col0;
#pragma unroll
                for (int bj = 0; bj < 2; ++bj) { f32x4 v0 = acc[ai][bj][m][0] * scale, v1 = acc[ai][bj][m][1] * scale;
                    if (act) {
#pragma unroll
                        for (int j = 0; j < 4; ++j) { v0[j] = gelu_tanh(v0[j]); v1[j] = gelu_tanh(v1[j]); } }
                    u32x4 w; w.x = cvt_pk_bf16(v0[0], v0[1]); w.y = cvt_pk_bf16(v0[2], v0[3]); w.z = cvt_pk_bf16(v1[0], v1[1]); w.w = cvt_pk_bf16(v1[2], v1[3]);
                    *(u32x4*)(rowp + bj * HALF) = w; } }
    }
};

typedef int v8i32 __attribute__((ext_vector_type(8)));
typedef short s16x16 __attribute__((ext_vector_type(16)));
template <class Epi, class Sched, bool ALIGN_EPI, bool GATHER, bool FP8 = false>
__device__ __forceinline__ void gemm_phase(LAS unsigned char* lds, const Gemm g, const Sched& S, const Epi& E, const int tid) {
    const int wid = __builtin_amdgcn_readfirstlane(tid >> 6), lane = tid & 63, wr = wid >> 2, wc = wid & 3, fr = lane & 15, fq = lane >> 4;
    const int K = g.K, nt = K / BK;
    unsigned voffA[2], voffB[2]; int Rr[2], Cc[2];
#pragma unroll
    for (int i = 0; i < 2; ++i) { int R, C; stage_rc(tid * 16 + i * 8192, R, C); const int Rb = Epi::PERM ? ((R & ~31) + perm32(R & 31)) : R; Rr[i] = R; Cc[i] = C;
        voffA[i] = (unsigned)(R * K + C) * 2u; voffB[i] = (unsigned)(Rb * K + C) * 2u; }
    const unsigned kstep = (unsigned)(BK * 2);
    const unsigned hstep = (unsigned)HALF * (unsigned)K * 2u;
    const unsigned tstep = 2u * hstep;
    const char* const baseA = (const char*)g.A; const char* const baseB = (const char*)g.Bt;
    const unsigned ldsw = (unsigned)wid * 1024u;
    const int aoff = lds_byte(wr * 64 + fr, fq * 8), boff = lds_byte(wc * 32 + fr, fq * 8);
    const int aoff0 = lds_byte(wr * 64 + fr, fq * 16), aoff1 = lds_byte(wr * 64 + fr, fq * 16 + 8), boff0 = lds_byte(wc * 32 + fr, fq * 16), boff1 = lds_byte(wc * 32 + fr, fq * 16 + 8);
#define PG8_SA(b, h) (((b) * 2 + (h)) * HTB)
#define PG8_SB(b, h) ((4 + (b) * 2 + (h)) * HTB)
#define PG8_STAGE(bufoff, gbase, voff) do { _Pragma("unroll") for (int _i = 0; _i < 2; ++_i) \
        __builtin_amdgcn_global_load_lds((const unsigned*)(baseB + (size_t)(unsigned)((gbase) + (voff)[_i])), (LAS unsigned*)(lds + (bufoff) + ldsw + _i * 8192), 16, 0, 0); } while (0)
#define PG8_STAGEA(bufoff, gbase, voff) do { _Pragma("unroll") for (int _i = 0; _i < 2; ++_i) \
        __builtin_amdgcn_global_load_lds((const unsigned*)(baseA + (size_t)(unsigned)((gbase) + (voff)[_i])), (LAS unsigned*)(lds + (bufoff) + ldsw + _i * 8192), 16, 0, 0); } while (0)
#define PG8_STAGE_A(bufoff, base, h, nx) do { if constexpr (GATHER) { _Pragma("unroll") for (int _i = 0; _i < 2; ++_i) { const unsigned _v = (nx) ? vAn[h][_i] : vAc[h][_i]; \
            __builtin_amdgcn_global_load_lds((const unsigned*)(baseA + (size_t)(unsigned)((base) + _v)), (LAS unsigned*)(lds + (bufoff) + ldsw + _i * 8192), 16, 0, 0); } } \
        else { PG8_STAGEA(bufoff, (base) + (h) * hstep, voffA); } } while (0)
#define PG8_LD8(dst, i, off0, off1) do { const bf16x8 _lo = *(const LAS bf16x8*)(lds + (off0)), _hi = *(const LAS bf16x8*)(lds + (off0) + 16); dst[i] = __builtin_bit_cast(v8i32, __builtin_shufflevector(_lo, _hi, 0, 1, 2, 3, 4, 5, 6, 7, 8, 9, 10, 11, 12, 13, 14, 15)); } while (0)
#define PG8_LDA8(dst, b, h) do { _Pragma("unroll") for (int m = 0; m < 4; ++m) PG8_LD8(dst, m, PG8_SA(b, h) + aoff0 + m * 2048, PG8_SA(b, h) + aoff1 + m * 2048); } while (0)
#define PG8_LDB8(dst, b, h) do { _Pragma("unroll") for (int n = 0; n < 2; ++n) PG8_LD8(dst, n, PG8_SB(b, h) + boff0 + n * 2048, PG8_SB(b, h) + boff1 + n * 2048); } while (0)
#define PG8_MMA8(ai, bj, At, Bt) do { __builtin_amdgcn_s_setprio(1); _Pragma("unroll") for (int m = 0; m < 4; ++m) _Pragma("unroll") for (int n = 0; n < 2; ++n) \
        asm volatile("v_mfma_scale_f32_16x16x128_f8f6f4 %0, %1, %2, %0, %3, %3 op_sel_hi:[0,0,0]" : "+v"(acc[ai][bj][m][n]) : "v"(Bt[n]), "v"(At[m]), "v"(one_scale)); __builtin_amdgcn_s_setprio(0); } while (0)
#define PG8_LDA(dst, b, h) do { _Pragma("unroll") for (int m = 0; m < 4; ++m) _Pragma("unroll") for (int k = 0; k < 2; ++k) dst[m][k] = *(const LAS bf16x8*)(lds + PG8_SA(b, h) + aoff + m * 2048 + k * 1024); } while (0)
#define PG8_LDB(dst, b, h) do { _Pragma("unroll") for (int n = 0; n < 2; ++n) _Pragma("unroll") for (int k = 0; k < 2; ++k) dst[n][k] = *(const LAS bf16x8*)(lds + PG8_SB(b, h) + boff + n * 2048 + k * 1024); } while (0)
#define PG8_MMA(ai, bj, At, Bt) do { __builtin_amdgcn_s_setprio(1); _Pragma("unroll") for (int m = 0; m < 4; ++m) _Pragma("unroll") for (int n = 0; n < 2; ++n) _Pragma("unroll") for (int k = 0; k < 2; ++k) \
        acc[ai][bj][m][n] = __builtin_amdgcn_mfma_f32_16x16x32_bf16(Bt[n][k], At[m][k], acc[ai][bj][m][n], 0, 0, 0); __builtin_amdgcn_s_setprio(0); } while (0)
#define PG8_WAIT_V(n) asm volatile("s_waitcnt vmcnt(" #n ")" ::: "memory")
#define PG8_WAIT_L(n) asm volatile("s_waitcnt lgkmcnt(" #n ")" ::: "memory")
#define PG8_BAR __builtin_amdgcn_s_barrier()
#define PG8_SCHED __builtin_amdgcn_sched_barrier(0)
    Unit cur, nxt; int ui = 0;
    if (!S.next(0, cur)) return;
    f32x4 acc[2][2][4][2];
#pragma unroll
    for (int a = 0; a < 2; ++a)
#pragma unroll
        for (int b = 0; b < 2; ++b)
#pragma unroll
            for (int m = 0; m < 4; ++m)
#pragma unroll
                for (int n = 0; n < 2; ++n) acc[a][b][m][n] = (f32x4){0.f, 0.f, 0.f, 0.f};
    bf16x8 At[4][2], B0[2][2], B1[2][2]; v8i32 At8[4], B08[2], B18[2]; const int one_scale = 0x7F7F7F7F;
#define XLDA(b, h) do { if constexpr (FP8) PG8_LDA8(At8, b, h); else PG8_LDA(At, b, h); } while (0)
#define XLDB0(b, h) do { if constexpr (FP8) PG8_LDB8(B08, b, h); else PG8_LDB(B0, b, h); } while (0)
#define XLDB1(b, h) do { if constexpr (FP8) PG8_LDB8(B18, b, h); else PG8_LDB(B1, b, h); } while (0)
#define XMMA0(ai, bj) do { if constexpr (FP8) PG8_MMA8(ai, bj, At8, B08); else PG8_MMA(ai, bj, At, B0); } while (0)
#define XMMA1(ai, bj) do { if constexpr (FP8) PG8_MMA8(ai, bj, At8, B18); else PG8_MMA(ai, bj, At, B1); } while (0)
    unsigned vAc[2][2], vAn[2][2];
#define PG8_ROWS(dst, un) do { if constexpr (GATHER) { _Pragma("unroll") for (int _h = 0; _h < 2; ++_h) _Pragma("unroll") for (int _i = 0; _i < 2; ++_i) \
        dst[_h][_i] = (S.arow(un, _h * HALF + Rr[0] + 64 * _i) * (unsigned)K + (unsigned)Cc[0]) * 2u; } } while (0)
    PG8_ROWS(vAc, cur);
#pragma unroll
    for (int _h = 0; _h < 2; ++_h)
#pragma unroll
        for (int _i = 0; _i < 2; ++_i) vAn[_h][_i] = vAc[_h][_i];
    unsigned cA = GATHER ? 0u : (unsigned)cur.pm * tstep; unsigned cB = (unsigned)cur.pn * tstep;
    PG8_STAGE(PG8_SB(0, 0), cB, voffB); PG8_STAGE(PG8_SB(0, 1), cB + hstep, voffB); PG8_STAGE_A(PG8_SA(0, 0), cA, 0, false); PG8_STAGE_A(PG8_SA(0, 1), cA, 1, false);
    if (wr == 1) PG8_BAR;
    PG8_WAIT_V(2); PG8_BAR;
    PG8_STAGE(PG8_SB(1, 0), cB + kstep, voffB); PG8_STAGE_A(PG8_SA(1, 0), cA + kstep, 0, false); PG8_STAGE(PG8_SB(1, 1), cB + hstep + kstep, voffB);
    PG8_WAIT_V(6); PG8_BAR;
    for (;;) {
        const bool has_next = S.next(ui + 1, nxt);
        if constexpr (GATHER) {
            if (has_next) {
                if (ui == 0) { PG8_ROWS(vAn, nxt); asm volatile("" : "+v"(vAn[0][0]), "+v"(vAn[0][1]), "+v"(vAn[1][0]), "+v"(vAn[1][1])); }
                else {
#pragma unroll
                    for (int _h = 0; _h < 2; ++_h)
#pragma unroll
                        for (int _i = 0; _i < 2; ++_i) { const int R_ = _h * HALF + Rr[0] + 64 * _i; const unsigned v_ = *(const LAS unsigned*)(lds + PRE_ROWS + ((ui + 1) & 1) * 1024 + R_ * 4);
                            vAn[_h][_i] = (S.rowval(nxt, R_, v_) * (unsigned)K + (unsigned)Cc[0]) * 2u; } }
            }
            Unit n2_; if (S.next(ui + 2, n2_)) { if (wid == 0) __builtin_amdgcn_global_load_lds((const unsigned*)(S.rows_ptr(n2_) + lane * 4), (LAS unsigned*)(lds + PRE_ROWS + (ui & 1) * 1024), 16, 0, 0); }
        } else { if (has_next) { PG8_ROWS(vAn, nxt); } }
        if constexpr (Epi::HAS_PRE) E.pre(lds + PRE_EPI + (ui & 1) * 2048, cur, wid, lane);
        const unsigned nA = GATHER ? 0u : (has_next ? (unsigned)nxt.pm * tstep : cA);
        const unsigned nB = has_next ? (unsigned)nxt.pn * tstep : cB;
#pragma unroll 1
        for (int t = 0; t < nt; t += 2) {
            const bool last = (t == nt - 2);
            const bool nx = last && has_next;
            const unsigned a1 = cA + (unsigned)(t + 1) * kstep;
            const unsigned a2 = last ? nA : cA + (unsigned)(t + 2) * kstep; const unsigned b2 = last ? nB : cB + (unsigned)(t + 2) * kstep;
            const unsigned a3 = a2 + kstep; const unsigned b3 = b2 + kstep;
            XLDB0(0, 0); XLDB1(0, 1); PG8_SCHED; XLDA(0, 0); PG8_STAGE_A(PG8_SA(1, 1), a1, 1, false);
            PG8_WAIT_V(8); PG8_WAIT_L(0); PG8_BAR; XMMA0(0, 0); XMMA1(0, 1); PG8_BAR; PG8_SCHED;
            XLDA(0, 1); PG8_STAGE(PG8_SB(0, 0), b2, voffB); PG8_STAGE(PG8_SB(0, 1), b2 + hstep, voffB); PG8_STAGE_A(PG8_SA(0, 0), a2, 0, nx);
            PG8_WAIT_V(8); PG8_WAIT_L(0); PG8_BAR; XMMA0(1, 0); XMMA1(1, 1); PG8_BAR; PG8_SCHED;
            XLDB0(1, 0); XLDB1(1, 1); PG8_SCHED; XLDA(1, 0); PG8_STAGE_A(PG8_SA(0, 1), a2, 1, nx);
            PG8_WAIT_V(8); PG8_WAIT_L(0); PG8_BAR; XMMA0(0, 0); XMMA1(0, 1); PG8_BAR; PG8_SCHED;
            XLDA(1, 1); PG8_STAGE(PG8_SB(1, 0), b3, voffB); PG8_STAGE(PG8_SB(1, 1), b3 + hstep, voffB); PG8_STAGE_A(PG8_SA(1, 0), a3, 0, nx);
            PG8_WAIT_V(8); PG8_WAIT_L(0); PG8_BAR; XMMA0(1, 0); XMMA1(1, 1); PG8_BAR; PG8_SCHED;
        }
        if constexpr (FP8) asm volatile("s_nop 15\n\ts_nop 15" ::: "memory");
        if constexpr (ALIGN_EPI) { if (wr == 0) PG8_BAR; }
        if constexpr (Epi::HAS_PRE) E(acc, cur, wr, wc, fr, fq, lds + PRE_EPI + (ui & 1) * 2048); else E(acc, cur, wr, wc, fr, fq);
        if (!has_next) break;
#pragma unroll
        for (int a = 0; a < 2; ++a)
#pragma unroll
            for (int b = 0; b < 2; ++b)
#pragma unroll
                for (int m = 0; m < 4; ++m)
#pragma unroll
                    for (int n = 0; n < 2; ++n) acc[a][b][m][n] = (f32x4){0.f, 0.f, 0.f, 0.f};
        cur = nxt; cA = nA; cB = nB; ++ui;
#pragma unroll
        for (int _h = 0; _h < 2; ++_h)
#pragma unroll
            for (int _i = 0; _i < 2; ++_i) vAc[_h][_i] = vAn[_h][_i];
        if constexpr (ALIGN_EPI) { if (wr == 1) PG8_BAR; }
    }
    PG8_WAIT_V(0);
    if constexpr (!ALIGN_EPI) { if (wr == 0) PG8_BAR; }
    PG8_BAR;
#undef PG8_SA
#undef PG8_SB
#undef PG8_STAGE
#undef PG8_STAGEA
#undef PG8_STAGE_A
#undef PG8_ROWS
#undef PG8_LDA
#undef PG8_LD8
#undef PG8_LDA8
#undef PG8_LDB8
#undef PG8_MMA8
#undef XLDA
#undef XLDB0
#undef XLDB1
#undef XMMA0
#undef XMMA1
#undef PG8_LDB
#undef PG8_MMA
#undef PG8_WAIT_V
#undef PG8_WAIT_L
#undef PG8_BAR
#undef PG8_SCHED
}
}

constexpr int DM = 1024, SEQ = 16384, NB = 2, T = NB * SEQ, CTX = 256, NCTX = NB * CTX, NKEY = SEQ + CTX;
constexpr int NE = 32, TOPK = 4, CAP = 32768;
constexpr float ALPHA = 1.4142135623730951f, LN_EPS = 1e-5f;
constexpr float QSCALE = 0.125f * 1.4426950408889634f;
constexpr float LAM_INIT0 = 0.2f;
constexpr int NWAVES = 8, NTHR = 512;

constexpr size_t MiB = 1u << 20;
constexpr size_t WS_CTL = 0, CTL_ZERO_BYTES = 1 * MiB;
constexpr size_t WS_MODP = 1 * MiB;
constexpr size_t WS_MOD = 3 * MiB;
constexpr size_t WS_TAB = 4 * MiB;
constexpr size_t WS_WEVIN = 6 * MiB, WS_WEVOUT = 11 * MiB, WS_WODIN = 13 * MiB, WS_WODOUT = 16 * MiB;
constexpr size_t WS_LIST = 18 * MiB, WS_GATES = 22 * MiB;
constexpr size_t WS_WGU = 32 * MiB;
constexpr size_t WS_WD = 288 * MiB;
constexpr size_t WS_U = 416 * MiB;
constexpr size_t WS_Q = 482 * MiB, WS_K = 514 * MiB, WS_V = 547 * MiB, WS_AB = 580 * MiB;
constexpr size_t WS_O0 = 612 * MiB;
constexpr size_t WS_MIX = 676 * MiB, WS_Y = 740 * MiB, WS_H1 = 804 * MiB, WS_U2 = 932 * MiB;
constexpr size_t WS_ACT = 996 * MiB;
constexpr size_t WS_YB = 1268 * MiB;
constexpr size_t WS_H2 = 1524 * MiB;
constexpr size_t WS_ZODD = 1652 * MiB;
constexpr size_t WS_WT = 1748 * MiB;
constexpr size_t WS_END = 1812 * MiB;
constexpr size_t TB_COS = 0, TB_SIN = 20480, TB_CS = 40960  , TB_AF = 106496  , TB_A3 = 237568  , TB_TW = 303104  , TB_WS = 434176  , TB_END = 565248;
constexpr int CW_ERR = 0, CW_BAR = 4096, CW_CNT = 16384;
#define XB_TMO      128
#define XB_XCNT(j)  (256  + 64 * (j))
#define XB_XSUB(j)  (1280 + 64 * (j))
#define XB_XGEN(j)  (2304 + 64 * (j))
#define XB_TOP      3328
#define XB_TOPGEN   3392
#define XCD_BAR_WORDS 3456
#define XB_SPIN_CAP (1u << 18)
constexpr int LDS_BYTES = 160 * 1024, MISC_OFF = LDS_BYTES - 256, META_OFF = 131072;

__device__ __forceinline__ unsigned xb_ld(unsigned* p)              { return __hip_atomic_load(p, __ATOMIC_RELAXED, __HIP_MEMORY_SCOPE_AGENT); }
__device__ __forceinline__ unsigned xb_add(unsigned* p, unsigned v) { return __hip_atomic_fetch_add(p, v, __ATOMIC_RELAXED, __HIP_MEMORY_SCOPE_AGENT); }
__device__ __forceinline__ unsigned xb_xcc_id() { return (unsigned)__builtin_amdgcn_s_getreg((3 << 11) | 20) & 0xFu; }
#define XB_SPIN(cond, bar) do { unsigned _sp = 0; while (cond) { __builtin_amdgcn_s_sleep(1); \
    if ((++_sp & 255u) == 0u) { if (xb_ld(&(bar)[XB_TMO])) break; if (_sp > XB_SPIN_CAP) { atomicAdd(&(bar)[XB_TMO], 1u); break; } } } } while (0)
struct XcdBarrier { unsigned* bar; unsigned x; volatile LAS unsigned* st; };
__device__ __forceinline__ XcdBarrier xcd_barrier_post(unsigned* bar, volatile LAS unsigned* st) {
    XcdBarrier b; b.bar = bar; b.x = xb_xcc_id(); b.st = st;
    if (threadIdx.x == 0) (void)xb_add(&bar[XB_XCNT(b.x)], 1u);
    return b;
}
__device__ __forceinline__ void xcd_barrier_complete(unsigned* bar, unsigned x, unsigned& nloc, unsigned& nx) {
    const unsigned G = gridDim.x * gridDim.y * gridDim.z;
    unsigned sum, cnt, mine, sp = 0u;
    for (;;) {
        sum = 0u; cnt = 0u; mine = 0u;
#pragma unroll
        for (unsigned j = 0; j < 16; ++j) { const unsigned c = xb_ld(&bar[XB_XCNT(j)]); sum += c; cnt += (c > 0u) ? 1u : 0u; mine = (j == x) ? c : mine; }
        if (sum == G) break;
        __builtin_amdgcn_s_sleep(1);
        if ((++sp & 255u) == 0u) { if (xb_ld(&bar[XB_TMO])) break; if (sp > XB_SPIN_CAP) { atomicAdd(&bar[XB_TMO], 1u); break; } }
    }
    nloc = mine > 0u ? mine : 1u; nx = cnt > 0u ? cnt : 1u;
}
__device__ __forceinline__ void xcd_barrier(const XcdBarrier& b) {
    asm volatile("s_waitcnt vmcnt(0)" ::: "memory");
    __syncthreads();
    if (threadIdx.x == 0) {
        unsigned* bar = b.bar;
        __builtin_amdgcn_s_waitcnt(0);
        unsigned nloc = b.st[0], nx = b.st[1];
        if (nloc == 0u) { xcd_barrier_complete(bar, b.x, nloc, nx); b.st[0] = nloc; b.st[1] = nx; }
        const unsigned old = xb_add(&bar[XB_XSUB(b.x)], 1u);
        const unsigned gen = old / nloc;
        if (old + 1u == (gen + 1u) * nloc) {
            __builtin_amdgcn_fence(__ATOMIC_RELEASE, "agent");
            asm volatile("s_waitcnt vmcnt(0)" ::: "memory");
            const unsigned og = xb_add(&bar[XB_TOP], 1u);
            const unsigned tg = og / nx;
            if (og + 1u == (tg + 1u) * nx) xb_add(&bar[XB_TOPGEN], 1u);
            else XB_SPIN(xb_ld(&bar[XB_TOPGEN]) == tg, bar);
            __builtin_amdgcn_fence(__ATOMIC_ACQUIRE, "agent");
            xb_add(&bar[XB_XGEN(b.x)], 1u);
            asm volatile("s_waitcnt vmcnt(0)" ::: "memory");
        } else {
            XB_SPIN(xb_ld(&bar[XB_XGEN(b.x)]) == gen, bar);
            __builtin_amdgcn_fence(__ATOMIC_ACQUIRE, "agent");
            asm volatile("s_waitcnt vmcnt(0)" ::: "memory");
        }
    }
    __syncthreads();
}

__device__ __forceinline__ float bf2f(unsigned short b) { return __uint_as_float(((unsigned)b) << 16); }
__device__ __forceinline__ unsigned f2bf(float f) { unsigned u = __float_as_uint(f); return (u + 0x7fffu + ((u >> 16) & 1u)) >> 16; }
__device__ __forceinline__ unsigned pk2(float lo, float hi) { return f2bf(lo) | (f2bf(hi) << 16); }
__device__ __forceinline__ unsigned char f2fp8(float a) { return (unsigned char)((unsigned)__builtin_amdgcn_cvt_pk_fp8_f32(a, 0.f, 0, false) & 0xffu); }
__device__ __forceinline__ unsigned pk4_fp8(float a, float b, float c, float d) { unsigned w = (unsigned)__builtin_amdgcn_cvt_pk_fp8_f32(a, b, 0, false); return (unsigned)__builtin_amdgcn_cvt_pk_fp8_f32(c, d, (int)w, true); }
constexpr float WO_SCALE = 64.0f;
constexpr float WGU_SCALE = 32.0f, WD_SCALE = 64.0f;
template <int CTRL> __device__ __forceinline__ float dpp_f(float v) { return __builtin_bit_cast(float, __builtin_amdgcn_update_dpp(0, __builtin_bit_cast(int, v), CTRL, 0xf, 0xf, true)); }
__device__ __forceinline__ float wave_sum(float v) {
    v += dpp_f<0xB1>(v); v += dpp_f<0x4E>(v); v += dpp_f<0x141>(v); v += dpp_f<0x140>(v);
    { const auto r = __builtin_amdgcn_permlane16_swap(__float_as_uint(v), __float_as_uint(v), false, false); v = __uint_as_float(r[0]) + __uint_as_float(r[1]); }
    { const auto r = __builtin_amdgcn_permlane32_swap(__float_as_uint(v), __float_as_uint(v), false, false); v = __uint_as_float(r[0]) + __uint_as_float(r[1]); }
    return v;
}
__device__ __forceinline__ float half_sum(float v) {
    v += dpp_f<0xB1>(v); v += dpp_f<0x4E>(v); v += dpp_f<0x141>(v); v += dpp_f<0x140>(v);
    { const auto r = __builtin_amdgcn_permlane16_swap(__float_as_uint(v), __float_as_uint(v), false, false); v = __uint_as_float(r[0]) + __uint_as_float(r[1]); }
    return v;
}
__device__ __forceinline__ float xhalf_sum(float v) {
    const auto r = __builtin_amdgcn_permlane32_swap(__float_as_uint(v), __float_as_uint(v), false, false); return __uint_as_float(r[0]) + __uint_as_float(r[1]);
}
__device__ __forceinline__ float wave_max(float v) {
    v = fmaxf(v, dpp_f<0xB1>(v)); v = fmaxf(v, dpp_f<0x4E>(v)); v = fmaxf(v, dpp_f<0x141>(v)); v = fmaxf(v, dpp_f<0x140>(v));
    { const auto r = __builtin_amdgcn_permlane16_swap(__float_as_uint(v), __float_as_uint(v), false, false); v = fmaxf(__uint_as_float(r[0]), __uint_as_float(r[1])); }
    { const auto r = __builtin_amdgcn_permlane32_swap(__float_as_uint(v), __float_as_uint(v), false, false); v = fmaxf(__uint_as_float(r[0]), __uint_as_float(r[1])); }
    return v;
}
__device__ __forceinline__ int crow(int r, int hi) { return (r & 3) + 8 * (r >> 2) + 4 * hi; }
__device__ __forceinline__ float silu_f(float x) { return x / (1.0f + __expf(-x)); }
__device__ __forceinline__ float sigmoid_f(float x) { return 1.0f / (1.0f + __expf(-x)); }
__device__ __forceinline__ int v_st(int k, int c) { const int kk = (k & ~0xC) | ((k & 4) << 1) | ((k & 8) >> 1); return ((kk >> 3) * 4 + (c >> 5)) * 512 + ((kk & 7) * 32 + (c & 31)) * 2; }
__device__ __forceinline__ int v_rd_base(int lane) { return ((lane & 3) << 3) | (((lane >> 2) & 3) << 6) | (((lane >> 4) & 1) << 5) | (((lane >> 5) & 1) << 8); }
__host__ __device__ constexpr int v_rd_off(int d0, int ks, int half) { return d0 * 512 + ks * 4096 + half * 2048; }
typedef short v4i16_t __attribute__((ext_vector_type(4)));
__device__ __forceinline__ bf16x8 vfrag(LAS unsigned char* tile_rd  , int d0, int ks) {
    const v4i16_t lo = __builtin_amdgcn_ds_read_tr16_b64_v4i16((LAS v4i16_t*)(tile_rd + v_rd_off(d0, ks, 0)));
    const v4i16_t hi = __builtin_amdgcn_ds_read_tr16_b64_v4i16((LAS v4i16_t*)(tile_rd + v_rd_off(d0, ks, 1)));
    return (bf16x8){lo[0], lo[1], lo[2], lo[3], hi[0], hi[1], hi[2], hi[3]};
}

struct Args { const float* in[35]; float* out; unsigned char* ws; int ph_lo, ph_hi; };

struct Frame { LAS unsigned char* lds; int tid, lane, wave, G, bx, kz; };
#define CAS __attribute__((address_space(4)))
__device__ __forceinline__ const float* kin_(int kz, int i) { return *(const float* const CAS*)((const CAS char*)__builtin_amdgcn_kernarg_segment_ptr() + kz + 8 * i); }
#define KIN(F, i) kin_((F).kz, (i))
#define KOUT(F) ((float*)kin_((F).kz, 35))
#define KWS(F) ((unsigned char*)kin_((F).kz, 36))
static_assert(sizeof(Args) == 37 * 8 + 8, "Args layout");

__device__ __forceinline__ void ph0_mod_tables(Frame& F) {
    const float* c = KIN(F, 1); const float* cctx = KIN(F, 3); const float* wmod = KIN(F, 4);
    LAS float* sv = (LAS float*)F.lds;
    for (int vb = F.bx; vb < 256; vb += F.G) {
    const int l = vb >> 7, rem = vb & 127, nch = rem & 7, kch = rem >> 3, k0 = kch * 64;
    if (F.tid < 192) { const int v = F.tid >> 6, k = F.tid & 63; const float x = (v < 2) ? c[v * DM + k0 + k] : cctx[k0 + k]; sv[v * 64 + k] = silu_f(x); }
    __syncthreads();
    if (F.tid < 384) {
        const int col = nch * 768 + F.tid * 2;
        const float* W = wmod + ((size_t)l * DM + k0) * 6144 + col;
        f32x2 a0 = {0.f, 0.f}, a1 = {0.f, 0.f}, a2 = {0.f, 0.f};
#pragma unroll 8
        for (int k = 0; k < 64; ++k) { const f32x2 w = *(const f32x2*)(W + (size_t)k * 6144); a0 += w * sv[k]; a1 += w * sv[64 + k]; a2 += w * sv[128 + k]; }
        float* mp = (float*)(KWS(F) + WS_MODP) + (size_t)kch * 5 * 6144 + col;
        if (l == 0) { *(f32x2*)(mp + 0 * 6144) = a0; *(f32x2*)(mp + 1 * 6144) = a1; *(f32x2*)(mp + 2 * 6144) = a2; }
        else { *(f32x2*)(mp + 3 * 6144) = a0; *(f32x2*)(mp + 4 * 6144) = a1; }
    }
    __syncthreads();
    }
    const int bx = F.bx;
    unsigned char* tb = KWS(F) + WS_TAB;
    const int gid = bx * NTHR + F.tid, NG = F.G * NTHR;
    const float s128 = 0.08838834764831845f;
    for (int i = gid; i < 5120; i += NG) {
        const int pos = i >> 4, f = i & 15; const int p = pos < 256 ? pos : pos - 256;
        const float inv = powf(10000.0f, -((float)f / 16.0f)); const float ang = (float)p * inv;
        ((float*)(tb + TB_COS))[i] = (float)cos((double)ang); ((float*)(tb + TB_SIN))[i] = (float)sin((double)ang);
    }
    for (int i = gid; i < 32768; i += NG) {
        const int j8 = i & 7, ln = (i >> 3) & 63, ks = (i >> 9) & 7, nb = i >> 12;
        const int n = 32 * nb + (ln & 31), cc = 16 * ks + 8 * (ln >> 5) + j8, part = n >> 7, jj = n & 127, m = (jj * cc) & 127;
        const double a = (double)m / 64.0; const float v = (part == 0 ? (float)cospi(a) : -(float)sinpi(a)) * s128;
        ((bf16_t*)(tb + TB_CS))[i] = (bf16_t)f2bf(v);
    }
    for (int i = gid; i < 65536; i += NG) {
        const int j8 = i & 7, ln = (i >> 3) & 63, ks = (i >> 9) & 15, mb = i >> 13;
        const int m = 32 * mb + (ln & 31), k = 16 * ks + 8 * (ln >> 5) + j8, mpart = m >> 7, k1 = m & 127, part = k >> 7, t1 = k & 127, ph = (k1 * t1) & 127;
        const double a = (double)ph / 64.0; const float cs = (float)cospi(a), sn = (float)sinpi(a);
        const float v = (mpart == 0 ? (part == 0 ? cs : sn) : (part == 0 ? -sn : cs)) * s128;
        ((bf16_t*)(tb + TB_AF))[i] = (bf16_t)f2bf(v);
    }
    for (int i = gid; i < 32768; i += NG) {
        const int j8 = i & 7, ln = (i >> 3) & 63, ks = (i >> 9) & 15, mb = i >> 13;
        const int k2 = 32 * mb + (ln & 31), k = 16 * ks + 8 * (ln >> 5) + j8, part = k >> 7, t2 = k & 127, ps = (k2 * t2) & 127;
        const double a = (double)ps / 64.0; const float v = (part == 0 ? (float)cospi(a) : (float)sinpi(a)) * s128;
        ((bf16_t*)(tb + TB_A3))[i] = (bf16_t)f2bf(v);
    }
    for (int i = gid; i < 16384; i += NG) {
        const int t2 = i >> 7, k1 = i & 127; const double a = (double)((k1 * t2) & 16383) / 8192.0;
        ((f32x2*)(tb + TB_TW))[i] = (f32x2){(float)cospi(a), (float)sinpi(a)};
    }
    const float* gws = KIN(F, 25);
    for (int i = gid; i < 65536; i += NG) ((bf16_t*)(tb + TB_WS))[i] = (bf16_t)f2bf(gws[i]);
}

__device__ __forceinline__ void transpose_item(const float* W, int K, int ldw, int k0, int n_src0, bf16_t* WT, int row_dst0, LAS float* scr, int lane) {
#pragma unroll 8
    for (int i = 0; i < 32; ++i) { const int kk = 2 * i + (lane >> 5); scr[kk * 33 + (lane & 31)] = W[(size_t)(k0 + kk) * ldw + n_src0 + (lane & 31)]; }
    asm volatile("s_waitcnt lgkmcnt(0)" ::: "memory");
    const int c = lane & 7;
#pragma unroll
    for (int j = 0; j < 4; ++j) { const int n = (lane >> 3) + 8 * j; const LAS float* s = scr + (8 * c) * 33 + n;
        u32x4 o; o.x = pk2(s[0 * 33], s[1 * 33]); o.y = pk2(s[2 * 33], s[3 * 33]); o.z = pk2(s[4 * 33], s[5 * 33]); o.w = pk2(s[6 * 33], s[7 * 33]);
        *(u32x4*)(WT + (size_t)(row_dst0 + n) * K + k0 + 8 * c) = o; }
    asm volatile("s_waitcnt lgkmcnt(0)" ::: "memory");
}
__device__ __forceinline__ void transpose_item_fp8(const float* W, int K, int ldw, int k0, int n_src0, unsigned char* WT8, int row_dst0, float scale, LAS float* scr, int lane) {
#pragma unroll 8
    for (int i = 0; i < 64; ++i) { const int kk = 2 * i + (lane >> 5); scr[kk * 33 + (lane & 31)] = W[(size_t)(k0 + kk) * ldw + n_src0 + (lane & 31)]; }
    asm volatile("s_waitcnt lgkmcnt(0)" ::: "memory");
    const int q = lane & 3;
#pragma unroll
    for (int j = 0; j < 2; ++j) { const int n = (lane >> 2) + 16 * j; const LAS float* s = scr + (32 * q) * 33 + n; unsigned w[8];
#pragma unroll
        for (int t = 0; t < 8; ++t) w[t] = pk4_fp8(s[(4 * t) * 33] * scale, s[(4 * t + 1) * 33] * scale, s[(4 * t + 2) * 33] * scale, s[(4 * t + 3) * 33] * scale);
        unsigned char* dst = WT8 + (size_t)(row_dst0 + n) * K + k0 + 32 * q;
        *(u32x4*)dst = (u32x4){w[0], w[1], w[2], w[3]}; *(u32x4*)(dst + 16) = (u32x4){w[4], w[5], w[6], w[7]}; }
    asm volatile("s_waitcnt lgkmcnt(0)" ::: "memory");
}
__device__ __forceinline__ void ph1_convert(Frame& F) {
    {
        const int gid = F.bx * NTHR + F.tid;
        if (gid < 5 * 6144) { const int vec = gid / 6144, n = gid % 6144, l = vec < 3 ? 0 : 1; float s = KIN(F, 5)[l * 6144 + n];
            const float* mp = (const float*)(KWS(F) + WS_MODP) + (size_t)vec * 6144 + n;
#pragma unroll
            for (int kc = 0; kc < 16; ++kc) s += mp[(size_t)kc * 5 * 6144];
            ((float*)(KWS(F) + WS_MOD))[gid] = s; }
    }
    LAS float* scr = (LAS float*)(F.lds + F.wave * 16896);
    const int gw = F.bx * NWAVES + F.wave, NGW = F.G * NWAVES;
    constexpr int I_EVIN = 16 * 80, I_EVOUT = 8 * 32, I_ODIN = 16 * 48, I_ODOUT = 8 * 32, I_DENSE = I_EVIN + I_EVOUT + I_ODIN + I_ODOUT;
    constexpr int I_GU = 64 * 512, I_DN = 64 * 256, NITEMS = I_DENSE + I_GU + I_DN;
    for (int it = gw; it < NITEMS; it += NGW) {
        int r = it;
        if (r < I_EVIN) { const int kb = r / 80, nb = r % 80, n0 = 32 * nb; int src = n0;
            if (n0 >= 1536) { const int u = (n0 - 1536) >> 8, w = (n0 - 1536) & 255; src = (w < 128) ? 1536 + 128 * u + w : 2048 + 128 * u + (w - 128); }
            transpose_item(KIN(F, 10), DM, 2560, 64 * kb, src, (bf16_t*)(KWS(F) + WS_WEVIN), n0, scr, F.lane); continue; } r -= I_EVIN;
        if (r < I_EVOUT) { const int kb = r / 32, nb = r % 32; transpose_item_fp8(KIN(F, 11), DM, 1024, 128 * kb, 32 * nb, (unsigned char*)(KWS(F) + WS_WEVOUT), 32 * nb, WO_SCALE, scr, F.lane); continue; } r -= I_EVOUT;
        if (r < I_ODIN) { const int kb = r / 48, nb = r % 48; transpose_item(KIN(F, 21), DM, 1536, 64 * kb, 32 * nb, (bf16_t*)(KWS(F) + WS_WODIN), 32 * nb, scr, F.lane); continue; } r -= I_ODIN;
        if (r < I_ODOUT) { const int kb = r / 32, nb = r % 32; transpose_item_fp8(KIN(F, 22), DM, 1024, 128 * kb, 32 * nb, (unsigned char*)(KWS(F) + WS_WODOUT), 32 * nb, WO_SCALE, scr, F.lane); continue; } r -= I_ODOUT;
        if (r < I_GU) { const int le = r >> 9, q = r & 511, kb = q >> 6, nb = q & 63, n0 = 32 * nb; const int u = n0 >> 8, w = n0 & 255;
            const int src = (w < 128) ? 128 * u + w : 1024 + 128 * u + (w - 128);
            transpose_item_fp8(KIN(F, 31) + (size_t)le * DM * 2048, DM, 2048, 128 * kb, src, (unsigned char*)(KWS(F) + WS_WGU) + (size_t)le * 2048 * DM, n0, WGU_SCALE, scr, F.lane); continue; } r -= I_GU;
        { const int le = r >> 8, q = r & 255, kb = q >> 5, nb = q & 31;
            transpose_item_fp8(KIN(F, 33) + (size_t)le * DM * 1024, DM, 1024, 128 * kb, 32 * nb, (unsigned char*)(KWS(F) + WS_WD) + (size_t)le * 1024 * DM, 32 * nb, WD_SCALE, scr, F.lane); }
    }
}

__device__ __forceinline__ void mod_row(const float* xrow, const float* sh, const float* sc, bf16_t* orow, int lane) {
    f32x4 x[4], a[4], b[4];
#pragma unroll
    for (int j = 0; j < 4; ++j) { const int d = 4 * lane + 256 * j; x[j] = *(const f32x4*)(xrow + d); a[j] = *(const f32x4*)(sc + d); b[j] = *(const f32x4*)(sh + d); }
    asm volatile("" ::: "memory");
#pragma unroll
    for (int j = 0; j < 4; ++j) { const int d = 4 * lane + 256 * j;
        const f32x4 v = x[j] * (a[j] + 1.0f) + b[j]; u32x2 w; w.x = pk2(v[0], v[1]); w.y = pk2(v[2], v[3]); *(u32x2*)(orow + d) = w; }
}
__device__ __forceinline__ void ph2_modulate(Frame& F) {
    const float* mod = (const float*)(KWS(F) + WS_MOD); bf16_t* U = (bf16_t*)(KWS(F) + WS_U);
    const int gw = F.bx * NWAVES + F.wave, NGW = F.G * NWAVES;
    for (int r = gw; r < T + NCTX; r += NGW) {
        if (r < T) { const int b = r >> 14; mod_row(KIN(F, 0) + (size_t)r * DM, mod + b * 6144, mod + b * 6144 + 1024, U + (size_t)r * DM, F.lane); }
        else { mod_row(KIN(F, 2) + (size_t)(r - T) * DM, mod + 2 * 6144, mod + 2 * 6144 + 1024, U + (size_t)r * DM, F.lane); }
    }
}

struct EvInOrder {
    pg8::StaticOrder so;
    __device__ bool next(int i, pg8::Unit& u) const {
        const long L = (long)i * so.G + so.c;
        if (L < so.nwg) return so.map(L, u);
        const int x = (int)(L - so.nwg); if (x >= 8) return false;
        u.pm = 128 + (x >> 2); u.pn = 2 + (x & 3); u.a0 = 0; u.a1 = 0; u.a2 = 256; return true;
    }
    __device__ __forceinline__ unsigned arow(const pg8::Unit&, int) const { return 0u; }
};
__device__ __forceinline__ int vpos64(int k) { return 32 * ((k >> 2) & 1) + 16 * (k >> 5) + ((k & 3) + 4 * ((k & 31) >> 3)); }
struct EpiEvIn {
    static constexpr bool PERM = false, HAS_PRE = false;
    unsigned char *Q8, *K8, *V8T; bf16_t* Ab; const float* cosT; const float* sinT;
    __device__ __forceinline__ void operator()(const f32x4 (&acc)[2][2][4][2], const pg8::Unit& u, int wr, int wc, int fr, int fq) const {
        const int pn = u.pn;
        if (pn < 4) {
            const int kind = pn >> 1, colbase = (pn & 1) * 256 + wc * 32 + 4 * fq; const bool isctx = u.pm >= 128;
            const float sc = (kind == 0) ? QSCALE : 1.0f;
#define QK_ROW(ai, m, CS, SN) do { const int row = u.pm * 256 + (ai) * 128 + wr * 64 + (m) * 16 + fr; int b_, key_; \
                if (!isctx) { b_ = row >> 14; key_ = row & (SEQ - 1); } else { const int rc_ = row - T; b_ = rc_ >> 8; key_ = SEQ + (rc_ & 255); } \
                unsigned char* dst = (kind == 0) ? Q8 + (size_t)row * 512 : K8 + (size_t)(b_ * NKEY + key_) * 512; \
                _Pragma("unroll") for (int bj = 0; bj < 2; ++bj) { const f32x4 x1 = acc[ai][bj][m][0], x2 = acc[ai][bj][m][1]; \
                    const f32x4 o1 = (x1 * (CS) - x2 * (SN)) * sc, o2 = (x1 * (SN) + x2 * (CS)) * sc; \
                    *(unsigned*)(dst + colbase + bj * 128) = pk4_fp8(o1[0], o1[1], o1[2], o1[3]); *(unsigned*)(dst + colbase + bj * 128 + 16) = pk4_fp8(o2[0], o2[1], o2[2], o2[3]); } } while (0)
            if (wc & 1) {
                f32x4 cs[4], sn[4];
#pragma unroll
                for (int m = 0; m < 4; ++m) { cs[m] = (f32x4){1.f, 1.f, 1.f, 1.f}; sn[m] = (f32x4){0.f, 0.f, 0.f, 0.f};
                    if (!isctx) { const int pos = 256 + m * 16 + fr; cs[m] = *(const f32x4*)(cosT + pos * 16 + 4 * fq); sn[m] = *(const f32x4*)(sinT + pos * 16 + 4 * fq); } }
                asm volatile("" ::: "memory");
#pragma unroll
                for (int ai = 0; ai < 2; ++ai)
#pragma unroll
                    for (int m = 0; m < 4; ++m) QK_ROW(ai, m, cs[m], sn[m]);
            } else {
                f32x4 cs[2], sn[2];
#pragma unroll
                for (int ai = 0; ai < 2; ++ai) { cs[ai] = (f32x4){1.f, 1.f, 1.f, 1.f}; sn[ai] = (f32x4){0.f, 0.f, 0.f, 0.f};
                    if (!isctx) { const int pos = ((u.pm * 256 + ai * 128 + wr * 64) & (SEQ - 1)) >> 6; cs[ai] = *(const f32x4*)(cosT + pos * 16 + 4 * fq); sn[ai] = *(const f32x4*)(sinT + pos * 16 + 4 * fq); } }
                asm volatile("" ::: "memory");
#pragma unroll
                for (int ai = 0; ai < 2; ++ai)
#pragma unroll
                    for (int m = 0; m < 4; ++m) QK_ROW(ai, m, cs[ai], sn[ai]);
            }
#undef QK_ROW
        } else if (pn < 6) {
            const int colbase = (pn & 1) * 256 + wc * 32 + 4 * fq;
#pragma unroll
            for (int ai = 0; ai < 2; ++ai)
#pragma unroll
                for (int m = 0; m < 4; ++m) {
                    const int row = u.pm * 256 + ai * 128 + wr * 64 + m * 16 + fr; const bool isctx = row >= T;
                    int b, key;
                    if (!isctx) { b = row >> 14; key = row & (SEQ - 1); } else { const int rc = row - T; b = rc >> 8; key = SEQ + (rc & 255); }
                    const size_t kofs = (size_t)(key & ~63) + vpos64(key & 63);
#pragma unroll
                    for (int bj = 0; bj < 2; ++bj)
#pragma unroll
                        for (int n = 0; n < 2; ++n) { const f32x4 x = acc[ai][bj][m][n]; const unsigned w = pk4_fp8(x[0], x[1], x[2], x[3]); const int vcol = colbase + bj * 128 + n * 16;
                            unsigned char* dst = V8T + ((size_t)(b * 4 + (vcol >> 7)) * 128 + (vcol & 127)) * NKEY + kofs;
                            dst[0] = (unsigned char)(w & 0xff); dst[NKEY] = (unsigned char)((w >> 8) & 0xff); dst[2 * NKEY] = (unsigned char)((w >> 16) & 0xff); dst[3 * NKEY] = (unsigned char)(w >> 24); }
                }
        } else {
            const int colbase = (pn - 6) * 128 + wc * 32 + 4 * fq;
#pragma unroll
            for (int ai = 0; ai < 2; ++ai)
#pragma unroll
                for (int m = 0; m < 4; ++m) {
                    const int row = u.pm * 256 + ai * 128 + wr * 64 + m * 16 + fr; if (row >= T) continue;
                    bf16_t* dst = Ab + (size_t)row * 512 + colbase;
#pragma unroll
                    for (int n = 0; n < 2; ++n) { const f32x4 v = acc[ai][0][m][n], g = acc[ai][1][m][n]; f32x4 o;
#pragma unroll
                        for (int j = 0; j < 4; ++j) o[j] = v[j] * sigmoid_f(g[j]);
                        u32x2 w; w.x = pk2(o[0], o[1]); w.y = pk2(o[2], o[3]); *(u32x2*)(dst + n * 16) = w; }
                }
        }
    }
};

__device__ __forceinline__ void ph4_conv(Frame& F) {
    const bf16_t* Ab = (const bf16_t*)(KWS(F) + WS_AB); unsigned char* MIX = (unsigned char*)(KWS(F) + WS_MIX);
    const float* cw = KIN(F, 12); const float* cb = KIN(F, 13); const float* lg = KIN(F, 14); const float* lb = KIN(F, 15);
    LAS bf16_t* At = (LAS bf16_t*)F.lds;
    LAS float* Yt = (LAS float*)(F.lds + 65536);
    const int ch = F.tid;
    float w[31];
#pragma unroll
    for (int j = 0; j < 31; ++j) w[j] = cw[j * 512 + ch];
    const float bias = cb[ch];
#define CONV_STAGE(tile_) do { const int b_ = (tile_) >> 9, t0_ = ((tile_) & 511) * 32; \
        _Pragma("unroll") for (int k_ = 0; k_ < 8; ++k_) { const int row_ = F.wave + 8 * k_; if (row_ < 62) { const int t_ = t0_ - 15 + row_; \
            if (t_ >= 0 && t_ < SEQ) __builtin_amdgcn_global_load_lds((const unsigned*)(Ab + ((size_t)(b_ * SEQ + t_)) * 512 + F.lane * 8), (LAS unsigned*)(At + row_ * 512), 16, 0, 0); \
            else { const unsigned z_ = (unsigned)F.kz; const u32x4 zv_ = {z_, z_, z_, z_}; *(LAS u32x4*)(At + row_ * 512 + F.lane * 8) = zv_; } } } } while (0)
    const f32x4 g0 = *(const f32x4*)(lg + 8 * F.lane), g1 = *(const f32x4*)(lg + 8 * F.lane + 4), b0 = *(const f32x4*)(lb + 8 * F.lane), b1 = *(const f32x4*)(lb + 8 * F.lane + 4);
    if (F.bx < T / 32) CONV_STAGE(F.bx);
    for (int tile = F.bx; tile < T / 32; tile += F.G) {
        const int b = tile >> 9, t0 = (tile & 511) * 32;
        asm volatile("s_waitcnt vmcnt(0)" ::: "memory");
        __syncthreads();
        float a[62];
#pragma unroll
        for (int r = 0; r < 62; ++r) a[r] = bf2f(At[r * 512 + ch]);
#pragma unroll
        for (int t = 0; t < 32; ++t) { float y = bias;
#pragma unroll
            for (int j = 0; j < 31; ++j) y = fmaf(a[t + j], w[j], y);
            Yt[t * 512 + ch] = y; }
        __syncthreads();
        if (tile + F.G < T / 32) CONV_STAGE(tile + F.G);
#pragma unroll
        for (int q = 0; q < 4; ++q) { const int t = F.wave * 4 + q; const LAS float* yr = Yt + t * 512 + 8 * F.lane;
            const f32x4 y0 = *(const LAS f32x4*)yr, y1 = *(const LAS f32x4*)(yr + 4);
            float s = (y0[0] + y0[1]) + (y0[2] + y0[3]) + (y1[0] + y1[1]) + (y1[2] + y1[3]);
            const float mean = wave_sum(s) * (1.0f / 512.0f);
            const f32x4 d0 = y0 - mean, d1 = y1 - mean;
            float q2 = (d0[0] * d0[0] + d0[1] * d0[1]) + (d0[2] * d0[2] + d0[3] * d0[3]) + (d1[0] * d1[0] + d1[1] * d1[1]) + (d1[2] * d1[2] + d1[3] * d1[3]);
            const float rstd = 1.0f / sqrtf(wave_sum(q2) * (1.0f / 512.0f) + LN_EPS);
            f32x4 o0 = d0 * rstd * g0 + b0, o1 = d1 * rstd * g1 + b1;
#pragma unroll
            for (int j = 0; j < 4; ++j) { o0[j] = silu_f(o0[j]); o1[j] = silu_f(o1[j]); }
            u32x2 wv; wv.x = pk4_fp8(o0[0], o0[1], o0[2], o0[3]); wv.y = pk4_fp8(o1[0], o1[1], o1[2], o1[3]);
            *(u32x2*)(MIX + (size_t)(b * SEQ + t0 + t) * 1024 + 8 * F.lane) = wv; }
        __syncthreads();
    }
#undef CONV_STAGE
}

namespace att {
constexpr int KVBLK = 64;
constexpr int SHM_V = 128 * 64, SHM_K = 64 * 64;
constexpr int SHM_1 = 32 * 64;
constexpr int NBUF = 5, DIST = 3, TILEB = SHM_V + SHM_1 + SHM_K;
constexpr int OFF_T = 0, OFF_WS = NBUF * TILEB;
constexpr int OFF_NEG = OFF_WS + 2048;
constexpr float PREF = 6.0f, PMAXLOG = 8.0f;
#define SBAR() __builtin_amdgcn_sched_barrier(0)
#define MX3(a, b, c) __builtin_fmaxf(__builtin_fmaxf((a), (b)), (c))
typedef int v8i32a __attribute__((ext_vector_type(8)));
__device__ __forceinline__ f32x16 mfma8(v8i32a a, v8i32a b, f32x16 c) { return __builtin_amdgcn_mfma_scale_f32_32x32x64_f8f6f4(a, b, c, 0, 0, 0, 0x7F7F7F7F, 0, 0x7F7F7F7F); }
template <bool FIRST> __device__ __forceinline__ void partialSM(f32x16& p0, f32x16& p1, f32x16& negm, float& alpha) {
    float a = MX3(p0[0], p0[1], p1[0]), b = MX3(p0[2], p0[3], p1[1]); a = MX3(a, p1[2], p1[3]);
#pragma unroll
    for (int r = 4; r < 16; r += 4) { a = MX3(a, p0[r], p0[r + 1]); b = MX3(b, p0[r + 2], p0[r + 3]); a = MX3(a, p1[r], p1[r + 1]); b = MX3(b, p1[r + 2], p1[r + 3]); }
    float pmax = fmaxf(a, b);
    { auto rr = __builtin_amdgcn_permlane32_swap(__float_as_uint(pmax), __float_as_uint(pmax), false, false);
      pmax = fmaxf(__uint_as_float(rr[0]), __uint_as_float(rr[1])); }
    alpha = 1.f;
    if (FIRST || __builtin_expect(__any(pmax > PMAXLOG), 0)) {
        const float dl = FIRST ? (pmax - PREF) : fmaxf(pmax - PREF, 0.f); const float nm = negm[0] - dl; alpha = __builtin_amdgcn_exp2f(-dl);
#pragma unroll
        for (int r = 0; r < 16; ++r) { p0[r] -= dl; p1[r] -= dl; negm[r] = nm; }
    }
#pragma unroll
    for (int r = 0; r < 16; ++r) p0[r] = __builtin_amdgcn_exp2f(p0[r]);
}
__device__ __forceinline__ void finishSM(f32x16& p0, f32x16& p1, v8i32a& pf) {
#pragma unroll
    for (int r = 0; r < 16; ++r) p1[r] = __builtin_amdgcn_exp2f(p1[r]);
#pragma unroll
    for (int i = 0; i < 4; ++i) { pf[i] = (int)pk4_fp8(p0[4 * i], p0[4 * i + 1], p0[4 * i + 2], p0[4 * i + 3]); pf[4 + i] = (int)pk4_fp8(p1[4 * i], p1[4 * i + 1], p1[4 * i + 2], p1[4 * i + 3]); }
}
__device__ __forceinline__ v8i32a frag32(const LAS unsigned char* base, int a0, int a1) {
    const bf16x8 lo = *(const LAS bf16x8*)(base + a0), hi = *(const LAS bf16x8*)(base + a1);
    return __builtin_bit_cast(v8i32a, __builtin_shufflevector(lo, hi, 0, 1, 2, 3, 4, 5, 6, 7, 8, 9, 10, 11, 12, 13, 14, 15));
}
__device__ __forceinline__ void attn_pass(const unsigned char* __restrict__ Qw, const unsigned char* __restrict__ Kh, const unsigned char* __restrict__ Vt, LAS unsigned char* lds, f32x16 (&o)[4], f32x16& lacc, const int tid, const int wid) {
    const int lane = tid & 63, r32 = lane & 31, hi = lane >> 5;
    LAS float* al_l = (LAS float*)(lds + OFF_WS) + wid * 64 + 32;
    f32x16 negm = f32x16{}; lacc = f32x16{};
#pragma unroll
    for (int d = 0; d < 4; ++d) o[d] = f32x16{};
    const v8i32a qf = __builtin_bit_cast(v8i32a, __builtin_shufflevector(*(const bf16x8*)Qw, *(const bf16x8*)(Qw + 16), 0, 1, 2, 3, 4, 5, 6, 7, 8, 9, 10, 11, 12, 13, 14, 15));
    const int sw = (r32 >> 2) & 3, a0 = r32 * 64 + (((2 * hi) ^ sw) << 4), a1 = r32 * 64 + (((2 * hi + 1) ^ sw) << 4);
    const int drow = 16 * wid + (lane >> 2), dch = (lane & 3) ^ ((drow >> 2) & 3);
    const unsigned vsrc = (unsigned)(drow * NKEY + dch * 16), ksrc = (unsigned)(drow * 512 + dch * 16); const bool kw = wid < 4;
    LAS unsigned char* T_lds = lds + OFF_T;
#define DMA(t, bi) do { __builtin_amdgcn_global_load_lds((const unsigned*)((const char*)Vt + (size_t)(t) * 64 + vsrc), (LAS unsigned*)(T_lds + (bi) * TILEB + wid * 1024), 16, 0, 0); \
    if (kw) __builtin_amdgcn_global_load_lds((const unsigned*)((const char*)Kh + (size_t)(t) * (64 * 512) + ksrc), (LAS unsigned*)(T_lds + (bi) * TILEB + SHM_V + SHM_1 + wid * 1024), 16, 0, 0); } while (0)
#define WAITBAR(n) do { if (kw) asm volatile("s_waitcnt vmcnt(%0) lgkmcnt(0)" :: "n"(2 * (n)) : "memory"); else asm volatile("s_waitcnt vmcnt(%0) lgkmcnt(0)" :: "n"(n) : "memory"); \
    __builtin_amdgcn_s_barrier(); asm volatile("" ::: "memory"); } while (0)
#define RESC(a) do { if (__any((a) < 1.f)) { if (hi == 0) al_l[r32] = (a); asm volatile("s_waitcnt lgkmcnt(0)" ::: "memory"); \
    _Pragma("unroll") for (int r = 0; r < 16; ++r) { const float f_ = al_l[crow(r, hi)]; o[0][r] *= f_; o[1][r] *= f_; o[2][r] *= f_; o[3][r] *= f_; lacc[r] *= f_; } } } while (0)
#define QKT(P0, P1, bi) do { const LAS unsigned char* kb_ = T_lds + (bi) * TILEB + SHM_V + SHM_1; P0 = mfma8(frag32(kb_, a0, a1), qf, negm); P1 = mfma8(frag32(kb_ + 2048, a0, a1), qf, negm); } while (0)
#ifndef MF8_ACC
#define MF8_ACC "+v"
#endif
#define MF8(acc_, v_) asm volatile("v_mfma_scale_f32_32x32x64_f8f6f4 %0, %1, %2, %0, %3, %3 op_sel_hi:[0,0,0]" : MF8_ACC(acc_) : "v"(pf), "v"(v_), "v"(one_sc))
#define PV(bi) do { const LAS unsigned char* vb_ = T_lds + (bi) * TILEB; { const v8i32a v0_ = frag32(vb_, a0, a1), v1_ = frag32(vb_ + 2048, a0, a1); asm volatile("s_nop 1" ::: ); MF8(o[0], v0_); MF8(o[1], v1_); } \
    { const v8i32a v2_ = frag32(vb_ + 4096, a0, a1), v3_ = frag32(vb_ + 6144, a0, a1); MF8(o[2], v2_); MF8(o[3], v3_); } \
    { const v8i32a v4_ = frag32(vb_ + 8192, a0, a1); MF8(lacc, v4_); } } while (0)
    f32x16 pA0, pA1, pB0, pB1; v8i32a pf; constexpr int NT = NKEY / KVBLK;
    const int one_sc = 0x7F7F7F7F;
#define MFQK(P_, kf_) P_ = mfma8(kf_, qf, negm)
#define EX8(P_, b_) do { _Pragma("unroll") for (int r_ = 0; r_ < 8; ++r_) P_[(b_) + r_] = __builtin_amdgcn_exp2f(P_[(b_) + r_]); } while (0)
#if defined(EXP_EXTRA_MFMA)
#define XMF() do { const v8i32a vn_ = frag32(lds + OFF_NEG, a0, a1); MF8(lacc, vn_); MF8(lacc, v4_); } while (0)
#else
#define XMF() do { } while (0)
#endif
#if defined(EXP_EXTRA_LDS)
#define XTRA(A_, B_) do { _Pragma("unroll") for (int r_ = 0; r_ < 5; ++r_) { const v8i32a t_ = frag32(vb_ + 2048 * r_, a0, a1); asm volatile("" :: "v"(t_)); } } while (0)
#elif defined(EXP_EXTRA_EXP)
#define XTRA(A_, B_) do { _Pragma("unroll") for (int r_ = 0; r_ < 16; ++r_) { float t_; asm volatile("v_exp_f32 %0, %1" : "=v"(t_) : "v"(A_[r_])); asm volatile("v_exp_f32 %0, %1" : "=v"(t_) : "v"(B_[r_])); } } while (0)
#elif defined(EXP_EXTRA_ADD)
#define XTRA(A_, B_) do { _Pragma("unroll") for (int r_ = 0; r_ < 16; ++r_) { float t_; asm volatile("v_add_f32 %0, %1, %1" : "=v"(t_) : "v"(A_[r_])); asm volatile("v_add_f32 %0, %1, %1" : "=v"(t_) : "v"(B_[r_])); } } while (0)
#else
#define XTRA(A_, B_) do { } while (0)
#endif
#define STEP(C0, C1, P0, P1, HAVEPREV, FIRSTT, tnext, dodma) do { \
    if (dodma) DMA(tnext, bd); \
    const LAS unsigned char* kb_ = T_lds + bc * TILEB + SHM_V + SHM_1; const LAS unsigned char* vb_ = T_lds + bp * TILEB; \
    const v8i32a kf0_ = frag32(kb_, a0, a1), kf1_ = frag32(kb_ + 2048, a0, a1); v8i32a v0_, v1_, v2_, v3_, v4_; if (HAVEPREV) { v0_ = frag32(vb_, a0, a1); v1_ = frag32(vb_ + 2048, a0, a1); } \
    SBAR(); MFQK(C0, kf0_); if (HAVEPREV) EX8(P1, 0); SBAR(); \
    MFQK(C1, kf1_); if (HAVEPREV) { EX8(P1, 8); _Pragma("unroll") for (int i_ = 0; i_ < 4; ++i_) { pf[i_] = (int)pk4_fp8(P0[4 * i_], P0[4 * i_ + 1], P0[4 * i_ + 2], P0[4 * i_ + 3]); pf[4 + i_] = (int)pk4_fp8(P1[4 * i_], P1[4 * i_ + 1], P1[4 * i_ + 2], P1[4 * i_ + 3]); } } SBAR(); \
    float al_ = 1.f; \
    if (HAVEPREV) { asm volatile("s_nop 1" ::: ); MF8(o[0], v0_); SBAR(); MF8(o[1], v1_); v2_ = frag32(vb_ + 4096, a0, a1); v3_ = frag32(vb_ + 6144, a0, a1); v4_ = frag32(vb_ + 8192, a0, a1); SBAR(); } \
    else { asm volatile("s_nop 15\n\ts_nop 15\n\ts_nop 15\n\ts_nop 15" ::: "memory"); }     \
    float mxa_ = MX3(C0[0], C0[1], C1[0]), mxb_ = MX3(C0[2], C0[3], C1[1]); mxa_ = MX3(mxa_, C1[2], C1[3]); \
    _Pragma("unroll") for (int r_ = 4; r_ < 16; r_ += 4) { mxa_ = MX3(mxa_, C0[r_], C0[r_ + 1]); mxb_ = MX3(mxb_, C0[r_ + 2], C0[r_ + 3]); mxa_ = MX3(mxa_, C1[r_], C1[r_ + 1]); mxb_ = MX3(mxb_, C1[r_ + 2], C1[r_ + 3]); } \
    float pm_ = fmaxf(mxa_, mxb_); { auto rr_ = __builtin_amdgcn_permlane32_swap(__float_as_uint(pm_), __float_as_uint(pm_), false, false); pm_ = fmaxf(__uint_as_float(rr_[0]), __uint_as_float(rr_[1])); } \
    SBAR(); \
    if (HAVEPREV) { MF8(o[2], v2_); SBAR(); MF8(o[3], v3_); SBAR(); } \
    if (FIRSTT || __builtin_expect(__any(pm_ > PMAXLOG), 0)) { const float dl_ = FIRSTT ? (pm_ - PREF) : fmaxf(pm_ - PREF, 0.f); const float nm_ = negm[0] - dl_; al_ = __builtin_amdgcn_exp2f(-dl_); \
        _Pragma("unroll") for (int r_ = 0; r_ < 16; ++r_) { C0[r_] -= dl_; C1[r_] -= dl_; negm[r_] = nm_; } } \
    SBAR(); \
    if (HAVEPREV) { MF8(lacc, v4_); XMF(); SBAR(); } \
    EX8(C0, 0); EX8(C0, 8); XTRA(C0, C1); SBAR(); \
    if (HAVEPREV) { if (__any(al_ < 1.f)) { asm volatile("s_nop 15\n\ts_nop 15" ::: "memory"); if (hi == 0) al_l[r32] = al_; asm volatile("s_waitcnt lgkmcnt(0)" ::: "memory"); \
        _Pragma("unroll") for (int r_ = 0; r_ < 16; ++r_) { const float f_ = al_l[crow(r_, hi)]; o[0][r_] *= f_; o[1][r_] *= f_; o[2][r_] *= f_; o[3][r_] *= f_; lacc[r_] *= f_; } } } \
    } while (0)
    int bp = 4, bc = 0, bd = 3;
#define ROT() do { bp = bc; bc = (bc == NBUF - 1) ? 0 : bc + 1; bd = (bd == NBUF - 1) ? 0 : bd + 1; } while (0)
#ifdef EXP_EXTRA_BAR
#define XBAR() do { __builtin_amdgcn_s_barrier(); asm volatile("" ::: "memory"); } while (0)
#else
#define XBAR() do { } while (0)
#endif
    DMA(0, 0); DMA(1, 1); DMA(2, 2); WAITBAR(2);
    STEP(pA0, pA1, pB0, pB1, false, true, 3, true); WAITBAR(2); ROT();
#pragma unroll 1
    for (int j = 1; j + 1 < NT; j += 2) {
        const bool more = (j + 4 < NT);
        STEP(pB0, pB1, pA0, pA1, true, false, j + 3, more); if (more) WAITBAR(2); else WAITBAR(0); XBAR(); ROT();
        STEP(pA0, pA1, pB0, pB1, true, false, j + 4, more); if (more) WAITBAR(2); else WAITBAR(0); XBAR(); ROT();
    }
    STEP(pB0, pB1, pA0, pA1, true, false, 0, false); WAITBAR(0); ROT();
    { EX8(pB1, 0); EX8(pB1, 8);
#pragma unroll
      for (int i_ = 0; i_ < 4; ++i_) { pf[i_] = (int)pk4_fp8(pB0[4 * i_], pB0[4 * i_ + 1], pB0[4 * i_ + 2], pB0[4 * i_ + 3]); pf[4 + i_] = (int)pk4_fp8(pB1[4 * i_], pB1[4 * i_ + 1], pB1[4 * i_ + 2], pB1[4 * i_ + 3]); }
      SBAR(); PV(bp); }
#undef STEP
#undef MFQK
#undef EX8
    __syncthreads();
#undef ROT
#undef DMA
#undef WAITBAR
#undef RESC
#undef QKT
#undef PV
#undef MF8
}
}

__device__ __forceinline__ void ph4_attention(Frame& F) {
    const unsigned char* Q8 = (const unsigned char*)(KWS(F) + WS_Q); const unsigned char* K8 = (const unsigned char*)(KWS(F) + WS_K); const unsigned char* V8T = (const unsigned char*)(KWS(F) + WS_V);
    float* O0 = (float*)(KWS(F) + WS_O0); unsigned char* MIX = (unsigned char*)(KWS(F) + WS_MIX); const float* gn = KIN(F, 20);
    const int lane = F.lane, wid = F.wave;
    float lam;
    { const float a = wave_sum(KIN(F, 16)[lane] * KIN(F, 17)[lane]), b = wave_sum(KIN(F, 18)[lane] * KIN(F, 19)[lane]); lam = __builtin_bit_cast(float, __builtin_amdgcn_readfirstlane(__builtin_bit_cast(int, __expf(a) - __expf(b) + LAM_INIT0))); }
    __syncthreads();
    const unsigned kz_ = (unsigned)F.kz;
    for (int i = F.tid; i < att::NBUF * (att::SHM_1 / 16); i += NTHR) { const int bi = i / (att::SHM_1 / 16), q = i % (att::SHM_1 / 16);
        *(LAS u32x4*)(F.lds + att::OFF_T + bi * att::TILEB + att::SHM_V + q * 16) = (u32x4){0x38383838u + kz_, 0x38383838u + kz_, 0x38383838u + kz_, 0x38383838u + kz_}; }
#if defined(EXP_EXTRA_MFMA)
    for (int i = F.tid; i < 128; i += NTHR) *(LAS u32x4*)(F.lds + att::OFF_NEG + i * 16) = (u32x4){0xB8B8B8B8u + kz_, 0xB8B8B8B8u + kz_, 0xB8B8B8B8u + kz_, 0xB8B8B8B8u + kz_};
#endif
    __syncthreads();
    const int x = F.bx & 7, jb = F.bx >> 3;
    for (int vb = x; vb < 8; vb += 8) { const int b = vb >> 2, h = vb & 3;
    for (int qb = jb; qb < SEQ / 256; qb += (F.G >> 3)) {
        const long rowbase = (long)b * SEQ + qb * 256 + wid * 32;
        f32x16 o[4]; f32x16 lacc;
#pragma unroll 1
        for (int c = 0; c < 2; ++c) {
            const unsigned char* Qw = Q8 + (rowbase + (lane & 31)) * 512 + h * 128 + c * 64 + (lane >> 5) * 32;
            const unsigned char* Kh = K8 + (long)b * NKEY * 512 + h * 128 + c * 64;
            const unsigned char* Vt = V8T + (long)(b * 4 + h) * 128 * NKEY;
            att::attn_pass(Qw, Kh, Vt, F.lds, o, lacc, F.tid, F.wave);
            int lane_e = lane; asm volatile("" : "+v"(lane_e));
            const int r32 = lane_e & 31, hi = lane_e >> 5;
            asm volatile("s_nop 15\n\ts_nop 15" : "+v"(lacc));
            float rli[16];
#pragma unroll
            for (int r = 0; r < 16; ++r) rli[r] = __builtin_amdgcn_rcpf(lacc[r]);
            if (c == 0) {
#pragma unroll
                for (int r = 0; r < 16; ++r) { const long grow = rowbase + crow(r, hi);
#pragma unroll
                    for (int d0 = 0; d0 < 4; ++d0) O0[grow * 512 + h * 128 + d0 * 32 + r32] = o[d0][r] * rli[r]; }
            } else {
                const float g0 = gn[r32], g1 = gn[32 + r32], g2 = gn[64 + r32], g3 = gn[96 + r32];
                float ov[16][4];
#pragma unroll
                for (int r = 0; r < 16; ++r) { const float* op = O0 + (rowbase + crow(r, hi)) * 512 + h * 128 + r32; ov[r][0] = op[0]; ov[r][1] = op[32]; ov[r][2] = op[64]; ov[r][3] = op[96]; }
                asm volatile("" ::: "memory");
#pragma unroll
                for (int r = 0; r < 16; ++r) { const long grow = rowbase + crow(r, hi);
                    const float v0 = ov[r][0] - lam * (o[0][r] * rli[r]), v1 = ov[r][1] - lam * (o[1][r] * rli[r]), v2 = ov[r][2] - lam * (o[2][r] * rli[r]), v3 = ov[r][3] - lam * (o[3][r] * rli[r]);
                    float ss = (v0 * v0 + v1 * v1) + (v2 * v2 + v3 * v3);
                    ss = half_sum(ss);
                    const float scl = (1.0f - LAM_INIT0) / sqrtf(ss * (1.0f / 128.0f) + LN_EPS);
                    unsigned char* mp = MIX + grow * 1024 + 512 + h * 128 + r32;
                    mp[0] = f2fp8(v0 * scl * g0); mp[32] = f2fp8(v1 * scl * g1); mp[64] = f2fp8(v2 * scl * g2); mp[96] = f2fp8(v3 * scl * g3);
                    if ((r & 3) == 3) asm volatile("" ::: "memory"); }
            }
        }
    } }
}

__device__ __forceinline__ void ph_router(Frame& F, int layer, const float* hin) {
    const float* mod = (const float*)(KWS(F) + WS_MOD) + (size_t)(layer * 3) * 6144;
    const bf16_t* Y = (const bf16_t*)(KWS(F) + WS_Y); float* H1 = (float*)(KWS(F) + WS_H1); unsigned char* U2 = (unsigned char*)(KWS(F) + WS_U2);
    const float* lng = KIN(F, 6) + layer * DM; const float* lnb = KIN(F, 7) + layer * DM;
    const float* rw = KIN(F, 29) + (size_t)layer * DM * NE; const float* rb = KIN(F, 30) + layer * NE;
    unsigned* gcnt = (unsigned*)(KWS(F) + WS_CTL) + CW_CNT + layer * NE;
    unsigned* list = (unsigned*)(KWS(F) + WS_LIST); float* gates = (float*)(KWS(F) + WS_GATES);
    constexpr int RWS = 1028, RSEL = 131584, RVEC = RSEL + 10240;
    LAS float* rwT = (LAS float*)F.lds;
    LAS int* sel_e = (LAS int*)(F.lds + RSEL);
    LAS float* sel_g = (LAS float*)(F.lds + RSEL + 2048);
    LAS unsigned* lcnt = (LAS unsigned*)(F.lds + RSEL + 4096);
    LAS unsigned* lbase = lcnt + 32;
    LAS unsigned* lpos = lcnt + 64;
    LAS float* vG = (LAS float*)(F.lds + RVEC);
    const int lane = F.lane;
    for (int i = F.tid; i < DM * NE; i += NTHR) { const int d = i >> 5, e = i & 31; rwT[e * RWS + d] = rw[i]; }
    __syncthreads();
    for (int blk = F.bx; blk < T / 128; blk += F.G) {
        const int r0 = blk * 128, b = r0 >> 14;
        const float* g1 = mod + b * 6144 + 2048; const float* sh2 = mod + b * 6144 + 3072; const float* sc2 = mod + b * 6144 + 4096;
        if (F.tid < 32) lcnt[F.tid] = 0u;
        for (int i = F.tid; i < DM; i += NTHR) { vG[i] = g1[i]; vG[DM + i] = lng[i]; vG[2 * DM + i] = lnb[i]; vG[3 * DM + i] = sc2[i] + 1.0f; vG[4 * DM + i] = sh2[i]; }
        __syncthreads();
        f32x4 nx[2][4]; u32x2 ny[2][4];
#pragma unroll
        for (int t = 0; t < 2; ++t)
#pragma unroll
            for (int j = 0; j < 4; ++j) { const int d = 4 * lane + 256 * j; const size_t rr = (size_t)(r0 + F.wave * 16 + t); nx[t][j] = *(const f32x4*)(hin + rr * DM + d); ny[t][j] = *(const u32x2*)(Y + rr * DM + d); }
        for (int qq = 0; qq < 8; ++qq) {
            int lane4 = 4 * lane; asm volatile("" : "+v"(lane4));
            const int tl0 = F.wave * 16 + 2 * qq;
            f32x4 pre[2][4]; float s1[2] = {0.f, 0.f}, s2[2] = {0.f, 0.f};
#pragma unroll
            for (int t = 0; t < 2; ++t)
#pragma unroll
                for (int j = 0; j < 4; ++j) { const int d = lane4 + 256 * j; const f32x4 x = nx[t][j]; const u32x2 yw = ny[t][j]; const f32x4 g = *(const LAS f32x4*)(vG + d);
                    f32x4 y; y[0] = __uint_as_float(yw.x << 16); y[1] = __uint_as_float(yw.x & 0xffff0000u); y[2] = __uint_as_float(yw.y << 16); y[3] = __uint_as_float(yw.y & 0xffff0000u);
                    const f32x4 p_ = x * ALPHA + g * y; pre[t][j] = p_; s1[t] += (p_[0] + p_[1]) + (p_[2] + p_[3]); s2[t] += (p_[0] * p_[0] + p_[1] * p_[1]) + (p_[2] * p_[2] + p_[3] * p_[3]); }
            if (qq + 1 < 8) {
#pragma unroll
                for (int t = 0; t < 2; ++t)
#pragma unroll
                    for (int j = 0; j < 4; ++j) { const int d = lane4 + 256 * j; const size_t rr = (size_t)(r0 + tl0 + 2 + t); nx[t][j] = *(const f32x4*)(hin + rr * DM + d); ny[t][j] = *(const u32x2*)(Y + rr * DM + d); } }
            s1[0] = wave_sum(s1[0]); s1[1] = wave_sum(s1[1]); s2[0] = wave_sum(s2[0]); s2[1] = wave_sum(s2[1]);
            f32x4 u2[2][4];
#pragma unroll
            for (int t = 0; t < 2; ++t) { const float mean = s1[t] * (1.0f / DM); const float var = fmaxf(s2[t] * (1.0f / DM) - mean * mean, 0.f); const float rstd = 1.0f / sqrtf(var + LN_EPS); const size_t row = (size_t)(r0 + tl0 + t);
#pragma unroll
                for (int j = 0; j < 4; ++j) { const int d = lane4 + 256 * j; const f32x4 h = (pre[t][j] - mean) * rstd * *(const LAS f32x4*)(vG + DM + d) + *(const LAS f32x4*)(vG + 2 * DM + d);
                    *(f32x4*)(H1 + row * DM + d) = h;
                    u2[t][j] = h * *(const LAS f32x4*)(vG + 3 * DM + d) + *(const LAS f32x4*)(vG + 4 * DM + d);
                    *(unsigned*)(U2 + row * DM + d) = pk4_fp8(u2[t][j][0], u2[t][j][1], u2[t][j][2], u2[t][j][3]); } }
            f32x2 up[4][4];
#pragma unroll
            for (int j = 0; j < 4; ++j)
#pragma unroll
                for (int i = 0; i < 4; ++i) { up[j][i][0] = u2[0][j][i]; up[j][i][1] = u2[1][j][i]; }
            f32x2 P[32];
            f32x4 wc[4], wn[4];
#pragma unroll
            for (int j = 0; j < 4; ++j) wc[j] = *(const LAS f32x4*)(rwT + 4 * lane + 256 * j);
#pragma unroll
            for (int e = 0; e < 32; ++e) {
                if (e + 1 < 32) {
#pragma unroll
                    for (int j = 0; j < 4; ++j) wn[j] = *(const LAS f32x4*)(rwT + (e + 1) * RWS + 4 * lane + 256 * j); }
                f32x2 a0 = {0.f, 0.f}, a1 = {0.f, 0.f};
#pragma unroll
                for (int j = 0; j < 4; ++j) { f32x2 w0 = {wc[j][0], wc[j][0]}, w1 = {wc[j][1], wc[j][1]}, w2 = {wc[j][2], wc[j][2]}, w3 = {wc[j][3], wc[j][3]};
                    a0 = __builtin_elementwise_fma(up[j][0], w0, a0); a1 = __builtin_elementwise_fma(up[j][1], w1, a1); a0 = __builtin_elementwise_fma(up[j][2], w2, a0); a1 = __builtin_elementwise_fma(up[j][3], w3, a1); }
                P[e] = a0 + a1;
#pragma unroll
                for (int j = 0; j < 4; ++j) wc[j] = wn[j];
                if ((e & 3) == 3) __builtin_amdgcn_sched_barrier(0); }
#define RSTEP(N, MASK, CTRL) do { _Pragma("unroll") for (int i = 0; i < (N); ++i) { int lm_ = lane & (MASK); asm volatile("" : "+v"(lm_)); const bool up_ = lm_ != 0;     \
                const f32x2 sv = up_ ? P[i] : P[i + (N)], kv = up_ ? P[i + (N)] : P[i]; f32x2 rv; rv[0] = dpp_f<CTRL>(sv[0]); rv[1] = dpp_f<CTRL>(sv[1]); P[i] = kv + rv; } } while (0)
#define RSWAP(N, SWAPFN) do { _Pragma("unroll") for (int i = 0; i < (N); ++i) { _Pragma("unroll") for (int c_ = 0; c_ < 2; ++c_) { \
                const auto r_ = SWAPFN(__float_as_uint(P[i][c_]), __float_as_uint(P[i + (N)][c_]), false, false); P[i][c_] = __uint_as_float(r_[0]) + __uint_as_float(r_[1]); } } } while (0)
            RSWAP(16, __builtin_amdgcn_permlane32_swap); RSWAP(8, __builtin_amdgcn_permlane16_swap);
#undef RSWAP
            RSTEP(4, 8, 0x140); RSTEP(2, 4, 0x141); RSTEP(1, 2, 0x4E);
#undef RSTEP
            const int me = lane >> 1; const float rbv = rb[me];
            float lgs[2]; lgs[0] = P[0][0] + dpp_f<0xB1>(P[0][0]) + rbv; lgs[1] = P[0][1] + dpp_f<0xB1>(P[0][1]) + rbv;
            LAS float* lgbuf = (LAS float*)(F.lds + RSEL + 8192) + F.wave * 64;
            if ((lane & 1) == 0) { lgbuf[me] = lgs[0]; lgbuf[32 + me] = lgs[1]; }
            asm volatile("s_waitcnt lgkmcnt(0)" ::: "memory");
#pragma unroll
            for (int t = 0; t < 2; ++t) { const float mine = lgs[t]; int rank = 0;
#pragma unroll
                for (int e4 = 0; e4 < 8; ++e4) { const f32x4 v = *(const LAS f32x4*)(lgbuf + 32 * t + 4 * e4);
#pragma unroll
                    for (int i = 0; i < 4; ++i) { const int e = 4 * e4 + i; rank += (v[i] > mine || (v[i] == mine && e < me)) ? 1 : 0; } }
                float ls[4]; int es[4];
#pragma unroll
                for (int k = 0; k < 4; ++k) { const unsigned long long bal = __ballot(rank == k); const int first = __ffsll((long long)bal) - 1; es[k] = first >> 1; ls[k] = lgbuf[32 * t + es[k]]; }
                const float e1 = __expf(ls[1] - ls[0]), e2 = __expf(ls[2] - ls[0]), e3 = __expf(ls[3] - ls[0]); const float inv = 1.0f / (1.0f + e1 + e2 + e3);
                const int tl = tl0 + t;
                if (lane == 0) { sel_e[tl * 4 + 0] = es[0]; sel_e[tl * 4 + 1] = es[1]; sel_e[tl * 4 + 2] = es[2]; sel_e[tl * 4 + 3] = es[3];
                    sel_g[tl * 4 + 0] = inv; sel_g[tl * 4 + 1] = e1 * inv; sel_g[tl * 4 + 2] = e2 * inv; sel_g[tl * 4 + 3] = e3 * inv; } }
        }
        __syncthreads();
        const int myE = sel_e[F.tid];
        lpos[F.tid] = __hip_atomic_fetch_add(&lcnt[myE], 1u, __ATOMIC_RELAXED, __HIP_MEMORY_SCOPE_WORKGROUP);
        __syncthreads();
        if (F.tid < 32) lbase[F.tid] = atomicAdd(&gcnt[F.tid], lcnt[F.tid]);
        __syncthreads();
        { const unsigned slot = (unsigned)(r0 * 4 + F.tid); list[(size_t)myE * CAP + lbase[myE] + lpos[F.tid]] = slot; gates[slot] = sel_g[F.tid]; }
        __syncthreads();
    }
}

struct MoeOrder {
    const LAS int* meta;
    const unsigned* list; int c, G, ncol, rpx;
    __device__ bool next(int i, pg8::Unit& u) const {
        const int x = c & 7, j = c >> 3; const int g = (i * 8 + x) * rpx + j / ncol; const int total = meta[32];
        if (g >= total) return false;
        const int ln_ = (int)__builtin_amdgcn_mbcnt_hi(~0u, __builtin_amdgcn_mbcnt_lo(~0u, 0u)) & 31;
        const int e = __popc((unsigned)__ballot(meta[ln_ + 1] <= g));
        const int rt = g - meta[e], cnt = meta[64 + e];
        u.pm = g; u.pn = e * ncol + (j % ncol); u.a0 = e; u.a1 = rt; u.a2 = min(256, cnt - rt * 256); return true;
    }
    __device__ __forceinline__ unsigned arow(const pg8::Unit& u, int R) const { return (R < u.a2) ? (list[(size_t)u.a0 * CAP + u.a1 * 256 + R] >> 2) : 0u; }
    __device__ __forceinline__ unsigned rowval(const pg8::Unit& u, int R, unsigned v) const { return (R < u.a2) ? (v >> 2) : 0u; }
    __device__ __forceinline__ const unsigned* rows_ptr(const pg8::Unit& u) const { return list + (size_t)u.a0 * CAP + u.a1 * 256; }
};
__device__ __forceinline__ void moe_meta(Frame& F, int layer) {
    LAS int* meta = (LAS int*)(F.lds + META_OFF);
    const unsigned* gcnt = (const unsigned*)(KWS(F) + WS_CTL) + CW_CNT + layer * NE;
    if (F.tid < NE) { const int c = (int)__hip_atomic_load(&gcnt[F.tid], __ATOMIC_RELAXED, __HIP_MEMORY_SCOPE_AGENT); meta[64 + F.tid] = c; meta[96 + F.tid] = (c + 255) >> 8; }
    __syncthreads();
    if (F.tid <= NE) { int acc = 0;
#pragma unroll
        for (int e = 0; e < NE; ++e) { const int t = meta[96 + e]; acc += (e < F.tid) ? t : 0; }
        meta[F.tid] = acc; }
    __syncthreads();
}
struct EpiGU {
    static constexpr bool PERM = true, HAS_PRE = true;
    unsigned char* ACT; const float* bgu;
    __device__ __forceinline__ void pre(LAS unsigned char* dst, const pg8::Unit& u, int wid, int lane) const {
        if (wid == 1) { const int e = u.a0, pnl = u.pn - e * 8; const float* src = bgu + e * 2048 + (lane >> 5) * 1024 + pnl * 128 + (lane & 31) * 4;
            __builtin_amdgcn_global_load_lds((const unsigned*)src, (LAS unsigned*)dst, 16, 0, 0); } }
    __device__ __forceinline__ void operator()(const f32x4 (&acc)[2][2][4][2], const pg8::Unit& u, int wr, int wc, int fr, int fq, const LAS unsigned char* pre_) const {
        const int e = u.a0, pnl = u.pn - e * 8; const int lcol = wc * 32 + 8 * fq, ccol = pnl * 128 + lcol; const int row0 = u.pm * 256 + wr * 64 + fr;
        f32x2 bg[2][2], bl[2][2];
#pragma unroll
        for (int n = 0; n < 2; ++n) { const f32x4 g4 = *(const LAS f32x4*)(pre_ + (lcol + 4 * n) * 4), l4 = *(const LAS f32x4*)(pre_ + 512 + (lcol + 4 * n) * 4);
            bg[n][0] = (f32x2){g4[0], g4[1]}; bg[n][1] = (f32x2){g4[2], g4[3]}; bl[n][0] = (f32x2){l4[0] + 1.0f, l4[1] + 1.0f}; bl[n][1] = (f32x2){l4[2] + 1.0f, l4[3] + 1.0f}; }
        const f32x2 s2 = {1.0f / WGU_SCALE, 1.0f / WGU_SCALE}, c2 = {-1.702f * 1.4426950408889634f, -1.702f * 1.4426950408889634f}, one2 = {1.0f, 1.0f};
#pragma unroll
        for (int ai = 0; ai < 2; ++ai)
#pragma unroll
            for (int m = 0; m < 4; ++m) { unsigned char* rowp = ACT + (size_t)(row0 + ai * 128 + m * 16) * 1024 + ccol; f32x2 o[2][2];
#pragma unroll
                for (int n = 0; n < 2; ++n)
#pragma unroll
                    for (int h = 0; h < 2; ++h) { const f32x4 A4 = acc[ai][0][m][n], L4 = acc[ai][1][m][n];
                        f32x2 gv = __builtin_elementwise_fma((f32x2){A4[2 * h], A4[2 * h + 1]}, s2, bg[n][h]), lv = __builtin_elementwise_fma((f32x2){L4[2 * h], L4[2 * h + 1]}, s2, bl[n][h]);
                        gv[0] = fminf(gv[0], 7.0f); gv[1] = fminf(gv[1], 7.0f);
                        lv[0] = __builtin_amdgcn_fmed3f(lv[0], -6.0f, 8.0f); lv[1] = __builtin_amdgcn_fmed3f(lv[1], -6.0f, 8.0f);
                        const f32x2 t = gv * c2; f32x2 d = {__builtin_amdgcn_exp2f(t[0]), __builtin_amdgcn_exp2f(t[1])}; d = d + one2;
                        const f32x2 r = {__builtin_amdgcn_rcpf(d[0]), __builtin_amdgcn_rcpf(d[1])};
                        o[n][h] = gv * r * lv; }
                u32x2 w; w.x = pk4_fp8(o[0][0][0], o[0][0][1], o[0][1][0], o[0][1][1]); w.y = pk4_fp8(o[1][0][0], o[1][0][1], o[1][1][0], o[1][1][1]);
                *(u32x2*)rowp = w; }
    }
};
struct EpiDown {
    static constexpr bool PERM = true, HAS_PRE = true;
    unsigned char* YB; const float* bd; const unsigned* list;
    __device__ __forceinline__ void pre(LAS unsigned char* dst, const pg8::Unit& u, int wid, int lane) const {
        const int e = u.a0, rt = u.a1, pnl = u.pn - e * 4;
        if (wid == 1) __builtin_amdgcn_global_load_lds((const unsigned*)(bd + e * 1024 + pnl * 256 + lane * 4), (LAS unsigned*)dst, 16, 0, 0);
        if (wid == 2) __builtin_amdgcn_global_load_lds((const unsigned*)(list + (size_t)e * CAP + rt * 256 + lane * 4), (LAS unsigned*)(dst + 1024), 16, 0, 0); }
    __device__ __forceinline__ void operator()(const f32x4 (&acc)[2][2][4][2], const pg8::Unit& u, int wr, int wc, int fr, int fq, const LAS unsigned char* pre_) const {
        const int e = u.a0, pnl = u.pn - e * 4; const int lcol = wc * 32 + 8 * fq, col = pnl * 256 + lcol;
        f32x4 bv[2][2];
#pragma unroll
        for (int bj = 0; bj < 2; ++bj)
#pragma unroll
            for (int n = 0; n < 2; ++n) bv[bj][n] = *(const LAS f32x4*)(pre_ + (lcol + bj * 128 + 4 * n) * 4);
#pragma unroll
        for (int ai = 0; ai < 2; ++ai)
#pragma unroll
            for (int m = 0; m < 4; ++m) { const int R = ai * 128 + wr * 64 + m * 16 + fr; if (R >= u.a2) continue;
                const unsigned slot = *(const LAS unsigned*)(pre_ + 1024 + R * 4); unsigned char* rowp = YB + (size_t)slot * 1024 + col;
#pragma unroll
                for (int bj = 0; bj < 2; ++bj) { const f32x4 v0 = acc[ai][bj][m][0] * (1.0f / WD_SCALE) + bv[bj][0], v1 = acc[ai][bj][m][1] * (1.0f / WD_SCALE) + bv[bj][1];
                    u32x2 w; w.x = pk4_fp8(v0[0], v0[1], v0[2], v0[3]); w.y = pk4_fp8(v1[0], v1[1], v1[2], v1[3]);
                    *(u32x2*)(rowp + bj * 128) = w; } }
    }
};

__device__ __forceinline__ void ph_combine(Frame& F, int layer, float* hout, bool next_mod) {
    const float* mod = (const float*)(KWS(F) + WS_MOD) + (size_t)(layer * 3) * 6144;
    const float* modn = (const float*)(KWS(F) + WS_MOD) + (size_t)3 * 6144;
    const float* H1 = (const float*)(KWS(F) + WS_H1); const unsigned char* YB = (const unsigned char*)(KWS(F) + WS_YB); const float* gates = (const float*)(KWS(F) + WS_GATES);
    const float* lng = KIN(F, 8) + layer * DM; const float* lnb = KIN(F, 9) + layer * DM; bf16_t* U = (bf16_t*)(KWS(F) + WS_U);
    const int gw = F.bx * NWAVES + F.wave, NGW = F.G * NWAVES, lane = F.lane;
    LAS float* vC = (LAS float*)F.lds;
    for (int i = F.tid; i < 2 * DM; i += NTHR) { const int b = i >> 10, d = i & (DM - 1); LAS float* v = vC + b * 5 * DM + d;
        v[0] = mod[b * 6144 + 5120 + d]; v[DM] = lng[d]; v[2 * DM] = lnb[d]; v[3 * DM] = modn[b * 6144 + 1024 + d] + 1.0f; v[4 * DM] = modn[b * 6144 + d]; }
    __syncthreads();
    f32x4 nh[4]; unsigned nyb[4][4]; f32x4 ngt;
#define CMB_LOAD(r_) do { _Pragma("unroll") for (int j = 0; j < 4; ++j) { const int d = 4 * lane + 256 * j; nh[j] = *(const f32x4*)(H1 + (size_t)(r_) * DM + d); \
        _Pragma("unroll") for (int k = 0; k < 4; ++k) nyb[j][k] = *(const unsigned*)(YB + ((size_t)(r_) * 4 + k) * DM + d); } ngt = *(const f32x4*)(gates + (size_t)(r_) * 4); } while (0)
    if (gw < T) CMB_LOAD(gw);
    for (int row = gw; row < T; row += NGW) {
        int vb = (row >> 14) * 5 * DM + 4 * lane; asm volatile("" : "+v"(vb));
        const LAS float* vr = vC + vb;
        f32x4 ch[4]; unsigned cyb[4][4]; const f32x4 gt = ngt;
#pragma unroll
        for (int j = 0; j < 4; ++j) { ch[j] = nh[j];
#pragma unroll
            for (int k = 0; k < 4; ++k) cyb[j][k] = nyb[j][k]; }
        if (row + NGW < T) CMB_LOAD(row + NGW);
        f32x4 pre[4]; float s = 0.f;
#pragma unroll
        for (int j = 0; j < 4; ++j) { f32x4 y = {0.f, 0.f, 0.f, 0.f};
#pragma unroll
            for (int k = 0; k < 4; ++k) { const unsigned yw = cyb[j][k]; const f32x2 lo = __builtin_amdgcn_cvt_pk_f32_fp8((int)yw, false), hi2 = __builtin_amdgcn_cvt_pk_f32_fp8((int)yw, true);
                const f32x4 v = {lo[0], lo[1], hi2[0], hi2[1]};
                y += v * gt[k]; }
            pre[j] = ch[j] * ALPHA + *(const LAS f32x4*)(vr + 256 * j) * y; s += (pre[j][0] + pre[j][1]) + (pre[j][2] + pre[j][3]); }
        const float mean = wave_sum(s) * (1.0f / DM); float q2 = 0.f;
#pragma unroll
        for (int j = 0; j < 4; ++j) { pre[j] = pre[j] - mean; q2 += (pre[j][0] * pre[j][0] + pre[j][1] * pre[j][1]) + (pre[j][2] * pre[j][2] + pre[j][3] * pre[j][3]); }
        const float rstd = 1.0f / sqrtf(wave_sum(q2) * (1.0f / DM) + LN_EPS);
#pragma unroll
        for (int j = 0; j < 4; ++j) { const int d = 4 * lane + 256 * j; const f32x4 h = pre[j] * rstd * *(const LAS f32x4*)(vr + DM + 256 * j) + *(const LAS f32x4*)(vr + 2 * DM + 256 * j);
            *(f32x4*)(hout + (size_t)row * DM + d) = h;
            if (next_mod) { const f32x4 v = h * *(const LAS f32x4*)(vr + 3 * DM + 256 * j) + *(const LAS f32x4*)(vr + 4 * DM + 256 * j);
                u32x2 w; w.x = pk2(v[0], v[1]); w.y = pk2(v[2], v[3]); *(u32x2*)(U + (size_t)row * DM + d) = w; } }
    }
#undef CMB_LOAD
}

__device__ __forceinline__ void ph_gmlp(Frame& F) {
    const bf16_t* Z = (const bf16_t*)(KWS(F) + WS_ZODD); unsigned char* MIX = (unsigned char*)(KWS(F) + WS_MIX);
    const float* lg = KIN(F, 23); const float* lb = KIN(F, 24); const float* bs = KIN(F, 26); const bf16_t* wsb = (const bf16_t*)(KWS(F) + WS_TAB + TB_WS);
    const int lane = F.lane, r32 = lane & 31, hi = lane >> 5, wid = F.wave;
    for (int chunk = F.bx; chunk < T / 128; chunk += F.G) {
        const int r0 = chunk * 128;
        for (int qq = 0; qq < 16; ++qq) { const int q = wid * 16 + qq; const bf16x8 raw = *(const bf16x8*)(Z + (size_t)(r0 + q) * 1536 + 512 + 8 * lane);
            float v[8]; float s = 0.f;
#pragma unroll
            for (int j = 0; j < 8; ++j) { v[j] = bf2f((unsigned short)raw[j]); s += v[j]; }
            const float mean = wave_sum(s) * (1.0f / 512.0f); float q2 = 0.f;
#pragma unroll
            for (int j = 0; j < 8; ++j) { v[j] -= mean; q2 += v[j] * v[j]; }
            const float rstd = 1.0f / sqrtf(wave_sum(q2) * (1.0f / 512.0f) + LN_EPS);
            const f32x4 g0 = *(const f32x4*)(lg + 8 * lane), g1 = *(const f32x4*)(lg + 8 * lane + 4), b0 = *(const f32x4*)(lb + 8 * lane), b1 = *(const f32x4*)(lb + 8 * lane + 4);
            u32x4 w; w.x = pk2(v[0] * rstd * g0[0] + b0[0], v[1] * rstd * g0[1] + b0[1]); w.y = pk2(v[2] * rstd * g0[2] + b0[2], v[3] * rstd * g0[3] + b0[3]);
            w.z = pk2(v[4] * rstd * g1[0] + b1[0], v[5] * rstd * g1[1] + b1[1]); w.w = pk2(v[6] * rstd * g1[2] + b1[2], v[7] * rstd * g1[3] + b1[3]);
            const int ch = 8 * lane, g = ch >> 7, col = ch & 127, kt = (q >> 6) * 4 + g;
            *(LAS u32x4*)(F.lds + kt * 16384 + v_st(q & 63, col)) = w; }
        __syncthreads();
        const int pb = wid & 3, gh = wid >> 2;
#pragma unroll 1
        for (int gi = 0; gi < 2; ++gi) { const int g = 2 * gh + gi;
            unsigned wofs = (unsigned)(((g * 128 + 32 * pb + r32) * 128 + 8 * hi) * 2); asm volatile("" : "+v"(wofs));
            f32x16 acc[4];
#pragma unroll
            for (int d0 = 0; d0 < 4; ++d0) acc[d0] = f32x16{};
            bf16x8 af[8];
#pragma unroll
            for (int ks = 0; ks < 8; ++ks) af[ks] = *(const bf16x8*)((const char*)wsb + wofs + 32 * ks);
#pragma unroll
            for (int ks = 0; ks < 8; ++ks) {
                LAS unsigned char* trd = F.lds + ((ks >> 2) * 4 + g) * 16384 + v_rd_base(lane);
#pragma unroll
                for (int d0 = 0; d0 < 4; ++d0) acc[d0] = __builtin_amdgcn_mfma_f32_32x32x16_bf16(af[ks], vfrag(trd, d0, ks & 3), acc[d0], 0, 0, 0); }
            unsigned short uraw[16][4]; float bias[16];
#pragma unroll
            for (int r = 0; r < 16; ++r) { const int p = 32 * pb + crow(r, hi); bias[r] = bs[g * 128 + p];
#pragma unroll
                for (int d0 = 0; d0 < 4; ++d0) uraw[r][d0] = Z[(size_t)(r0 + p) * 1536 + g * 128 + d0 * 32 + r32]; }
            asm volatile("" ::: "memory");
#pragma unroll
            for (int r = 0; r < 16; ++r) { const int p = 32 * pb + crow(r, hi);
#pragma unroll
                for (int d0 = 0; d0 < 4; ++d0) { const int ch = g * 128 + d0 * 32 + r32;
                    MIX[(size_t)(r0 + p) * 1024 + ch] = f2fp8(bf2f(uraw[r][d0]) * (acc[d0][r] + bias[r])); } }
        }
        __syncthreads();
    }
}

__device__ __forceinline__ void ph_fourier1(Frame& F) {
    const bf16_t* Z = (const bf16_t*)(KWS(F) + WS_ZODD); bf16_t* WT = (bf16_t*)(KWS(F) + WS_WT);
    const float* lg = KIN(F, 27); const float* lb = KIN(F, 28);
    const bf16x8* CSf = (const bf16x8*)(KWS(F) + WS_TAB + TB_CS); const bf16x8* AFf = (const bf16x8*)(KWS(F) + WS_TAB + TB_AF); const f32x2* tw = (const f32x2*)(KWS(F) + WS_TAB + TB_TW);
    const int lane = F.lane, r32 = lane & 31, hi = lane >> 5, wid = F.wave;
    for (int unit = F.bx; unit < NB * 128; unit += F.G) {
        const int b = unit >> 7, t2 = unit & 127;
#pragma unroll 1
        for (int g = 0; g < 4; ++g) {
            {
                int lane_g = lane; asm volatile("" : "+v"(lane_g)); const int r32 = lane_g & 31, hi = lane_g >> 5;
                const int tb = wid & 3, part = wid >> 2; int t1 = 32 * tb + r32; asm volatile("" : "+v"(t1)); const size_t row = (size_t)b * SEQ + 128 * t1 + t2;
                bf16x8 raw[8]; float s = 0.f;
#pragma unroll
                for (int ks = 0; ks < 8; ++ks) { raw[ks] = *(const bf16x8*)(Z + row * 1536 + 1024 + g * 128 + 16 * ks + 8 * hi);
#pragma unroll
                    for (int j = 0; j < 8; ++j) s += bf2f((unsigned short)raw[ks][j]); }
                s = xhalf_sum(s); const float mean = s * (1.0f / 128.0f); float q2 = 0.f;
#pragma unroll
                for (int ks = 0; ks < 8; ++ks)
#pragma unroll
                    for (int j = 0; j < 8; ++j) { const float d = bf2f((unsigned short)raw[ks][j]) - mean; q2 += d * d; }
                q2 = xhalf_sum(q2); const float rstd = 1.0f / sqrtf(q2 * (1.0f / 128.0f) + LN_EPS);
                bf16x8 af[8];
#pragma unroll
                for (int ks = 0; ks < 8; ++ks) { const int c0 = g * 128 + 16 * ks + 8 * hi; const f32x4 g0 = *(const f32x4*)(lg + c0), g1 = *(const f32x4*)(lg + c0 + 4), b0 = *(const f32x4*)(lb + c0), b1 = *(const f32x4*)(lb + c0 + 4);
                    float x[8];
#pragma unroll
                    for (int j = 0; j < 8; ++j) x[j] = (bf2f((unsigned short)raw[ks][j]) - mean) * rstd;
                    u32x4 w; w.x = pk2(x[0] * g0[0] + b0[0], x[1] * g0[1] + b0[1]); w.y = pk2(x[2] * g0[2] + b0[2], x[3] * g0[3] + b0[3]);
                    w.z = pk2(x[4] * g1[0] + b1[0], x[5] * g1[1] + b1[1]); w.w = pk2(x[6] * g1[2] + b1[2], x[7] * g1[3] + b1[3]);
                    af[ks] = __builtin_bit_cast(bf16x8, w); }
                f32x16 acc[4];
#pragma unroll
                for (int d0 = 0; d0 < 4; ++d0) acc[d0] = f32x16{};
#pragma unroll
                for (int ks = 0; ks < 8; ++ks) { unsigned fo = (unsigned)(((4 * part) * 8 + ks) * 64 + lane) * 16u; asm volatile("" : "+v"(fo));
#pragma unroll
                    for (int d0 = 0; d0 < 4; ++d0) acc[d0] = __builtin_amdgcn_mfma_f32_32x32x16_bf16(af[ks], *(const bf16x8*)((const char*)CSf + fo + d0 * 8192), acc[d0], 0, 0, 0); }
                int ybase = (part * 2 + (tb >> 1)) * 16384 + (tb & 1) * 8192 + hi * 2048 + r32 * 2; asm volatile("" : "+v"(ybase));
#pragma unroll
                for (int r = 0; r < 16; ++r)
#pragma unroll
                    for (int d0 = 0; d0 < 4; ++d0) *(LAS bf16_t*)(F.lds + ybase + ((r >> 3) & 1) * 4096 + d0 * 512 + ((r & 3) + 4 * ((r >> 2) & 1)) * 64) = (bf16_t)f2bf(acc[d0][r]);
            }
            __syncthreads();
            {
                const int kb = wid & 3, ch2 = wid >> 2;
                f32x16 aR[2], aI[2];
#pragma unroll
                for (int dd = 0; dd < 2; ++dd) { aR[dd] = f32x16{}; aI[dd] = f32x16{}; }
#pragma unroll
                for (int kh = 0; kh < 4; ++kh) {
                    unsigned fo = (unsigned)((kb * 16 + kh * 4) * 64 + lane) * 16u; asm volatile("" : "+v"(fo));
                    bf16x8 fr8[4], fi8[4];
#pragma unroll
                    for (int k8 = 0; k8 < 4; ++k8) { fr8[k8] = *(const bf16x8*)((const char*)AFf + fo + k8 * 1024); fi8[k8] = *(const bf16x8*)((const char*)AFf + fo + k8 * 1024 + 65536); }
#pragma unroll
                    for (int k8 = 0; k8 < 4; ++k8) { const int ks = kh * 4 + k8;
                        LAS unsigned char* trd = F.lds + (ks >> 2) * 16384 + v_rd_base(lane);
#pragma unroll
                        for (int dd = 0; dd < 2; ++dd) { const bf16x8 bf = vfrag(trd, 2 * ch2 + dd, ks & 3);
                            aR[dd] = __builtin_amdgcn_mfma_f32_32x32x16_bf16(fr8[k8], bf, aR[dd], 0, 0, 0); aI[dd] = __builtin_amdgcn_mfma_f32_32x32x16_bf16(fi8[k8], bf, aI[dd], 0, 0, 0); } }
                }
                int k1b = 32 * kb + 4 * hi; asm volatile("" : "+v"(k1b));
                f32x2 csv[16];
#pragma unroll
                for (int r = 0; r < 16; ++r) csv[r] = tw[t2 * 128 + k1b + (r & 3) + 8 * (r >> 2)];
                asm volatile("" ::: "memory");
#pragma unroll
                for (int r = 0; r < 16; ++r) { const int k1 = k1b + (r & 3) + 8 * (r >> 2); const f32x2 cs = csv[r];
                    bf16_t* dst = WT + ((((size_t)b * 128 + k1) * 128 + t2) * 4 + g) * 256;
#pragma unroll
                    for (int dd = 0; dd < 2; ++dd) { const float wr_ = aR[dd][r], wi_ = aI[dd][r]; const int j = 32 * (2 * ch2 + dd) + r32;
                        dst[j] = (bf16_t)f2bf(wr_ * cs[0] + wi_ * cs[1]); dst[128 + j] = (bf16_t)f2bf(wi_ * cs[0] - wr_ * cs[1]); }
                    if ((r & 3) == 3) asm volatile("" ::: "memory"); }
            }
            __syncthreads();
        }
    }
}
__device__ __forceinline__ void ph_fourier2(Frame& F) {
    const bf16_t* WT = (const bf16_t*)(KWS(F) + WS_WT); unsigned char* MIX = (unsigned char*)(KWS(F) + WS_MIX);
    const bf16x8* A3f = (const bf16x8*)(KWS(F) + WS_TAB + TB_A3);
    const int lane = F.lane, r32 = lane & 31, hi = lane >> 5, wid = F.wave;
    for (int unit = F.bx; unit < NB * 128; unit += F.G) {
        const int b = unit >> 7, k1 = unit & 127;
#pragma unroll 1
        for (int g = 0; g < 4; ++g) {
            for (int idx = F.tid; idx < 4096; idx += NTHR) { const int t2 = idx >> 5, c = idx & 31, part = c >> 4, j0 = (c & 15) * 8;
                const u32x4 v = *(const u32x4*)(WT + ((((size_t)b * 128 + k1) * 128 + t2) * 4 + g) * 256 + part * 128 + j0);
                *(LAS u32x4*)(F.lds + (part * 2 + (t2 >> 6)) * 16384 + v_st(t2 & 63, j0)) = v; }
            __syncthreads();
            const int mb = wid & 3, ch2 = wid >> 2;
            f32x16 acc[2] = {f32x16{}, f32x16{}};
#pragma unroll
            for (int ks = 0; ks < 16; ++ks) { unsigned fo = (unsigned)((mb * 16 + ks) * 64 + lane) * 16u; asm volatile("" : "+v"(fo)); const bf16x8 af = *(const bf16x8*)((const char*)A3f + fo);
                LAS unsigned char* trd = F.lds + (ks >> 2) * 16384 + v_rd_base(lane);
#pragma unroll
                for (int dd = 0; dd < 2; ++dd) acc[dd] = __builtin_amdgcn_mfma_f32_32x32x16_bf16(af, vfrag(trd, 2 * ch2 + dd, ks & 3), acc[dd], 0, 0, 0); }
#pragma unroll
            for (int r = 0; r < 16; ++r) { const int k2 = 32 * mb + crow(r, hi); const size_t row = (size_t)b * SEQ + k1 + 128 * k2;
#pragma unroll
                for (int dd = 0; dd < 2; ++dd) MIX[row * 1024 + 512 + g * 128 + 32 * (2 * ch2 + dd) + r32] = f2fp8(acc[dd][r]); }
            __syncthreads();
        }
    }
}

#ifndef MK_ONE_LAUNCH
#define MK_ONE_LAUNCH 1
#endif
constexpr int NPH = 18;
#ifndef PHMASK
#define PHMASK 0x3FFFF
#endif
#define HAS(k) (((PHMASK) >> (k)) & 1)
__global__ void __launch_bounds__(NTHR, 2) fwd_kernel(Args args) {
    extern __shared__ __attribute__((aligned(16))) unsigned char lds_raw[];
    Frame F;
    F.lds = (LAS unsigned char*)lds_raw; F.tid = threadIdx.x; F.lane = F.tid & 63; F.wave = __builtin_amdgcn_readfirstlane(F.tid >> 6); F.G = gridDim.x; F.bx = blockIdx.x;
    F.kz = 0;
    volatile LAS unsigned* MISC = (volatile LAS unsigned*)(F.lds + MISC_OFF);
    if (F.tid < 64) MISC[F.tid] = 0u;
    __syncthreads();
    if (MK_ONE_LAUNCH) (void)xcd_barrier_post((unsigned*)(args.ws + WS_CTL) + CW_BAR, MISC + 8);
    const int lo = args.ph_lo, hi = args.ph_hi;
#define IN(k) (lo <= (k) && (k) < hi)
#ifndef REPMASK
#define REPMASK 0
#endif
#define REP(k) (((REPMASK) >> (k)) & 1)
#define BARNOW() do { ENTER(); XcdBarrier bar_; bar_.bar = (unsigned*)(KWS(F) + WS_CTL) + CW_BAR; bar_.x = xb_xcc_id(); bar_.st = (volatile LAS unsigned*)(F.lds + MISC_OFF) + 8; xcd_barrier(bar_); } while (0)
#ifndef DIAG_PH
#define DIAG_PH -1
#endif
    int nstamp = 0;
#define STAMP() do { if (DIAG_PH >= 0) { if (F.tid == 0) ((volatile LAS unsigned*)(F.lds + MISC_OFF))[16 + nstamp] = (unsigned)__builtin_amdgcn_s_memrealtime(); ++nstamp; } } while (0)
    STAMP();
#define ENTER() do { asm volatile("" : "+s"(F.kz), "+s"(F.wave), "+s"(F.G), "+s"(F.bx), "+v"(F.tid), "+v"(F.lane)); F.kz = __builtin_amdgcn_readfirstlane(F.kz); F.wave = __builtin_amdgcn_readfirstlane(F.wave); \
    F.G = __builtin_amdgcn_readfirstlane(F.G); F.bx = __builtin_amdgcn_readfirstlane(F.bx); } while (0)
#define SEAM(k) do { if (IN(k) && IN((k) + 1)) { if (MK_ONE_LAUNCH) { ENTER(); XcdBarrier bar_; bar_.bar = (unsigned*)(KWS(F) + WS_CTL) + CW_BAR; bar_.x = xb_xcc_id(); bar_.st = (volatile LAS unsigned*)(F.lds + MISC_OFF) + 8; xcd_barrier(bar_); STAMP(); } } } while (0)

    if (HAS(0) && IN(0)) { ENTER(); for (int rep_ = 0; rep_ <= REP(0); ++rep_) { if (rep_) BARNOW(); ph0_mod_tables(F); } } SEAM(0);
    if (HAS(1) && IN(1)) { ENTER(); for (int rep_ = 0; rep_ <= REP(1); ++rep_) { if (rep_) BARNOW(); ph1_convert(F); } } SEAM(1);
    if (HAS(2) && IN(2)) { ENTER(); for (int rep_ = 0; rep_ <= REP(2); ++rep_) { if (rep_) BARNOW(); ph2_modulate(F); } } SEAM(2);

    for (int layer = 0; layer < 2; ++layer) {
        const int pb = layer == 0 ? 5 : 13;
        if (layer == 0) {
            if (HAS(3) && IN(3)) { ENTER(); for (int rep_ = 0; rep_ <= REP(3); ++rep_) { if (rep_) BARNOW();
                pg8::Gemm g{(const bf16_t*)(KWS(F) + WS_U), (const bf16_t*)(KWS(F) + WS_WEVIN), T, 2560, DM};
                EvInOrder S; S.so.init(T, 2560, F.G, F.bx);
                EpiEvIn E{(unsigned char*)(KWS(F) + WS_Q), (unsigned char*)(KWS(F) + WS_K), (unsigned char*)(KWS(F) + WS_V), (bf16_t*)(KWS(F) + WS_AB), (const float*)(KWS(F) + WS_TAB + TB_COS), (const float*)(KWS(F) + WS_TAB + TB_SIN)};
                pg8::gemm_phase<EpiEvIn, EvInOrder, true, false>(F.lds, g, S, E, F.tid);
            } } SEAM(3);
            if (HAS(4) && IN(4)) { ENTER(); for (int rep_ = 0; rep_ <= REP(4); ++rep_) { if (rep_) BARNOW(); ph4_conv(F); ph4_attention(F); } } SEAM(4);
        } else {
            if (HAS(10) && IN(10)) { ENTER(); for (int rep_ = 0; rep_ <= REP(10); ++rep_) { if (rep_) BARNOW();
                pg8::Gemm g{(const bf16_t*)(KWS(F) + WS_U), (const bf16_t*)(KWS(F) + WS_WODIN), T, 1536, DM};
                pg8::StaticOrder S; S.init(T, 1536, F.G, F.bx);
                pg8::EpiBf16 E{(bf16_t*)(KWS(F) + WS_ZODD), 1536, 4, 1.0f};
                pg8::gemm_phase<pg8::EpiBf16, pg8::StaticOrder, true, false>(F.lds, g, S, E, F.tid);
            } } SEAM(10);
            if (HAS(11) && IN(11)) { ENTER(); for (int rep_ = 0; rep_ <= REP(11); ++rep_) { if (rep_) BARNOW(); ph_gmlp(F); ph_fourier1(F); } } SEAM(11);
            if (HAS(12) && IN(12)) { ENTER(); for (int rep_ = 0; rep_ <= REP(12); ++rep_) { if (rep_) BARNOW(); ph_fourier2(F); } } SEAM(12);
        }
        if (HAS(5) && IN(pb)) { ENTER(); for (int rep_ = 0; rep_ <= REP(5); ++rep_) { if (rep_) BARNOW();
            pg8::Gemm g{(const bf16_t*)(KWS(F) + WS_MIX), (const bf16_t*)(KWS(F) + (layer == 0 ? WS_WEVOUT : WS_WODOUT)), T, DM, DM / 2};
            pg8::StaticOrder S; S.init(T, DM, F.G, F.bx);
            pg8::EpiBf16 E{(bf16_t*)(KWS(F) + WS_Y), DM, 0, 1.0f / WO_SCALE};
            pg8::gemm_phase<pg8::EpiBf16, pg8::StaticOrder, true, false, true>(F.lds, g, S, E, F.tid);
        } } SEAM(pb);
        if (HAS(6) && IN(pb + 1)) { ENTER(); for (int rep_ = 0; rep_ <= REP(6); ++rep_) { if (rep_) BARNOW(); ph_router(F, layer, layer == 0 ? KIN(F, 0) : (const float*)(KWS(F) + WS_H2)); } } SEAM(pb + 1);
        if (HAS(7) && IN(pb + 2)) { ENTER(); for (int rep_ = 0; rep_ <= REP(7); ++rep_) { if (rep_) BARNOW();
            moe_meta(F, layer);
            pg8::Gemm g{(const bf16_t*)(KWS(F) + WS_U2), (const bf16_t*)(KWS(F) + WS_WGU + (size_t)layer * NE * 2048 * DM), 0, 0, DM / 2};
            MoeOrder S{(const LAS int*)(F.lds + META_OFF), (const unsigned*)(KWS(F) + WS_LIST), F.bx, F.G, 8, 4};
            EpiGU E{(unsigned char*)(KWS(F) + WS_ACT), KIN(F, 32) + (size_t)layer * NE * 2048};
            pg8::gemm_phase<EpiGU, MoeOrder, true, true, true>(F.lds, g, S, E, F.tid);
        } } SEAM(pb + 2);
        if (HAS(8) && IN(pb + 3)) { ENTER(); for (int rep_ = 0; rep_ <= REP(8); ++rep_) { if (rep_) BARNOW();
            moe_meta(F, layer);
            pg8::Gemm g{(const bf16_t*)(KWS(F) + WS_ACT), (const bf16_t*)(KWS(F) + WS_WD + (size_t)layer * NE * 1024 * DM), 0, 0, DM / 2};
            MoeOrder S{(const LAS int*)(F.lds + META_OFF), (const unsigned*)(KWS(F) + WS_LIST), F.bx, F.G, 4, 8};
            EpiDown E{(unsigned char*)(KWS(F) + WS_YB), KIN(F, 34) + (size_t)layer * NE * 1024, (const unsigned*)(KWS(F) + WS_LIST)};
            pg8::gemm_phase<EpiDown, MoeOrder, true, false, true>(F.lds, g, S, E, F.tid);
        } } SEAM(pb + 3);
        if (HAS(9) && IN(pb + 4)) { ENTER(); for (int rep_ = 0; rep_ <= REP(9); ++rep_) { if (rep_) BARNOW(); ph_combine(F, layer, layer == 0 ? (float*)(KWS(F) + WS_H2) : KOUT(F), layer == 0); } }
        if (layer == 0) SEAM(pb + 4);
    }
    if (DIAG_PH >= 0) {
        ENTER(); XcdBarrier bar_; bar_.bar = (unsigned*)(KWS(F) + WS_CTL) + CW_BAR; bar_.x = xb_xcc_id(); bar_.st = (volatile LAS unsigned*)(F.lds + MISC_OFF) + 8; xcd_barrier(bar_); STAMP();
        __syncthreads();
        volatile LAS unsigned* st = (volatile LAS unsigned*)(F.lds + MISC_OFF) + 16;
        const unsigned d = st[DIAG_PH + 1] - st[DIAG_PH];
        const float c = sqrtf((float)d * 0.01f);
        float* o = KOUT(F);
        for (size_t i = (size_t)F.bx * NTHR + F.tid; i < (size_t)T * DM; i += (size_t)F.G * NTHR) o[i] = c;
    }
#undef IN
#undef SEAM
}

extern "C" void kernel_launch(void* const* d_in, const int* in_sizes, int n_in, void* d_out, int out_size, void* d_ws, size_t ws_size, hipStream_t stream) {
    static int grid = 0;
    if (grid == 0) {
        if (n_in != 35 || out_size != T * DM || ws_size < WS_END) { fprintf(stderr, "kernel_launch: unexpected shapes: n_in %d out %d ws %zu (need %zu)\n", n_in, out_size, ws_size, (size_t)WS_END); grid = -1; return; }
        int dev = 0, cus = 0;
        if (hipGetDevice(&dev) != hipSuccess || hipDeviceGetAttribute(&cus, hipDeviceAttributeMultiprocessorCount, dev) != hipSuccess) { grid = -1; return; }
        if (hipFuncSetAttribute((const void*)fwd_kernel, hipFuncAttributeMaxDynamicSharedMemorySize, LDS_BYTES) != hipSuccess) { fprintf(stderr, "kernel_launch: hipFuncSetAttribute failed\n"); grid = -1; return; }
        int per_cu = 0; (void)hipOccupancyMaxActiveBlocksPerMultiprocessor(&per_cu, (const void*)fwd_kernel, NTHR, LDS_BYTES); (void)hipGetLastError();
        if (per_cu < 1) fprintf(stderr, "kernel_launch: occupancy query reports %d blocks per CU\n", per_cu);
        grid = cus > 256 ? 256 : cus;
        if (grid != 256) fprintf(stderr, "kernel_launch: %d CUs; this kernel is laid out for 256\n", cus);
    }
    if (grid < 0) return;
    (void)hipMemsetAsync((char*)d_ws + WS_CTL, 0, CTL_ZERO_BYTES, stream);
    Args a{};
    for (int i = 0; i < 35; ++i) a.in[i] = (const float*)d_in[i];
    a.out = (float*)d_out; a.ws = (unsigned char*)d_ws;
#if MK_ONE_LAUNCH
    a.ph_lo = 0; a.ph_hi = NPH;
    hipLaunchKernelGGL(fwd_kernel, dim3(grid), dim3(NTHR), LDS_BYTES, stream, a);
#else
    for (int p = 0; p < NPH; ++p) { a.ph_lo = p; a.ph_hi = p + 1; hipLaunchKernelGGL(fwd_kernel, dim3(grid), dim3(NTHR), LDS_BYTES, stream, a); }
#endif
    const hipError_t le = hipPeekAtLastError();
    if (le != hipSuccess) fprintf(stderr, "kernel_launch: launch failed: %s\n", hipGetErrorName(le));
}
```

```cpp
#include <hip/hip_runtime.h>
#include <cstdio>
#include <cstdint>

#define LAS __attribute__((address_space(3)))
#define GAS __attribute__((address_space(1)))
typedef unsigned short bf16_t;
typedef short bf16x8 __attribute__((ext_vector_type(8)));
typedef short s16x4 __attribute__((ext_vector_type(4)));
typedef float f32x4 __attribute__((ext_vector_type(4)));
typedef float f32x2 __attribute__((ext_vector_type(2)));
typedef float f32x16 __attribute__((ext_vector_type(16)));
typedef unsigned u32x4 __attribute__((ext_vector_type(4)));
typedef unsigned u32x2 __attribute__((ext_vector_type(2)));

namespace pg8 {
constexpr int BM = 256, BK = 64, HALF = 128, HTB = HALF * BK * 2, STAGE_BYTES = 8 * HTB, NXCD = 8, WGM = 8;
__host__ __device__ __forceinline__ int lds_byte(int r, int c) { const int st = (r >> 4) * 2 + (c >> 5), rr = r & 15, cc = c & 31, ob = rr * 64 + cc * 2; return st * 1024 + (ob ^ (((ob >> 9) & 1) << 5)); }
__host__ __device__ __forceinline__ void stage_rc(int b, int& R, int& C) { const int st = b / 1024, sb = b % 1024, swz = sb ^ (((sb >> 9) & 1) << 5); R = (st >> 1) * 16 + swz / 64; C = (st & 1) * 32 + (swz % 64) / 2; }
__host__ __device__ __forceinline__ int perm32(int rho) { const int n = rho >> 4, i = rho & 15; return 8 * (i >> 2) + 4 * n + (i & 3); }

struct Unit { int pm, pn, a0, a1, a2; };
struct Gemm { const bf16_t* A; const bf16_t* Bt; int M, N, K; };

constexpr int PRE_ROWS = 131072 + 1024, PRE_EPI = PRE_ROWS + 2048;
struct StaticOrder {
    int nM, nN, nwg, G, c;
    __device__ void init(int M, int N, int G_, int c_) { nM = M / BM; nN = N / BM; nwg = nM * nN; G = G_; c = c_; }
    __device__ bool map(long L, Unit& u) const {
        if (L >= nwg) return false;
        int wgid = (int)L; { const int q = nwg / NXCD, r = nwg % NXCD, xcd = wgid % NXCD, off = wgid / NXCD; wgid = (xcd < r ? xcd * (q + 1) : r * (q + 1) + (xcd - r) * q) + off; }
        const int nig = WGM * nN, gid = wgid / nig, fm = gid * WGM, gsz = (nM - fm) < WGM ? (nM - fm) : WGM;
        u.pm = fm + ((wgid % nig) % gsz); u.pn = (wgid % nig) / gsz; u.a0 = 0; u.a1 = 0; u.a2 = 256; return true;
    }
    __device__ bool next(int i, Unit& u) const { return map((long)i * G + c, u); }
    __device__ __forceinline__ unsigned arow(const Unit&, int) const { return 0u; }
    __device__ __forceinline__ unsigned rowval(const Unit&, int, unsigned) const { return 0u; }
    __device__ __forceinline__ const unsigned* rows_ptr(const Unit&) const { return nullptr; }
};

__device__ __forceinline__ unsigned cvt_pk_bf16(float lo, float hi) { unsigned r; asm volatile("v_cvt_pk_bf16_f32 %0, %1, %2" : "=v"(r) : "v"(lo), "v"(hi)); return r; }

__device__ __forceinline__ float gelu_tanh(float x) {
    const float t = x * (1.0f + 0.044715f * x * x) * (2.0f * 0.7978845608028654f * 1.4426950408889634f);
    return x * __builtin_amdgcn_rcpf(1.0f + __builtin_amdgcn_exp2f(-t));
}

struct EpiBf16 {
    static constexpr bool PERM = true, HAS_PRE = false;
    bf16_t* O; int ldc; int gelu_pn; float scale;
    __device__ __forceinline__ void operator()(const f32x4 (&acc)[2][2][4][2], const Unit& u, int wr, int wc, int fr, int fq) const {
        const int row0 = u.pm * BM + wr * 64 + fr; const int col0 = u.pn * BM + wc * 32 + 8 * fq;
        const bool act = u.pn < gelu_pn;
#pragma unroll
        for (int ai = 0; ai < 2; ++ai)
#pragma unroll
            for (int m = 0; m < 4; ++m) { bf16_t* rowp = O + (size_t)(row0 + ai * HALF + m * 16) * ldc + col0;
#pragma unroll
                for (int bj = 0; bj < 2; ++bj) { f32x4 v0 = acc[ai][bj][m][0] * scale, v1 = acc[ai][bj][m][1] * scale;
                    if (act) {
#pragma unroll
                        for (int j = 0; j < 4; ++j) { v0[j] = gelu_tanh(v0[j]); v1[j] = gelu_tanh(v1[j]); } }
                    u32x4 w; w.x = cvt_pk_bf16(v0[0], v0[1]); w.y = cvt_pk_bf16(v0[2], v0[3]); w.z = cvt_pk_bf16(v1[0], v1[1]); w.w = cvt_pk_bf16(v1[2], v1[3]);
                    *(u32x4*)(rowp + bj * HALF) = w; } }
    }
};

typedef int v8i32 __attribute__((ext_vector_type(8)));
typedef short s16x16 __attribute__((ext_vector_type(16)));
template <class Epi, class Sched, bool ALIGN_EPI, bool GATHER, bool FP8 = false>
__device__ __forceinline__ void gemm_phase(LAS unsigned char* lds, const Gemm g, const Sched& S, const Epi& E, const int tid) {
    const int wid = __builtin_amdgcn_readfirstlane(tid >> 6), lane = tid & 63, wr = wid >> 2, wc = wid & 3, fr = lane & 15, fq = lane >> 4;
    const int K = g.K, nt = K / BK;
    unsigned voffA[2], voffB[2]; int Rr[2], Cc[2];
#pragma unroll
    for (int i = 0; i < 2; ++i) { int R, C; stage_rc(tid * 16 + i * 8192, R, C); const int Rb = Epi::PERM ? ((R & ~31) + perm32(R & 31)) : R; Rr[i] = R; Cc[i] = C;
        voffA[i] = (unsigned)(R * K + C) * 2u; voffB[i] = (unsigned)(Rb * K + C) * 2u; }
    const unsigned kstep = (unsigned)(BK * 2);
    const unsigned hstep = (unsigned)HALF * (unsigned)K * 2u;
    const unsigned tstep = 2u * hstep;
    const char* const baseA = (const char*)g.A; const char* const baseB = (const char*)g.Bt;
    const unsigned ldsw = (unsigned)wid * 1024u;
    const int aoff = lds_byte(wr * 64 + fr, fq * 8), boff = lds_byte(wc * 32 + fr, fq * 8);
    const int aoff0 = lds_byte(wr * 64 + fr, fq * 16), aoff1 = lds_byte(wr * 64 + fr, fq * 16 + 8), boff0 = lds_byte(wc * 32 + fr, fq * 16), boff1 = lds_byte(wc * 32 + fr, fq * 16 + 8);
#define PG8_SA(b, h) (((b) * 2 + (h)) * HTB)
#define PG8_SB(b, h) ((4 + (b) * 2 + (h)) * HTB)
#define PG8_STAGE(bufoff, gbase, voff) do { _Pragma("unroll") for (int _i = 0; _i < 2; ++_i) \
        __builtin_amdgcn_global_load_lds((const unsigned*)(baseB + (size_t)(unsigned)((gbase) + (voff)[_i])), (LAS unsigned*)(lds + (bufoff) + ldsw + _i * 8192), 16, 0, 0); } while (0)
#define PG8_STAGEA(bufoff, gbase, voff) do { _Pragma("unroll") for (int _i = 0; _i < 2; ++_i) \
        __builtin_amdgcn_global_load_lds((const unsigned*)(baseA + (size_t)(unsigned)((gbase) + (voff)[_i])), (LAS unsigned*)(lds + (bufoff) + ldsw + _i * 8192), 16, 0, 0); } while (0)
#define PG8_STAGE_A(bufoff, base, h, nx) do { if constexpr (GATHER) { _Pragma("unroll") for (int _i = 0; _i < 2; ++_i) { const unsigned _v = (nx) ? vAn[h][_i] : vAc[h][_i]; \
            __builtin_amdgcn_global_load_lds((const unsigned*)(baseA + (size_t)(unsigned)((base) + _v)), (LAS unsigned*)(lds + (bufoff) + ldsw + _i * 8192), 16, 0, 0); } } \
        else { PG8_STAGEA(bufoff, (base) + (h) * hstep, voffA); } } while (0)
#define PG8_LD8(dst, i, off0, off1) do { const bf16x8 _lo = *(const LAS bf16x8*)(lds + (off0)), _hi = *(const LAS bf16x8*)(lds + (off0) + 16); dst[i] = __builtin_bit_cast(v8i32, __builtin_shufflevector(_lo, _hi, 0, 1, 2, 3, 4, 5, 6, 7, 8, 9, 10, 11, 12, 13, 14, 15)); } while (0)
#define PG8_LDA8(dst, b, h) do { _Pragma("unroll") for (int m = 0; m < 4; ++m) PG8_LD8(dst, m, PG8_SA(b, h) + aoff0 + m * 2048, PG8_SA(b, h) + aoff1 + m * 2048); } while (0)
#define PG8_LDB8(dst, b, h) do { _Pragma("unroll") for (int n = 0; n < 2; ++n) PG8_LD8(dst, n, PG8_SB(b, h) + boff0 + n * 2048, PG8_SB(b, h) + boff1 + n * 2048); } while (0)
#define PG8_MMA8(ai, bj, At, Bt) do { __builtin_amdgcn_s_setprio(1); _Pragma("unroll") for (int m = 0; m < 4; ++m) _Pragma("unroll") for (int n = 0; n < 2; ++n) \
        asm volatile("v_mfma_scale_f32_16x16x128_f8f6f4 %0, %1, %2, %0, %3, %3 op_sel_hi:[0,0,0]" : "+v"(acc[ai][bj][m][n]) : "v"(Bt[n]), "v"(At[m]), "v"(one_scale)); __builtin_amdgcn_s_setprio(0); } while (0)
#define PG8_LDA(dst, b, h) do { _Pragma("unroll") for (int m = 0; m < 4; ++m) _Pragma("unroll") for (int k = 0; k < 2; ++k) dst[m][k] = *(const LAS bf16x8*)(lds + PG8_SA(b, h) + aoff + m * 2048 + k * 1024); } while (0)
#define PG8_LDB(dst, b, h) do { _Pragma("unroll") for (int n = 0; n < 2; ++n) _Pragma("unroll") for (int k = 0; k < 2; ++k) dst[n][k] = *(const LAS bf16x8*)(lds + PG8_SB(b, h) + boff + n * 2048 + k * 1024); } while (0)
#define PG8_MMA(ai, bj, At, Bt) do { __builtin_amdgcn_s_setprio(1); _Pragma("unroll") for (int m = 0; m < 4; ++m) _Pragma("unroll") for (int n = 0; n < 2; ++n) _Pragma("unroll") for (int k = 0; k < 2; ++k) \
        acc[ai][bj][m][n] = __builtin_amdgcn_mfma_f32_16x16x32_bf16(Bt[n][k], At[m][k], acc[ai][bj][m][n], 0, 0, 0); __builtin_amdgcn_s_setprio(0); } while (0)
#define PG8_WAIT_V(n) asm volatile("s_waitcnt vmcnt(" #n ")" ::: "memory")
#define PG8_WAIT_L(n) asm volatile("s_waitcnt lgkmcnt(" #n ")" ::: "memory")
#define PG8_BAR __builtin_amdgcn_s_barrier()
#define PG8_SCHED __builtin_amdgcn_sched_barrier(0)
    Unit cur, nxt; int ui = 0;
    if (!S.next(0, cur)) return;
    f32x4 acc[2][2][4][2];
#pragma unroll
    for (int a = 0; a < 2; ++a)
#pragma unroll
        for (int b = 0; b < 2; ++b)
#pragma unroll
            for (int m = 0; m < 4; ++m)
#pragma unroll
                for (int n = 0; n < 2; ++n) acc[a][b][m][n] = (f32x4){0.f, 0.f, 0.f, 0.f};
    bf16x8 At[4][2], B0[2][2], B1[2][2]; v8i32 At8[4], B08[2], B18[2]; const int one_scale = 0x7F7F7F7F;
#define XLDA(b, h) do { if constexpr (FP8) PG8_LDA8(At8, b, h); else PG8_LDA(At, b, h); } while (0)
#define XLDB0(b, h) do { if constexpr (FP8) PG8_LDB8(B08, b, h); else PG8_LDB(B0, b, h); } while (0)
#define XLDB1(b, h) do { if constexpr (FP8) PG8_LDB8(B18, b, h); else PG8_LDB(B1, b, h); } while (0)
#define XMMA0(ai, bj) do { if constexpr (FP8) PG8_MMA8(ai, bj, At8, B08); else PG8_MMA(ai, bj, At, B0); } while (0)
#define XMMA1(ai, bj) do { if constexpr (FP8) PG8_MMA8(ai, bj, At8, B18); else PG8_MMA(ai, bj, At, B1); } while (0)
    unsigned vAc[2][2], vAn[2][2];
#define PG8_ROWS(dst, un) do { if constexpr (GATHER) { _Pragma("unroll") for (int _h = 0; _h < 2; ++_h) _Pragma("unroll") for (int _i = 0; _i < 2; ++_i) \
        dst[_h][_i] = (S.arow(un, _h * HALF + Rr[0] + 64 * _i) * (unsigned)K + (unsigned)Cc[0]) * 2u; } } while (0)
    PG8_ROWS(vAc, cur);
#pragma unroll
    for (int _h = 0; _h < 2; ++_h)
#pragma unroll
        for (int _i = 0; _i < 2; ++_i) vAn[_h][_i] = vAc[_h][_i];
    unsigned cA = GATHER ? 0u : (unsigned)cur.pm * tstep; unsigned cB = (unsigned)cur.pn * tstep;
    PG8_STAGE(PG8_SB(0, 0), cB, voffB); PG8_STAGE(PG8_SB(0, 1), cB + hstep, voffB); PG8_STAGE_A(PG8_SA(0, 0), cA, 0, false); PG8_STAGE_A(PG8_SA(0, 1), cA, 1, false);
    if (wr == 1) PG8_BAR;
    PG8_WAIT_V(2); PG8_BAR;
    PG8_STAGE(PG8_SB(1, 0), cB + kstep, voffB); PG8_STAGE_A(PG8_SA(1, 0), cA + kstep, 0, false); PG8_STAGE(PG8_SB(1, 1), cB + hstep + kstep, voffB);
    PG8_WAIT_V(6); PG8_BAR;
    for (;;) {
        const bool has_next = S.next(ui + 1, nxt);
        if constexpr (GATHER) {
            if (has_next) {
                if (ui == 0) { PG8_ROWS(vAn, nxt); asm volatile("" : "+v"(vAn[0][0]), "+v"(vAn[0][1]), "+v"(vAn[1][0]), "+v"(vAn[1][1])); }
                else {
#pragma unroll
                    for (int _h = 0; _h < 2; ++_h)
#pragma unroll
                        for (int _i = 0; _i < 2; ++_i) { const int R_ = _h * HALF + Rr[0] + 64 * _i; const unsigned v_ = *(const LAS unsigned*)(lds + PRE_ROWS + ((ui + 1) & 1) * 1024 + R_ * 4);
                            vAn[_h][_i] = (S.rowval(nxt, R_, v_) * (unsigned)K + (unsigned)Cc[0]) * 2u; } }
            }
            Unit n2_; if (S.next(ui + 2, n2_)) { if (wid == 0) __builtin_amdgcn_global_load_lds((const unsigned*)(S.rows_ptr(n2_) + lane * 4), (LAS unsigned*)(lds + PRE_ROWS + (ui & 1) * 1024), 16, 0, 0); }
        } else { if (has_next) { PG8_ROWS(vAn, nxt); } }
        if constexpr (Epi::HAS_PRE) E.pre(lds + PRE_EPI + (ui & 1) * 2048, cur, wid, lane);
        const unsigned nA = GATHER ? 0u : (has_next ? (unsigned)nxt.pm * tstep : cA);
        const unsigned nB = has_next ? (unsigned)nxt.pn * tstep : cB;
#pragma unroll 1
        for (int t = 0; t < nt; t += 2) {
            const bool last = (t == nt - 2);
            const bool nx = last && has_next;
            const unsigned a1 = cA + (unsigned)(t + 1) * kstep;
            const unsigned a2 = last ? nA : cA + (unsigned)(t + 2) * kstep; const unsigned b2 = last ? nB : cB + (unsigned)(t + 2) * kstep;
            const unsigned a3 = a2 + kstep; const unsigned b3 = b2 + kstep;
            XLDB0(0, 0); XLDB1(0, 1); PG8_SCHED; XLDA(0, 0); PG8_STAGE_A(PG8_SA(1, 1), a1, 1, false);
            PG8_WAIT_V(8); PG8_WAIT_L(0); PG8_BAR; XMMA0(0, 0); XMMA1(0, 1); PG8_BAR; PG8_SCHED;
            XLDA(0, 1); PG8_STAGE(PG8_SB(0, 0), b2, voffB); PG8_STAGE(PG8_SB(0, 1), b2 + hstep, voffB); PG8_STAGE_A(PG8_SA(0, 0), a2, 0, nx);
            PG8_WAIT_V(8); PG8_WAIT_L(0); PG8_BAR; XMMA0(1, 0); XMMA1(1, 1); PG8_BAR; PG8_SCHED;
            XLDB0(1, 0); XLDB1(1, 1); PG8_SCHED; XLDA(1, 0); PG8_STAGE_A(PG8_SA(0, 1), a2, 1, nx);
            PG8_WAIT_V(8); PG8_WAIT_L(0); PG8_BAR; XMMA0(0, 0); XMMA1(0, 1); PG8_BAR; PG8_SCHED;
            XLDA(1, 1); PG8_STAGE(PG8_SB(1, 0), b3, voffB); PG8_STAGE(PG8_SB(1, 1), b3 + hstep, voffB); PG8_STAGE_A(PG8_SA(1, 0), a3, 0, nx);
            PG8_WAIT_V(8); PG8_WAIT_L(0); PG8_BAR; XMMA0(1, 0); XMMA1(1, 1); PG8_BAR; PG8_SCHED;
        }
        if constexpr (FP8) asm volatile("s_nop 15\n\ts_nop 15" ::: "memory");
        if constexpr (ALIGN_EPI) { if (wr == 0) PG8_BAR; }
        if constexpr (Epi::HAS_PRE) E(acc, cur, wr, wc, fr, fq, lds + PRE_EPI + (ui & 1) * 2048); else E(acc, cur, wr, wc, fr, fq);
        if (!has_next) break;
#pragma unroll
        for (int a = 0; a < 2; ++a)
#pragma unroll
            for (int b = 0; b < 2; ++b)
#pragma unroll
                for (int m = 0; m < 4; ++m)
#pragma unroll
                    for (int n = 0; n < 2; ++n) acc[a][b][m][n] = (f32x4){0.f, 0.f, 0.f, 0.f};
        cur = nxt; cA = nA; cB = nB; ++ui;
#pragma unroll
        for (int _h = 0; _h < 2; ++_h)
#pragma unroll
            for (int _i = 0; _i < 2; ++_i) vAc[_h][_i] = vAn[_h][_i];
        if constexpr (ALIGN_EPI) { if (wr == 1) PG8_BAR; }
    }
    PG8_WAIT_V(0);
    if constexpr (!ALIGN_EPI) { if (wr == 0) PG8_BAR; }
    PG8_BAR;
#undef PG8_SA
#undef PG8_SB
#undef PG8_STAGE
#undef PG8_STAGEA
#undef PG8_STAGE_A
#undef PG8_ROWS
#undef PG8_LDA
#undef PG8_LD8
#undef PG8_LDA8
#undef PG8_LDB8
#undef PG8_MMA8
#undef XLDA
#undef XLDB0
#undef XLDB1
#undef XMMA0
#undef XMMA1
#undef PG8_LDB
#undef PG8_MMA
#undef PG8_WAIT_V
#undef PG8_WAIT_L
#undef PG8_BAR
#undef PG8_SCHED
}
}

constexpr int DM = 1024, SEQ = 16384, NB = 2, T = NB * SEQ, CTX = 256, NCTX = NB * CTX, NKEY = SEQ + CTX;
constexpr int NE = 32, TOPK = 4, CAP = 32768;
constexpr float ALPHA = 1.4142135623730951f, LN_EPS = 1e-5f;
constexpr float QSCALE = 0.125f * 1.4426950408889634f;
constexpr float LAM_INIT0 = 0.2f;
constexpr int NWAVES = 8, NTHR = 512;

constexpr size_t MiB = 1u << 20;
constexpr size_t WS_CTL = 0, CTL_ZERO_BYTES = 1 * MiB;
constexpr size_t WS_MODP = 1 * MiB;
constexpr size_t WS_MOD = 3 * MiB;
constexpr size_t WS_TAB = 4 * MiB;
constexpr size_t WS_WEVIN = 6 * MiB, WS_WEVOUT = 11 * MiB, WS_WODIN = 13 * MiB, WS_WODOUT = 16 * MiB;
constexpr size_t WS_LIST = 18 * MiB, WS_GATES = 22 * MiB;
constexpr size_t WS_WGU = 32 * MiB;
constexpr size_t WS_WD = 288 * MiB;
constexpr size_t WS_U = 416 * MiB;
constexpr size_t WS_Q = 482 * MiB, WS_K = 514 * MiB, WS_V = 547 * MiB, WS_AB = 580 * MiB;
constexpr size_t WS_O0 = 612 * MiB;
constexpr size_t WS_MIX = 676 * MiB, WS_Y = 740 * MiB, WS_H1 = 804 * MiB, WS_U2 = 932 * MiB;
constexpr size_t WS_ACT = 996 * MiB;
constexpr size_t WS_YB = 1268 * MiB;
constexpr size_t WS_H2 = 1524 * MiB;
constexpr size_t WS_ZODD = 1652 * MiB;
constexpr size_t WS_WT = 1748 * MiB;
constexpr size_t WS_END = 1812 * MiB;
constexpr size_t TB_COS = 0, TB_SIN = 20480, TB_CS = 40960  , TB_AF = 106496  , TB_A3 = 237568  , TB_TW = 303104  , TB_WS = 434176  , TB_END = 565248;
constexpr int CW_ERR = 0, CW_BAR = 4096, CW_CNT = 16384;
#define XB_TMO      128
#define XB_XCNT(j)  (256  + 64 * (j))
#define XB_XSUB(j)  (1280 + 64 * (j))
#define XB_XGEN(j)  (2304 + 64 * (j))
#define XB_TOP      3328
#define XB_TOPGEN   3392
#define XCD_BAR_WORDS 3456
#define XB_SPIN_CAP (1u << 18)
constexpr int LDS_BYTES = 160 * 1024, MISC_OFF = LDS_BYTES - 256, META_OFF = 131072;

__device__ __forceinline__ unsigned xb_ld(unsigned* p)              { return __hip_atomic_load(p, __ATOMIC_RELAXED, __HIP_MEMORY_SCOPE_AGENT); }
__device__ __forceinline__ unsigned xb_add(unsigned* p, unsigned v) { return __hip_atomic_fetch_add(p, v, __ATOMIC_RELAXED, __HIP_MEMORY_SCOPE_AGENT); }
__device__ __forceinline__ unsigned xb_xcc_id() { return (unsigned)__builtin_amdgcn_s_getreg((3 << 11) | 20) & 0xFu; }
#define XB_SPIN(cond, bar) do { unsigned _sp = 0; while (cond) { __builtin_amdgcn_s_sleep(1); \
    if ((++_sp & 255u) == 0u) { if (xb_ld(&(bar)[XB_TMO])) break; if (_sp > XB_SPIN_CAP) { atomicAdd(&(bar)[XB_TMO], 1u); break; } } } } while (0)
struct XcdBarrier { unsigned* bar; unsigned x; volatile LAS unsigned* st; };
__device__ __forceinline__ XcdBarrier xcd_barrier_post(unsigned* bar, volatile LAS unsigned* st) {
    XcdBarrier b; b.bar = bar; b.x = xb_xcc_id(); b.st = st;
    if (threadIdx.x == 0) (void)xb_add(&bar[XB_XCNT(b.x)], 1u);
    return b;
}
__device__ __forceinline__ void xcd_barrier_complete(unsigned* bar, unsigned x, unsigned& nloc, unsigned& nx) {
    const unsigned G = gridDim.x * gridDim.y * gridDim.z;
    unsigned sum, cnt, mine, sp = 0u;
    for (;;) {
        sum = 0u; cnt = 0u; mine = 0u;
#pragma unroll
        for (unsigned j = 0; j < 16; ++j) { const unsigned c = xb_ld(&bar[XB_XCNT(j)]); sum += c; cnt += (c > 0u) ? 1u : 0u; mine = (j == x) ? c : mine; }
        if (sum == G) break;
        __builtin_amdgcn_s_sleep(1);
        if ((++sp & 255u) == 0u) { if (xb_ld(&bar[XB_TMO])) break; if (sp > XB_SPIN_CAP) { atomicAdd(&bar[XB_TMO], 1u); break; } }
    }
    nloc = mine > 0u ? mine : 1u; nx = cnt > 0u ? cnt : 1u;
}
__device__ __forceinline__ void xcd_barrier(const XcdBarrier& b) {
    asm volatile("s_waitcnt vmcnt(0)" ::: "memory");
    __syncthreads();
    if (threadIdx.x == 0) {
        unsigned* bar = b.bar;
        __builtin_amdgcn_s_waitcnt(0);
        unsigned nloc = b.st[0], nx = b.st[1];
        if (nloc == 0u) { xcd_barrier_complete(bar, b.x, nloc, nx); b.st[0] = nloc; b.st[1] = nx; }
        const unsigned old = xb_add(&bar[XB_XSUB(b.x)], 1u);
        const unsigned gen = old / nloc;
        if (old + 1u == (gen + 1u) * nloc) {
            __builtin_amdgcn_fence(__ATOMIC_RELEASE, "agent");
            asm volatile("s_waitcnt vmcnt(0)" ::: "memory");
            const unsigned og = xb_add(&bar[XB_TOP], 1u);
            const unsigned tg = og / nx;
            if (og + 1u == (tg + 1u) * nx) xb_add(&bar[XB_TOPGEN], 1u);
            else XB_SPIN(xb_ld(&bar[XB_TOPGEN]) == tg, bar);
            __builtin_amdgcn_fence(__ATOMIC_ACQUIRE, "agent");
            xb_add(&bar[XB_XGEN(b.x)], 1u);
            asm volatile("s_waitcnt vmcnt(0)" ::: "memory");
        } else {
            XB_SPIN(xb_ld(&bar[XB_XGEN(b.x)]) == gen, bar);
            __builtin_amdgcn_fence(__ATOMIC_ACQUIRE, "agent");
            asm volatile("s_waitcnt vmcnt(0)" ::: "memory");
        }
    }
    __syncthreads();
}

__device__ __forceinline__ float bf2f(unsigned short b) { return __uint_as_float(((unsigned)b) << 16); }
__device__ __forceinline__ unsigned f2bf(float f) { unsigned u = __float_as_uint(f); return (u + 0x7fffu + ((u >> 16) & 1u)) >> 16; }
__device__ __forceinline__ unsigned pk2(float lo, float hi) { return f2bf(lo) | (f2bf(hi) << 16); }
__device__ __forceinline__ unsigned char f2fp8(float a) { return (unsigned char)((unsigned)__builtin_amdgcn_cvt_pk_fp8_f32(a, 0.f, 0, false) & 0xffu); }
__device__ __forceinline__ unsigned pk4_fp8(float a, float b, float c, float d) { unsigned w = (unsigned)__builtin_amdgcn_cvt_pk_fp8_f32(a, b, 0, false); return (unsigned)__builtin_amdgcn_cvt_pk_fp8_f32(c, d, (int)w, true); }
constexpr float WI_SCALE = 32.0f;
constexpr float WO_SCALE = 64.0f;
constexpr float WGU_SCALE = 32.0f, WD_SCALE = 64.0f;
template <int CTRL> __device__ __forceinline__ float dpp_f(float v) { return __builtin_bit_cast(float, __builtin_amdgcn_update_dpp(0, __builtin_bit_cast(int, v), CTRL, 0xf, 0xf, true)); }
__device__ __forceinline__ float wave_sum(float v) {
    v += dpp_f<0xB1>(v); v += dpp_f<0x4E>(v); v += dpp_f<0x141>(v); v += dpp_f<0x140>(v);
    { const auto r = __builtin_amdgcn_permlane16_swap(__float_as_uint(v), __float_as_uint(v), false, false); v = __uint_as_float(r[0]) + __uint_as_float(r[1]); }
    { const auto r = __builtin_amdgcn_permlane32_swap(__float_as_uint(v), __float_as_uint(v), false, false); v = __uint_as_float(r[0]) + __uint_as_float(r[1]); }
    return v;
}
__device__ __forceinline__ float half_sum(float v) {
    v += dpp_f<0xB1>(v); v += dpp_f<0x4E>(v); v += dpp_f<0x141>(v); v += dpp_f<0x140>(v);
    { const auto r = __builtin_amdgcn_permlane16_swap(__float_as_uint(v), __float_as_uint(v), false, false); v = __uint_as_float(r[0]) + __uint_as_float(r[1]); }
    return v;
}
__device__ __forceinline__ float xhalf_sum(float v) {
    const auto r = __builtin_amdgcn_permlane32_swap(__float_as_uint(v), __float_as_uint(v), false, false); return __uint_as_float(r[0]) + __uint_as_float(r[1]);
}
__device__ __forceinline__ float wave_max(float v) {
    v = fmaxf(v, dpp_f<0xB1>(v)); v = fmaxf(v, dpp_f<0x4E>(v)); v = fmaxf(v, dpp_f<0x141>(v)); v = fmaxf(v, dpp_f<0x140>(v));
    { const auto r = __builtin_amdgcn_permlane16_swap(__float_as_uint(v), __float_as_uint(v), false, false); v = fmaxf(__uint_as_float(r[0]), __uint_as_float(r[1])); }
    { const auto r = __builtin_amdgcn_permlane32_swap(__float_as_uint(v), __float_as_uint(v), false, false); v = fmaxf(__uint_as_float(r[0]), __uint_as_float(r[1])); }
    return v;
}
__device__ __forceinline__ int crow(int r, int hi) { return (r & 3) + 8 * (r >> 2) + 4 * hi; }
__device__ __forceinline__ float silu_f(float x) { return x / (1.0f + __expf(-x)); }
__device__ __forceinline__ float sigmoid_f(float x) { return 1.0f / (1.0f + __expf(-x)); }
__device__ __forceinline__ int v_st(int k, int c) { const int kk = (k & ~0xC) | ((k & 4) << 1) | ((k & 8) >> 1); return ((kk >> 3) * 4 + (c >> 5)) * 512 + ((kk & 7) * 32 + (c & 31)) * 2; }
__device__ __forceinline__ int v_rd_base(int lane) { return ((lane & 3) << 3) | (((lane >> 2) & 3) << 6) | (((lane >> 4) & 1) << 5) | (((lane >> 5) & 1) << 8); }
__host__ __device__ constexpr int v_rd_off(int d0, int ks, int half) { return d0 * 512 + ks * 4096 + half * 2048; }
typedef short v4i16_t __attribute__((ext_vector_type(4)));
__device__ __forceinline__ bf16x8 vfrag(LAS unsigned char* tile_rd  , int d0, int ks) {
    const v4i16_t lo = __builtin_amdgcn_ds_read_tr16_b64_v4i16((LAS v4i16_t*)(tile_rd + v_rd_off(d0, ks, 0)));
    const v4i16_t hi = __builtin_amdgcn_ds_read_tr16_b64_v4i16((LAS v4i16_t*)(tile_rd + v_rd_off(d0, ks, 1)));
    return (bf16x8){lo[0], lo[1], lo[2], lo[3], hi[0], hi[1], hi[2], hi[3]};
}

struct Args { const float* in[35]; float* out; unsigned char* ws; int ph_lo, ph_hi; };

struct Frame { LAS unsigned char* lds; int tid, lane, wave, G, bx, kz; };
#define CAS __attribute__((address_space(4)))
__device__ __forceinline__ const float* kin_(int kz, int i) { return *(const float* const CAS*)((const CAS char*)__builtin_amdgcn_kernarg_segment_ptr() + kz + 8 * i); }
#define KIN(F, i) kin_((F).kz, (i))
#define KOUT(F) ((float*)kin_((F).kz, 35))
#define KWS(F) ((unsigned char*)kin_((F).kz, 36))
static_assert(sizeof(Args) == 37 * 8 + 8, "Args layout");

__device__ __forceinline__ void ph0_mod_tables(Frame& F) {
    const float* c = KIN(F, 1); const float* cctx = KIN(F, 3); const float* wmod = KIN(F, 4);
    LAS float* sv = (LAS float*)F.lds;
    for (int vb = F.bx; vb < 256; vb += F.G) {
    const int l = vb >> 7, rem = vb & 127, nch = rem & 7, kch = rem >> 3, k0 = kch * 64;
    if (F.tid < 192) { const int v = F.tid >> 6, k = F.tid & 63; const float x = (v < 2) ? c[v * DM + k0 + k] : cctx[k0 + k]; sv[v * 64 + k] = silu_f(x); }
    __syncthreads();
    if (F.tid < 384) {
        const int col = nch * 768 + F.tid * 2;
        const float* W = wmod + ((size_t)l * DM + k0) * 6144 + col;
        f32x2 a0 = {0.f, 0.f}, a1 = {0.f, 0.f}, a2 = {0.f, 0.f};
#pragma unroll 8
        for (int k = 0; k < 64; ++k) { const f32x2 w = *(const f32x2*)(W + (size_t)k * 6144); a0 += w * sv[k]; a1 += w * sv[64 + k]; a2 += w * sv[128 + k]; }
        float* mp = (float*)(KWS(F) + WS_MODP) + (size_t)kch * 5 * 6144 + col;
        if (l == 0) { *(f32x2*)(mp + 0 * 6144) = a0; *(f32x2*)(mp + 1 * 6144) = a1; *(f32x2*)(mp + 2 * 6144) = a2; }
        else { *(f32x2*)(mp + 3 * 6144) = a0; *(f32x2*)(mp + 4 * 6144) = a1; }
    }
    __syncthreads();
    }
    const int bx = F.bx;
    unsigned char* tb = KWS(F) + WS_TAB;
    const int gid = bx * NTHR + F.tid, NG = F.G * NTHR;
    const float s128 = 0.08838834764831845f;
    for (int i = gid; i < 5120; i += NG) {
        const int pos = i >> 4, f = i & 15; const int p = pos < 256 ? pos : pos - 256;
        const float inv = powf(10000.0f, -((float)f / 16.0f)); const float ang = (float)p * inv;
        ((float*)(tb + TB_COS))[i] = (float)cos((double)ang); ((float*)(tb + TB_SIN))[i] = (float)sin((double)ang);
    }
    for (int i = gid; i < 32768; i += NG) {
        const int j8 = i & 7, ln = (i >> 3) & 63, ks = (i >> 9) & 7, nb = i >> 12;
        const int n = 32 * nb + (ln & 31), cc = 16 * ks + 8 * (ln >> 5) + j8, part = n >> 7, jj = n & 127, m = (jj * cc) & 127;
        const double a = (double)m / 64.0; const float v = (part == 0 ? (float)cospi(a) : -(float)sinpi(a)) * s128;
        ((bf16_t*)(tb + TB_CS))[i] = (bf16_t)f2bf(v);
    }
    for (int i = gid; i < 65536; i += NG) {
        const int j8 = i & 7, ln = (i >> 3) & 63, ks = (i >> 9) & 15, mb = i >> 13;
        const int m = 32 * mb + (ln & 31), k = 16 * ks + 8 * (ln >> 5) + j8, mpart = m >> 7, k1 = m & 127, part = k >> 7, t1 = k & 127, ph = (k1 * t1) & 127;
        const double a = (double)ph / 64.0; const float cs = (float)cospi(a), sn = (float)sinpi(a);
        const float v = (mpart == 0 ? (part == 0 ? cs : sn) : (part == 0 ? -sn : cs)) * s128;
        ((bf16_t*)(tb + TB_AF))[i] = (bf16_t)f2bf(v);
    }
    for (int i = gid; i < 32768; i += NG) {
        const int j8 = i & 7, ln = (i >> 3) & 63, ks = (i >> 9) & 15, mb = i >> 13;
        const int k2 = 32 * mb + (ln & 31), k = 16 * ks + 8 * (ln >> 5) + j8, part = k >> 7, t2 = k & 127, ps = (k2 * t2) & 127;
        const double a = (double)ps / 64.0; const float v = (part == 0 ? (float)cospi(a) : (float)sinpi(a)) * s128;
        ((bf16_t*)(tb + TB_A3))[i] = (bf16_t)f2bf(v);
    }
    for (int i = gid; i < 16384; i += NG) {
        const int t2 = i >> 7, k1 = i & 127; const double a = (double)((k1 * t2) & 16383) / 8192.0;
        ((f32x2*)(tb + TB_TW))[i] = (f32x2){(float)cospi(a), (float)sinpi(a)};
    }
    const float* gws = KIN(F, 25);
    for (int i = gid; i < 65536; i += NG) ((bf16_t*)(tb + TB_WS))[i] = (bf16_t)f2bf(gws[i]);
}

__device__ __forceinline__ void transpose_item(const float* W, int K, int ldw, int k0, int n_src0, bf16_t* WT, int row_dst0, LAS float* scr, int lane) {
#pragma unroll 8
    for (int i = 0; i < 32; ++i) { const int kk = 2 * i + (lane >> 5); scr[kk * 33 + (lane & 31)] = W[(size_t)(k0 + kk) * ldw + n_src0 + (lane & 31)]; }
    asm volatile("s_waitcnt lgkmcnt(0)" ::: "memory");
    const int c = lane & 7;
#pragma unroll
    for (int j = 0; j < 4; ++j) { const int n = (lane >> 3) + 8 * j; const LAS float* s = scr + (8 * c) * 33 + n;
        u32x4 o; o.x = pk2(s[0 * 33], s[1 * 33]); o.y = pk2(s[2 * 33], s[3 * 33]); o.z = pk2(s[4 * 33], s[5 * 33]); o.w = pk2(s[6 * 33], s[7 * 33]);
        *(u32x4*)(WT + (size_t)(row_dst0 + n) * K + k0 + 8 * c) = o; }
    asm volatile("s_waitcnt lgkmcnt(0)" ::: "memory");
}
__device__ __forceinline__ void transpose_item_fp8(const float* W, int K, int ldw, int k0, int n_src0, unsigned char* WT8, int row_dst0, float scale, LAS float* scr, int lane) {
#pragma unroll 8
    for (int i = 0; i < 64; ++i) { const int kk = 2 * i + (lane >> 5); scr[kk * 33 + (lane & 31)] = W[(size_t)(k0 + kk) * ldw + n_src0 + (lane & 31)]; }
    asm volatile("s_waitcnt lgkmcnt(0)" ::: "memory");
    const int q = lane & 3;
#pragma unroll
    for (int j = 0; j < 2; ++j) { const int n = (lane >> 2) + 16 * j; const LAS float* s = scr + (32 * q) * 33 + n; unsigned w[8];
#pragma unroll
        for (int t = 0; t < 8; ++t) w[t] = pk4_fp8(s[(4 * t) * 33] * scale, s[(4 * t + 1) * 33] * scale, s[(4 * t + 2) * 33] * scale, s[(4 * t + 3) * 33] * scale);
        unsigned char* dst = WT8 + (size_t)(row_dst0 + n) * K + k0 + 32 * q;
        *(u32x4*)dst = (u32x4){w[0], w[1], w[2], w[3]}; *(u32x4*)(dst + 16) = (u32x4){w[4], w[5], w[6], w[7]}; }
    asm volatile("s_waitcnt lgkmcnt(0)" ::: "memory");
}
__device__ __forceinline__ void ph1_convert(Frame& F) {
    {
        const int gid = F.bx * NTHR + F.tid;
        if (gid < 5 * 6144) { const int vec = gid / 6144, n = gid % 6144, l = vec < 3 ? 0 : 1; float s = KIN(F, 5)[l * 6144 + n];
            const float* mp = (const float*)(KWS(F) + WS_MODP) + (size_t)vec * 6144 + n;
#pragma unroll
            for (int kc = 0; kc < 16; ++kc) s += mp[(size_t)kc * 5 * 6144];
            ((float*)(KWS(F) + WS_MOD))[gid] = s; }
    }
    LAS float* scr = (LAS float*)(F.lds + F.wave * 16896);
    const int gw = F.bx * NWAVES + F.wave, NGW = F.G * NWAVES;
    constexpr int I_EVIN = 8 * 80, I_EVOUT = 8 * 32, I_ODIN = 8 * 48, I_ODOUT = 8 * 32, I_DENSE = I_EVIN + I_EVOUT + I_ODIN + I_ODOUT;
    constexpr int I_GU = 64 * 512, I_DN = 64 * 256, NITEMS = I_DENSE + I_GU + I_DN;
    for (int it = gw; it < NITEMS; it += NGW) {
        int r = it;
        if (r < I_EVIN) { const int kb = r / 80, nb = r % 80, n0 = 32 * nb; int src = n0;
            if (n0 >= 1536) { const int u = (n0 - 1536) >> 8, w = (n0 - 1536) & 255; src = (w < 128) ? 1536 + 128 * u + w : 2048 + 128 * u + (w - 128); }
            transpose_item_fp8(KIN(F, 10), DM, 2560, 128 * kb, src, (unsigned char*)(KWS(F) + WS_WEVIN), n0, WI_SCALE, scr, F.lane); continue; } r -= I_EVIN;
        if (r < I_EVOUT) { const int kb = r / 32, nb = r % 32; transpose_item_fp8(KIN(F, 11), DM, 1024, 128 * kb, 32 * nb, (unsigned char*)(KWS(F) + WS_WEVOUT), 32 * nb, WO_SCALE, scr, F.lane); continue; } r -= I_EVOUT;
        if (r < I_ODIN) { const int kb = r / 48, nb = r % 48; transpose_item_fp8(KIN(F, 21), DM, 1536, 128 * kb, 32 * nb, (unsigned char*)(KWS(F) + WS_WODIN), 32 * nb, WI_SCALE, scr, F.lane); continue; } r -= I_ODIN;
        if (r < I_ODOUT) { const int kb = r / 32, nb = r % 32; transpose_item_fp8(KIN(F, 22), DM, 1024, 128 * kb, 32 * nb, (unsigned char*)(KWS(F) + WS_WODOUT), 32 * nb, WO_SCALE, scr, F.lane); continue; } r -= I_ODOUT;
        if (r < I_GU) { const int le = r >> 9, q = r & 511, kb = q >> 6, nb = q & 63, n0 = 32 * nb; const int u = n0 >> 8, w = n0 & 255;
            const int src = (w < 128) ? 128 * u + w : 1024 + 128 * u + (w - 128);
            transpose_item_fp8(KIN(F, 31) + (size_t)le * DM * 2048, DM, 2048, 128 * kb, src, (unsigned char*)(KWS(F) + WS_WGU) + (size_t)le * 2048 * DM, n0, WGU_SCALE, scr, F.lane); continue; } r -= I_GU;
        { const int le = r >> 8, q = r & 255, kb = q >> 5, nb = q & 31;
            transpose_item_fp8(KIN(F, 33) + (size_t)le * DM * 1024, DM, 1024, 128 * kb, 32 * nb, (unsigned char*)(KWS(F) + WS_WD) + (size_t)le * 1024 * DM, 32 * nb, WD_SCALE, scr, F.lane); }
    }
}

__device__ __forceinline__ void mod_row(const float* xrow, const float* sh, const float* sc, unsigned char* orow, int lane) {
    f32x4 x[4], a[4], b[4];
#pragma unroll
    for (int j = 0; j < 4; ++j) { const int d = 4 * lane + 256 * j; x[j] = *(const f32x4*)(xrow + d); a[j] = *(const f32x4*)(sc + d); b[j] = *(const f32x4*)(sh + d); }
    asm volatile("" ::: "memory");
#pragma unroll
    for (int j = 0; j < 4; ++j) { const int d = 4 * lane + 256 * j;
        const f32x4 v = x[j] * (a[j] + 1.0f) + b[j]; *(unsigned*)(orow + d) = pk4_fp8(v[0], v[1], v[2], v[3]); }
}
__device__ __forceinline__ void ph2_modulate(Frame& F) {
    const float* mod = (const float*)(KWS(F) + WS_MOD); unsigned char* U = (unsigned char*)(KWS(F) + WS_U);
    const int gw = F.bx * NWAVES + F.wave, NGW = F.G * NWAVES;
    for (int r = gw; r < T + NCTX; r += NGW) {
        if (r < T) { const int b = r >> 14; mod_row(KIN(F, 0) + (size_t)r * DM, mod + b * 6144, mod + b * 6144 + 1024, U + (size_t)r * DM, F.lane); }
        else { mod_row(KIN(F, 2) + (size_t)(r - T) * DM, mod + 2 * 6144, mod + 2 * 6144 + 1024, U + (size_t)r * DM, F.lane); }
    }
}

struct EvInOrder {
    pg8::StaticOrder so;
    __device__ bool next(int i, pg8::Unit& u) const {
        const long L = (long)i * so.G + so.c;
        if (L < so.nwg) return so.map(L, u);
        const int x = (int)(L - so.nwg); if (x >= 8) return false;
        u.pm = 128 + (x >> 2); u.pn = 2 + (x & 3); u.a0 = 0; u.a1 = 0; u.a2 = 256; return true;
    }
    __device__ __forceinline__ unsigned arow(const pg8::Unit&, int) const { return 0u; }
};
__device__ __forceinline__ int vpos64(int k) { return 32 * ((k >> 2) & 1) + 16 * (k >> 5) + ((k & 3) + 4 * ((k & 31) >> 3)); }
struct EpiEvIn {
    static constexpr bool PERM = false, HAS_PRE = false;
    unsigned char *Q8, *K8, *V8T; bf16_t* Ab; const float* cosT; const float* sinT;
    __device__ __forceinline__ void operator()(const f32x4 (&acc)[2][2][4][2], const pg8::Unit& u, int wr, int wc, int fr, int fq) const {
        const int pn = u.pn;
        if (pn < 4) {
            const int kind = pn >> 1, colbase = (pn & 1) * 256 + wc * 32 + 4 * fq; const bool isctx = u.pm >= 128;
            const float sc = ((kind == 0) ? QSCALE : 1.0f) * (1.0f / WI_SCALE);
#define QK_ROW(ai, m, CS, SN) do { const int row = u.pm * 256 + (ai) * 128 + wr * 64 + (m) * 16 + fr; int b_, key_; \
                if (!isctx) { b_ = row >> 14; key_ = row & (SEQ - 1); } else { const int rc_ = row - T; b_ = rc_ >> 8; key_ = SEQ + (rc_ & 255); } \
                unsigned char* dst = (kind == 0) ? Q8 + (size_t)row * 512 : K8 + (size_t)(b_ * NKEY + key_) * 512; \
                _Pragma("unroll") for (int bj = 0; bj < 2; ++bj) { const f32x4 x1 = acc[ai][bj][m][0], x2 = acc[ai][bj][m][1]; \
                    const f32x4 o1 = (x1 * (CS) - x2 * (SN)) * sc, o2 = (x1 * (SN) + x2 * (CS)) * sc; \
                    *(unsigned*)(dst + colbase + bj * 128) = pk4_fp8(o1[0], o1[1], o1[2], o1[3]); *(unsigned*)(dst + colbase + bj * 128 + 16) = pk4_fp8(o2[0], o2[1], o2[2], o2[3]); } } while (0)
            if (wc & 1) {
#pragma unroll
                for (int mh = 0; mh < 2; ++mh) {
                    f32x4 cs[2], sn[2];
#pragma unroll
                    for (int mm = 0; mm < 2; ++mm) { cs[mm] = (f32x4){1.f, 1.f, 1.f, 1.f}; sn[mm] = (f32x4){0.f, 0.f, 0.f, 0.f};
                        if (!isctx) { const int pos = 256 + (2 * mh + mm) * 16 + fr; cs[mm] = *(const f32x4*)(cosT + pos * 16 + 4 * fq); sn[mm] = *(const f32x4*)(sinT + pos * 16 + 4 * fq); } }
                    asm volatile("" ::: "memory");
#pragma unroll
                    for (int ai = 0; ai < 2; ++ai)
#pragma unroll
                        for (int mm = 0; mm < 2; ++mm) QK_ROW(ai, 2 * mh + mm, cs[mm], sn[mm]);
                }
            } else {
                f32x4 cs[2], sn[2];
#pragma unroll
                for (int ai = 0; ai < 2; ++ai) { cs[ai] = (f32x4){1.f, 1.f, 1.f, 1.f}; sn[ai] = (f32x4){0.f, 0.f, 0.f, 0.f};
                    if (!isctx) { const int pos = ((u.pm * 256 + ai * 128 + wr * 64) & (SEQ - 1)) >> 6; cs[ai] = *(const f32x4*)(cosT + pos * 16 + 4 * fq); sn[ai] = *(const f32x4*)(sinT + pos * 16 + 4 * fq); } }
                asm volatile("" ::: "memory");
#pragma unroll
                for (int ai = 0; ai < 2; ++ai)
#pragma unroll
                    for (int m = 0; m < 4; ++m) QK_ROW(ai, m, cs[ai], sn[ai]);
            }
#undef QK_ROW
        } else if (pn < 6) {
            const int colbase = (pn & 1) * 256 + wc * 32 + 4 * fq;
#pragma unroll
            for (int ai = 0; ai < 2; ++ai)
#pragma unroll
                for (int m = 0; m < 4; ++m) {
                    const int row = u.pm * 256 + ai * 128 + wr * 64 + m * 16 + fr; const bool isctx = row >= T;
                    int b, key;
                    if (!isctx) { b = row >> 14; key = row & (SEQ - 1); } else { const int rc = row - T; b = rc >> 8; key = SEQ + (rc & 255); }
                    const size_t kofs = (size_t)(key & ~63) + vpos64(key & 63);
#pragma unroll
                    for (int bj = 0; bj < 2; ++bj)
#pragma unroll
                        for (int n = 0; n < 2; ++n) { const f32x4 x = acc[ai][bj][m][n] * (1.0f / WI_SCALE); const unsigned w = pk4_fp8(x[0], x[1], x[2], x[3]); const int vcol = colbase + bj * 128 + n * 16;
                            unsigned char* dst = V8T + ((size_t)(b * 4 + (vcol >> 7)) * 128 + (vcol & 127)) * NKEY + kofs;
                            dst[0] = (unsigned char)(w & 0xff); dst[NKEY] = (unsigned char)((w >> 8) & 0xff); dst[2 * NKEY] = (unsigned char)((w >> 16) & 0xff); dst[3 * NKEY] = (unsigned char)(w >> 24); }
                }
        } else {
            const int colbase = (pn - 6) * 128 + wc * 32 + 4 * fq;
#pragma unroll
            for (int ai = 0; ai < 2; ++ai)
#pragma unroll
                for (int m = 0; m < 4; ++m) {
                    const int row = u.pm * 256 + ai * 128 + wr * 64 + m * 16 + fr; if (row >= T) continue;
                    bf16_t* dst = Ab + (size_t)row * 512 + colbase;
#pragma unroll
                    for (int n = 0; n < 2; ++n) { const f32x4 v = acc[ai][0][m][n] * (1.0f / WI_SCALE), g = acc[ai][1][m][n] * (1.0f / WI_SCALE); f32x4 o;
#pragma unroll
                        for (int j = 0; j < 4; ++j) o[j] = v[j] * sigmoid_f(g[j]);
                        u32x2 w; w.x = pk2(o[0], o[1]); w.y = pk2(o[2], o[3]); *(u32x2*)(dst + n * 16) = w; }
                }
        }
    }
};

__device__ __forceinline__ void ph4_conv(Frame& F) {
    const bf16_t* Ab = (const bf16_t*)(KWS(F) + WS_AB); unsigned char* MIX = (unsigned char*)(KWS(F) + WS_MIX);
    const float* cw = KIN(F, 12); const float* cb = KIN(F, 13); const float* lg = KIN(F, 14); const float* lb = KIN(F, 15);
    LAS bf16_t* At = (LAS bf16_t*)F.lds;
    LAS float* Yt = (LAS float*)(F.lds + 65536);
    const int ch = F.tid;
    float w[31];
#pragma unroll
    for (int j = 0; j < 31; ++j) w[j] = cw[j * 512 + ch];
    const float bias = cb[ch];
#define CONV_STAGE(tile_) do { const int b_ = (tile_) >> 9, t0_ = ((tile_) & 511) * 32; \
        _Pragma("unroll") for (int k_ = 0; k_ < 8; ++k_) { const int row_ = F.wave + 8 * k_; if (row_ < 62) { const int t_ = t0_ - 15 + row_; \
            if (t_ >= 0 && t_ < SEQ) __builtin_amdgcn_global_load_lds((const unsigned*)(Ab + ((size_t)(b_ * SEQ + t_)) * 512 + F.lane * 8), (LAS unsigned*)(At + row_ * 512), 16, 0, 0); \
            else { const unsigned z_ = (unsigned)F.kz; const u32x4 zv_ = {z_, z_, z_, z_}; *(LAS u32x4*)(At + row_ * 512 + F.lane * 8) = zv_; } } } } while (0)
    const f32x4 g0 = *(const f32x4*)(lg + 8 * F.lane), g1 = *(const f32x4*)(lg + 8 * F.lane + 4), b0 = *(const f32x4*)(lb + 8 * F.lane), b1 = *(const f32x4*)(lb + 8 * F.lane + 4);
    if (F.bx < T / 32) CONV_STAGE(F.bx);
    for (int tile = F.bx; tile < T / 32; tile += F.G) {
        const int b = tile >> 9, t0 = (tile & 511) * 32;
        asm volatile("s_waitcnt vmcnt(0)" ::: "memory");
        __syncthreads();
        float a[62];
#pragma unroll
        for (int r = 0; r < 62; ++r) a[r] = bf2f(At[r * 512 + ch]);
#pragma unroll
        for (int t = 0; t < 32; ++t) { float y = bias;
#pragma unroll
            for (int j = 0; j < 31; ++j) y = fmaf(a[t + j], w[j], y);
            Yt[t * 512 + ch] = y; }
        __syncthreads();
        if (tile + F.G < T / 32) CONV_STAGE(tile + F.G);
#pragma unroll
        for (int q = 0; q < 4; ++q) { const int t = F.wave * 4 + q; const LAS float* yr = Yt + t * 512 + 8 * F.lane;
            const f32x4 y0 = *(const LAS f32x4*)yr, y1 = *(const LAS f32x4*)(yr + 4);
            float s = (y0[0] + y0[1]) + (y0[2] + y0[3]) + (y1[0] + y1[1]) + (y1[2] + y1[3]);
            const float mean = wave_sum(s) * (1.0f / 512.0f);
            const f32x4 d0 = y0 - mean, d1 = y1 - mean;
            float q2 = (d0[0] * d0[0] + d0[1] * d0[1]) + (d0[2] * d0[2] + d0[3] * d0[3]) + (d1[0] * d1[0] + d1[1] * d1[1]) + (d1[2] * d1[2] + d1[3] * d1[3]);
            const float rstd = 1.0f / sqrtf(wave_sum(q2) * (1.0f / 512.0f) + LN_EPS);
            f32x4 o0 = d0 * rstd * g0 + b0, o1 = d1 * rstd * g1 + b1;
#pragma unroll
            for (int j = 0; j < 4; ++j) { o0[j] = silu_f(o0[j]); o1[j] = silu_f(o1[j]); }
            u32x2 wv; wv.x = pk4_fp8(o0[0], o0[1], o0[2], o0[3]); wv.y = pk4_fp8(o1[0], o1[1], o1[2], o1[3]);
            *(u32x2*)(MIX + (size_t)(b * SEQ + t0 + t) * 1024 + 8 * F.lane) = wv; }
        __syncthreads();
    }
#undef CONV_STAGE
}

namespace att {
constexpr int KVBLK = 64;
constexpr int SHM_V = 128 * 64, SHM_K = 64 * 64;
constexpr int SHM_1 = 32 * 64;
constexpr int NBUF = 5, DIST = 3, TILEB = SHM_V + SHM_1 + SHM_K;
constexpr int OFF_T = 0, OFF_WS = NBUF * TILEB;
constexpr int OFF_NEG = OFF_WS + 2048;
constexpr float PREF = 6.0f, PMAXLOG = 8.0f;
#define SBAR() __builtin_amdgcn_sched_barrier(0)
#define MX3(a, b, c) __builtin_fmaxf(__builtin_fmaxf((a), (b)), (c))
typedef int v8i32a __attribute__((ext_vector_type(8)));
__device__ __forceinline__ f32x16 mfma8(v8i32a a, v8i32a b, f32x16 c) { return __builtin_amdgcn_mfma_scale_f32_32x32x64_f8f6f4(a, b, c, 0, 0, 0, 0x7F7F7F7F, 0, 0x7F7F7F7F); }
template <bool FIRST> __device__ __forceinline__ void partialSM(f32x16& p0, f32x16& p1, f32x16& negm, float& alpha) {
    float a = MX3(p0[0], p0[1], p1[0]), b = MX3(p0[2], p0[3], p1[1]); a = MX3(a, p1[2], p1[3]);
#pragma unroll
    for (int r = 4; r < 16; r += 4) { a = MX3(a, p0[r], p0[r + 1]); b = MX3(b, p0[r + 2], p0[r + 3]); a = MX3(a, p1[r], p1[r + 1]); b = MX3(b, p1[r + 2], p1[r + 3]); }
    float pmax = fmaxf(a, b);
    { auto rr = __builtin_amdgcn_permlane32_swap(__float_as_uint(pmax), __float_as_uint(pmax), false, false);
      pmax = fmaxf(__uint_as_float(rr[0]), __uint_as_float(rr[1])); }
    alpha = 1.f;
    if (FIRST || __builtin_expect(__any(pmax > PMAXLOG), 0)) {
        const float dl = FIRST ? (pmax - PREF) : fmaxf(pmax - PREF, 0.f); const float nm = negm[0] - dl; alpha = __builtin_amdgcn_exp2f(-dl);
#pragma unroll
        for (int r = 0; r < 16; ++r) { p0[r] -= dl; p1[r] -= dl; negm[r] = nm; }
    }
#pragma unroll
    for (int r = 0; r < 16; ++r) p0[r] = __builtin_amdgcn_exp2f(p0[r]);
}
__device__ __forceinline__ void finishSM(f32x16& p0, f32x16& p1, v8i32a& pf) {
#pragma unroll
    for (int r = 0; r < 16; ++r) p1[r] = __builtin_amdgcn_exp2f(p1[r]);
#pragma unroll
    for (int i = 0; i < 4; ++i) { pf[i] = (int)pk4_fp8(p0[4 * i], p0[4 * i + 1], p0[4 * i + 2], p0[4 * i + 3]); pf[4 + i] = (int)pk4_fp8(p1[4 * i], p1[4 * i + 1], p1[4 * i + 2], p1[4 * i + 3]); }
}
__device__ __forceinline__ v8i32a frag32(const LAS unsigned char* base, int a0, int a1) {
    const bf16x8 lo = *(const LAS bf16x8*)(base + a0), hi = *(const LAS bf16x8*)(base + a1);
    return __builtin_bit_cast(v8i32a, __builtin_shufflevector(lo, hi, 0, 1, 2, 3, 4, 5, 6, 7, 8, 9, 10, 11, 12, 13, 14, 15));
}
__device__ __forceinline__ void attn_pass(const unsigned char* __restrict__ Qw, const unsigned char* __restrict__ Kh, const unsigned char* __restrict__ Vt, LAS unsigned char* lds, f32x16 (&o)[4], f32x16& lacc, const int tid, const int wid) {
    const int lane = tid & 63, r32 = lane & 31, hi = lane >> 5;
    LAS float* al_l = (LAS float*)(lds + OFF_WS) + wid * 64 + 32;
    f32x16 negm = f32x16{}; lacc = f32x16{};
#pragma unroll
    for (int d = 0; d < 4; ++d) o[d] = f32x16{};
    const v8i32a qf = __builtin_bit_cast(v8i32a, __builtin_shufflevector(*(const bf16x8*)Qw, *(const bf16x8*)(Qw + 16), 0, 1, 2, 3, 4, 5, 6, 7, 8, 9, 10, 11, 12, 13, 14, 15));
    const int sw = (r32 >> 2) & 3, a0 = r32 * 64 + (((2 * hi) ^ sw) << 4), a1 = r32 * 64 + (((2 * hi + 1) ^ sw) << 4);
    const int drow = 16 * wid + (lane >> 2), dch = (lane & 3) ^ ((drow >> 2) & 3);
    const unsigned vsrc = (unsigned)(drow * NKEY + dch * 16), ksrc = (unsigned)(drow * 512 + dch * 16); const bool kw = wid < 4;
    LAS unsigned char* T_lds = lds + OFF_T;
#define DMA(t, bi) do { __builtin_amdgcn_global_load_lds((const unsigned*)((const char*)Vt + (size_t)(t) * 64 + vsrc), (LAS unsigned*)(T_lds + (bi) * TILEB + wid * 1024), 16, 0, 0); \
    if (kw) __builtin_amdgcn_global_load_lds((const unsigned*)((const char*)Kh + (size_t)(t) * (64 * 512) + ksrc), (LAS unsigned*)(T_lds + (bi) * TILEB + SHM_V + SHM_1 + wid * 1024), 16, 0, 0); } while (0)
#define WAITBAR(n) do { if (kw) asm volatile("s_waitcnt vmcnt(%0) lgkmcnt(0)" :: "n"(2 * (n)) : "memory"); else asm volatile("s_waitcnt vmcnt(%0) lgkmcnt(0)" :: "n"(n) : "memory"); \
    __builtin_amdgcn_s_barrier(); asm volatile("" ::: "memory"); } while (0)
#define RESC(a) do { if (__any((a) < 1.f)) { if (hi == 0) al_l[r32] = (a); asm volatile("s_waitcnt lgkmcnt(0)" ::: "memory"); \
    _Pragma("unroll") for (int r = 0; r < 16; ++r) { const float f_ = al_l[crow(r, hi)]; o[0][r] *= f_; o[1][r] *= f_; o[2][r] *= f_; o[3][r] *= f_; lacc[r] *= f_; } } } while (0)
#define QKT(P0, P1, bi) do { const LAS unsigned char* kb_ = T_lds + (bi) * TILEB + SHM_V + SHM_1; P0 = mfma8(frag32(kb_, a0, a1), qf, negm); P1 = mfma8(frag32(kb_ + 2048, a0, a1), qf, negm); } while (0)
#ifndef MF8_ACC
#define MF8_ACC "+v"
#endif
#define MF8(acc_, v_) asm volatile("v_mfma_scale_f32_32x32x64_f8f6f4 %0, %1, %2, %0, %3, %3 op_sel_hi:[0,0,0]" : MF8_ACC(acc_) : "v"(pf), "v"(v_), "v"(one_sc))
#define PV(bi) do { const LAS unsigned char* vb_ = T_lds + (bi) * TILEB; { const v8i32a v0_ = frag32(vb_, a0, a1), v1_ = frag32(vb_ + 2048, a0, a1); asm volatile("s_nop 1" ::: ); MF8(o[0], v0_); MF8(o[1], v1_); } \
    { const v8i32a v2_ = frag32(vb_ + 4096, a0, a1), v3_ = frag32(vb_ + 6144, a0, a1); MF8(o[2], v2_); MF8(o[3], v3_); } \
    { const v8i32a v4_ = frag32(vb_ + 8192, a0, a1); MF8(lacc, v4_); } } while (0)
    f32x16 pA0, pA1, pB0, pB1; v8i32a pf; constexpr int NT = NKEY / KVBLK;
    const int one_sc = 0x7F7F7F7F;
#define MFQK(P_, kf_) P_ = mfma8(kf_, qf, negm)
#define EX8(P_, b_) do { _Pragma("unroll") for (int r_ = 0; r_ < 8; ++r_) P_[(b_) + r_] = __builtin_amdgcn_exp2f(P_[(b_) + r_]); } while (0)
#if defined(EXP_EXTRA_MFMA)
#define XMF() do { const v8i32a vn_ = frag32(lds + OFF_NEG, a0, a1); MF8(lacc, vn_); MF8(lacc, v4_); } while (0)
#else
#define XMF() do { } while (0)
#endif
#if defined(EXP_EXTRA_LDS)
#define XTRA(A_, B_) do { _Pragma("unroll") for (int r_ = 0; r_ < 5; ++r_) { const v8i32a t_ = frag32(vb_ + 2048 * r_, a0, a1); asm volatile("" :: "v"(t_)); } } while (0)
#elif defined(EXP_EXTRA_EXP)
#define XTRA(A_, B_) do { _Pragma("unroll") for (int r_ = 0; r_ < 16; ++r_) { float t_; asm volatile("v_exp_f32 %0, %1" : "=v"(t_) : "v"(A_[r_])); asm volatile("v_exp_f32 %0, %1" : "=v"(t_) : "v"(B_[r_])); } } while (0)
#elif defined(EXP_EXTRA_ADD)
#define XTRA(A_, B_) do { _Pragma("unroll") for (int r_ = 0; r_ < 16; ++r_) { float t_; asm volatile("v_add_f32 %0, %1, %1" : "=v"(t_) : "v"(A_[r_])); asm volatile("v_add_f32 %0, %1, %1" : "=v"(t_) : "v"(B_[r_])); } } while (0)
#else
#define XTRA(A_, B_) do { } while (0)
#endif
#define STEP(C0, C1, P0, P1, HAVEPREV, FIRSTT, tnext, dodma) do { \
    if (dodma) DMA(tnext, bd); \
    const LAS unsigned char* kb_ = T_lds + bc * TILEB + SHM_V + SHM_1; const LAS unsigned char* vb_ = T_lds + bp * TILEB; \
    const v8i32a kf0_ = frag32(kb_, a0, a1), kf1_ = frag32(kb_ + 2048, a0, a1); v8i32a v0_, v1_, v2_, v3_, v4_; if (HAVEPREV) { v0_ = frag32(vb_, a0, a1); v1_ = frag32(vb_ + 2048, a0, a1); } \
    SBAR(); MFQK(C0, kf0_); if (HAVEPREV) EX8(P1, 0); SBAR(); \
    MFQK(C1, kf1_); if (HAVEPREV) { EX8(P1, 8); _Pragma("unroll") for (int i_ = 0; i_ < 4; ++i_) { pf[i_] = (int)pk4_fp8(P0[4 * i_], P0[4 * i_ + 1], P0[4 * i_ + 2], P0[4 * i_ + 3]); pf[4 + i_] = (int)pk4_fp8(P1[4 * i_], P1[4 * i_ + 1], P1[4 * i_ + 2], P1[4 * i_ + 3]); } } SBAR(); \
    float al_ = 1.f; \
    if (HAVEPREV) { asm volatile("s_nop 1" ::: ); MF8(o[0], v0_); SBAR(); MF8(o[1], v1_); v2_ = frag32(vb_ + 4096, a0, a1); v3_ = frag32(vb_ + 6144, a0, a1); v4_ = frag32(vb_ + 8192, a0, a1); SBAR(); } \
    else { asm volatile("s_nop 15\n\ts_nop 15\n\ts_nop 15\n\ts_nop 15" ::: "memory"); }     \
    float mxa_ = MX3(C0[0], C0[1], C1[0]), mxb_ = MX3(C0[2], C0[3], C1[1]); mxa_ = MX3(mxa_, C1[2], C1[3]); \
    _Pragma("unroll") for (int r_ = 4; r_ < 16; r_ += 4) { mxa_ = MX3(mxa_, C0[r_], C0[r_ + 1]); mxb_ = MX3(mxb_, C0[r_ + 2], C0[r_ + 3]); mxa_ = MX3(mxa_, C1[r_], C1[r_ + 1]); mxb_ = MX3(mxb_, C1[r_ + 2], C1[r_ + 3]); } \
    float pm_ = fmaxf(mxa_, mxb_); { auto rr_ = __builtin_amdgcn_permlane32_swap(__float_as_uint(pm_), __float_as_uint(pm_), false, false); pm_ = fmaxf(__uint_as_float(rr_[0]), __uint_as_float(rr_[1])); } \
    SBAR(); \
    if (HAVEPREV) { MF8(o[2], v2_); SBAR(); MF8(o[3], v3_); SBAR(); } \
    if (FIRSTT || __builtin_expect(__any(pm_ > PMAXLOG), 0)) { const float dl_ = FIRSTT ? (pm_ - PREF) : fmaxf(pm_ - PREF, 0.f); const float nm_ = negm[0] - dl_; al_ = __builtin_amdgcn_exp2f(-dl_); \
        _Pragma("unroll") for (int r_ = 0; r_ < 16; ++r_) { C0[r_] -= dl_; C1[r_] -= dl_; negm[r_] = nm_; } } \
    SBAR(); \
    if (HAVEPREV) { MF8(lacc, v4_); XMF(); SBAR(); } \
    EX8(C0, 0); EX8(C0, 8); XTRA(C0, C1); SBAR(); \
    if (HAVEPREV) { if (__any(al_ < 1.f)) { asm volatile("s_nop 15\n\ts_nop 15" ::: "memory"); if (hi == 0) al_l[r32] = al_; asm volatile("s_waitcnt lgkmcnt(0)" ::: "memory"); \
        _Pragma("unroll") for (int r_ = 0; r_ < 16; ++r_) { const float f_ = al_l[crow(r_, hi)]; o[0][r_] *= f_; o[1][r_] *= f_; o[2][r_] *= f_; o[3][r_] *= f_; lacc[r_] *= f_; } } } \
    } while (0)
    int bp = 4, bc = 0, bd = 3;
#define ROT() do { bp = bc; bc = (bc == NBUF - 1) ? 0 : bc + 1; bd = (bd == NBUF - 1) ? 0 : bd + 1; } while (0)
#ifdef EXP_EXTRA_BAR
#define XBAR() do { __builtin_amdgcn_s_barrier(); asm volatile("" ::: "memory"); } while (0)
#else
#define XBAR() do { } while (0)
#endif
    DMA(0, 0); DMA(1, 1); DMA(2, 2); WAITBAR(2);
    STEP(pA0, pA1, pB0, pB1, false, true, 3, true); WAITBAR(2); ROT();
#pragma unroll 1
    for (int j = 1; j + 1 < NT; j += 2) {
        const bool more = (j + 4 < NT);
        STEP(pB0, pB1, pA0, pA1, true, false, j + 3, more); if (more) WAITBAR(2); else WAITBAR(0); XBAR(); ROT();
        STEP(pA0, pA1, pB0, pB1, true, false, j + 4, more); if (more) WAITBAR(2); else WAITBAR(0); XBAR(); ROT();
    }
    STEP(pB0, pB1, pA0, pA1, true, false, 0, false); WAITBAR(0); ROT();
    { EX8(pB1, 0); EX8(pB1, 8);
#pragma unroll
      for (int i_ = 0; i_ < 4; ++i_) { pf[i_] = (int)pk4_fp8(pB0[4 * i_], pB0[4 * i_ + 1], pB0[4 * i_ + 2], pB0[4 * i_ + 3]); pf[4 + i_] = (int)pk4_fp8(pB1[4 * i_], pB1[4 * i_ + 1], pB1[4 * i_ + 2], pB1[4 * i_ + 3]); }
      SBAR(); PV(bp); }
#undef STEP
#undef MFQK
#undef EX8
    __syncthreads();
#undef ROT
#undef DMA
#undef WAITBAR
#undef RESC
#undef QKT
#undef PV
#undef MF8
}
}

__device__ __forceinline__ void ph4_attention(Frame& F) {
    const unsigned char* Q8 = (const unsigned char*)(KWS(F) + WS_Q); const unsigned char* K8 = (const unsigned char*)(KWS(F) + WS_K); const unsigned char* V8T = (const unsigned char*)(KWS(F) + WS_V);
    float* O0 = (float*)(KWS(F) + WS_O0); unsigned char* MIX = (unsigned char*)(KWS(F) + WS_MIX); const float* gn = KIN(F, 20);
    const int lane = F.lane, wid = F.wave;
    float lam;
    { const float a = wave_sum(KIN(F, 16)[lane] * KIN(F, 17)[lane]), b = wave_sum(KIN(F, 18)[lane] * KIN(F, 19)[lane]); lam = __builtin_bit_cast(float, __builtin_amdgcn_readfirstlane(__builtin_bit_cast(int, __expf(a) - __expf(b) + LAM_INIT0))); }
    __syncthreads();
    const unsigned kz_ = (unsigned)F.kz;
    for (int i = F.tid; i < att::NBUF * (att::SHM_1 / 16); i += NTHR) { const int bi = i / (att::SHM_1 / 16), q = i % (att::SHM_1 / 16);
        *(LAS u32x4*)(F.lds + att::OFF_T + bi * att::TILEB + att::SHM_V + q * 16) = (u32x4){0x38383838u + kz_, 0x38383838u + kz_, 0x38383838u + kz_, 0x38383838u + kz_}; }
#if defined(EXP_EXTRA_MFMA)
    for (int i = F.tid; i < 128; i += NTHR) *(LAS u32x4*)(F.lds + att::OFF_NEG + i * 16) = (u32x4){0xB8B8B8B8u + kz_, 0xB8B8B8B8u + kz_, 0xB8B8B8B8u + kz_, 0xB8B8B8B8u + kz_};
#endif
    __syncthreads();
    const int x = F.bx & 7, jb = F.bx >> 3;
    for (int vb = x; vb < 8; vb += 8) { const int b = vb >> 2, h = vb & 3;
    for (int qb = jb; qb < SEQ / 256; qb += (F.G >> 3)) {
        const long rowbase = (long)b * SEQ + qb * 256 + wid * 32;
        f32x16 o[4]; f32x16 lacc;
#pragma unroll 1
        for (int c = 0; c < 2; ++c) {
            const unsigned char* Qw = Q8 + (rowbase + (lane & 31)) * 512 + h * 128 + c * 64 + (lane >> 5) * 32;
            const unsigned char* Kh = K8 + (long)b * NKEY * 512 + h * 128 + c * 64;
            const unsigned char* Vt = V8T + (long)(b * 4 + h) * 128 * NKEY;
            att::attn_pass(Qw, Kh, Vt, F.lds, o, lacc, F.tid, F.wave);
            int lane_e = lane; asm volatile("" : "+v"(lane_e));
            const int r32 = lane_e & 31, hi = lane_e >> 5;
            asm volatile("s_nop 15\n\ts_nop 15" : "+v"(lacc));
            float rli[16];
#pragma unroll
            for (int r = 0; r < 16; ++r) rli[r] = __builtin_amdgcn_rcpf(lacc[r]);
            if (c == 0) {
#pragma unroll
                for (int r = 0; r < 16; ++r) { const long grow = rowbase + crow(r, hi);
#pragma unroll
                    for (int d0 = 0; d0 < 4; ++d0) O0[grow * 512 + h * 128 + d0 * 32 + r32] = o[d0][r] * rli[r]; }
            } else {
                const float g0 = gn[r32], g1 = gn[32 + r32], g2 = gn[64 + r32], g3 = gn[96 + r32];
                float ov[16][4];
#pragma unroll
                for (int r = 0; r < 16; ++r) { const float* op = O0 + (rowbase + crow(r, hi)) * 512 + h * 128 + r32; ov[r][0] = op[0]; ov[r][1] = op[32]; ov[r][2] = op[64]; ov[r][3] = op[96]; }
                asm volatile("" ::: "memory");
#pragma unroll
                for (int r = 0; r < 16; ++r) { const long grow = rowbase + crow(r, hi);
                    const float v0 = ov[r][0] - lam * (o[0][r] * rli[r]), v1 = ov[r][1] - lam * (o[1][r] * rli[r]), v2 = ov[r][2] - lam * (o[2][r] * rli[r]), v3 = ov[r][3] - lam * (o[3][r] * rli[r]);
                    float ss = (v0 * v0 + v1 * v1) + (v2 * v2 + v3 * v3);
                    ss = half_sum(ss);
                    const float scl = (1.0f - LAM_INIT0) / sqrtf(ss * (1.0f / 128.0f) + LN_EPS);
                    unsigned char* mp = MIX + grow * 1024 + 512 + h * 128 + r32;
                    mp[0] = f2fp8(v0 * scl * g0); mp[32] = f2fp8(v1 * scl * g1); mp[64] = f2fp8(v2 * scl * g2); mp[96] = f2fp8(v3 * scl * g3);
                    if ((r & 3) == 3) asm volatile("" ::: "memory"); }
            }
        }
    } }
}

__device__ __forceinline__ void ph_router(Frame& F, int layer, const float* hin) {
    const float* mod = (const float*)(KWS(F) + WS_MOD) + (size_t)(layer * 3) * 6144;
    const bf16_t* Y = (const bf16_t*)(KWS(F) + WS_Y); float* H1 = (float*)(KWS(F) + WS_H1); unsigned char* U2 = (unsigned char*)(KWS(F) + WS_U2);
    const float* lng = KIN(F, 6) + layer * DM; const float* lnb = KIN(F, 7) + layer * DM;
    const float* rw = KIN(F, 29) + (size_t)layer * DM * NE; const float* rb = KIN(F, 30) + layer * NE;
    unsigned* gcnt = (unsigned*)(KWS(F) + WS_CTL) + CW_CNT + layer * NE;
    unsigned* list = (unsigned*)(KWS(F) + WS_LIST); float* gates = (float*)(KWS(F) + WS_GATES);
    constexpr int RWS = 1028, RSEL = 131584, RVEC = RSEL + 10240;
    LAS float* rwT = (LAS float*)F.lds;
    LAS int* sel_e = (LAS int*)(F.lds + RSEL);
    LAS float* sel_g = (LAS float*)(F.lds + RSEL + 2048);
    LAS unsigned* lcnt = (LAS unsigned*)(F.lds + RSEL + 4096);
    LAS unsigned* lbase = lcnt + 32;
    LAS unsigned* lpos = lcnt + 64;
    LAS float* vG = (LAS float*)(F.lds + RVEC);
    const int lane = F.lane;
    for (int i = F.tid; i < DM * NE; i += NTHR) { const int d = i >> 5, e = i & 31; rwT[e * RWS + d] = rw[i]; }
    __syncthreads();
    for (int blk = F.bx; blk < T / 128; blk += F.G) {
        const int r0 = blk * 128, b = r0 >> 14;
        const float* g1 = mod + b * 6144 + 2048; const float* sh2 = mod + b * 6144 + 3072; const float* sc2 = mod + b * 6144 + 4096;
        if (F.tid < 32) lcnt[F.tid] = 0u;
        for (int i = F.tid; i < DM; i += NTHR) { vG[i] = g1[i]; vG[DM + i] = lng[i]; vG[2 * DM + i] = lnb[i]; vG[3 * DM + i] = sc2[i] + 1.0f; vG[4 * DM + i] = sh2[i]; }
        __syncthreads();
        f32x4 nx[2][4]; u32x2 ny[2][4];
#pragma unroll
        for (int t = 0; t < 2; ++t)
#pragma unroll
            for (int j = 0; j < 4; ++j) { const int d = 4 * lane + 256 * j; const size_t rr = (size_t)(r0 + F.wave * 16 + t); nx[t][j] = *(const f32x4*)(hin + rr * DM + d); ny[t][j] = *(const u32x2*)(Y + rr * DM + d); }
        for (int qq = 0; qq < 8; ++qq) {
            int lane4 = 4 * lane; asm volatile("" : "+v"(lane4));
            const int tl0 = F.wave * 16 + 2 * qq;
            f32x4 pre[2][4]; float s1[2] = {0.f, 0.f}, s2[2] = {0.f, 0.f};
#pragma unroll
            for (int t = 0; t < 2; ++t)
#pragma unroll
                for (int j = 0; j < 4; ++j) { const int d = lane4 + 256 * j; const f32x4 x = nx[t][j]; const u32x2 yw = ny[t][j]; const f32x4 g = *(const LAS f32x4*)(vG + d);
                    f32x4 y; y[0] = __uint_as_float(yw.x << 16); y[1] = __uint_as_float(yw.x & 0xffff0000u); y[2] = __uint_as_float(yw.y << 16); y[3] = __uint_as_float(yw.y & 0xffff0000u);
                    const f32x4 p_ = x * ALPHA + g * y; pre[t][j] = p_; s1[t] += (p_[0] + p_[1]) + (p_[2] + p_[3]); s2[t] += (p_[0] * p_[0] + p_[1] * p_[1]) + (p_[2] * p_[2] + p_[3] * p_[3]); }
            if (qq + 1 < 8) {
#pragma unroll
                for (int t = 0; t < 2; ++t)
#pragma unroll
                    for (int j = 0; j < 4; ++j) { const int d = lane4 + 256 * j; const size_t rr = (size_t)(r0 + tl0 + 2 + t); nx[t][j] = *(const f32x4*)(hin + rr * DM + d); ny[t][j] = *(const u32x2*)(Y + rr * DM + d); } }
            s1[0] = wave_sum(s1[0]); s1[1] = wave_sum(s1[1]); s2[0] = wave_sum(s2[0]); s2[1] = wave_sum(s2[1]);
            f32x4 u2[2][4];
#pragma unroll
            for (int t = 0; t < 2; ++t) { const float mean = s1[t] * (1.0f / DM); const float var = fmaxf(s2[t] * (1.0f / DM) - mean * mean, 0.f); const float rstd = 1.0f / sqrtf(var + LN_EPS); const size_t row = (size_t)(r0 + tl0 + t);
#pragma unroll
                for (int j = 0; j < 4; ++j) { const int d = lane4 + 256 * j; const f32x4 h = (pre[t][j] - mean) * rstd * *(const LAS f32x4*)(vG + DM + d) + *(const LAS f32x4*)(vG + 2 * DM + d);
                    *(f32x4*)(H1 + row * DM + d) = h;
                    u2[t][j] = h * *(const LAS f32x4*)(vG + 3 * DM + d) + *(const LAS f32x4*)(vG + 4 * DM + d);
                    *(unsigned*)(U2 + row * DM + d) = pk4_fp8(u2[t][j][0], u2[t][j][1], u2[t][j][2], u2[t][j][3]); } }
            f32x2 up[4][4];
#pragma unroll
            for (int j = 0; j < 4; ++j)
#pragma unroll
                for (int i = 0; i < 4; ++i) { up[j][i][0] = u2[0][j][i]; up[j][i][1] = u2[1][j][i]; }
            f32x2 P[32];
            f32x4 wc[4], wn[4];
#pragma unroll
            for (int j = 0; j < 4; ++j) wc[j] = *(const LAS f32x4*)(rwT + 4 * lane + 256 * j);
#pragma unroll
            for (int e = 0; e < 32; ++e) {
                if (e + 1 < 32) {
#pragma unroll
                    for (int j = 0; j < 4; ++j) wn[j] = *(const LAS f32x4*)(rwT + (e + 1) * RWS + 4 * lane + 256 * j); }
                f32x2 a0 = {0.f, 0.f}, a1 = {0.f, 0.f};
#pragma unroll
                for (int j = 0; j < 4; ++j) { f32x2 w0 = {wc[j][0], wc[j][0]}, w1 = {wc[j][1], wc[j][1]}, w2 = {wc[j][2], wc[j][2]}, w3 = {wc[j][3], wc[j][3]};
                    a0 = __builtin_elementwise_fma(up[j][0], w0, a0); a1 = __builtin_elementwise_fma(up[j][1], w1, a1); a0 = __builtin_elementwise_fma(up[j][2], w2, a0); a1 = __builtin_elementwise_fma(up[j][3], w3, a1); }
                P[e] = a0 + a1;
#pragma unroll
                for (int j = 0; j < 4; ++j) wc[j] = wn[j];
                if ((e & 3) == 3) __builtin_amdgcn_sched_barrier(0); }
#define RSTEP(N, MASK, CTRL) do { _Pragma("unroll") for (int i = 0; i < (N); ++i) { int lm_ = lane & (MASK); asm volatile("" : "+v"(lm_)); const bool up_ = lm_ != 0;     \
                const f32x2 sv = up_ ? P[i] : P[i + (N)], kv = up_ ? P[i + (N)] : P[i]; f32x2 rv; rv[0] = dpp_f<CTRL>(sv[0]); rv[1] = dpp_f<CTRL>(sv[1]); P[i] = kv + rv; } } while (0)
#define RSWAP(N, SWAPFN) do { _Pragma("unroll") for (int i = 0; i < (N); ++i) { _Pragma("unroll") for (int c_ = 0; c_ < 2; ++c_) { \
                const auto r_ = SWAPFN(__float_as_uint(P[i][c_]), __float_as_uint(P[i + (N)][c_]), false, false); P[i][c_] = __uint_as_float(r_[0]) + __uint_as_float(r_[1]); } } } while (0)
            RSWAP(16, __builtin_amdgcn_permlane32_swap); RSWAP(8, __builtin_amdgcn_permlane16_swap);
#undef RSWAP
            RSTEP(4, 8, 0x140); RSTEP(2, 4, 0x141); RSTEP(1, 2, 0x4E);
#undef RSTEP
            const int me = lane >> 1; const float rbv = rb[me];
            float lgs[2]; lgs[0] = P[0][0] + dpp_f<0xB1>(P[0][0]) + rbv; lgs[1] = P[0][1] + dpp_f<0xB1>(P[0][1]) + rbv;
            LAS float* lgbuf = (LAS float*)(F.lds + RSEL + 8192) + F.wave * 64;
            if ((lane & 1) == 0) { lgbuf[me] = lgs[0]; lgbuf[32 + me] = lgs[1]; }
            asm volatile("s_waitcnt lgkmcnt(0)" ::: "memory");
#pragma unroll
            for (int t = 0; t < 2; ++t) { const float mine = lgs[t]; int rank = 0;
#pragma unroll
                for (int e4 = 0; e4 < 8; ++e4) { const f32x4 v = *(const LAS f32x4*)(lgbuf + 32 * t + 4 * e4);
#pragma unroll
                    for (int i = 0; i < 4; ++i) { const int e = 4 * e4 + i; rank += (v[i] > mine || (v[i] == mine && e < me)) ? 1 : 0; } }
                float ls[4]; int es[4];
#pragma unroll
                for (int k = 0; k < 4; ++k) { const unsigned long long bal = __ballot(rank == k); const int first = __ffsll((long long)bal) - 1; es[k] = first >> 1; ls[k] = lgbuf[32 * t + es[k]]; }
                const float e1 = __expf(ls[1] - ls[0]), e2 = __expf(ls[2] - ls[0]), e3 = __expf(ls[3] - ls[0]); const float inv = 1.0f / (1.0f + e1 + e2 + e3);
                const int tl = tl0 + t;
                if (lane == 0) { sel_e[tl * 4 + 0] = es[0]; sel_e[tl * 4 + 1] = es[1]; sel_e[tl * 4 + 2] = es[2]; sel_e[tl * 4 + 3] = es[3];
                    sel_g[tl * 4 + 0] = inv; sel_g[tl * 4 + 1] = e1 * inv; sel_g[tl * 4 + 2] = e2 * inv; sel_g[tl * 4 + 3] = e3 * inv; } }
        }
        __syncthreads();
        const int myE = sel_e[F.tid];
        lpos[F.tid] = __hip_atomic_fetch_add(&lcnt[myE], 1u, __ATOMIC_RELAXED, __HIP_MEMORY_SCOPE_WORKGROUP);
        __syncthreads();
        if (F.tid < 32) lbase[F.tid] = atomicAdd(&gcnt[F.tid], lcnt[F.tid]);
        __syncthreads();
        { const unsigned slot = (unsigned)(r0 * 4 + F.tid); list[(size_t)myE * CAP + lbase[myE] + lpos[F.tid]] = slot; gates[slot] = sel_g[F.tid]; }
        __syncthreads();
    }
}

struct MoeOrder {
    const LAS int* meta;
    const unsigned* list; int c, G, ncol, rpx;
    __device__ bool next(int i, pg8::Unit& u) const {
        const int x = c & 7, j = c >> 3; const int g = (i * 8 + x) * rpx + j / ncol; const int total = meta[32];
        if (g >= total) return false;
        const int ln_ = (int)__builtin_amdgcn_mbcnt_hi(~0u, __builtin_amdgcn_mbcnt_lo(~0u, 0u)) & 31;
        const int e = __popc((unsigned)__ballot(meta[ln_ + 1] <= g));
        const int rt = g - meta[e], cnt = meta[64 + e];
        u.pm = g; u.pn = e * ncol + (j % ncol); u.a0 = e; u.a1 = rt; u.a2 = min(256, cnt - rt * 256); return true;
    }
    __device__ __forceinline__ unsigned arow(const pg8::Unit& u, int R) const { return (R < u.a2) ? (list[(size_t)u.a0 * CAP + u.a1 * 256 + R] >> 2) : 0u; }
    __device__ __forceinline__ unsigned rowval(const pg8::Unit& u, int R, unsigned v) const { return (R < u.a2) ? (v >> 2) : 0u; }
    __device__ __forceinline__ const unsigned* rows_ptr(const pg8::Unit& u) const { return list + (size_t)u.a0 * CAP + u.a1 * 256; }
};
__device__ __forceinline__ void moe_meta(Frame& F, int layer) {
    LAS int* meta = (LAS int*)(F.lds + META_OFF);
    const unsigned* gcnt = (const unsigned*)(KWS(F) + WS_CTL) + CW_CNT + layer * NE;
    if (F.tid < NE) { const int c = (int)__hip_atomic_load(&gcnt[F.tid], __ATOMIC_RELAXED, __HIP_MEMORY_SCOPE_AGENT); meta[64 + F.tid] = c; meta[96 + F.tid] = (c + 255) >> 8; }
    __syncthreads();
    if (F.tid <= NE) { int acc = 0;
#pragma unroll
        for (int e = 0; e < NE; ++e) { const int t = meta[96 + e]; acc += (e < F.tid) ? t : 0; }
        meta[F.tid] = acc; }
    __syncthreads();
}
struct EpiGU {
    static constexpr bool PERM = true, HAS_PRE = true;
    unsigned char* ACT; const float* bgu;
    __device__ __forceinline__ void pre(LAS unsigned char* dst, const pg8::Unit& u, int wid, int lane) const {
        if (wid == 1) { const int e = u.a0, pnl = u.pn - e * 8; const float* src = bgu + e * 2048 + (lane >> 5) * 1024 + pnl * 128 + (lane & 31) * 4;
            __builtin_amdgcn_global_load_lds((const unsigned*)src, (LAS unsigned*)dst, 16, 0, 0); } }
    __device__ __forceinline__ void operator()(const f32x4 (&acc)[2][2][4][2], const pg8::Unit& u, int wr, int wc, int fr, int fq, const LAS unsigned char* pre_) const {
        const int e = u.a0, pnl = u.pn - e * 8; const int lcol = wc * 32 + 8 * fq, ccol = pnl * 128 + lcol; const int row0 = u.pm * 256 + wr * 64 + fr;
        f32x2 bg[2][2], bl[2][2];
#pragma unroll
        for (int n = 0; n < 2; ++n) { const f32x4 g4 = *(const LAS f32x4*)(pre_ + (lcol + 4 * n) * 4), l4 = *(const LAS f32x4*)(pre_ + 512 + (lcol + 4 * n) * 4);
            bg[n][0] = (f32x2){g4[0], g4[1]}; bg[n][1] = (f32x2){g4[2], g4[3]}; bl[n][0] = (f32x2){l4[0] + 1.0f, l4[1] + 1.0f}; bl[n][1] = (f32x2){l4[2] + 1.0f, l4[3] + 1.0f}; }
        const f32x2 s2 = {1.0f / WGU_SCALE, 1.0f / WGU_SCALE}, c2 = {-1.702f * 1.4426950408889634f, -1.702f * 1.4426950408889634f}, one2 = {1.0f, 1.0f};
#pragma unroll
        for (int ai = 0; ai < 2; ++ai)
#pragma unroll
            for (int m = 0; m < 4; ++m) { unsigned char* rowp = ACT + (size_t)(row0 + ai * 128 + m * 16) * 1024 + ccol; f32x2 o[2][2];
#pragma unroll
                for (int n = 0; n < 2; ++n)
#pragma unroll
                    for (int h = 0; h < 2; ++h) { const f32x4 A4 = acc[ai][0][m][n], L4 = acc[ai][1][m][n];
                        f32x2 gv = __builtin_elementwise_fma((f32x2){A4[2 * h], A4[2 * h + 1]}, s2, bg[n][h]), lv = __builtin_elementwise_fma((f32x2){L4[2 * h], L4[2 * h + 1]}, s2, bl[n][h]);
                        gv[0] = fminf(gv[0], 7.0f); gv[1] = fminf(gv[1], 7.0f);
                        lv[0] = __builtin_amdgcn_fmed3f(lv[0], -6.0f, 8.0f); lv[1] = __builtin_amdgcn_fmed3f(lv[1], -6.0f, 8.0f);
                        const f32x2 t = gv * c2; f32x2 d = {__builtin_amdgcn_exp2f(t[0]), __builtin_amdgcn_exp2f(t[1])}; d = d + one2;
                        const f32x2 r = {__builtin_amdgcn_rcpf(d[0]), __builtin_amdgcn_rcpf(d[1])};
                        o[n][h] = gv * r * lv; }
                u32x2 w; w.x = pk4_fp8(o[0][0][0], o[0][0][1], o[0][1][0], o[0][1][1]); w.y = pk4_fp8(o[1][0][0], o[1][0][1], o[1][1][0], o[1][1][1]);
                *(u32x2*)rowp = w; }
    }
};
struct EpiDown {
    static constexpr bool PERM = true, HAS_PRE = true;
    unsigned char* YB; const float* bd; const unsigned* list;
    __device__ __forceinline__ void pre(LAS unsigned char* dst, const pg8::Unit& u, int wid, int lane) const {
        const int e = u.a0, rt = u.a1, pnl = u.pn - e * 4;
        if (wid == 1) __builtin_amdgcn_global_load_lds((const unsigned*)(bd + e * 1024 + pnl * 256 + lane * 4), (LAS unsigned*)dst, 16, 0, 0);
        if (wid == 2) __builtin_amdgcn_global_load_lds((const unsigned*)(list + (size_t)e * CAP + rt * 256 + lane * 4), (LAS unsigned*)(dst + 1024), 16, 0, 0); }
    __device__ __forceinline__ void operator()(const f32x4 (&acc)[2][2][4][2], const pg8::Unit& u, int wr, int wc, int fr, int fq, const LAS unsigned char* pre_) const {
        const int e = u.a0, pnl = u.pn - e * 4; const int lcol = wc * 32 + 8 * fq, col = pnl * 256 + lcol;
        f32x4 bv[2][2];
#pragma unroll
        for (int bj = 0; bj < 2; ++bj)
#pragma unroll
            for (int n = 0; n < 2; ++n) bv[bj][n] = *(const LAS f32x4*)(pre_ + (lcol + bj * 128 + 4 * n) * 4);
#pragma unroll
        for (int ai = 0; ai < 2; ++ai)
#pragma unroll
            for (int m = 0; m < 4; ++m) { const int R = ai * 128 + wr * 64 + m * 16 + fr; if (R >= u.a2) continue;
                const unsigned slot = *(const LAS unsigned*)(pre_ + 1024 + R * 4); unsigned char* rowp = YB + (size_t)slot * 1024 + col;
#pragma unroll
                for (int bj = 0; bj < 2; ++bj) { const f32x4 v0 = acc[ai][bj][m][0] * (1.0f / WD_SCALE) + bv[bj][0], v1 = acc[ai][bj][m][1] * (1.0f / WD_SCALE) + bv[bj][1];
                    u32x2 w; w.x = pk4_fp8(v0[0], v0[1], v0[2], v0[3]); w.y = pk4_fp8(v1[0], v1[1], v1[2], v1[3]);
                    *(u32x2*)(rowp + bj * 128) = w; } }
    }
};

__device__ __forceinline__ void ph_combine(Frame& F, int layer, float* hout, bool next_mod) {
    const float* mod = (const float*)(KWS(F) + WS_MOD) + (size_t)(layer * 3) * 6144;
    const float* modn = (const float*)(KWS(F) + WS_MOD) + (size_t)3 * 6144;
    const float* H1 = (const float*)(KWS(F) + WS_H1); const unsigned char* YB = (const unsigned char*)(KWS(F) + WS_YB); const float* gates = (const float*)(KWS(F) + WS_GATES);
    const float* lng = KIN(F, 8) + layer * DM; const float* lnb = KIN(F, 9) + layer * DM; unsigned char* U = (unsigned char*)(KWS(F) + WS_U);
    const int gw = F.bx * NWAVES + F.wave, NGW = F.G * NWAVES, lane = F.lane;
    LAS float* vC = (LAS float*)F.lds;
    for (int i = F.tid; i < 2 * DM; i += NTHR) { const int b = i >> 10, d = i & (DM - 1); LAS float* v = vC + b * 5 * DM + d;
        v[0] = mod[b * 6144 + 5120 + d]; v[DM] = lng[d]; v[2 * DM] = lnb[d]; v[3 * DM] = modn[b * 6144 + 1024 + d] + 1.0f; v[4 * DM] = modn[b * 6144 + d]; }
    __syncthreads();
    f32x4 nh[4]; unsigned nyb[4][4]; f32x4 ngt;
#define CMB_LOAD(r_) do { _Pragma("unroll") for (int j = 0; j < 4; ++j) { const int d = 4 * lane + 256 * j; nh[j] = *(const f32x4*)(H1 + (size_t)(r_) * DM + d); \
        _Pragma("unroll") for (int k = 0; k < 4; ++k) nyb[j][k] = *(const unsigned*)(YB + ((size_t)(r_) * 4 + k) * DM + d); } ngt = *(const f32x4*)(gates + (size_t)(r_) * 4); } while (0)
    if (gw < T) CMB_LOAD(gw);
    for (int row = gw; row < T; row += NGW) {
        int vb = (row >> 14) * 5 * DM + 4 * lane; asm volatile("" : "+v"(vb));
        const LAS float* vr = vC + vb;
        f32x4 ch[4]; unsigned cyb[4][4]; const f32x4 gt = ngt;
#pragma unroll
        for (int j = 0; j < 4; ++j) { ch[j] = nh[j];
#pragma unroll
            for (int k = 0; k < 4; ++k) cyb[j][k] = nyb[j][k]; }
        if (row + NGW < T) CMB_LOAD(row + NGW);
        f32x4 pre[4]; float s = 0.f;
#pragma unroll
        for (int j = 0; j < 4; ++j) { f32x4 y = {0.f, 0.f, 0.f, 0.f};
#pragma unroll
            for (int k = 0; k < 4; ++k) { const unsigned yw = cyb[j][k]; const f32x2 lo = __builtin_amdgcn_cvt_pk_f32_fp8((int)yw, false), hi2 = __builtin_amdgcn_cvt_pk_f32_fp8((int)yw, true);
                const f32x4 v = {lo[0], lo[1], hi2[0], hi2[1]};
                y += v * gt[k]; }
            pre[j] = ch[j] * ALPHA + *(const LAS f32x4*)(vr + 256 * j) * y; s += (pre[j][0] + pre[j][1]) + (pre[j][2] + pre[j][3]); }
        const float mean = wave_sum(s) * (1.0f / DM); float q2 = 0.f;
#pragma unroll
        for (int j = 0; j < 4; ++j) { pre[j] = pre[j] - mean; q2 += (pre[j][0] * pre[j][0] + pre[j][1] * pre[j][1]) + (pre[j][2] * pre[j][2] + pre[j][3] * pre[j][3]); }
        const float rstd = 1.0f / sqrtf(wave_sum(q2) * (1.0f / DM) + LN_EPS);
#pragma unroll
        for (int j = 0; j < 4; ++j) { const int d = 4 * lane + 256 * j; const f32x4 h = pre[j] * rstd * *(const LAS f32x4*)(vr + DM + 256 * j) + *(const LAS f32x4*)(vr + 2 * DM + 256 * j);
            *(f32x4*)(hout + (size_t)row * DM + d) = h;
            if (next_mod) { const f32x4 v = h * *(const LAS f32x4*)(vr + 3 * DM + 256 * j) + *(const LAS f32x4*)(vr + 4 * DM + 256 * j);
                *(unsigned*)(U + (size_t)row * DM + d) = pk4_fp8(v[0], v[1], v[2], v[3]); } }
    }
#undef CMB_LOAD
}

__device__ __forceinline__ void ph_gmlp(Frame& F) {
    const bf16_t* Z = (const bf16_t*)(KWS(F) + WS_ZODD); unsigned char* MIX = (unsigned char*)(KWS(F) + WS_MIX);
    const float* lg = KIN(F, 23); const float* lb = KIN(F, 24); const float* bs = KIN(F, 26); const bf16_t* wsb = (const bf16_t*)(KWS(F) + WS_TAB + TB_WS);
    const int lane = F.lane, r32 = lane & 31, hi = lane >> 5, wid = F.wave;
    for (int chunk = F.bx; chunk < T / 128; chunk += F.G) {
        const int r0 = chunk * 128;
        for (int qq = 0; qq < 16; ++qq) { const int q = wid * 16 + qq; const bf16x8 raw = *(const bf16x8*)(Z + (size_t)(r0 + q) * 1536 + 512 + 8 * lane);
            float v[8]; float s = 0.f;
#pragma unroll
            for (int j = 0; j < 8; ++j) { v[j] = bf2f((unsigned short)raw[j]); s += v[j]; }
            const float mean = wave_sum(s) * (1.0f / 512.0f); float q2 = 0.f;
#pragma unroll
            for (int j = 0; j < 8; ++j) { v[j] -= mean; q2 += v[j] * v[j]; }
            const float rstd = 1.0f / sqrtf(wave_sum(q2) * (1.0f / 512.0f) + LN_EPS);
            const f32x4 g0 = *(const f32x4*)(lg + 8 * lane), g1 = *(const f32x4*)(lg + 8 * lane + 4), b0 = *(const f32x4*)(lb + 8 * lane), b1 = *(const f32x4*)(lb + 8 * lane + 4);
            u32x4 w; w.x = pk2(v[0] * rstd * g0[0] + b0[0], v[1] * rstd * g0[1] + b0[1]); w.y = pk2(v[2] * rstd * g0[2] + b0[2], v[3] * rstd * g0[3] + b0[3]);
            w.z = pk2(v[4] * rstd * g1[0] + b1[0], v[5] * rstd * g1[1] + b1[1]); w.w = pk2(v[6] * rstd * g1[2] + b1[2], v[7] * rstd * g1[3] + b1[3]);
            const int ch = 8 * lane, g = ch >> 7, col = ch & 127, kt = (q >> 6) * 4 + g;
            *(LAS u32x4*)(F.lds + kt * 16384 + v_st(q & 63, col)) = w; }
        __syncthreads();
        const int pb = wid & 3, gh = wid >> 2;
#pragma unroll 1
        for (int gi = 0; gi < 2; ++gi) { const int g = 2 * gh + gi;
            unsigned wofs = (unsigned)(((g * 128 + 32 * pb + r32) * 128 + 8 * hi) * 2); asm volatile("" : "+v"(wofs));
            f32x16 acc[4];
#pragma unroll
            for (int d0 = 0; d0 < 4; ++d0) acc[d0] = f32x16{};
            bf16x8 af[8];
#pragma unroll
            for (int ks = 0; ks < 8; ++ks) af[ks] = *(const bf16x8*)((const char*)wsb + wofs + 32 * ks);
#pragma unroll
            for (int ks = 0; ks < 8; ++ks) {
                LAS unsigned char* trd = F.lds + ((ks >> 2) * 4 + g) * 16384 + v_rd_base(lane);
#pragma unroll
                for (int d0 = 0; d0 < 4; ++d0) acc[d0] = __builtin_amdgcn_mfma_f32_32x32x16_bf16(af[ks], vfrag(trd, d0, ks & 3), acc[d0], 0, 0, 0); }
            unsigned short uraw[16][4]; float bias[16];
#pragma unroll
            for (int r = 0; r < 16; ++r) { const int p = 32 * pb + crow(r, hi); bias[r] = bs[g * 128 + p];
#pragma unroll
                for (int d0 = 0; d0 < 4; ++d0) uraw[r][d0] = Z[(size_t)(r0 + p) * 1536 + g * 128 + d0 * 32 + r32]; }
            asm volatile("" ::: "memory");
#pragma unroll
            for (int r = 0; r < 16; ++r) { const int p = 32 * pb + crow(r, hi);
#pragma unroll
                for (int d0 = 0; d0 < 4; ++d0) { const int ch = g * 128 + d0 * 32 + r32;
                    MIX[(size_t)(r0 + p) * 1024 + ch] = f2fp8(bf2f(uraw[r][d0]) * (acc[d0][r] + bias[r])); } }
        }
        __syncthreads();
    }
}

__device__ __forceinline__ void ph_fourier1(Frame& F) {
    const bf16_t* Z = (const bf16_t*)(KWS(F) + WS_ZODD); bf16_t* WT = (bf16_t*)(KWS(F) + WS_WT);
    const float* lg = KIN(F, 27); const float* lb = KIN(F, 28);
    const bf16x8* CSf = (const bf16x8*)(KWS(F) + WS_TAB + TB_CS); const bf16x8* AFf = (const bf16x8*)(KWS(F) + WS_TAB + TB_AF); const f32x2* tw = (const f32x2*)(KWS(F) + WS_TAB + TB_TW);
    const int lane = F.lane, r32 = lane & 31, hi = lane >> 5, wid = F.wave;
    for (int unit = F.bx; unit < NB * 128; unit += F.G) {
        const int b = unit >> 7, t2 = unit & 127;
#pragma unroll 1
        for (int g = 0; g < 4; ++g) {
            {
                int lane_g = lane; asm volatile("" : "+v"(lane_g)); const int r32 = lane_g & 31, hi = lane_g >> 5;
                const int tb = wid & 3, part = wid >> 2; int t1 = 32 * tb + r32; asm volatile("" : "+v"(t1)); const size_t row = (size_t)b * SEQ + 128 * t1 + t2;
                bf16x8 raw[8]; float s = 0.f;
#pragma unroll
                for (int ks = 0; ks < 8; ++ks) { raw[ks] = *(const bf16x8*)(Z + row * 1536 + 1024 + g * 128 + 16 * ks + 8 * hi);
#pragma unroll
                    for (int j = 0; j < 8; ++j) s += bf2f((unsigned short)raw[ks][j]); }
                s = xhalf_sum(s); const float mean = s * (1.0f / 128.0f); float q2 = 0.f;
#pragma unroll
                for (int ks = 0; ks < 8; ++ks)
#pragma unroll
                    for (int j = 0; j < 8; ++j) { const float d = bf2f((unsigned short)raw[ks][j]) - mean; q2 += d * d; }
                q2 = xhalf_sum(q2); const float rstd = 1.0f / sqrtf(q2 * (1.0f / 128.0f) + LN_EPS);
                bf16x8 af[8];
#pragma unroll
                for (int ks = 0; ks < 8; ++ks) { const int c0 = g * 128 + 16 * ks + 8 * hi; const f32x4 g0 = *(const f32x4*)(lg + c0), g1 = *(const f32x4*)(lg + c0 + 4), b0 = *(const f32x4*)(lb + c0), b1 = *(const f32x4*)(lb + c0 + 4);
                    float x[8];
#pragma unroll
                    for (int j = 0; j < 8; ++j) x[j] = (bf2f((unsigned short)raw[ks][j]) - mean) * rstd;
                    u32x4 w; w.x = pk2(x[0] * g0[0] + b0[0], x[1] * g0[1] + b0[1]); w.y = pk2(x[2] * g0[2] + b0[2], x[3] * g0[3] + b0[3]);
                    w.z = pk2(x[4] * g1[0] + b1[0], x[5] * g1[1] + b1[1]); w.w = pk2(x[6] * g1[2] + b1[2], x[7] * g1[3] + b1[3]);
                    af[ks] = __builtin_bit_cast(bf16x8, w); }
                f32x16 acc[4];
#pragma unroll
                for (int d0 = 0; d0 < 4; ++d0) acc[d0] = f32x16{};
#pragma unroll
                for (int ks = 0; ks < 8; ++ks) { unsigned fo = (unsigned)(((4 * part) * 8 + ks) * 64 + lane) * 16u; asm volatile("" : "+v"(fo));
#pragma unroll
                    for (int d0 = 0; d0 < 4; ++d0) acc[d0] = __builtin_amdgcn_mfma_f32_32x32x16_bf16(af[ks], *(const bf16x8*)((const char*)CSf + fo + d0 * 8192), acc[d0], 0, 0, 0); }
                int ybase = (part * 2 + (tb >> 1)) * 16384 + (tb & 1) * 8192 + hi * 2048 + r32 * 2; asm volatile("" : "+v"(ybase));
#pragma unroll
                for (int r = 0; r < 16; ++r)
#pragma unroll
                    for (int d0 = 0; d0 < 4; ++d0) *(LAS bf16_t*)(F.lds + ybase + ((r >> 3) & 1) * 4096 + d0 * 512 + ((r & 3) + 4 * ((r >> 2) & 1)) * 64) = (bf16_t)f2bf(acc[d0][r]);
            }
            __syncthreads();
            {
                const int kb = wid & 3, ch2 = wid >> 2;
                f32x16 aR[2], aI[2];
#pragma unroll
                for (int dd = 0; dd < 2; ++dd) { aR[dd] = f32x16{}; aI[dd] = f32x16{}; }
#pragma unroll
                for (int kh = 0; kh < 4; ++kh) {
                    unsigned fo = (unsigned)((kb * 16 + kh * 4) * 64 + lane) * 16u; asm volatile("" : "+v"(fo));
                    bf16x8 fr8[4], fi8[4];
#pragma unroll
                    for (int k8 = 0; k8 < 4; ++k8) { fr8[k8] = *(const bf16x8*)((const char*)AFf + fo + k8 * 1024); fi8[k8] = *(const bf16x8*)((const char*)AFf + fo + k8 * 1024 + 65536); }
#pragma unroll
                    for (int k8 = 0; k8 < 4; ++k8) { const int ks = kh * 4 + k8;
                        LAS unsigned char* trd = F.lds + (ks >> 2) * 16384 + v_rd_base(lane);
#pragma unroll
                        for (int dd = 0; dd < 2; ++dd) { const bf16x8 bf = vfrag(trd, 2 * ch2 + dd, ks & 3);
                            aR[dd] = __builtin_amdgcn_mfma_f32_32x32x16_bf16(fr8[k8], bf, aR[dd], 0, 0, 0); aI[dd] = __builtin_amdgcn_mfma_f32_32x32x16_bf16(fi8[k8], bf, aI[dd], 0, 0, 0); } }
                }
                int k1b = 32 * kb + 4 * hi; asm volatile("" : "+v"(k1b));
                f32x2 csv[16];
#pragma unroll
                for (int r = 0; r < 16; ++r) csv[r] = tw[t2 * 128 + k1b + (r & 3) + 8 * (r >> 2)];
                asm volatile("" ::: "memory");
#pragma unroll
                for (int r = 0; r < 16; ++r) { const int k1 = k1b + (r & 3) + 8 * (r >> 2); const f32x2 cs = csv[r];
                    bf16_t* dst = WT + ((((size_t)b * 128 + k1) * 128 + t2) * 4 + g) * 256;
#pragma unroll
                    for (int dd = 0; dd < 2; ++dd) { const float wr_ = aR[dd][r], wi_ = aI[dd][r]; const int j = 32 * (2 * ch2 + dd) + r32;
                        dst[j] = (bf16_t)f2bf(wr_ * cs[0] + wi_ * cs[1]); dst[128 + j] = (bf16_t)f2bf(wi_ * cs[0] - wr_ * cs[1]); }
                    if ((r & 3) == 3) asm volatile("" ::: "memory"); }
            }
            __syncthreads();
        }
    }
}
__device__ __forceinline__ void ph_fourier2(Frame& F) {
    const bf16_t* WT = (const bf16_t*)(KWS(F) + WS_WT); unsigned char* MIX = (unsigned char*)(KWS(F) + WS_MIX);
    const bf16x8* A3f = (const bf16x8*)(KWS(F) + WS_TAB + TB_A3);
    const int lane = F.lane, r32 = lane & 31, hi = lane >> 5, wid = F.wave;
    for (int unit = F.bx; unit < NB * 128; unit += F.G) {
        const int b = unit >> 7, k1 = unit & 127;
#pragma unroll 1
        for (int g = 0; g < 4; ++g) {
            for (int idx = F.tid; idx < 4096; idx += NTHR) { const int t2 = idx >> 5, c = idx & 31, part = c >> 4, j0 = (c & 15) * 8;
                const u32x4 v = *(const u32x4*)(WT + ((((size_t)b * 128 + k1) * 128 + t2) * 4 + g) * 256 + part * 128 + j0);
                *(LAS u32x4*)(F.lds + (part * 2 + (t2 >> 6)) * 16384 + v_st(t2 & 63, j0)) = v; }
            __syncthreads();
            const int mb = wid & 3, ch2 = wid >> 2;
            f32x16 acc[2] = {f32x16{}, f32x16{}};
#pragma unroll
            for (int ks = 0; ks < 16; ++ks) { unsigned fo = (unsigned)((mb * 16 + ks) * 64 + lane) * 16u; asm volatile("" : "+v"(fo)); const bf16x8 af = *(const bf16x8*)((const char*)A3f + fo);
                LAS unsigned char* trd = F.lds + (ks >> 2) * 16384 + v_rd_base(lane);
#pragma unroll
                for (int dd = 0; dd < 2; ++dd) acc[dd] = __builtin_amdgcn_mfma_f32_32x32x16_bf16(af, vfrag(trd, 2 * ch2 + dd, ks & 3), acc[dd], 0, 0, 0); }
#pragma unroll
            for (int r = 0; r < 16; ++r) { const int k2 = 32 * mb + crow(r, hi); const size_t row = (size_t)b * SEQ + k1 + 128 * k2;
#pragma unroll
                for (int dd = 0; dd < 2; ++dd) MIX[row * 1024 + 512 + g * 128 + 32 * (2 * ch2 + dd) + r32] = f2fp8(acc[dd][r]); }
            __syncthreads();
        }
    }
}

#ifndef MK_ONE_LAUNCH
#define MK_ONE_LAUNCH 1
#endif
constexpr int NPH = 18;
#ifndef PHMASK
#define PHMASK 0x3FFFF
#endif
#define HAS(k) (((PHMASK) >> (k)) & 1)
__global__ void __launch_bounds__(NTHR, 2) fwd_kernel(Args args) {
    extern __shared__ __attribute__((aligned(16))) unsigned char lds_raw[];
    Frame F;
    F.lds = (LAS unsigned char*)lds_raw; F.tid = threadIdx.x; F.lane = F.tid & 63; F.wave = __builtin_amdgcn_readfirstlane(F.tid >> 6); F.G = gridDim.x; F.bx = blockIdx.x;
    F.kz = 0;
    volatile LAS unsigned* MISC = (volatile LAS unsigned*)(F.lds + MISC_OFF);
    if (F.tid < 64) MISC[F.tid] = 0u;
    __syncthreads();
    if (MK_ONE_LAUNCH) (void)xcd_barrier_post((unsigned*)(args.ws + WS_CTL) + CW_BAR, MISC + 8);
    const int lo = args.ph_lo, hi = args.ph_hi;
#define IN(k) (lo <= (k) && (k) < hi)
#ifndef REPMASK
#define REPMASK 0
#endif
#define REP(k) (((REPMASK) >> (k)) & 1)
#define BARNOW() do { ENTER(); XcdBarrier bar_; bar_.bar = (unsigned*)(KWS(F) + WS_CTL) + CW_BAR; bar_.x = xb_xcc_id(); bar_.st = (volatile LAS unsigned*)(F.lds + MISC_OFF) + 8; xcd_barrier(bar_); } while (0)
#ifndef DIAG_PH
#define DIAG_PH -1
#endif
    int nstamp = 0;
#define STAMP() do { if (DIAG_PH >= 0) { if (F.tid == 0) ((volatile LAS unsigned*)(F.lds + MISC_OFF))[16 + nstamp] = (unsigned)__builtin_amdgcn_s_memrealtime(); ++nstamp; } } while (0)
    STAMP();
#define ENTER() do { asm volatile("" : "+s"(F.kz), "+s"(F.wave), "+s"(F.G), "+s"(F.bx), "+v"(F.tid), "+v"(F.lane)); F.kz = __builtin_amdgcn_readfirstlane(F.kz); F.wave = __builtin_amdgcn_readfirstlane(F.wave); \
    F.G = __builtin_amdgcn_readfirstlane(F.G); F.bx = __builtin_amdgcn_readfirstlane(F.bx); } while (0)
#define SEAM(k) do { if (IN(k) && IN((k) + 1)) { if (MK_ONE_LAUNCH) { ENTER(); XcdBarrier bar_; bar_.bar = (unsigned*)(KWS(F) + WS_CTL) + CW_BAR; bar_.x = xb_xcc_id(); bar_.st = (volatile LAS unsigned*)(F.lds + MISC_OFF) + 8; xcd_barrier(bar_); STAMP(); } } } while (0)

    if (HAS(0) && IN(0)) { ENTER(); for (int rep_ = 0; rep_ <= REP(0); ++rep_) { if (rep_) BARNOW(); ph0_mod_tables(F); } } SEAM(0);
    if (HAS(1) && IN(1)) { ENTER(); for (int rep_ = 0; rep_ <= REP(1); ++rep_) { if (rep_) BARNOW(); ph1_convert(F); } } SEAM(1);
    if (HAS(2) && IN(2)) { ENTER(); for (int rep_ = 0; rep_ <= REP(2); ++rep_) { if (rep_) BARNOW(); ph2_modulate(F); } } SEAM(2);

    for (int layer = 0; layer < 2; ++layer) {
        const int pb = layer == 0 ? 5 : 13;
        if (layer == 0) {
            if (HAS(3) && IN(3)) { ENTER(); for (int rep_ = 0; rep_ <= REP(3); ++rep_) { if (rep_) BARNOW();
                pg8::Gemm g{(const bf16_t*)(KWS(F) + WS_U), (const bf16_t*)(KWS(F) + WS_WEVIN), T, 2560, DM / 2};
                EvInOrder S; S.so.init(T, 2560, F.G, F.bx);
                EpiEvIn E{(unsigned char*)(KWS(F) + WS_Q), (unsigned char*)(KWS(F) + WS_K), (unsigned char*)(KWS(F) + WS_V), (bf16_t*)(KWS(F) + WS_AB), (const float*)(KWS(F) + WS_TAB + TB_COS), (const float*)(KWS(F) + WS_TAB + TB_SIN)};
                pg8::gemm_phase<EpiEvIn, EvInOrder, true, false, true>(F.lds, g, S, E, F.tid);
            } } SEAM(3);
            if (HAS(4) && IN(4)) { ENTER(); for (int rep_ = 0; rep_ <= REP(4); ++rep_) { if (rep_) BARNOW(); ph4_conv(F); ph4_attention(F); } } SEAM(4);
        } else {
            if (HAS(10) && IN(10)) { ENTER(); for (int rep_ = 0; rep_ <= REP(10); ++rep_) { if (rep_) BARNOW();
                pg8::Gemm g{(const bf16_t*)(KWS(F) + WS_U), (const bf16_t*)(KWS(F) + WS_WODIN), T, 1536, DM / 2};
                pg8::StaticOrder S; S.init(T, 1536, F.G, F.bx);
                pg8::EpiBf16 E{(bf16_t*)(KWS(F) + WS_ZODD), 1536, 4, 1.0f / WI_SCALE};
                pg8::gemm_phase<pg8::EpiBf16, pg8::StaticOrder, true, false, true>(F.lds, g, S, E, F.tid);
            } } SEAM(10);
            if (HAS(11) && IN(11)) { ENTER(); for (int rep_ = 0; rep_ <= REP(11); ++rep_) { if (rep_) BARNOW(); ph_gmlp(F); ph_fourier1(F); } } SEAM(11);
            if (HAS(12) && IN(12)) { ENTER(); for (int rep_ = 0; rep_ <= REP(12); ++rep_) { if (rep_) BARNOW(); ph_fourier2(F); } } SEAM(12);
        }
        if (HAS(5) && IN(pb)) { ENTER(); for (int rep_ = 0; rep_ <= REP(5); ++rep_) { if (rep_) BARNOW();
            pg8::Gemm g{(const bf16_t*)(KWS(F) + WS_MIX), (const bf16_t*)(KWS(F) + (layer == 0 ? WS_WEVOUT : WS_WODOUT)), T, DM, DM / 2};
            pg8::StaticOrder S; S.init(T, DM, F.G, F.bx);
            pg8::EpiBf16 E{(bf16_t*)(KWS(F) + WS_Y), DM, 0, 1.0f / WO_SCALE};
            pg8::gemm_phase<pg8::EpiBf16, pg8::StaticOrder, true, false, true>(F.lds, g, S, E, F.tid);
        } } SEAM(pb);
        if (HAS(6) && IN(pb + 1)) { ENTER(); for (int rep_ = 0; rep_ <= REP(6); ++rep_) { if (rep_) BARNOW(); ph_router(F, layer, layer == 0 ? KIN(F, 0) : (const float*)(KWS(F) + WS_H2)); } } SEAM(pb + 1);
        if (HAS(7) && IN(pb + 2)) { ENTER(); for (int rep_ = 0; rep_ <= REP(7); ++rep_) { if (rep_) BARNOW();
            moe_meta(F, layer);
            pg8::Gemm g{(const bf16_t*)(KWS(F) + WS_U2), (const bf16_t*)(KWS(F) + WS_WGU + (size_t)layer * NE * 2048 * DM), 0, 0, DM / 2};
            MoeOrder S{(const LAS int*)(F.lds + META_OFF), (const unsigned*)(KWS(F) + WS_LIST), F.bx, F.G, 8, 4};
            EpiGU E{(unsigned char*)(KWS(F) + WS_ACT), KIN(F, 32) + (size_t)layer * NE * 2048};
            pg8::gemm_phase<EpiGU, MoeOrder, true, true, true>(F.lds, g, S, E, F.tid);
        } } SEAM(pb + 2);
        if (HAS(8) && IN(pb + 3)) { ENTER(); for (int rep_ = 0; rep_ <= REP(8); ++rep_) { if (rep_) BARNOW();
            moe_meta(F, layer);
            pg8::Gemm g{(const bf16_t*)(KWS(F) + WS_ACT), (const bf16_t*)(KWS(F) + WS_WD + (size_t)layer * NE * 1024 * DM), 0, 0, DM / 2};
            MoeOrder S{(const LAS int*)(F.lds + META_OFF), (const unsigned*)(KWS(F) + WS_LIST), F.bx, F.G, 4, 8};
            EpiDown E{(unsigned char*)(KWS(F) + WS_YB), KIN(F, 34) + (size_t)layer * NE * 1024, (const unsigned*)(KWS(F) + WS_LIST)};
            pg8::gemm_phase<EpiDown, MoeOrder, true, false, true>(F.lds, g, S, E, F.tid);
        } } SEAM(pb + 3);
        if (HAS(9) && IN(pb + 4)) { ENTER(); for (int rep_ = 0; rep_ <= REP(9); ++rep_) { if (rep_) BARNOW(); ph_combine(F, layer, layer == 0 ? (float*)(KWS(F) + WS_H2) : KOUT(F), layer == 0); } }
        if (layer == 0) SEAM(pb + 4);
    }
    if (DIAG_PH >= 0) {
        ENTER(); XcdBarrier bar_; bar_.bar = (unsigned*)(KWS(F) + WS_CTL) + CW_BAR; bar_.x = xb_xcc_id(); bar_.st = (volatile LAS unsigned*)(F.lds + MISC_OFF) + 8; xcd_barrier(bar_); STAMP();
        __syncthreads();
        volatile LAS unsigned* st = (volatile LAS unsigned*)(F.lds + MISC_OFF) + 16;
        const unsigned d = st[DIAG_PH + 1] - st[DIAG_PH];
        const float c = sqrtf((float)d * 0.01f);
        float* o = KOUT(F);
        for (size_t i = (size_t)F.bx * NTHR + F.tid; i < (size_t)T * DM; i += (size_t)F.G * NTHR) o[i] = c;
    }
#undef IN
#undef SEAM
}

extern "C" void kernel_launch(void* const* d_in, const int* in_sizes, int n_in, void* d_out, int out_size, void* d_ws, size_t ws_size, hipStream_t stream) {
    static int grid = 0;
    if (grid == 0) {
        if (n_in != 35 || out_size != T * DM || ws_size < WS_END) { fprintf(stderr, "kernel_launch: unexpected shapes: n_in %d out %d ws %zu (need %zu)\n", n_in, out_size, ws_size, (size_t)WS_END); grid = -1; return; }
        int dev = 0, cus = 0;
        if (hipGetDevice(&dev) != hipSuccess || hipDeviceGetAttribute(&cus, hipDeviceAttributeMultiprocessorCount, dev) != hipSuccess) { grid = -1; return; }
        if (hipFuncSetAttribute((const void*)fwd_kernel, hipFuncAttributeMaxDynamicSharedMemorySize, LDS_BYTES) != hipSuccess) { fprintf(stderr, "kernel_launch: hipFuncSetAttribute failed\n"); grid = -1; return; }
        int per_cu = 0; (void)hipOccupancyMaxActiveBlocksPerMultiprocessor(&per_cu, (const void*)fwd_kernel, NTHR, LDS_BYTES); (void)hipGetLastError();
        if (per_cu < 1) fprintf(stderr, "kernel_launch: occupancy query reports %d blocks per CU\n", per_cu);
        grid = cus > 256 ? 256 : cus;
        if (grid != 256) fprintf(stderr, "kernel_launch: %d CUs; this kernel is laid out for 256\n", cus);
    }
    if (grid < 0) return;
    (void)hipMemsetAsync((char*)d_ws + WS_CTL, 0, CTL_ZERO_BYTES, stream);
    Args a{};
    for (int i = 0; i < 35; ++i) a.in[i] = (const float*)d_in[i];
    a.out = (float*)d_out; a.ws = (unsigned char*)d_ws;
#if MK_ONE_LAUNCH
    a.ph_lo = 0; a.ph_hi = NPH;
    hipLaunchKernelGGL(fwd_kernel, dim3(grid), dim3(NTHR), LDS_BYTES, stream, a);
#else
    for (int p = 0; p < NPH; ++p) { a.ph_lo = p; a.ph_hi = p + 1; hipLaunchKernelGGL(fwd_kernel, dim3(grid), dim3(NTHR), LDS_BYTES, stream, a); }
#endif
    const hipError_t le = hipPeekAtLastError();
    if (le != hipSuccess) fprintf(stderr, "kernel_launch: launch failed: %s\n", hipGetErrorName(le));
}
```

```cpp
#include <hip/hip_runtime.h>
#include <cstdio>
#include <cstdint>

#define LAS __attribute__((address_space(3)))
#define GAS __attribute__((address_space(1)))
typedef unsigned short bf16_t;
typedef short bf16x8 __attribute__((ext_vector_type(8)));
typedef short s16x4 __attribute__((ext_vector_type(4)));
typedef float f32x4 __attribute__((ext_vector_type(4)));
typedef float f32x2 __attribute__((ext_vector_type(2)));
typedef float f32x16 __attribute__((ext_vector_type(16)));
typedef unsigned u32x4 __attribute__((ext_vector_type(4)));
typedef unsigned u32x2 __attribute__((ext_vector_type(2)));

namespace pg8 {
constexpr int BM = 256, BK = 64, HALF = 128, HTB = HALF * BK * 2, STAGE_BYTES = 8 * HTB, NXCD = 8, WGM = 8;
__host__ __device__ __forceinline__ int lds_byte(int r, int c) { const int st = (r >> 4) * 2 + (c >> 5), rr = r & 15, cc = c & 31, ob = rr * 64 + cc * 2; return st * 1024 + (ob ^ (((ob >> 9) & 1) << 5)); }
__host__ __device__ __forceinline__ void stage_rc(int b, int& R, int& C) { const int st = b / 1024, sb = b % 1024, swz = sb ^ (((sb >> 9) & 1) << 5); R = (st >> 1) * 16 + swz / 64; C = (st & 1) * 32 + (swz % 64) / 2; }
__host__ __device__ __forceinline__ int perm32(int rho) { const int n = rho >> 4, i = rho & 15; return 8 * (i >> 2) + 4 * n + (i & 3); }

struct Unit { int pm, pn, a0, a1, a2; };
struct Gemm { const bf16_t* A; const bf16_t* Bt; int M, N, K; };

constexpr int PRE_ROWS = 131072 + 1024, PRE_EPI = PRE_ROWS + 2048;
struct StaticOrder {
    int nM, nN, nwg, G, c;
    __device__ void init(int M, int N, int G_, int c_) { nM = M / BM; nN = N / BM; nwg = nM * nN; G = G_; c = c_; }
    __device__ bool map(long L, Unit& u) const {
        if (L >= nwg) return false;
        int wgid = (int)L; { const int q = nwg / NXCD, r = nwg % NXCD, xcd = wgid % NXCD, off = wgid / NXCD; wgid = (xcd < r ? xcd * (q + 1) : r * (q + 1) + (xcd - r) * q) + off; }
        const int nig = WGM * nN, gid = wgid / nig, fm = gid * WGM, gsz = (nM - fm) < WGM ? (nM - fm) : WGM;
        u.pm = fm + ((wgid % nig) % gsz); u.pn = (wgid % nig) / gsz; u.a0 = 0; u.a1 = 0; u.a2 = 256; return true;
    }
    __device__ bool next(int i, Unit& u) const { return map((long)i * G + c, u); }
    __device__ __forceinline__ unsigned arow(const Unit&, int) const { return 0u; }
    __device__ __forceinline__ unsigned rowval(const Unit&, int, unsigned) const { return 0u; }
    __device__ __forceinline__ const unsigned* rows_ptr(const Unit&) const { return nullptr; }
};

__device__ __forceinline__ unsigned cvt_pk_bf16(float lo, float hi) { unsigned r; asm volatile("v_cvt_pk_bf16_f32 %0, %1, %2" : "=v"(r) : "v"(lo), "v"(hi)); return r; }

__device__ __forceinline__ float gelu_tanh(float x) {
    const float t = x * (1.0f + 0.044715f * x * x) * (2.0f * 0.7978845608028654f * 1.4426950408889634f);
    return x * __builtin_amdgcn_rcpf(1.0f + __builtin_amdgcn_exp2f(-t));
}

struct EpiBf16 {
    static constexpr bool PERM = true, HAS_PRE = false;
    bf16_t* O; int ldc; int gelu_pn; float scale;
    __device__ __forceinline__ void operator()(const f32x4 (&acc)[2][2][4][2], const Unit& u, int wr, int wc, int fr, int fq) const {
        const int row0 = u.pm * BM + wr * 64 + fr; const int col0 = u.pn * BM + wc * 32 + 8 * fq;
        const bool act = u.pn < gelu_pn;
#pragma unroll
        for (int ai = 0; ai < 2; ++ai)
#pragma unroll
            for (int m = 0; m < 4; ++m) { bf16_t* rowp = O + (size_t)(row0 + ai * HALF + m * 16) * ldc + col0;
#pragma unroll
                for (int bj = 0; bj < 2; ++bj) { f32x4 v0 = acc[ai][bj][m][0] * scale, v1 = acc[ai][bj][m][1] * scale;
                    if (act) {
#pragma unroll
                        for (int j = 0; j < 4; ++j) { v0[j] = gelu_tanh(v0[j]); v1[j] = gelu_tanh(v1[j]); } }
                    u32x4 w; w.x = cvt_pk_bf16(v0[0], v0[1]); w.y = cvt_pk_bf16(v0[2], v0[3]); w.z = cvt_pk_bf16(v1[0], v1[1]); w.w = cvt_pk_bf16(v1[2], v1[3]);
                    *(u32x4*)(rowp + bj * HALF) = w; } }
    }
};

typedef int v8i32 __attribute__((ext_vector_type(8)));
typedef short s16x16 __attribute__((ext_vector_type(16)));
template <class Epi, class Sched, bool ALIGN_EPI, bool GATHER, bool FP8 = false>
__device__ __forceinline__ void gemm_phase(LAS unsigned char* lds, const Gemm g, const Sched& S, const Epi& E, const int tid) {
    const int wid = __builtin_amdgcn_readfirstlane(tid >> 6), lane = tid & 63, wr = wid >> 2, wc = wid & 3, fr = lane & 15, fq = lane >> 4;
    const int K = g.K, nt = K / BK;
    unsigned voffA[2], voffB[2]; int Rr[2], Cc[2];
#pragma unroll
    for (int i = 0; i < 2; ++i) { int R, C; stage_rc(tid * 16 + i * 8192, R, C); const int Rb = Epi::PERM ? ((R & ~31) + perm32(R & 31)) : R; Rr[i] = R; Cc[i] = C;
        voffA[i] = (unsigned)(R * K + C) * 2u; voffB[i] = (unsigned)(Rb * K + C) * 2u; }
    const unsigned kstep = (unsigned)(BK * 2);
    const unsigned hstep = (unsigned)HALF * (unsigned)K * 2u;
    const unsigned tstep = 2u * hstep;
    const char* const baseA = (const char*)g.A; const char* const baseB = (const char*)g.Bt;
    const unsigned ldsw = (unsigned)wid * 1024u;
    const int aoff = lds_byte(wr * 64 + fr, fq * 8), boff = lds_byte(wc * 32 + fr, fq * 8);
    const int aoff0 = lds_byte(wr * 64 + fr, fq * 16), aoff1 = lds_byte(wr * 64 + fr, fq * 16 + 8), boff0 = lds_byte(wc * 32 + fr, fq * 16), boff1 = lds_byte(wc * 32 + fr, fq * 16 + 8);
#define PG8_SA(b, h) (((b) * 2 + (h)) * HTB)
#define PG8_SB(b, h) ((4 + (b) * 2 + (h)) * HTB)
#define PG8_STAGE(bufoff, gbase, voff) do { _Pragma("unroll") for (int _i = 0; _i < 2; ++_i) \
        __builtin_amdgcn_global_load_lds((const unsigned*)(baseB + (size_t)(unsigned)((gbase) + (voff)[_i])), (LAS unsigned*)(lds + (bufoff) + ldsw + _i * 8192), 16, 0, 0); } while (0)
#define PG8_STAGEA(bufoff, gbase, voff) do { _Pragma("unroll") for (int _i = 0; _i < 2; ++_i) \
        __builtin_amdgcn_global_load_lds((const unsigned*)(baseA + (size_t)(unsigned)((gbase) + (voff)[_i])), (LAS unsigned*)(lds + (bufoff) + ldsw + _i * 8192), 16, 0, 0); } while (0)
#define PG8_STAGE_A(bufoff, base, h, nx) do { if constexpr (GATHER) { _Pragma("unroll") for (int _i = 0; _i < 2; ++_i) { const unsigned _v = (nx) ? vAn[h][_i] : vAc[h][_i]; \
            __builtin_amdgcn_global_load_lds((const unsigned*)(baseA + (size_t)(unsigned)((base) + _v)), (LAS unsigned*)(lds + (bufoff) + ldsw + _i * 8192), 16, 0, 0); } } \
        else { PG8_STAGEA(bufoff, (base) + (h) * hstep, voffA); } } while (0)
#define PG8_LD8(dst, i, off0, off1) do { const bf16x8 _lo = *(const LAS bf16x8*)(lds + (off0)), _hi = *(const LAS bf16x8*)(lds + (off0) + 16); dst[i] = __builtin_bit_cast(v8i32, __builtin_shufflevector(_lo, _hi, 0, 1, 2, 3, 4, 5, 6, 7, 8, 9, 10, 11, 12, 13, 14, 15)); } while (0)
#define PG8_LDA8(dst, b, h) do { _Pragma("unroll") for (int m = 0; m < 4; ++m) PG8_LD8(dst, m, PG8_SA(b, h) + aoff0 + m * 2048, PG8_SA(b, h) + aoff1 + m * 2048); } while (0)
#define PG8_LDB8(dst, b, h) do { _Pragma("unroll") for (int n = 0; n < 2; ++n) PG8_LD8(dst, n, PG8_SB(b, h) + boff0 + n * 2048, PG8_SB(b, h) + boff1 + n * 2048); } while (0)
#define PG8_MMA8(ai, bj, At, Bt) do { __builtin_amdgcn_s_setprio(1); _Pragma("unroll") for (int m = 0; m < 4; ++m) _Pragma("unroll") for (int n = 0; n < 2; ++n) \
        asm volatile("v_mfma_scale_f32_16x16x128_f8f6f4 %0, %1, %2, %0, %3, %3 op_sel_hi:[0,0,0]" : "+v"(acc[ai][bj][m][n]) : "v"(Bt[n]), "v"(At[m]), "v"(one_scale)); __builtin_amdgcn_s_setprio(0); } while (0)
#define PG8_LDA(dst, b, h) do { _Pragma("unroll") for (int m = 0; m < 4; ++m) _Pragma("unroll") for (int k = 0; k < 2; ++k) dst[m][k] = *(const LAS bf16x8*)(lds + PG8_SA(b, h) + aoff + m * 2048 + k * 1024); } while (0)
#define PG8_LDB(dst, b, h) do { _Pragma("unroll") for (int n = 0; n < 2; ++n) _Pragma("unroll") for (int k = 0; k < 2; ++k) dst[n][k] = *(const LAS bf16x8*)(lds + PG8_SB(b, h) + boff + n * 2048 + k * 1024); } while (0)
#define PG8_MMA(ai, bj, At, Bt) do { __builtin_amdgcn_s_setprio(1); _Pragma("unroll") for (int m = 0; m < 4; ++m) _Pragma("unroll") for (int n = 0; n < 2; ++n) _Pragma("unroll") for (int k = 0; k < 2; ++k) \
        acc[ai][bj][m][n] = __builtin_amdgcn_mfma_f32_16x16x32_bf16(Bt[n][k], At[m][k], acc[ai][bj][m][n], 0, 0, 0); __builtin_amdgcn_s_setprio(0); } while (0)
#define PG8_WAIT_V(n) asm volatile("s_waitcnt vmcnt(" #n ")" ::: "memory")
#define PG8_WAIT_L(n) asm volatile("s_waitcnt lgkmcnt(" #n ")" ::: "memory")
#define PG8_BAR __builtin_amdgcn_s_barrier()
#define PG8_SCHED __builtin_amdgcn_sched_barrier(0)
    Unit cur, nxt; int ui = 0;
    if (!S.next(0, cur)) return;
    f32x4 acc[2][2][4][2];
#pragma unroll
    for (int a = 0; a < 2; ++a)
#pragma unroll
        for (int b = 0; b < 2; ++b)
#pragma unroll
            for (int m = 0; m < 4; ++m)
#pragma unroll
                for (int n = 0; n < 2; ++n) acc[a][b][m][n] = (f32x4){0.f, 0.f, 0.f, 0.f};
    bf16x8 At[4][2], B0[2][2], B1[2][2]; v8i32 At8[4], B08[2], B18[2]; const int one_scale = 0x7F7F7F7F;
#define XLDA(b, h) do { if constexpr (FP8) PG8_LDA8(At8, b, h); else PG8_LDA(At, b, h); } while (0)
#define XLDB0(b, h) do { if constexpr (FP8) PG8_LDB8(B08, b, h); else PG8_LDB(B0, b, h); } while (0)
#define XLDB1(b, h) do { if constexpr (FP8) PG8_LDB8(B18, b, h); else PG8_LDB(B1, b, h); } while (0)
#define XMMA0(ai, bj) do { if constexpr (FP8) PG8_MMA8(ai, bj, At8, B08); else PG8_MMA(ai, bj, At, B0); } while (0)
#define XMMA1(ai, bj) do { if constexpr (FP8) PG8_MMA8(ai, bj, At8, B18); else PG8_MMA(ai, bj, At, B1); } while (0)
    unsigned vAc[2][2], vAn[2][2];
#define PG8_ROWS(dst, un) do { if constexpr (GATHER) { _Pragma("unroll") for (int _h = 0; _h < 2; ++_h) _Pragma("unroll") for (int _i = 0; _i < 2; ++_i) \
        dst[_h][_i] = (S.arow(un, _h * HALF + Rr[0] + 64 * _i) * (unsigned)K + (unsigned)Cc[0]) * 2u; } } while (0)
    PG8_ROWS(vAc, cur);
#pragma unroll
    for (int _h = 0; _h < 2; ++_h)
#pragma unroll
        for (int _i = 0; _i < 2; ++_i) vAn[_h][_i] = vAc[_h][_i];
    unsigned cA = GATHER ? 0u : (unsigned)cur.pm * tstep; unsigned cB = (unsigned)cur.pn * tstep;
    PG8_STAGE(PG8_SB(0, 0), cB, voffB); PG8_STAGE(PG8_SB(0, 1), cB + hstep, voffB); PG8_STAGE_A(PG8_SA(0, 0), cA, 0, false); PG8_STAGE_A(PG8_SA(0, 1), cA, 1, false);
    if (wr == 1) PG8_BAR;
    PG8_WAIT_V(2); PG8_BAR;
    PG8_STAGE(PG8_SB(1, 0), cB + kstep, voffB); PG8_STAGE_A(PG8_SA(1, 0), cA + kstep, 0, false); PG8_STAGE(PG8_SB(1, 1), cB + hstep + kstep, voffB);
    PG8_WAIT_V(6); PG8_BAR;
    for (;;) {
        const bool has_next = S.next(ui + 1, nxt);
        if constexpr (GATHER) {
            if (has_next) {
                if (ui == 0) { PG8_ROWS(vAn, nxt); asm volatile("" : "+v"(vAn[0][0]), "+v"(vAn[0][1]), "+v"(vAn[1][0]), "+v"(vAn[1][1])); }
                else {
#pragma unroll
                    for (int _h = 0; _h < 2; ++_h)
#pragma unroll
                        for (int _i = 0; _i < 2; ++_i) { const int R_ = _h * HALF + Rr[0] + 64 * _i; const unsigned v_ = *(const LAS unsigned*)(lds + PRE_ROWS + ((ui + 1) & 1) * 1024 + R_ * 4);
                            vAn[_h][_i] = (S.rowval(nxt, R_, v_) * (unsigned)K + (unsigned)Cc[0]) * 2u; } }
            }
            Unit n2_; if (S.next(ui + 2, n2_)) { if (wid == 0) __builtin_amdgcn_global_load_lds((const unsigned*)(S.rows_ptr(n2_) + lane * 4), (LAS unsigned*)(lds + PRE_ROWS + (ui & 1) * 1024), 16, 0, 0); }
        } else { if (has_next) { PG8_ROWS(vAn, nxt); } }
        if constexpr (Epi::HAS_PRE) E.pre(lds + PRE_EPI + (ui & 1) * 2048, cur, wid, lane);
        const unsigned nA = GATHER ? 0u : (has_next ? (unsigned)nxt.pm * tstep : cA);
        const unsigned nB = has_next ? (unsigned)nxt.pn * tstep : cB;
#pragma unroll 1
        for (int t = 0; t < nt; t += 2) {
            const bool last = (t == nt - 2);
            const bool nx = last && has_next;
            const unsigned a1 = cA + (unsigned)(t + 1) * kstep;
            const unsigned a2 = last ? nA : cA + (unsigned)(t + 2) * kstep; const unsigned b2 = last ? nB : cB + (unsigned)(t + 2) * kstep;
            const unsigned a3 = a2 + kstep; const unsigned b3 = b2 + kstep;
            XLDB0(0, 0); XLDB1(0, 1); PG8_SCHED; XLDA(0, 0); PG8_STAGE_A(PG8_SA(1, 1), a1, 1, false);
            PG8_WAIT_V(8); PG8_WAIT_L(0); PG8_BAR; XMMA0(0, 0); XMMA1(0, 1); PG8_BAR; PG8_SCHED;
            XLDA(0, 1); PG8_STAGE(PG8_SB(0, 0), b2, voffB); PG8_STAGE(PG8_SB(0, 1), b2 + hstep, voffB); PG8_STAGE_A(PG8_SA(0, 0), a2, 0, nx);
            PG8_WAIT_V(8); PG8_WAIT_L(0); PG8_BAR; XMMA0(1, 0); XMMA1(1, 1); PG8_BAR; PG8_SCHED;
            XLDB0(1, 0); XLDB1(1, 1); PG8_SCHED; XLDA(1, 0); PG8_STAGE_A(PG8_SA(0, 1), a2, 1, nx);
            PG8_WAIT_V(8); PG8_WAIT_L(0); PG8_BAR; XMMA0(0, 0); XMMA1(0, 1); PG8_BAR; PG8_SCHED;
            XLDA(1, 1); PG8_STAGE(PG8_SB(1, 0), b3, voffB); PG8_STAGE(PG8_SB(1, 1), b3 + hstep, voffB); PG8_STAGE_A(PG8_SA(1, 0), a3, 0, nx);
            PG8_WAIT_V(8); PG8_WAIT_L(0); PG8_BAR; XMMA0(1, 0); XMMA1(1, 1); PG8_BAR; PG8_SCHED;
        }
        if constexpr (FP8) asm volatile("s_nop 15\n\ts_nop 15" ::: "memory");
        if constexpr (ALIGN_EPI) { if (wr == 0) PG8_BAR; }
        if constexpr (Epi::HAS_PRE) E(acc, cur, wr, wc, fr, fq, lds + PRE_EPI + (ui & 1) * 2048); else E(acc, cur, wr, wc, fr, fq);
        if (!has_next) break;
#pragma unroll
        for (int a = 0; a < 2; ++a)
#pragma unroll
            for (int b = 0; b < 2; ++b)
#pragma unroll
                for (int m = 0; m < 4; ++m)
#pragma unroll
                    for (int n = 0; n < 2; ++n) acc[a][b][m][n] = (f32x4){0.f, 0.f, 0.f, 0.f};
        cur = nxt; cA = nA; cB = nB; ++ui;
#pragma unroll
        for (int _h = 0; _h < 2; ++_h)
#pragma unroll
            for (int _i = 0; _i < 2; ++_i) vAc[_h][_i] = vAn[_h][_i];
        if constexpr (ALIGN_EPI) { if (wr == 1) PG8_BAR; }
    }
    PG8_WAIT_V(0);
    if constexpr (!ALIGN_EPI) { if (wr == 0) PG8_BAR; }
    PG8_BAR;
#undef PG8_SA
#undef PG8_SB
#undef PG8_STAGE
#undef PG8_STAGEA
#undef PG8_STAGE_A
#undef PG8_ROWS
#undef PG8_LDA
#undef PG8_LD8
#undef PG8_LDA8
#undef PG8_LDB8
#undef PG8_MMA8
#undef XLDA
#undef XLDB0
#undef XLDB1
#undef XMMA0
#undef XMMA1
#undef PG8_LDB
#undef PG8_MMA
#undef PG8_WAIT_V
#undef PG8_WAIT_L
#undef PG8_BAR
#undef PG8_SCHED
}
}

constexpr int DM = 1024, SEQ = 16384, NB = 2, T = NB * SEQ, CTX = 256, NCTX = NB * CTX, NKEY = SEQ + CTX;
constexpr int NE = 32, TOPK = 4, CAP = 32768;
constexpr float ALPHA = 1.4142135623730951f, LN_EPS = 1e-5f;
constexpr float QSCALE = 0.125f * 1.4426950408889634f;
constexpr float LAM_INIT0 = 0.2f;
constexpr int NWAVES = 8, NTHR = 512;

constexpr size_t MiB = 1u << 20;
constexpr size_t WS_CTL = 0, CTL_ZERO_BYTES = 1 * MiB;
constexpr size_t WS_MODP = 1 * MiB;
constexpr size_t WS_MOD = 3 * MiB;
constexpr size_t WS_TAB = 4 * MiB;
constexpr size_t WS_WEVIN = 6 * MiB, WS_WEVOUT = 11 * MiB, WS_WODIN = 13 * MiB, WS_WODOUT = 16 * MiB;
constexpr size_t WS_LIST = 18 * MiB, WS_GATES = 22 * MiB;
constexpr size_t WS_WGU = 32 * MiB;
constexpr size_t WS_WD = 288 * MiB;
constexpr size_t WS_U = 416 * MiB;
constexpr size_t WS_Q = 482 * MiB, WS_K = 514 * MiB, WS_V = 547 * MiB, WS_AB = 580 * MiB;
constexpr size_t WS_O0 = 612 * MiB;
constexpr size_t WS_MIX = 676 * MiB, WS_Y = 740 * MiB, WS_H1 = 804 * MiB, WS_U2 = 932 * MiB;
constexpr size_t WS_ACT = 996 * MiB;
constexpr size_t WS_YB = 1268 * MiB;
constexpr size_t WS_H2 = 1524 * MiB;
constexpr size_t WS_ZODD = 1652 * MiB;
constexpr size_t WS_WT = 1748 * MiB;
constexpr size_t WS_END = 1812 * MiB;
constexpr size_t TB_COS = 0, TB_SIN = 20480, TB_CS = 40960  , TB_AF = 106496  , TB_A3 = 237568  , TB_TW = 303104  , TB_WS = 434176  , TB_END = 565248;
constexpr int CW_ERR = 0, CW_BAR = 4096, CW_CNT = 16384;
#define XB_TMO      128
#define XB_XCNT(j)  (256  + 64 * (j))
#define XB_XSUB(j)  (1280 + 64 * (j))
#define XB_XGEN(j)  (2304 + 64 * (j))
#define XB_TOP      3328
#define XB_TOPGEN   3392
#define XCD_BAR_WORDS 3456
#define XB_SPIN_CAP (1u << 18)
constexpr int LDS_BYTES = 160 * 1024, MISC_OFF = LDS_BYTES - 256, META_OFF = 131072;

__device__ __forceinline__ unsigned xb_ld(unsigned* p)              { return __hip_atomic_load(p, __ATOMIC_RELAXED, __HIP_MEMORY_SCOPE_AGENT); }
__device__ __forceinline__ unsigned xb_add(unsigned* p, unsigned v) { return __hip_atomic_fetch_add(p, v, __ATOMIC_RELAXED, __HIP_MEMORY_SCOPE_AGENT); }
__device__ __forceinline__ unsigned xb_xcc_id() { return (unsigned)__builtin_amdgcn_s_getreg((3 << 11) | 20) & 0xFu; }
#define XB_SPIN(cond, bar) do { unsigned _sp = 0; while (cond) { __builtin_amdgcn_s_sleep(1); \
    if ((++_sp & 255u) == 0u) { if (xb_ld(&(bar)[XB_TMO])) break; if (_sp > XB_SPIN_CAP) { atomicAdd(&(bar)[XB_TMO], 1u); break; } } } } while (0)
struct XcdBarrier { unsigned* bar; unsigned x; volatile LAS unsigned* st; };
__device__ __forceinline__ XcdBarrier xcd_barrier_post(unsigned* bar, volatile LAS unsigned* st) {
    XcdBarrier b; b.bar = bar; b.x = xb_xcc_id(); b.st = st;
    if (threadIdx.x == 0) (void)xb_add(&bar[XB_XCNT(b.x)], 1u);
    return b;
}
__device__ __forceinline__ void xcd_barrier_complete(unsigned* bar, unsigned x, unsigned& nloc, unsigned& nx) {
    const unsigned G = gridDim.x * gridDim.y * gridDim.z;
    unsigned sum, cnt, mine, sp = 0u;
    for (;;) {
        sum = 0u; cnt = 0u; mine = 0u;
#pragma unroll
        for (unsigned j = 0; j < 16; ++j) { const unsigned c = xb_ld(&bar[XB_XCNT(j)]); sum += c; cnt += (c > 0u) ? 1u : 0u; mine = (j == x) ? c : mine; }
        if (sum == G) break;
        __builtin_amdgcn_s_sleep(1);
        if ((++sp & 255u) == 0u) { if (xb_ld(&bar[XB_TMO])) break; if (sp > XB_SPIN_CAP) { atomicAdd(&bar[XB_TMO], 1u); break; } }
    }
    nloc = mine > 0u ? mine : 1u; nx = cnt > 0u ? cnt : 1u;
}
__device__ __forceinline__ void xcd_barrier(const XcdBarrier& b) {
    asm volatile("s_waitcnt vmcnt(0)" ::: "memory");
    __syncthreads();
    if (threadIdx.x == 0) {
        unsigned* bar = b.bar;
        __builtin_amdgcn_s_waitcnt(0);
        unsigned nloc = b.st[0], nx = b.st[1];
        if (nloc == 0u) { xcd_barrier_complete(bar, b.x, nloc, nx); b.st[0] = nloc; b.st[1] = nx; }
        const unsigned old = xb_add(&bar[XB_XSUB(b.x)], 1u);
        const unsigned gen = old / nloc;
        if (old + 1u == (gen + 1u) * nloc) {
            __builtin_amdgcn_fence(__ATOMIC_RELEASE, "agent");
            asm volatile("s_waitcnt vmcnt(0)" ::: "memory");
            const unsigned og = xb_add(&bar[XB_TOP], 1u);
            const unsigned tg = og / nx;
            if (og + 1u == (tg + 1u) * nx) xb_add(&bar[XB_TOPGEN], 1u);
            else XB_SPIN(xb_ld(&bar[XB_TOPGEN]) == tg, bar);
            __builtin_amdgcn_fence(__ATOMIC_ACQUIRE, "agent");
            xb_add(&bar[XB_XGEN(b.x)], 1u);
            asm volatile("s_waitcnt vmcnt(0)" ::: "memory");
        } else {
            XB_SPIN(xb_ld(&bar[XB_XGEN(b.x)]) == gen, bar);
            __builtin_amdgcn_fence(__ATOMIC_ACQUIRE, "agent");
            asm volatile("s_waitcnt vmcnt(0)" ::: "memory");
        }
    }
    __syncthreads();
}

__device__ __forceinline__ float bf2f(unsigned short b) { return __uint_as_float(((unsigned)b) << 16); }
__device__ __forceinline__ unsigned f2bf(float f) { unsigned u = __float_as_uint(f); return (u + 0x7fffu + ((u >> 16) & 1u)) >> 16; }
__device__ __forceinline__ unsigned pk2(float lo, float hi) { return f2bf(lo) | (f2bf(hi) << 16); }
__device__ __forceinline__ unsigned char f2fp8(float a) { return (unsigned char)((unsigned)__builtin_amdgcn_cvt_pk_fp8_f32(a, 0.f, 0, false) & 0xffu); }
__device__ __forceinline__ unsigned pk4_fp8(float a, float b, float c, float d) { unsigned w = (unsigned)__builtin_amdgcn_cvt_pk_fp8_f32(a, b, 0, false); return (unsigned)__builtin_amdgcn_cvt_pk_fp8_f32(c, d, (int)w, true); }
constexpr float WI_SCALE = 32.0f;
constexpr float WO_SCALE = 64.0f;
constexpr float WGU_SCALE = 32.0f, WD_SCALE = 64.0f;
template <int CTRL> __device__ __forceinline__ float dpp_f(float v) { return __builtin_bit_cast(float, __builtin_amdgcn_update_dpp(0, __builtin_bit_cast(int, v), CTRL, 0xf, 0xf, true)); }
__device__ __forceinline__ float wave_sum(float v) {
    v += dpp_f<0xB1>(v); v += dpp_f<0x4E>(v); v += dpp_f<0x141>(v); v += dpp_f<0x140>(v);
    { const auto r = __builtin_amdgcn_permlane16_swap(__float_as_uint(v), __float_as_uint(v), false, false); v = __uint_as_float(r[0]) + __uint_as_float(r[1]); }
    { const auto r = __builtin_amdgcn_permlane32_swap(__float_as_uint(v), __float_as_uint(v), false, false); v = __uint_as_float(r[0]) + __uint_as_float(r[1]); }
    return v;
}
__device__ __forceinline__ float half_sum(float v) {
    v += dpp_f<0xB1>(v); v += dpp_f<0x4E>(v); v += dpp_f<0x141>(v); v += dpp_f<0x140>(v);
    { const auto r = __builtin_amdgcn_permlane16_swap(__float_as_uint(v), __float_as_uint(v), false, false); v = __uint_as_float(r[0]) + __uint_as_float(r[1]); }
    return v;
}
__device__ __forceinline__ float xhalf_sum(float v) {
    const auto r = __builtin_amdgcn_permlane32_swap(__float_as_uint(v), __float_as_uint(v), false, false); return __uint_as_float(r[0]) + __uint_as_float(r[1]);
}
__device__ __forceinline__ float wave_max(float v) {
    v = fmaxf(v, dpp_f<0xB1>(v)); v = fmaxf(v, dpp_f<0x4E>(v)); v = fmaxf(v, dpp_f<0x141>(v)); v = fmaxf(v, dpp_f<0x140>(v));
    { const auto r = __builtin_amdgcn_permlane16_swap(__float_as_uint(v), __float_as_uint(v), false, false); v = fmaxf(__uint_as_float(r[0]), __uint_as_float(r[1])); }
    { const auto r = __builtin_amdgcn_permlane32_swap(__float_as_uint(v), __float_as_uint(v), false, false); v = fmaxf(__uint_as_float(r[0]), __uint_as_float(r[1])); }
    return v;
}
__device__ __forceinline__ int crow(int r, int hi) { return (r & 3) + 8 * (r >> 2) + 4 * hi; }
__device__ __forceinline__ float silu_f(float x) { return x / (1.0f + __expf(-x)); }
__device__ __forceinline__ float sigmoid_f(float x) { return 1.0f / (1.0f + __expf(-x)); }
__device__ __forceinline__ int v_st(int k, int c) { const int kk = (k & ~0xC) | ((k & 4) << 1) | ((k & 8) >> 1); return ((kk >> 3) * 4 + (c >> 5)) * 512 + ((kk & 7) * 32 + (c & 31)) * 2; }
__device__ __forceinline__ int v_rd_base(int lane) { return ((lane & 3) << 3) | (((lane >> 2) & 3) << 6) | (((lane >> 4) & 1) << 5) | (((lane >> 5) & 1) << 8); }
__host__ __device__ constexpr int v_rd_off(int d0, int ks, int half) { return d0 * 512 + ks * 4096 + half * 2048; }
typedef short v4i16_t __attribute__((ext_vector_type(4)));
__device__ __forceinline__ bf16x8 vfrag(LAS unsigned char* tile_rd  , int d0, int ks) {
    const v4i16_t lo = __builtin_amdgcn_ds_read_tr16_b64_v4i16((LAS v4i16_t*)(tile_rd + v_rd_off(d0, ks, 0)));
    const v4i16_t hi = __builtin_amdgcn_ds_read_tr16_b64_v4i16((LAS v4i16_t*)(tile_rd + v_rd_off(d0, ks, 1)));
    return (bf16x8){lo[0], lo[1], lo[2], lo[3], hi[0], hi[1], hi[2], hi[3]};
}

struct Args { const float* in[35]; float* out; unsigned char* ws; int ph_lo, ph_hi; };

struct Frame { LAS unsigned char* lds; int tid, lane, wave, G, bx, kz; };
#define CAS __attribute__((address_space(4)))
__device__ __forceinline__ const float* kin_(int kz, int i) { return *(const float* const CAS*)((const CAS char*)__builtin_amdgcn_kernarg_segment_ptr() + kz + 8 * i); }
#define KIN(F, i) kin_((F).kz, (i))
#define KOUT(F) ((float*)kin_((F).kz, 35))
#define KWS(F) ((unsigned char*)kin_((F).kz, 36))
static_assert(sizeof(Args) == 37 * 8 + 8, "Args layout");

__device__ __forceinline__ void ph0_mod_tables(Frame& F) {
    const float* c = KIN(F, 1); const float* cctx = KIN(F, 3); const float* wmod = KIN(F, 4);
    LAS float* sv = (LAS float*)F.lds;
    for (int vb = F.bx; vb < 256; vb += F.G) {
    const int l = vb >> 7, rem = vb & 127, nch = rem & 7, kch = rem >> 3, k0 = kch * 64;
    if (F.tid < 192) { const int v = F.tid >> 6, k = F.tid & 63; const float x = (v < 2) ? c[v * DM + k0 + k] : cctx[k0 + k]; sv[v * 64 + k] = silu_f(x); }
    __syncthreads();
    if (F.tid < 384) {
        const int col = nch * 768 + F.tid * 2;
        const float* W = wmod + ((size_t)l * DM + k0) * 6144 + col;
        f32x2 a0 = {0.f, 0.f}, a1 = {0.f, 0.f}, a2 = {0.f, 0.f};
#pragma unroll 8
        for (int k = 0; k < 64; ++k) { const f32x2 w = *(const f32x2*)(W + (size_t)k * 6144); a0 += w * sv[k]; a1 += w * sv[64 + k]; a2 += w * sv[128 + k]; }
        float* mp = (float*)(KWS(F) + WS_MODP) + (size_t)kch * 5 * 6144 + col;
        if (l == 0) { *(f32x2*)(mp + 0 * 6144) = a0; *(f32x2*)(mp + 1 * 6144) = a1; *(f32x2*)(mp + 2 * 6144) = a2; }
        else { *(f32x2*)(mp + 3 * 6144) = a0; *(f32x2*)(mp + 4 * 6144) = a1; }
    }
    __syncthreads();
    }
    const int bx = F.bx;
    unsigned char* tb = KWS(F) + WS_TAB;
    const int gid = bx * NTHR + F.tid, NG = F.G * NTHR;
    const float s128 = 0.08838834764831845f;
    for (int i = gid; i < 5120; i += NG) {
        const int pos = i >> 4, f = i & 15; const int p = pos < 256 ? pos : pos - 256;
        const float inv = powf(10000.0f, -((float)f / 16.0f)); const float ang = (float)p * inv;
        ((float*)(tb + TB_COS))[i] = (float)cos((double)ang); ((float*)(tb + TB_SIN))[i] = (float)sin((double)ang);
    }
    for (int i = gid; i < 32768; i += NG) {
        const int j8 = i & 7, ln = (i >> 3) & 63, ks = (i >> 9) & 7, nb = i >> 12;
        const int n = 32 * nb + (ln & 31), cc = 16 * ks + 8 * (ln >> 5) + j8, part = n >> 7, jj = n & 127, m = (jj * cc) & 127;
        const double a = (double)m / 64.0; const float v = (part == 0 ? (float)cospi(a) : -(float)sinpi(a)) * s128;
        ((bf16_t*)(tb + TB_CS))[i] = (bf16_t)f2bf(v);
    }
    for (int i = gid; i < 65536; i += NG) {
        const int j8 = i & 7, ln = (i >> 3) & 63, ks = (i >> 9) & 15, mb = i >> 13;
        const int m = 32 * mb + (ln & 31), k = 16 * ks + 8 * (ln >> 5) + j8, mpart = m >> 7, k1 = m & 127, part = k >> 7, t1 = k & 127, ph = (k1 * t1) & 127;
        const double a = (double)ph / 64.0; const float cs = (float)cospi(a), sn = (float)sinpi(a);
        const float v = (mpart == 0 ? (part == 0 ? cs : sn) : (part == 0 ? -sn : cs)) * s128;
        ((bf16_t*)(tb + TB_AF))[i] = (bf16_t)f2bf(v);
    }
    for (int i = gid; i < 32768; i += NG) {
        const int j8 = i & 7, ln = (i >> 3) & 63, ks = (i >> 9) & 15, mb = i >> 13;
        const int k2 = 32 * mb + (ln & 31), k = 16 * ks + 8 * (ln >> 5) + j8, part = k >> 7, t2 = k & 127, ps = (k2 * t2) & 127;
        const double a = (double)ps / 64.0; const float v = (part == 0 ? (float)cospi(a) : (float)sinpi(a)) * s128;
        ((bf16_t*)(tb + TB_A3))[i] = (bf16_t)f2bf(v);
    }
    for (int i = gid; i < 16384; i += NG) {
        const int t2 = i >> 7, k1 = i & 127; const double a = (double)((k1 * t2) & 16383) / 8192.0;
        ((f32x2*)(tb + TB_TW))[i] = (f32x2){(float)cospi(a), (float)sinpi(a)};
    }
    const float* gws = KIN(F, 25);
    for (int i = gid; i < 65536; i += NG) ((bf16_t*)(tb + TB_WS))[i] = (bf16_t)f2bf(gws[i]);
}

__device__ __forceinline__ void transpose_item(const float* W, int K, int ldw, int k0, int n_src0, bf16_t* WT, int row_dst0, LAS float* scr, int lane) {
#pragma unroll 8
    for (int i = 0; i < 32; ++i) { const int kk = 2 * i + (lane >> 5); scr[kk * 33 + (lane & 31)] = W[(size_t)(k0 + kk) * ldw + n_src0 + (lane & 31)]; }
    asm volatile("s_waitcnt lgkmcnt(0)" ::: "memory");
    const int c = lane & 7;
#pragma unroll
    for (int j = 0; j < 4; ++j) { const int n = (lane >> 3) + 8 * j; const LAS float* s = scr + (8 * c) * 33 + n;
        u32x4 o; o.x = pk2(s[0 * 33], s[1 * 33]); o.y = pk2(s[2 * 33], s[3 * 33]); o.z = pk2(s[4 * 33], s[5 * 33]); o.w = pk2(s[6 * 33], s[7 * 33]);
        *(u32x4*)(WT + (size_t)(row_dst0 + n) * K + k0 + 8 * c) = o; }
    asm volatile("s_waitcnt lgkmcnt(0)" ::: "memory");
}
__device__ __forceinline__ void transpose_item_fp8(const float* W, int K, int ldw, int k0, int n_src0, unsigned char* WT8, int row_dst0, float scale, LAS float* scr, int lane) {
#pragma unroll 8
    for (int i = 0; i < 64; ++i) { const int kk = 2 * i + (lane >> 5); scr[kk * 33 + (lane & 31)] = W[(size_t)(k0 + kk) * ldw + n_src0 + (lane & 31)]; }
    asm volatile("s_waitcnt lgkmcnt(0)" ::: "memory");
    const int q = lane & 3;
#pragma unroll
    for (int j = 0; j < 2; ++j) { const int n = (lane >> 2) + 16 * j; const LAS float* s = scr + (32 * q) * 33 + n; unsigned w[8];
#pragma unroll
        for (int t = 0; t < 8; ++t) w[t] = pk4_fp8(s[(4 * t) * 33] * scale, s[(4 * t + 1) * 33] * scale, s[(4 * t + 2) * 33] * scale, s[(4 * t + 3) * 33] * scale);
        unsigned char* dst = WT8 + (size_t)(row_dst0 + n) * K + k0 + 32 * q;
        *(u32x4*)dst = (u32x4){w[0], w[1], w[2], w[3]}; *(u32x4*)(dst + 16) = (u32x4){w[4], w[5], w[6], w[7]}; }
    asm volatile("s_waitcnt lgkmcnt(0)" ::: "memory");
}
__device__ __forceinline__ void ph1_convert(Frame& F) {
    {
        const int gid = F.bx * NTHR + F.tid;
        if (gid < 5 * 6144) { const int vec = gid / 6144, n = gid % 6144, l = vec < 3 ? 0 : 1; float s = KIN(F, 5)[l * 6144 + n];
            const float* mp = (const float*)(KWS(F) + WS_MODP) + (size_t)vec * 6144 + n;
#pragma unroll
            for (int kc = 0; kc < 16; ++kc) s += mp[(size_t)kc * 5 * 6144];
            ((float*)(KWS(F) + WS_MOD))[gid] = s; }
    }
    LAS float* scr = (LAS float*)(F.lds + F.wave * 16896);
    const int gw = F.bx * NWAVES + F.wave, NGW = F.G * NWAVES;
    constexpr int I_EVIN = 8 * 80, I_EVOUT = 8 * 32, I_ODIN = 8 * 48, I_ODOUT = 8 * 32, I_DENSE = I_EVIN + I_EVOUT + I_ODIN + I_ODOUT;
    constexpr int I_GU = 64 * 512, I_DN = 64 * 256, NITEMS = I_DENSE + I_GU + I_DN;
    for (int it = gw; it < NITEMS; it += NGW) {
        int r = it;
        if (r < I_EVIN) { const int kb = r / 80, nb = r % 80, n0 = 32 * nb; int src = n0;
            if (n0 >= 1536) { const int u = (n0 - 1536) >> 8, w = (n0 - 1536) & 255; src = (w < 128) ? 1536 + 128 * u + w : 2048 + 128 * u + (w - 128); }
            transpose_item_fp8(KIN(F, 10), DM, 2560, 128 * kb, src, (unsigned char*)(KWS(F) + WS_WEVIN), n0, WI_SCALE, scr, F.lane); continue; } r -= I_EVIN;
        if (r < I_EVOUT) { const int kb = r / 32, nb = r % 32; transpose_item_fp8(KIN(F, 11), DM, 1024, 128 * kb, 32 * nb, (unsigned char*)(KWS(F) + WS_WEVOUT), 32 * nb, WO_SCALE, scr, F.lane); continue; } r -= I_EVOUT;
        if (r < I_ODIN) { const int kb = r / 48, nb = r % 48; transpose_item_fp8(KIN(F, 21), DM, 1536, 128 * kb, 32 * nb, (unsigned char*)(KWS(F) + WS_WODIN), 32 * nb, WI_SCALE, scr, F.lane); continue; } r -= I_ODIN;
        if (r < I_ODOUT) { const int kb = r / 32, nb = r % 32; transpose_item_fp8(KIN(F, 22), DM, 1024, 128 * kb, 32 * nb, (unsigned char*)(KWS(F) + WS_WODOUT), 32 * nb, WO_SCALE, scr, F.lane); continue; } r -= I_ODOUT;
        if (r < I_GU) { const int le = r >> 9, q = r & 511, kb = q >> 6, nb = q & 63, n0 = 32 * nb; const int u = n0 >> 8, w = n0 & 255;
            const int src = (w < 128) ? 128 * u + w : 1024 + 128 * u + (w - 128);
            transpose_item_fp8(KIN(F, 31) + (size_t)le * DM * 2048, DM, 2048, 128 * kb, src, (unsigned char*)(KWS(F) + WS_WGU) + (size_t)le * 2048 * DM, n0, WGU_SCALE, scr, F.lane); continue; } r -= I_GU;
        { const int le = r >> 8, q = r & 255, kb = q >> 5, nb = q & 31;
            transpose_item_fp8(KIN(F, 33) + (size_t)le * DM * 1024, DM, 1024, 128 * kb, 32 * nb, (unsigned char*)(KWS(F) + WS_WD) + (size_t)le * 1024 * DM, 32 * nb, WD_SCALE, scr, F.lane); }
    }
}

__device__ __forceinline__ void mod_row(const float* xrow, const float* sh, const float* sc, unsigned char* orow, int lane) {
    f32x4 x[4], a[4], b[4];
#pragma unroll
    for (int j = 0; j < 4; ++j) { const int d = 4 * lane + 256 * j; x[j] = *(const f32x4*)(xrow + d); a[j] = *(const f32x4*)(sc + d); b[j] = *(const f32x4*)(sh + d); }
    asm volatile("" ::: "memory");
#pragma unroll
    for (int j = 0; j < 4; ++j) { const int d = 4 * lane + 256 * j;
        const f32x4 v = x[j] * (a[j] + 1.0f) + b[j]; *(unsigned*)(orow + d) = pk4_fp8(v[0], v[1], v[2], v[3]); }
}
__device__ __forceinline__ void ph2_modulate(Frame& F) {
    const float* mod = (const float*)(KWS(F) + WS_MOD); unsigned char* U = (unsigned char*)(KWS(F) + WS_U);
    const int gw = F.bx * NWAVES + F.wave, NGW = F.G * NWAVES;
    for (int r = gw; r < T + NCTX; r += NGW) {
        if (r < T) { const int b = r >> 14; mod_row(KIN(F, 0) + (size_t)r * DM, mod + b * 6144, mod + b * 6144 + 1024, U + (size_t)r * DM, F.lane); }
        else { mod_row(KIN(F, 2) + (size_t)(r - T) * DM, mod + 2 * 6144, mod + 2 * 6144 + 1024, U + (size_t)r * DM, F.lane); }
    }
}

struct EvInOrder {
    pg8::StaticOrder so;
    __device__ bool next(int i, pg8::Unit& u) const {
        const long L = (long)i * so.G + so.c;
        if (L < so.nwg) return so.map(L, u);
        const int x = (int)(L - so.nwg); if (x >= 8) return false;
        u.pm = 128 + (x >> 2); u.pn = 2 + (x & 3); u.a0 = 0; u.a1 = 0; u.a2 = 256; return true;
    }
    __device__ __forceinline__ unsigned arow(const pg8::Unit&, int) const { return 0u; }
};
__device__ __forceinline__ int vpos64(int k) { return 32 * ((k >> 2) & 1) + 16 * (k >> 5) + ((k & 3) + 4 * ((k & 31) >> 3)); }
struct EpiEvIn {
    static constexpr bool PERM = false, HAS_PRE = false;
    unsigned char *Q8, *K8, *V8T; bf16_t* Ab; const float* cosT; const float* sinT;
    __device__ __forceinline__ void operator()(const f32x4 (&acc)[2][2][4][2], const pg8::Unit& u, int wr, int wc, int fr, int fq) const {
        const int pn = u.pn;
        if (pn < 4) {
            const int kind = pn >> 1, colbase = (pn & 1) * 256 + wc * 32 + 4 * fq; const bool isctx = u.pm >= 128;
            const float sc = ((kind == 0) ? QSCALE : 1.0f) * (1.0f / WI_SCALE);
#define QK_ROW(ai, m, CS, SN) do { const int row = u.pm * 256 + (ai) * 128 + wr * 64 + (m) * 16 + fr; int b_, key_; \
                if (!isctx) { b_ = row >> 14; key_ = row & (SEQ - 1); } else { const int rc_ = row - T; b_ = rc_ >> 8; key_ = SEQ + (rc_ & 255); } \
                unsigned char* dst = (kind == 0) ? Q8 + (size_t)row * 512 : K8 + (size_t)(b_ * NKEY + key_) * 512; \
                _Pragma("unroll") for (int bj = 0; bj < 2; ++bj) { const f32x4 x1 = acc[ai][bj][m][0], x2 = acc[ai][bj][m][1]; \
                    const f32x4 o1 = (x1 * (CS) - x2 * (SN)) * sc, o2 = (x1 * (SN) + x2 * (CS)) * sc; \
                    *(unsigned*)(dst + colbase + bj * 128) = pk4_fp8(o1[0], o1[1], o1[2], o1[3]); *(unsigned*)(dst + colbase + bj * 128 + 16) = pk4_fp8(o2[0], o2[1], o2[2], o2[3]); } } while (0)
            if (wc & 1) {
#pragma unroll
                for (int mh = 0; mh < 2; ++mh) {
                    f32x4 cs[2], sn[2];
#pragma unroll
                    for (int mm = 0; mm < 2; ++mm) { cs[mm] = (f32x4){1.f, 1.f, 1.f, 1.f}; sn[mm] = (f32x4){0.f, 0.f, 0.f, 0.f};
                        if (!isctx) { const int pos = 256 + (2 * mh + mm) * 16 + fr; cs[mm] = *(const f32x4*)(cosT + pos * 16 + 4 * fq); sn[mm] = *(const f32x4*)(sinT + pos * 16 + 4 * fq); } }
                    asm volatile("" ::: "memory");
#pragma unroll
                    for (int ai = 0; ai < 2; ++ai)
#pragma unroll
                        for (int mm = 0; mm < 2; ++mm) QK_ROW(ai, 2 * mh + mm, cs[mm], sn[mm]);
                }
            } else {
                f32x4 cs[2], sn[2];
#pragma unroll
                for (int ai = 0; ai < 2; ++ai) { cs[ai] = (f32x4){1.f, 1.f, 1.f, 1.f}; sn[ai] = (f32x4){0.f, 0.f, 0.f, 0.f};
                    if (!isctx) { const int pos = ((u.pm * 256 + ai * 128 + wr * 64) & (SEQ - 1)) >> 6; cs[ai] = *(const f32x4*)(cosT + pos * 16 + 4 * fq); sn[ai] = *(const f32x4*)(sinT + pos * 16 + 4 * fq); } }
                asm volatile("" ::: "memory");
#pragma unroll
                for (int ai = 0; ai < 2; ++ai)
#pragma unroll
                    for (int m = 0; m < 4; ++m) QK_ROW(ai, m, cs[ai], sn[ai]);
            }
#undef QK_ROW
        } else if (pn < 6) {
            const int colbase = (pn & 1) * 256 + wc * 32 + 4 * fq;
#pragma unroll
            for (int ai = 0; ai < 2; ++ai)
#pragma unroll
                for (int m = 0; m < 4; ++m) {
                    const int row = u.pm * 256 + ai * 128 + wr * 64 + m * 16 + fr; const bool isctx = row >= T;
                    int b, key;
                    if (!isctx) { b = row >> 14; key = row & (SEQ - 1); } else { const int rc = row - T; b = rc >> 8; key = SEQ + (rc & 255); }
                    const size_t kofs = (size_t)(key & ~63) + vpos64(key & 63);
#pragma unroll
                    for (int bj = 0; bj < 2; ++bj)
#pragma unroll
                        for (int n = 0; n < 2; ++n) { const f32x4 x = acc[ai][bj][m][n] * (1.0f / WI_SCALE); const unsigned w = pk4_fp8(x[0], x[1], x[2], x[3]); const int vcol = colbase + bj * 128 + n * 16;
                            unsigned char* dst = V8T + ((size_t)(b * 4 + (vcol >> 7)) * 128 + (vcol & 127)) * NKEY + kofs;
                            dst[0] = (unsigned char)(w & 0xff); dst[NKEY] = (unsigned char)((w >> 8) & 0xff); dst[2 * NKEY] = (unsigned char)((w >> 16) & 0xff); dst[3 * NKEY] = (unsigned char)(w >> 24); }
                }
        } else {
            const int colbase = (pn - 6) * 128 + wc * 32 + 4 * fq;
#pragma unroll
            for (int ai = 0; ai < 2; ++ai)
#pragma unroll
                for (int m = 0; m < 4; ++m) {
                    const int row = u.pm * 256 + ai * 128 + wr * 64 + m * 16 + fr; if (row >= T) continue;
                    bf16_t* dst = Ab + (size_t)row * 512 + colbase;
#pragma unroll
                    for (int n = 0; n < 2; ++n) { const f32x4 v = acc[ai][0][m][n] * (1.0f / WI_SCALE), g = acc[ai][1][m][n] * (1.0f / WI_SCALE); f32x4 o;
#pragma unroll
                        for (int j = 0; j < 4; ++j) o[j] = v[j] * sigmoid_f(g[j]);
                        u32x2 w; w.x = pk2(o[0], o[1]); w.y = pk2(o[2], o[3]); *(u32x2*)(dst + n * 16) = w; }
                }
        }
    }
};

__device__ __forceinline__ void ph4_conv(Frame& F) {
    const bf16_t* Ab = (const bf16_t*)(KWS(F) + WS_AB); unsigned char* MIX = (unsigned char*)(KWS(F) + WS_MIX);
    const float* cw = KIN(F, 12); const float* cb = KIN(F, 13); const float* lg = KIN(F, 14); const float* lb = KIN(F, 15);
    LAS bf16_t* At = (LAS bf16_t*)F.lds;
    LAS float* Yt = (LAS float*)(F.lds + 65536);
    const int ch = F.tid;
    float w[31];
#pragma unroll
    for (int j = 0; j < 31; ++j) w[j] = cw[j * 512 + ch];
    const float bias = cb[ch];
#define CONV_STAGE(tile_) do { const int b_ = (tile_) >> 9, t0_ = ((tile_) & 511) * 32; \
        _Pragma("unroll") for (int k_ = 0; k_ < 8; ++k_) { const int row_ = F.wave + 8 * k_; if (row_ < 62) { const int t_ = t0_ - 15 + row_; \
            if (t_ >= 0 && t_ < SEQ) __builtin_amdgcn_global_load_lds((const unsigned*)(Ab + ((size_t)(b_ * SEQ + t_)) * 512 + F.lane * 8), (LAS unsigned*)(At + row_ * 512), 16, 0, 0); \
            else { const unsigned z_ = (unsigned)F.kz; const u32x4 zv_ = {z_, z_, z_, z_}; *(LAS u32x4*)(At + row_ * 512 + F.lane * 8) = zv_; } } } } while (0)
    const f32x4 g0 = *(const f32x4*)(lg + 8 * F.lane), g1 = *(const f32x4*)(lg + 8 * F.lane + 4), b0 = *(const f32x4*)(lb + 8 * F.lane), b1 = *(const f32x4*)(lb + 8 * F.lane + 4);
    if (F.bx < T / 32) CONV_STAGE(F.bx);
    for (int tile = F.bx; tile < T / 32; tile += F.G) {
        const int b = tile >> 9, t0 = (tile & 511) * 32;
        asm volatile("s_waitcnt vmcnt(0)" ::: "memory");
        __syncthreads();
        float a[62];
#pragma unroll
        for (int r = 0; r < 62; ++r) a[r] = bf2f(At[r * 512 + ch]);
#pragma unroll
        for (int t = 0; t < 32; ++t) { float y = bias;
#pragma unroll
            for (int j = 0; j < 31; ++j) y = fmaf(a[t + j], w[j], y);
            Yt[t * 512 + ch] = y; }
        __syncthreads();
        if (tile + F.G < T / 32) CONV_STAGE(tile + F.G);
#pragma unroll
        for (int q = 0; q < 4; ++q) { const int t = F.wave * 4 + q; const LAS float* yr = Yt + t * 512 + 8 * F.lane;
            const f32x4 y0 = *(const LAS f32x4*)yr, y1 = *(const LAS f32x4*)(yr + 4);
            float s = (y0[0] + y0[1]) + (y0[2] + y0[3]) + (y1[0] + y1[1]) + (y1[2] + y1[3]);
            const float mean = wave_sum(s) * (1.0f / 512.0f);
            const f32x4 d0 = y0 - mean, d1 = y1 - mean;
            float q2 = (d0[0] * d0[0] + d0[1] * d0[1]) + (d0[2] * d0[2] + d0[3] * d0[3]) + (d1[0] * d1[0] + d1[1] * d1[1]) + (d1[2] * d1[2] + d1[3] * d1[3]);
            const float rstd = 1.0f / sqrtf(wave_sum(q2) * (1.0f / 512.0f) + LN_EPS);
            f32x4 o0 = d0 * rstd * g0 + b0, o1 = d1 * rstd * g1 + b1;
#pragma unroll
            for (int j = 0; j < 4; ++j) { o0[j] = silu_f(o0[j]); o1[j] = silu_f(o1[j]); }
            u32x2 wv; wv.x = pk4_fp8(o0[0], o0[1], o0[2], o0[3]); wv.y = pk4_fp8(o1[0], o1[1], o1[2], o1[3]);
            *(u32x2*)(MIX + (size_t)(b * SEQ + t0 + t) * 1024 + 8 * F.lane) = wv; }
        __syncthreads();
    }
#undef CONV_STAGE
}

namespace att {
constexpr int KVBLK = 64;
constexpr int SHM_V = 128 * 64, SHM_K = 64 * 64;
constexpr int SHM_1 = 32 * 64;
constexpr int NBUF = 8, DIST = 4, TILEB = SHM_V + SHM_1 + SHM_K;
constexpr int OFF_T = 0, OFF_WS = NBUF * TILEB;
constexpr int OFF_NEG = OFF_WS + 2048;
constexpr float PREF = 6.0f, PMAXLOG = 8.0f;
#define SBAR() __builtin_amdgcn_sched_barrier(0)
#define MX3(a, b, c) __builtin_fmaxf(__builtin_fmaxf((a), (b)), (c))
typedef int v8i32a __attribute__((ext_vector_type(8)));
__device__ __forceinline__ f32x16 mfma8(v8i32a a, v8i32a b, f32x16 c) { return __builtin_amdgcn_mfma_scale_f32_32x32x64_f8f6f4(a, b, c, 0, 0, 0, 0x7F7F7F7F, 0, 0x7F7F7F7F); }
template <bool FIRST> __device__ __forceinline__ void partialSM(f32x16& p0, f32x16& p1, f32x16& negm, float& alpha) {
    float a = MX3(p0[0], p0[1], p1[0]), b = MX3(p0[2], p0[3], p1[1]); a = MX3(a, p1[2], p1[3]);
#pragma unroll
    for (int r = 4; r < 16; r += 4) { a = MX3(a, p0[r], p0[r + 1]); b = MX3(b, p0[r + 2], p0[r + 3]); a = MX3(a, p1[r], p1[r + 1]); b = MX3(b, p1[r + 2], p1[r + 3]); }
    float pmax = fmaxf(a, b);
    { auto rr = __builtin_amdgcn_permlane32_swap(__float_as_uint(pmax), __float_as_uint(pmax), false, false);
      pmax = fmaxf(__uint_as_float(rr[0]), __uint_as_float(rr[1])); }
    alpha = 1.f;
    if (FIRST || __builtin_expect(__any(pmax > PMAXLOG), 0)) {
        const float dl = FIRST ? (pmax - PREF) : fmaxf(pmax - PREF, 0.f); const float nm = negm[0] - dl; alpha = __builtin_amdgcn_exp2f(-dl);
#pragma unroll
        for (int r = 0; r < 16; ++r) { p0[r] -= dl; p1[r] -= dl; negm[r] = nm; }
    }
#pragma unroll
    for (int r = 0; r < 16; ++r) p0[r] = __builtin_amdgcn_exp2f(p0[r]);
}
__device__ __forceinline__ void finishSM(f32x16& p0, f32x16& p1, v8i32a& pf) {
#pragma unroll
    for (int r = 0; r < 16; ++r) p1[r] = __builtin_amdgcn_exp2f(p1[r]);
#pragma unroll
    for (int i = 0; i < 4; ++i) { pf[i] = (int)pk4_fp8(p0[4 * i], p0[4 * i + 1], p0[4 * i + 2], p0[4 * i + 3]); pf[4 + i] = (int)pk4_fp8(p1[4 * i], p1[4 * i + 1], p1[4 * i + 2], p1[4 * i + 3]); }
}
__device__ __forceinline__ v8i32a frag32(const LAS unsigned char* base, int a0, int a1) {
    const bf16x8 lo = *(const LAS bf16x8*)(base + a0), hi = *(const LAS bf16x8*)(base + a1);
    return __builtin_bit_cast(v8i32a, __builtin_shufflevector(lo, hi, 0, 1, 2, 3, 4, 5, 6, 7, 8, 9, 10, 11, 12, 13, 14, 15));
}
__device__ __forceinline__ void attn_pass(const unsigned char* __restrict__ Qw, const unsigned char* __restrict__ Kh, const unsigned char* __restrict__ Vt, LAS unsigned char* lds, f32x16 (&o)[4], f32x16& lacc, const int tid, const int wid) {
    const int lane = tid & 63, r32 = lane & 31, hi = lane >> 5;
    LAS float* al_l = (LAS float*)(lds + OFF_WS) + wid * 64 + 32;
    f32x16 negm = f32x16{}; lacc = f32x16{};
#pragma unroll
    for (int d = 0; d < 4; ++d) o[d] = f32x16{};
    const v8i32a qf = __builtin_bit_cast(v8i32a, __builtin_shufflevector(*(const bf16x8*)Qw, *(const bf16x8*)(Qw + 16), 0, 1, 2, 3, 4, 5, 6, 7, 8, 9, 10, 11, 12, 13, 14, 15));
    const int sw = (r32 >> 2) & 3, a0 = r32 * 64 + (((2 * hi) ^ sw) << 4), a1 = r32 * 64 + (((2 * hi + 1) ^ sw) << 4);
    const int drow = 16 * wid + (lane >> 2), dch = (lane & 3) ^ ((drow >> 2) & 3);
    const unsigned vsrc = (unsigned)(drow * NKEY + dch * 16), ksrc = (unsigned)(drow * 512 + dch * 16); const bool kw = wid < 4;
    LAS unsigned char* T_lds = lds + OFF_T;
#define DMA(t, bi) do { __builtin_amdgcn_global_load_lds((const unsigned*)((const char*)Vt + (size_t)(t) * 64 + vsrc), (LAS unsigned*)(T_lds + (bi) * TILEB + wid * 1024), 16, 0, 0); \
    if (kw) __builtin_amdgcn_global_load_lds((const unsigned*)((const char*)Kh + (size_t)(t) * (64 * 512) + ksrc), (LAS unsigned*)(T_lds + (bi) * TILEB + SHM_V + SHM_1 + wid * 1024), 16, 0, 0); } while (0)
#define WAITBAR(n) do { if (kw) asm volatile("s_waitcnt vmcnt(%0) lgkmcnt(0)" :: "n"(2 * (n)) : "memory"); else asm volatile("s_waitcnt vmcnt(%0) lgkmcnt(0)" :: "n"(n) : "memory"); \
    __builtin_amdgcn_s_barrier(); asm volatile("" ::: "memory"); } while (0)
#define RESC(a) do { if (__any((a) < 1.f)) { if (hi == 0) al_l[r32] = (a); asm volatile("s_waitcnt lgkmcnt(0)" ::: "memory"); \
    _Pragma("unroll") for (int r = 0; r < 16; ++r) { const float f_ = al_l[crow(r, hi)]; o[0][r] *= f_; o[1][r] *= f_; o[2][r] *= f_; o[3][r] *= f_; lacc[r] *= f_; } } } while (0)
#define QKT(P0, P1, bi) do { const LAS unsigned char* kb_ = T_lds + (bi) * TILEB + SHM_V + SHM_1; P0 = mfma8(frag32(kb_, a0, a1), qf, negm); P1 = mfma8(frag32(kb_ + 2048, a0, a1), qf, negm); } while (0)
#ifndef MF8_ACC
#define MF8_ACC "+v"
#endif
#define MF8(acc_, v_) asm volatile("v_mfma_scale_f32_32x32x64_f8f6f4 %0, %1, %2, %0, %3, %3 op_sel_hi:[0,0,0]" : MF8_ACC(acc_) : "v"(pf), "v"(v_), "v"(one_sc))
#define PV(bi) do { const LAS unsigned char* vb_ = T_lds + (bi) * TILEB; { const v8i32a v0_ = frag32(vb_, a0, a1), v1_ = frag32(vb_ + 2048, a0, a1); asm volatile("s_nop 1" ::: ); MF8(o[0], v0_); MF8(o[1], v1_); } \
    { const v8i32a v2_ = frag32(vb_ + 4096, a0, a1), v3_ = frag32(vb_ + 6144, a0, a1); MF8(o[2], v2_); MF8(o[3], v3_); } \
    { const v8i32a v4_ = frag32(vb_ + 8192, a0, a1); MF8(lacc, v4_); } } while (0)
    f32x16 pA0, pA1, pB0, pB1; v8i32a pf; constexpr int NT = NKEY / KVBLK;
    const int one_sc = 0x7F7F7F7F;
#define MFQK(P_, kf_) P_ = mfma8(kf_, qf, negm)
#define EX8(P_, b_) do { _Pragma("unroll") for (int r_ = 0; r_ < 8; ++r_) P_[(b_) + r_] = __builtin_amdgcn_exp2f(P_[(b_) + r_]); } while (0)
#if defined(EXP_EXTRA_MFMA)
#define XMF() do { const v8i32a vn_ = frag32(lds + OFF_NEG, a0, a1); MF8(lacc, vn_); MF8(lacc, v4_); } while (0)
#else
#define XMF() do { } while (0)
#endif
#if defined(EXP_EXTRA_LDS)
#define XTRA(A_, B_) do { _Pragma("unroll") for (int r_ = 0; r_ < 5; ++r_) { const v8i32a t_ = frag32(vb_ + 2048 * r_, a0, a1); asm volatile("" :: "v"(t_)); } } while (0)
#elif defined(EXP_EXTRA_EXP)
#define XTRA(A_, B_) do { _Pragma("unroll") for (int r_ = 0; r_ < 16; ++r_) { float t_; asm volatile("v_exp_f32 %0, %1" : "=v"(t_) : "v"(A_[r_])); asm volatile("v_exp_f32 %0, %1" : "=v"(t_) : "v"(B_[r_])); } } while (0)
#elif defined(EXP_EXTRA_ADD)
#define XTRA(A_, B_) do { _Pragma("unroll") for (int r_ = 0; r_ < 16; ++r_) { float t_; asm volatile("v_add_f32 %0, %1, %1" : "=v"(t_) : "v"(A_[r_])); asm volatile("v_add_f32 %0, %1, %1" : "=v"(t_) : "v"(B_[r_])); } } while (0)
#else
#define XTRA(A_, B_) do { } while (0)
#endif
#define STEP(C0, C1, P0, P1, HAVEPREV, FIRSTT, tnext, dodma) do { \
    if (dodma) DMA(tnext, bd); \
    const LAS unsigned char* kb_ = T_lds + bc * TILEB + SHM_V + SHM_1; const LAS unsigned char* vb_ = T_lds + bp * TILEB; \
    const v8i32a kf0_ = frag32(kb_, a0, a1), kf1_ = frag32(kb_ + 2048, a0, a1); v8i32a v0_, v1_, v2_, v3_, v4_; if (HAVEPREV) { v0_ = frag32(vb_, a0, a1); v1_ = frag32(vb_ + 2048, a0, a1); } \
    SBAR(); MFQK(C0, kf0_); if (HAVEPREV) EX8(P1, 0); SBAR(); \
    MFQK(C1, kf1_); if (HAVEPREV) { EX8(P1, 8); _Pragma("unroll") for (int i_ = 0; i_ < 4; ++i_) { pf[i_] = (int)pk4_fp8(P0[4 * i_], P0[4 * i_ + 1], P0[4 * i_ + 2], P0[4 * i_ + 3]); pf[4 + i_] = (int)pk4_fp8(P1[4 * i_], P1[4 * i_ + 1], P1[4 * i_ + 2], P1[4 * i_ + 3]); } } SBAR(); \
    float al_ = 1.f; \
    if (HAVEPREV) { asm volatile("s_nop 1" ::: ); MF8(o[0], v0_); SBAR(); MF8(o[1], v1_); v2_ = frag32(vb_ + 4096, a0, a1); v3_ = frag32(vb_ + 6144, a0, a1); v4_ = frag32(vb_ + 8192, a0, a1); SBAR(); } \
    else { asm volatile("s_nop 15\n\ts_nop 15\n\ts_nop 15\n\ts_nop 15" ::: "memory"); }     \
    float mxa_ = MX3(C0[0], C0[1], C1[0]), mxb_ = MX3(C0[2], C0[3], C1[1]); mxa_ = MX3(mxa_, C1[2], C1[3]); \
    _Pragma("unroll") for (int r_ = 4; r_ < 16; r_ += 4) { mxa_ = MX3(mxa_, C0[r_], C0[r_ + 1]); mxb_ = MX3(mxb_, C0[r_ + 2], C0[r_ + 3]); mxa_ = MX3(mxa_, C1[r_], C1[r_ + 1]); mxb_ = MX3(mxb_, C1[r_ + 2], C1[r_ + 3]); } \
    float pm_ = fmaxf(mxa_, mxb_); { auto rr_ = __builtin_amdgcn_permlane32_swap(__float_as_uint(pm_), __float_as_uint(pm_), false, false); pm_ = fmaxf(__uint_as_float(rr_[0]), __uint_as_float(rr_[1])); } \
    SBAR(); \
    if (HAVEPREV) { MF8(o[2], v2_); SBAR(); MF8(o[3], v3_); SBAR(); } \
    if (FIRSTT || __builtin_expect(__any(pm_ > PMAXLOG), 0)) { const float dl_ = FIRSTT ? (pm_ - PREF) : fmaxf(pm_ - PREF, 0.f); const float nm_ = negm[0] - dl_; al_ = __builtin_amdgcn_exp2f(-dl_); \
        _Pragma("unroll") for (int r_ = 0; r_ < 16; ++r_) { C0[r_] -= dl_; C1[r_] -= dl_; negm[r_] = nm_; } } \
    SBAR(); \
    if (HAVEPREV) { MF8(lacc, v4_); XMF(); SBAR(); } \
    EX8(C0, 0); EX8(C0, 8); XTRA(C0, C1); SBAR(); \
    if (HAVEPREV) { if (__any(al_ < 1.f)) { asm volatile("s_nop 15\n\ts_nop 15" ::: "memory"); if (hi == 0) al_l[r32] = al_; asm volatile("s_waitcnt lgkmcnt(0)" ::: "memory"); \
        _Pragma("unroll") for (int r_ = 0; r_ < 16; ++r_) { const float f_ = al_l[crow(r_, hi)]; o[0][r_] *= f_; o[1][r_] *= f_; o[2][r_] *= f_; o[3][r_] *= f_; lacc[r_] *= f_; } } } \
    } while (0)
    int bp = 7, bc = 0, bd = 4;
#define ROT() do { bp = bc; bc = (bc + 1) & (NBUF - 1); bd = (bd + 1) & (NBUF - 1); } while (0)
#define XBAR() do { } while (0)
    DMA(0, 0); DMA(1, 1); DMA(2, 2); DMA(3, 3); WAITBAR(3);
    STEP(pA0, pA1, pB0, pB1, false, true, 4, true); WAITBAR(2); ROT();
#pragma unroll 1
    for (int j = 1; j + 1 < NT; j += 2) {
        const bool more0 = (j + 4 < NT), more1 = (j + 5 < NT);
        STEP(pB0, pB1, pA0, pA1, true, false, j + 4, more0); ROT();
        STEP(pA0, pA1, pB0, pB1, true, false, j + 5, more1);
        if (more1) WAITBAR(2); else if (more0) WAITBAR(1); else WAITBAR(0);
        ROT();
    }
    STEP(pB0, pB1, pA0, pA1, true, false, 0, false); WAITBAR(0); ROT();
    { EX8(pB1, 0); EX8(pB1, 8);
#pragma unroll
      for (int i_ = 0; i_ < 4; ++i_) { pf[i_] = (int)pk4_fp8(pB0[4 * i_], pB0[4 * i_ + 1], pB0[4 * i_ + 2], pB0[4 * i_ + 3]); pf[4 + i_] = (int)pk4_fp8(pB1[4 * i_], pB1[4 * i_ + 1], pB1[4 * i_ + 2], pB1[4 * i_ + 3]); }
      SBAR(); PV(bp); }
#undef STEP
#undef MFQK
#undef EX8
    __syncthreads();
#undef ROT
#undef DMA
#undef WAITBAR
#undef RESC
#undef QKT
#undef PV
#undef MF8
}
}

__device__ __forceinline__ void ph4_attention(Frame& F) {
    const unsigned char* Q8 = (const unsigned char*)(KWS(F) + WS_Q); const unsigned char* K8 = (const unsigned char*)(KWS(F) + WS_K); const unsigned char* V8T = (const unsigned char*)(KWS(F) + WS_V);
    float* O0 = (float*)(KWS(F) + WS_O0); unsigned char* MIX = (unsigned char*)(KWS(F) + WS_MIX); const float* gn = KIN(F, 20);
    const int lane = F.lane, wid = F.wave;
    float lam;
    { const float a = wave_sum(KIN(F, 16)[lane] * KIN(F, 17)[lane]), b = wave_sum(KIN(F, 18)[lane] * KIN(F, 19)[lane]); lam = __builtin_bit_cast(float, __builtin_amdgcn_readfirstlane(__builtin_bit_cast(int, __expf(a) - __expf(b) + LAM_INIT0))); }
    __syncthreads();
    const unsigned kz_ = (unsigned)F.kz;
    for (int i = F.tid; i < att::NBUF * (att::SHM_1 / 16); i += NTHR) { const int bi = i / (att::SHM_1 / 16), q = i % (att::SHM_1 / 16);
        *(LAS u32x4*)(F.lds + att::OFF_T + bi * att::TILEB + att::SHM_V + q * 16) = (u32x4){0x38383838u + kz_, 0x38383838u + kz_, 0x38383838u + kz_, 0x38383838u + kz_}; }
#if defined(EXP_EXTRA_MFMA)
    for (int i = F.tid; i < 128; i += NTHR) *(LAS u32x4*)(F.lds + att::OFF_NEG + i * 16) = (u32x4){0xB8B8B8B8u + kz_, 0xB8B8B8B8u + kz_, 0xB8B8B8B8u + kz_, 0xB8B8B8B8u + kz_};
#endif
    __syncthreads();
    const int x = F.bx & 7, jb = F.bx >> 3;
    for (int vb = x; vb < 8; vb += 8) { const int b = vb >> 2, h = vb & 3;
    for (int qb = jb; qb < SEQ / 256; qb += (F.G >> 3)) {
        const long rowbase = (long)b * SEQ + qb * 256 + wid * 32;
        f32x16 o[4]; f32x16 lacc;
#pragma unroll 1
        for (int c = 0; c < 2; ++c) {
            const unsigned char* Qw = Q8 + (rowbase + (lane & 31)) * 512 + h * 128 + c * 64 + (lane >> 5) * 32;
            const unsigned char* Kh = K8 + (long)b * NKEY * 512 + h * 128 + c * 64;
            const unsigned char* Vt = V8T + (long)(b * 4 + h) * 128 * NKEY;
            att::attn_pass(Qw, Kh, Vt, F.lds, o, lacc, F.tid, F.wave);
            int lane_e = lane; asm volatile("" : "+v"(lane_e));
            const int r32 = lane_e & 31, hi = lane_e >> 5;
            asm volatile("s_nop 15\n\ts_nop 15" : "+v"(lacc));
            float rli[16];
#pragma unroll
            for (int r = 0; r < 16; ++r) rli[r] = __builtin_amdgcn_rcpf(lacc[r]);
            if (c == 0) {
#pragma unroll
                for (int r = 0; r < 16; ++r) { const long grow = rowbase + crow(r, hi);
#pragma unroll
                    for (int d0 = 0; d0 < 4; ++d0) O0[grow * 512 + h * 128 + d0 * 32 + r32] = o[d0][r] * rli[r]; }
            } else {
                const float g0 = gn[r32], g1 = gn[32 + r32], g2 = gn[64 + r32], g3 = gn[96 + r32];
                float ov[16][4];
#pragma unroll
                for (int r = 0; r < 16; ++r) { const float* op = O0 + (rowbase + crow(r, hi)) * 512 + h * 128 + r32; ov[r][0] = op[0]; ov[r][1] = op[32]; ov[r][2] = op[64]; ov[r][3] = op[96]; }
                asm volatile("" ::: "memory");
#pragma unroll
                for (int r = 0; r < 16; ++r) { const long grow = rowbase + crow(r, hi);
                    const float v0 = ov[r][0] - lam * (o[0][r] * rli[r]), v1 = ov[r][1] - lam * (o[1][r] * rli[r]), v2 = ov[r][2] - lam * (o[2][r] * rli[r]), v3 = ov[r][3] - lam * (o[3][r] * rli[r]);
                    float ss = (v0 * v0 + v1 * v1) + (v2 * v2 + v3 * v3);
                    ss = half_sum(ss);
                    const float scl = (1.0f - LAM_INIT0) / sqrtf(ss * (1.0f / 128.0f) + LN_EPS);
                    unsigned char* mp = MIX + grow * 1024 + 512 + h * 128 + r32;
                    mp[0] = f2fp8(v0 * scl * g0); mp[32] = f2fp8(v1 * scl * g1); mp[64] = f2fp8(v2 * scl * g2); mp[96] = f2fp8(v3 * scl * g3);
                    if ((r & 3) == 3) asm volatile("" ::: "memory"); }
            }
        }
    } }
}

__device__ __forceinline__ void ph_router(Frame& F, int layer, const float* hin) {
    const float* mod = (const float*)(KWS(F) + WS_MOD) + (size_t)(layer * 3) * 6144;
    const bf16_t* Y = (const bf16_t*)(KWS(F) + WS_Y); float* H1 = (float*)(KWS(F) + WS_H1); unsigned char* U2 = (unsigned char*)(KWS(F) + WS_U2);
    const float* lng = KIN(F, 6) + layer * DM; const float* lnb = KIN(F, 7) + layer * DM;
    const float* rw = KIN(F, 29) + (size_t)layer * DM * NE; const float* rb = KIN(F, 30) + layer * NE;
    unsigned* gcnt = (unsigned*)(KWS(F) + WS_CTL) + CW_CNT + layer * NE;
    unsigned* list = (unsigned*)(KWS(F) + WS_LIST); float* gates = (float*)(KWS(F) + WS_GATES);
    constexpr int RWS = 1028, RSEL = 131584, RVEC = RSEL + 10240;
    LAS float* rwT = (LAS float*)F.lds;
    LAS int* sel_e = (LAS int*)(F.lds + RSEL);
    LAS float* sel_g = (LAS float*)(F.lds + RSEL + 2048);
    LAS unsigned* lcnt = (LAS unsigned*)(F.lds + RSEL + 4096);
    LAS unsigned* lbase = lcnt + 32;
    LAS unsigned* lpos = lcnt + 64;
    LAS float* vG = (LAS float*)(F.lds + RVEC);
    const int lane = F.lane;
    for (int i = F.tid; i < DM * NE; i += NTHR) { const int d = i >> 5, e = i & 31; rwT[e * RWS + d] = rw[i]; }
    __syncthreads();
    for (int blk = F.bx; blk < T / 128; blk += F.G) {
        const int r0 = blk * 128, b = r0 >> 14;
        const float* g1 = mod + b * 6144 + 2048; const float* sh2 = mod + b * 6144 + 3072; const float* sc2 = mod + b * 6144 + 4096;
        if (F.tid < 32) lcnt[F.tid] = 0u;
        for (int i = F.tid; i < DM; i += NTHR) { vG[i] = g1[i]; vG[DM + i] = lng[i]; vG[2 * DM + i] = lnb[i]; vG[3 * DM + i] = sc2[i] + 1.0f; vG[4 * DM + i] = sh2[i]; }
        __syncthreads();
        f32x4 nx[2][4]; u32x2 ny[2][4];
#pragma unroll
        for (int t = 0; t < 2; ++t)
#pragma unroll
            for (int j = 0; j < 4; ++j) { const int d = 4 * lane + 256 * j; const size_t rr = (size_t)(r0 + F.wave * 16 + t); nx[t][j] = *(const f32x4*)(hin + rr * DM + d); ny[t][j] = *(const u32x2*)(Y + rr * DM + d); }
        for (int qq = 0; qq < 8; ++qq) {
            int lane4 = 4 * lane; asm volatile("" : "+v"(lane4));
            const int tl0 = F.wave * 16 + 2 * qq;
            f32x4 pre[2][4]; float s1[2] = {0.f, 0.f}, s2[2] = {0.f, 0.f};
#pragma unroll
            for (int t = 0; t < 2; ++t)
#pragma unroll
                for (int j = 0; j < 4; ++j) { const int d = lane4 + 256 * j; const f32x4 x = nx[t][j]; const u32x2 yw = ny[t][j]; const f32x4 g = *(const LAS f32x4*)(vG + d);
                    f32x4 y; y[0] = __uint_as_float(yw.x << 16); y[1] = __uint_as_float(yw.x & 0xffff0000u); y[2] = __uint_as_float(yw.y << 16); y[3] = __uint_as_float(yw.y & 0xffff0000u);
                    const f32x4 p_ = x * ALPHA + g * y; pre[t][j] = p_; s1[t] += (p_[0] + p_[1]) + (p_[2] + p_[3]); s2[t] += (p_[0] * p_[0] + p_[1] * p_[1]) + (p_[2] * p_[2] + p_[3] * p_[3]); }
            if (qq + 1 < 8) {
#pragma unroll
                for (int t = 0; t < 2; ++t)
#pragma unroll
                    for (int j = 0; j < 4; ++j) { const int d = lane4 + 256 * j; const size_t rr = (size_t)(r0 + tl0 + 2 + t); nx[t][j] = *(const f32x4*)(hin + rr * DM + d); ny[t][j] = *(const u32x2*)(Y + rr * DM + d); } }
            s1[0] = wave_sum(s1[0]); s1[1] = wave_sum(s1[1]); s2[0] = wave_sum(s2[0]); s2[1] = wave_sum(s2[1]);
            f32x4 u2[2][4];
#pragma unroll
            for (int t = 0; t < 2; ++t) { const float mean = s1[t] * (1.0f / DM); const float var = fmaxf(s2[t] * (1.0f / DM) - mean * mean, 0.f); const float rstd = 1.0f / sqrtf(var + LN_EPS); const size_t row = (size_t)(r0 + tl0 + t);
#pragma unroll
                for (int j = 0; j < 4; ++j) { const int d = lane4 + 256 * j; const f32x4 h = (pre[t][j] - mean) * rstd * *(const LAS f32x4*)(vG + DM + d) + *(const LAS f32x4*)(vG + 2 * DM + d);
                    *(f32x4*)(H1 + row * DM + d) = h;
                    u2[t][j] = h * *(const LAS f32x4*)(vG + 3 * DM + d) + *(const LAS f32x4*)(vG + 4 * DM + d);
                    *(unsigned*)(U2 + row * DM + d) = pk4_fp8(u2[t][j][0], u2[t][j][1], u2[t][j][2], u2[t][j][3]); } }
            f32x2 up[4][4];
#pragma unroll
            for (int j = 0; j < 4; ++j)
#pragma unroll
                for (int i = 0; i < 4; ++i) { up[j][i][0] = u2[0][j][i]; up[j][i][1] = u2[1][j][i]; }
            f32x2 P[32];
            f32x4 wc[4], wn[4];
#pragma unroll
            for (int j = 0; j < 4; ++j) wc[j] = *(const LAS f32x4*)(rwT + 4 * lane + 256 * j);
#pragma unroll
            for (int e = 0; e < 32; ++e) {
                if (e + 1 < 32) {
#pragma unroll
                    for (int j = 0; j < 4; ++j) wn[j] = *(const LAS f32x4*)(rwT + (e + 1) * RWS + 4 * lane + 256 * j); }
                f32x2 a0 = {0.f, 0.f}, a1 = {0.f, 0.f};
#pragma unroll
                for (int j = 0; j < 4; ++j) { f32x2 w0 = {wc[j][0], wc[j][0]}, w1 = {wc[j][1], wc[j][1]}, w2 = {wc[j][2], wc[j][2]}, w3 = {wc[j][3], wc[j][3]};
                    a0 = __builtin_elementwise_fma(up[j][0], w0, a0); a1 = __builtin_elementwise_fma(up[j][1], w1, a1); a0 = __builtin_elementwise_fma(up[j][2], w2, a0); a1 = __builtin_elementwise_fma(up[j][3], w3, a1); }
                P[e] = a0 + a1;
#pragma unroll
                for (int j = 0; j < 4; ++j) wc[j] = wn[j];
                if ((e & 3) == 3) __builtin_amdgcn_sched_barrier(0); }
#define RSTEP(N, MASK, CTRL) do { _Pragma("unroll") for (int i = 0; i < (N); ++i) { int lm_ = lane & (MASK); asm volatile("" : "+v"(lm_)); const bool up_ = lm_ != 0;     \
                const f32x2 sv = up_ ? P[i] : P[i + (N)], kv = up_ ? P[i + (N)] : P[i]; f32x2 rv; rv[0] = dpp_f<CTRL>(sv[0]); rv[1] = dpp_f<CTRL>(sv[1]); P[i] = kv + rv; } } while (0)
#define RSWAP(N, SWAPFN) do { _Pragma("unroll") for (int i = 0; i < (N); ++i) { _Pragma("unroll") for (int c_ = 0; c_ < 2; ++c_) { \
                const auto r_ = SWAPFN(__float_as_uint(P[i][c_]), __float_as_uint(P[i + (N)][c_]), false, false); P[i][c_] = __uint_as_float(r_[0]) + __uint_as_float(r_[1]); } } } while (0)
            RSWAP(16, __builtin_amdgcn_permlane32_swap); RSWAP(8, __builtin_amdgcn_permlane16_swap);
#undef RSWAP
            RSTEP(4, 8, 0x140); RSTEP(2, 4, 0x141); RSTEP(1, 2, 0x4E);
#undef RSTEP
            const int me = lane >> 1; const float rbv = rb[me];
            float lgs[2]; lgs[0] = P[0][0] + dpp_f<0xB1>(P[0][0]) + rbv; lgs[1] = P[0][1] + dpp_f<0xB1>(P[0][1]) + rbv;
            LAS float* lgbuf = (LAS float*)(F.lds + RSEL + 8192) + F.wave * 64;
            if ((lane & 1) == 0) { lgbuf[me] = lgs[0]; lgbuf[32 + me] = lgs[1]; }
            asm volatile("s_waitcnt lgkmcnt(0)" ::: "memory");
#pragma unroll
            for (int t = 0; t < 2; ++t) { const float mine = lgs[t]; int rank = 0;
#pragma unroll
                for (int e4 = 0; e4 < 8; ++e4) { const f32x4 v = *(const LAS f32x4*)(lgbuf + 32 * t + 4 * e4);
#pragma unroll
                    for (int i = 0; i < 4; ++i) { const int e = 4 * e4 + i; rank += (v[i] > mine || (v[i] == mine && e < me)) ? 1 : 0; } }
                float ls[4]; int es[4];
#pragma unroll
                for (int k = 0; k < 4; ++k) { const unsigned long long bal = __ballot(rank == k); const int first = __ffsll((long long)bal) - 1; es[k] = first >> 1; ls[k] = lgbuf[32 * t + es[k]]; }
                const float e1 = __expf(ls[1] - ls[0]), e2 = __expf(ls[2] - ls[0]), e3 = __expf(ls[3] - ls[0]); const float inv = 1.0f / (1.0f + e1 + e2 + e3);
                const int tl = tl0 + t;
                if (lane == 0) { sel_e[tl * 4 + 0] = es[0]; sel_e[tl * 4 + 1] = es[1]; sel_e[tl * 4 + 2] = es[2]; sel_e[tl * 4 + 3] = es[3];
                    sel_g[tl * 4 + 0] = inv; sel_g[tl * 4 + 1] = e1 * inv; sel_g[tl * 4 + 2] = e2 * inv; sel_g[tl * 4 + 3] = e3 * inv; } }
        }
        __syncthreads();
        const int myE = sel_e[F.tid];
        lpos[F.tid] = __hip_atomic_fetch_add(&lcnt[myE], 1u, __ATOMIC_RELAXED, __HIP_MEMORY_SCOPE_WORKGROUP);
        __syncthreads();
        if (F.tid < 32) lbase[F.tid] = atomicAdd(&gcnt[F.tid], lcnt[F.tid]);
        __syncthreads();
        { const unsigned slot = (unsigned)(r0 * 4 + F.tid); list[(size_t)myE * CAP + lbase[myE] + lpos[F.tid]] = slot; gates[slot] = sel_g[F.tid]; }
        __syncthreads();
    }
}

struct MoeOrder {
    const LAS int* meta;
    const unsigned* list; int c, G, ncol, rpx;
    __device__ bool next(int i, pg8::Unit& u) const {
        const int x = c & 7, j = c >> 3; const int g = (i * 8 + x) * rpx + j / ncol; const int total = meta[32];
        if (g >= total) return false;
        const int ln_ = (int)__builtin_amdgcn_mbcnt_hi(~0u, __builtin_amdgcn_mbcnt_lo(~0u, 0u)) & 31;
        const int e = __popc((unsigned)__ballot(meta[ln_ + 1] <= g));
        const int rt = g - meta[e], cnt = meta[64 + e];
        u.pm = g; u.pn = e * ncol + (j % ncol); u.a0 = e; u.a1 = rt; u.a2 = min(256, cnt - rt * 256); return true;
    }
    __device__ __forceinline__ unsigned arow(const pg8::Unit& u, int R) const { return (R < u.a2) ? (list[(size_t)u.a0 * CAP + u.a1 * 256 + R] >> 2) : 0u; }
    __device__ __forceinline__ unsigned rowval(const pg8::Unit& u, int R, unsigned v) const { return (R < u.a2) ? (v >> 2) : 0u; }
    __device__ __forceinline__ const unsigned* rows_ptr(const pg8::Unit& u) const { return list + (size_t)u.a0 * CAP + u.a1 * 256; }
};
__device__ __forceinline__ void moe_meta(Frame& F, int layer) {
    LAS int* meta = (LAS int*)(F.lds + META_OFF);
    const unsigned* gcnt = (const unsigned*)(KWS(F) + WS_CTL) + CW_CNT + layer * NE;
    if (F.tid < NE) { const int c = (int)__hip_atomic_load(&gcnt[F.tid], __ATOMIC_RELAXED, __HIP_MEMORY_SCOPE_AGENT); meta[64 + F.tid] = c; meta[96 + F.tid] = (c + 255) >> 8; }
    __syncthreads();
    if (F.tid <= NE) { int acc = 0;
#pragma unroll
        for (int e = 0; e < NE; ++e) { const int t = meta[96 + e]; acc += (e < F.tid) ? t : 0; }
        meta[F.tid] = acc; }
    __syncthreads();
}
struct EpiGU {
    static constexpr bool PERM = true, HAS_PRE = true;
    unsigned char* ACT; const float* bgu;
    __device__ __forceinline__ void pre(LAS unsigned char* dst, const pg8::Unit& u, int wid, int lane) const {
        if (wid == 1) { const int e = u.a0, pnl = u.pn - e * 8; const float* src = bgu + e * 2048 + (lane >> 5) * 1024 + pnl * 128 + (lane & 31) * 4;
            __builtin_amdgcn_global_load_lds((const unsigned*)src, (LAS unsigned*)dst, 16, 0, 0); } }
    __device__ __forceinline__ void operator()(const f32x4 (&acc)[2][2][4][2], const pg8::Unit& u, int wr, int wc, int fr, int fq, const LAS unsigned char* pre_) const {
        const int e = u.a0, pnl = u.pn - e * 8; const int lcol = wc * 32 + 8 * fq, ccol = pnl * 128 + lcol; const int row0 = u.pm * 256 + wr * 64 + fr;
        f32x2 bg[2][2], bl[2][2];
#pragma unroll
        for (int n = 0; n < 2; ++n) { const f32x4 g4 = *(const LAS f32x4*)(pre_ + (lcol + 4 * n) * 4), l4 = *(const LAS f32x4*)(pre_ + 512 + (lcol + 4 * n) * 4);
            bg[n][0] = (f32x2){g4[0], g4[1]}; bg[n][1] = (f32x2){g4[2], g4[3]}; bl[n][0] = (f32x2){l4[0] + 1.0f, l4[1] + 1.0f}; bl[n][1] = (f32x2){l4[2] + 1.0f, l4[3] + 1.0f}; }
        const f32x2 s2 = {1.0f / WGU_SCALE, 1.0f / WGU_SCALE}, c2 = {-1.702f * 1.4426950408889634f, -1.702f * 1.4426950408889634f}, one2 = {1.0f, 1.0f};
#pragma unroll
        for (int ai = 0; ai < 2; ++ai)
#pragma unroll
            for (int m = 0; m < 4; ++m) { unsigned char* rowp = ACT + (size_t)(row0 + ai * 128 + m * 16) * 1024 + ccol; f32x2 o[2][2];
#pragma unroll
                for (int n = 0; n < 2; ++n)
#pragma unroll
                    for (int h = 0; h < 2; ++h) { const f32x4 A4 = acc[ai][0][m][n], L4 = acc[ai][1][m][n];
                        f32x2 gv = __builtin_elementwise_fma((f32x2){A4[2 * h], A4[2 * h + 1]}, s2, bg[n][h]), lv = __builtin_elementwise_fma((f32x2){L4[2 * h], L4[2 * h + 1]}, s2, bl[n][h]);
                        gv[0] = fminf(gv[0], 7.0f); gv[1] = fminf(gv[1], 7.0f);
                        lv[0] = __builtin_amdgcn_fmed3f(lv[0], -6.0f, 8.0f); lv[1] = __builtin_amdgcn_fmed3f(lv[1], -6.0f, 8.0f);
                        const f32x2 t = gv * c2; f32x2 d = {__builtin_amdgcn_exp2f(t[0]), __builtin_amdgcn_exp2f(t[1])}; d = d + one2;
                        const f32x2 r = {__builtin_amdgcn_rcpf(d[0]), __builtin_amdgcn_rcpf(d[1])};
                        o[n][h] = gv * r * lv; }
                u32x2 w; w.x = pk4_fp8(o[0][0][0], o[0][0][1], o[0][1][0], o[0][1][1]); w.y = pk4_fp8(o[1][0][0], o[1][0][1], o[1][1][0], o[1][1][1]);
                *(u32x2*)rowp = w; }
    }
};
struct EpiDown {
    static constexpr bool PERM = true, HAS_PRE = true;
    unsigned char* YB; const float* bd; const unsigned* list;
    __device__ __forceinline__ void pre(LAS unsigned char* dst, const pg8::Unit& u, int wid, int lane) const {
        const int e = u.a0, rt = u.a1, pnl = u.pn - e * 4;
        if (wid == 1) __builtin_amdgcn_global_load_lds((const unsigned*)(bd + e * 1024 + pnl * 256 + lane * 4), (LAS unsigned*)dst, 16, 0, 0);
        if (wid == 2) __builtin_amdgcn_global_load_lds((const unsigned*)(list + (size_t)e * CAP + rt * 256 + lane * 4), (LAS unsigned*)(dst + 1024), 16, 0, 0); }
    __device__ __forceinline__ void operator()(const f32x4 (&acc)[2][2][4][2], const pg8::Unit& u, int wr, int wc, int fr, int fq, const LAS unsigned char* pre_) const {
        const int e = u.a0, pnl = u.pn - e * 4; const int lcol = wc * 32 + 8 * fq, col = pnl * 256 + lcol;
        f32x4 bv[2][2];
#pragma unroll
        for (int bj = 0; bj < 2; ++bj)
#pragma unroll
            for (int n = 0; n < 2; ++n) bv[bj][n] = *(const LAS f32x4*)(pre_ + (lcol + bj * 128 + 4 * n) * 4);
#pragma unroll
        for (int ai = 0; ai < 2; ++ai)
#pragma unroll
            for (int m = 0; m < 4; ++m) { const int R = ai * 128 + wr * 64 + m * 16 + fr; if (R >= u.a2) continue;
                const unsigned slot = *(const LAS unsigned*)(pre_ + 1024 + R * 4); unsigned char* rowp = YB + (size_t)slot * 1024 + col;
#pragma unroll
                for (int bj = 0; bj < 2; ++bj) { const f32x4 v0 = acc[ai][bj][m][0] * (1.0f / WD_SCALE) + bv[bj][0], v1 = acc[ai][bj][m][1] * (1.0f / WD_SCALE) + bv[bj][1];
                    u32x2 w; w.x = pk4_fp8(v0[0], v0[1], v0[2], v0[3]); w.y = pk4_fp8(v1[0], v1[1], v1[2], v1[3]);
                    *(u32x2*)(rowp + bj * 128) = w; } }
    }
};

__device__ __forceinline__ void ph_combine(Frame& F, int layer, float* hout, bool next_mod) {
    const float* mod = (const float*)(KWS(F) + WS_MOD) + (size_t)(layer * 3) * 6144;
    const float* modn = (const float*)(KWS(F) + WS_MOD) + (size_t)3 * 6144;
    const float* H1 = (const float*)(KWS(F) + WS_H1); const unsigned char* YB = (const unsigned char*)(KWS(F) + WS_YB); const float* gates = (const float*)(KWS(F) + WS_GATES);
    const float* lng = KIN(F, 8) + layer * DM; const float* lnb = KIN(F, 9) + layer * DM; unsigned char* U = (unsigned char*)(KWS(F) + WS_U);
    const int gw = F.bx * NWAVES + F.wave, NGW = F.G * NWAVES, lane = F.lane;
    LAS float* vC = (LAS float*)F.lds;
    for (int i = F.tid; i < 2 * DM; i += NTHR) { const int b = i >> 10, d = i & (DM - 1); LAS float* v = vC + b * 5 * DM + d;
        v[0] = mod[b * 6144 + 5120 + d]; v[DM] = lng[d]; v[2 * DM] = lnb[d]; v[3 * DM] = modn[b * 6144 + 1024 + d] + 1.0f; v[4 * DM] = modn[b * 6144 + d]; }
    __syncthreads();
    f32x4 nh[4]; unsigned nyb[4][4]; f32x4 ngt;
#define CMB_LOAD(r_) do { _Pragma("unroll") for (int j = 0; j < 4; ++j) { const int d = 4 * lane + 256 * j; nh[j] = *(const f32x4*)(H1 + (size_t)(r_) * DM + d); \
        _Pragma("unroll") for (int k = 0; k < 4; ++k) nyb[j][k] = *(const unsigned*)(YB + ((size_t)(r_) * 4 + k) * DM + d); } ngt = *(const f32x4*)(gates + (size_t)(r_) * 4); } while (0)
    if (gw < T) CMB_LOAD(gw);
    for (int row = gw; row < T; row += NGW) {
        int vb = (row >> 14) * 5 * DM + 4 * lane; asm volatile("" : "+v"(vb));
        const LAS float* vr = vC + vb;
        f32x4 ch[4]; unsigned cyb[4][4]; const f32x4 gt = ngt;
#pragma unroll
        for (int j = 0; j < 4; ++j) { ch[j] = nh[j];
#pragma unroll
            for (int k = 0; k < 4; ++k) cyb[j][k] = nyb[j][k]; }
        if (row + NGW < T) CMB_LOAD(row + NGW);
        f32x4 pre[4]; float s = 0.f;
#pragma unroll
        for (int j = 0; j < 4; ++j) { f32x4 y = {0.f, 0.f, 0.f, 0.f};
#pragma unroll
            for (int k = 0; k < 4; ++k) { const unsigned yw = cyb[j][k]; const f32x2 lo = __builtin_amdgcn_cvt_pk_f32_fp8((int)yw, false), hi2 = __builtin_amdgcn_cvt_pk_f32_fp8((int)yw, true);
                const f32x4 v = {lo[0], lo[1], hi2[0], hi2[1]};
                y += v * gt[k]; }
            pre[j] = ch[j] * ALPHA + *(const LAS f32x4*)(vr + 256 * j) * y; s += (pre[j][0] + pre[j][1]) + (pre[j][2] + pre[j][3]); }
        const float mean = wave_sum(s) * (1.0f / DM); float q2 = 0.f;
#pragma unroll
        for (int j = 0; j < 4; ++j) { pre[j] = pre[j] - mean; q2 += (pre[j][0] * pre[j][0] + pre[j][1] * pre[j][1]) + (pre[j][2] * pre[j][2] + pre[j][3] * pre[j][3]); }
        const float rstd = 1.0f / sqrtf(wave_sum(q2) * (1.0f / DM) + LN_EPS);
#pragma unroll
        for (int j = 0; j < 4; ++j) { const int d = 4 * lane + 256 * j; const f32x4 h = pre[j] * rstd * *(const LAS f32x4*)(vr + DM + 256 * j) + *(const LAS f32x4*)(vr + 2 * DM + 256 * j);
            *(f32x4*)(hout + (size_t)row * DM + d) = h;
            if (next_mod) { const f32x4 v = h * *(const LAS f32x4*)(vr + 3 * DM + 256 * j) + *(const LAS f32x4*)(vr + 4 * DM + 256 * j);
                *(unsigned*)(U + (size_t)row * DM + d) = pk4_fp8(v[0], v[1], v[2], v[3]); } }
    }
#undef CMB_LOAD
}

__device__ __forceinline__ void ph_gmlp(Frame& F) {
    const bf16_t* Z = (const bf16_t*)(KWS(F) + WS_ZODD); unsigned char* MIX = (unsigned char*)(KWS(F) + WS_MIX);
    const float* lg = KIN(F, 23); const float* lb = KIN(F, 24); const float* bs = KIN(F, 26); const bf16_t* wsb = (const bf16_t*)(KWS(F) + WS_TAB + TB_WS);
    const int lane = F.lane, r32 = lane & 31, hi = lane >> 5, wid = F.wave;
    for (int chunk = F.bx; chunk < T / 128; chunk += F.G) {
        const int r0 = chunk * 128;
        for (int qq = 0; qq < 16; ++qq) { const int q = wid * 16 + qq; const bf16x8 raw = *(const bf16x8*)(Z + (size_t)(r0 + q) * 1536 + 512 + 8 * lane);
            float v[8]; float s = 0.f;
#pragma unroll
            for (int j = 0; j < 8; ++j) { v[j] = bf2f((unsigned short)raw[j]); s += v[j]; }
            const float mean = wave_sum(s) * (1.0f / 512.0f); float q2 = 0.f;
#pragma unroll
            for (int j = 0; j < 8; ++j) { v[j] -= mean; q2 += v[j] * v[j]; }
            const float rstd = 1.0f / sqrtf(wave_sum(q2) * (1.0f / 512.0f) + LN_EPS);
            const f32x4 g0 = *(const f32x4*)(lg + 8 * lane), g1 = *(const f32x4*)(lg + 8 * lane + 4), b0 = *(const f32x4*)(lb + 8 * lane), b1 = *(const f32x4*)(lb + 8 * lane + 4);
            u32x4 w; w.x = pk2(v[0] * rstd * g0[0] + b0[0], v[1] * rstd * g0[1] + b0[1]); w.y = pk2(v[2] * rstd * g0[2] + b0[2], v[3] * rstd * g0[3] + b0[3]);
            w.z = pk2(v[4] * rstd * g1[0] + b1[0], v[5] * rstd * g1[1] + b1[1]); w.w = pk2(v[6] * rstd * g1[2] + b1[2], v[7] * rstd * g1[3] + b1[3]);
            const int ch = 8 * lane, g = ch >> 7, col = ch & 127, kt = (q >> 6) * 4 + g;
            *(LAS u32x4*)(F.lds + kt * 16384 + v_st(q & 63, col)) = w; }
        __syncthreads();
        const int pb = wid & 3, gh = wid >> 2;
#pragma unroll 1
        for (int gi = 0; gi < 2; ++gi) { const int g = 2 * gh + gi;
            unsigned wofs = (unsigned)(((g * 128 + 32 * pb + r32) * 128 + 8 * hi) * 2); asm volatile("" : "+v"(wofs));
            f32x16 acc[4];
#pragma unroll
            for (int d0 = 0; d0 < 4; ++d0) acc[d0] = f32x16{};
            bf16x8 af[8];
#pragma unroll
            for (int ks = 0; ks < 8; ++ks) af[ks] = *(const bf16x8*)((const char*)wsb + wofs + 32 * ks);
#pragma unroll
            for (int ks = 0; ks < 8; ++ks) {
                LAS unsigned char* trd = F.lds + ((ks >> 2) * 4 + g) * 16384 + v_rd_base(lane);
#pragma unroll
                for (int d0 = 0; d0 < 4; ++d0) acc[d0] = __builtin_amdgcn_mfma_f32_32x32x16_bf16(af[ks], vfrag(trd, d0, ks & 3), acc[d0], 0, 0, 0); }
            unsigned short uraw[16][4]; float bias[16];
#pragma unroll
            for (int r = 0; r < 16; ++r) { const int p = 32 * pb + crow(r, hi); bias[r] = bs[g * 128 + p];
#pragma unroll
                for (int d0 = 0; d0 < 4; ++d0) uraw[r][d0] = Z[(size_t)(r0 + p) * 1536 + g * 128 + d0 * 32 + r32]; }
            asm volatile("" ::: "memory");
#pragma unroll
            for (int r = 0; r < 16; ++r) { const int p = 32 * pb + crow(r, hi);
#pragma unroll
                for (int d0 = 0; d0 < 4; ++d0) { const int ch = g * 128 + d0 * 32 + r32;
                    MIX[(size_t)(r0 + p) * 1024 + ch] = f2fp8(bf2f(uraw[r][d0]) * (acc[d0][r] + bias[r])); } }
        }
        __syncthreads();
    }
}

__device__ __forceinline__ void ph_fourier1(Frame& F) {
    const bf16_t* Z = (const bf16_t*)(KWS(F) + WS_ZODD); bf16_t* WT = (bf16_t*)(KWS(F) + WS_WT);
    const float* lg = KIN(F, 27); const float* lb = KIN(F, 28);
    const bf16x8* CSf = (const bf16x8*)(KWS(F) + WS_TAB + TB_CS); const bf16x8* AFf = (const bf16x8*)(KWS(F) + WS_TAB + TB_AF); const f32x2* tw = (const f32x2*)(KWS(F) + WS_TAB + TB_TW);
    const int lane = F.lane, r32 = lane & 31, hi = lane >> 5, wid = F.wave;
    for (int unit = F.bx; unit < NB * 128; unit += F.G) {
        const int b = unit >> 7, t2 = unit & 127;
#pragma unroll 1
        for (int g = 0; g < 4; ++g) {
            {
                int lane_g = lane; asm volatile("" : "+v"(lane_g)); const int r32 = lane_g & 31, hi = lane_g >> 5;
                const int tb = wid & 3, part = wid >> 2; int t1 = 32 * tb + r32; asm volatile("" : "+v"(t1)); const size_t row = (size_t)b * SEQ + 128 * t1 + t2;
                bf16x8 raw[8]; float s = 0.f;
#pragma unroll
                for (int ks = 0; ks < 8; ++ks) { raw[ks] = *(const bf16x8*)(Z + row * 1536 + 1024 + g * 128 + 16 * ks + 8 * hi);
#pragma unroll
                    for (int j = 0; j < 8; ++j) s += bf2f((unsigned short)raw[ks][j]); }
                s = xhalf_sum(s); const float mean = s * (1.0f / 128.0f); float q2 = 0.f;
#pragma unroll
                for (int ks = 0; ks < 8; ++ks)
#pragma unroll
                    for (int j = 0; j < 8; ++j) { const float d = bf2f((unsigned short)raw[ks][j]) - mean; q2 += d * d; }
                q2 = xhalf_sum(q2); const float rstd = 1.0f / sqrtf(q2 * (1.0f / 128.0f) + LN_EPS);
                bf16x8 af[8];
#pragma unroll
                for (int ks = 0; ks < 8; ++ks) { const int c0 = g * 128 + 16 * ks + 8 * hi; const f32x4 g0 = *(const f32x4*)(lg + c0), g1 = *(const f32x4*)(lg + c0 + 4), b0 = *(const f32x4*)(lb + c0), b1 = *(const f32x4*)(lb + c0 + 4);
                    float x[8];
#pragma unroll
                    for (int j = 0; j < 8; ++j) x[j] = (bf2f((unsigned short)raw[ks][j]) - mean) * rstd;
                    u32x4 w; w.x = pk2(x[0] * g0[0] + b0[0], x[1] * g0[1] + b0[1]); w.y = pk2(x[2] * g0[2] + b0[2], x[3] * g0[3] + b0[3]);
                    w.z = pk2(x[4] * g1[0] + b1[0], x[5] * g1[1] + b1[1]); w.w = pk2(x[6] * g1[2] + b1[2], x[7] * g1[3] + b1[3]);
                    af[ks] = __builtin_bit_cast(bf16x8, w); }
                f32x16 acc[4];
#pragma unroll
                for (int d0 = 0; d0 < 4; ++d0) acc[d0] = f32x16{};
#pragma unroll
                for (int ks = 0; ks < 8; ++ks) { unsigned fo = (unsigned)(((4 * part) * 8 + ks) * 64 + lane) * 16u; asm volatile("" : "+v"(fo));
#pragma unroll
                    for (int d0 = 0; d0 < 4; ++d0) acc[d0] = __builtin_amdgcn_mfma_f32_32x32x16_bf16(af[ks], *(const bf16x8*)((const char*)CSf + fo + d0 * 8192), acc[d0], 0, 0, 0); }
                int ybase = (part * 2 + (tb >> 1)) * 16384 + (tb & 1) * 8192 + hi * 2048 + r32 * 2; asm volatile("" : "+v"(ybase));
#pragma unroll
                for (int r = 0; r < 16; ++r)
#pragma unroll
                    for (int d0 = 0; d0 < 4; ++d0) *(LAS bf16_t*)(F.lds + ybase + ((r >> 3) & 1) * 4096 + d0 * 512 + ((r & 3) + 4 * ((r >> 2) & 1)) * 64) = (bf16_t)f2bf(acc[d0][r]);
            }
            __syncthreads();
            {
                const int kb = wid & 3, ch2 = wid >> 2;
                f32x16 aR[2], aI[2];
#pragma unroll
                for (int dd = 0; dd < 2; ++dd) { aR[dd] = f32x16{}; aI[dd] = f32x16{}; }
#pragma unroll
                for (int kh = 0; kh < 4; ++kh) {
                    unsigned fo = (unsigned)((kb * 16 + kh * 4) * 64 + lane) * 16u; asm volatile("" : "+v"(fo));
                    bf16x8 fr8[4], fi8[4];
#pragma unroll
                    for (int k8 = 0; k8 < 4; ++k8) { fr8[k8] = *(const bf16x8*)((const char*)AFf + fo + k8 * 1024); fi8[k8] = *(const bf16x8*)((const char*)AFf + fo + k8 * 1024 + 65536); }
#pragma unroll
                    for (int k8 = 0; k8 < 4; ++k8) { const int ks = kh * 4 + k8;
                        LAS unsigned char* trd = F.lds + (ks >> 2) * 16384 + v_rd_base(lane);
#pragma unroll
                        for (int dd = 0; dd < 2; ++dd) { const bf16x8 bf = vfrag(trd, 2 * ch2 + dd, ks & 3);
                            aR[dd] = __builtin_amdgcn_mfma_f32_32x32x16_bf16(fr8[k8], bf, aR[dd], 0, 0, 0); aI[dd] = __builtin_amdgcn_mfma_f32_32x32x16_bf16(fi8[k8], bf, aI[dd], 0, 0, 0); } }
                }
                int k1b = 32 * kb + 4 * hi; asm volatile("" : "+v"(k1b));
                f32x2 csv[16];
#pragma unroll
                for (int r = 0; r < 16; ++r) csv[r] = tw[t2 * 128 + k1b + (r & 3) + 8 * (r >> 2)];
                asm volatile("" ::: "memory");
#pragma unroll
                for (int r = 0; r < 16; ++r) { const int k1 = k1b + (r & 3) + 8 * (r >> 2); const f32x2 cs = csv[r];
                    bf16_t* dst = WT + ((((size_t)b * 128 + k1) * 128 + t2) * 4 + g) * 256;
#pragma unroll
                    for (int dd = 0; dd < 2; ++dd) { const float wr_ = aR[dd][r], wi_ = aI[dd][r]; const int j = 32 * (2 * ch2 + dd) + r32;
                        dst[j] = (bf16_t)f2bf(wr_ * cs[0] + wi_ * cs[1]); dst[128 + j] = (bf16_t)f2bf(wi_ * cs[0] - wr_ * cs[1]); }
                    if ((r & 3) == 3) asm volatile("" ::: "memory"); }
            }
            __syncthreads();
        }
    }
}
__device__ __forceinline__ void ph_fourier2(Frame& F) {
    const bf16_t* WT = (const bf16_t*)(KWS(F) + WS_WT); unsigned char* MIX = (unsigned char*)(KWS(F) + WS_MIX);
    const bf16x8* A3f = (const bf16x8*)(KWS(F) + WS_TAB + TB_A3);
    const int lane = F.lane, r32 = lane & 31, hi = lane >> 5, wid = F.wave;
    for (int unit = F.bx; unit < NB * 128; unit += F.G) {
        const int b = unit >> 7, k1 = unit & 127;
#pragma unroll 1
        for (int g = 0; g < 4; ++g) {
            for (int idx = F.tid; idx < 4096; idx += NTHR) { const int t2 = idx >> 5, c = idx & 31, part = c >> 4, j0 = (c & 15) * 8;
                const u32x4 v = *(const u32x4*)(WT + ((((size_t)b * 128 + k1) * 128 + t2) * 4 + g) * 256 + part * 128 + j0);
                *(LAS u32x4*)(F.lds + (part * 2 + (t2 >> 6)) * 16384 + v_st(t2 & 63, j0)) = v; }
            __syncthreads();
            const int mb = wid & 3, ch2 = wid >> 2;
            f32x16 acc[2] = {f32x16{}, f32x16{}};
#pragma unroll
            for (int ks = 0; ks < 16; ++ks) { unsigned fo = (unsigned)((mb * 16 + ks) * 64 + lane) * 16u; asm volatile("" : "+v"(fo)); const bf16x8 af = *(const bf16x8*)((const char*)A3f + fo);
                LAS unsigned char* trd = F.lds + (ks >> 2) * 16384 + v_rd_base(lane);
#pragma unroll
                for (int dd = 0; dd < 2; ++dd) acc[dd] = __builtin_amdgcn_mfma_f32_32x32x16_bf16(af, vfrag(trd, 2 * ch2 + dd, ks & 3), acc[dd], 0, 0, 0); }
#pragma unroll
            for (int r = 0; r < 16; ++r) { const int k2 = 32 * mb + crow(r, hi); const size_t row = (size_t)b * SEQ + k1 + 128 * k2;
#pragma unroll
                for (int dd = 0; dd < 2; ++dd) MIX[row * 1024 + 512 + g * 128 + 32 * (2 * ch2 + dd) + r32] = f2fp8(acc[dd][r]); }
            __syncthreads();
        }
    }
}

#ifndef MK_ONE_LAUNCH
#define MK_ONE_LAUNCH 1
#endif
constexpr int NPH = 18;
#ifndef PHMASK
#define PHMASK 0x3FFFF
#endif
#define HAS(k) (((PHMASK) >> (k)) & 1)
__global__ void __launch_bounds__(NTHR, 2) fwd_kernel(Args args) {
    extern __shared__ __attribute__((aligned(16))) unsigned char lds_raw[];
    Frame F;
    F.lds = (LAS unsigned char*)lds_raw; F.tid = threadIdx.x; F.lane = F.tid & 63; F.wave = __builtin_amdgcn_readfirstlane(F.tid >> 6); F.G = gridDim.x; F.bx = blockIdx.x;
    F.kz = 0;
    volatile LAS unsigned* MISC = (volatile LAS unsigned*)(F.lds + MISC_OFF);
    if (F.tid < 64) MISC[F.tid] = 0u;
    __syncthreads();
    if (MK_ONE_LAUNCH) (void)xcd_barrier_post((unsigned*)(args.ws + WS_CTL) + CW_BAR, MISC + 8);
    const int lo = args.ph_lo, hi = args.ph_hi;
#define IN(k) (lo <= (k) && (k) < hi)
#ifndef REPMASK
#define REPMASK 0
#endif
#define REP(k) (((REPMASK) >> (k)) & 1)
#define BARNOW() do { ENTER(); XcdBarrier bar_; bar_.bar = (unsigned*)(KWS(F) + WS_CTL) + CW_BAR; bar_.x = xb_xcc_id(); bar_.st = (volatile LAS unsigned*)(F.lds + MISC_OFF) + 8; xcd_barrier(bar_); } while (0)
#ifndef DIAG_PH
#define DIAG_PH -1
#endif
    int nstamp = 0;
#define STAMP() do { if (DIAG_PH >= 0) { if (F.tid == 0) ((volatile LAS unsigned*)(F.lds + MISC_OFF))[16 + nstamp] = (unsigned)__builtin_amdgcn_s_memrealtime(); ++nstamp; } } while (0)
    STAMP();
#define ENTER() do { asm volatile("" : "+s"(F.kz), "+s"(F.wave), "+s"(F.G), "+s"(F.bx), "+v"(F.tid), "+v"(F.lane)); F.kz = __builtin_amdgcn_readfirstlane(F.kz); F.wave = __builtin_amdgcn_readfirstlane(F.wave); \
    F.G = __builtin_amdgcn_readfirstlane(F.G); F.bx = __builtin_amdgcn_readfirstlane(F.bx); } while (0)
#define SEAM(k) do { if (IN(k) && IN((k) + 1)) { if (MK_ONE_LAUNCH) { ENTER(); XcdBarrier bar_; bar_.bar = (unsigned*)(KWS(F) + WS_CTL) + CW_BAR; bar_.x = xb_xcc_id(); bar_.st = (volatile LAS unsigned*)(F.lds + MISC_OFF) + 8; xcd_barrier(bar_); STAMP(); } } } while (0)

    if (HAS(0) && IN(0)) { ENTER(); for (int rep_ = 0; rep_ <= REP(0); ++rep_) { if (rep_) BARNOW(); ph0_mod_tables(F); } } SEAM(0);
    if (HAS(1) && IN(1)) { ENTER(); for (int rep_ = 0; rep_ <= REP(1); ++rep_) { if (rep_) BARNOW(); ph1_convert(F); } } SEAM(1);
    if (HAS(2) && IN(2)) { ENTER(); for (int rep_ = 0; rep_ <= REP(2); ++rep_) { if (rep_) BARNOW(); ph2_modulate(F); } } SEAM(2);

    for (int layer = 0; layer < 2; ++layer) {
        const int pb = layer == 0 ? 5 : 13;
        if (layer == 0) {
            if (HAS(3) && IN(3)) { ENTER(); for (int rep_ = 0; rep_ <= REP(3); ++rep_) { if (rep_) BARNOW();
                pg8::Gemm g{(const bf16_t*)(KWS(F) + WS_U), (const bf16_t*)(KWS(F) + WS_WEVIN), T, 2560, DM / 2};
                EvInOrder S; S.so.init(T, 2560, F.G, F.bx);
                EpiEvIn E{(unsigned char*)(KWS(F) + WS_Q), (unsigned char*)(KWS(F) + WS_K), (unsigned char*)(KWS(F) + WS_V), (bf16_t*)(KWS(F) + WS_AB), (const float*)(KWS(F) + WS_TAB + TB_COS), (const float*)(KWS(F) + WS_TAB + TB_SIN)};
                pg8::gemm_phase<EpiEvIn, EvInOrder, true, false, true>(F.lds, g, S, E, F.tid);
            } } SEAM(3);
            if (HAS(4) && IN(4)) { ENTER(); for (int rep_ = 0; rep_ <= REP(4); ++rep_) { if (rep_) BARNOW(); ph4_conv(F); ph4_attention(F); } } SEAM(4);
        } else {
            if (HAS(10) && IN(10)) { ENTER(); for (int rep_ = 0; rep_ <= REP(10); ++rep_) { if (rep_) BARNOW();
                pg8::Gemm g{(const bf16_t*)(KWS(F) + WS_U), (const bf16_t*)(KWS(F) + WS_WODIN), T, 1536, DM / 2};
                pg8::StaticOrder S; S.init(T, 1536, F.G, F.bx);
                pg8::EpiBf16 E{(bf16_t*)(KWS(F) + WS_ZODD), 1536, 4, 1.0f / WI_SCALE};
                pg8::gemm_phase<pg8::EpiBf16, pg8::StaticOrder, true, false, true>(F.lds, g, S, E, F.tid);
            } } SEAM(10);
            if (HAS(11) && IN(11)) { ENTER(); for (int rep_ = 0; rep_ <= REP(11); ++rep_) { if (rep_) BARNOW(); ph_gmlp(F); ph_fourier1(F); } } SEAM(11);
            if (HAS(12) && IN(12)) { ENTER(); for (int rep_ = 0; rep_ <= REP(12); ++rep_) { if (rep_) BARNOW(); ph_fourier2(F); } } SEAM(12);
        }
        if (HAS(5) && IN(pb)) { ENTER(); for (int rep_ = 0; rep_ <= REP(5); ++rep_) { if (rep_) BARNOW();
            pg8::Gemm g{(const bf16_t*)(KWS(F) + WS_MIX), (const bf16_t*)(KWS(F) + (layer == 0 ? WS_WEVOUT : WS_WODOUT)), T, DM, DM / 2};
            pg8::StaticOrder S; S.init(T, DM, F.G, F.bx);
            pg8::EpiBf16 E{(bf16_t*)(KWS(F) + WS_Y), DM, 0, 1.0f / WO_SCALE};
            pg8::gemm_phase<pg8::EpiBf16, pg8::StaticOrder, true, false, true>(F.lds, g, S, E, F.tid);
        } } SEAM(pb);
        if (HAS(6) && IN(pb + 1)) { ENTER(); for (int rep_ = 0; rep_ <= REP(6); ++rep_) { if (rep_) BARNOW(); ph_router(F, layer, layer == 0 ? KIN(F, 0) : (const float*)(KWS(F) + WS_H2)); } } SEAM(pb + 1);
        if (HAS(7) && IN(pb + 2)) { ENTER(); for (int rep_ = 0; rep_ <= REP(7); ++rep_) { if (rep_) BARNOW();
            moe_meta(F, layer);
            pg8::Gemm g{(const bf16_t*)(KWS(F) + WS_U2), (const bf16_t*)(KWS(F) + WS_WGU + (size_t)layer * NE * 2048 * DM), 0, 0, DM / 2};
            MoeOrder S{(const LAS int*)(F.lds + META_OFF), (const unsigned*)(KWS(F) + WS_LIST), F.bx, F.G, 8, 4};
            EpiGU E{(unsigned char*)(KWS(F) + WS_ACT), KIN(F, 32) + (size_t)layer * NE * 2048};
            pg8::gemm_phase<EpiGU, MoeOrder, true, true, true>(F.lds, g, S, E, F.tid);
        } } SEAM(pb + 2);
        if (HAS(8) && IN(pb + 3)) { ENTER(); for (int rep_ = 0; rep_ <= REP(8); ++rep_) { if (rep_) BARNOW();
            moe_meta(F, layer);
            pg8::Gemm g{(const bf16_t*)(KWS(F) + WS_ACT), (const bf16_t*)(KWS(F) + WS_WD + (size_t)layer * NE * 1024 * DM), 0, 0, DM / 2};
            MoeOrder S{(const LAS int*)(F.lds + META_OFF), (const unsigned*)(KWS(F) + WS_LIST), F.bx, F.G, 4, 8};
            EpiDown E{(unsigned char*)(KWS(F) + WS_YB), KIN(F, 34) + (size_t)layer * NE * 1024, (const unsigned*)(KWS(F) + WS_LIST)};
            pg8::gemm_phase<EpiDown, MoeOrder, true, false, true>(F.lds, g, S, E, F.tid);
        } } SEAM(pb + 3);
        if (HAS(9) && IN(pb + 4)) { ENTER(); for (int rep_ = 0; rep_ <= REP(9); ++rep_) { if (rep_) BARNOW(); ph_combine(F, layer, layer == 0 ? (float*)(KWS(F) + WS_H2) : KOUT(F), layer == 0); } }
        if (layer == 0) SEAM(pb + 4);
    }
    if (DIAG_PH >= 0) {
        ENTER(); XcdBarrier bar_; bar_.bar = (unsigned*)(KWS(F) + WS_CTL) + CW_BAR; bar_.x = xb_xcc_id(); bar_.st = (volatile LAS unsigned*)(F.lds + MISC_OFF) + 8; xcd_barrier(bar_); STAMP();
        __syncthreads();
        volatile LAS unsigned* st = (volatile LAS unsigned*)(F.lds + MISC_OFF) + 16;
        const unsigned d = st[DIAG_PH + 1] - st[DIAG_PH];
        const float c = sqrtf((float)d * 0.01f);
        float* o = KOUT(F);
        for (size_t i = (size_t)F.bx * NTHR + F.tid; i < (size_t)T * DM; i += (size_t)F.G * NTHR) o[i] = c;
    }
#undef IN
#undef SEAM
}

extern "C" void kernel_launch(void* const* d_in, const int* in_sizes, int n_in, void* d_out, int out_size, void* d_ws, size_t ws_size, hipStream_t stream) {
    static int grid = 0;
    if (grid == 0) {
        if (n_in != 35 || out_size != T * DM || ws_size < WS_END) { fprintf(stderr, "kernel_launch: unexpected shapes: n_in %d out %d ws %zu (need %zu)\n", n_in, out_size, ws_size, (size_t)WS_END); grid = -1; return; }
        int dev = 0, cus = 0;
        if (hipGetDevice(&dev) != hipSuccess || hipDeviceGetAttribute(&cus, hipDeviceAttributeMultiprocessorCount, dev) != hipSuccess) { grid = -1; return; }
        if (hipFuncSetAttribute((const void*)fwd_kernel, hipFuncAttributeMaxDynamicSharedMemorySize, LDS_BYTES) != hipSuccess) { fprintf(stderr, "kernel_launch: hipFuncSetAttribute failed\n"); grid = -1; return; }
        int per_cu = 0; (void)hipOccupancyMaxActiveBlocksPerMultiprocessor(&per_cu, (const void*)fwd_kernel, NTHR, LDS_BYTES); (void)hipGetLastError();
        if (per_cu < 1) fprintf(stderr, "kernel_launch: occupancy query reports %d blocks per CU\n", per_cu);
        grid = cus > 256 ? 256 : cus;
        if (grid != 256) fprintf(stderr, "kernel_launch: %d CUs; this kernel is laid out for 256\n", cus);
    }
    if (grid < 0) return;
    (void)hipMemsetAsync((char*)d_ws + WS_CTL, 0, CTL_ZERO_BYTES, stream);
    Args a{};
    for (int i = 0; i < 35; ++i) a.in[i] = (const float*)d_in[i];
    a.out = (float*)d_out; a.ws = (unsigned char*)d_ws;
#if MK_ONE_LAUNCH
    a.ph_lo = 0; a.ph_hi = NPH;
    hipLaunchKernelGGL(fwd_kernel, dim3(grid), dim3(NTHR), LDS_BYTES, stream, a);
#else
    for (int p = 0; p < NPH; ++p) { a.ph_lo = p; a.ph_hi = p + 1; hipLaunchKernelGGL(fwd_kernel, dim3(grid), dim3(NTHR), LDS_BYTES, stream, a); }
#endif
    const hipError_t le = hipPeekAtLastError();
    if (le != hipSuccess) fprintf(stderr, "kernel_launch: launch failed: %s\n", hipGetErrorName(le));
}
```

```cpp
#include <hip/hip_runtime.h>
#include <cstdio>
#include <cstdint>

#define LAS __attribute__((address_space(3)))
#define GAS __attribute__((address_space(1)))
typedef unsigned short bf16_t;
typedef short bf16x8 __attribute__((ext_vector_type(8)));
typedef short s16x4 __attribute__((ext_vector_type(4)));
typedef float f32x4 __attribute__((ext_vector_type(4)));
typedef float f32x2 __attribute__((ext_vector_type(2)));
typedef float f32x16 __attribute__((ext_vector_type(16)));
typedef unsigned u32x4 __attribute__((ext_vector_type(4)));
typedef unsigned u32x2 __attribute__((ext_vector_type(2)));

namespace pg8 {
constexpr int BM = 256, BK = 64, HALF = 128, HTB = HALF * BK * 2, STAGE_BYTES = 8 * HTB, NXCD = 8, WGM = 8;
__host__ __device__ __forceinline__ int lds_byte(int r, int c) { const int st = (r >> 4) * 2 + (c >> 5), rr = r & 15, cc = c & 31, ob = rr * 64 + cc * 2; return st * 1024 + (ob ^ (((ob >> 9) & 1) << 5)); }
__host__ __device__ __forceinline__ void stage_rc(int b, int& R, int& C) { const int st = b / 1024, sb = b % 1024, swz = sb ^ (((sb >> 9) & 1) << 5); R = (st >> 1) * 16 + swz / 64; C = (st & 1) * 32 + (swz % 64) / 2; }
__host__ __device__ __forceinline__ int perm32(int rho) { const int n = rho >> 4, i = rho & 15; return 8 * (i >> 2) + 4 * n + (i & 3); }

struct Unit { int pm, pn, a0, a1, a2; };
struct Gemm { const bf16_t* A; const bf16_t* Bt; int M, N, K; };

constexpr int PRE_ROWS = 131072 + 1024, PRE_EPI = PRE_ROWS + 2048;
struct StaticOrder {
    int nM, nN, nwg, G, c;
    __device__ void init(int M, int N, int G_, int c_) { nM = M / BM; nN = N / BM; nwg = nM * nN; G = G_; c = c_; }
    __device__ bool map(long L, Unit& u) const {
        if (L >= nwg) return false;
        int wgid = (int)L; { const int q = nwg / NXCD, r = nwg % NXCD, xcd = wgid % NXCD, off = wgid / NXCD; wgid = (xcd < r ? xcd * (q + 1) : r * (q + 1) + (xcd - r) * q) + off; }
        const int nig = WGM * nN, gid = wgid / nig, fm = gid * WGM, gsz = (nM - fm) < WGM ? (nM - fm) : WGM;
        u.pm = fm + ((wgid % nig) % gsz); u.pn = (wgid % nig) / gsz; u.a0 = 0; u.a1 = 0; u.a2 = 256; return true;
    }
    __device__ bool next(int i, Unit& u) const { return map((long)i * G + c, u); }
    __device__ __forceinline__ unsigned arow(const Unit&, int) const { return 0u; }
    __device__ __forceinline__ unsigned rowval(const Unit&, int, unsigned) const { return 0u; }
    __device__ __forceinline__ const unsigned* rows_ptr(const Unit&) const { return nullptr; }
};

__device__ __forceinline__ unsigned cvt_pk_bf16(float lo, float hi) { unsigned r; asm volatile("v_cvt_pk_bf16_f32 %0, %1, %2" : "=v"(r) : "v"(lo), "v"(hi)); return r; }

__device__ __forceinline__ float gelu_tanh(float x) {
    const float t = x * (1.0f + 0.044715f * x * x) * (2.0f * 0.7978845608028654f * 1.4426950408889634f);
    return x * __builtin_amdgcn_rcpf(1.0f + __builtin_amdgcn_exp2f(-t));
}

struct EpiBf16 {
    static constexpr bool PERM = true, HAS_PRE = false;
    bf16_t* O; int ldc; int gelu_pn; float scale;
    __device__ __forceinline__ void operator()(const f32x4 (&acc)[2][2][4][2], const Unit& u, int wr, int wc, int fr, int fq) const {
        const int row0 = u.pm * BM + wr * 64 + fr; const int col0 = u.pn * BM + wc * 32 + 8 * fq;
        const bool act = u.pn < gelu_pn;
#pragma unroll
        for (int ai = 0; ai < 2; ++ai)
#pragma unroll
            for (int m = 0; m < 4; ++m) { bf16_t* rowp = O + (size_t)(row0 + ai * HALF + m * 16) * ldc + col0;
#pragma unroll
                for (int bj = 0; bj < 2; ++bj) { f32x4 v0 = acc[ai][bj][m][0] * scale, v1 = acc[ai][bj][m][1] * scale;
                    if (act) {
#pragma unroll
                        for (int j = 0; j < 4; ++j) { v0[j] = gelu_tanh(v0[j]); v1[j] = gelu_tanh(v1[j]); } }
                    u32x4 w; w.x = cvt_pk_bf16(v0[0], v0[1]); w.y = cvt_pk_bf16(v0[2], v0[3]); w.z = cvt_pk_bf16(v1[0], v1[1]); w.w = cvt_pk_bf16(v1[2], v1[3]);
                    *(u32x4*)(rowp + bj * HALF) = w; } }
    }
};

typedef int v8i32 __attribute__((ext_vector_type(8)));
typedef short s16x16 __attribute__((ext_vector_type(16)));
template <class Epi, class Sched, bool ALIGN_EPI, bool GATHER, bool FP8 = false>
__device__ __forceinline__ void gemm_phase(LAS unsigned char* lds, const Gemm g, const Sched& S, const Epi& E, const int tid) {
    const int wid = __builtin_amdgcn_readfirstlane(tid >> 6), lane = tid & 63, wr = wid >> 2, wc = wid & 3, fr = lane & 15, fq = lane >> 4;
    const int K = g.K, nt = K / BK;
    unsigned voffA[2], voffB[2]; int Rr[2], Cc[2];
#pragma unroll
    for (int i = 0; i < 2; ++i) { int R, C; stage_rc(tid * 16 + i * 8192, R, C); const int Rb = Epi::PERM ? ((R & ~31) + perm32(R & 31)) : R; Rr[i] = R; Cc[i] = C;
        voffA[i] = (unsigned)(R * K + C) * 2u; voffB[i] = (unsigned)(Rb * K + C) * 2u; }
    const unsigned kstep = (unsigned)(BK * 2);
    const unsigned hstep = (unsigned)HALF * (unsigned)K * 2u;
    const unsigned tstep = 2u * hstep;
    const char* const baseA = (const char*)g.A; const char* const baseB = (const char*)g.Bt;
    const unsigned ldsw = (unsigned)wid * 1024u;
    const int aoff = lds_byte(wr * 64 + fr, fq * 8), boff = lds_byte(wc * 32 + fr, fq * 8);
    const int aoff0 = lds_byte(wr * 64 + fr, fq * 16), aoff1 = lds_byte(wr * 64 + fr, fq * 16 + 8), boff0 = lds_byte(wc * 32 + fr, fq * 16), boff1 = lds_byte(wc * 32 + fr, fq * 16 + 8);
#define PG8_SA(b, h) (((b) * 2 + (h)) * HTB)
#define PG8_SB(b, h) ((4 + (b) * 2 + (h)) * HTB)
#define PG8_STAGE(bufoff, gbase, voff) do { _Pragma("unroll") for (int _i = 0; _i < 2; ++_i) \
        __builtin_amdgcn_global_load_lds((const unsigned*)(baseB + (size_t)(unsigned)((gbase) + (voff)[_i])), (LAS unsigned*)(lds + (bufoff) + ldsw + _i * 8192), 16, 0, 0); } while (0)
#define PG8_STAGEA(bufoff, gbase, voff) do { _Pragma("unroll") for (int _i = 0; _i < 2; ++_i) \
        __builtin_amdgcn_global_load_lds((const unsigned*)(baseA + (size_t)(unsigned)((gbase) + (voff)[_i])), (LAS unsigned*)(lds + (bufoff) + ldsw + _i * 8192), 16, 0, 0); } while (0)
#define PG8_STAGE_A(bufoff, base, h, nx) do { if constexpr (GATHER) { _Pragma("unroll") for (int _i = 0; _i < 2; ++_i) { const unsigned _v = (nx) ? vAn[h][_i] : vAc[h][_i]; \
            __builtin_amdgcn_global_load_lds((const unsigned*)(baseA + (size_t)(unsigned)((base) + _v)), (LAS unsigned*)(lds + (bufoff) + ldsw + _i * 8192), 16, 0, 0); } } \
        else { PG8_STAGEA(bufoff, (base) + (h) * hstep, voffA); } } while (0)
#define PG8_LD8(dst, i, off0, off1) do { const bf16x8 _lo = *(const LAS bf16x8*)(lds + (off0)), _hi = *(const LAS bf16x8*)(lds + (off0) + 16); dst[i] = __builtin_bit_cast(v8i32, __builtin_shufflevector(_lo, _hi, 0, 1, 2, 3, 4, 5, 6, 7, 8, 9, 10, 11, 12, 13, 14, 15)); } while (0)
#define PG8_LDA8(dst, b, h) do { _Pragma("unroll") for (int m = 0; m < 4; ++m) PG8_LD8(dst, m, PG8_SA(b, h) + aoff0 + m * 2048, PG8_SA(b, h) + aoff1 + m * 2048); } while (0)
#define PG8_LDB8(dst, b, h) do { _Pragma("unroll") for (int n = 0; n < 2; ++n) PG8_LD8(dst, n, PG8_SB(b, h) + boff0 + n * 2048, PG8_SB(b, h) + boff1 + n * 2048); } while (0)
#define PG8_MMA8(ai, bj, At, Bt) do { __builtin_amdgcn_s_setprio(1); _Pragma("unroll") for (int m = 0; m < 4; ++m) _Pragma("unroll") for (int n = 0; n < 2; ++n) \
        asm volatile("v_mfma_scale_f32_16x16x128_f8f6f4 %0, %1, %2, %0, %3, %3 op_sel_hi:[0,0,0]" : "+v"(acc[ai][bj][m][n]) : "v"(Bt[n]), "v"(At[m]), "v"(one_scale)); __builtin_amdgcn_s_setprio(0); } while (0)
#define PG8_LDA(dst, b, h) do { _Pragma("unroll") for (int m = 0; m < 4; ++m) _Pragma("unroll") for (int k = 0; k < 2; ++k) dst[m][k] = *(const LAS bf16x8*)(lds + PG8_SA(b, h) + aoff + m * 2048 + k * 1024); } while (0)
#define PG8_LDB(dst, b, h) do { _Pragma("unroll") for (int n = 0; n < 2; ++n) _Pragma("unroll") for (int k = 0; k < 2; ++k) dst[n][k] = *(const LAS bf16x8*)(lds + PG8_SB(b, h) + boff + n * 2048 + k * 1024); } while (0)
#define PG8_MMA(ai, bj, At, Bt) do { __builtin_amdgcn_s_setprio(1); _Pragma("unroll") for (int m = 0; m < 4; ++m) _Pragma("unroll") for (int n = 0; n < 2; ++n) _Pragma("unroll") for (int k = 0; k < 2; ++k) \
        acc[ai][bj][m][n] = __builtin_amdgcn_mfma_f32_16x16x32_bf16(Bt[n][k], At[m][k], acc[ai][bj][m][n], 0, 0, 0); __builtin_amdgcn_s_setprio(0); } while (0)
#define PG8_WAIT_V(n) asm volatile("s_waitcnt vmcnt(" #n ")" ::: "memory")
#define PG8_WAIT_L(n) asm volatile("s_waitcnt lgkmcnt(" #n ")" ::: "memory")
#define PG8_BAR __builtin_amdgcn_s_barrier()
#define PG8_SCHED __builtin_amdgcn_sched_barrier(0)
    Unit cur, nxt; int ui = 0;
    if (!S.next(0, cur)) return;
    f32x4 acc[2][2][4][2];
#pragma unroll
    for (int a = 0; a < 2; ++a)
#pragma unroll
        for (int b = 0; b < 2; ++b)
#pragma unroll
            for (int m = 0; m < 4; ++m)
#pragma unroll
                for (int n = 0; n < 2; ++n) acc[a][b][m][n] = (f32x4){0.f, 0.f, 0.f, 0.f};
    bf16x8 At[4][2], B0[2][2], B1[2][2]; v8i32 At8[4], B08[2], B18[2]; const int one_scale = 0x7F7F7F7F;
#define XLDA(b, h) do { if constexpr (FP8) PG8_LDA8(At8, b, h); else PG8_LDA(At, b, h); } while (0)
#define XLDB0(b, h) do { if constexpr (FP8) PG8_LDB8(B08, b, h); else PG8_LDB(B0, b, h); } while (0)
#define XLDB1(b, h) do { if constexpr (FP8) PG8_LDB8(B18, b, h); else PG8_LDB(B1, b, h); } while (0)
#define XMMA0(ai, bj) do { if constexpr (FP8) PG8_MMA8(ai, bj, At8, B08); else PG8_MMA(ai, bj, At, B0); } while (0)
#define XMMA1(ai, bj) do { if constexpr (FP8) PG8_MMA8(ai, bj, At8, B18); else PG8_MMA(ai, bj, At, B1); } while (0)
    unsigned vAc[2][2], vAn[2][2];
#define PG8_ROWS(dst, un) do { if constexpr (GATHER) { _Pragma("unroll") for (int _h = 0; _h < 2; ++_h) _Pragma("unroll") for (int _i = 0; _i < 2; ++_i) \
        dst[_h][_i] = (S.arow(un, _h * HALF + Rr[0] + 64 * _i) * (unsigned)K + (unsigned)Cc[0]) * 2u; } } while (0)
    PG8_ROWS(vAc, cur);
#pragma unroll
    for (int _h = 0; _h < 2; ++_h)
#pragma unroll
        for (int _i = 0; _i < 2; ++_i) vAn[_h][_i] = vAc[_h][_i];
    unsigned cA = GATHER ? 0u : (unsigned)cur.pm * tstep; unsigned cB = (unsigned)cur.pn * tstep;
    PG8_STAGE(PG8_SB(0, 0), cB, voffB); PG8_STAGE(PG8_SB(0, 1), cB + hstep, voffB); PG8_STAGE_A(PG8_SA(0, 0), cA, 0, false); PG8_STAGE_A(PG8_SA(0, 1), cA, 1, false);
    if (wr == 1) PG8_BAR;
    PG8_WAIT_V(2); PG8_BAR;
    PG8_STAGE(PG8_SB(1, 0), cB + kstep, voffB); PG8_STAGE_A(PG8_SA(1, 0), cA + kstep, 0, false); PG8_STAGE(PG8_SB(1, 1), cB + hstep + kstep, voffB);
    PG8_WAIT_V(6); PG8_BAR;
    for (;;) {
        const bool has_next = S.next(ui + 1, nxt);
        if constexpr (GATHER) {
            if (has_next) {
                if (ui == 0) { PG8_ROWS(vAn, nxt); asm volatile("" : "+v"(vAn[0][0]), "+v"(vAn[0][1]), "+v"(vAn[1][0]), "+v"(vAn[1][1])); }
                else {
#pragma unroll
                    for (int _h = 0; _h < 2; ++_h)
#pragma unroll
                        for (int _i = 0; _i < 2; ++_i) { const int R_ = _h * HALF + Rr[0] + 64 * _i; const unsigned v_ = *(const LAS unsigned*)(lds + PRE_ROWS + ((ui + 1) & 1) * 1024 + R_ * 4);
                            vAn[_h][_i] = (S.rowval(nxt, R_, v_) * (unsigned)K + (unsigned)Cc[0]) * 2u; } }
            }
            Unit n2_; if (S.next(ui + 2, n2_)) { if (wid == 0) __builtin_amdgcn_global_load_lds((const unsigned*)(S.rows_ptr(n2_) + lane * 4), (LAS unsigned*)(lds + PRE_ROWS + (ui & 1) * 1024), 16, 0, 0); }
        } else { if (has_next) { PG8_ROWS(vAn, nxt); } }
        if constexpr (Epi::HAS_PRE) E.pre(lds + PRE_EPI + (ui & 1) * 2048, cur, wid, lane);
        const unsigned nA = GATHER ? 0u : (has_next ? (unsigned)nxt.pm * tstep : cA);
        const unsigned nB = has_next ? (unsigned)nxt.pn * tstep : cB;
#pragma unroll 1
        for (int t = 0; t < nt; t += 2) {
            const bool last = (t == nt - 2);
            const bool nx = last && has_next;
            const unsigned a1 = cA + (unsigned)(t + 1) * kstep;
            const unsigned a2 = last ? nA : cA + (unsigned)(t + 2) * kstep; const unsigned b2 = last ? nB : cB + (unsigned)(t + 2) * kstep;
            const unsigned a3 = a2 + kstep; const unsigned b3 = b2 + kstep;
            XLDB0(0, 0); XLDB1(0, 1); PG8_SCHED; XLDA(0, 0); PG8_STAGE_A(PG8_SA(1, 1), a1, 1, false);
            PG8_WAIT_V(8); PG8_WAIT_L(0); PG8_BAR; XMMA0(0, 0); XMMA1(0, 1); PG8_BAR; PG8_SCHED;
            XLDA(0, 1); PG8_STAGE(PG8_SB(0, 0), b2, voffB); PG8_STAGE(PG8_SB(0, 1), b2 + hstep, voffB); PG8_STAGE_A(PG8_SA(0, 0), a2, 0, nx);
            PG8_WAIT_V(8); PG8_WAIT_L(0); PG8_BAR; XMMA0(1, 0); XMMA1(1, 1); PG8_BAR; PG8_SCHED;
            XLDB0(1, 0); XLDB1(1, 1); PG8_SCHED; XLDA(1, 0); PG8_STAGE_A(PG8_SA(0, 1), a2, 1, nx);
            PG8_WAIT_V(8); PG8_WAIT_L(0); PG8_BAR; XMMA0(0, 0); XMMA1(0, 1); PG8_BAR; PG8_SCHED;
            XLDA(1, 1); PG8_STAGE(PG8_SB(1, 0), b3, voffB); PG8_STAGE(PG8_SB(1, 1), b3 + hstep, voffB); PG8_STAGE_A(PG8_SA(1, 0), a3, 0, nx);
            PG8_WAIT_V(8); PG8_WAIT_L(0); PG8_BAR; XMMA0(1, 0); XMMA1(1, 1); PG8_BAR; PG8_SCHED;
        }
        if constexpr (FP8) asm volatile("s_nop 15\n\ts_nop 15" ::: "memory");
        if constexpr (ALIGN_EPI) { if (wr == 0) PG8_BAR; }
        if constexpr (Epi::HAS_PRE) E(acc, cur, wr, wc, fr, fq, lds + PRE_EPI + (ui & 1) * 2048); else E(acc, cur, wr, wc, fr, fq);
        if (!has_next) break;
#pragma unroll
        for (int a = 0; a < 2; ++a)
#pragma unroll
            for (int b = 0; b < 2; ++b)
#pragma unroll
                for (int m = 0; m < 4; ++m)
#pragma unroll
                    for (int n = 0; n < 2; ++n) acc[a][b][m][n] = (f32x4){0.f, 0.f, 0.f, 0.f};
        cur = nxt; cA = nA; cB = nB; ++ui;
#pragma unroll
        for (int _h = 0; _h < 2; ++_h)
#pragma unroll
            for (int _i = 0; _i < 2; ++_i) vAc[_h][_i] = vAn[_h][_i];
        if constexpr (ALIGN_EPI) { if (wr == 1) PG8_BAR; }
    }
    PG8_WAIT_V(0);
    if constexpr (!ALIGN_EPI) { if (wr == 0) PG8_BAR; }
    PG8_BAR;
#undef PG8_SA
#undef PG8_SB
#undef PG8_STAGE
#undef PG8_STAGEA
#undef PG8_STAGE_A
#undef PG8_ROWS
#undef PG8_LDA
#undef PG8_LD8
#undef PG8_LDA8
#undef PG8_LDB8
#undef PG8_MMA8
#undef XLDA
#undef XLDB0
#undef XLDB1
#undef XMMA0
#undef XMMA1
#undef PG8_LDB
#undef PG8_MMA
#undef PG8_WAIT_V
#undef PG8_WAIT_L
#undef PG8_BAR
#undef PG8_SCHED
}
}

constexpr int DM = 1024, SEQ = 16384, NB = 2, T = NB * SEQ, CTX = 256, NCTX = NB * CTX, NKEY = SEQ + CTX;
constexpr int NE = 32, TOPK = 4, CAP = 32768;
constexpr float ALPHA = 1.4142135623730951f, LN_EPS = 1e-5f;
constexpr float QSCALE = 0.125f * 1.4426950408889634f;
constexpr float LAM_INIT0 = 0.2f;
constexpr int NWAVES = 8, NTHR = 512;

constexpr size_t MiB = 1u << 20;
constexpr size_t WS_CTL = 0, CTL_ZERO_BYTES = 1 * MiB;
constexpr size_t WS_MODP = 1 * MiB;
constexpr size_t WS_MOD = 3 * MiB;
constexpr size_t WS_TAB = 4 * MiB;
constexpr size_t WS_WEVIN = 6 * MiB, WS_WEVOUT = 11 * MiB, WS_WODIN = 13 * MiB, WS_WODOUT = 16 * MiB;
constexpr size_t WS_LIST = 18 * MiB, WS_GATES = 22 * MiB;
constexpr size_t WS_WGU = 32 * MiB;
constexpr size_t WS_WD = 288 * MiB;
constexpr size_t WS_U = 416 * MiB;
constexpr size_t WS_Q = 482 * MiB, WS_K = 514 * MiB, WS_V = 547 * MiB, WS_AB = 580 * MiB;
constexpr size_t WS_O0 = 612 * MiB;
constexpr size_t WS_MIX = 676 * MiB, WS_Y = 740 * MiB, WS_H1 = 804 * MiB, WS_U2 = 932 * MiB;
constexpr size_t WS_ACT = 996 * MiB;
constexpr size_t WS_YB = 1268 * MiB;
constexpr size_t WS_H2 = 1524 * MiB;
constexpr size_t WS_ZODD = 1652 * MiB;
constexpr size_t WS_WT = 1748 * MiB;
constexpr size_t WS_END = 1812 * MiB;
constexpr size_t TB_COS = 0, TB_SIN = 20480, TB_CS = 40960  , TB_AF = 106496  , TB_A3 = 237568  , TB_TW = 303104  , TB_WS = 434176  , TB_END = 565248;
constexpr int CW_ERR = 0, CW_BAR = 4096, CW_CNT = 16384;
#define XB_TMO      128
#define XB_XCNT(j)  (256  + 64 * (j))
#define XB_XSUB(j)  (1280 + 64 * (j))
#define XB_XGEN(j)  (2304 + 64 * (j))
#define XB_TOP      3328
#define XB_TOPGEN   3392
#define XCD_BAR_WORDS 3456
#define XB_SPIN_CAP (1u << 18)
constexpr int LDS_BYTES = 160 * 1024, MISC_OFF = LDS_BYTES - 256, META_OFF = 131072;

__device__ __forceinline__ unsigned xb_ld(unsigned* p)              { return __hip_atomic_load(p, __ATOMIC_RELAXED, __HIP_MEMORY_SCOPE_AGENT); }
__device__ __forceinline__ unsigned xb_add(unsigned* p, unsigned v) { return __hip_atomic_fetch_add(p, v, __ATOMIC_RELAXED, __HIP_MEMORY_SCOPE_AGENT); }
__device__ __forceinline__ unsigned xb_xcc_id() { return (unsigned)__builtin_amdgcn_s_getreg((3 << 11) | 20) & 0xFu; }
#define XB_SPIN(cond, bar) do { unsigned _sp = 0; while (cond) { __builtin_amdgcn_s_sleep(1); \
    if ((++_sp & 255u) == 0u) { if (xb_ld(&(bar)[XB_TMO])) break; if (_sp > XB_SPIN_CAP) { atomicAdd(&(bar)[XB_TMO], 1u); break; } } } } while (0)
struct XcdBarrier { unsigned* bar; unsigned x; volatile LAS unsigned* st; };
__device__ __forceinline__ XcdBarrier xcd_barrier_post(unsigned* bar, volatile LAS unsigned* st) {
    XcdBarrier b; b.bar = bar; b.x = xb_xcc_id(); b.st = st;
    if (threadIdx.x == 0) (void)xb_add(&bar[XB_XCNT(b.x)], 1u);
    return b;
}
__device__ __forceinline__ void xcd_barrier_complete(unsigned* bar, unsigned x, unsigned& nloc, unsigned& nx) {
    const unsigned G = gridDim.x * gridDim.y * gridDim.z;
    unsigned sum, cnt, mine, sp = 0u;
    for (;;) {
        sum = 0u; cnt = 0u; mine = 0u;
#pragma unroll
        for (unsigned j = 0; j < 16; ++j) { const unsigned c = xb_ld(&bar[XB_XCNT(j)]); sum += c; cnt += (c > 0u) ? 1u : 0u; mine = (j == x) ? c : mine; }
        if (sum == G) break;
        __builtin_amdgcn_s_sleep(1);
        if ((++sp & 255u) == 0u) { if (xb_ld(&bar[XB_TMO])) break; if (sp > XB_SPIN_CAP) { atomicAdd(&bar[XB_TMO], 1u); break; } }
    }
    nloc = mine > 0u ? mine : 1u; nx = cnt > 0u ? cnt : 1u;
}
__device__ __forceinline__ void xcd_barrier(const XcdBarrier& b) {
    asm volatile("s_waitcnt vmcnt(0)" ::: "memory");
    __syncthreads();
    if (threadIdx.x == 0) {
        unsigned* bar = b.bar;
        __builtin_amdgcn_s_waitcnt(0);
        unsigned nloc = b.st[0], nx = b.st[1];
        if (nloc == 0u) { xcd_barrier_complete(bar, b.x, nloc, nx); b.st[0] = nloc; b.st[1] = nx; }
        const unsigned old = xb_add(&bar[XB_XSUB(b.x)], 1u);
        const unsigned gen = old / nloc;
        if (old + 1u == (gen + 1u) * nloc) {
            __builtin_amdgcn_fence(__ATOMIC_RELEASE, "agent");
            asm volatile("s_waitcnt vmcnt(0)" ::: "memory");
            const unsigned og = xb_add(&bar[XB_TOP], 1u);
            const unsigned tg = og / nx;
            if (og + 1u == (tg + 1u) * nx) xb_add(&bar[XB_TOPGEN], 1u);
            else XB_SPIN(xb_ld(&bar[XB_TOPGEN]) == tg, bar);
            __builtin_amdgcn_fence(__ATOMIC_ACQUIRE, "agent");
            xb_add(&bar[XB_XGEN(b.x)], 1u);
            asm volatile("s_waitcnt vmcnt(0)" ::: "memory");
        } else {
            XB_SPIN(xb_ld(&bar[XB_XGEN(b.x)]) == gen, bar);
            __builtin_amdgcn_fence(__ATOMIC_ACQUIRE, "agent");
            asm volatile("s_waitcnt vmcnt(0)" ::: "memory");
        }
    }
    __syncthreads();
}

__device__ __forceinline__ float bf2f(unsigned short b) { return __uint_as_float(((unsigned)b) << 16); }
__device__ __forceinline__ unsigned f2bf(float f) { unsigned u = __float_as_uint(f); return (u + 0x7fffu + ((u >> 16) & 1u)) >> 16; }
__device__ __forceinline__ unsigned pk2(float lo, float hi) { return f2bf(lo) | (f2bf(hi) << 16); }
__device__ __forceinline__ unsigned char f2fp8(float a) { return (unsigned char)((unsigned)__builtin_amdgcn_cvt_pk_fp8_f32(a, 0.f, 0, false) & 0xffu); }
__device__ __forceinline__ unsigned pk4_fp8(float a, float b, float c, float d) { unsigned w = (unsigned)__builtin_amdgcn_cvt_pk_fp8_f32(a, b, 0, false); return (unsigned)__builtin_amdgcn_cvt_pk_fp8_f32(c, d, (int)w, true); }
constexpr float WI_SCALE = 32.0f;
constexpr float WO_SCALE = 64.0f;
constexpr float WGU_SCALE = 32.0f, WD_SCALE = 64.0f;
template <int CTRL> __device__ __forceinline__ float dpp_f(float v) { return __builtin_bit_cast(float, __builtin_amdgcn_update_dpp(0, __builtin_bit_cast(int, v), CTRL, 0xf, 0xf, true)); }
__device__ __forceinline__ float wave_sum(float v) {
    v += dpp_f<0xB1>(v); v += dpp_f<0x4E>(v); v += dpp_f<0x141>(v); v += dpp_f<0x140>(v);
    { const auto r = __builtin_amdgcn_permlane16_swap(__float_as_uint(v), __float_as_uint(v), false, false); v = __uint_as_float(r[0]) + __uint_as_float(r[1]); }
    { const auto r = __builtin_amdgcn_permlane32_swap(__float_as_uint(v), __float_as_uint(v), false, false); v = __uint_as_float(r[0]) + __uint_as_float(r[1]); }
    return v;
}
__device__ __forceinline__ float half_sum(float v) {
    v += dpp_f<0xB1>(v); v += dpp_f<0x4E>(v); v += dpp_f<0x141>(v); v += dpp_f<0x140>(v);
    { const auto r = __builtin_amdgcn_permlane16_swap(__float_as_uint(v), __float_as_uint(v), false, false); v = __uint_as_float(r[0]) + __uint_as_float(r[1]); }
    return v;
}
__device__ __forceinline__ float xhalf_sum(float v) {
    const auto r = __builtin_amdgcn_permlane32_swap(__float_as_uint(v), __float_as_uint(v), false, false); return __uint_as_float(r[0]) + __uint_as_float(r[1]);
}
__device__ __forceinline__ float wave_max(float v) {
    v = fmaxf(v, dpp_f<0xB1>(v)); v = fmaxf(v, dpp_f<0x4E>(v)); v = fmaxf(v, dpp_f<0x141>(v)); v = fmaxf(v, dpp_f<0x140>(v));
    { const auto r = __builtin_amdgcn_permlane16_swap(__float_as_uint(v), __float_as_uint(v), false, false); v = fmaxf(__uint_as_float(r[0]), __uint_as_float(r[1])); }
    { const auto r = __builtin_amdgcn_permlane32_swap(__float_as_uint(v), __float_as_uint(v), false, false); v = fmaxf(__uint_as_float(r[0]), __uint_as_float(r[1])); }
    return v;
}
__device__ __forceinline__ int crow(int r, int hi) { return (r & 3) + 8 * (r >> 2) + 4 * hi; }
__device__ __forceinline__ float silu_f(float x) { return x / (1.0f + __expf(-x)); }
__device__ __forceinline__ float sigmoid_f(float x) { return 1.0f / (1.0f + __expf(-x)); }
__device__ __forceinline__ int v_st(int k, int c) { const int kk = (k & ~0xC) | ((k & 4) << 1) | ((k & 8) >> 1); return ((kk >> 3) * 4 + (c >> 5)) * 512 + ((kk & 7) * 32 + (c & 31)) * 2; }
__device__ __forceinline__ int v_rd_base(int lane) { return ((lane & 3) << 3) | (((lane >> 2) & 3) << 6) | (((lane >> 4) & 1) << 5) | (((lane >> 5) & 1) << 8); }
__host__ __device__ constexpr int v_rd_off(int d0, int ks, int half) { return d0 * 512 + ks * 4096 + half * 2048; }
typedef short v4i16_t __attribute__((ext_vector_type(4)));
__device__ __forceinline__ bf16x8 vfrag(LAS unsigned char* tile_rd  , int d0, int ks) {
    const v4i16_t lo = __builtin_amdgcn_ds_read_tr16_b64_v4i16((LAS v4i16_t*)(tile_rd + v_rd_off(d0, ks, 0)));
    const v4i16_t hi = __builtin_amdgcn_ds_read_tr16_b64_v4i16((LAS v4i16_t*)(tile_rd + v_rd_off(d0, ks, 1)));
    return (bf16x8){lo[0], lo[1], lo[2], lo[3], hi[0], hi[1], hi[2], hi[3]};
}

struct Args { const float* in[35]; float* out; unsigned char* ws; int ph_lo, ph_hi; };

struct Frame { LAS unsigned char* lds; int tid, lane, wave, G, bx, kz; };
#define CAS __attribute__((address_space(4)))
__device__ __forceinline__ const float* kin_(int kz, int i) { return *(const float* const CAS*)((const CAS char*)__builtin_amdgcn_kernarg_segment_ptr() + kz + 8 * i); }
#define KIN(F, i) kin_((F).kz, (i))
#define KOUT(F) ((float*)kin_((F).kz, 35))
#define KWS(F) ((unsigned char*)kin_((F).kz, 36))
static_assert(sizeof(Args) == 37 * 8 + 8, "Args layout");

__device__ __forceinline__ void ph0_mod_tables(Frame& F) {
    const float* c = KIN(F, 1); const float* cctx = KIN(F, 3); const float* wmod = KIN(F, 4);
    LAS float* sv = (LAS float*)F.lds;
    for (int vb = F.bx; vb < 256; vb += F.G) {
    const int l = vb >> 7, rem = vb & 127, nch = rem & 7, kch = rem >> 3, k0 = kch * 64;
    if (F.tid < 192) { const int v = F.tid >> 6, k = F.tid & 63; const float x = (v < 2) ? c[v * DM + k0 + k] : cctx[k0 + k]; sv[v * 64 + k] = silu_f(x); }
    __syncthreads();
    if (F.tid < 384) {
        const int col = nch * 768 + F.tid * 2;
        const float* W = wmod + ((size_t)l * DM + k0) * 6144 + col;
        f32x2 a0 = {0.f, 0.f}, a1 = {0.f, 0.f}, a2 = {0.f, 0.f};
#pragma unroll 8
        for (int k = 0; k < 64; ++k) { const f32x2 w = *(const f32x2*)(W + (size_t)k * 6144); a0 += w * sv[k]; a1 += w * sv[64 + k]; a2 += w * sv[128 + k]; }
        float* mp = (float*)(KWS(F) + WS_MODP) + (size_t)kch * 5 * 6144 + col;
        if (l == 0) { *(f32x2*)(mp + 0 * 6144) = a0; *(f32x2*)(mp + 1 * 6144) = a1; *(f32x2*)(mp + 2 * 6144) = a2; }
        else { *(f32x2*)(mp + 3 * 6144) = a0; *(f32x2*)(mp + 4 * 6144) = a1; }
    }
    __syncthreads();
    }
    const int bx = F.bx;
    unsigned char* tb = KWS(F) + WS_TAB;
    const int gid = bx * NTHR + F.tid, NG = F.G * NTHR;
    const float s128 = 0.08838834764831845f;
    for (int i = gid; i < 5120; i += NG) {
        const int pos = i >> 4, f = i & 15; const int p = pos < 256 ? pos : pos - 256;
        const float inv = powf(10000.0f, -((float)f / 16.0f)); const float ang = (float)p * inv;
        ((float*)(tb + TB_COS))[i] = (float)cos((double)ang); ((float*)(tb + TB_SIN))[i] = (float)sin((double)ang);
    }
    for (int i = gid; i < 32768; i += NG) {
        const int j8 = i & 7, ln = (i >> 3) & 63, ks = (i >> 9) & 7, nb = i >> 12;
        const int n = 32 * nb + (ln & 31), cc = 16 * ks + 8 * (ln >> 5) + j8, part = n >> 7, jj = n & 127, m = (jj * cc) & 127;
        const double a = (double)m / 64.0; const float v = (part == 0 ? (float)cospi(a) : -(float)sinpi(a)) * s128;
        ((bf16_t*)(tb + TB_CS))[i] = (bf16_t)f2bf(v);
    }
    for (int i = gid; i < 65536; i += NG) {
        const int j8 = i & 7, ln = (i >> 3) & 63, ks = (i >> 9) & 15, mb = i >> 13;
        const int m = 32 * mb + (ln & 31), k = 16 * ks + 8 * (ln >> 5) + j8, mpart = m >> 7, k1 = m & 127, part = k >> 7, t1 = k & 127, ph = (k1 * t1) & 127;
        const double a = (double)ph / 64.0; const float cs = (float)cospi(a), sn = (float)sinpi(a);
        const float v = (mpart == 0 ? (part == 0 ? cs : sn) : (part == 0 ? -sn : cs)) * s128;
        ((bf16_t*)(tb + TB_AF))[i] = (bf16_t)f2bf(v);
    }
    for (int i = gid; i < 32768; i += NG) {
        const int j8 = i & 7, ln = (i >> 3) & 63, ks = (i >> 9) & 15, mb = i >> 13;
        const int k2 = 32 * mb + (ln & 31), k = 16 * ks + 8 * (ln >> 5) + j8, part = k >> 7, t2 = k & 127, ps = (k2 * t2) & 127;
        const double a = (double)ps / 64.0; const float v = (part == 0 ? (float)cospi(a) : (float)sinpi(a)) * s128;
        ((bf16_t*)(tb + TB_A3))[i] = (bf16_t)f2bf(v);
    }
    for (int i = gid; i < 16384; i += NG) {
        const int t2 = i >> 7, k1 = i & 127; const double a = (double)((k1 * t2) & 16383) / 8192.0;
        ((f32x2*)(tb + TB_TW))[i] = (f32x2){(float)cospi(a), (float)sinpi(a)};
    }
    const float* gws = KIN(F, 25);
    for (int i = gid; i < 65536; i += NG) ((bf16_t*)(tb + TB_WS))[i] = (bf16_t)f2bf(gws[i]);
}

__device__ __forceinline__ void transpose_item(const float* W, int K, int ldw, int k0, int n_src0, bf16_t* WT, int row_dst0, LAS float* scr, int lane) {
#pragma unroll 8
    for (int i = 0; i < 32; ++i) { const int kk = 2 * i + (lane >> 5); scr[kk * 33 + (lane & 31)] = W[(size_t)(k0 + kk) * ldw + n_src0 + (lane & 31)]; }
    asm volatile("s_waitcnt lgkmcnt(0)" ::: "memory");
    const int c = lane & 7;
#pragma unroll
    for (int j = 0; j < 4; ++j) { const int n = (lane >> 3) + 8 * j; const LAS float* s = scr + (8 * c) * 33 + n;
        u32x4 o; o.x = pk2(s[0 * 33], s[1 * 33]); o.y = pk2(s[2 * 33], s[3 * 33]); o.z = pk2(s[4 * 33], s[5 * 33]); o.w = pk2(s[6 * 33], s[7 * 33]);
        *(u32x4*)(WT + (size_t)(row_dst0 + n) * K + k0 + 8 * c) = o; }
    asm volatile("s_waitcnt lgkmcnt(0)" ::: "memory");
}
__device__ __forceinline__ void transpose_item_fp8(const float* W, int K, int ldw, int k0, int n_src0, unsigned char* WT8, int row_dst0, float scale, LAS float* scr, int lane) {
#pragma unroll 8
    for (int i = 0; i < 64; ++i) { const int kk = 2 * i + (lane >> 5); scr[kk * 33 + (lane & 31)] = W[(size_t)(k0 + kk) * ldw + n_src0 + (lane & 31)]; }
    asm volatile("s_waitcnt lgkmcnt(0)" ::: "memory");
    const int q = lane & 3;
#pragma unroll
    for (int j = 0; j < 2; ++j) { const int n = (lane >> 2) + 16 * j; const LAS float* s = scr + (32 * q) * 33 + n; unsigned w[8];
#pragma unroll
        for (int t = 0; t < 8; ++t) w[t] = pk4_fp8(s[(4 * t) * 33] * scale, s[(4 * t + 1) * 33] * scale, s[(4 * t + 2) * 33] * scale, s[(4 * t + 3) * 33] * scale);
        unsigned char* dst = WT8 + (size_t)(row_dst0 + n) * K + k0 + 32 * q;
        *(u32x4*)dst = (u32x4){w[0], w[1], w[2], w[3]}; *(u32x4*)(dst + 16) = (u32x4){w[4], w[5], w[6], w[7]}; }
    asm volatile("s_waitcnt lgkmcnt(0)" ::: "memory");
}
__device__ __forceinline__ void ph1_convert(Frame& F) {
    {
        const int gid = F.bx * NTHR + F.tid;
        if (gid < 5 * 6144) { const int vec = gid / 6144, n = gid % 6144, l = vec < 3 ? 0 : 1; float s = KIN(F, 5)[l * 6144 + n];
            const float* mp = (const float*)(KWS(F) + WS_MODP) + (size_t)vec * 6144 + n;
#pragma unroll
            for (int kc = 0; kc < 16; ++kc) s += mp[(size_t)kc * 5 * 6144];
            ((float*)(KWS(F) + WS_MOD))[gid] = s; }
    }
    LAS float* scr = (LAS float*)(F.lds + F.wave * 16896);
    const int gw = F.bx * NWAVES + F.wave, NGW = F.G * NWAVES;
    constexpr int I_EVIN = 8 * 80, I_EVOUT = 8 * 32, I_ODIN = 8 * 48, I_ODOUT = 8 * 32, I_DENSE = I_EVIN + I_EVOUT + I_ODIN + I_ODOUT;
    constexpr int I_GU = 64 * 512, I_DN = 64 * 256, NITEMS = I_DENSE + I_GU + I_DN;
    for (int it = gw; it < NITEMS; it += NGW) {
        int r = it;
        if (r < I_EVIN) { const int kb = r / 80, nb = r % 80, n0 = 32 * nb; int src = n0;
            if (n0 >= 1536) { const int u = (n0 - 1536) >> 8, w = (n0 - 1536) & 255; src = (w < 128) ? 1536 + 128 * u + w : 2048 + 128 * u + (w - 128); }
            transpose_item_fp8(KIN(F, 10), DM, 2560, 128 * kb, src, (unsigned char*)(KWS(F) + WS_WEVIN), n0, WI_SCALE, scr, F.lane); continue; } r -= I_EVIN;
        if (r < I_EVOUT) { const int kb = r / 32, nb = r % 32; transpose_item_fp8(KIN(F, 11), DM, 1024, 128 * kb, 32 * nb, (unsigned char*)(KWS(F) + WS_WEVOUT), 32 * nb, WO_SCALE, scr, F.lane); continue; } r -= I_EVOUT;
        if (r < I_ODIN) { const int kb = r / 48, nb = r % 48; transpose_item_fp8(KIN(F, 21), DM, 1536, 128 * kb, 32 * nb, (unsigned char*)(KWS(F) + WS_WODIN), 32 * nb, WI_SCALE, scr, F.lane); continue; } r -= I_ODIN;
        if (r < I_ODOUT) { const int kb = r / 32, nb = r % 32; transpose_item_fp8(KIN(F, 22), DM, 1024, 128 * kb, 32 * nb, (unsigned char*)(KWS(F) + WS_WODOUT), 32 * nb, WO_SCALE, scr, F.lane); continue; } r -= I_ODOUT;
        if (r < I_GU) { const int le = r >> 9, q = r & 511, kb = q >> 6, nb = q & 63, n0 = 32 * nb; const int u = n0 >> 8, w = n0 & 255;
            const int src = (w < 128) ? 128 * u + w : 1024 + 128 * u + (w - 128);
            transpose_item_fp8(KIN(F, 31) + (size_t)le * DM * 2048, DM, 2048, 128 * kb, src, (unsigned char*)(KWS(F) + WS_WGU) + (size_t)le * 2048 * DM, n0, WGU_SCALE, scr, F.lane); continue; } r -= I_GU;
        { const int le = r >> 8, q = r & 255, kb = q >> 5, nb = q & 31;
            transpose_item_fp8(KIN(F, 33) + (size_t)le * DM * 1024, DM, 1024, 128 * kb, 32 * nb, (unsigned char*)(KWS(F) + WS_WD) + (size_t)le * 1024 * DM, 32 * nb, WD_SCALE, scr, F.lane); }
    }
}

__device__ __forceinline__ void mod_row(const float* xrow, const float* sh, const float* sc, unsigned char* orow, int lane) {
    f32x4 x[4], a[4], b[4];
#pragma unroll
    for (int j = 0; j < 4; ++j) { const int d = 4 * lane + 256 * j; x[j] = *(const f32x4*)(xrow + d); a[j] = *(const f32x4*)(sc + d); b[j] = *(const f32x4*)(sh + d); }
    asm volatile("" ::: "memory");
#pragma unroll
    for (int j = 0; j < 4; ++j) { const int d = 4 * lane + 256 * j;
        const f32x4 v = x[j] * (a[j] + 1.0f) + b[j]; *(unsigned*)(orow + d) = pk4_fp8(v[0], v[1], v[2], v[3]); }
}
__device__ __forceinline__ void ph2_modulate(Frame& F) {
    const float* mod = (const float*)(KWS(F) + WS_MOD); unsigned char* U = (unsigned char*)(KWS(F) + WS_U);
    const int gw = F.bx * NWAVES + F.wave, NGW = F.G * NWAVES;
    for (int r = gw; r < T + NCTX; r += NGW) {
        if (r < T) { const int b = r >> 14; mod_row(KIN(F, 0) + (size_t)r * DM, mod + b * 6144, mod + b * 6144 + 1024, U + (size_t)r * DM, F.lane); }
        else { mod_row(KIN(F, 2) + (size_t)(r - T) * DM, mod + 2 * 6144, mod + 2 * 6144 + 1024, U + (size_t)r * DM, F.lane); }
    }
}

struct EvInOrder {
    pg8::StaticOrder so;
    __device__ bool next(int i, pg8::Unit& u) const {
        const long L = (long)i * so.G + so.c;
        if (L < so.nwg) return so.map(L, u);
        const int x = (int)(L - so.nwg); if (x >= 8) return false;
        u.pm = 128 + (x >> 2); u.pn = 2 + (x & 3); u.a0 = 0; u.a1 = 0; u.a2 = 256; return true;
    }
    __device__ __forceinline__ unsigned arow(const pg8::Unit&, int) const { return 0u; }
};
__device__ __forceinline__ int vpos64(int k) { return 32 * ((k >> 2) & 1) + 16 * (k >> 5) + ((k & 3) + 4 * ((k & 31) >> 3)); }
struct EpiEvIn {
    static constexpr bool PERM = false, HAS_PRE = false;
    unsigned char *Q8, *K8, *V8T; bf16_t* Ab; const float* cosT; const float* sinT;
    __device__ __forceinline__ void operator()(const f32x4 (&acc)[2][2][4][2], const pg8::Unit& u, int wr, int wc, int fr, int fq) const {
        const int pn = u.pn;
        if (pn < 4) {
            const int kind = pn >> 1, colbase = (pn & 1) * 256 + wc * 32 + 4 * fq; const bool isctx = u.pm >= 128;
            const float sc = ((kind == 0) ? QSCALE : 1.0f) * (1.0f / WI_SCALE);
#define QK_ROW(ai, m, CS, SN) do { const int row = u.pm * 256 + (ai) * 128 + wr * 64 + (m) * 16 + fr; int b_, key_; \
                if (!isctx) { b_ = row >> 14; key_ = row & (SEQ - 1); } else { const int rc_ = row - T; b_ = rc_ >> 8; key_ = SEQ + (rc_ & 255); } \
                unsigned char* dst = (kind == 0) ? Q8 + (size_t)row * 512 : K8 + (size_t)(b_ * NKEY + key_) * 512; \
                _Pragma("unroll") for (int bj = 0; bj < 2; ++bj) { const f32x4 x1 = acc[ai][bj][m][0], x2 = acc[ai][bj][m][1]; \
                    const f32x4 o1 = (x1 * (CS) - x2 * (SN)) * sc, o2 = (x1 * (SN) + x2 * (CS)) * sc; \
                    *(unsigned*)(dst + colbase + bj * 128) = pk4_fp8(o1[0], o1[1], o1[2], o1[3]); *(unsigned*)(dst + colbase + bj * 128 + 16) = pk4_fp8(o2[0], o2[1], o2[2], o2[3]); } } while (0)
            if (wc & 1) {
#pragma unroll
                for (int mh = 0; mh < 2; ++mh) {
                    f32x4 cs[2], sn[2];
#pragma unroll
                    for (int mm = 0; mm < 2; ++mm) { cs[mm] = (f32x4){1.f, 1.f, 1.f, 1.f}; sn[mm] = (f32x4){0.f, 0.f, 0.f, 0.f};
                        if (!isctx) { const int pos = 256 + (2 * mh + mm) * 16 + fr; cs[mm] = *(const f32x4*)(cosT + pos * 16 + 4 * fq); sn[mm] = *(const f32x4*)(sinT + pos * 16 + 4 * fq); } }
                    asm volatile("" ::: "memory");
#pragma unroll
                    for (int ai = 0; ai < 2; ++ai)
#pragma unroll
                        for (int mm = 0; mm < 2; ++mm) QK_ROW(ai, 2 * mh + mm, cs[mm], sn[mm]);
                }
            } else {
                f32x4 cs[2], sn[2];
#pragma unroll
                for (int ai = 0; ai < 2; ++ai) { cs[ai] = (f32x4){1.f, 1.f, 1.f, 1.f}; sn[ai] = (f32x4){0.f, 0.f, 0.f, 0.f};
                    if (!isctx) { const int pos = ((u.pm * 256 + ai * 128 + wr * 64) & (SEQ - 1)) >> 6; cs[ai] = *(const f32x4*)(cosT + pos * 16 + 4 * fq); sn[ai] = *(const f32x4*)(sinT + pos * 16 + 4 * fq); } }
                asm volatile("" ::: "memory");
#pragma unroll
                for (int ai = 0; ai < 2; ++ai)
#pragma unroll
                    for (int m = 0; m < 4; ++m) QK_ROW(ai, m, cs[ai], sn[ai]);
            }
#undef QK_ROW
        } else if (pn < 6) {
            const int colbase = (pn & 1) * 256 + wc * 32 + 4 * fq;
#pragma unroll
            for (int ai = 0; ai < 2; ++ai)
#pragma unroll
                for (int m = 0; m < 4; ++m) {
                    const int row = u.pm * 256 + ai * 128 + wr * 64 + m * 16 + fr; const bool isctx = row >= T;
                    int b, key;
                    if (!isctx) { b = row >> 14; key = row & (SEQ - 1); } else { const int rc = row - T; b = rc >> 8; key = SEQ + (rc & 255); }
                    const size_t kofs = (size_t)(key & ~63) + vpos64(key & 63);
#pragma unroll
                    for (int bj = 0; bj < 2; ++bj)
#pragma unroll
                        for (int n = 0; n < 2; ++n) { const f32x4 x = acc[ai][bj][m][n] * (1.0f / WI_SCALE); const unsigned w = pk4_fp8(x[0], x[1], x[2], x[3]); const int vcol = colbase + bj * 128 + n * 16;
                            unsigned char* dst = V8T + ((size_t)(b * 4 + (vcol >> 7)) * 128 + (vcol & 127)) * NKEY + kofs;
                            dst[0] = (unsigned char)(w & 0xff); dst[NKEY] = (unsigned char)((w >> 8) & 0xff); dst[2 * NKEY] = (unsigned char)((w >> 16) & 0xff); dst[3 * NKEY] = (unsigned char)(w >> 24); }
                }
        } else {
            const int colbase = (pn - 6) * 128 + wc * 32 + 4 * fq;
#pragma unroll
            for (int ai = 0; ai < 2; ++ai)
#pragma unroll
                for (int m = 0; m < 4; ++m) {
                    const int row = u.pm * 256 + ai * 128 + wr * 64 + m * 16 + fr; if (row >= T) continue;
                    bf16_t* dst = Ab + (size_t)row * 512 + colbase;
#pragma unroll
                    for (int n = 0; n < 2; ++n) { const f32x4 v = acc[ai][0][m][n] * (1.0f / WI_SCALE), g = acc[ai][1][m][n] * (1.0f / WI_SCALE); f32x4 o;
#pragma unroll
                        for (int j = 0; j < 4; ++j) o[j] = v[j] * sigmoid_f(g[j]);
                        u32x2 w; w.x = pk2(o[0], o[1]); w.y = pk2(o[2], o[3]); *(u32x2*)(dst + n * 16) = w; }
                }
        }
    }
};

__device__ __forceinline__ void ph4_conv(Frame& F) {
    const bf16_t* Ab = (const bf16_t*)(KWS(F) + WS_AB); unsigned char* MIX = (unsigned char*)(KWS(F) + WS_MIX);
    const float* cw = KIN(F, 12); const float* cb = KIN(F, 13); const float* lg = KIN(F, 14); const float* lb = KIN(F, 15);
    LAS bf16_t* At = (LAS bf16_t*)F.lds;
    LAS float* Yt = (LAS float*)(F.lds + 65536);
    const int ch = F.tid;
    float w[31];
#pragma unroll
    for (int j = 0; j < 31; ++j) w[j] = cw[j * 512 + ch];
    const float bias = cb[ch];
#define CONV_STAGE(tile_) do { const int b_ = (tile_) >> 9, t0_ = ((tile_) & 511) * 32; \
        _Pragma("unroll") for (int k_ = 0; k_ < 8; ++k_) { const int row_ = F.wave + 8 * k_; if (row_ < 62) { const int t_ = t0_ - 15 + row_; \
            if (t_ >= 0 && t_ < SEQ) __builtin_amdgcn_global_load_lds((const unsigned*)(Ab + ((size_t)(b_ * SEQ + t_)) * 512 + F.lane * 8), (LAS unsigned*)(At + row_ * 512), 16, 0, 0); \
            else { const unsigned z_ = (unsigned)F.kz; const u32x4 zv_ = {z_, z_, z_, z_}; *(LAS u32x4*)(At + row_ * 512 + F.lane * 8) = zv_; } } } } while (0)
    const f32x4 g0 = *(const f32x4*)(lg + 8 * F.lane), g1 = *(const f32x4*)(lg + 8 * F.lane + 4), b0 = *(const f32x4*)(lb + 8 * F.lane), b1 = *(const f32x4*)(lb + 8 * F.lane + 4);
    if (F.bx < T / 32) CONV_STAGE(F.bx);
    for (int tile = F.bx; tile < T / 32; tile += F.G) {
        const int b = tile >> 9, t0 = (tile & 511) * 32;
        asm volatile("s_waitcnt vmcnt(0)" ::: "memory");
        __syncthreads();
        float a[62];
#pragma unroll
        for (int r = 0; r < 62; ++r) a[r] = bf2f(At[r * 512 + ch]);
#pragma unroll
        for (int t = 0; t < 32; ++t) { float y = bias;
#pragma unroll
            for (int j = 0; j < 31; ++j) y = fmaf(a[t + j], w[j], y);
            Yt[t * 512 + ch] = y; }
        __syncthreads();
        if (tile + F.G < T / 32) CONV_STAGE(tile + F.G);
#pragma unroll
        for (int q = 0; q < 4; ++q) { const int t = F.wave * 4 + q; const LAS float* yr = Yt + t * 512 + 8 * F.lane;
            const f32x4 y0 = *(const LAS f32x4*)yr, y1 = *(const LAS f32x4*)(yr + 4);
            float s = (y0[0] + y0[1]) + (y0[2] + y0[3]) + (y1[0] + y1[1]) + (y1[2] + y1[3]);
            const float mean = wave_sum(s) * (1.0f / 512.0f);
            const f32x4 d0 = y0 - mean, d1 = y1 - mean;
            float q2 = (d0[0] * d0[0] + d0[1] * d0[1]) + (d0[2] * d0[2] + d0[3] * d0[3]) + (d1[0] * d1[0] + d1[1] * d1[1]) + (d1[2] * d1[2] + d1[3] * d1[3]);
            const float rstd = 1.0f / sqrtf(wave_sum(q2) * (1.0f / 512.0f) + LN_EPS);
            f32x4 o0 = d0 * rstd * g0 + b0, o1 = d1 * rstd * g1 + b1;
#pragma unroll
            for (int j = 0; j < 4; ++j) { o0[j] = silu_f(o0[j]); o1[j] = silu_f(o1[j]); }
            u32x2 wv; wv.x = pk4_fp8(o0[0], o0[1], o0[2], o0[3]); wv.y = pk4_fp8(o1[0], o1[1], o1[2], o1[3]);
            *(u32x2*)(MIX + (size_t)(b * SEQ + t0 + t) * 1024 + 8 * F.lane) = wv; }
        __syncthreads();
    }
#undef CONV_STAGE
}

namespace att {
constexpr int KVBLK = 64;
constexpr int SHM_V = 128 * 64, SHM_K = 64 * 64;
constexpr int SHM_1 = 32 * 64;
constexpr int NBUF = 8, DIST = 4, TILEB = SHM_V + SHM_1 + SHM_K;
constexpr int OFF_T = 0, OFF_WS = NBUF * TILEB;
constexpr int OFF_NEG = OFF_WS + 2048;
constexpr float PREF = 6.0f, PMAXLOG = 8.0f;
#define SBAR() __builtin_amdgcn_sched_barrier(0)
#define MX3(a, b, c) __builtin_fmaxf(__builtin_fmaxf((a), (b)), (c))
typedef int v8i32a __attribute__((ext_vector_type(8)));
__device__ __forceinline__ f32x16 mfma8(v8i32a a, v8i32a b, f32x16 c) { return __builtin_amdgcn_mfma_scale_f32_32x32x64_f8f6f4(a, b, c, 0, 0, 0, 0x7F7F7F7F, 0, 0x7F7F7F7F); }
template <bool FIRST> __device__ __forceinline__ void partialSM(f32x16& p0, f32x16& p1, f32x16& negm, float& alpha) {
    float a = MX3(p0[0], p0[1], p1[0]), b = MX3(p0[2], p0[3], p1[1]); a = MX3(a, p1[2], p1[3]);
#pragma unroll
    for (int r = 4; r < 16; r += 4) { a = MX3(a, p0[r], p0[r + 1]); b = MX3(b, p0[r + 2], p0[r + 3]); a = MX3(a, p1[r], p1[r + 1]); b = MX3(b, p1[r + 2], p1[r + 3]); }
    float pmax = fmaxf(a, b);
    { auto rr = __builtin_amdgcn_permlane32_swap(__float_as_uint(pmax), __float_as_uint(pmax), false, false);
      pmax = fmaxf(__uint_as_float(rr[0]), __uint_as_float(rr[1])); }
    alpha = 1.f;
    if (FIRST || __builtin_expect(__any(pmax > PMAXLOG), 0)) {
        const float dl = FIRST ? (pmax - PREF) : fmaxf(pmax - PREF, 0.f); const float nm = negm[0] - dl; alpha = __builtin_amdgcn_exp2f(-dl);
#pragma unroll
        for (int r = 0; r < 16; ++r) { p0[r] -= dl; p1[r] -= dl; negm[r] = nm; }
    }
#pragma unroll
    for (int r = 0; r < 16; ++r) p0[r] = __builtin_amdgcn_exp2f(p0[r]);
}
__device__ __forceinline__ void finishSM(f32x16& p0, f32x16& p1, v8i32a& pf) {
#pragma unroll
    for (int r = 0; r < 16; ++r) p1[r] = __builtin_amdgcn_exp2f(p1[r]);
#pragma unroll
    for (int i = 0; i < 4; ++i) { pf[i] = (int)pk4_fp8(p0[4 * i], p0[4 * i + 1], p0[4 * i + 2], p0[4 * i + 3]); pf[4 + i] = (int)pk4_fp8(p1[4 * i], p1[4 * i + 1], p1[4 * i + 2], p1[4 * i + 3]); }
}
__device__ __forceinline__ v8i32a frag32(const LAS unsigned char* base, int a0, int a1) {
    const bf16x8 lo = *(const LAS bf16x8*)(base + a0), hi = *(const LAS bf16x8*)(base + a1);
    return __builtin_bit_cast(v8i32a, __builtin_shufflevector(lo, hi, 0, 1, 2, 3, 4, 5, 6, 7, 8, 9, 10, 11, 12, 13, 14, 15));
}
__device__ __forceinline__ void attn_pass(const unsigned char* __restrict__ Qw, const unsigned char* __restrict__ Kh, const unsigned char* __restrict__ Vt, LAS unsigned char* lds, f32x16 (&o)[4], f32x16& lacc, const int tid, const int wid) {
    const int lane = tid & 63, r32 = lane & 31, hi = lane >> 5;
    LAS float* al_l = (LAS float*)(lds + OFF_WS) + wid * 64 + 32;
    f32x16 negm = f32x16{}; lacc = f32x16{};
#pragma unroll
    for (int d = 0; d < 4; ++d) o[d] = f32x16{};
    const v8i32a qf = __builtin_bit_cast(v8i32a, __builtin_shufflevector(*(const bf16x8*)Qw, *(const bf16x8*)(Qw + 16), 0, 1, 2, 3, 4, 5, 6, 7, 8, 9, 10, 11, 12, 13, 14, 15));
    const int sw = (r32 >> 2) & 3, a0 = r32 * 64 + (((2 * hi) ^ sw) << 4), a1 = r32 * 64 + (((2 * hi + 1) ^ sw) << 4);
    const int drow = 16 * wid + (lane >> 2), dch = (lane & 3) ^ ((drow >> 2) & 3);
    const unsigned vsrc = (unsigned)(drow * NKEY + dch * 16), ksrc = (unsigned)(drow * 512 + dch * 16); const bool kw = wid < 4;
    LAS unsigned char* T_lds = lds + OFF_T;
#define DMA(t, bi) do { __builtin_amdgcn_global_load_lds((const unsigned*)((const char*)Vt + (size_t)(t) * 64 + vsrc), (LAS unsigned*)(T_lds + (bi) * TILEB + wid * 1024), 16, 0, 0); \
    if (kw) __builtin_amdgcn_global_load_lds((const unsigned*)((const char*)Kh + (size_t)(t) * (64 * 512) + ksrc), (LAS unsigned*)(T_lds + (bi) * TILEB + SHM_V + SHM_1 + wid * 1024), 16, 0, 0); } while (0)
#define WAITBAR(n) do { if (kw) asm volatile("s_waitcnt vmcnt(%0) lgkmcnt(0)" :: "n"(2 * (n)) : "memory"); else asm volatile("s_waitcnt vmcnt(%0) lgkmcnt(0)" :: "n"(n) : "memory"); \
    __builtin_amdgcn_s_barrier(); asm volatile("" ::: "memory"); } while (0)
#define RESC(a) do { if (__any((a) < 1.f)) { if (hi == 0) al_l[r32] = (a); asm volatile("s_waitcnt lgkmcnt(0)" ::: "memory"); \
    _Pragma("unroll") for (int r = 0; r < 16; ++r) { const float f_ = al_l[crow(r, hi)]; o[0][r] *= f_; o[1][r] *= f_; o[2][r] *= f_; o[3][r] *= f_; lacc[r] *= f_; } } } while (0)
#define QKT(P0, P1, bi) do { const LAS unsigned char* kb_ = T_lds + (bi) * TILEB + SHM_V + SHM_1; P0 = mfma8(frag32(kb_, a0, a1), qf, negm); P1 = mfma8(frag32(kb_ + 2048, a0, a1), qf, negm); } while (0)
#ifndef MF8_ACC
#define MF8_ACC "+v"
#endif
#define MF8(acc_, v_) asm volatile("v_mfma_scale_f32_32x32x64_f8f6f4 %0, %1, %2, %0, %3, %3 op_sel_hi:[0,0,0]" : MF8_ACC(acc_) : "v"(pf), "v"(v_), "v"(one_sc))
#define PV(bi) do { const LAS unsigned char* vb_ = T_lds + (bi) * TILEB; { const v8i32a v0_ = frag32(vb_, a0, a1), v1_ = frag32(vb_ + 2048, a0, a1); asm volatile("s_nop 1" ::: ); MF8(o[0], v0_); MF8(o[1], v1_); } \
    { const v8i32a v2_ = frag32(vb_ + 4096, a0, a1), v3_ = frag32(vb_ + 6144, a0, a1); MF8(o[2], v2_); MF8(o[3], v3_); } \
    { const v8i32a v4_ = frag32(vb_ + 8192, a0, a1); MF8(lacc, v4_); } } while (0)
    f32x16 pA0, pA1, pB0, pB1; v8i32a pf; constexpr int NT = NKEY / KVBLK;
    const int one_sc = 0x7F7F7F7F;
#define MFQK(P_, kf_) P_ = mfma8(kf_, qf, negm)
#define EX8(P_, b_) do { _Pragma("unroll") for (int r_ = 0; r_ < 8; ++r_) P_[(b_) + r_] = __builtin_amdgcn_exp2f(P_[(b_) + r_]); } while (0)
#if defined(EXP_EXTRA_MFMA)
#define XMF() do { const v8i32a vn_ = frag32(lds + OFF_NEG, a0, a1); MF8(lacc, vn_); MF8(lacc, v4_); } while (0)
#else
#define XMF() do { } while (0)
#endif
#if defined(EXP_EXTRA_LDS)
#define XTRA(A_, B_) do { _Pragma("unroll") for (int r_ = 0; r_ < 5; ++r_) { const v8i32a t_ = frag32(vb_ + 2048 * r_, a0, a1); asm volatile("" :: "v"(t_)); } } while (0)
#elif defined(EXP_EXTRA_EXP)
#define XTRA(A_, B_) do { _Pragma("unroll") for (int r_ = 0; r_ < 16; ++r_) { float t_; asm volatile("v_exp_f32 %0, %1" : "=v"(t_) : "v"(A_[r_])); asm volatile("v_exp_f32 %0, %1" : "=v"(t_) : "v"(B_[r_])); } } while (0)
#elif defined(EXP_EXTRA_ADD)
#define XTRA(A_, B_) do { _Pragma("unroll") for (int r_ = 0; r_ < 16; ++r_) { float t_; asm volatile("v_add_f32 %0, %1, %1" : "=v"(t_) : "v"(A_[r_])); asm volatile("v_add_f32 %0, %1, %1" : "=v"(t_) : "v"(B_[r_])); } } while (0)
#else
#define XTRA(A_, B_) do { } while (0)
#endif
#define STEP(C0, C1, P0, P1, HAVEPREV, FIRSTT, tnext, dodma) do { \
    if (dodma) DMA(tnext, bd); \
    const LAS unsigned char* kb_ = T_lds + bc * TILEB + SHM_V + SHM_1; const LAS unsigned char* vb_ = T_lds + bp * TILEB; \
    const v8i32a kf0_ = frag32(kb_, a0, a1), kf1_ = frag32(kb_ + 2048, a0, a1); v8i32a v0_, v1_, v2_, v3_, v4_; if (HAVEPREV) { v0_ = frag32(vb_, a0, a1); v1_ = frag32(vb_ + 2048, a0, a1); } \
    SBAR(); MFQK(C0, kf0_); if (HAVEPREV) EX8(P1, 0); SBAR(); \
    MFQK(C1, kf1_); if (HAVEPREV) { EX8(P1, 8); _Pragma("unroll") for (int i_ = 0; i_ < 4; ++i_) { pf[i_] = (int)pk4_fp8(P0[4 * i_], P0[4 * i_ + 1], P0[4 * i_ + 2], P0[4 * i_ + 3]); pf[4 + i_] = (int)pk4_fp8(P1[4 * i_], P1[4 * i_ + 1], P1[4 * i_ + 2], P1[4 * i_ + 3]); } } SBAR(); \
    float al_ = 1.f; \
    if (HAVEPREV) { asm volatile("s_nop 1" ::: ); MF8(o[0], v0_); SBAR(); MF8(o[1], v1_); v2_ = frag32(vb_ + 4096, a0, a1); v3_ = frag32(vb_ + 6144, a0, a1); v4_ = frag32(vb_ + 8192, a0, a1); SBAR(); } \
    else { asm volatile("s_nop 15\n\ts_nop 15\n\ts_nop 15\n\ts_nop 15" ::: "memory"); }     \
    float mxa_ = MX3(C0[0], C0[1], C1[0]), mxb_ = MX3(C0[2], C0[3], C1[1]); mxa_ = MX3(mxa_, C1[2], C1[3]); \
    _Pragma("unroll") for (int r_ = 4; r_ < 16; r_ += 4) { mxa_ = MX3(mxa_, C0[r_], C0[r_ + 1]); mxb_ = MX3(mxb_, C0[r_ + 2], C0[r_ + 3]); mxa_ = MX3(mxa_, C1[r_], C1[r_ + 1]); mxb_ = MX3(mxb_, C1[r_ + 2], C1[r_ + 3]); } \
    float pm_ = fmaxf(mxa_, mxb_); { auto rr_ = __builtin_amdgcn_permlane32_swap(__float_as_uint(pm_), __float_as_uint(pm_), false, false); pm_ = fmaxf(__uint_as_float(rr_[0]), __uint_as_float(rr_[1])); } \
    SBAR(); \
    if (HAVEPREV) { MF8(o[2], v2_); SBAR(); MF8(o[3], v3_); SBAR(); } \
    if (FIRSTT || __builtin_expect(__any(pm_ > PMAXLOG), 0)) { const float dl_ = FIRSTT ? (pm_ - PREF) : fmaxf(pm_ - PREF, 0.f); const float nm_ = negm[0] - dl_; al_ = __builtin_amdgcn_exp2f(-dl_); \
        _Pragma("unroll") for (int r_ = 0; r_ < 16; ++r_) { C0[r_] -= dl_; C1[r_] -= dl_; negm[r_] = nm_; } } \
    SBAR(); \
    if (HAVEPREV) { MF8(lacc, v4_); XMF(); SBAR(); } \
    EX8(C0, 0); EX8(C0, 8); XTRA(C0, C1); SBAR(); \
    if (HAVEPREV) { if (__any(al_ < 1.f)) { asm volatile("s_nop 15\n\ts_nop 15" ::: "memory"); if (hi == 0) al_l[r32] = al_; asm volatile("s_waitcnt lgkmcnt(0)" ::: "memory"); \
        _Pragma("unroll") for (int r_ = 0; r_ < 16; ++r_) { const float f_ = al_l[crow(r_, hi)]; o[0][r_] *= f_; o[1][r_] *= f_; o[2][r_] *= f_; o[3][r_] *= f_; lacc[r_] *= f_; } } } \
    } while (0)
    int bp = 7, bc = 0, bd = 4;
#define ROT() do { bp = bc; bc = (bc + 1) & (NBUF - 1); bd = (bd + 1) & (NBUF - 1); } while (0)
#define XBAR() do { } while (0)
    DMA(0, 0); DMA(1, 1); DMA(2, 2); DMA(3, 3); WAITBAR(3);
    STEP(pA0, pA1, pB0, pB1, false, true, 4, true); WAITBAR(2); ROT();
#pragma unroll 1
    for (int j = 1; j + 1 < NT; j += 2) {
        const bool more0 = (j + 4 < NT), more1 = (j + 5 < NT);
        STEP(pB0, pB1, pA0, pA1, true, false, j + 4, more0); ROT();
        STEP(pA0, pA1, pB0, pB1, true, false, j + 5, more1);
        if (more1) WAITBAR(2); else if (more0) WAITBAR(1); else WAITBAR(0);
        ROT();
    }
    STEP(pB0, pB1, pA0, pA1, true, false, 0, false); WAITBAR(0); ROT();
    { EX8(pB1, 0); EX8(pB1, 8);
#pragma unroll
      for (int i_ = 0; i_ < 4; ++i_) { pf[i_] = (int)pk4_fp8(pB0[4 * i_], pB0[4 * i_ + 1], pB0[4 * i_ + 2], pB0[4 * i_ + 3]); pf[4 + i_] = (int)pk4_fp8(pB1[4 * i_], pB1[4 * i_ + 1], pB1[4 * i_ + 2], pB1[4 * i_ + 3]); }
      SBAR(); PV(bp); }
#undef STEP
#undef MFQK
#undef EX8
    __syncthreads();
#undef ROT
#undef DMA
#undef WAITBAR
#undef RESC
#undef QKT
#undef PV
#undef MF8
}
}

__device__ __forceinline__ void ph4_attention(Frame& F) {
    const unsigned char* Q8 = (const unsigned char*)(KWS(F) + WS_Q); const unsigned char* K8 = (const unsigned char*)(KWS(F) + WS_K); const unsigned char* V8T = (const unsigned char*)(KWS(F) + WS_V);
    float* O0 = (float*)(KWS(F) + WS_O0); unsigned char* MIX = (unsigned char*)(KWS(F) + WS_MIX); const float* gn = KIN(F, 20);
    const int lane = F.lane, wid = F.wave;
    float lam;
    { const float a = wave_sum(KIN(F, 16)[lane] * KIN(F, 17)[lane]), b = wave_sum(KIN(F, 18)[lane] * KIN(F, 19)[lane]); lam = __builtin_bit_cast(float, __builtin_amdgcn_readfirstlane(__builtin_bit_cast(int, __expf(a) - __expf(b) + LAM_INIT0))); }
    __syncthreads();
    const unsigned kz_ = (unsigned)F.kz;
    for (int i = F.tid; i < att::NBUF * (att::SHM_1 / 16); i += NTHR) { const int bi = i / (att::SHM_1 / 16), q = i % (att::SHM_1 / 16);
        *(LAS u32x4*)(F.lds + att::OFF_T + bi * att::TILEB + att::SHM_V + q * 16) = (u32x4){0x38383838u + kz_, 0x38383838u + kz_, 0x38383838u + kz_, 0x38383838u + kz_}; }
#if defined(EXP_EXTRA_MFMA)
    for (int i = F.tid; i < 128; i += NTHR) *(LAS u32x4*)(F.lds + att::OFF_NEG + i * 16) = (u32x4){0xB8B8B8B8u + kz_, 0xB8B8B8B8u + kz_, 0xB8B8B8B8u + kz_, 0xB8B8B8B8u + kz_};
#endif
    __syncthreads();
    const int x = F.bx & 7, jb = F.bx >> 3;
    for (int vb = x; vb < 8; vb += 8) { const int b = vb >> 2, h = vb & 3;
    for (int qb = jb; qb < SEQ / 256; qb += (F.G >> 3)) {
        const long rowbase = (long)b * SEQ + qb * 256 + wid * 32;
        f32x16 o[4]; f32x16 lacc;
#pragma unroll 1
        for (int c = 0; c < 2; ++c) {
            const unsigned char* Qw = Q8 + (rowbase + (lane & 31)) * 512 + h * 128 + c * 64 + (lane >> 5) * 32;
            const unsigned char* Kh = K8 + (long)b * NKEY * 512 + h * 128 + c * 64;
            const unsigned char* Vt = V8T + (long)(b * 4 + h) * 128 * NKEY;
            att::attn_pass(Qw, Kh, Vt, F.lds, o, lacc, F.tid, F.wave);
            int lane_e = lane; asm volatile("" : "+v"(lane_e));
            const int r32 = lane_e & 31, hi = lane_e >> 5;
            asm volatile("s_nop 15\n\ts_nop 15" : "+v"(lacc));
            float rli[16];
#pragma unroll
            for (int r = 0; r < 16; ++r) rli[r] = __builtin_amdgcn_rcpf(lacc[r]);
            if (c == 0) {
#pragma unroll
                for (int r = 0; r < 16; ++r) { const long grow = rowbase + crow(r, hi);
#pragma unroll
                    for (int d0 = 0; d0 < 4; ++d0) O0[grow * 512 + h * 128 + d0 * 32 + r32] = o[d0][r] * rli[r]; }
            } else {
                const float g0 = gn[r32], g1 = gn[32 + r32], g2 = gn[64 + r32], g3 = gn[96 + r32];
                float ov[16][4];
#pragma unroll
                for (int r = 0; r < 16; ++r) { const float* op = O0 + (rowbase + crow(r, hi)) * 512 + h * 128 + r32; ov[r][0] = op[0]; ov[r][1] = op[32]; ov[r][2] = op[64]; ov[r][3] = op[96]; }
                asm volatile("" ::: "memory");
#pragma unroll
                for (int r = 0; r < 16; ++r) { const long grow = rowbase + crow(r, hi);
                    const float v0 = ov[r][0] - lam * (o[0][r] * rli[r]), v1 = ov[r][1] - lam * (o[1][r] * rli[r]), v2 = ov[r][2] - lam * (o[2][r] * rli[r]), v3 = ov[r][3] - lam * (o[3][r] * rli[r]);
                    float ss = (v0 * v0 + v1 * v1) + (v2 * v2 + v3 * v3);
                    ss = half_sum(ss);
                    const float scl = (1.0f - LAM_INIT0) / sqrtf(ss * (1.0f / 128.0f) + LN_EPS);
                    unsigned char* mp = MIX + grow * 1024 + 512 + h * 128 + r32;
                    mp[0] = f2fp8(v0 * scl * g0); mp[32] = f2fp8(v1 * scl * g1); mp[64] = f2fp8(v2 * scl * g2); mp[96] = f2fp8(v3 * scl * g3);
                    if ((r & 3) == 3) asm volatile("" ::: "memory"); }
            }
        }
    } }
}

__device__ __forceinline__ void ph_router(Frame& F, int layer, const float* hin) {
    const float* mod = (const float*)(KWS(F) + WS_MOD) + (size_t)(layer * 3) * 6144;
    const bf16_t* Y = (const bf16_t*)(KWS(F) + WS_Y); float* H1 = (float*)(KWS(F) + WS_H1); unsigned char* U2 = (unsigned char*)(KWS(F) + WS_U2);
    const float* lng = KIN(F, 6) + layer * DM; const float* lnb = KIN(F, 7) + layer * DM;
    const float* rw = KIN(F, 29) + (size_t)layer * DM * NE; const float* rb = KIN(F, 30) + layer * NE;
    unsigned* gcnt = (unsigned*)(KWS(F) + WS_CTL) + CW_CNT + layer * NE;
    unsigned* list = (unsigned*)(KWS(F) + WS_LIST); float* gates = (float*)(KWS(F) + WS_GATES);
    constexpr int RWS = 1028, RSEL = 131584, RVEC = RSEL + 10240;
    LAS float* rwT = (LAS float*)F.lds;
    LAS int* sel_e = (LAS int*)(F.lds + RSEL);
    LAS float* sel_g = (LAS float*)(F.lds + RSEL + 2048);
    LAS unsigned* lcnt = (LAS unsigned*)(F.lds + RSEL + 4096);
    LAS unsigned* lbase = lcnt + 32;
    LAS unsigned* lpos = lcnt + 64;
    LAS float* vG = (LAS float*)(F.lds + RVEC);
    const int lane = F.lane;
    for (int i = F.tid; i < DM * NE; i += NTHR) { const int d = i >> 5, e = i & 31; rwT[e * RWS + d] = rw[i]; }
    __syncthreads();
    for (int blk = F.bx; blk < T / 128; blk += F.G) {
        const int r0 = blk * 128, b = r0 >> 14;
        const float* g1 = mod + b * 6144 + 2048; const float* sh2 = mod + b * 6144 + 3072; const float* sc2 = mod + b * 6144 + 4096;
        if (F.tid < 32) lcnt[F.tid] = 0u;
        for (int i = F.tid; i < DM; i += NTHR) { vG[i] = g1[i]; vG[DM + i] = lng[i]; vG[2 * DM + i] = lnb[i]; vG[3 * DM + i] = sc2[i] + 1.0f; vG[4 * DM + i] = sh2[i]; }
        __syncthreads();
        f32x4 nx[2][4]; u32x2 ny[2][4];
#pragma unroll
        for (int t = 0; t < 2; ++t)
#pragma unroll
            for (int j = 0; j < 4; ++j) { const int d = 4 * lane + 256 * j; const size_t rr = (size_t)(r0 + F.wave * 16 + t); if (layer == 0) nx[t][j] = *(const f32x4*)(hin + rr * DM + d); else { const u32x2 rw_ = *(const u32x2*)((const bf16_t*)hin + rr * DM + d); nx[t][j][0] = __uint_as_float(rw_.x); nx[t][j][1] = __uint_as_float(rw_.y); } ny[t][j] = *(const u32x2*)(Y + rr * DM + d); }
        for (int qq = 0; qq < 8; ++qq) {
            int lane4 = 4 * lane; asm volatile("" : "+v"(lane4));
            const int tl0 = F.wave * 16 + 2 * qq;
            f32x4 pre[2][4]; float s1[2] = {0.f, 0.f}, s2[2] = {0.f, 0.f};
#pragma unroll
            for (int t = 0; t < 2; ++t)
#pragma unroll
                for (int j = 0; j < 4; ++j) { const int d = lane4 + 256 * j; f32x4 x = nx[t][j]; const u32x2 yw = ny[t][j];
                    if (layer != 0) { const unsigned r0_ = __float_as_uint(x[0]), r1_ = __float_as_uint(x[1]); x[0] = __uint_as_float(r0_ << 16); x[1] = __uint_as_float(r0_ & 0xffff0000u); x[2] = __uint_as_float(r1_ << 16); x[3] = __uint_as_float(r1_ & 0xffff0000u); }     const f32x4 g = *(const LAS f32x4*)(vG + d);
                    f32x4 y; y[0] = __uint_as_float(yw.x << 16); y[1] = __uint_as_float(yw.x & 0xffff0000u); y[2] = __uint_as_float(yw.y << 16); y[3] = __uint_as_float(yw.y & 0xffff0000u);
                    const f32x4 p_ = x * ALPHA + g * y; pre[t][j] = p_; s1[t] += (p_[0] + p_[1]) + (p_[2] + p_[3]); s2[t] += (p_[0] * p_[0] + p_[1] * p_[1]) + (p_[2] * p_[2] + p_[3] * p_[3]); }
            if (qq + 1 < 8) {
#pragma unroll
                for (int t = 0; t < 2; ++t)
#pragma unroll
                    for (int j = 0; j < 4; ++j) { const int d = lane4 + 256 * j; const size_t rr = (size_t)(r0 + tl0 + 2 + t); if (layer == 0) nx[t][j] = *(const f32x4*)(hin + rr * DM + d); else { const u32x2 rw_ = *(const u32x2*)((const bf16_t*)hin + rr * DM + d); nx[t][j][0] = __uint_as_float(rw_.x); nx[t][j][1] = __uint_as_float(rw_.y); } ny[t][j] = *(const u32x2*)(Y + rr * DM + d); } }
            s1[0] = wave_sum(s1[0]); s1[1] = wave_sum(s1[1]); s2[0] = wave_sum(s2[0]); s2[1] = wave_sum(s2[1]);
            f32x4 u2[2][4];
#pragma unroll
            for (int t = 0; t < 2; ++t) { const float mean = s1[t] * (1.0f / DM); const float var = fmaxf(s2[t] * (1.0f / DM) - mean * mean, 0.f); const float rstd = 1.0f / sqrtf(var + LN_EPS); const size_t row = (size_t)(r0 + tl0 + t);
#pragma unroll
                for (int j = 0; j < 4; ++j) { const int d = lane4 + 256 * j; const f32x4 h = (pre[t][j] - mean) * rstd * *(const LAS f32x4*)(vG + DM + d) + *(const LAS f32x4*)(vG + 2 * DM + d);
                    *(f32x4*)(H1 + row * DM + d) = h;
                    u2[t][j] = h * *(const LAS f32x4*)(vG + 3 * DM + d) + *(const LAS f32x4*)(vG + 4 * DM + d);
                    *(unsigned*)(U2 + row * DM + d) = pk4_fp8(u2[t][j][0], u2[t][j][1], u2[t][j][2], u2[t][j][3]); } }
            f32x2 up[4][4];
#pragma unroll
            for (int j = 0; j < 4; ++j)
#pragma unroll
                for (int i = 0; i < 4; ++i) { up[j][i][0] = u2[0][j][i]; up[j][i][1] = u2[1][j][i]; }
            f32x2 P[32];
            f32x4 wc[4], wn[4];
#pragma unroll
            for (int j = 0; j < 4; ++j) wc[j] = *(const LAS f32x4*)(rwT + 4 * lane + 256 * j);
#pragma unroll
            for (int e = 0; e < 32; ++e) {
                if (e + 1 < 32) {
#pragma unroll
                    for (int j = 0; j < 4; ++j) wn[j] = *(const LAS f32x4*)(rwT + (e + 1) * RWS + 4 * lane + 256 * j); }
                f32x2 a0 = {0.f, 0.f}, a1 = {0.f, 0.f};
#pragma unroll
                for (int j = 0; j < 4; ++j) { f32x2 w0 = {wc[j][0], wc[j][0]}, w1 = {wc[j][1], wc[j][1]}, w2 = {wc[j][2], wc[j][2]}, w3 = {wc[j][3], wc[j][3]};
                    a0 = __builtin_elementwise_fma(up[j][0], w0, a0); a1 = __builtin_elementwise_fma(up[j][1], w1, a1); a0 = __builtin_elementwise_fma(up[j][2], w2, a0); a1 = __builtin_elementwise_fma(up[j][3], w3, a1); }
                P[e] = a0 + a1;
#pragma unroll
                for (int j = 0; j < 4; ++j) wc[j] = wn[j];
                if ((e & 3) == 3) __builtin_amdgcn_sched_barrier(0); }
#define RSTEP(N, MASK, CTRL) do { _Pragma("unroll") for (int i = 0; i < (N); ++i) { int lm_ = lane & (MASK); asm volatile("" : "+v"(lm_)); const bool up_ = lm_ != 0;     \
                const f32x2 sv = up_ ? P[i] : P[i + (N)], kv = up_ ? P[i + (N)] : P[i]; f32x2 rv; rv[0] = dpp_f<CTRL>(sv[0]); rv[1] = dpp_f<CTRL>(sv[1]); P[i] = kv + rv; } } while (0)
#define RSWAP(N, SWAPFN) do { _Pragma("unroll") for (int i = 0; i < (N); ++i) { _Pragma("unroll") for (int c_ = 0; c_ < 2; ++c_) { \
                const auto r_ = SWAPFN(__float_as_uint(P[i][c_]), __float_as_uint(P[i + (N)][c_]), false, false); P[i][c_] = __uint_as_float(r_[0]) + __uint_as_float(r_[1]); } } } while (0)
            RSWAP(16, __builtin_amdgcn_permlane32_swap); RSWAP(8, __builtin_amdgcn_permlane16_swap);
#undef RSWAP
            RSTEP(4, 8, 0x140); RSTEP(2, 4, 0x141); RSTEP(1, 2, 0x4E);
#undef RSTEP
            const int me = lane >> 1; const float rbv = rb[me];
            float lgs[2]; lgs[0] = P[0][0] + dpp_f<0xB1>(P[0][0]) + rbv; lgs[1] = P[0][1] + dpp_f<0xB1>(P[0][1]) + rbv;
            LAS float* lgbuf = (LAS float*)(F.lds + RSEL + 8192) + F.wave * 64;
            if ((lane & 1) == 0) { lgbuf[me] = lgs[0]; lgbuf[32 + me] = lgs[1]; }
            asm volatile("s_waitcnt lgkmcnt(0)" ::: "memory");
#pragma unroll
            for (int t = 0; t < 2; ++t) { const float mine = lgs[t]; int rank = 0;
#pragma unroll
                for (int e4 = 0; e4 < 8; ++e4) { const f32x4 v = *(const LAS f32x4*)(lgbuf + 32 * t + 4 * e4);
#pragma unroll
                    for (int i = 0; i < 4; ++i) { const int e = 4 * e4 + i; rank += (v[i] > mine || (v[i] == mine && e < me)) ? 1 : 0; } }
                float ls[4]; int es[4];
#pragma unroll
                for (int k = 0; k < 4; ++k) { const unsigned long long bal = __ballot(rank == k); const int first = __ffsll((long long)bal) - 1; es[k] = first >> 1; ls[k] = lgbuf[32 * t + es[k]]; }
                const float e1 = __expf(ls[1] - ls[0]), e2 = __expf(ls[2] - ls[0]), e3 = __expf(ls[3] - ls[0]); const float inv = 1.0f / (1.0f + e1 + e2 + e3);
                const int tl = tl0 + t;
                if (lane == 0) { sel_e[tl * 4 + 0] = es[0]; sel_e[tl * 4 + 1] = es[1]; sel_e[tl * 4 + 2] = es[2]; sel_e[tl * 4 + 3] = es[3];
                    sel_g[tl * 4 + 0] = inv; sel_g[tl * 4 + 1] = e1 * inv; sel_g[tl * 4 + 2] = e2 * inv; sel_g[tl * 4 + 3] = e3 * inv; } }
        }
        __syncthreads();
        const int myE = sel_e[F.tid];
        lpos[F.tid] = __hip_atomic_fetch_add(&lcnt[myE], 1u, __ATOMIC_RELAXED, __HIP_MEMORY_SCOPE_WORKGROUP);
        __syncthreads();
        if (F.tid < 32) lbase[F.tid] = atomicAdd(&gcnt[F.tid], lcnt[F.tid]);
        __syncthreads();
        { const unsigned slot = (unsigned)(r0 * 4 + F.tid); list[(size_t)myE * CAP + lbase[myE] + lpos[F.tid]] = slot; gates[slot] = sel_g[F.tid]; }
        __syncthreads();
    }
}

struct MoeOrder {
    const LAS int* meta;
    const unsigned* list; int c, G, ncol, rpx;
    __device__ bool next(int i, pg8::Unit& u) const {
        const int x = c & 7, j = c >> 3; const int g = (i * 8 + x) * rpx + j / ncol; const int total = meta[32];
        if (g >= total) return false;
        const int ln_ = (int)__builtin_amdgcn_mbcnt_hi(~0u, __builtin_amdgcn_mbcnt_lo(~0u, 0u)) & 31;
        const int e = __popc((unsigned)__ballot(meta[ln_ + 1] <= g));
        const int rt = g - meta[e], cnt = meta[64 + e];
        u.pm = g; u.pn = e * ncol + (j % ncol); u.a0 = e; u.a1 = rt; u.a2 = min(256, cnt - rt * 256); return true;
    }
    __device__ __forceinline__ unsigned arow(const pg8::Unit& u, int R) const { return (R < u.a2) ? (list[(size_t)u.a0 * CAP + u.a1 * 256 + R] >> 2) : 0u; }
    __device__ __forceinline__ unsigned rowval(const pg8::Unit& u, int R, unsigned v) const { return (R < u.a2) ? (v >> 2) : 0u; }
    __device__ __forceinline__ const unsigned* rows_ptr(const pg8::Unit& u) const { return list + (size_t)u.a0 * CAP + u.a1 * 256; }
};
__device__ __forceinline__ void moe_meta(Frame& F, int layer) {
    LAS int* meta = (LAS int*)(F.lds + META_OFF);
    const unsigned* gcnt = (const unsigned*)(KWS(F) + WS_CTL) + CW_CNT + layer * NE;
    if (F.tid < NE) { const int c = (int)__hip_atomic_load(&gcnt[F.tid], __ATOMIC_RELAXED, __HIP_MEMORY_SCOPE_AGENT); meta[64 + F.tid] = c; meta[96 + F.tid] = (c + 255) >> 8; }
    __syncthreads();
    if (F.tid <= NE) { int acc = 0;
#pragma unroll
        for (int e = 0; e < NE; ++e) { const int t = meta[96 + e]; acc += (e < F.tid) ? t : 0; }
        meta[F.tid] = acc; }
    __syncthreads();
}
struct EpiGU {
    static constexpr bool PERM = true, HAS_PRE = true;
    unsigned char* ACT; const float* bgu;
    __device__ __forceinline__ void pre(LAS unsigned char* dst, const pg8::Unit& u, int wid, int lane) const {
        if (wid == 1) { const int e = u.a0, pnl = u.pn - e * 8; const float* src = bgu + e * 2048 + (lane >> 5) * 1024 + pnl * 128 + (lane & 31) * 4;
            __builtin_amdgcn_global_load_lds((const unsigned*)src, (LAS unsigned*)dst, 16, 0, 0); } }
    __device__ __forceinline__ void operator()(const f32x4 (&acc)[2][2][4][2], const pg8::Unit& u, int wr, int wc, int fr, int fq, const LAS unsigned char* pre_) const {
        const int e = u.a0, pnl = u.pn - e * 8; const int lcol = wc * 32 + 8 * fq, ccol = pnl * 128 + lcol; const int row0 = u.pm * 256 + wr * 64 + fr;
        f32x2 bg[2][2], bl[2][2];
#pragma unroll
        for (int n = 0; n < 2; ++n) { const f32x4 g4 = *(const LAS f32x4*)(pre_ + (lcol + 4 * n) * 4), l4 = *(const LAS f32x4*)(pre_ + 512 + (lcol + 4 * n) * 4);
            bg[n][0] = (f32x2){g4[0], g4[1]}; bg[n][1] = (f32x2){g4[2], g4[3]}; bl[n][0] = (f32x2){l4[0] + 1.0f, l4[1] + 1.0f}; bl[n][1] = (f32x2){l4[2] + 1.0f, l4[3] + 1.0f}; }
        const f32x2 s2 = {1.0f / WGU_SCALE, 1.0f / WGU_SCALE}, c2 = {-1.702f * 1.4426950408889634f, -1.702f * 1.4426950408889634f}, one2 = {1.0f, 1.0f};
#pragma unroll
        for (int ai = 0; ai < 2; ++ai)
#pragma unroll
            for (int m = 0; m < 4; ++m) { unsigned char* rowp = ACT + (size_t)(row0 + ai * 128 + m * 16) * 1024 + ccol; f32x2 o[2][2];
#pragma unroll
                for (int n = 0; n < 2; ++n)
#pragma unroll
                    for (int h = 0; h < 2; ++h) { const f32x4 A4 = acc[ai][0][m][n], L4 = acc[ai][1][m][n];
                        f32x2 gv = __builtin_elementwise_fma((f32x2){A4[2 * h], A4[2 * h + 1]}, s2, bg[n][h]), lv = __builtin_elementwise_fma((f32x2){L4[2 * h], L4[2 * h + 1]}, s2, bl[n][h]);
                        gv[0] = fminf(gv[0], 7.0f); gv[1] = fminf(gv[1], 7.0f);
                        lv[0] = __builtin_amdgcn_fmed3f(lv[0], -6.0f, 8.0f); lv[1] = __builtin_amdgcn_fmed3f(lv[1], -6.0f, 8.0f);
                        const f32x2 t = gv * c2; f32x2 d = {__builtin_amdgcn_exp2f(t[0]), __builtin_amdgcn_exp2f(t[1])}; d = d + one2;
                        const f32x2 r = {__builtin_amdgcn_rcpf(d[0]), __builtin_amdgcn_rcpf(d[1])};
                        o[n][h] = gv * r * lv; }
                u32x2 w; w.x = pk4_fp8(o[0][0][0], o[0][0][1], o[0][1][0], o[0][1][1]); w.y = pk4_fp8(o[1][0][0], o[1][0][1], o[1][1][0], o[1][1][1]);
                *(u32x2*)rowp = w; }
    }
};
struct EpiDown {
    static constexpr bool PERM = true, HAS_PRE = true;
    unsigned char* YB; const float* bd; const unsigned* list;
    __device__ __forceinline__ void pre(LAS unsigned char* dst, const pg8::Unit& u, int wid, int lane) const {
        const int e = u.a0, rt = u.a1, pnl = u.pn - e * 4;
        if (wid == 1) __builtin_amdgcn_global_load_lds((const unsigned*)(bd + e * 1024 + pnl * 256 + lane * 4), (LAS unsigned*)dst, 16, 0, 0);
        if (wid == 2) __builtin_amdgcn_global_load_lds((const unsigned*)(list + (size_t)e * CAP + rt * 256 + lane * 4), (LAS unsigned*)(dst + 1024), 16, 0, 0); }
    __device__ __forceinline__ void operator()(const f32x4 (&acc)[2][2][4][2], const pg8::Unit& u, int wr, int wc, int fr, int fq, const LAS unsigned char* pre_) const {
        const int e = u.a0, pnl = u.pn - e * 4; const int lcol = wc * 32 + 8 * fq, col = pnl * 256 + lcol;
        f32x4 bv[2][2];
#pragma unroll
        for (int bj = 0; bj < 2; ++bj)
#pragma unroll
            for (int n = 0; n < 2; ++n) bv[bj][n] = *(const LAS f32x4*)(pre_ + (lcol + bj * 128 + 4 * n) * 4);
#pragma unroll
        for (int ai = 0; ai < 2; ++ai)
#pragma unroll
            for (int m = 0; m < 4; ++m) { const int R = ai * 128 + wr * 64 + m * 16 + fr; if (R >= u.a2) continue;
                const unsigned slot = *(const LAS unsigned*)(pre_ + 1024 + R * 4); unsigned char* rowp = YB + (size_t)slot * 1024 + col;
#pragma unroll
                for (int bj = 0; bj < 2; ++bj) { const f32x4 v0 = acc[ai][bj][m][0] * (1.0f / WD_SCALE) + bv[bj][0], v1 = acc[ai][bj][m][1] * (1.0f / WD_SCALE) + bv[bj][1];
                    u32x2 w; w.x = pk4_fp8(v0[0], v0[1], v0[2], v0[3]); w.y = pk4_fp8(v1[0], v1[1], v1[2], v1[3]);
                    *(u32x2*)(rowp + bj * 128) = w; } }
    }
};

__device__ __forceinline__ void ph_combine(Frame& F, int layer, float* hout, bool next_mod) {
    const float* mod = (const float*)(KWS(F) + WS_MOD) + (size_t)(layer * 3) * 6144;
    const float* modn = (const float*)(KWS(F) + WS_MOD) + (size_t)3 * 6144;
    const float* H1 = (const float*)(KWS(F) + WS_H1); const unsigned char* YB = (const unsigned char*)(KWS(F) + WS_YB); const float* gates = (const float*)(KWS(F) + WS_GATES);
    const float* lng = KIN(F, 8) + layer * DM; const float* lnb = KIN(F, 9) + layer * DM; unsigned char* U = (unsigned char*)(KWS(F) + WS_U);
    const int gw = F.bx * NWAVES + F.wave, NGW = F.G * NWAVES, lane = F.lane;
    LAS float* vC = (LAS float*)F.lds;
    for (int i = F.tid; i < 2 * DM; i += NTHR) { const int b = i >> 10, d = i & (DM - 1); LAS float* v = vC + b * 5 * DM + d;
        v[0] = mod[b * 6144 + 5120 + d]; v[DM] = lng[d]; v[2 * DM] = lnb[d]; v[3 * DM] = modn[b * 6144 + 1024 + d] + 1.0f; v[4 * DM] = modn[b * 6144 + d]; }
    __syncthreads();
    f32x4 nh[4]; unsigned nyb[4][4]; f32x4 ngt;
#define CMB_LOAD(r_) do { _Pragma("unroll") for (int j = 0; j < 4; ++j) { const int d = 4 * lane + 256 * j; nh[j] = *(const f32x4*)(H1 + (size_t)(r_) * DM + d); \
        _Pragma("unroll") for (int k = 0; k < 4; ++k) nyb[j][k] = *(const unsigned*)(YB + ((size_t)(r_) * 4 + k) * DM + d); } ngt = *(const f32x4*)(gates + (size_t)(r_) * 4); } while (0)
    if (gw < T) CMB_LOAD(gw);
    for (int row = gw; row < T; row += NGW) {
        int vb = (row >> 14) * 5 * DM + 4 * lane; asm volatile("" : "+v"(vb));
        const LAS float* vr = vC + vb;
        f32x4 ch[4]; unsigned cyb[4][4]; const f32x4 gt = ngt;
#pragma unroll
        for (int j = 0; j < 4; ++j) { ch[j] = nh[j];
#pragma unroll
            for (int k = 0; k < 4; ++k) cyb[j][k] = nyb[j][k]; }
        if (row + NGW < T) CMB_LOAD(row + NGW);
        f32x4 pre[4]; float s = 0.f;
#pragma unroll
        for (int j = 0; j < 4; ++j) { f32x4 y = {0.f, 0.f, 0.f, 0.f};
#pragma unroll
            for (int k = 0; k < 4; ++k) { const unsigned yw = cyb[j][k]; const f32x2 lo = __builtin_amdgcn_cvt_pk_f32_fp8((int)yw, false), hi2 = __builtin_amdgcn_cvt_pk_f32_fp8((int)yw, true);
                const f32x4 v = {lo[0], lo[1], hi2[0], hi2[1]};
                y += v * gt[k]; }
            pre[j] = ch[j] * ALPHA + *(const LAS f32x4*)(vr + 256 * j) * y; s += (pre[j][0] + pre[j][1]) + (pre[j][2] + pre[j][3]); }
        const float mean = wave_sum(s) * (1.0f / DM); float q2 = 0.f;
#pragma unroll
        for (int j = 0; j < 4; ++j) { pre[j] = pre[j] - mean; q2 += (pre[j][0] * pre[j][0] + pre[j][1] * pre[j][1]) + (pre[j][2] * pre[j][2] + pre[j][3] * pre[j][3]); }
        const float rstd = 1.0f / sqrtf(wave_sum(q2) * (1.0f / DM) + LN_EPS);
#pragma unroll
        for (int j = 0; j < 4; ++j) { const int d = 4 * lane + 256 * j; const f32x4 h = pre[j] * rstd * *(const LAS f32x4*)(vr + DM + 256 * j) + *(const LAS f32x4*)(vr + 2 * DM + 256 * j);
            if (next_mod) { u32x2 hw_; hw_.x = pk2(h[0], h[1]); hw_.y = pk2(h[2], h[3]); *(u32x2*)((bf16_t*)hout + (size_t)row * DM + d) = hw_; }
            else *(f32x4*)(hout + (size_t)row * DM + d) = h;
            if (next_mod) { const f32x4 v = h * *(const LAS f32x4*)(vr + 3 * DM + 256 * j) + *(const LAS f32x4*)(vr + 4 * DM + 256 * j);
                *(unsigned*)(U + (size_t)row * DM + d) = pk4_fp8(v[0], v[1], v[2], v[3]); } }
    }
#undef CMB_LOAD
}

__device__ __forceinline__ void ph_gmlp(Frame& F) {
    const bf16_t* Z = (const bf16_t*)(KWS(F) + WS_ZODD); unsigned char* MIX = (unsigned char*)(KWS(F) + WS_MIX);
    const float* lg = KIN(F, 23); const float* lb = KIN(F, 24); const float* bs = KIN(F, 26); const bf16_t* wsb = (const bf16_t*)(KWS(F) + WS_TAB + TB_WS);
    const int lane = F.lane, r32 = lane & 31, hi = lane >> 5, wid = F.wave;
    for (int chunk = F.bx; chunk < T / 128; chunk += F.G) {
        const int r0 = chunk * 128;
        for (int qq = 0; qq < 16; ++qq) { const int q = wid * 16 + qq; const bf16x8 raw = *(const bf16x8*)(Z + (size_t)(r0 + q) * 1536 + 512 + 8 * lane);
            float v[8]; float s = 0.f;
#pragma unroll
            for (int j = 0; j < 8; ++j) { v[j] = bf2f((unsigned short)raw[j]); s += v[j]; }
            const float mean = wave_sum(s) * (1.0f / 512.0f); float q2 = 0.f;
#pragma unroll
            for (int j = 0; j < 8; ++j) { v[j] -= mean; q2 += v[j] * v[j]; }
            const float rstd = 1.0f / sqrtf(wave_sum(q2) * (1.0f / 512.0f) + LN_EPS);
            const f32x4 g0 = *(const f32x4*)(lg + 8 * lane), g1 = *(const f32x4*)(lg + 8 * lane + 4), b0 = *(const f32x4*)(lb + 8 * lane), b1 = *(const f32x4*)(lb + 8 * lane + 4);
            u32x4 w; w.x = pk2(v[0] * rstd * g0[0] + b0[0], v[1] * rstd * g0[1] + b0[1]); w.y = pk2(v[2] * rstd * g0[2] + b0[2], v[3] * rstd * g0[3] + b0[3]);
            w.z = pk2(v[4] * rstd * g1[0] + b1[0], v[5] * rstd * g1[1] + b1[1]); w.w = pk2(v[6] * rstd * g1[2] + b1[2], v[7] * rstd * g1[3] + b1[3]);
            const int ch = 8 * lane, g = ch >> 7, col = ch & 127, kt = (q >> 6) * 4 + g;
            *(LAS u32x4*)(F.lds + kt * 16384 + v_st(q & 63, col)) = w; }
        __syncthreads();
        const int pb = wid & 3, gh = wid >> 2;
#pragma unroll 1
        for (int gi = 0; gi < 2; ++gi) { const int g = 2 * gh + gi;
            unsigned wofs = (unsigned)(((g * 128 + 32 * pb + r32) * 128 + 8 * hi) * 2); asm volatile("" : "+v"(wofs));
            f32x16 acc[4];
#pragma unroll
            for (int d0 = 0; d0 < 4; ++d0) acc[d0] = f32x16{};
            bf16x8 af[8];
#pragma unroll
            for (int ks = 0; ks < 8; ++ks) af[ks] = *(const bf16x8*)((const char*)wsb + wofs + 32 * ks);
#pragma unroll
            for (int ks = 0; ks < 8; ++ks) {
                LAS unsigned char* trd = F.lds + ((ks >> 2) * 4 + g) * 16384 + v_rd_base(lane);
#pragma unroll
                for (int d0 = 0; d0 < 4; ++d0) acc[d0] = __builtin_amdgcn_mfma_f32_32x32x16_bf16(af[ks], vfrag(trd, d0, ks & 3), acc[d0], 0, 0, 0); }
            unsigned short uraw[16][4]; float bias[16];
#pragma unroll
            for (int r = 0; r < 16; ++r) { const int p = 32 * pb + crow(r, hi); bias[r] = bs[g * 128 + p];
#pragma unroll
                for (int d0 = 0; d0 < 4; ++d0) uraw[r][d0] = Z[(size_t)(r0 + p) * 1536 + g * 128 + d0 * 32 + r32]; }
            asm volatile("" ::: "memory");
#pragma unroll
            for (int r = 0; r < 16; ++r) { const int p = 32 * pb + crow(r, hi);
#pragma unroll
                for (int d0 = 0; d0 < 4; ++d0) { const int ch = g * 128 + d0 * 32 + r32;
                    MIX[(size_t)(r0 + p) * 1024 + ch] = f2fp8(bf2f(uraw[r][d0]) * (acc[d0][r] + bias[r])); } }
        }
        __syncthreads();
    }
}

__device__ __forceinline__ void ph_fourier1(Frame& F) {
    const bf16_t* Z = (const bf16_t*)(KWS(F) + WS_ZODD); bf16_t* WT = (bf16_t*)(KWS(F) + WS_WT);
    const float* lg = KIN(F, 27); const float* lb = KIN(F, 28);
    const bf16x8* CSf = (const bf16x8*)(KWS(F) + WS_TAB + TB_CS); const bf16x8* AFf = (const bf16x8*)(KWS(F) + WS_TAB + TB_AF); const f32x2* tw = (const f32x2*)(KWS(F) + WS_TAB + TB_TW);
    const int lane = F.lane, r32 = lane & 31, hi = lane >> 5, wid = F.wave;
    for (int unit = F.bx; unit < NB * 128; unit += F.G) {
        const int b = unit >> 7, t2 = unit & 127;
#pragma unroll 1
        for (int g = 0; g < 4; ++g) {
            {
                int lane_g = lane; asm volatile("" : "+v"(lane_g)); const int r32 = lane_g & 31, hi = lane_g >> 5;
                const int tb = wid & 3, part = wid >> 2; int t1 = 32 * tb + r32; asm volatile("" : "+v"(t1)); const size_t row = (size_t)b * SEQ + 128 * t1 + t2;
                bf16x8 raw[8]; float s = 0.f;
#pragma unroll
                for (int ks = 0; ks < 8; ++ks) { raw[ks] = *(const bf16x8*)(Z + row * 1536 + 1024 + g * 128 + 16 * ks + 8 * hi);
#pragma unroll
                    for (int j = 0; j < 8; ++j) s += bf2f((unsigned short)raw[ks][j]); }
                s = xhalf_sum(s); const float mean = s * (1.0f / 128.0f); float q2 = 0.f;
#pragma unroll
                for (int ks = 0; ks < 8; ++ks)
#pragma unroll
                    for (int j = 0; j < 8; ++j) { const float d = bf2f((unsigned short)raw[ks][j]) - mean; q2 += d * d; }
                q2 = xhalf_sum(q2); const float rstd = 1.0f / sqrtf(q2 * (1.0f / 128.0f) + LN_EPS);
                bf16x8 af[8];
#pragma unroll
                for (int ks = 0; ks < 8; ++ks) { const int c0 = g * 128 + 16 * ks + 8 * hi; const f32x4 g0 = *(const f32x4*)(lg + c0), g1 = *(const f32x4*)(lg + c0 + 4), b0 = *(const f32x4*)(lb + c0), b1 = *(const f32x4*)(lb + c0 + 4);
                    float x[8];
#pragma unroll
                    for (int j = 0; j < 8; ++j) x[j] = (bf2f((unsigned short)raw[ks][j]) - mean) * rstd;
                    u32x4 w; w.x = pk2(x[0] * g0[0] + b0[0], x[1] * g0[1] + b0[1]); w.y = pk2(x[2] * g0[2] + b0[2], x[3] * g0[3] + b0[3]);
                    w.z = pk2(x[4] * g1[0] + b1[0], x[5] * g1[1] + b1[1]); w.w = pk2(x[6] * g1[2] + b1[2], x[7] * g1[3] + b1[3]);
                    af[ks] = __builtin_bit_cast(bf16x8, w); }
                f32x16 acc[4];
#pragma unroll
                for (int d0 = 0; d0 < 4; ++d0) acc[d0] = f32x16{};
#pragma unroll
                for (int ks = 0; ks < 8; ++ks) { unsigned fo = (unsigned)(((4 * part) * 8 + ks) * 64 + lane) * 16u; asm volatile("" : "+v"(fo));
#pragma unroll
                    for (int d0 = 0; d0 < 4; ++d0) acc[d0] = __builtin_amdgcn_mfma_f32_32x32x16_bf16(af[ks], *(const bf16x8*)((const char*)CSf + fo + d0 * 8192), acc[d0], 0, 0, 0); }
                int ybase = (part * 2 + (tb >> 1)) * 16384 + (tb & 1) * 8192 + hi * 2048 + r32 * 2; asm volatile("" : "+v"(ybase));
#pragma unroll
                for (int r = 0; r < 16; ++r)
#pragma unroll
                    for (int d0 = 0; d0 < 4; ++d0) *(LAS bf16_t*)(F.lds + ybase + ((r >> 3) & 1) * 4096 + d0 * 512 + ((r & 3) + 4 * ((r >> 2) & 1)) * 64) = (bf16_t)f2bf(acc[d0][r]);
            }
            __syncthreads();
            {
                const int kb = wid & 3, ch2 = wid >> 2;
                f32x16 aR[2], aI[2];
#pragma unroll
                for (int dd = 0; dd < 2; ++dd) { aR[dd] = f32x16{}; aI[dd] = f32x16{}; }
#pragma unroll
                for (int kh = 0; kh < 4; ++kh) {
                    unsigned fo = (unsigned)((kb * 16 + kh * 4) * 64 + lane) * 16u; asm volatile("" : "+v"(fo));
                    bf16x8 fr8[4], fi8[4];
#pragma unroll
                    for (int k8 = 0; k8 < 4; ++k8) { fr8[k8] = *(const bf16x8*)((const char*)AFf + fo + k8 * 1024); fi8[k8] = *(const bf16x8*)((const char*)AFf + fo + k8 * 1024 + 65536); }
#pragma unroll
                    for (int k8 = 0; k8 < 4; ++k8) { const int ks = kh * 4 + k8;
                        LAS unsigned char* trd = F.lds + (ks >> 2) * 16384 + v_rd_base(lane);
#pragma unroll
                        for (int dd = 0; dd < 2; ++dd) { const bf16x8 bf = vfrag(trd, 2 * ch2 + dd, ks & 3);
                            aR[dd] = __builtin_amdgcn_mfma_f32_32x32x16_bf16(fr8[k8], bf, aR[dd], 0, 0, 0); aI[dd] = __builtin_amdgcn_mfma_f32_32x32x16_bf16(fi8[k8], bf, aI[dd], 0, 0, 0); } }
                }
                int k1b = 32 * kb + 4 * hi; asm volatile("" : "+v"(k1b));
                f32x2 csv[16];
#pragma unroll
                for (int r = 0; r < 16; ++r) csv[r] = tw[t2 * 128 + k1b + (r & 3) + 8 * (r >> 2)];
                asm volatile("" ::: "memory");
#pragma unroll
                for (int r = 0; r < 16; ++r) { const int k1 = k1b + (r & 3) + 8 * (r >> 2); const f32x2 cs = csv[r];
                    bf16_t* dst = WT + ((((size_t)b * 128 + k1) * 128 + t2) * 4 + g) * 256;
#pragma unroll
                    for (int dd = 0; dd < 2; ++dd) { const float wr_ = aR[dd][r], wi_ = aI[dd][r]; const int j = 32 * (2 * ch2 + dd) + r32;
                        dst[j] = (bf16_t)f2bf(wr_ * cs[0] + wi_ * cs[1]); dst[128 + j] = (bf16_t)f2bf(wi_ * cs[0] - wr_ * cs[1]); }
                    if ((r & 3) == 3) asm volatile("" ::: "memory"); }
            }
            __syncthreads();
        }
    }
}
__device__ __forceinline__ void ph_fourier2(Frame& F) {
    const bf16_t* WT = (const bf16_t*)(KWS(F) + WS_WT); unsigned char* MIX = (unsigned char*)(KWS(F) + WS_MIX);
    const bf16x8* A3f = (const bf16x8*)(KWS(F) + WS_TAB + TB_A3);
    const int lane = F.lane, r32 = lane & 31, hi = lane >> 5, wid = F.wave;
    for (int unit = F.bx; unit < NB * 128; unit += F.G) {
        const int b = unit >> 7, k1 = unit & 127;
#pragma unroll 1
        for (int g = 0; g < 4; ++g) {
            for (int idx = F.tid; idx < 4096; idx += NTHR) { const int t2 = idx >> 5, c = idx & 31, part = c >> 4, j0 = (c & 15) * 8;
                const u32x4 v = *(const u32x4*)(WT + ((((size_t)b * 128 + k1) * 128 + t2) * 4 + g) * 256 + part * 128 + j0);
                *(LAS u32x4*)(F.lds + (part * 2 + (t2 >> 6)) * 16384 + v_st(t2 & 63, j0)) = v; }
            __syncthreads();
            const int mb = wid & 3, ch2 = wid >> 2;
            f32x16 acc[2] = {f32x16{}, f32x16{}};
#pragma unroll
            for (int ks = 0; ks < 16; ++ks) { unsigned fo = (unsigned)((mb * 16 + ks) * 64 + lane) * 16u; asm volatile("" : "+v"(fo)); const bf16x8 af = *(const bf16x8*)((const char*)A3f + fo);
                LAS unsigned char* trd = F.lds + (ks >> 2) * 16384 + v_rd_base(lane);
#pragma unroll
                for (int dd = 0; dd < 2; ++dd) acc[dd] = __builtin_amdgcn_mfma_f32_32x32x16_bf16(af, vfrag(trd, 2 * ch2 + dd, ks & 3), acc[dd], 0, 0, 0); }
#pragma unroll
            for (int r = 0; r < 16; ++r) { const int k2 = 32 * mb + crow(r, hi); const size_t row = (size_t)b * SEQ + k1 + 128 * k2;
#pragma unroll
                for (int dd = 0; dd < 2; ++dd) MIX[row * 1024 + 512 + g * 128 + 32 * (2 * ch2 + dd) + r32] = f2fp8(acc[dd][r]); }
            __syncthreads();
        }
    }
}

#ifndef MK_ONE_LAUNCH
#define MK_ONE_LAUNCH 1
#endif
constexpr int NPH = 18;
#ifndef PHMASK
#define PHMASK 0x3FFFF
#endif
#define HAS(k) (((PHMASK) >> (k)) & 1)
__global__ void __launch_bounds__(NTHR, 2) fwd_kernel(Args args) {
    extern __shared__ __attribute__((aligned(16))) unsigned char lds_raw[];
    Frame F;
    F.lds = (LAS unsigned char*)lds_raw; F.tid = threadIdx.x; F.lane = F.tid & 63; F.wave = __builtin_amdgcn_readfirstlane(F.tid >> 6); F.G = gridDim.x; F.bx = blockIdx.x;
    F.kz = 0;
    volatile LAS unsigned* MISC = (volatile LAS unsigned*)(F.lds + MISC_OFF);
    if (F.tid < 64) MISC[F.tid] = 0u;
    __syncthreads();
    if (MK_ONE_LAUNCH) (void)xcd_barrier_post((unsigned*)(args.ws + WS_CTL) + CW_BAR, MISC + 8);
    const int lo = args.ph_lo, hi = args.ph_hi;
#define IN(k) (lo <= (k) && (k) < hi)
#ifndef REPMASK
#define REPMASK 0
#endif
#define REP(k) (((REPMASK) >> (k)) & 1)
#define BARNOW() do { ENTER(); XcdBarrier bar_; bar_.bar = (unsigned*)(KWS(F) + WS_CTL) + CW_BAR; bar_.x = xb_xcc_id(); bar_.st = (volatile LAS unsigned*)(F.lds + MISC_OFF) + 8; xcd_barrier(bar_); } while (0)
#ifndef DIAG_PH
#define DIAG_PH -1
#endif
    int nstamp = 0;
#define STAMP() do { if (DIAG_PH >= 0) { if (F.tid == 0) ((volatile LAS unsigned*)(F.lds + MISC_OFF))[16 + nstamp] = (unsigned)__builtin_amdgcn_s_memrealtime(); ++nstamp; } } while (0)
    STAMP();
#define ENTER() do { asm volatile("" : "+s"(F.kz), "+s"(F.wave), "+s"(F.G), "+s"(F.bx), "+v"(F.tid), "+v"(F.lane)); F.kz = __builtin_amdgcn_readfirstlane(F.kz); F.wave = __builtin_amdgcn_readfirstlane(F.wave); \
    F.G = __builtin_amdgcn_readfirstlane(F.G); F.bx = __builtin_amdgcn_readfirstlane(F.bx); } while (0)
#define SEAM(k) do { if (IN(k) && IN((k) + 1)) { if (MK_ONE_LAUNCH) { ENTER(); XcdBarrier bar_; bar_.bar = (unsigned*)(KWS(F) + WS_CTL) + CW_BAR; bar_.x = xb_xcc_id(); bar_.st = (volatile LAS unsigned*)(F.lds + MISC_OFF) + 8; xcd_barrier(bar_); STAMP(); } } } while (0)

    if (HAS(0) && IN(0)) { ENTER(); for (int rep_ = 0; rep_ <= REP(0); ++rep_) { if (rep_) BARNOW(); ph0_mod_tables(F); } } SEAM(0);
    if (HAS(1) && IN(1)) { ENTER(); for (int rep_ = 0; rep_ <= REP(1); ++rep_) { if (rep_) BARNOW(); ph1_convert(F); } } SEAM(1);
    if (HAS(2) && IN(2)) { ENTER(); for (int rep_ = 0; rep_ <= REP(2); ++rep_) { if (rep_) BARNOW(); ph2_modulate(F); } } SEAM(2);

    for (int layer = 0; layer < 2; ++layer) {
        const int pb = layer == 0 ? 5 : 13;
        if (layer == 0) {
            if (HAS(3) && IN(3)) { ENTER(); for (int rep_ = 0; rep_ <= REP(3); ++rep_) { if (rep_) BARNOW();
                pg8::Gemm g{(const bf16_t*)(KWS(F) + WS_U), (const bf16_t*)(KWS(F) + WS_WEVIN), T, 2560, DM / 2};
                EvInOrder S; S.so.init(T, 2560, F.G, F.bx);
                EpiEvIn E{(unsigned char*)(KWS(F) + WS_Q), (unsigned char*)(KWS(F) + WS_K), (unsigned char*)(KWS(F) + WS_V), (bf16_t*)(KWS(F) + WS_AB), (const float*)(KWS(F) + WS_TAB + TB_COS), (const float*)(KWS(F) + WS_TAB + TB_SIN)};
                pg8::gemm_phase<EpiEvIn, EvInOrder, true, false, true>(F.lds, g, S, E, F.tid);
            } } SEAM(3);
            if (HAS(4) && IN(4)) { ENTER(); for (int rep_ = 0; rep_ <= REP(4); ++rep_) { if (rep_) BARNOW(); ph4_conv(F); ph4_attention(F); } } SEAM(4);
        } else {
            if (HAS(10) && IN(10)) { ENTER(); for (int rep_ = 0; rep_ <= REP(10); ++rep_) { if (rep_) BARNOW();
                pg8::Gemm g{(const bf16_t*)(KWS(F) + WS_U), (const bf16_t*)(KWS(F) + WS_WODIN), T, 1536, DM / 2};
                pg8::StaticOrder S; S.init(T, 1536, F.G, F.bx);
                pg8::EpiBf16 E{(bf16_t*)(KWS(F) + WS_ZODD), 1536, 4, 1.0f / WI_SCALE};
                pg8::gemm_phase<pg8::EpiBf16, pg8::StaticOrder, true, false, true>(F.lds, g, S, E, F.tid);
            } } SEAM(10);
            if (HAS(11) && IN(11)) { ENTER(); for (int rep_ = 0; rep_ <= REP(11); ++rep_) { if (rep_) BARNOW(); ph_gmlp(F); ph_fourier1(F); } } SEAM(11);
            if (HAS(12) && IN(12)) { ENTER(); for (int rep_ = 0; rep_ <= REP(12); ++rep_) { if (rep_) BARNOW(); ph_fourier2(F); } } SEAM(12);
        }
        if (HAS(5) && IN(pb)) { ENTER(); for (int rep_ = 0; rep_ <= REP(5); ++rep_) { if (rep_) BARNOW();
            pg8::Gemm g{(const bf16_t*)(KWS(F) + WS_MIX), (const bf16_t*)(KWS(F) + (layer == 0 ? WS_WEVOUT : WS_WODOUT)), T, DM, DM / 2};
            pg8::StaticOrder S; S.init(T, DM, F.G, F.bx);
            pg8::EpiBf16 E{(bf16_t*)(KWS(F) + WS_Y), DM, 0, 1.0f / WO_SCALE};
            pg8::gemm_phase<pg8::EpiBf16, pg8::StaticOrder, true, false, true>(F.lds, g, S, E, F.tid);
        } } SEAM(pb);
        if (HAS(6) && IN(pb + 1)) { ENTER(); for (int rep_ = 0; rep_ <= REP(6); ++rep_) { if (rep_) BARNOW(); ph_router(F, layer, layer == 0 ? KIN(F, 0) : (const float*)(KWS(F) + WS_H2)); } } SEAM(pb + 1);
        if (HAS(7) && IN(pb + 2)) { ENTER(); for (int rep_ = 0; rep_ <= REP(7); ++rep_) { if (rep_) BARNOW();
            moe_meta(F, layer);
            pg8::Gemm g{(const bf16_t*)(KWS(F) + WS_U2), (const bf16_t*)(KWS(F) + WS_WGU + (size_t)layer * NE * 2048 * DM), 0, 0, DM / 2};
            MoeOrder S{(const LAS int*)(F.lds + META_OFF), (const unsigned*)(KWS(F) + WS_LIST), F.bx, F.G, 8, 4};
            EpiGU E{(unsigned char*)(KWS(F) + WS_ACT), KIN(F, 32) + (size_t)layer * NE * 2048};
            pg8::gemm_phase<EpiGU, MoeOrder, true, true, true>(F.lds, g, S, E, F.tid);
        } } SEAM(pb + 2);
        if (HAS(8) && IN(pb + 3)) { ENTER(); for (int rep_ = 0; rep_ <= REP(8); ++rep_) { if (rep_) BARNOW();
            moe_meta(F, layer);
            pg8::Gemm g{(const bf16_t*)(KWS(F) + WS_ACT), (const bf16_t*)(KWS(F) + WS_WD + (size_t)layer * NE * 1024 * DM), 0, 0, DM / 2};
            MoeOrder S{(const LAS int*)(F.lds + META_OFF), (const unsigned*)(KWS(F) + WS_LIST), F.bx, F.G, 4, 8};
            EpiDown E{(unsigned char*)(KWS(F) + WS_YB), KIN(F, 34) + (size_t)layer * NE * 1024, (const unsigned*)(KWS(F) + WS_LIST)};
            pg8::gemm_phase<EpiDown, MoeOrder, true, false, true>(F.lds, g, S, E, F.tid);
        } } SEAM(pb + 3);
        if (HAS(9) && IN(pb + 4)) { ENTER(); for (int rep_ = 0; rep_ <= REP(9); ++rep_) { if (rep_) BARNOW(); ph_combine(F, layer, layer == 0 ? (float*)(KWS(F) + WS_H2) : KOUT(F), layer == 0); } }
        if (layer == 0) SEAM(pb + 4);
    }
    if (DIAG_PH >= 0) {
        ENTER(); XcdBarrier bar_; bar_.bar = (unsigned*)(KWS(F) + WS_CTL) + CW_BAR; bar_.x = xb_xcc_id(); bar_.st = (volatile LAS unsigned*)(F.lds + MISC_OFF) + 8; xcd_barrier(bar_); STAMP();
        __syncthreads();
        volatile LAS unsigned* st = (volatile LAS unsigned*)(F.lds + MISC_OFF) + 16;
        const unsigned d = st[DIAG_PH + 1] - st[DIAG_PH];
        const float c = sqrtf((float)d * 0.01f);
        float* o = KOUT(F);
        for (size_t i = (size_t)F.bx * NTHR + F.tid; i < (size_t)T * DM; i += (size_t)F.G * NTHR) o[i] = c;
    }
#undef IN
#undef SEAM
}

extern "C" void kernel_launch(void* const* d_in, const int* in_sizes, int n_in, void* d_out, int out_size, void* d_ws, size_t ws_size, hipStream_t stream) {
    static int grid = 0;
    if (grid == 0) {
        if (n_in != 35 || out_size != T * DM || ws_size < WS_END) { fprintf(stderr, "kernel_launch: unexpected shapes: n_in %d out %d ws %zu (need %zu)\n", n_in, out_size, ws_size, (size_t)WS_END); grid = -1; return; }
        int dev = 0, cus = 0;
        if (hipGetDevice(&dev) != hipSuccess || hipDeviceGetAttribute(&cus, hipDeviceAttributeMultiprocessorCount, dev) != hipSuccess) { grid = -1; return; }
        if (hipFuncSetAttribute((const void*)fwd_kernel, hipFuncAttributeMaxDynamicSharedMemorySize, LDS_BYTES) != hipSuccess) { fprintf(stderr, "kernel_launch: hipFuncSetAttribute failed\n"); grid = -1; return; }
        int per_cu = 0; (void)hipOccupancyMaxActiveBlocksPerMultiprocessor(&per_cu, (const void*)fwd_kernel, NTHR, LDS_BYTES); (void)hipGetLastError();
        if (per_cu < 1) fprintf(stderr, "kernel_launch: occupancy query reports %d blocks per CU\n", per_cu);
        grid = cus > 256 ? 256 : cus;
        if (grid != 256) fprintf(stderr, "kernel_launch: %d CUs; this kernel is laid out for 256\n", cus);
    }
    if (grid < 0) return;
    (void)hipMemsetAsync((char*)d_ws + WS_CTL, 0, CTL_ZERO_BYTES, stream);
    Args a{};
    for (int i = 0; i < 35; ++i) a.in[i] = (const float*)d_in[i];
    a.out = (float*)d_out; a.ws = (unsigned char*)d_ws;
#if MK_ONE_LAUNCH
    a.ph_lo = 0; a.ph_hi = NPH;
    hipLaunchKernelGGL(fwd_kernel, dim3(grid), dim3(NTHR), LDS_BYTES, stream, a);
#else
    for (int p = 0; p < NPH; ++p) { a.ph_lo = p; a.ph_hi = p + 1; hipLaunchKernelGGL(fwd_kernel, dim3(grid), dim3(NTHR), LDS_BYTES, stream, a); }
#endif
    const hipError_t le = hipPeekAtLastError();
    if (le != hipSuccess) fprintf(stderr, "kernel_launch: launch failed: %s\n", hipGetErrorName(le));
}
```

```cpp
#include <hip/hip_runtime.h>
#include <cstdio>
#include <cstdint>

#define LAS __attribute__((address_space(3)))
#define GAS __attribute__((address_space(1)))
typedef unsigned short bf16_t;
typedef short bf16x8 __attribute__((ext_vector_type(8)));
typedef short s16x4 __attribute__((ext_vector_type(4)));
typedef float f32x4 __attribute__((ext_vector_type(4)));
typedef float f32x2 __attribute__((ext_vector_type(2)));
typedef float f32x16 __attribute__((ext_vector_type(16)));
typedef unsigned u32x4 __attribute__((ext_vector_type(4)));
typedef unsigned u32x2 __attribute__((ext_vector_type(2)));

namespace pg8 {
constexpr int BM = 256, BK = 64, HALF = 128, HTB = HALF * BK * 2, STAGE_BYTES = 8 * HTB, NXCD = 8, WGM = 4;
__host__ __device__ __forceinline__ int lds_byte(int r, int c) { const int st = (r >> 4) * 2 + (c >> 5), rr = r & 15, cc = c & 31, ob = rr * 64 + cc * 2; return st * 1024 + (ob ^ (((ob >> 9) & 1) << 5)); }
__host__ __device__ __forceinline__ void stage_rc(int b, int& R, int& C) { const int st = b / 1024, sb = b % 1024, swz = sb ^ (((sb >> 9) & 1) << 5); R = (st >> 1) * 16 + swz / 64; C = (st & 1) * 32 + (swz % 64) / 2; }
__host__ __device__ __forceinline__ int perm256(int h, int R) { const int wc = R >> 5, rho = R & 31, n = rho >> 4, ii = rho & 15; return wc * 64 + (ii >> 2) * 16 + h * 8 + n * 4 + (ii & 3); }
__host__ __device__ __forceinline__ int perm32(int rho) { const int n = rho >> 4, i = rho & 15; return 8 * (i >> 2) + 4 * n + (i & 3); }

struct Unit { int pm, pn, a0, a1, a2; };
struct Gemm { const bf16_t* A; const bf16_t* Bt; int M, N, K; };

constexpr int PRE_ROWS = 131072 + 1024, PRE_EPI = PRE_ROWS + 2048;
struct StaticOrder {
    int nM, nN, nwg, G, c;
    __device__ void init(int M, int N, int G_, int c_) { nM = M / BM; nN = N / BM; nwg = nM * nN; G = G_; c = c_; }
    __device__ bool map(long L, Unit& u) const {
        if (L >= nwg) return false;
        int wgid = (int)L; { const int q = nwg / NXCD, r = nwg % NXCD, xcd = wgid % NXCD, off = wgid / NXCD; wgid = (xcd < r ? xcd * (q + 1) : r * (q + 1) + (xcd - r) * q) + off; }
        const int nig = WGM * nN, gid = wgid / nig, fm = gid * WGM, gsz = (nM - fm) < WGM ? (nM - fm) : WGM;
        u.pm = fm + ((wgid % nig) % gsz); u.pn = (wgid % nig) / gsz; u.a0 = 0; u.a1 = 0; u.a2 = 256; return true;
    }
    __device__ bool next(int i, Unit& u) const { return map((long)i * G + c, u); }
    __device__ __forceinline__ unsigned arow(const Unit&, int) const { return 0u; }
    __device__ __forceinline__ unsigned rowval(const Unit&, int, unsigned) const { return 0u; }
    __device__ __forceinline__ const unsigned* rows_ptr(const Unit&) const { return nullptr; }
};

__device__ __forceinline__ unsigned cvt_pk_bf16(float lo, float hi) { unsigned r; asm volatile("v_cvt_pk_bf16_f32 %0, %1, %2" : "=v"(r) : "v"(lo), "v"(hi)); return r; }

__device__ __forceinline__ float gelu_tanh(float x) {
    const float t = x * (1.0f + 0.044715f * x * x) * (2.0f * 0.7978845608028654f * 1.4426950408889634f);
    return x * __builtin_amdgcn_rcpf(1.0f + __builtin_amdgcn_exp2f(-t));
}

struct EpiBf16 {
    static constexpr bool PERM = true, HAS_PRE = false, PERM256 = false;
    bf16_t* O; int ldc; int gelu_pn; float scale;
    __device__ __forceinline__ void operator()(const f32x4 (&acc)[2][2][4][2], const Unit& u, int wr, int wc, int fr, int fq) const {
        const int row0 = u.pm * BM + wr * 64 + fr; const int col0 = u.pn * BM + wc * 32 + 8 * fq;
        const bool act = u.pn < gelu_pn;
#pragma unroll
        for (int ai = 0; ai < 2; ++ai)
#pragma unroll
            for (int m = 0; m < 4; ++m) { bf16_t* rowp = O + (size_t)(row0 + ai * HALF + m * 16) * ldc + col0;
#pragma unroll
                for (int bj = 0; bj < 2; ++bj) { f32x4 v0 = acc[ai][bj][m][0] * scale, v1 = acc[ai][bj][m][1] * scale;
                    if (act) {
#pragma unroll
                        for (int j = 0; j < 4; ++j) { v0[j] = gelu_tanh(v0[j]); v1[j] = gelu_tanh(v1[j]); } }
                    u32x4 w; w.x = cvt_pk_bf16(v0[0], v0[1]); w.y = cvt_pk_bf16(v0[2], v0[3]); w.z = cvt_pk_bf16(v1[0], v1[1]); w.w = cvt_pk_bf16(v1[2], v1[3]);
                    *(u32x4*)(rowp + bj * HALF) = w; } }
    }
};

typedef int v8i32 __attribute__((ext_vector_type(8)));
typedef short s16x16 __attribute__((ext_vector_type(16)));
template <class Epi, class Sched, bool ALIGN_EPI, bool GATHER, bool FP8 = false>
__device__ __forceinline__ void gemm_phase(LAS unsigned char* lds, const Gemm g, const Sched& S, const Epi& E, const int tid) {
    const int wid = __builtin_amdgcn_readfirstlane(tid >> 6), lane = tid & 63, wr = wid >> 2, wc = wid & 3, fr = lane & 15, fq = lane >> 4;
    const int K = g.K, nt = K / BK;
    unsigned voffA[2], voffB[2], voffB1[2]; int Rr[2], Cc[2];
#pragma unroll
    for (int i = 0; i < 2; ++i) { int R, C; stage_rc(tid * 16 + i * 8192, R, C); const int Rb = Epi::PERM256 ? perm256(0, R) : (Epi::PERM ? ((R & ~31) + perm32(R & 31)) : R); Rr[i] = R; Cc[i] = C;
        voffA[i] = (unsigned)(R * K + C) * 2u; voffB[i] = (unsigned)(Rb * K + C) * 2u; voffB1[i] = Epi::PERM256 ? (unsigned)(perm256(1, R) * K + C) * 2u : 0u; }
    const unsigned kstep = (unsigned)(BK * 2);
    const unsigned hstep = (unsigned)HALF * (unsigned)K * 2u;
    const unsigned tstep = 2u * hstep;
    const char* const baseA = (const char*)g.A; const char* const baseB = (const char*)g.Bt;
    const unsigned ldsw = (unsigned)wid * 1024u;
    const int aoff = lds_byte(wr * 64 + fr, fq * 8), boff = lds_byte(wc * 32 + fr, fq * 8);
    const int aoff0 = lds_byte(wr * 64 + fr, fq * 16), aoff1 = lds_byte(wr * 64 + fr, fq * 16 + 8), boff0 = lds_byte(wc * 32 + fr, fq * 16), boff1 = lds_byte(wc * 32 + fr, fq * 16 + 8);
#define PG8_SA(b, h) (((b) * 2 + (h)) * HTB)
#define PG8_SB(b, h) ((4 + (b) * 2 + (h)) * HTB)
#define PG8_STAGE(bufoff, gbase, voff) do { _Pragma("unroll") for (int _i = 0; _i < 2; ++_i) \
        __builtin_amdgcn_global_load_lds((const unsigned*)(baseB + (size_t)(unsigned)((gbase) + (voff)[_i])), (LAS unsigned*)(lds + (bufoff) + ldsw + _i * 8192), 16, 0, 0); } while (0)
#define PG8_STAGE_B(bufoff, gbase, h) do { if constexpr (Epi::PERM256) { if (h) PG8_STAGE(bufoff, gbase, voffB1); else PG8_STAGE(bufoff, gbase, voffB); } else PG8_STAGE(bufoff, (gbase) + (h) * hstep, voffB); } while (0)
#define PG8_STAGEA(bufoff, gbase, voff) do { _Pragma("unroll") for (int _i = 0; _i < 2; ++_i) \
        __builtin_amdgcn_global_load_lds((const unsigned*)(baseA + (size_t)(unsigned)((gbase) + (voff)[_i])), (LAS unsigned*)(lds + (bufoff) + ldsw + _i * 8192), 16, 0, 0); } while (0)
#define PG8_STAGE_A(bufoff, base, h, nx) do { if constexpr (GATHER) { _Pragma("unroll") for (int _i = 0; _i < 2; ++_i) { const unsigned _v = (nx) ? vAn[h][_i] : vAc[h][_i]; \
            __builtin_amdgcn_global_load_lds((const unsigned*)(baseA + (size_t)(unsigned)((base) + _v)), (LAS unsigned*)(lds + (bufoff) + ldsw + _i * 8192), 16, 0, 0); } } \
        else { PG8_STAGEA(bufoff, (base) + (h) * hstep, voffA); } } while (0)
#define PG8_LD8(dst, i, off0, off1) do { const bf16x8 _lo = *(const LAS bf16x8*)(lds + (off0)), _hi = *(const LAS bf16x8*)(lds + (off0) + 16); dst[i] = __builtin_bit_cast(v8i32, __builtin_shufflevector(_lo, _hi, 0, 1, 2, 3, 4, 5, 6, 7, 8, 9, 10, 11, 12, 13, 14, 15)); } while (0)
#define PG8_LDA8(dst, b, h) do { _Pragma("unroll") for (int m = 0; m < 4; ++m) PG8_LD8(dst, m, PG8_SA(b, h) + aoff0 + m * 2048, PG8_SA(b, h) + aoff1 + m * 2048); } while (0)
#define PG8_LDB8(dst, b, h) do { _Pragma("unroll") for (int n = 0; n < 2; ++n) PG8_LD8(dst, n, PG8_SB(b, h) + boff0 + n * 2048, PG8_SB(b, h) + boff1 + n * 2048); } while (0)
#define PG8_MMA8(ai, bj, At, Bt) do { __builtin_amdgcn_s_setprio(1); _Pragma("unroll") for (int m = 0; m < 4; ++m) _Pragma("unroll") for (int n = 0; n < 2; ++n) \
        asm volatile("v_mfma_scale_f32_16x16x128_f8f6f4 %0, %1, %2, %0, %3, %3 op_sel_hi:[0,0,0]" : "+v"(acc[ai][bj][m][n]) : "v"(Bt[n]), "v"(At[m]), "v"(one_scale)); __builtin_amdgcn_s_setprio(0); } while (0)
#define PG8_LDA(dst, b, h) do { _Pragma("unroll") for (int m = 0; m < 4; ++m) _Pragma("unroll") for (int k = 0; k < 2; ++k) dst[m][k] = *(const LAS bf16x8*)(lds + PG8_SA(b, h) + aoff + m * 2048 + k * 1024); } while (0)
#define PG8_LDB(dst, b, h) do { _Pragma("unroll") for (int n = 0; n < 2; ++n) _Pragma("unroll") for (int k = 0; k < 2; ++k) dst[n][k] = *(const LAS bf16x8*)(lds + PG8_SB(b, h) + boff + n * 2048 + k * 1024); } while (0)
#define PG8_MMA(ai, bj, At, Bt) do { __builtin_amdgcn_s_setprio(1); _Pragma("unroll") for (int m = 0; m < 4; ++m) _Pragma("unroll") for (int n = 0; n < 2; ++n) _Pragma("unroll") for (int k = 0; k < 2; ++k) \
        acc[ai][bj][m][n] = __builtin_amdgcn_mfma_f32_16x16x32_bf16(Bt[n][k], At[m][k], acc[ai][bj][m][n], 0, 0, 0); __builtin_amdgcn_s_setprio(0); } while (0)
#define PG8_WAIT_V(n) asm volatile("s_waitcnt vmcnt(" #n ")" ::: "memory")
#define PG8_WAIT_L(n) asm volatile("s_waitcnt lgkmcnt(" #n ")" ::: "memory")
#define PG8_BAR __builtin_amdgcn_s_barrier()
#define PG8_SCHED __builtin_amdgcn_sched_barrier(0)
    Unit cur, nxt; int ui = 0;
    if (!S.next(0, cur)) return;
    f32x4 acc[2][2][4][2];
#pragma unroll
    for (int a = 0; a < 2; ++a)
#pragma unroll
        for (int b = 0; b < 2; ++b)
#pragma unroll
            for (int m = 0; m < 4; ++m)
#pragma unroll
                for (int n = 0; n < 2; ++n) acc[a][b][m][n] = (f32x4){0.f, 0.f, 0.f, 0.f};
    bf16x8 At[4][2], B0[2][2], B1[2][2]; v8i32 At8[4], B08[2], B18[2]; const int one_scale = 0x7F7F7F7F;
#define XLDA(b, h) do { if constexpr (FP8) PG8_LDA8(At8, b, h); else PG8_LDA(At, b, h); } while (0)
#define XLDB0(b, h) do { if constexpr (FP8) PG8_LDB8(B08, b, h); else PG8_LDB(B0, b, h); } while (0)
#define XLDB1(b, h) do { if constexpr (FP8) PG8_LDB8(B18, b, h); else PG8_LDB(B1, b, h); } while (0)
#define XMMA0(ai, bj) do { if constexpr (FP8) PG8_MMA8(ai, bj, At8, B08); else PG8_MMA(ai, bj, At, B0); } while (0)
#define XMMA1(ai, bj) do { if constexpr (FP8) PG8_MMA8(ai, bj, At8, B18); else PG8_MMA(ai, bj, At, B1); } while (0)
    unsigned vAc[2][2], vAn[2][2];
#define PG8_ROWS(dst, un) do { if constexpr (GATHER) { _Pragma("unroll") for (int _h = 0; _h < 2; ++_h) _Pragma("unroll") for (int _i = 0; _i < 2; ++_i) \
        dst[_h][_i] = (S.arow(un, _h * HALF + Rr[0] + 64 * _i) * (unsigned)K + (unsigned)Cc[0]) * 2u; } } while (0)
    PG8_ROWS(vAc, cur);
#pragma unroll
    for (int _h = 0; _h < 2; ++_h)
#pragma unroll
        for (int _i = 0; _i < 2; ++_i) vAn[_h][_i] = vAc[_h][_i];
    unsigned cA = GATHER ? 0u : (unsigned)cur.pm * tstep; unsigned cB = (unsigned)cur.pn * tstep;
    PG8_STAGE_B(PG8_SB(0, 0), cB, 0); PG8_STAGE_B(PG8_SB(0, 1), cB, 1); PG8_STAGE_A(PG8_SA(0, 0), cA, 0, false); PG8_STAGE_A(PG8_SA(0, 1), cA, 1, false);
    if (wr == 1) PG8_BAR;
    PG8_WAIT_V(2); PG8_BAR;
    PG8_STAGE_B(PG8_SB(1, 0), cB + kstep, 0); PG8_STAGE_A(PG8_SA(1, 0), cA + kstep, 0, false); PG8_STAGE_B(PG8_SB(1, 1), cB + kstep, 1);
    PG8_WAIT_V(6); PG8_BAR;
    for (;;) {
        const bool has_next = S.next(ui + 1, nxt);
        if constexpr (GATHER) {
            if (has_next) {
                if (ui == 0) { PG8_ROWS(vAn, nxt); asm volatile("" : "+v"(vAn[0][0]), "+v"(vAn[0][1]), "+v"(vAn[1][0]), "+v"(vAn[1][1])); }
                else {
#pragma unroll
                    for (int _h = 0; _h < 2; ++_h)
#pragma unroll
                        for (int _i = 0; _i < 2; ++_i) { const int R_ = _h * HALF + Rr[0] + 64 * _i; const unsigned v_ = *(const LAS unsigned*)(lds + PRE_ROWS + ((ui + 1) & 1) * 1024 + R_ * 4);
                            vAn[_h][_i] = (S.rowval(nxt, R_, v_) * (unsigned)K + (unsigned)Cc[0]) * 2u; } }
            }
            Unit n2_; if (S.next(ui + 2, n2_)) { if (wid == 0) __builtin_amdgcn_global_load_lds((const unsigned*)(S.rows_ptr(n2_) + lane * 4), (LAS unsigned*)(lds + PRE_ROWS + (ui & 1) * 1024), 16, 0, 0); }
        } else { if (has_next) { PG8_ROWS(vAn, nxt); } }
        if constexpr (Epi::HAS_PRE) E.pre(lds + PRE_EPI + (ui & 1) * 2048, cur, wid, lane);
        const unsigned nA = GATHER ? 0u : (has_next ? (unsigned)nxt.pm * tstep : cA);
        const unsigned nB = has_next ? (unsigned)nxt.pn * tstep : cB;
#pragma unroll 1
        for (int t = 0; t < nt; t += 2) {
            const bool last = (t == nt - 2);
            const bool nx = last && has_next;
            const unsigned a1 = cA + (unsigned)(t + 1) * kstep;
            const unsigned a2 = last ? nA : cA + (unsigned)(t + 2) * kstep; const unsigned b2 = last ? nB : cB + (unsigned)(t + 2) * kstep;
            const unsigned a3 = a2 + kstep; const unsigned b3 = b2 + kstep;
            XLDB0(0, 0); XLDB1(0, 1); PG8_SCHED; XLDA(0, 0); PG8_STAGE_A(PG8_SA(1, 1), a1, 1, false);
            PG8_WAIT_V(8); PG8_WAIT_L(0); PG8_BAR; XMMA0(0, 0); XMMA1(0, 1); PG8_BAR; PG8_SCHED;
            XLDA(0, 1); PG8_STAGE_B(PG8_SB(0, 0), b2, 0); PG8_STAGE_B(PG8_SB(0, 1), b2, 1); PG8_STAGE_A(PG8_SA(0, 0), a2, 0, nx);
            PG8_WAIT_V(8); PG8_WAIT_L(0); PG8_BAR; XMMA0(1, 0); XMMA1(1, 1); PG8_BAR; PG8_SCHED;
            XLDB0(1, 0); XLDB1(1, 1); PG8_SCHED; XLDA(1, 0); PG8_STAGE_A(PG8_SA(0, 1), a2, 1, nx);
            PG8_WAIT_V(8); PG8_WAIT_L(0); PG8_BAR; XMMA0(0, 0); XMMA1(0, 1); PG8_BAR; PG8_SCHED;
            XLDA(1, 1); PG8_STAGE_B(PG8_SB(1, 0), b3, 0); PG8_STAGE_B(PG8_SB(1, 1), b3, 1); PG8_STAGE_A(PG8_SA(1, 0), a3, 0, nx);
            PG8_WAIT_V(8); PG8_WAIT_L(0); PG8_BAR; XMMA0(1, 0); XMMA1(1, 1); PG8_BAR; PG8_SCHED;
        }
        if constexpr (FP8) asm volatile("s_nop 15\n\ts_nop 15" ::: "memory");
        if constexpr (ALIGN_EPI) { if (wr == 0) PG8_BAR; }
        if constexpr (Epi::HAS_PRE) E(acc, cur, wr, wc, fr, fq, lds + PRE_EPI + (ui & 1) * 2048); else E(acc, cur, wr, wc, fr, fq);
        if (!has_next) break;
#pragma unroll
        for (int a = 0; a < 2; ++a)
#pragma unroll
            for (int b = 0; b < 2; ++b)
#pragma unroll
                for (int m = 0; m < 4; ++m)
#pragma unroll
                    for (int n = 0; n < 2; ++n) acc[a][b][m][n] = (f32x4){0.f, 0.f, 0.f, 0.f};
        cur = nxt; cA = nA; cB = nB; ++ui;
#pragma unroll
        for (int _h = 0; _h < 2; ++_h)
#pragma unroll
            for (int _i = 0; _i < 2; ++_i) vAc[_h][_i] = vAn[_h][_i];
        if constexpr (ALIGN_EPI) { if (wr == 1) PG8_BAR; }
    }
    PG8_WAIT_V(0);
    if constexpr (!ALIGN_EPI) { if (wr == 0) PG8_BAR; }
    PG8_BAR;
#undef PG8_SA
#undef PG8_SB
#undef PG8_STAGE
#undef PG8_STAGEA
#undef PG8_STAGE_B
#undef PG8_STAGE_A
#undef PG8_ROWS
#undef PG8_LDA
#undef PG8_LD8
#undef PG8_LDA8
#undef PG8_LDB8
#undef PG8_MMA8
#undef XLDA
#undef XLDB0
#undef XLDB1
#undef XMMA0
#undef XMMA1
#undef PG8_LDB
#undef PG8_MMA
#undef PG8_WAIT_V
#undef PG8_WAIT_L
#undef PG8_BAR
#undef PG8_SCHED
}
}

constexpr int DM = 1024, SEQ = 16384, NB = 2, T = NB * SEQ, CTX = 256, NCTX = NB * CTX, NKEY = SEQ + CTX;
constexpr int NE = 32, TOPK = 4, CAP = 32768;
constexpr float ALPHA = 1.4142135623730951f, LN_EPS = 1e-5f;
constexpr float QSCALE = 0.125f * 1.4426950408889634f;
constexpr float LAM_INIT0 = 0.2f;
constexpr int NWAVES = 8, NTHR = 512;

constexpr size_t MiB = 1u << 20;
constexpr size_t WS_CTL = 0, CTL_ZERO_BYTES = 1 * MiB;
constexpr size_t WS_MODP = 1 * MiB;
constexpr size_t WS_MOD = 3 * MiB;
constexpr size_t WS_TAB = 4 * MiB;
constexpr size_t WS_WEVIN = 6 * MiB, WS_WEVOUT = 11 * MiB, WS_WODIN = 13 * MiB, WS_WODOUT = 16 * MiB;
constexpr size_t WS_LIST = 18 * MiB, WS_GATES = 22 * MiB;
constexpr size_t WS_WGU = 32 * MiB;
constexpr size_t WS_WD = 288 * MiB;
constexpr size_t WS_U = 416 * MiB;
constexpr size_t WS_Q = 482 * MiB, WS_K = 514 * MiB, WS_V = 547 * MiB, WS_AB = 580 * MiB;
constexpr size_t WS_O0 = 612 * MiB;
constexpr size_t WS_MIX = 676 * MiB, WS_Y = 740 * MiB, WS_H1 = 804 * MiB, WS_U2 = 932 * MiB;
constexpr size_t WS_ACT = 996 * MiB;
constexpr size_t WS_YB = 1268 * MiB;
constexpr size_t WS_H2 = 1524 * MiB;
constexpr size_t WS_ZODD = 1652 * MiB;
constexpr size_t WS_WT = 1748 * MiB;
constexpr size_t WS_END = 1812 * MiB;
constexpr size_t TB_COS = 0, TB_SIN = 20480, TB_CS = 40960  , TB_AF = 106496  , TB_A3 = 237568  , TB_TW = 303104  , TB_WS = 434176  , TB_END = 565248;
constexpr int CW_ERR = 0, CW_BAR = 4096, CW_CNT = 16384;
#define XB_TMO      128
#define XB_XCNT(j)  (256  + 64 * (j))
#define XB_XSUB(j)  (1280 + 64 * (j))
#define XB_XGEN(j)  (2304 + 64 * (j))
#define XB_TOP      3328
#define XB_TOPGEN   3392
#define XCD_BAR_WORDS 3456
#define XB_SPIN_CAP (1u << 18)
constexpr int LDS_BYTES = 160 * 1024, MISC_OFF = LDS_BYTES - 256, META_OFF = 131072;

__device__ __forceinline__ unsigned xb_ld(unsigned* p)              { return __hip_atomic_load(p, __ATOMIC_RELAXED, __HIP_MEMORY_SCOPE_AGENT); }
__device__ __forceinline__ unsigned xb_add(unsigned* p, unsigned v) { return __hip_atomic_fetch_add(p, v, __ATOMIC_RELAXED, __HIP_MEMORY_SCOPE_AGENT); }
__device__ __forceinline__ unsigned xb_xcc_id() { return (unsigned)__builtin_amdgcn_s_getreg((3 << 11) | 20) & 0xFu; }
#define XB_SPIN(cond, bar) do { unsigned _sp = 0; while (cond) { __builtin_amdgcn_s_sleep(1); \
    if ((++_sp & 255u) == 0u) { if (xb_ld(&(bar)[XB_TMO])) break; if (_sp > XB_SPIN_CAP) { atomicAdd(&(bar)[XB_TMO], 1u); break; } } } } while (0)
struct XcdBarrier { unsigned* bar; unsigned x; volatile LAS unsigned* st; };
__device__ __forceinline__ XcdBarrier xcd_barrier_post(unsigned* bar, volatile LAS unsigned* st) {
    XcdBarrier b; b.bar = bar; b.x = xb_xcc_id(); b.st = st;
    if (threadIdx.x == 0) (void)xb_add(&bar[XB_XCNT(b.x)], 1u);
    return b;
}
__device__ __forceinline__ void xcd_barrier_complete(unsigned* bar, unsigned x, unsigned& nloc, unsigned& nx) {
    const unsigned G = gridDim.x * gridDim.y * gridDim.z;
    unsigned sum, cnt, mine, sp = 0u;
    for (;;) {
        sum = 0u; cnt = 0u; mine = 0u;
#pragma unroll
        for (unsigned j = 0; j < 16; ++j) { const unsigned c = xb_ld(&bar[XB_XCNT(j)]); sum += c; cnt += (c > 0u) ? 1u : 0u; mine = (j == x) ? c : mine; }
        if (sum == G) break;
        __builtin_amdgcn_s_sleep(1);
        if ((++sp & 255u) == 0u) { if (xb_ld(&bar[XB_TMO])) break; if (sp > XB_SPIN_CAP) { atomicAdd(&bar[XB_TMO], 1u); break; } }
    }
    nloc = mine > 0u ? mine : 1u; nx = cnt > 0u ? cnt : 1u;
}
__device__ __forceinline__ void xcd_barrier(const XcdBarrier& b) {
    asm volatile("s_waitcnt vmcnt(0)" ::: "memory");
    __syncthreads();
    if (threadIdx.x == 0) {
        unsigned* bar = b.bar;
        __builtin_amdgcn_s_waitcnt(0);
        unsigned nloc = b.st[0], nx = b.st[1];
        if (nloc == 0u) { xcd_barrier_complete(bar, b.x, nloc, nx); b.st[0] = nloc; b.st[1] = nx; }
        const unsigned old = xb_add(&bar[XB_XSUB(b.x)], 1u);
        const unsigned gen = old / nloc;
        if (old + 1u == (gen + 1u) * nloc) {
            __builtin_amdgcn_fence(__ATOMIC_RELEASE, "agent");
            asm volatile("s_waitcnt vmcnt(0)" ::: "memory");
            const unsigned og = xb_add(&bar[XB_TOP], 1u);
            const unsigned tg = og / nx;
            if (og + 1u == (tg + 1u) * nx) xb_add(&bar[XB_TOPGEN], 1u);
            else XB_SPIN(xb_ld(&bar[XB_TOPGEN]) == tg, bar);
            __builtin_amdgcn_fence(__ATOMIC_ACQUIRE, "agent");
            xb_add(&bar[XB_XGEN(b.x)], 1u);
            asm volatile("s_waitcnt vmcnt(0)" ::: "memory");
        } else {
            XB_SPIN(xb_ld(&bar[XB_XGEN(b.x)]) == gen, bar);
            __builtin_amdgcn_fence(__ATOMIC_ACQUIRE, "agent");
            asm volatile("s_waitcnt vmcnt(0)" ::: "memory");
        }
    }
    __syncthreads();
}

__device__ __forceinline__ float bf2f(unsigned short b) { return __uint_as_float(((unsigned)b) << 16); }
__device__ __forceinline__ unsigned f2bf(float f) { unsigned u = __float_as_uint(f); return (u + 0x7fffu + ((u >> 16) & 1u)) >> 16; }
__device__ __forceinline__ unsigned pk2(float lo, float hi) { return f2bf(lo) | (f2bf(hi) << 16); }
__device__ __forceinline__ unsigned char f2fp8(float a) { return (unsigned char)((unsigned)__builtin_amdgcn_cvt_pk_fp8_f32(a, 0.f, 0, false) & 0xffu); }
__device__ __forceinline__ unsigned pk4_fp8(float a, float b, float c, float d) { unsigned w = (unsigned)__builtin_amdgcn_cvt_pk_fp8_f32(a, b, __builtin_bit_cast(int, a), false); return (unsigned)__builtin_amdgcn_cvt_pk_fp8_f32(c, d, (int)w, true); }
constexpr float WI_SCALE = 32.0f;
constexpr float WO_SCALE = 64.0f;
constexpr float WGU_SCALE = 32.0f, WD_SCALE = 64.0f;
template <int CTRL> __device__ __forceinline__ float dpp_f(float v) { return __builtin_bit_cast(float, __builtin_amdgcn_update_dpp(0, __builtin_bit_cast(int, v), CTRL, 0xf, 0xf, true)); }
__device__ __forceinline__ float wave_sum(float v) {
    v += dpp_f<0xB1>(v); v += dpp_f<0x4E>(v); v += dpp_f<0x141>(v); v += dpp_f<0x140>(v);
    { const auto r = __builtin_amdgcn_permlane16_swap(__float_as_uint(v), __float_as_uint(v), false, false); v = __uint_as_float(r[0]) + __uint_as_float(r[1]); }
    { const auto r = __builtin_amdgcn_permlane32_swap(__float_as_uint(v), __float_as_uint(v), false, false); v = __uint_as_float(r[0]) + __uint_as_float(r[1]); }
    return v;
}
__device__ __forceinline__ float half_sum(float v) {
    v += dpp_f<0xB1>(v); v += dpp_f<0x4E>(v); v += dpp_f<0x141>(v); v += dpp_f<0x140>(v);
    { const auto r = __builtin_amdgcn_permlane16_swap(__float_as_uint(v), __float_as_uint(v), false, false); v = __uint_as_float(r[0]) + __uint_as_float(r[1]); }
    return v;
}
__device__ __forceinline__ float xhalf_sum(float v) {
    const auto r = __builtin_amdgcn_permlane32_swap(__float_as_uint(v), __float_as_uint(v), false, false); return __uint_as_float(r[0]) + __uint_as_float(r[1]);
}
__device__ __forceinline__ float wave_max(float v) {
    v = fmaxf(v, dpp_f<0xB1>(v)); v = fmaxf(v, dpp_f<0x4E>(v)); v = fmaxf(v, dpp_f<0x141>(v)); v = fmaxf(v, dpp_f<0x140>(v));
    { const auto r = __builtin_amdgcn_permlane16_swap(__float_as_uint(v), __float_as_uint(v), false, false); v = fmaxf(__uint_as_float(r[0]), __uint_as_float(r[1])); }
    { const auto r = __builtin_amdgcn_permlane32_swap(__float_as_uint(v), __float_as_uint(v), false, false); v = fmaxf(__uint_as_float(r[0]), __uint_as_float(r[1])); }
    return v;
}
__device__ __forceinline__ int crow(int r, int hi) { return (r & 3) + 8 * (r >> 2) + 4 * hi; }
__device__ __forceinline__ float silu_f(float x) { return x / (1.0f + __expf(-x)); }
__device__ __forceinline__ float sigmoid_f(float x) { return 1.0f / (1.0f + __expf(-x)); }
__device__ __forceinline__ int v_st(int k, int c) { const int kk = (k & ~0xC) | ((k & 4) << 1) | ((k & 8) >> 1); return ((kk >> 3) * 4 + (c >> 5)) * 512 + ((kk & 7) * 32 + (c & 31)) * 2; }
__device__ __forceinline__ int v_rd_base(int lane) { return ((lane & 3) << 3) | (((lane >> 2) & 3) << 6) | (((lane >> 4) & 1) << 5) | (((lane >> 5) & 1) << 8); }
__host__ __device__ constexpr int v_rd_off(int d0, int ks, int half) { return d0 * 512 + ks * 4096 + half * 2048; }
typedef short v4i16_t __attribute__((ext_vector_type(4)));
__device__ __forceinline__ bf16x8 vfrag(LAS unsigned char* tile_rd  , int d0, int ks) {
    const v4i16_t lo = __builtin_amdgcn_ds_read_tr16_b64_v4i16((LAS v4i16_t*)(tile_rd + v_rd_off(d0, ks, 0)));
    const v4i16_t hi = __builtin_amdgcn_ds_read_tr16_b64_v4i16((LAS v4i16_t*)(tile_rd + v_rd_off(d0, ks, 1)));
    return (bf16x8){lo[0], lo[1], lo[2], lo[3], hi[0], hi[1], hi[2], hi[3]};
}

struct Args { const float* in[35]; float* out; unsigned char* ws; int ph_lo, ph_hi; };

struct Frame { LAS unsigned char* lds; int tid, lane, wave, G, bx, kz; };
#define CAS __attribute__((address_space(4)))
__device__ __forceinline__ const float* kin_(int kz, int i) { return *(const float* const CAS*)((const CAS char*)__builtin_amdgcn_kernarg_segment_ptr() + kz + 8 * i); }
#define KIN(F, i) kin_((F).kz, (i))
#define KOUT(F) ((float*)kin_((F).kz, 35))
#define KWS(F) ((unsigned char*)kin_((F).kz, 36))
static_assert(sizeof(Args) == 37 * 8 + 8, "Args layout");

__device__ __forceinline__ void ph0_mod_tables(Frame& F) {
    const float* c = KIN(F, 1); const float* cctx = KIN(F, 3); const float* wmod = KIN(F, 4);
    LAS float* sv = (LAS float*)F.lds;
    for (int vb = F.bx; vb < 256; vb += F.G) {
    const int l = vb >> 7, rem = vb & 127, nch = rem & 7, kch = rem >> 3, k0 = kch * 64;
    if (F.tid < 192) { const int v = F.tid >> 6, k = F.tid & 63; const float x = (v < 2) ? c[v * DM + k0 + k] : cctx[k0 + k]; sv[v * 64 + k] = silu_f(x); }
    __syncthreads();
    if (F.tid < 384) {
        const int col = nch * 768 + F.tid * 2;
        const float* W = wmod + ((size_t)l * DM + k0) * 6144 + col;
        f32x2 a0 = {0.f, 0.f}, a1 = {0.f, 0.f}, a2 = {0.f, 0.f};
#pragma unroll 8
        for (int k = 0; k < 64; ++k) { const f32x2 w = *(const f32x2*)(W + (size_t)k * 6144); a0 += w * sv[k]; a1 += w * sv[64 + k]; a2 += w * sv[128 + k]; }
        float* mp = (float*)(KWS(F) + WS_MODP) + (size_t)kch * 5 * 6144 + col;
        if (l == 0) { *(f32x2*)(mp + 0 * 6144) = a0; *(f32x2*)(mp + 1 * 6144) = a1; *(f32x2*)(mp + 2 * 6144) = a2; }
        else { *(f32x2*)(mp + 3 * 6144) = a0; *(f32x2*)(mp + 4 * 6144) = a1; }
    }
    __syncthreads();
    }
    const int bx = F.bx;
    unsigned char* tb = KWS(F) + WS_TAB;
    const int gid = bx * NTHR + F.tid, NG = F.G * NTHR;
    const float s128 = 0.08838834764831845f;
    for (int i = gid; i < 5120; i += NG) {
        const int pos = i >> 4, f = i & 15; const int p = pos < 256 ? pos : pos - 256;
        const float inv = powf(10000.0f, -((float)f / 16.0f)); const float ang = (float)p * inv;
        ((float*)(tb + TB_COS))[i] = (float)cos((double)ang); ((float*)(tb + TB_SIN))[i] = (float)sin((double)ang);
    }
    for (int i = gid; i < 32768; i += NG) {
        const int j8 = i & 7, ln = (i >> 3) & 63, ks = (i >> 9) & 7, nb = i >> 12;
        const int n = 32 * nb + (ln & 31), cc = 16 * ks + 8 * (ln >> 5) + j8, part = n >> 7, jj = n & 127, m = (jj * cc) & 127;
        const double a = (double)m / 64.0; const float v = (part == 0 ? (float)cospi(a) : -(float)sinpi(a)) * s128;
        ((bf16_t*)(tb + TB_CS))[i] = (bf16_t)f2bf(v);
    }
    for (int i = gid; i < 65536; i += NG) {
        const int j8 = i & 7, ln = (i >> 3) & 63, ks = (i >> 9) & 15, mb = i >> 13;
        const int m = 32 * mb + (ln & 31), k = 16 * ks + 8 * (ln >> 5) + j8, mpart = m >> 7, k1 = m & 127, part = k >> 7, t1 = k & 127, ph = (k1 * t1) & 127;
        const double a = (double)ph / 64.0; const float cs = (float)cospi(a), sn = (float)sinpi(a);
        const float v = (mpart == 0 ? (part == 0 ? cs : sn) : (part == 0 ? -sn : cs)) * s128;
        ((bf16_t*)(tb + TB_AF))[i] = (bf16_t)f2bf(v);
    }
    for (int i = gid; i < 32768; i += NG) {
        const int j8 = i & 7, ln = (i >> 3) & 63, ks = (i >> 9) & 15, mb = i >> 13;
        const int k2 = 32 * mb + (ln & 31), k = 16 * ks + 8 * (ln >> 5) + j8, part = k >> 7, t2 = k & 127, ps = (k2 * t2) & 127;
        const double a = (double)ps / 64.0; const float v = (part == 0 ? (float)cospi(a) : (float)sinpi(a)) * s128;
        ((bf16_t*)(tb + TB_A3))[i] = (bf16_t)f2bf(v);
    }
    for (int i = gid; i < 16384; i += NG) {
        const int t2 = i >> 7, k1 = i & 127; const double a = (double)((k1 * t2) & 16383) / 8192.0;
        ((f32x2*)(tb + TB_TW))[i] = (f32x2){(float)cospi(a), (float)sinpi(a)};
    }
    const float* gws = KIN(F, 25);
    for (int i = gid; i < 65536; i += NG) ((bf16_t*)(tb + TB_WS))[i] = (bf16_t)f2bf(gws[i]);
}

__device__ __forceinline__ void transpose_item(const float* W, int K, int ldw, int k0, int n_src0, bf16_t* WT, int row_dst0, LAS float* scr, int lane) {
#pragma unroll 8
    for (int i = 0; i < 32; ++i) { const int kk = 2 * i + (lane >> 5); scr[kk * 33 + (lane & 31)] = W[(size_t)(k0 + kk) * ldw + n_src0 + (lane & 31)]; }
    asm volatile("s_waitcnt lgkmcnt(0)" ::: "memory");
    const int c = lane & 7;
#pragma unroll
    for (int j = 0; j < 4; ++j) { const int n = (lane >> 3) + 8 * j; const LAS float* s = scr + (8 * c) * 33 + n;
        u32x4 o; o.x = pk2(s[0 * 33], s[1 * 33]); o.y = pk2(s[2 * 33], s[3 * 33]); o.z = pk2(s[4 * 33], s[5 * 33]); o.w = pk2(s[6 * 33], s[7 * 33]);
        *(u32x4*)(WT + (size_t)(row_dst0 + n) * K + k0 + 8 * c) = o; }
    asm volatile("s_waitcnt lgkmcnt(0)" ::: "memory");
}
__device__ __forceinline__ void transpose_item_fp8(const float* W, int K, int ldw, int k0, int n_src0, unsigned char* WT8, int row_dst0, float scale, LAS float* scr, int lane, const bool permn = false, const bool permk = false) {
#pragma unroll 8
    for (int i = 0; i < 64; ++i) { const int kk = 2 * i + (lane >> 5); scr[kk * 33 + (lane & 31)] = W[(size_t)(k0 + kk) * ldw + n_src0 + (lane & 31)]; }
    asm volatile("s_waitcnt lgkmcnt(0)" ::: "memory");
    const int q = lane & 3;
#pragma unroll
    for (int j = 0; j < 2; ++j) { const int n = (lane >> 2) + 16 * j; const LAS float* s = scr + (32 * q) * 33 + (permn ? pg8::perm32(n) : n); unsigned w[8];
#pragma unroll
        for (int t = 0; t < 8; ++t) { if (permk) { const LAS float* sp = s - (32 * q) * 33 + (8 * q + t) * 33; w[t] = pk4_fp8(sp[0] * scale, sp[32 * 33] * scale, sp[64 * 33] * scale, sp[96 * 33] * scale); }
            else w[t] = pk4_fp8(s[(4 * t) * 33] * scale, s[(4 * t + 1) * 33] * scale, s[(4 * t + 2) * 33] * scale, s[(4 * t + 3) * 33] * scale); }
        unsigned char* dst = WT8 + (size_t)(row_dst0 + n) * K + k0 + 32 * q;
        *(u32x4*)dst = (u32x4){w[0], w[1], w[2], w[3]}; *(u32x4*)(dst + 16) = (u32x4){w[4], w[5], w[6], w[7]}; }
    asm volatile("s_waitcnt lgkmcnt(0)" ::: "memory");
}
__device__ __forceinline__ void ph1_convert(Frame& F) {
    {
        const int gid = F.bx * NTHR + F.tid;
        if (gid < 5 * 6144) { const int vec = gid / 6144, n = gid % 6144, l = vec < 3 ? 0 : 1; float s = KIN(F, 5)[l * 6144 + n];
            const float* mp = (const float*)(KWS(F) + WS_MODP) + (size_t)vec * 6144 + n;
#pragma unroll
            for (int kc = 0; kc < 16; ++kc) s += mp[(size_t)kc * 5 * 6144];
            ((float*)(KWS(F) + WS_MOD))[gid] = s; }
    }
    LAS float* scr = (LAS float*)(F.lds + F.wave * 16896);
    const int gw = F.bx * NWAVES + F.wave, NGW = F.G * NWAVES;
    constexpr int I_EVIN = 8 * 80, I_EVOUT = 8 * 32, I_ODIN = 8 * 48, I_ODOUT = 8 * 32, I_DENSE = I_EVIN + I_EVOUT + I_ODIN + I_ODOUT;
    constexpr int I_GU = 64 * 512, I_DN = 64 * 256, NITEMS = I_DENSE + I_GU + I_DN;
    for (int it = gw; it < NITEMS; it += NGW) {
        int r = it;
        if (r < I_EVIN) { const int kb = r / 80, nb = r % 80, n0 = 32 * nb; int src = n0;
            if (n0 >= 1536) { const int u = (n0 - 1536) >> 8, w = (n0 - 1536) & 255; src = (w < 128) ? 1536 + 128 * u + w : 2048 + 128 * u + (w - 128); }
            transpose_item_fp8(KIN(F, 10), DM, 2560, 128 * kb, src, (unsigned char*)(KWS(F) + WS_WEVIN), n0, WI_SCALE, scr, F.lane, n0 >= 1536); continue; } r -= I_EVIN;
        if (r < I_EVOUT) { const int kb = r / 32, nb = r % 32; transpose_item_fp8(KIN(F, 11), DM, 1024, 128 * kb, 32 * nb, (unsigned char*)(KWS(F) + WS_WEVOUT), 32 * nb, WO_SCALE, scr, F.lane, false, kb >= 4); continue; } r -= I_EVOUT;
        if (r < I_ODIN) { const int kb = r / 48, nb = r % 48; transpose_item_fp8(KIN(F, 21), DM, 1536, 128 * kb, 32 * nb, (unsigned char*)(KWS(F) + WS_WODIN), 32 * nb, WI_SCALE, scr, F.lane); continue; } r -= I_ODIN;
        if (r < I_ODOUT) { const int kb = r / 32, nb = r % 32; transpose_item_fp8(KIN(F, 22), DM, 1024, 128 * kb, 32 * nb, (unsigned char*)(KWS(F) + WS_WODOUT), 32 * nb, WO_SCALE, scr, F.lane, false, true); continue; } r -= I_ODOUT;
        if (r < I_GU) { const int le = r >> 9, q = r & 511, kb = q >> 6, nb = q & 63, n0 = 32 * nb; const int u = n0 >> 8, w = n0 & 255;
            const int src = (w < 128) ? 128 * u + w : 1024 + 128 * u + (w - 128);
            transpose_item_fp8(KIN(F, 31) + (size_t)le * DM * 2048, DM, 2048, 128 * kb, src, (unsigned char*)(KWS(F) + WS_WGU) + (size_t)le * 2048 * DM, n0, WGU_SCALE, scr, F.lane); continue; } r -= I_GU;
        { const int le = r >> 8, q = r & 255, kb = q >> 5, nb = q & 31;
            transpose_item_fp8(KIN(F, 33) + (size_t)le * DM * 1024, DM, 1024, 128 * kb, 32 * nb, (unsigned char*)(KWS(F) + WS_WD) + (size_t)le * 1024 * DM, 32 * nb, WD_SCALE, scr, F.lane); }
    }
}

__device__ __forceinline__ void mod_row(const float* xrow, const float* sh, const float* sc, unsigned char* orow, int lane) {
    f32x4 x[4], a[4], b[4];
#pragma unroll
    for (int j = 0; j < 4; ++j) { const int d = 4 * lane + 256 * j; x[j] = *(const f32x4*)(xrow + d); a[j] = *(const f32x4*)(sc + d); b[j] = *(const f32x4*)(sh + d); }
    asm volatile("" ::: "memory");
#pragma unroll
    for (int j = 0; j < 4; ++j) { const int d = 4 * lane + 256 * j;
        const f32x4 v = x[j] * (a[j] + 1.0f) + b[j]; *(unsigned*)(orow + d) = pk4_fp8(v[0], v[1], v[2], v[3]); }
}
__device__ __forceinline__ void ph2_modulate(Frame& F) {
    const float* mod = (const float*)(KWS(F) + WS_MOD); unsigned char* U = (unsigned char*)(KWS(F) + WS_U);
    const int gw = F.bx * NWAVES + F.wave, NGW = F.G * NWAVES;
    for (int r = gw; r < T + NCTX; r += NGW) {
        if (r < T) { const int b = r >> 14; mod_row(KIN(F, 0) + (size_t)r * DM, mod + b * 6144, mod + b * 6144 + 1024, U + (size_t)r * DM, F.lane); }
        else { mod_row(KIN(F, 2) + (size_t)(r - T) * DM, mod + 2 * 6144, mod + 2 * 6144 + 1024, U + (size_t)r * DM, F.lane); }
    }
}

struct EvInOrder {
    pg8::StaticOrder so;
    __device__ bool next(int i, pg8::Unit& u) const {
        const long L = (long)i * so.G + so.c;
        if (L < so.nwg) return so.map(L, u);
        const int x = (int)(L - so.nwg); if (x >= 8) return false;
        u.pm = 128 + (x >> 2); u.pn = 2 + (x & 3); u.a0 = 0; u.a1 = 0; u.a2 = 256; return true;
    }
    __device__ __forceinline__ unsigned arow(const pg8::Unit&, int) const { return 0u; }
};
__device__ __forceinline__ int vpos64(int k) { return 32 * ((k >> 2) & 1) + 16 * (k >> 5) + ((k & 3) + 4 * ((k & 31) >> 3)); }
struct EpiEvIn {
    static constexpr bool PERM = false, HAS_PRE = false, PERM256 = false;
    unsigned char *Q8, *K8, *V8T; bf16_t* Ab; const float* cosT; const float* sinT;
    __device__ __forceinline__ void operator()(const f32x4 (&acc)[2][2][4][2], const pg8::Unit& u, int wr, int wc, int fr, int fq) const {
        const int pn = u.pn;
        if (pn < 4) {
            const int kind = pn >> 1, colbase = (pn & 1) * 256 + wc * 32 + 4 * fq; const bool isctx = u.pm >= 128;
            const float sc = ((kind == 0) ? QSCALE : 1.0f) * (1.0f / WI_SCALE);
#define QK_ROW(ai, m, CS, SN) do { const int row = u.pm * 256 + (ai) * 128 + wr * 64 + (m) * 16 + fr; int b_, key_; \
                if (!isctx) { b_ = row >> 14; key_ = row & (SEQ - 1); } else { const int rc_ = row - T; b_ = rc_ >> 8; key_ = SEQ + (rc_ & 255); } \
                unsigned char* dst = (kind == 0) ? Q8 + (size_t)row * 512 : K8 + (size_t)(b_ * NKEY + key_) * 512; \
                _Pragma("unroll") for (int bj = 0; bj < 2; ++bj) { const f32x4 x1 = acc[ai][bj][m][0], x2 = acc[ai][bj][m][1]; \
                    const f32x4 o1 = (x1 * (CS) - x2 * (SN)) * sc, o2 = (x1 * (SN) + x2 * (CS)) * sc; \
                    *(unsigned*)(dst + colbase + bj * 128) = pk4_fp8(o1[0], o1[1], o1[2], o1[3]); *(unsigned*)(dst + colbase + bj * 128 + 16) = pk4_fp8(o2[0], o2[1], o2[2], o2[3]); } } while (0)
            if (wc & 1) {
#pragma unroll
                for (int mh = 0; mh < 2; ++mh) {
                    f32x4 cs[2], sn[2];
#pragma unroll
                    for (int mm = 0; mm < 2; ++mm) { cs[mm] = (f32x4){1.f, 1.f, 1.f, 1.f}; sn[mm] = (f32x4){0.f, 0.f, 0.f, 0.f};
                        if (!isctx) { const int pos = 256 + (2 * mh + mm) * 16 + fr; cs[mm] = *(const f32x4*)(cosT + pos * 16 + 4 * fq); sn[mm] = *(const f32x4*)(sinT + pos * 16 + 4 * fq); } }
                    asm volatile("" ::: "memory");
#pragma unroll
                    for (int ai = 0; ai < 2; ++ai)
#pragma unroll
                        for (int mm = 0; mm < 2; ++mm) QK_ROW(ai, 2 * mh + mm, cs[mm], sn[mm]);
                }
            } else {
                f32x4 cs[2], sn[2];
#pragma unroll
                for (int ai = 0; ai < 2; ++ai) { cs[ai] = (f32x4){1.f, 1.f, 1.f, 1.f}; sn[ai] = (f32x4){0.f, 0.f, 0.f, 0.f};
                    if (!isctx) { const int pos = ((u.pm * 256 + ai * 128 + wr * 64) & (SEQ - 1)) >> 6; cs[ai] = *(const f32x4*)(cosT + pos * 16 + 4 * fq); sn[ai] = *(const f32x4*)(sinT + pos * 16 + 4 * fq); } }
                asm volatile("" ::: "memory");
#pragma unroll
                for (int ai = 0; ai < 2; ++ai)
#pragma unroll
                    for (int m = 0; m < 4; ++m) QK_ROW(ai, m, cs[ai], sn[ai]);
            }
#undef QK_ROW
        } else if (pn < 6) {
            const int colbase = (pn & 1) * 256 + wc * 32 + 4 * fq;
#pragma unroll
            for (int ai = 0; ai < 2; ++ai)
#pragma unroll
                for (int m = 0; m < 4; ++m) {
                    const int row = u.pm * 256 + ai * 128 + wr * 64 + m * 16 + fr; const bool isctx = row >= T;
                    int b, key;
                    if (!isctx) { b = row >> 14; key = row & (SEQ - 1); } else { const int rc = row - T; b = rc >> 8; key = SEQ + (rc & 255); }
                    const size_t kofs = (size_t)(key & ~63) + vpos64(key & 63);
#pragma unroll
                    for (int bj = 0; bj < 2; ++bj)
#pragma unroll
                        for (int n = 0; n < 2; ++n) { const f32x4 x = acc[ai][bj][m][n] * (1.0f / WI_SCALE); const unsigned w = pk4_fp8(x[0], x[1], x[2], x[3]); const int vcol = colbase + bj * 128 + n * 16;
                            unsigned char* dst = V8T + ((size_t)(b * 4 + (vcol >> 7)) * 128 + (vcol & 127)) * NKEY + kofs;
                            dst[0] = (unsigned char)(w & 0xff); dst[NKEY] = (unsigned char)((w >> 8) & 0xff); dst[2 * NKEY] = (unsigned char)((w >> 16) & 0xff); dst[3 * NKEY] = (unsigned char)(w >> 24); }
                }
        } else {
            const int colbase = (pn - 6) * 128 + wc * 32 + 8 * fq;
#pragma unroll
            for (int ai = 0; ai < 2; ++ai)
#pragma unroll
                for (int m = 0; m < 4; ++m) {
                    const int row = u.pm * 256 + ai * 128 + wr * 64 + m * 16 + fr; if (row >= T) continue;
                    u32x4 w;
#pragma unroll
                    for (int n = 0; n < 2; ++n) { const f32x4 v = acc[ai][0][m][n] * (1.0f / WI_SCALE), g = acc[ai][1][m][n] * (1.0f / WI_SCALE); f32x4 o;
#pragma unroll
                        for (int j = 0; j < 4; ++j) o[j] = v[j] * sigmoid_f(g[j]);
                        w[2 * n] = pk2(o[0], o[1]); w[2 * n + 1] = pk2(o[2], o[3]); }
                    *(u32x4*)(Ab + (size_t)row * 512 + colbase) = w;
                }
        }
    }
};

__device__ __forceinline__ void ph4_conv(Frame& F) {
    const bf16_t* Ab = (const bf16_t*)(KWS(F) + WS_AB); unsigned char* MIX = (unsigned char*)(KWS(F) + WS_MIX);
    const float* cw = KIN(F, 12); const float* cb = KIN(F, 13); const float* lg = KIN(F, 14); const float* lb = KIN(F, 15);
    LAS bf16_t* At = (LAS bf16_t*)F.lds;
    LAS float* Yt = (LAS float*)(F.lds + 65536);
    const int ch = F.tid;
    float w[31];
#pragma unroll
    for (int j = 0; j < 31; ++j) w[j] = cw[j * 512 + ch];
    const float bias = cb[ch];
#define CONV_STAGE(tile_) do { const int b_ = (tile_) >> 9, t0_ = ((tile_) & 511) * 32; \
        _Pragma("unroll") for (int k_ = 0; k_ < 8; ++k_) { const int row_ = F.wave + 8 * k_; if (row_ < 62) { const int t_ = t0_ - 15 + row_; \
            if (t_ >= 0 && t_ < SEQ) __builtin_amdgcn_global_load_lds((const unsigned*)(Ab + ((size_t)(b_ * SEQ + t_)) * 512 + F.lane * 8), (LAS unsigned*)(At + row_ * 512), 16, 0, 0); \
            else { const unsigned z_ = (unsigned)F.kz; const u32x4 zv_ = {z_, z_, z_, z_}; *(LAS u32x4*)(At + row_ * 512 + F.lane * 8) = zv_; } } } } while (0)
    const f32x4 g0 = *(const f32x4*)(lg + 8 * F.lane), g1 = *(const f32x4*)(lg + 8 * F.lane + 4), b0 = *(const f32x4*)(lb + 8 * F.lane), b1 = *(const f32x4*)(lb + 8 * F.lane + 4);
    if (F.bx < T / 32) CONV_STAGE(F.bx);
    for (int tile = F.bx; tile < T / 32; tile += F.G) {
        const int b = tile >> 9, t0 = (tile & 511) * 32;
        asm volatile("s_waitcnt vmcnt(0)" ::: "memory");
        __syncthreads();
        float a[62];
#pragma unroll
        for (int r = 0; r < 62; ++r) a[r] = bf2f(At[r * 512 + ch]);
#pragma unroll
        for (int t = 0; t < 32; ++t) { float y = bias;
#pragma unroll
            for (int j = 0; j < 31; ++j) y = fmaf(a[t + j], w[j], y);
            Yt[t * 512 + ch] = y; }
        __syncthreads();
        if (tile + F.G < T / 32) CONV_STAGE(tile + F.G);
#pragma unroll
        for (int q = 0; q < 4; ++q) { const int t = F.wave * 4 + q; const LAS float* yr = Yt + t * 512 + 8 * F.lane;
            const f32x4 y0 = *(const LAS f32x4*)yr, y1 = *(const LAS f32x4*)(yr + 4);
            float s = (y0[0] + y0[1]) + (y0[2] + y0[3]) + (y1[0] + y1[1]) + (y1[2] + y1[3]);
            const float mean = wave_sum(s) * (1.0f / 512.0f);
            const f32x4 d0 = y0 - mean, d1 = y1 - mean;
            float q2 = (d0[0] * d0[0] + d0[1] * d0[1]) + (d0[2] * d0[2] + d0[3] * d0[3]) + (d1[0] * d1[0] + d1[1] * d1[1]) + (d1[2] * d1[2] + d1[3] * d1[3]);
            const float rstd = 1.0f / sqrtf(wave_sum(q2) * (1.0f / 512.0f) + LN_EPS);
            f32x4 o0 = d0 * rstd * g0 + b0, o1 = d1 * rstd * g1 + b1;
#pragma unroll
            for (int j = 0; j < 4; ++j) { o0[j] = silu_f(o0[j]); o1[j] = silu_f(o1[j]); }
            u32x2 wv; wv.x = pk4_fp8(o0[0], o0[1], o0[2], o0[3]); wv.y = pk4_fp8(o1[0], o1[1], o1[2], o1[3]);
            *(u32x2*)(MIX + (size_t)(b * SEQ + t0 + t) * 1024 + 8 * F.lane) = wv; }
        __syncthreads();
    }
#undef CONV_STAGE
}

namespace att {
constexpr int KVBLK = 64;
constexpr int SHM_V = 128 * 64, SHM_K = 64 * 64;
constexpr int SHM_1 = 32 * 64;
constexpr int NBUF = 8, DIST = 4, TILEB = SHM_V + SHM_1 + SHM_K;
constexpr int OFF_T = 0, OFF_WS = NBUF * TILEB;
constexpr int OFF_NEG = OFF_WS + 2048;
constexpr float PREF = 6.0f, PMAXLOG = 8.0f;
#define SBAR() __builtin_amdgcn_sched_barrier(0)
#define MX3(a, b, c) __builtin_fmaxf(__builtin_fmaxf((a), (b)), (c))
typedef int v8i32a __attribute__((ext_vector_type(8)));
__device__ __forceinline__ f32x16 mfma8(v8i32a a, v8i32a b, f32x16 c) { return __builtin_amdgcn_mfma_scale_f32_32x32x64_f8f6f4(a, b, c, 0, 0, 0, 0x7F7F7F7F, 0, 0x7F7F7F7F); }
template <bool FIRST> __device__ __forceinline__ void partialSM(f32x16& p0, f32x16& p1, f32x16& negm, float& alpha) {
    float a = MX3(p0[0], p0[1], p1[0]), b = MX3(p0[2], p0[3], p1[1]); a = MX3(a, p1[2], p1[3]);
#pragma unroll
    for (int r = 4; r < 16; r += 4) { a = MX3(a, p0[r], p0[r + 1]); b = MX3(b, p0[r + 2], p0[r + 3]); a = MX3(a, p1[r], p1[r + 1]); b = MX3(b, p1[r + 2], p1[r + 3]); }
    float pmax = fmaxf(a, b);
    { auto rr = __builtin_amdgcn_permlane32_swap(__float_as_uint(pmax), __float_as_uint(pmax), false, false);
      pmax = fmaxf(__uint_as_float(rr[0]), __uint_as_float(rr[1])); }
    alpha = 1.f;
    if (FIRST || __builtin_expect(__any(pmax > PMAXLOG), 0)) {
        const float dl = FIRST ? (pmax - PREF) : fmaxf(pmax - PREF, 0.f); const float nm = negm[0] - dl; alpha = __builtin_amdgcn_exp2f(-dl);
#pragma unroll
        for (int r = 0; r < 16; ++r) { p0[r] -= dl; p1[r] -= dl; negm[r] = nm; }
    }
#pragma unroll
    for (int r = 0; r < 16; ++r) p0[r] = __builtin_amdgcn_exp2f(p0[r]);
}
__device__ __forceinline__ void finishSM(f32x16& p0, f32x16& p1, v8i32a& pf) {
#pragma unroll
    for (int r = 0; r < 16; ++r) p1[r] = __builtin_amdgcn_exp2f(p1[r]);
#pragma unroll
    for (int i = 0; i < 4; ++i) { pf[i] = (int)pk4_fp8(p0[4 * i], p0[4 * i + 1], p0[4 * i + 2], p0[4 * i + 3]); pf[4 + i] = (int)pk4_fp8(p1[4 * i], p1[4 * i + 1], p1[4 * i + 2], p1[4 * i + 3]); }
}
__device__ __forceinline__ v8i32a frag32(const LAS unsigned char* base, int a0, int a1) {
    const bf16x8 lo = *(const LAS bf16x8*)(base + a0), hi = *(const LAS bf16x8*)(base + a1);
    return __builtin_bit_cast(v8i32a, __builtin_shufflevector(lo, hi, 0, 1, 2, 3, 4, 5, 6, 7, 8, 9, 10, 11, 12, 13, 14, 15));
}
__device__ __forceinline__ void attn_pass(const unsigned char* __restrict__ Qw, const unsigned char* __restrict__ Kh, const unsigned char* __restrict__ Vt, LAS unsigned char* lds, f32x16 (&o)[4], f32x16& lacc, const int tid, const int wid) {
    const int lane = tid & 63, r32 = lane & 31, hi = lane >> 5;
    LAS float* al_l = (LAS float*)(lds + OFF_WS) + wid * 64 + 32;
    f32x16 negm = f32x16{}; lacc = f32x16{}; f32x4 l4 = f32x4{};
#pragma unroll
    for (int d = 0; d < 4; ++d) o[d] = f32x16{};
    const v8i32a qf = __builtin_bit_cast(v8i32a, __builtin_shufflevector(*(const bf16x8*)Qw, *(const bf16x8*)(Qw + 16), 0, 1, 2, 3, 4, 5, 6, 7, 8, 9, 10, 11, 12, 13, 14, 15));
    const int sw = (r32 >> 2) & 3, a0 = r32 * 64 + (((2 * hi) ^ sw) << 4), a1 = r32 * 64 + (((2 * hi + 1) ^ sw) << 4);
    const int drow = 16 * wid + (lane >> 2), dch = (lane & 3) ^ ((drow >> 2) & 3);
    const unsigned vsrc = (unsigned)(drow * NKEY + dch * 16), ksrc = (unsigned)(drow * 512 + dch * 16); const bool kw = wid < 4;
    LAS unsigned char* T_lds = lds + OFF_T;
#define DMA(t, bi) do { __builtin_amdgcn_global_load_lds((const unsigned*)((const char*)Vt + (size_t)(t) * 64 + vsrc), (LAS unsigned*)(T_lds + (bi) * TILEB + wid * 1024), 16, 0, 0); \
    if (kw) __builtin_amdgcn_global_load_lds((const unsigned*)((const char*)Kh + (size_t)(t) * (64 * 512) + ksrc), (LAS unsigned*)(T_lds + (bi) * TILEB + SHM_V + SHM_1 + wid * 1024), 16, 0, 0); } while (0)
#define WAITBAR(n) do { if (kw) asm volatile("s_waitcnt vmcnt(%0) lgkmcnt(0)" :: "n"(2 * (n)) : "memory"); else asm volatile("s_waitcnt vmcnt(%0) lgkmcnt(0)" :: "n"(n) : "memory"); \
    __builtin_amdgcn_s_barrier(); asm volatile("" ::: "memory"); } while (0)
#define RESC(a) do { if (__any((a) < 1.f)) { if (hi == 0) al_l[r32] = (a); asm volatile("s_waitcnt lgkmcnt(0)" ::: "memory"); \
    _Pragma("unroll") for (int r = 0; r < 16; ++r) { const float f_ = al_l[crow(r, hi)]; o[0][r] *= f_; o[1][r] *= f_; o[2][r] *= f_; o[3][r] *= f_; lacc[r] *= f_; } } } while (0)
#define QKT(P0, P1, bi) do { const LAS unsigned char* kb_ = T_lds + (bi) * TILEB + SHM_V + SHM_1; P0 = mfma8(frag32(kb_, a0, a1), qf, negm); P1 = mfma8(frag32(kb_ + 2048, a0, a1), qf, negm); } while (0)
#ifndef MF8_ACC
#define MF8_ACC "+v"
#endif
#define MF8(acc_, v_) asm volatile("v_mfma_scale_f32_32x32x64_f8f6f4 %0, %1, %2, %0, %3, %3 op_sel_hi:[0,0,0]" : MF8_ACC(acc_) : "v"(pf), "v"(v_), "v"(one_sc))
#define MF16(acc_, v_) asm volatile("v_mfma_scale_f32_16x16x128_f8f6f4 %0, %1, %2, %0, %3, %3 op_sel_hi:[0,0,0]" : "+v"(acc_) : "v"(pf), "v"(v_), "v"(one_sc))
#define PV(bi) do { const LAS unsigned char* vb_ = T_lds + (bi) * TILEB; { const v8i32a v0_ = frag32(vb_, a0, a1), v1_ = frag32(vb_ + 2048, a0, a1); asm volatile("s_nop 1" ::: ); MF8(o[0], v0_); MF8(o[1], v1_); } \
    { const v8i32a v2_ = frag32(vb_ + 4096, a0, a1), v3_ = frag32(vb_ + 6144, a0, a1); MF8(o[2], v2_); MF8(o[3], v3_); } \
    { const v8i32a v4_ = ones8_; MF16(l4, v4_); } } while (0)
    f32x16 pA0, pA1, pB0, pB1; v8i32a pf; constexpr int NT = NKEY / KVBLK;
    const int one_sc = 0x7F7F7F7F;
#define MFQK(P_, kf_) P_ = mfma8(kf_, qf, negm)
#define EX8(P_, b_) do { _Pragma("unroll") for (int r_ = 0; r_ < 8; ++r_) P_[(b_) + r_] = __builtin_amdgcn_exp2f(P_[(b_) + r_]); } while (0)
#if defined(EXP_EXTRA_MFMA)
#define XMF() do { const v8i32a vn_ = frag32(lds + OFF_NEG, a0, a1); MF8(lacc, vn_); MF8(lacc, v4_); } while (0)
#else
#define XMF() do { } while (0)
#endif
#if defined(EXP_EXTRA_LDS)
#define XTRA(A_, B_) do { _Pragma("unroll") for (int r_ = 0; r_ < 5; ++r_) { const v8i32a t_ = frag32(vb_ + 2048 * r_, a0, a1); asm volatile("" :: "v"(t_)); } } while (0)
#elif defined(EXP_EXTRA_EXP)
#define XTRA(A_, B_) do { _Pragma("unroll") for (int r_ = 0; r_ < 16; ++r_) { float t_; asm volatile("v_exp_f32 %0, %1" : "=v"(t_) : "v"(A_[r_])); asm volatile("v_exp_f32 %0, %1" : "=v"(t_) : "v"(B_[r_])); } } while (0)
#elif defined(EXP_EXTRA_ADD)
#define XTRA(A_, B_) do { _Pragma("unroll") for (int r_ = 0; r_ < 16; ++r_) { float t_; asm volatile("v_add_f32 %0, %1, %1" : "=v"(t_) : "v"(A_[r_])); asm volatile("v_add_f32 %0, %1, %1" : "=v"(t_) : "v"(B_[r_])); } } while (0)
#else
#define XTRA(A_, B_) do { } while (0)
#endif
#define STEP(C0, C1, P0, P1, HAVEPREV, FIRSTT, tnext, dodma, WBSTMT) do { \
    if (dodma) DMA(tnext, bd); \
    const LAS unsigned char* kb_ = T_lds + bc * TILEB + SHM_V + SHM_1; const LAS unsigned char* vb_ = T_lds + bp * TILEB; \
    const v8i32a kf0_ = frag32(kb_, a0, a1), kf1_ = frag32(kb_ + 2048, a0, a1); v8i32a v0_, v1_, v2_, v3_, v4_; if (HAVEPREV) { v0_ = frag32(vb_, a0, a1); v1_ = frag32(vb_ + 2048, a0, a1); } \
    SBAR(); MFQK(C0, kf0_); if (HAVEPREV) EX8(P1, 0); SBAR(); \
    MFQK(C1, kf1_); if (HAVEPREV) { EX8(P1, 8); _Pragma("unroll") for (int i_ = 0; i_ < 4; ++i_) { pf[i_] = (int)pk4_fp8(P0[4 * i_], P0[4 * i_ + 1], P0[4 * i_ + 2], P0[4 * i_ + 3]); pf[4 + i_] = (int)pk4_fp8(P1[4 * i_], P1[4 * i_ + 1], P1[4 * i_ + 2], P1[4 * i_ + 3]); } } SBAR(); \
    float al_ = 1.f; \
    if (HAVEPREV) { asm volatile("s_nop 1" ::: ); MF8(o[0], v0_); SBAR(); MF8(o[1], v1_); v2_ = frag32(vb_ + 4096, a0, a1); v3_ = frag32(vb_ + 6144, a0, a1); v4_ = ones8_; SBAR(); } \
    else { asm volatile("s_nop 15\n\ts_nop 15\n\ts_nop 15\n\ts_nop 15" ::: "memory"); }     \
    float mxa_ = MX3(C0[0], C0[1], C1[0]), mxb_ = MX3(C0[2], C0[3], C1[1]); mxa_ = MX3(mxa_, C1[2], C1[3]); \
    _Pragma("unroll") for (int r_ = 4; r_ < 16; r_ += 4) { mxa_ = MX3(mxa_, C0[r_], C0[r_ + 1]); mxb_ = MX3(mxb_, C0[r_ + 2], C0[r_ + 3]); mxa_ = MX3(mxa_, C1[r_], C1[r_ + 1]); mxb_ = MX3(mxb_, C1[r_ + 2], C1[r_ + 3]); } \
    float pm_ = fmaxf(mxa_, mxb_); { auto rr_ = __builtin_amdgcn_permlane32_swap(__float_as_uint(pm_), __float_as_uint(pm_), false, false); pm_ = fmaxf(__uint_as_float(rr_[0]), __uint_as_float(rr_[1])); } \
    SBAR(); \
    if (HAVEPREV) { MF8(o[2], v2_); SBAR(); MF8(o[3], v3_); SBAR(); } \
    if (FIRSTT || __builtin_expect(__any(pm_ > PMAXLOG), 0)) { const float dl_ = FIRSTT ? (pm_ - PREF) : fmaxf(pm_ - PREF, 0.f); const float nm_ = negm[0] - dl_; al_ = __builtin_amdgcn_exp2f(-dl_); \
        _Pragma("unroll") for (int r_ = 0; r_ < 16; ++r_) { C0[r_] -= dl_; C1[r_] -= dl_; negm[r_] = nm_; } } \
    SBAR(); \
    if (HAVEPREV) { MF16(l4, v4_); XMF(); SBAR(); } \
    if (grpB) { WBSTMT; }     \
    EX8(C0, 0); EX8(C0, 8); XTRA(C0, C1); SBAR(); \
    if (HAVEPREV) { if (__any(al_ < 1.f)) { asm volatile("s_nop 15\n\ts_nop 15" ::: "memory"); if (hi == 0) al_l[r32] = al_; asm volatile("s_waitcnt lgkmcnt(0)" ::: "memory"); \
        _Pragma("unroll") for (int r_ = 0; r_ < 16; ++r_) { const float f_ = al_l[crow(r_, hi)]; o[0][r_] *= f_; o[1][r_] *= f_; o[2][r_] *= f_; o[3][r_] *= f_; } \
        _Pragma("unroll") for (int i_ = 0; i_ < 4; ++i_) l4[i_] *= al_l[(lane & 1) * 16 + 4 * (lane >> 4) + i_]; } } \
    } while (0)
    v8i32a ones8_; { int o1_ = ((lane & 15) == ((lane >> 4) & 1)) ? 0x38383838 : 0; asm volatile("" : "+v"(o1_));     ones8_ = (v8i32a){o1_, o1_, o1_, o1_, o1_, o1_, o1_, o1_}; asm volatile("" : "+v"(ones8_)); }
    int bp = 7, bc = 0, bd = 4;
#define ROT() do { bp = bc; bc = (bc + 1) & (NBUF - 1); bd = (bd + 1) & (NBUF - 1); } while (0)
#define XBAR() do { } while (0)
    const bool grpB = wid >= 4;
    if (!grpB) __builtin_amdgcn_s_setprio(1);
    DMA(0, 0); DMA(1, 1); DMA(2, 2); DMA(3, 3); WAITBAR(3);
    STEP(pA0, pA1, pB0, pB1, false, true, 4, true, WAITBAR(2)); if (!grpB) WAITBAR(2); ROT();
#pragma unroll 1
    for (int j = 1; j + 1 < NT; j += 2) {
        const bool more0 = (j + 4 < NT), more1 = (j + 5 < NT);
        STEP(pB0, pB1, pA0, pA1, true, false, j + 4, more0, (void)0); ROT();
#define PAIRBAR() do { if (more1) WAITBAR(2); else if (more0) WAITBAR(1); else WAITBAR(0); } while (0)
        STEP(pA0, pA1, pB0, pB1, true, false, j + 5, more1, PAIRBAR()); if (!grpB) PAIRBAR();
#undef PAIRBAR
        ROT();
    }
    STEP(pB0, pB1, pA0, pA1, true, false, 0, false, WAITBAR(0)); if (!grpB) WAITBAR(0); ROT();
    { EX8(pB1, 0); EX8(pB1, 8);
#pragma unroll
      for (int i_ = 0; i_ < 4; ++i_) { pf[i_] = (int)pk4_fp8(pB0[4 * i_], pB0[4 * i_ + 1], pB0[4 * i_ + 2], pB0[4 * i_ + 3]); pf[4 + i_] = (int)pk4_fp8(pB1[4 * i_], pB1[4 * i_ + 1], pB1[4 * i_ + 2], pB1[4 * i_ + 3]); }
      SBAR(); PV(bp); }
#undef STEP
#undef MFQK
#undef EX8
    __builtin_amdgcn_s_setprio(0);
    __syncthreads();
    asm volatile("s_nop 15\n\ts_nop 15" : "+v"(l4));
    if ((lane & 15) < 2) {
#pragma unroll
        for (int i = 0; i < 4; ++i) al_l[(lane & 1) * 16 + 4 * (lane >> 4) + i] = l4[i]; }
    asm volatile("s_waitcnt lgkmcnt(0)" ::: "memory");
#pragma unroll
    for (int r = 0; r < 16; ++r) lacc[r] = al_l[crow(r, hi)];
    asm volatile("s_waitcnt lgkmcnt(0)" ::: "memory");
#undef ROT
#undef DMA
#undef WAITBAR
#undef RESC
#undef QKT
#undef PV
#undef MF8
}
}

__device__ __forceinline__ void ph4_attention(Frame& F) {
    const unsigned char* Q8 = (const unsigned char*)(KWS(F) + WS_Q); const unsigned char* K8 = (const unsigned char*)(KWS(F) + WS_K); const unsigned char* V8T = (const unsigned char*)(KWS(F) + WS_V);
    float* O0 = (float*)(KWS(F) + WS_O0); unsigned char* MIX = (unsigned char*)(KWS(F) + WS_MIX); const float* gn = KIN(F, 20);
    const int lane = F.lane, wid = F.wave;
    float lam;
    { const float a = wave_sum(KIN(F, 16)[lane] * KIN(F, 17)[lane]), b = wave_sum(KIN(F, 18)[lane] * KIN(F, 19)[lane]); lam = __builtin_bit_cast(float, __builtin_amdgcn_readfirstlane(__builtin_bit_cast(int, __expf(a) - __expf(b) + LAM_INIT0))); }
    __syncthreads();
    const unsigned kz_ = (unsigned)F.kz;
    for (int i = F.tid; i < att::NBUF * (att::SHM_1 / 16); i += NTHR) { const int bi = i / (att::SHM_1 / 16), q = i % (att::SHM_1 / 16);
        *(LAS u32x4*)(F.lds + att::OFF_T + bi * att::TILEB + att::SHM_V + q * 16) = (u32x4){0x38383838u + kz_, 0x38383838u + kz_, 0x38383838u + kz_, 0x38383838u + kz_}; }
#if defined(EXP_EXTRA_MFMA)
    for (int i = F.tid; i < 128; i += NTHR) *(LAS u32x4*)(F.lds + att::OFF_NEG + i * 16) = (u32x4){0xB8B8B8B8u + kz_, 0xB8B8B8B8u + kz_, 0xB8B8B8B8u + kz_, 0xB8B8B8B8u + kz_};
#endif
    __syncthreads();
    const int x = F.bx & 7, jb = F.bx >> 3;
    for (int vb = x; vb < 8; vb += 8) { const int b = vb >> 2, h = vb & 3;
    for (int qb = jb; qb < SEQ / 256; qb += (F.G >> 3)) {
        const long rowbase = (long)b * SEQ + qb * 256 + wid * 32;
        f32x16 o[4]; f32x16 lacc;
#pragma unroll 1
        for (int c = 0; c < 2; ++c) {
            const unsigned char* Qw = Q8 + (rowbase + (lane & 31)) * 512 + h * 128 + c * 64 + (lane >> 5) * 32;
            const unsigned char* Kh = K8 + (long)b * NKEY * 512 + h * 128 + c * 64;
            const unsigned char* Vt = V8T + (long)(b * 4 + h) * 128 * NKEY;
            att::attn_pass(Qw, Kh, Vt, F.lds, o, lacc, F.tid, F.wave);
            int lane_e = lane; asm volatile("" : "+v"(lane_e));
            const int r32 = lane_e & 31, hi = lane_e >> 5;
            asm volatile("s_nop 15\n\ts_nop 15" : "+v"(lacc));
            float rli[16];
#pragma unroll
            for (int r = 0; r < 16; ++r) rli[r] = __builtin_amdgcn_rcpf(lacc[r]);
            float* ow = O0 + ((size_t)(rowbase >> 5) * 4 + h) * 4096 + lane_e * 4;
            if (c == 0) {
#pragma unroll
                for (int d0 = 0; d0 < 4; ++d0)
#pragma unroll
                    for (int g = 0; g < 4; ++g) { const f32x4 v = {o[d0][4 * g] * rli[4 * g], o[d0][4 * g + 1] * rli[4 * g + 1], o[d0][4 * g + 2] * rli[4 * g + 2], o[d0][4 * g + 3] * rli[4 * g + 3]};
                        *(f32x4*)(ow + (d0 * 4 + g) * 256) = v; }
            } else {
                const float g0 = gn[r32], g1 = gn[32 + r32], g2 = gn[64 + r32], g3 = gn[96 + r32];
                float ov[16][4];
#pragma unroll
                for (int d0 = 0; d0 < 4; ++d0)
#pragma unroll
                    for (int g = 0; g < 4; ++g) { const f32x4 v = *(const f32x4*)(ow + (d0 * 4 + g) * 256); ov[4 * g][d0] = v[0]; ov[4 * g + 1][d0] = v[1]; ov[4 * g + 2][d0] = v[2]; ov[4 * g + 3][d0] = v[3]; }
                asm volatile("" ::: "memory");
#pragma unroll
                for (int r = 0; r < 16; ++r) { const long grow = rowbase + crow(r, hi);
                    const float v0 = ov[r][0] - lam * (o[0][r] * rli[r]), v1 = ov[r][1] - lam * (o[1][r] * rli[r]), v2 = ov[r][2] - lam * (o[2][r] * rli[r]), v3 = ov[r][3] - lam * (o[3][r] * rli[r]);
                    float ss = (v0 * v0 + v1 * v1) + (v2 * v2 + v3 * v3);
                    ss = half_sum(ss);
                    const float scl = (1.0f - LAM_INIT0) / sqrtf(ss * (1.0f / 128.0f) + LN_EPS);
                    *(unsigned*)(MIX + grow * 1024 + 512 + h * 128 + 4 * r32) = pk4_fp8(v0 * scl * g0, v1 * scl * g1, v2 * scl * g2, v3 * scl * g3);
                    if ((r & 3) == 3) asm volatile("" ::: "memory"); }
            }
        }
    } }
}

__device__ __forceinline__ void ph_router(Frame& F, int layer, const float* hin) {
    const float* mod = (const float*)(KWS(F) + WS_MOD) + (size_t)(layer * 3) * 6144;
    const bf16_t* Y = (const bf16_t*)(KWS(F) + WS_Y); bf16_t* H1 = (bf16_t*)(KWS(F) + WS_H1); unsigned char* U2 = (unsigned char*)(KWS(F) + WS_U2);
    const float* lng = KIN(F, 6) + layer * DM; const float* lnb = KIN(F, 7) + layer * DM;
    const float* rw = KIN(F, 29) + (size_t)layer * DM * NE; const float* rb = KIN(F, 30) + layer * NE;
    unsigned* gcnt = (unsigned*)(KWS(F) + WS_CTL) + CW_CNT + layer * NE;
    unsigned* list = (unsigned*)(KWS(F) + WS_LIST); float* gates = (float*)(KWS(F) + WS_GATES);
    constexpr int RWS = 1028, RSEL = 131584, RVEC = RSEL + 10240;
    LAS float* rwT = (LAS float*)F.lds;
    LAS int* sel_e = (LAS int*)(F.lds + RSEL);
    LAS float* sel_g = (LAS float*)(F.lds + RSEL + 2048);
    LAS unsigned* lcnt = (LAS unsigned*)(F.lds + RSEL + 4096);
    LAS unsigned* lbase = lcnt + 32;
    LAS unsigned* lpos = lcnt + 64;
    LAS float* vG = (LAS float*)(F.lds + RVEC);
    const int lane = F.lane;
    for (int i = F.tid; i < DM * NE / 4; i += NTHR) { const int d = i >> 3, e = (i & 7) * 4; const f32x4 w4 = *(const f32x4*)(rw + 4 * i);
        rwT[e * RWS + d] = w4[0]; rwT[(e + 1) * RWS + d] = w4[1]; rwT[(e + 2) * RWS + d] = w4[2]; rwT[(e + 3) * RWS + d] = w4[3]; }
    __syncthreads();
    for (int blk = F.bx; blk < T / 128; blk += F.G) {
        const int r0 = blk * 128, b = r0 >> 14;
        const float* g1 = mod + b * 6144 + 2048; const float* sh2 = mod + b * 6144 + 3072; const float* sc2 = mod + b * 6144 + 4096;
        if (F.tid < 32) lcnt[F.tid] = 0u;
        for (int i = F.tid; i < DM; i += NTHR) { vG[i] = g1[i]; vG[DM + i] = lng[i]; vG[2 * DM + i] = lnb[i]; vG[3 * DM + i] = sc2[i] + 1.0f; vG[4 * DM + i] = sh2[i]; }
        __syncthreads();
        f32x4 nx[2][4]; u32x2 ny[2][4];
#pragma unroll
        for (int t = 0; t < 2; ++t)
#pragma unroll
            for (int j = 0; j < 4; ++j) { const int d = 4 * lane + 256 * j; const size_t rr = (size_t)(r0 + F.wave * 16 + t); if (layer == 0) nx[t][j] = *(const f32x4*)(hin + rr * DM + d); else { const u32x2 rw_ = *(const u32x2*)((const bf16_t*)hin + rr * DM + d); nx[t][j][0] = __uint_as_float(rw_.x); nx[t][j][1] = __uint_as_float(rw_.y); } ny[t][j] = *(const u32x2*)(Y + rr * DM + d); }
        for (int qq = 0; qq < 8; ++qq) {
            int lane4 = 4 * lane; asm volatile("" : "+v"(lane4));
            const int tl0 = F.wave * 16 + 2 * qq;
            f32x4 pre[2][4]; float s1[2] = {0.f, 0.f}, s2[2] = {0.f, 0.f};
#pragma unroll
            for (int t = 0; t < 2; ++t)
#pragma unroll
                for (int j = 0; j < 4; ++j) { const int d = lane4 + 256 * j; f32x4 x = nx[t][j]; const u32x2 yw = ny[t][j];
                    if (layer != 0) { const unsigned r0_ = __float_as_uint(x[0]), r1_ = __float_as_uint(x[1]); x[0] = __uint_as_float(r0_ << 16); x[1] = __uint_as_float(r0_ & 0xffff0000u); x[2] = __uint_as_float(r1_ << 16); x[3] = __uint_as_float(r1_ & 0xffff0000u); }     const f32x4 g = *(const LAS f32x4*)(vG + d);
                    f32x4 y; y[0] = __uint_as_float(yw.x << 16); y[1] = __uint_as_float(yw.x & 0xffff0000u); y[2] = __uint_as_float(yw.y << 16); y[3] = __uint_as_float(yw.y & 0xffff0000u);
                    const f32x4 p_ = x * ALPHA + g * y; pre[t][j] = p_; s1[t] += (p_[0] + p_[1]) + (p_[2] + p_[3]); s2[t] += (p_[0] * p_[0] + p_[1] * p_[1]) + (p_[2] * p_[2] + p_[3] * p_[3]); }
            if (qq + 1 < 8) {
#pragma unroll
                for (int t = 0; t < 2; ++t)
#pragma unroll
                    for (int j = 0; j < 4; ++j) { const int d = lane4 + 256 * j; const size_t rr = (size_t)(r0 + tl0 + 2 + t); if (layer == 0) nx[t][j] = *(const f32x4*)(hin + rr * DM + d); else { const u32x2 rw_ = *(const u32x2*)((const bf16_t*)hin + rr * DM + d); nx[t][j][0] = __uint_as_float(rw_.x); nx[t][j][1] = __uint_as_float(rw_.y); } ny[t][j] = *(const u32x2*)(Y + rr * DM + d); } }
            s1[0] = wave_sum(s1[0]); s1[1] = wave_sum(s1[1]); s2[0] = wave_sum(s2[0]); s2[1] = wave_sum(s2[1]);
            f32x4 u2[2][4];
#pragma unroll
            for (int t = 0; t < 2; ++t) { const float mean = s1[t] * (1.0f / DM); const float var = fmaxf(s2[t] * (1.0f / DM) - mean * mean, 0.f); const float rstd = 1.0f / sqrtf(var + LN_EPS); const size_t row = (size_t)(r0 + tl0 + t);
#pragma unroll
                for (int j = 0; j < 4; ++j) { const int d = lane4 + 256 * j; const f32x4 h = (pre[t][j] - mean) * rstd * *(const LAS f32x4*)(vG + DM + d) + *(const LAS f32x4*)(vG + 2 * DM + d);
                    { u32x2 hw_; hw_.x = pk2(h[0], h[1]); hw_.y = pk2(h[2], h[3]); *(u32x2*)(H1 + row * DM + d) = hw_; }
                    u2[t][j] = h * *(const LAS f32x4*)(vG + 3 * DM + d) + *(const LAS f32x4*)(vG + 4 * DM + d);
                    *(unsigned*)(U2 + row * DM + d) = pk4_fp8(u2[t][j][0], u2[t][j][1], u2[t][j][2], u2[t][j][3]); } }
            f32x2 up[4][4];
#pragma unroll
            for (int j = 0; j < 4; ++j)
#pragma unroll
                for (int i = 0; i < 4; ++i) { up[j][i][0] = u2[0][j][i]; up[j][i][1] = u2[1][j][i]; }
            f32x2 P[32];
            f32x4 wc[4], wn[4];
#pragma unroll
            for (int j = 0; j < 4; ++j) wc[j] = *(const LAS f32x4*)(rwT + 4 * lane + 256 * j);
#pragma unroll
            for (int e = 0; e < 32; ++e) {
                if (e + 1 < 32) {
#pragma unroll
                    for (int j = 0; j < 4; ++j) wn[j] = *(const LAS f32x4*)(rwT + (e + 1) * RWS + 4 * lane + 256 * j); }
                f32x2 a0 = {0.f, 0.f}, a1 = {0.f, 0.f};
#pragma unroll
                for (int j = 0; j < 4; ++j) { f32x2 w0 = {wc[j][0], wc[j][0]}, w1 = {wc[j][1], wc[j][1]}, w2 = {wc[j][2], wc[j][2]}, w3 = {wc[j][3], wc[j][3]};
                    a0 = __builtin_elementwise_fma(up[j][0], w0, a0); a1 = __builtin_elementwise_fma(up[j][1], w1, a1); a0 = __builtin_elementwise_fma(up[j][2], w2, a0); a1 = __builtin_elementwise_fma(up[j][3], w3, a1); }
                P[e] = a0 + a1;
#pragma unroll
                for (int j = 0; j < 4; ++j) wc[j] = wn[j];
                if ((e & 3) == 3) __builtin_amdgcn_sched_barrier(0); }
#define RSTEP(N, MASK, CTRL) do { _Pragma("unroll") for (int i = 0; i < (N); ++i) { int lm_ = lane & (MASK); asm volatile("" : "+v"(lm_)); const bool up_ = lm_ != 0;     \
                const f32x2 sv = up_ ? P[i] : P[i + (N)], kv = up_ ? P[i + (N)] : P[i]; f32x2 rv; rv[0] = dpp_f<CTRL>(sv[0]); rv[1] = dpp_f<CTRL>(sv[1]); P[i] = kv + rv; } } while (0)
#define RSWAP(N, SWAPFN) do { _Pragma("unroll") for (int i = 0; i < (N); ++i) { _Pragma("unroll") for (int c_ = 0; c_ < 2; ++c_) { \
                const auto r_ = SWAPFN(__float_as_uint(P[i][c_]), __float_as_uint(P[i + (N)][c_]), false, false); P[i][c_] = __uint_as_float(r_[0]) + __uint_as_float(r_[1]); } } } while (0)
            RSWAP(16, __builtin_amdgcn_permlane32_swap); RSWAP(8, __builtin_amdgcn_permlane16_swap);
#undef RSWAP
            RSTEP(4, 8, 0x140); RSTEP(2, 4, 0x141); RSTEP(1, 2, 0x4E);
#undef RSTEP
            const int me = lane >> 1; const float rbv = rb[me];
            float lgs[2]; lgs[0] = P[0][0] + dpp_f<0xB1>(P[0][0]) + rbv; lgs[1] = P[0][1] + dpp_f<0xB1>(P[0][1]) + rbv;
            LAS float* lgbuf = (LAS float*)(F.lds + RSEL + 8192) + F.wave * 64;
            if ((lane & 1) == 0) { lgbuf[me] = lgs[0]; lgbuf[32 + me] = lgs[1]; }
            asm volatile("s_waitcnt lgkmcnt(0)" ::: "memory");
#pragma unroll
            for (int t = 0; t < 2; ++t) { const float mine = lgs[t]; int rank = 0;
#pragma unroll
                for (int e4 = 0; e4 < 8; ++e4) { const f32x4 v = *(const LAS f32x4*)(lgbuf + 32 * t + 4 * e4);
#pragma unroll
                    for (int i = 0; i < 4; ++i) { const int e = 4 * e4 + i; rank += (v[i] > mine || (v[i] == mine && e < me)) ? 1 : 0; } }
                float ls[4]; int es[4];
#pragma unroll
                for (int k = 0; k < 4; ++k) { const unsigned long long bal = __ballot(rank == k); const int first = __ffsll((long long)bal) - 1; es[k] = first >> 1; ls[k] = lgbuf[32 * t + es[k]]; }
                const float e1 = __expf(ls[1] - ls[0]), e2 = __expf(ls[2] - ls[0]), e3 = __expf(ls[3] - ls[0]); const float inv = 1.0f / (1.0f + e1 + e2 + e3);
                const int tl = tl0 + t;
                if (lane == 0) { sel_e[tl * 4 + 0] = es[0]; sel_e[tl * 4 + 1] = es[1]; sel_e[tl * 4 + 2] = es[2]; sel_e[tl * 4 + 3] = es[3];
                    sel_g[tl * 4 + 0] = inv; sel_g[tl * 4 + 1] = e1 * inv; sel_g[tl * 4 + 2] = e2 * inv; sel_g[tl * 4 + 3] = e3 * inv; } }
        }
        __syncthreads();
        const int myE = sel_e[F.tid];
        lpos[F.tid] = __hip_atomic_fetch_add(&lcnt[myE], 1u, __ATOMIC_RELAXED, __HIP_MEMORY_SCOPE_WORKGROUP);
        __syncthreads();
        if (F.tid < 32) lbase[F.tid] = atomicAdd(&gcnt[F.tid], lcnt[F.tid]);
        __syncthreads();
        { const unsigned slot = (unsigned)(r0 * 4 + F.tid); list[(size_t)myE * CAP + lbase[myE] + lpos[F.tid]] = slot; gates[slot] = sel_g[F.tid]; }
        __syncthreads();
    }
}

struct MoeOrder {
    const LAS int* meta;
    const unsigned* list; int c, G, ncol, rpx;
    __device__ bool next(int i, pg8::Unit& u) const {
        const int x = c & 7, j = c >> 3; const int g = (i * 8 + x) * rpx + j / ncol; const int total = meta[32];
        if (g >= total) return false;
        const int ln_ = (int)__builtin_amdgcn_mbcnt_hi(~0u, __builtin_amdgcn_mbcnt_lo(~0u, 0u)) & 31;
        const int e = __popc((unsigned)__ballot(meta[ln_ + 1] <= g));
        const int rt = g - meta[e], cnt = meta[64 + e];
        u.pm = g; u.pn = e * ncol + (j % ncol); u.a0 = e; u.a1 = rt; u.a2 = min(256, cnt - rt * 256); return true;
    }
    __device__ __forceinline__ unsigned arow(const pg8::Unit& u, int R) const { return (R < u.a2) ? (list[(size_t)u.a0 * CAP + u.a1 * 256 + R] >> 2) : 0u; }
    __device__ __forceinline__ unsigned rowval(const pg8::Unit& u, int R, unsigned v) const { return (R < u.a2) ? (v >> 2) : 0u; }
    __device__ __forceinline__ const unsigned* rows_ptr(const pg8::Unit& u) const { return list + (size_t)u.a0 * CAP + u.a1 * 256; }
};
__device__ __forceinline__ void moe_meta(Frame& F, int layer) {
    LAS int* meta = (LAS int*)(F.lds + META_OFF);
    const unsigned* gcnt = (const unsigned*)(KWS(F) + WS_CTL) + CW_CNT + layer * NE;
    if (F.tid < NE) { const int c = (int)__hip_atomic_load(&gcnt[F.tid], __ATOMIC_RELAXED, __HIP_MEMORY_SCOPE_AGENT); meta[64 + F.tid] = c; meta[96 + F.tid] = (c + 255) >> 8; }
    __syncthreads();
    if (F.tid <= NE) { int acc = 0;
#pragma unroll
        for (int e = 0; e < NE; ++e) { const int t = meta[96 + e]; acc += (e < F.tid) ? t : 0; }
        meta[F.tid] = acc; }
    __syncthreads();
}
struct EpiGU {
    static constexpr bool PERM = true, HAS_PRE = true, PERM256 = false;
    unsigned char* ACT; const float* bgu;
    __device__ __forceinline__ void pre(LAS unsigned char* dst, const pg8::Unit& u, int wid, int lane) const {
        if (wid == 1) { const int e = u.a0, pnl = u.pn - e * 8; const float* src = bgu + e * 2048 + (lane >> 5) * 1024 + pnl * 128 + (lane & 31) * 4;
            __builtin_amdgcn_global_load_lds((const unsigned*)src, (LAS unsigned*)dst, 16, 0, 0); } }
    __device__ __forceinline__ void operator()(const f32x4 (&acc)[2][2][4][2], const pg8::Unit& u, int wr, int wc, int fr, int fq, const LAS unsigned char* pre_) const {
        const int e = u.a0, pnl = u.pn - e * 8; const int lcol = wc * 32 + 8 * fq, ccol = pnl * 128 + lcol; const int row0 = u.pm * 256 + wr * 64 + fr;
        f32x2 bg[2][2], bl[2][2];
#pragma unroll
        for (int n = 0; n < 2; ++n) { const f32x4 g4 = *(const LAS f32x4*)(pre_ + (lcol + 4 * n) * 4), l4 = *(const LAS f32x4*)(pre_ + 512 + (lcol + 4 * n) * 4);
            bg[n][0] = (f32x2){g4[0], g4[1]}; bg[n][1] = (f32x2){g4[2], g4[3]}; bl[n][0] = (f32x2){l4[0] + 1.0f, l4[1] + 1.0f}; bl[n][1] = (f32x2){l4[2] + 1.0f, l4[3] + 1.0f}; }
        const f32x2 s2 = {1.0f / WGU_SCALE, 1.0f / WGU_SCALE}, c2 = {-1.702f * 1.4426950408889634f, -1.702f * 1.4426950408889634f}, one2 = {1.0f, 1.0f};
#pragma unroll
        for (int ai = 0; ai < 2; ++ai)
#pragma unroll
            for (int m = 0; m < 4; ++m) { unsigned char* rowp = ACT + (size_t)(row0 + ai * 128 + m * 16) * 1024 + ccol; f32x2 o[2][2];
#pragma unroll
                for (int n = 0; n < 2; ++n)
#pragma unroll
                    for (int h = 0; h < 2; ++h) { const f32x4 A4 = acc[ai][0][m][n], L4 = acc[ai][1][m][n];
                        f32x2 gv = __builtin_elementwise_fma((f32x2){A4[2 * h], A4[2 * h + 1]}, s2, bg[n][h]), lv = __builtin_elementwise_fma((f32x2){L4[2 * h], L4[2 * h + 1]}, s2, bl[n][h]);
                        gv[0] = fminf(gv[0], 7.0f); gv[1] = fminf(gv[1], 7.0f);
                        lv[0] = __builtin_amdgcn_fmed3f(lv[0], -6.0f, 8.0f); lv[1] = __builtin_amdgcn_fmed3f(lv[1], -6.0f, 8.0f);
                        const f32x2 t = gv * c2; f32x2 d = {__builtin_amdgcn_exp2f(t[0]), __builtin_amdgcn_exp2f(t[1])}; d = d + one2;
                        const f32x2 r = {__builtin_amdgcn_rcpf(d[0]), __builtin_amdgcn_rcpf(d[1])};
                        o[n][h] = gv * r * lv; }
                u32x2 w; w.x = pk4_fp8(o[0][0][0], o[0][0][1], o[0][1][0], o[0][1][1]); w.y = pk4_fp8(o[1][0][0], o[1][0][1], o[1][1][0], o[1][1][1]);
                *(u32x2*)rowp = w; }
    }
};
struct EpiDown {
    static constexpr bool PERM = true, HAS_PRE = true, PERM256 = true;
    unsigned char* YB; const float* bd; const unsigned* list;
    __device__ __forceinline__ void pre(LAS unsigned char* dst, const pg8::Unit& u, int wid, int lane) const {
        const int e = u.a0, rt = u.a1, pnl = u.pn - e * 4;
        if (wid == 1) __builtin_amdgcn_global_load_lds((const unsigned*)(bd + e * 1024 + pnl * 256 + lane * 4), (LAS unsigned*)dst, 16, 0, 0);
        if (wid == 2) __builtin_amdgcn_global_load_lds((const unsigned*)(list + (size_t)e * CAP + rt * 256 + lane * 4), (LAS unsigned*)(dst + 1024), 16, 0, 0); }
    __device__ __forceinline__ void operator()(const f32x4 (&acc)[2][2][4][2], const pg8::Unit& u, int wr, int wc, int fr, int fq, const LAS unsigned char* pre_) const {
        const int e = u.a0, pnl = u.pn - e * 4; const int lcol = wc * 64 + fq * 16, col = pnl * 256 + lcol;
        f32x4 bv[2][2];
#pragma unroll
        for (int bj = 0; bj < 2; ++bj)
#pragma unroll
            for (int n = 0; n < 2; ++n) bv[bj][n] = *(const LAS f32x4*)(pre_ + (lcol + bj * 8 + 4 * n) * 4);
#pragma unroll
        for (int ai = 0; ai < 2; ++ai)
#pragma unroll
            for (int m = 0; m < 4; ++m) { const int R = ai * 128 + wr * 64 + m * 16 + fr; if (R >= u.a2) continue;
                const unsigned slot = *(const LAS unsigned*)(pre_ + 1024 + R * 4); unsigned char* rowp = YB + (size_t)slot * 1024 + col;
                u32x4 w;
#pragma unroll
                for (int bj = 0; bj < 2; ++bj) { const f32x4 v0 = acc[ai][bj][m][0] * (1.0f / WD_SCALE) + bv[bj][0], v1 = acc[ai][bj][m][1] * (1.0f / WD_SCALE) + bv[bj][1];
                    w[2 * bj] = pk4_fp8(v0[0], v0[1], v0[2], v0[3]); w[2 * bj + 1] = pk4_fp8(v1[0], v1[1], v1[2], v1[3]); }
                *(u32x4*)rowp = w; }
    }
};

__device__ __forceinline__ void ph_combine(Frame& F, int layer, float* hout, bool next_mod) {
    const float* mod = (const float*)(KWS(F) + WS_MOD) + (size_t)(layer * 3) * 6144;
    const float* modn = (const float*)(KWS(F) + WS_MOD) + (size_t)3 * 6144;
    const bf16_t* H1 = (const bf16_t*)(KWS(F) + WS_H1); const unsigned char* YB = (const unsigned char*)(KWS(F) + WS_YB); const float* gates = (const float*)(KWS(F) + WS_GATES);
    const float* lng = KIN(F, 8) + layer * DM; const float* lnb = KIN(F, 9) + layer * DM; unsigned char* U = (unsigned char*)(KWS(F) + WS_U);
    const int gw = F.bx * NWAVES + F.wave, NGW = F.G * NWAVES, lane = F.lane;
    LAS float* vC = (LAS float*)F.lds;
    for (int i = F.tid; i < 2 * DM; i += NTHR) { const int b = i >> 10, d = i & (DM - 1); LAS float* v = vC + b * 5 * DM + d;
        v[0] = mod[b * 6144 + 5120 + d]; v[DM] = lng[d]; v[2 * DM] = lnb[d]; v[3 * DM] = modn[b * 6144 + 1024 + d] + 1.0f; v[4 * DM] = modn[b * 6144 + d]; }
    __syncthreads();
    u32x2 nh[4]; unsigned nyb[4][4]; f32x4 ngt;
#define CMB_LOAD(r_) do { _Pragma("unroll") for (int j = 0; j < 4; ++j) { const int d = 4 * lane + 256 * j; nh[j] = *(const u32x2*)(H1 + (size_t)(r_) * DM + d); \
        _Pragma("unroll") for (int k = 0; k < 4; ++k) nyb[j][k] = *(const unsigned*)(YB + ((size_t)(r_) * 4 + k) * DM + d); } ngt = *(const f32x4*)(gates + (size_t)(r_) * 4); } while (0)
    if (gw < T) CMB_LOAD(gw);
    for (int row = gw; row < T; row += NGW) {
        int vb = (row >> 14) * 5 * DM + 4 * lane; asm volatile("" : "+v"(vb));
        const LAS float* vr = vC + vb;
        f32x4 ch[4]; unsigned cyb[4][4]; const f32x4 gt = ngt;
#pragma unroll
        for (int j = 0; j < 4; ++j) { const u32x2 hw_ = nh[j]; ch[j][0] = __uint_as_float(hw_.x << 16); ch[j][1] = __uint_as_float(hw_.x & 0xffff0000u); ch[j][2] = __uint_as_float(hw_.y << 16); ch[j][3] = __uint_as_float(hw_.y & 0xffff0000u);
#pragma unroll
            for (int k = 0; k < 4; ++k) cyb[j][k] = nyb[j][k]; }
        if (row + NGW < T) CMB_LOAD(row + NGW);
        f32x4 pre[4]; float s = 0.f;
#pragma unroll
        for (int j = 0; j < 4; ++j) { f32x4 y = {0.f, 0.f, 0.f, 0.f};
#pragma unroll
            for (int k = 0; k < 4; ++k) { const unsigned yw = cyb[j][k]; const f32x2 lo = __builtin_amdgcn_cvt_pk_f32_fp8((int)yw, false), hi2 = __builtin_amdgcn_cvt_pk_f32_fp8((int)yw, true);
                const f32x4 v = {lo[0], lo[1], hi2[0], hi2[1]};
                y += v * gt[k]; }
            pre[j] = ch[j] * ALPHA + *(const LAS f32x4*)(vr + 256 * j) * y; s += (pre[j][0] + pre[j][1]) + (pre[j][2] + pre[j][3]); }
        const float mean = wave_sum(s) * (1.0f / DM); float q2 = 0.f;
#pragma unroll
        for (int j = 0; j < 4; ++j) { pre[j] = pre[j] - mean; q2 += (pre[j][0] * pre[j][0] + pre[j][1] * pre[j][1]) + (pre[j][2] * pre[j][2] + pre[j][3] * pre[j][3]); }
        const float rstd = 1.0f / sqrtf(wave_sum(q2) * (1.0f / DM) + LN_EPS);
#pragma unroll
        for (int j = 0; j < 4; ++j) { const int d = 4 * lane + 256 * j; const f32x4 h = pre[j] * rstd * *(const LAS f32x4*)(vr + DM + 256 * j) + *(const LAS f32x4*)(vr + 2 * DM + 256 * j);
            if (next_mod) { u32x2 hw_; hw_.x = pk2(h[0], h[1]); hw_.y = pk2(h[2], h[3]); *(u32x2*)((bf16_t*)hout + (size_t)row * DM + d) = hw_; }
            else *(f32x4*)(hout + (size_t)row * DM + d) = h;
            if (next_mod) { const f32x4 v = h * *(const LAS f32x4*)(vr + 3 * DM + 256 * j) + *(const LAS f32x4*)(vr + 4 * DM + 256 * j);
                *(unsigned*)(U + (size_t)row * DM + d) = pk4_fp8(v[0], v[1], v[2], v[3]); } }
    }
#undef CMB_LOAD
}

__device__ __forceinline__ void ph_gmlp(Frame& F) {
    const bf16_t* Z = (const bf16_t*)(KWS(F) + WS_ZODD); unsigned char* MIX = (unsigned char*)(KWS(F) + WS_MIX);
    const float* lg = KIN(F, 23); const float* lb = KIN(F, 24); const float* bs = KIN(F, 26); const bf16_t* wsb = (const bf16_t*)(KWS(F) + WS_TAB + TB_WS);
    const int lane = F.lane, r32 = lane & 31, hi = lane >> 5, wid = F.wave;
    for (int chunk = F.bx; chunk < T / 128; chunk += F.G) {
        const int r0 = chunk * 128;
        for (int qq = 0; qq < 16; ++qq) { const int q = wid * 16 + qq; const bf16x8 raw = *(const bf16x8*)(Z + (size_t)(r0 + q) * 1536 + 512 + 8 * lane);
            float v[8]; float s = 0.f;
#pragma unroll
            for (int j = 0; j < 8; ++j) { v[j] = bf2f((unsigned short)raw[j]); s += v[j]; }
            const float mean = wave_sum(s) * (1.0f / 512.0f); float q2 = 0.f;
#pragma unroll
            for (int j = 0; j < 8; ++j) { v[j] -= mean; q2 += v[j] * v[j]; }
            const float rstd = 1.0f / sqrtf(wave_sum(q2) * (1.0f / 512.0f) + LN_EPS);
            const f32x4 g0 = *(const f32x4*)(lg + 8 * lane), g1 = *(const f32x4*)(lg + 8 * lane + 4), b0 = *(const f32x4*)(lb + 8 * lane), b1 = *(const f32x4*)(lb + 8 * lane + 4);
            u32x4 w; w.x = pk2(v[0] * rstd * g0[0] + b0[0], v[1] * rstd * g0[1] + b0[1]); w.y = pk2(v[2] * rstd * g0[2] + b0[2], v[3] * rstd * g0[3] + b0[3]);
            w.z = pk2(v[4] * rstd * g1[0] + b1[0], v[5] * rstd * g1[1] + b1[1]); w.w = pk2(v[6] * rstd * g1[2] + b1[2], v[7] * rstd * g1[3] + b1[3]);
            const int ch = 8 * lane, g = ch >> 7, col = ch & 127, kt = (q >> 6) * 4 + g;
            *(LAS u32x4*)(F.lds + kt * 16384 + v_st(q & 63, col)) = w; }
        __syncthreads();
        const int pb = wid & 3, gh = wid >> 2;
#pragma unroll 1
        for (int gi = 0; gi < 2; ++gi) { const int g = 2 * gh + gi;
            unsigned wofs = (unsigned)(((g * 128 + 32 * pb + r32) * 128 + 8 * hi) * 2); asm volatile("" : "+v"(wofs));
            f32x16 acc[4];
#pragma unroll
            for (int d0 = 0; d0 < 4; ++d0) acc[d0] = f32x16{};
            bf16x8 af[8];
#pragma unroll
            for (int ks = 0; ks < 8; ++ks) af[ks] = *(const bf16x8*)((const char*)wsb + wofs + 32 * ks);
#pragma unroll
            for (int ks = 0; ks < 8; ++ks) {
                LAS unsigned char* trd = F.lds + ((ks >> 2) * 4 + g) * 16384 + v_rd_base(lane);
#pragma unroll
                for (int d0 = 0; d0 < 4; ++d0) acc[d0] = __builtin_amdgcn_mfma_f32_32x32x16_bf16(af[ks], vfrag(trd, d0, ks & 3), acc[d0], 0, 0, 0); }
            unsigned short uraw[16][4]; float bias[16];
#pragma unroll
            for (int r = 0; r < 16; ++r) { const int p = 32 * pb + crow(r, hi); bias[r] = bs[g * 128 + p];
#pragma unroll
                for (int d0 = 0; d0 < 4; ++d0) uraw[r][d0] = Z[(size_t)(r0 + p) * 1536 + g * 128 + d0 * 32 + r32]; }
            asm volatile("" ::: "memory");
#pragma unroll
            for (int r = 0; r < 16; ++r) { const int p = 32 * pb + crow(r, hi);
                *(unsigned*)(MIX + (size_t)(r0 + p) * 1024 + g * 128 + 4 * r32) = pk4_fp8(bf2f(uraw[r][0]) * (acc[0][r] + bias[r]), bf2f(uraw[r][1]) * (acc[1][r] + bias[r]), bf2f(uraw[r][2]) * (acc[2][r] + bias[r]), bf2f(uraw[r][3]) * (acc[3][r] + bias[r])); }
        }
        __syncthreads();
    }
}

__device__ __forceinline__ void ph_fourier1(Frame& F) {
    const bf16_t* Z = (const bf16_t*)(KWS(F) + WS_ZODD); bf16_t* WT = (bf16_t*)(KWS(F) + WS_WT);
    const float* lg = KIN(F, 27); const float* lb = KIN(F, 28);
    const bf16x8* CSf = (const bf16x8*)(KWS(F) + WS_TAB + TB_CS); const bf16x8* AFf = (const bf16x8*)(KWS(F) + WS_TAB + TB_AF); const f32x2* tw = (const f32x2*)(KWS(F) + WS_TAB + TB_TW);
    const int lane = F.lane, r32 = lane & 31, hi = lane >> 5, wid = F.wave;
    for (int unit = F.bx; unit < NB * 128; unit += F.G) {
        const int b = unit >> 7, t2 = unit & 127;
#pragma unroll 1
        for (int g = 0; g < 4; ++g) {
            {
                int lane_g = lane; asm volatile("" : "+v"(lane_g)); const int r32 = lane_g & 31, hi = lane_g >> 5;
                const int tb = wid & 3, part = wid >> 2; int t1 = 32 * tb + r32; asm volatile("" : "+v"(t1)); const size_t row = (size_t)b * SEQ + 128 * t1 + t2;
                bf16x8 raw[8]; float s = 0.f;
#pragma unroll
                for (int ks = 0; ks < 8; ++ks) { raw[ks] = *(const bf16x8*)(Z + row * 1536 + 1024 + g * 128 + 16 * ks + 8 * hi);
#pragma unroll
                    for (int j = 0; j < 8; ++j) s += bf2f((unsigned short)raw[ks][j]); }
                s = xhalf_sum(s); const float mean = s * (1.0f / 128.0f); float q2 = 0.f;
#pragma unroll
                for (int ks = 0; ks < 8; ++ks)
#pragma unroll
                    for (int j = 0; j < 8; ++j) { const float d = bf2f((unsigned short)raw[ks][j]) - mean; q2 += d * d; }
                q2 = xhalf_sum(q2); const float rstd = 1.0f / sqrtf(q2 * (1.0f / 128.0f) + LN_EPS);
                bf16x8 af[8];
#pragma unroll
                for (int ks = 0; ks < 8; ++ks) { const int c0 = g * 128 + 16 * ks + 8 * hi; const f32x4 g0 = *(const f32x4*)(lg + c0), g1 = *(const f32x4*)(lg + c0 + 4), b0 = *(const f32x4*)(lb + c0), b1 = *(const f32x4*)(lb + c0 + 4);
                    float x[8];
#pragma unroll
                    for (int j = 0; j < 8; ++j) x[j] = (bf2f((unsigned short)raw[ks][j]) - mean) * rstd;
                    u32x4 w; w.x = pk2(x[0] * g0[0] + b0[0], x[1] * g0[1] + b0[1]); w.y = pk2(x[2] * g0[2] + b0[2], x[3] * g0[3] + b0[3]);
                    w.z = pk2(x[4] * g1[0] + b1[0], x[5] * g1[1] + b1[1]); w.w = pk2(x[6] * g1[2] + b1[2], x[7] * g1[3] + b1[3]);
                    af[ks] = __builtin_bit_cast(bf16x8, w); }
                f32x16 acc[4];
#pragma unroll
                for (int d0 = 0; d0 < 4; ++d0) acc[d0] = f32x16{};
#pragma unroll
                for (int ks = 0; ks < 8; ++ks) { unsigned fo = (unsigned)(((4 * part) * 8 + ks) * 64 + lane) * 16u; asm volatile("" : "+v"(fo));
#pragma unroll
                    for (int d0 = 0; d0 < 4; ++d0) acc[d0] = __builtin_amdgcn_mfma_f32_32x32x16_bf16(af[ks], *(const bf16x8*)((const char*)CSf + fo + d0 * 8192), acc[d0], 0, 0, 0); }
                int ybase = (part * 2 + (tb >> 1)) * 16384 + (tb & 1) * 8192 + hi * 2048 + r32 * 2; asm volatile("" : "+v"(ybase));
#pragma unroll
                for (int r = 0; r < 16; ++r)
#pragma unroll
                    for (int d0 = 0; d0 < 4; ++d0) *(LAS bf16_t*)(F.lds + ybase + ((r >> 3) & 1) * 4096 + d0 * 512 + ((r & 3) + 4 * ((r >> 2) & 1)) * 64) = (bf16_t)f2bf(acc[d0][r]);
            }
            __syncthreads();
            {
                const int kb = wid & 3, ch2 = wid >> 2;
                f32x16 aR[2], aI[2];
#pragma unroll
                for (int dd = 0; dd < 2; ++dd) { aR[dd] = f32x16{}; aI[dd] = f32x16{}; }
#pragma unroll
                for (int kh = 0; kh < 4; ++kh) {
                    unsigned fo = (unsigned)((kb * 16 + kh * 4) * 64 + lane) * 16u; asm volatile("" : "+v"(fo));
                    bf16x8 fr8[4], fi8[4];
#pragma unroll
                    for (int k8 = 0; k8 < 4; ++k8) { fr8[k8] = *(const bf16x8*)((const char*)AFf + fo + k8 * 1024); fi8[k8] = *(const bf16x8*)((const char*)AFf + fo + k8 * 1024 + 65536); }
#pragma unroll
                    for (int k8 = 0; k8 < 4; ++k8) { const int ks = kh * 4 + k8;
                        LAS unsigned char* trd = F.lds + (ks >> 2) * 16384 + v_rd_base(lane);
#pragma unroll
                        for (int dd = 0; dd < 2; ++dd) { const bf16x8 bf = vfrag(trd, 2 * ch2 + dd, ks & 3);
                            aR[dd] = __builtin_amdgcn_mfma_f32_32x32x16_bf16(fr8[k8], bf, aR[dd], 0, 0, 0); aI[dd] = __builtin_amdgcn_mfma_f32_32x32x16_bf16(fi8[k8], bf, aI[dd], 0, 0, 0); } }
                }
                int k1b = 32 * kb + 4 * hi; asm volatile("" : "+v"(k1b));
                f32x2 csv[16];
#pragma unroll
                for (int r = 0; r < 16; ++r) csv[r] = tw[t2 * 128 + k1b + (r & 3) + 8 * (r >> 2)];
                asm volatile("" ::: "memory");
#pragma unroll
                for (int r = 0; r < 16; ++r) { const int k1 = k1b + (r & 3) + 8 * (r >> 2); const f32x2 cs = csv[r];
                    bf16_t* dst = WT + ((((size_t)b * 128 + k1) * 128 + t2) * 4 + g) * 256;
#pragma unroll
                    for (int dd = 0; dd < 2; ++dd) { const float wr_ = aR[dd][r], wi_ = aI[dd][r]; const int j = 32 * (2 * ch2 + dd) + r32;
                        dst[j] = (bf16_t)f2bf(wr_ * cs[0] + wi_ * cs[1]); dst[128 + j] = (bf16_t)f2bf(wi_ * cs[0] - wr_ * cs[1]); }
                    if ((r & 3) == 3) asm volatile("" ::: "memory"); }
            }
            __syncthreads();
        }
    }
}
__device__ __forceinline__ void ph_fourier2(Frame& F) {
    const bf16_t* WT = (const bf16_t*)(KWS(F) + WS_WT); unsigned char* MIX = (unsigned char*)(KWS(F) + WS_MIX);
    const bf16x8* A3f = (const bf16x8*)(KWS(F) + WS_TAB + TB_A3);
    const int lane = F.lane, r32 = lane & 31, hi = lane >> 5, wid = F.wave;
    for (int unit = F.bx; unit < NB * 128; unit += F.G) {
        const int b = unit >> 7, k1 = unit & 127;
#pragma unroll 1
        for (int g = 0; g < 4; ++g) {
            for (int idx = F.tid; idx < 4096; idx += NTHR) { const int t2 = idx >> 5, c = idx & 31, part = c >> 4, j0 = (c & 15) * 8;
                const u32x4 v = *(const u32x4*)(WT + ((((size_t)b * 128 + k1) * 128 + t2) * 4 + g) * 256 + part * 128 + j0);
                *(LAS u32x4*)(F.lds + (part * 2 + (t2 >> 6)) * 16384 + v_st(t2 & 63, j0)) = v; }
            __syncthreads();
            const int mb = wid & 3, ch2 = wid >> 2;
            f32x16 acc[2] = {f32x16{}, f32x16{}};
#pragma unroll
            for (int ks = 0; ks < 16; ++ks) { unsigned fo = (unsigned)((mb * 16 + ks) * 64 + lane) * 16u; asm volatile("" : "+v"(fo)); const bf16x8 af = *(const bf16x8*)((const char*)A3f + fo);
                LAS unsigned char* trd = F.lds + (ks >> 2) * 16384 + v_rd_base(lane);
#pragma unroll
                for (int dd = 0; dd < 2; ++dd) acc[dd] = __builtin_amdgcn_mfma_f32_32x32x16_bf16(af, vfrag(trd, 2 * ch2 + dd, ks & 3), acc[dd], 0, 0, 0); }
#pragma unroll
            for (int r = 0; r < 16; ++r) { const int k2 = 32 * mb + crow(r, hi); const size_t row = (size_t)b * SEQ + k1 + 128 * k2;
                { const unsigned w2_ = pk4_fp8(acc[0][r], acc[1][r], 0.f, 0.f); *(unsigned short*)(MIX + row * 1024 + 512 + g * 128 + 4 * r32 + 2 * ch2) = (unsigned short)(w2_ & 0xffffu); } }
            __syncthreads();
        }
    }
}

#ifndef MK_ONE_LAUNCH
#define MK_ONE_LAUNCH 1
#endif
constexpr int NPH = 18;
#ifndef PHMASK
#define PHMASK 0x3FFFF
#endif
#define HAS(k) (((PHMASK) >> (k)) & 1)
__global__ void __launch_bounds__(NTHR, 2) fwd_kernel(Args args) {
    extern __shared__ __attribute__((aligned(16))) unsigned char lds_raw[];
    Frame F;
    F.lds = (LAS unsigned char*)lds_raw; F.tid = threadIdx.x; F.lane = F.tid & 63; F.wave = __builtin_amdgcn_readfirstlane(F.tid >> 6); F.G = gridDim.x; F.bx = blockIdx.x;
    F.kz = 0;
    volatile LAS unsigned* MISC = (volatile LAS unsigned*)(F.lds + MISC_OFF);
    if (F.tid < 64) MISC[F.tid] = 0u;
    __syncthreads();
    if (MK_ONE_LAUNCH) (void)xcd_barrier_post((unsigned*)(args.ws + WS_CTL) + CW_BAR, MISC + 8);
    const int lo = args.ph_lo, hi = args.ph_hi;
#define IN(k) (lo <= (k) && (k) < hi)
#ifndef REPMASK
#define REPMASK 0
#endif
#define REP(k) (((REPMASK) >> (k)) & 1)
#define BARNOW() do { ENTER(); XcdBarrier bar_; bar_.bar = (unsigned*)(KWS(F) + WS_CTL) + CW_BAR; bar_.x = xb_xcc_id(); bar_.st = (volatile LAS unsigned*)(F.lds + MISC_OFF) + 8; xcd_barrier(bar_); } while (0)
#ifndef DIAG_PH
#define DIAG_PH -1
#endif
    int nstamp = 0;
#define STAMP() do { if (DIAG_PH >= 0) { if (F.tid == 0) ((volatile LAS unsigned*)(F.lds + MISC_OFF))[16 + nstamp] = (unsigned)__builtin_amdgcn_s_memrealtime(); ++nstamp; } } while (0)
    STAMP();
#define ENTER() do { asm volatile("" : "+s"(F.kz), "+s"(F.wave), "+s"(F.G), "+s"(F.bx), "+v"(F.tid), "+v"(F.lane)); F.kz = __builtin_amdgcn_readfirstlane(F.kz); F.wave = __builtin_amdgcn_readfirstlane(F.wave); \
    F.G = __builtin_amdgcn_readfirstlane(F.G); F.bx = __builtin_amdgcn_readfirstlane(F.bx); } while (0)
#define SEAM(k) do { if (IN(k) && IN((k) + 1)) { if (MK_ONE_LAUNCH) { ENTER(); XcdBarrier bar_; bar_.bar = (unsigned*)(KWS(F) + WS_CTL) + CW_BAR; bar_.x = xb_xcc_id(); bar_.st = (volatile LAS unsigned*)(F.lds + MISC_OFF) + 8; xcd_barrier(bar_); STAMP(); } } } while (0)

    if (HAS(0) && IN(0)) { ENTER(); for (int rep_ = 0; rep_ <= REP(0); ++rep_) { if (rep_) BARNOW(); ph0_mod_tables(F); } } SEAM(0);
    if (HAS(1) && IN(1)) { ENTER(); for (int rep_ = 0; rep_ <= REP(1); ++rep_) { if (rep_) BARNOW(); ph1_convert(F); } } SEAM(1);
    if (HAS(2) && IN(2)) { ENTER(); for (int rep_ = 0; rep_ <= REP(2); ++rep_) { if (rep_) BARNOW(); ph2_modulate(F); } } SEAM(2);

    for (int layer = 0; layer < 2; ++layer) {
        const int pb = layer == 0 ? 5 : 13;
        if (layer == 0) {
            if (HAS(3) && IN(3)) { ENTER(); for (int rep_ = 0; rep_ <= REP(3); ++rep_) { if (rep_) BARNOW();
                pg8::Gemm g{(const bf16_t*)(KWS(F) + WS_U), (const bf16_t*)(KWS(F) + WS_WEVIN), T, 2560, DM / 2};
                EvInOrder S; S.so.init(T, 2560, F.G, F.bx);
                EpiEvIn E{(unsigned char*)(KWS(F) + WS_Q), (unsigned char*)(KWS(F) + WS_K), (unsigned char*)(KWS(F) + WS_V), (bf16_t*)(KWS(F) + WS_AB), (const float*)(KWS(F) + WS_TAB + TB_COS), (const float*)(KWS(F) + WS_TAB + TB_SIN)};
                pg8::gemm_phase<EpiEvIn, EvInOrder, true, false, true>(F.lds, g, S, E, F.tid);
            } } SEAM(3);
            if (HAS(4) && IN(4)) { ENTER(); for (int rep_ = 0; rep_ <= REP(4); ++rep_) { if (rep_) BARNOW(); ph4_conv(F); ph4_attention(F); } } SEAM(4);
        } else {
            if (HAS(10) && IN(10)) { ENTER(); for (int rep_ = 0; rep_ <= REP(10); ++rep_) { if (rep_) BARNOW();
                pg8::Gemm g{(const bf16_t*)(KWS(F) + WS_U), (const bf16_t*)(KWS(F) + WS_WODIN), T, 1536, DM / 2};
                pg8::StaticOrder S; S.init(T, 1536, F.G, F.bx);
                pg8::EpiBf16 E{(bf16_t*)(KWS(F) + WS_ZODD), 1536, 4, 1.0f / WI_SCALE};
                pg8::gemm_phase<pg8::EpiBf16, pg8::StaticOrder, true, false, true>(F.lds, g, S, E, F.tid);
            } } SEAM(10);
            if (HAS(11) && IN(11)) { ENTER(); for (int rep_ = 0; rep_ <= REP(11); ++rep_) { if (rep_) BARNOW(); ph_gmlp(F); ph_fourier1(F); } } SEAM(11);
            if (HAS(12) && IN(12)) { ENTER(); for (int rep_ = 0; rep_ <= REP(12); ++rep_) { if (rep_) BARNOW(); ph_fourier2(F); } } SEAM(12);
        }
        if (HAS(5) && IN(pb)) { ENTER(); for (int rep_ = 0; rep_ <= REP(5); ++rep_) { if (rep_) BARNOW();
            pg8::Gemm g{(const bf16_t*)(KWS(F) + WS_MIX), (const bf16_t*)(KWS(F) + (layer == 0 ? WS_WEVOUT : WS_WODOUT)), T, DM, DM / 2};
            pg8::StaticOrder S; S.init(T, DM, F.G, F.bx);
            pg8::EpiBf16 E{(bf16_t*)(KWS(F) + WS_Y), DM, 0, 1.0f / WO_SCALE};
            pg8::gemm_phase<pg8::EpiBf16, pg8::StaticOrder, true, false, true>(F.lds, g, S, E, F.tid);
        } } SEAM(pb);
        if (HAS(6) && IN(pb + 1)) { ENTER(); for (int rep_ = 0; rep_ <= REP(6); ++rep_) { if (rep_) BARNOW(); ph_router(F, layer, layer == 0 ? KIN(F, 0) : (const float*)(KWS(F) + WS_H2)); } } SEAM(pb + 1);
        if (HAS(7) && IN(pb + 2)) { ENTER(); for (int rep_ = 0; rep_ <= REP(7); ++rep_) { if (rep_) BARNOW();
            moe_meta(F, layer);
            pg8::Gemm g{(const bf16_t*)(KWS(F) + WS_U2), (const bf16_t*)(KWS(F) + WS_WGU + (size_t)layer * NE * 2048 * DM), 0, 0, DM / 2};
            MoeOrder S{(const LAS int*)(F.lds + META_OFF), (const unsigned*)(KWS(F) + WS_LIST), F.bx, F.G, 8, 4};
            EpiGU E{(unsigned char*)(KWS(F) + WS_ACT), KIN(F, 32) + (size_t)layer * NE * 2048};
            pg8::gemm_phase<EpiGU, MoeOrder, true, true, true>(F.lds, g, S, E, F.tid);
        } } SEAM(pb + 2);
        if (HAS(8) && IN(pb + 3)) { ENTER(); for (int rep_ = 0; rep_ <= REP(8); ++rep_) { if (rep_) BARNOW();
            moe_meta(F, layer);
            pg8::Gemm g{(const bf16_t*)(KWS(F) + WS_ACT), (const bf16_t*)(KWS(F) + WS_WD + (size_t)layer * NE * 1024 * DM), 0, 0, DM / 2};
            MoeOrder S{(const LAS int*)(F.lds + META_OFF), (const unsigned*)(KWS(F) + WS_LIST), F.bx, F.G, 4, 8};
            EpiDown E{(unsigned char*)(KWS(F) + WS_YB), KIN(F, 34) + (size_t)layer * NE * 1024, (const unsigned*)(KWS(F) + WS_LIST)};
            pg8::gemm_phase<EpiDown, MoeOrder, true, false, true>(F.lds, g, S, E, F.tid);
        } } SEAM(pb + 3);
        if (HAS(9) && IN(pb + 4)) { ENTER(); for (int rep_ = 0; rep_ <= REP(9); ++rep_) { if (rep_) BARNOW(); ph_combine(F, layer, layer == 0 ? (float*)(KWS(F) + WS_H2) : KOUT(F), layer == 0); } }
        if (layer == 0) SEAM(pb + 4);
    }
    if (DIAG_PH >= 0) {
        ENTER(); XcdBarrier bar_; bar_.bar = (unsigned*)(KWS(F) + WS_CTL) + CW_BAR; bar_.x = xb_xcc_id(); bar_.st = (volatile LAS unsigned*)(F.lds + MISC_OFF) + 8; xcd_barrier(bar_); STAMP();
        __syncthreads();
        volatile LAS unsigned* st = (volatile LAS unsigned*)(F.lds + MISC_OFF) + 16;
        const unsigned d = st[DIAG_PH + 1] - st[DIAG_PH];
        const float c = sqrtf((float)d * 0.01f);
        float* o = KOUT(F);
        for (size_t i = (size_t)F.bx * NTHR + F.tid; i < (size_t)T * DM; i += (size_t)F.G * NTHR) o[i] = c;
    }
#undef IN
#undef SEAM
}

extern "C" void kernel_launch(void* const* d_in, const int* in_sizes, int n_in, void* d_out, int out_size, void* d_ws, size_t ws_size, hipStream_t stream) {
    static int grid = 0;
    if (grid == 0) {
        if (n_in != 35 || out_size != T * DM || ws_size < WS_END) { fprintf(stderr, "kernel_launch: unexpected shapes: n_in %d out %d ws %zu (need %zu)\n", n_in, out_size, ws_size, (size_t)WS_END); grid = -1; return; }
        int dev = 0, cus = 0;
        if (hipGetDevice(&dev) != hipSuccess || hipDeviceGetAttribute(&cus, hipDeviceAttributeMultiprocessorCount, dev) != hipSuccess) { grid = -1; return; }
        if (hipFuncSetAttribute((const void*)fwd_kernel, hipFuncAttributeMaxDynamicSharedMemorySize, LDS_BYTES) != hipSuccess) { fprintf(stderr, "kernel_launch: hipFuncSetAttribute failed\n"); grid = -1; return; }
        int per_cu = 0; (void)hipOccupancyMaxActiveBlocksPerMultiprocessor(&per_cu, (const void*)fwd_kernel, NTHR, LDS_BYTES); (void)hipGetLastError();
        if (per_cu < 1) fprintf(stderr, "kernel_launch: occupancy query reports %d blocks per CU\n", per_cu);
        grid = cus > 256 ? 256 : cus;
        if (grid != 256) fprintf(stderr, "kernel_launch: %d CUs; this kernel is laid out for 256\n", cus);
    }
    if (grid < 0) return;
    (void)hipMemsetAsync((char*)d_ws + WS_CTL, 0, CTL_ZERO_BYTES, stream);
    Args a{};
    for (int i = 0; i < 35; ++i) a.in[i] = (const float*)d_in[i];
    a.out = (float*)d_out; a.ws = (unsigned char*)d_ws;
#if MK_ONE_LAUNCH
    a.ph_lo = 0; a.ph_hi = NPH;
    hipLaunchKernelGGL(fwd_kernel, dim3(grid), dim3(NTHR), LDS_BYTES, stream, a);
#else
    for (int p = 0; p < NPH; ++p) { a.ph_lo = p; a.ph_hi = p + 1; hipLaunchKernelGGL(fwd_kernel, dim3(grid), dim3(NTHR), LDS_BYTES, stream, a); }
#endif
    const hipError_t le = hipPeekAtLastError();
    if (le != hipSuccess) fprintf(stderr, "kernel_launch: launch failed: %s\n", hipGetErrorName(le));
}
```
